# Optimizing an MI355X kernel written in HIP

```python
import math
import jax, jax.numpy as jnp
from jax import lax
import numpy as np

D_MODEL = 2048
BATCH = 4
SEQ = 4096
DEPTH = 4

N_MIXERS = 3
MEM_LEN = 256
MIX_WIDTH = D_MODEL * 3 // 4
MEM_HEADS = 4
MEM_HEAD_DIM = (D_MODEL - MIX_WIDTH) // MEM_HEADS
MEM_WIDTH = MEM_HEADS * MEM_HEAD_DIM
RWKV_HEAD_DIM = 64
RWKV_HEADS = MIX_WIDTH // RWKV_HEAD_DIM
DECAY_LORA = 96
AAA_LORA = 96
GATE_LORA = 256
RWKV_GN_EPS = 64e-5
RWKV_SPLITS = (MIX_WIDTH, 2 * MIX_WIDTH, 3 * MIX_WIDTH, 3 * MIX_WIDTH + DECAY_LORA, 3 * MIX_WIDTH + DECAY_LORA + AAA_LORA)
RWKV_COLS = 3 * MIX_WIDTH + DECAY_LORA + AAA_LORA + GATE_LORA
CONV_WIDTH = 3
CONV_COLS = 3 * MIX_WIDTH
SB_HEAD_DIM = 128
SB_HEADS = MIX_WIDTH // SB_HEAD_DIM
SB_COLS = 3 * MIX_WIDTH
Q_BLOCK = 128
N_GROUPS = 4
EXPERTS_PER_GROUP = 8
N_EXPERTS = N_GROUPS * EXPERTS_PER_GROUP
TOP_K = 2
D_EXPERT = 512
DISPATCH_BLOCK = 128
DEEPNORM_ALPHA = (2 * DEPTH) ** 0.25
DEEPNORM_BETA = (8 * DEPTH) ** -0.25
LN_EPS = 1e-5
N_RWKV_LAYERS = (DEPTH + 2) // 3
N_CONV_LAYERS = (DEPTH + 1) // 3
N_SB_LAYERS = DEPTH // 3

kernel_name = "hybrid_rwkv7_shortconv_stickbreaking_hmoe_deepnorm"


def layer_norm(x, g, b):
    xf = x.astype(jnp.float32)
    mu = jnp.mean(xf, axis=-1, keepdims=True)
    var = jnp.mean(jnp.square(xf - mu), axis=-1, keepdims=True)
    return ((xf - mu) * lax.rsqrt(var + LN_EPS) * g + b).astype(x.dtype)


def token_shift(z):
    return jnp.pad(z[:, :-1], ((0, 0), (1, 0), (0, 0)))


def split_heads(t, n_heads):
    B, T, C = t.shape
    return t.reshape(B, T, n_heads, C // n_heads)


def wkv7_scan(r, decay, k, v, kk, a):
    B, T, H, N = r.shape

    def step(S, inp):
        r_t, w_t, k_t, v_t, kk_t, a_t = inp
        sa = jnp.einsum('bhij,bhj->bhi', S, -kk_t)
        S = S * w_t[:, :, None, :] + sa[..., None] * (kk_t * a_t)[:, :, None, :] + v_t[..., None] * k_t[:, :, None, :]
        return S, jnp.einsum('bhij,bhj->bhi', S, r_t)

    xs = tuple(jnp.moveaxis(t, 1, 0) for t in (r, decay, k, v, kk, a))
    _, y = lax.scan(step, jnp.zeros((B, H, N, N), jnp.float32), xs)
    return jnp.moveaxis(y, 0, 1)


def rwkv7_time_mix(z, mu, w0, w2, a0, a2, g2, k_k, k_a, r_k, gn_g, gn_b):
    B, T, _ = z.shape
    z = z + (token_shift(z) - z) * mu
    r, k, v, zw, za, zg = jnp.split(z, RWKV_SPLITS, axis=-1)
    w_log = -jax.nn.softplus(-(w0 + jnp.tanh(zw) @ w2).astype(jnp.float32)) - 0.5
    decay = jnp.exp(-jnp.exp(w_log))
    a = jax.nn.sigmoid((a0 + za @ a2).astype(jnp.float32))
    gate = jax.nn.sigmoid(zg) @ g2
    r, k, v = r.astype(jnp.float32), k.astype(jnp.float32), v.astype(jnp.float32)
    kk = split_heads(k * k_k, RWKV_HEADS)
    kk = kk / jnp.maximum(jnp.linalg.norm(kk, axis=-1, keepdims=True), 1e-12)
    k = k * (1.0 + (a - 1.0) * k_a)
    r, k, v, a, decay = [split_heads(t, RWKV_HEADS) for t in (r, k, v, a, decay)]
    y = wkv7_scan(r, decay, k, v, kk, a)
    mean = jnp.mean(y, axis=-1, keepdims=True)
    var = jnp.mean(jnp.square(y - mean), axis=-1, keepdims=True)
    y = ((y - mean) * lax.rsqrt(var + RWKV_GN_EPS)).reshape(B, T, MIX_WIDTH) * gn_g + gn_b
    bonus = jnp.sum(r * k * r_k, axis=-1, keepdims=True) * v
    y = y + bonus.reshape(B, T, MIX_WIDTH)
    return (y * gate).astype(z.dtype)


def short_conv_mix(z, conv_w):
    b_gate, c_gate, h = jnp.split(z, 3, axis=-1)
    u = c_gate * h
    y = lax.conv_general_dilated(u, conv_w[:, None, :].astype(u.dtype), window_strides=(1,),
                                 padding=[(CONV_WIDTH - 1, 0)], dimension_numbers=('NWC', 'WIO', 'NWC'),
                                 feature_group_count=MIX_WIDTH)
    return b_gate * y


def stick_breaking_mix(z):
    B, T, _ = z.shape
    q, k, v = [jnp.moveaxis(split_heads(t, SB_HEADS), 2, 1) for t in jnp.split(z, 3, axis=-1)]
    n_blocks = T // Q_BLOCK
    qb = jnp.moveaxis(q.reshape(B, SB_HEADS, n_blocks, Q_BLOCK, SB_HEAD_DIM), 2, 0)
    key_pos = jnp.arange(T)
    scale = 1.0 / math.sqrt(SB_HEAD_DIM)

    def block(args):
        i, q_i = args
        logits = jnp.einsum('bhqd,bhkd->bhqk', q_i, k).astype(jnp.float32) * scale
        q_pos = i * Q_BLOCK + jnp.arange(Q_BLOCK)
        causal = key_pos[None, :] < q_pos[:, None]
        log_not = jnp.where(causal, jax.nn.log_sigmoid(-logits), 0.0)
        between = lax.cumsum(log_not, axis=3, reverse=True) - log_not
        attn = jnp.where(causal, jnp.exp(jax.nn.log_sigmoid(logits) + between), 0.0)
        return jnp.einsum('bhqk,bhkd->bhqd', attn.astype(v.dtype), v)

    o = lax.map(block, (jnp.arange(n_blocks), qb))
    return jnp.transpose(o, (1, 0, 3, 2, 4)).reshape(B, T, MIX_WIDTH)


def memory_cross_attention(q, mem, wk, wv):
    B, T, _ = q.shape
    km = split_heads(mem @ wk, MEM_HEADS)
    vm = split_heads(mem @ wv, MEM_HEADS)
    s = jnp.einsum('bthd,bmhd->bhtm', split_heads(q, MEM_HEADS), km).astype(jnp.float32) / math.sqrt(MEM_HEAD_DIM)
    p = jax.nn.softmax(s, axis=-1).astype(vm.dtype)
    return jnp.einsum('bhtm,bmhd->bthd', p, vm).reshape(B, T, MEM_WIDTH)


def hierarchical_moe(x, rg_w, rg_b, re_w, re_b, w_gate, w_up, w_down):
    B, T, D = x.shape
    N = B * T
    xf = x.reshape(N, D)
    g_logits = (xf @ rg_w + rg_b).astype(jnp.float32)
    p_group = jax.nn.softmax(g_logits, axis=-1)
    group = jnp.argmax(g_logits, axis=-1)
    p_group_sel = jnp.take_along_axis(p_group, group[:, None], axis=1)
    e_logits = (xf @ re_w + re_b).astype(jnp.float32).reshape(N, N_GROUPS, EXPERTS_PER_GROUP)
    e_logits = jnp.take_along_axis(e_logits, group[:, None, None], axis=1)[:, 0]
    top_p, top_i = lax.top_k(jax.nn.softmax(e_logits, axis=-1), TOP_K)
    gate = p_group_sel * top_p / jnp.sum(top_p, axis=-1, keepdims=True)
    expert = (group[:, None] * EXPERTS_PER_GROUP + top_i).astype(jnp.int32)
    n_slots = N * TOP_K
    e_flat = expert.reshape(-1)
    g_flat = gate.reshape(-1).astype(x.dtype)
    tok_flat = jnp.arange(n_slots, dtype=jnp.int32) // TOP_K
    counts = jnp.bincount(e_flat, length=N_EXPERTS).astype(jnp.int32)
    padded = (counts + DISPATCH_BLOCK - 1) // DISPATCH_BLOCK * DISPATCH_BLOCK
    pad_end = jnp.cumsum(padded)
    pad_start = pad_end - padded
    start = jnp.cumsum(counts) - counts
    order = jnp.argsort(e_flat)
    e_sorted = e_flat[order]
    dest = pad_start[e_sorted] + jnp.arange(n_slots, dtype=jnp.int32) - start[e_sorted]
    n_blocks = -(-n_slots // DISPATCH_BLOCK) + N_EXPERTS
    cap = n_blocks * DISPATCH_BLOCK
    buf_tok = jnp.full((cap,), N, jnp.int32).at[dest].set(tok_flat[order])
    buf_gate = jnp.zeros((cap,), x.dtype).at[dest].set(g_flat[order])
    block_expert = jnp.minimum(jnp.searchsorted(pad_end, jnp.arange(n_blocks, dtype=jnp.int32) * DISPATCH_BLOCK, side='right'), N_EXPERTS - 1)
    x_pad = jnp.concatenate([xf, jnp.zeros((1, D), x.dtype)], axis=0)
    xb = x_pad[buf_tok].reshape(n_blocks, DISPATCH_BLOCK, D)

    def expert_block(args):
        xe, e = args
        return (jax.nn.silu(xe @ w_gate[e]) * (xe @ w_up[e])) @ w_down[e]

    yb = lax.map(expert_block, (xb, block_expert)).reshape(cap, D) * buf_gate[:, None]
    out = jnp.zeros((N + 1, D), x.dtype).at[buf_tok].add(yb)[:N]
    return out.reshape(B, T, D)


def setup_inputs(seed: int = 0) -> dict:
    key = jax.random.key(seed)
    it = iter(list(jax.random.split(key, 40)))

    def nrm(shape, scale):
        return scale * jax.random.normal(next(it), shape, jnp.float32)

    def unif(shape, lo, hi):
        return jax.random.uniform(next(it), shape, jnp.float32, lo, hi)

    D, C, L = D_MODEL, MIX_WIDTH, DEPTH
    return {
        'x': nrm((BATCH, SEQ, D), 1.0),
        'mem': nrm((BATCH, MEM_LEN, D), 1.0),
        'w_out': nrm((L, C + MEM_WIDTH, D), DEEPNORM_BETA * (C + MEM_WIDTH) ** -0.5),
        'mem_wk': nrm((L, D, MEM_WIDTH), D ** -0.5),
        'mem_wv': nrm((L, D, MEM_WIDTH), DEEPNORM_BETA * D ** -0.5),
        'ln_mix_g': 1.0 + nrm((L, D), 0.02),
        'ln_mix_b': nrm((L, D), 0.02),
        'ln_ffn_g': 1.0 + nrm((L, D), 0.02),
        'ln_ffn_b': nrm((L, D), 0.02),
        'router_group_w': nrm((L, D, N_GROUPS), D ** -0.5),
        'router_group_b': nrm((L, N_GROUPS), 0.01),
        'router_expert_w': nrm((L, D, N_EXPERTS), D ** -0.5),
        'router_expert_b': nrm((L, N_EXPERTS), 0.01),
        'expert_w_gate': nrm((L, N_EXPERTS, D, D_EXPERT), D ** -0.5),
        'expert_w_up': nrm((L, N_EXPERTS, D, D_EXPERT), D ** -0.5),
        'expert_w_down': nrm((L, N_EXPERTS, D_EXPERT, D), DEEPNORM_BETA * D_EXPERT ** -0.5),
        'rwkv_w_in': nrm((N_RWKV_LAYERS, D, RWKV_COLS + MEM_WIDTH), D ** -0.5),
        'rwkv_mu': unif((N_RWKV_LAYERS, RWKV_COLS), 0.0, 1.0),
        'rwkv_w0': unif((N_RWKV_LAYERS, C), -6.0, -1.0),
        'rwkv_w2': nrm((N_RWKV_LAYERS, DECAY_LORA, C), 0.5 * DECAY_LORA ** -0.5),
        'rwkv_a0': nrm((N_RWKV_LAYERS, C), 0.1),
        'rwkv_a2': nrm((N_RWKV_LAYERS, AAA_LORA, C), 0.5 * AAA_LORA ** -0.5),
        'rwkv_g2': nrm((N_RWKV_LAYERS, GATE_LORA, C), GATE_LORA ** -0.5),
        'rwkv_k_k': 0.85 + nrm((N_RWKV_LAYERS, C), 0.05),
        'rwkv_k_a': 1.0 + nrm((N_RWKV_LAYERS, C), 0.05),
        'rwkv_r_k': nrm((N_RWKV_LAYERS, RWKV_HEADS, RWKV_HEAD_DIM), 0.1),
        'rwkv_gn_g': 1.0 + nrm((N_RWKV_LAYERS, C), 0.02),
        'rwkv_gn_b': nrm((N_RWKV_LAYERS, C), 0.02),
        'conv_w_in': nrm((N_CONV_LAYERS, D, CONV_COLS + MEM_WIDTH), D ** -0.5),
        'conv_w': nrm((N_CONV_LAYERS, CONV_WIDTH, C), CONV_WIDTH ** -0.5),
        'sb_w_in': nrm((N_SB_LAYERS, D, SB_COLS + MEM_WIDTH), D ** -0.5),
    }


def reference(x, mem, w_out, mem_wk, mem_wv, ln_mix_g, ln_mix_b, ln_ffn_g, ln_ffn_b,
              router_group_w, router_group_b, router_expert_w, router_expert_b,
              expert_w_gate, expert_w_up, expert_w_down,
              rwkv_w_in, rwkv_mu, rwkv_w0, rwkv_w2, rwkv_a0, rwkv_a2, rwkv_g2,
              rwkv_k_k, rwkv_k_a, rwkv_r_k, rwkv_gn_g, rwkv_gn_b,
              conv_w_in, conv_w, sb_w_in):
    for i in range(DEPTH):
        kind, j = i % N_MIXERS, i // N_MIXERS
        if kind == 0:
            z = x @ rwkv_w_in[j]
            mix = rwkv7_time_mix(z[..., :RWKV_COLS], rwkv_mu[j], rwkv_w0[j], rwkv_w2[j], rwkv_a0[j], rwkv_a2[j],
                                 rwkv_g2[j], rwkv_k_k[j], rwkv_k_a[j], rwkv_r_k[j], rwkv_gn_g[j], rwkv_gn_b[j])
            q_mem = z[..., RWKV_COLS:]
        elif kind == 1:
            z = x @ conv_w_in[j]
            mix = short_conv_mix(z[..., :CONV_COLS], conv_w[j])
            q_mem = z[..., CONV_COLS:]
        else:
            z = x @ sb_w_in[j]
            mix = stick_breaking_mix(z[..., :SB_COLS])
            q_mem = z[..., SB_COLS:]
        mem_out = memory_cross_attention(q_mem, mem, mem_wk[i], mem_wv[i])
        h = jnp.concatenate([mix, mem_out], axis=-1) @ w_out[i]
        x = layer_norm(DEEPNORM_ALPHA * x + h, ln_mix_g[i], ln_mix_b[i])
        f = hierarchical_moe(x, router_group_w[i], router_group_b[i], router_expert_w[i], router_expert_b[i],
                             expert_w_gate[i], expert_w_up[i], expert_w_down[i])
        x = layer_norm(DEEPNORM_ALPHA * x + f, ln_ffn_g[i], ln_ffn_b[i])
    return x
```

```cpp
#include <hip/hip_runtime.h>
#include <cstdio>
#include <cstdint>

#ifndef MK_PER_PHASE
#define MK_PER_PHASE 0
#endif
#ifndef MK_PH_HI
#define MK_PH_HI N_PHASES
#endif
#ifndef REP_GEMM
#define REP_GEMM 1
#endif
#ifndef REP_MOE
#define REP_MOE 1
#endif
#ifndef REP_SCAN
#define REP_SCAN 1
#endif
#ifndef REP_PREP
#define REP_PREP 1
#endif
#ifndef REP_MIX
#define REP_MIX 1
#endif
#ifndef REP_CONV
#define REP_CONV 1
#endif
#ifndef REP_SB
#define REP_SB 1
#endif
#ifndef REP_MA
#define REP_MA 1
#endif
#ifndef REP_WX
#define REP_WX 1
#endif
#ifndef REP_WS
#define REP_WS 1
#endif
#ifndef REP_WO
#define REP_WO 1
#endif
#ifndef REP_W2
#define REP_W2 1
#endif

#define LAS __attribute__((address_space(3)))
#define GAS __attribute__((address_space(1)))
#define DI __device__ __forceinline__
typedef unsigned short bf16_t;
typedef short bf16x8 __attribute__((ext_vector_type(8)));
typedef short s16x4 __attribute__((ext_vector_type(4)));
typedef float f32x2 __attribute__((ext_vector_type(2)));
typedef float f32x4 __attribute__((ext_vector_type(4)));
typedef float f32x8 __attribute__((ext_vector_type(8)));
typedef float f32x16 __attribute__((ext_vector_type(16)));
typedef unsigned u32x2 __attribute__((ext_vector_type(2)));
typedef unsigned u32x4 __attribute__((ext_vector_type(4)));

constexpr int NTOK = 16384, DM = 2048, SEQ = 4096, NBATCH = 4, CMIX = 1536, MEMW = 512, MEML = 256, NLAYER = 4;
constexpr int ZW_RWKV = 5632  , ZW_OTH = 5120, RW_IN_COLS = 5568;
constexpr int NEXP = 32, DEXP = 512, LISTCAP = 16384, MAXTILES = 160;
constexpr float LN_EPS = 1e-5f, ALPHA = 1.681792830507429f, GN_EPS = 64e-5f;
constexpr int NT = 512, NWAVES = 8;

constexpr size_t MiB = (size_t)1 << 20;
constexpr size_t WS_CTL = 0, CTL_BYTES = 1 * MiB;
constexpr size_t WS_WIN = 2 * MiB;
constexpr size_t WIN_STRIDE = 22 * MiB;
constexpr size_t WS_WOUT = 90 * MiB;
constexpr size_t WS_WK = 122 * MiB;
constexpr size_t WS_WV = 130 * MiB;
constexpr size_t WS_MEMB = 138 * MiB;
constexpr size_t WS_KM = 142 * MiB;
constexpr size_t WS_VMT = 146 * MiB;
constexpr size_t WS_LORA = 150 * MiB;
constexpr size_t LORA_STRIDE = 3 * MiB;
constexpr size_t WS_WSW = 156 * MiB;
constexpr size_t WSW_STRIDE = 393216;
constexpr size_t WS_EXP1 = 160 * MiB;
constexpr size_t WS_EXP2 = 288 * MiB;
constexpr size_t WS_XB = 352 * MiB;
constexpr size_t WS_Z = 416 * MiB;
constexpr size_t WS_CAT = 592 * MiB;
constexpr size_t WS_HB = 656 * MiB;
constexpr size_t WS_LTOK = 720 * MiB;
constexpr size_t WS_LGATE = 722 * MiB;
constexpr size_t WS_LSLOT = 724 * MiB;
constexpr size_t WS_HE = 728 * MiB;
constexpr size_t WS_YS = 768 * MiB;
constexpr size_t WS_ACT = 896 * MiB;
constexpr size_t WS_LW = 944 * MiB;
constexpr size_t WS_GATE = 1040 * MiB;
constexpr size_t WS_SCAN = 1088 * MiB;
constexpr size_t WS_V = 1568 * MiB;
constexpr size_t WS_Y = 1664 * MiB;
constexpr size_t WS_GH = 1760 * MiB;
constexpr size_t WS_QY = 1088 * MiB;
constexpr size_t WS_Y0T = 1152 * MiB;
constexpr size_t WS_E = 1280 * MiB;
constexpr size_t WS_END = 1952 * MiB;
constexpr int CW_BAR = 4096;
constexpr int CW_CNT = 16384;

constexpr int LDS_BYTES = 147456;
constexpr int LDS_CTL_OFF = 146432;

DI float bf2f(unsigned b) { return __uint_as_float(b << 16); }
typedef float cvt_f32x2 __attribute__((ext_vector_type(2)));
typedef __bf16 cvt_bf16x2 __attribute__((ext_vector_type(2)));
DI unsigned cvt_pk_bf16(float lo, float hi) { const cvt_f32x2 v = {lo, hi}; return __builtin_bit_cast(unsigned, __builtin_convertvector(v, cvt_bf16x2)); }
DI float bflo(unsigned w) { return __uint_as_float(w << 16); }
DI float bfhi(unsigned w) { return __uint_as_float(w & 0xffff0000u); }
DI float wave_sum(float v) {
#pragma unroll
    for (int o = 1; o < 64; o <<= 1) v += __shfl_xor(v, o);
    return v;
}
DI float sum16(float v) {
    v += __builtin_bit_cast(float, __builtin_amdgcn_update_dpp(0, __builtin_bit_cast(int, v), 0x128, 0xf, 0xf, false));
    v += __builtin_bit_cast(float, __builtin_amdgcn_update_dpp(0, __builtin_bit_cast(int, v), 0x124, 0xf, 0xf, false));
    v += __builtin_bit_cast(float, __builtin_amdgcn_update_dpp(0, __builtin_bit_cast(int, v), 0x122, 0xf, 0xf, false));
    v += __builtin_bit_cast(float, __builtin_amdgcn_update_dpp(0, __builtin_bit_cast(int, v), 0x121, 0xf, 0xf, false));
    return v;
}
DI float fma_s(float a, float b, float c) { float d; asm("v_fma_f32 %0, %1, %2, %3" : "=v"(d) : "v"(a), "v"(b), "v"(c)); return d; }
DI float sigmoidf_(float x) { return __builtin_amdgcn_rcpf(1.f + __expf(-x)); }
DI float softplusf_(float x) { return fmaxf(x, 0.f) + __logf(1.f + __expf(-fabsf(x))); }
#define LDS_WAIT() asm volatile("s_waitcnt lgkmcnt(0)" ::: "memory")
#define VM_WAIT() asm volatile("s_waitcnt vmcnt(0)" ::: "memory")
#define LDS_BARRIER() do { asm volatile("s_waitcnt lgkmcnt(0)" ::: "memory"); __builtin_amdgcn_s_barrier(); asm volatile("" ::: "memory"); } while (0)

template <class T> DI T* as_global(T* p) { return p; }
DI const float* kin_ptr(int i) { int off = i * 8; asm volatile("" : "+v"(off)); const char* ka = (const char*)__builtin_amdgcn_kernarg_segment_ptr();
    const unsigned long long p = *(const unsigned long long*)(ka + off);
    const unsigned lo = __builtin_amdgcn_readfirstlane((unsigned)p), hi = __builtin_amdgcn_readfirstlane((unsigned)(p >> 32));
    return as_global((const float*)(((unsigned long long)hi << 32) | lo)); }
#define PIN(i) kin_ptr(i)
DI unsigned char* opq(unsigned char* p) { asm volatile("" : "+s"(p)); return p; }
DI float* opqf(float* p) { asm volatile("" : "+s"(p)); return p; }

#define XB_TMO      128
#define XB_XCNT(j)  (256  + 64 * (j))
#define XB_XSUB(j)  (1280 + 64 * (j))
#define XB_XGEN(j)  (2304 + 64 * (j))
#define XB_TOP      3328
#define XB_TOPGEN   3392
#define XCD_BAR_WORDS 3456
#define XB_SPIN_CAP (1u << 20)

__device__ __forceinline__ unsigned xb_ld(unsigned* p)              { return __hip_atomic_load(p, __ATOMIC_RELAXED, __HIP_MEMORY_SCOPE_AGENT); }
__device__ __forceinline__ unsigned xb_add(unsigned* p, unsigned v) { return __hip_atomic_fetch_add(p, v, __ATOMIC_RELAXED, __HIP_MEMORY_SCOPE_AGENT); }
__device__ __forceinline__ unsigned xb_xcc_id() { return (unsigned)__builtin_amdgcn_s_getreg((3 << 11) | 20) & 0xFu; }
#define XB_SPIN(cond, bar) do { unsigned _sp = 0; while (cond) { __builtin_amdgcn_s_sleep(1); \
    if ((++_sp & 255u) == 0u) { if (xb_ld(&(bar)[XB_TMO])) break; if (_sp > XB_SPIN_CAP) { atomicAdd(&(bar)[XB_TMO], 1u); break; } } } } while (0)

struct XcdBarrier { unsigned* bar; unsigned x; volatile LAS unsigned* st; };

__device__ __forceinline__ XcdBarrier xcd_barrier_post(unsigned* bar, volatile LAS unsigned* st) {
    XcdBarrier b; b.bar = bar; b.x = xb_xcc_id(); b.st = st;
    if (threadIdx.x == 0) (void)xb_add(&bar[XB_XCNT(b.x)], 1u);
    return b;
}
__device__ __forceinline__ void xcd_barrier_complete(unsigned* bar, unsigned x, unsigned& nloc, unsigned& nx) {
    const unsigned G = gridDim.x * gridDim.y * gridDim.z;
    unsigned sum, cnt, mine, sp = 0u;
    for (;;) {
        sum = 0u; cnt = 0u; mine = 0u;
#pragma unroll
        for (unsigned j = 0; j < 16; ++j) { const unsigned c = xb_ld(&bar[XB_XCNT(j)]); sum += c; cnt += (c > 0u) ? 1u : 0u; mine = (j == x) ? c : mine; }
        if (sum == G) break;
        __builtin_amdgcn_s_sleep(1);
        if ((++sp & 255u) == 0u) { if (xb_ld(&bar[XB_TMO])) break; if (sp > XB_SPIN_CAP) { atomicAdd(&bar[XB_TMO], 1u); break; } }
    }
    nloc = mine > 0u ? mine : 1u; nx = cnt > 0u ? cnt : 1u;
}
__device__ __forceinline__ void xcd_barrier(const XcdBarrier& b) {
    asm volatile("s_waitcnt vmcnt(0)" ::: "memory");
    __syncthreads();
    if (threadIdx.x == 0) {
        unsigned* bar = b.bar;
        __builtin_amdgcn_s_waitcnt(0);
        unsigned nloc = b.st[0], nx = b.st[1];
        if (nloc == 0u) { xcd_barrier_complete(bar, b.x, nloc, nx); b.st[0] = nloc; b.st[1] = nx; }
        const unsigned old = xb_add(&bar[XB_XSUB(b.x)], 1u);
        const unsigned gen = old / nloc;
        if (old + 1u == (gen + 1u) * nloc) {
            __builtin_amdgcn_fence(__ATOMIC_RELEASE, "agent");
            asm volatile("s_waitcnt vmcnt(0)" ::: "memory");
            const unsigned og = xb_add(&bar[XB_TOP], 1u);
            const unsigned tg = og / nx;
            if (og + 1u == (tg + 1u) * nx) xb_add(&bar[XB_TOPGEN], 1u);
            else XB_SPIN(xb_ld(&bar[XB_TOPGEN]) == tg, bar);
            __builtin_amdgcn_fence(__ATOMIC_ACQUIRE, "agent");
            xb_add(&bar[XB_XGEN(b.x)], 1u);
            asm volatile("s_waitcnt vmcnt(0)" ::: "memory");
        } else {
            XB_SPIN(xb_ld(&bar[XB_XGEN(b.x)]) == gen, bar);
            __builtin_amdgcn_fence(__ATOMIC_ACQUIRE, "agent");
            asm volatile("s_waitcnt vmcnt(0)" ::: "memory");
        }
    }
    __syncthreads();
}

namespace pg8 {
constexpr int BM = 256, BK = 64, HALF = 128, HTB = HALF * BK * 2, STAGE_BYTES = 8 * HTB, NXCD = 8, WGM = 8;
DI int lds_byte(int r, int c) { const int st = (r >> 4) * 2 + (c >> 5), rr = r & 15, cc = c & 31, ob = rr * 64 + cc * 2; return st * 1024 + (ob ^ (((ob >> 9) & 1) << 5)); }
DI void stage_rc(int b, int& R, int& C) { const int st = b / 1024, sb = b % 1024, swz = sb ^ (((sb >> 9) & 1) << 5); R = (st >> 1) * 16 + swz / 64; C = (st & 1) * 32 + (swz % 64) / 2; }
DI int perm32(int rho) { const int n = rho >> 4, i = rho & 15; return 8 * (i >> 2) + 4 * n + (i & 3); }

struct Unit { int pm, pn, e, rt; };
struct Gemm { const bf16_t* A; const bf16_t* Bt; int lda, ldb, K; };

struct StaticOrder {
    static constexpr bool GATHER = false;
    int nM, nN, nwg, G, c;
    DI void init(int M, int N, int G_, int c_) { nM = M / BM; nN = N / BM; nwg = nM * nN; G = G_; c = c_; }
    DI bool next(int i, Unit& u) const {
        const long L = (long)i * G + c; if (L >= nwg) return false;
        int wgid = (int)L; { const int q = nwg / NXCD, r = nwg % NXCD, xcd = wgid % NXCD, off = wgid / NXCD; wgid = (xcd < r ? xcd * (q + 1) : r * (q + 1) + (xcd - r) * q) + off; }
        const int nig = WGM * nN, gid = wgid / nig, fm = gid * WGM, gsz = (nM - fm) < WGM ? (nM - fm) : WGM;
        u.pm = fm + ((wgid % nig) % gsz); u.pn = (wgid % nig) / gsz; u.e = 0; u.rt = 0; return true;
    }
    DI const char* a_base(const Gemm& g, const Unit& u) const { return (const char*)g.A + (size_t)u.pm * BM * g.lda * 2; }
    DI const char* b_base(const Gemm& g, const Unit& u) const { return (const char*)g.Bt + (size_t)u.pn * BM * g.ldb * 2; }
    DI unsigned gather_voff(const Unit&, int, int, int) const { return 0u; }
};

template <bool GATH> struct MoeOrder {
    static constexpr bool GATHER = GATH;
    int G, c, npn, total; const LAS int* tb; size_t estride; const int* ltok; const unsigned* cnt;
    DI bool next(int i, Unit& u) const {
        if ((G & 7) == 0) {
            const int x = c & 7, r = c >> 3, W = G >> 3, idx = i * W + r;
            const int q = idx / npn, pn = idx - q * npn; int base = 0;
#pragma unroll
            for (int k = 0; k < 4; ++k) { const int e = x + 8 * k, nt = tb[e + 1] - tb[e];
                if (q < base + nt) { u.e = e; u.rt = q - base; u.pm = tb[e] + u.rt; u.pn = pn; return true; }
                base += nt; }
            return false;
        }
        const int L = i * G + c; if (L >= total) return false;
        const int q = L / npn; u.pn = L - q * npn; u.pm = q;
        int e = 0; while (e < NEXP - 1 && tb[e + 1] <= q) ++e;
        u.e = e; u.rt = q - tb[e]; return true;
    }
    DI const char* a_base(const Gemm& g, const Unit& u) const { return (const char*)g.A + (size_t)u.pm * BM * g.lda * 2; }
    DI const char* b_base(const Gemm& g, const Unit& u) const { return (const char*)g.Bt + (size_t)u.e * estride + (size_t)u.pn * BM * g.ldb * 2; }
    DI unsigned gather_voff(const Unit& u, int r, int C, int lda) const {
        const int pos = u.rt * BM + r; const int n = (int)__hip_atomic_load(cnt + u.e * 64, __ATOMIC_RELAXED, __HIP_MEMORY_SCOPE_AGENT);
        const int tok = pos < n ? ltok[u.e * LISTCAP + pos] : 0;
        return (unsigned)(tok * lda + C) * 2u;
    }
};

struct EpiStore {
    bf16_t* O; int ldc;
    DI void operator()(const f32x4 (&acc)[2][2][4][2], const Unit& u, int wr, int wc, int fr, int fq) const {
        const int row0 = u.pm * BM + wr * 64 + fr, col0 = u.pn * BM + wc * 32 + 8 * fq;
#pragma unroll
        for (int ai = 0; ai < 2; ++ai)
#pragma unroll
            for (int m = 0; m < 4; ++m) { bf16_t* rowp = O + (size_t)(row0 + ai * HALF + m * 16) * ldc + col0;
#pragma unroll
                for (int bj = 0; bj < 2; ++bj) { const f32x4 v0 = acc[ai][bj][m][0], v1 = acc[ai][bj][m][1];
                    u32x4 w; w.x = cvt_pk_bf16(v0[0], v0[1]); w.y = cvt_pk_bf16(v0[2], v0[3]); w.z = cvt_pk_bf16(v1[0], v1[1]); w.w = cvt_pk_bf16(v1[2], v1[3]);
                    *(GAS u32x4*)(rowp + bj * HALF) = w; } }
    }
};
struct EpiSwiGLU {
    bf16_t* H;
    DI void operator()(const f32x4 (&acc)[2][2][4][2], const Unit& u, int wr, int wc, int fr, int fq) const {
        const int row0 = u.pm * BM + wr * 64 + fr, col0 = u.pn * HALF + wc * 32 + 8 * fq;
#pragma unroll
        for (int ai = 0; ai < 2; ++ai)
#pragma unroll
            for (int m = 0; m < 4; ++m) { bf16_t* rowp = H + (size_t)(row0 + ai * HALF + m * 16) * DEXP + col0;
                float h[8];
#pragma unroll
                for (int n = 0; n < 2; ++n)
#pragma unroll
                    for (int j = 0; j < 4; ++j) { const float gt = acc[ai][0][m][n][j], up = acc[ai][1][m][n][j]; h[n * 4 + j] = gt * __builtin_amdgcn_rcpf(1.f + __expf(-gt)) * up; }
                u32x4 w; w.x = cvt_pk_bf16(h[0], h[1]); w.y = cvt_pk_bf16(h[2], h[3]); w.z = cvt_pk_bf16(h[4], h[5]); w.w = cvt_pk_bf16(h[6], h[7]);
                *(GAS u32x4*)rowp = w; }
    }
};
struct EpiScatter {
    bf16_t* YS; const int* lslot; const float* lgate; const unsigned* cnt;
    DI void operator()(const f32x4 (&acc)[2][2][4][2], const Unit& u, int wr, int wc, int fr, int fq) const {
        const int n = (int)__hip_atomic_load(cnt + u.e * 64, __ATOMIC_RELAXED, __HIP_MEMORY_SCOPE_AGENT);
        const int col0 = u.pn * BM + wc * 32 + 8 * fq;
#pragma unroll
        for (int ai = 0; ai < 2; ++ai)
#pragma unroll
            for (int m = 0; m < 4; ++m) { const int pos = u.rt * BM + ai * HALF + wr * 64 + m * 16 + fr;
                if (pos < n) { const int slot = lslot[u.e * LISTCAP + pos]; const float gt = lgate[u.e * LISTCAP + pos];
                    bf16_t* rowp = YS + (size_t)slot * DM + col0;
#pragma unroll
                    for (int bj = 0; bj < 2; ++bj) { const f32x4 v0 = acc[ai][bj][m][0] * gt, v1 = acc[ai][bj][m][1] * gt;
                        u32x4 w; w.x = cvt_pk_bf16(v0[0], v0[1]); w.y = cvt_pk_bf16(v0[2], v0[3]); w.z = cvt_pk_bf16(v1[0], v1[1]); w.w = cvt_pk_bf16(v1[2], v1[3]);
                        *(GAS u32x4*)(rowp + bj * HALF) = w; } } }
    }
};

template <class Epi, class Sched>
DI void gemm_phase(LAS unsigned char* lds, const Gemm g, const Sched& S, const Epi& E) {
    int tid = threadIdx.x; asm volatile("" : "+v"(tid));
    const int wid = __builtin_amdgcn_readfirstlane(tid >> 6), lane = tid & 63, wr = wid >> 2, wc = wid & 3, fr = lane & 15, fq = lane >> 4;
    const int K = g.K, nt = K / BK;
    unsigned voffA[2], voffB[2];
#pragma unroll
    for (int i = 0; i < 2; ++i) { int R, C; stage_rc(tid * 16 + i * 8192, R, C); const int Rb = (R & ~31) + perm32(R & 31);
        voffA[i] = (unsigned)(R * g.lda + C) * 2u; voffB[i] = (unsigned)(Rb * g.ldb + C) * 2u; }
    const size_t kstep = (size_t)(BK * 2);
    const size_t hstepA = (size_t)HALF * g.lda * 2, hstepB = (size_t)HALF * g.ldb * 2;
    const unsigned ldsw = (unsigned)wid * 1024u;
    const int aoff = lds_byte(wr * 64 + fr, fq * 8), boff = lds_byte(wc * 32 + fr, fq * 8);
    unsigned gvC[2][2], gvN[2][2];
#define PG8_SA(b, h) (((b) * 2 + (h)) * HTB)
#define PG8_SB(b, h) ((4 + (b) * 2 + (h)) * HTB)
#define PG8_STAGE(bufoff, gbase, voff) do { _Pragma("unroll") for (int _i = 0; _i < 2; ++_i) \
        __builtin_amdgcn_global_load_lds((const unsigned*)((const char*)(gbase) + (voff)[_i]), (LAS unsigned*)(lds + (bufoff) + ldsw + _i * 8192), 16, 0, 0); } while (0)
#define PG8_STAGE_A(bufoff, h, nxtsel, kt) do { \
        if constexpr (Sched::GATHER) { const char* _gb = (const char*)g.A + (size_t)(kt) * kstep; unsigned _vo[2]; _vo[0] = (nxtsel) ? gvN[h][0] : gvC[h][0]; _vo[1] = (nxtsel) ? gvN[h][1] : gvC[h][1]; PG8_STAGE(bufoff, _gb, _vo); } \
        else { const char* _gb = ((nxtsel) ? nA : cA) + (size_t)(h) * hstepA + (size_t)(kt) * kstep; PG8_STAGE(bufoff, _gb, voffA); } } while (0)
#define PG8_GSETUP(dst, u) do { if constexpr (Sched::GATHER) { _Pragma("unroll") for (int _h = 0; _h < 2; ++_h) _Pragma("unroll") for (int _i = 0; _i < 2; ++_i) { int _R, _C; stage_rc(tid * 16 + _i * 8192, _R, _C); \
        dst[_h][_i] = S.gather_voff(u, _h * HALF + _R, _C, g.lda); } asm volatile("s_waitcnt vmcnt(0)" : "+v"(dst[0][0]), "+v"(dst[0][1]), "+v"(dst[1][0]), "+v"(dst[1][1]) :: "memory"); } } while (0)
#define PG8_LDA(dst, b, h) do { _Pragma("unroll") for (int m = 0; m < 4; ++m) _Pragma("unroll") for (int k = 0; k < 2; ++k) dst[m][k] = *(const LAS bf16x8*)(lds + PG8_SA(b, h) + aoff + m * 2048 + k * 1024); } while (0)
#define PG8_LDB(dst, b, h) do { _Pragma("unroll") for (int n = 0; n < 2; ++n) _Pragma("unroll") for (int k = 0; k < 2; ++k) dst[n][k] = *(const LAS bf16x8*)(lds + PG8_SB(b, h) + boff + n * 2048 + k * 1024); } while (0)
#define PG8_MMA(ai, bj, At, Bt) do { __builtin_amdgcn_s_setprio(1); _Pragma("unroll") for (int m = 0; m < 4; ++m) _Pragma("unroll") for (int n = 0; n < 2; ++n) _Pragma("unroll") for (int k = 0; k < 2; ++k) \
        acc[ai][bj][m][n] = __builtin_amdgcn_mfma_f32_16x16x32_bf16(Bt[n][k], At[m][k], acc[ai][bj][m][n], 0, 0, 0); __builtin_amdgcn_s_setprio(0); } while (0)
#define PG8_WAIT_V(n) asm volatile("s_waitcnt vmcnt(" #n ")" ::: "memory")
#define PG8_WAIT_L(n) asm volatile("s_waitcnt lgkmcnt(" #n ")" ::: "memory")
#define PG8_BAR __builtin_amdgcn_s_barrier()
#define PG8_SCHED __builtin_amdgcn_sched_barrier(0)
    Unit cur, nxt; int ui = 0;
    if (!S.next(0, cur)) return;
    f32x4 acc[2][2][4][2];
#pragma unroll
    for (int a = 0; a < 2; ++a)
#pragma unroll
        for (int b = 0; b < 2; ++b)
#pragma unroll
            for (int m = 0; m < 4; ++m)
#pragma unroll
                for (int n = 0; n < 2; ++n) acc[a][b][m][n] = (f32x4){0.f, 0.f, 0.f, 0.f};
    bf16x8 At[4][2], B0[2][2], B1[2][2];
    const char* cA = S.a_base(g, cur); const char* cB = S.b_base(g, cur);
    const char* nA = cA;
    PG8_GSETUP(gvC, cur);
    PG8_STAGE(PG8_SB(0, 0), cB, voffB); PG8_STAGE_A(PG8_SA(0, 0), 0, false, 0); PG8_STAGE(PG8_SB(0, 1), cB + hstepB, voffB); PG8_STAGE_A(PG8_SA(0, 1), 1, false, 0);
    if (wr == 1) PG8_BAR;
    PG8_WAIT_V(4); PG8_BAR;
    PG8_STAGE(PG8_SB(1, 0), cB + kstep, voffB); PG8_STAGE_A(PG8_SA(1, 0), 0, false, 1); PG8_STAGE(PG8_SB(1, 1), cB + hstepB + kstep, voffB);
    PG8_WAIT_V(6); PG8_BAR;
    for (;;) {
        const bool has_next = S.next(ui + 1, nxt);
        nA = has_next ? S.a_base(g, nxt) : cA; const char* nB = has_next ? S.b_base(g, nxt) : cB;
        if constexpr (Sched::GATHER) { if (has_next) { PG8_GSETUP(gvN, nxt); } else {
#pragma unroll
            for (int _h = 0; _h < 2; ++_h) { gvN[_h][0] = gvC[_h][0]; gvN[_h][1] = gvC[_h][1]; } } }
        for (int t = 0; t < nt; t += 2) {
            const bool last = (t == nt - 2);
            const int kt2 = last ? 0 : t + 2;
            const char* b2 = last ? nB : cB + (size_t)(t + 2) * kstep;
            const char* b3 = b2 + kstep;
            PG8_LDB(B0, 0, 0); PG8_SCHED; PG8_LDA(At, 0, 0); PG8_STAGE_A(PG8_SA(1, 1), 1, false, t + 1);
            PG8_WAIT_L(8); PG8_BAR; PG8_WAIT_L(0); PG8_MMA(0, 0, At, B0); PG8_BAR; PG8_SCHED;
            PG8_LDB(B1, 0, 1); PG8_STAGE(PG8_SB(0, 0), b2, voffB);
            PG8_BAR; PG8_WAIT_L(0); PG8_MMA(0, 1, At, B1); PG8_BAR;
            PG8_LDA(At, 0, 1); PG8_STAGE_A(PG8_SA(0, 0), 0, last, kt2);
            PG8_BAR; PG8_WAIT_L(0); PG8_MMA(1, 0, At, B0); PG8_BAR; PG8_SCHED;
            PG8_STAGE(PG8_SB(0, 1), b2 + hstepB, voffB);
            PG8_WAIT_V(6); PG8_BAR; PG8_MMA(1, 1, At, B1); PG8_BAR;
            PG8_LDB(B0, 1, 0); PG8_SCHED; PG8_LDA(At, 1, 0); PG8_STAGE_A(PG8_SA(0, 1), 1, last, kt2);
            PG8_WAIT_L(8); PG8_BAR; PG8_WAIT_L(0); PG8_MMA(0, 0, At, B0); PG8_BAR; PG8_SCHED;
            PG8_LDB(B1, 1, 1); PG8_STAGE(PG8_SB(1, 0), b3, voffB);
            PG8_BAR; PG8_WAIT_L(0); PG8_MMA(0, 1, At, B1); PG8_BAR;
            PG8_LDA(At, 1, 1); PG8_STAGE_A(PG8_SA(1, 0), 0, last, kt2 + 1);
            PG8_BAR; PG8_WAIT_L(0); PG8_MMA(1, 0, At, B0); PG8_BAR; PG8_SCHED;
            PG8_STAGE(PG8_SB(1, 1), b3 + hstepB, voffB);
            PG8_WAIT_V(6); PG8_BAR; PG8_MMA(1, 1, At, B1); PG8_BAR;
        }
        E(acc, cur, wr, wc, fr, fq);
        if (!has_next) break;
#pragma unroll
        for (int a = 0; a < 2; ++a)
#pragma unroll
            for (int b = 0; b < 2; ++b)
#pragma unroll
                for (int m = 0; m < 4; ++m)
#pragma unroll
                    for (int n = 0; n < 2; ++n) acc[a][b][m][n] = (f32x4){0.f, 0.f, 0.f, 0.f};
        cur = nxt; cA = nA; cB = nB; ++ui;
        if constexpr (Sched::GATHER) {
#pragma unroll
            for (int _h = 0; _h < 2; ++_h) { gvC[_h][0] = gvN[_h][0]; gvC[_h][1] = gvN[_h][1]; } }
    }
    PG8_WAIT_V(0);
    if (wr == 0) PG8_BAR;
    PG8_BAR;
#undef PG8_SA
#undef PG8_SB
#undef PG8_STAGE
#undef PG8_STAGE_A
#undef PG8_GSETUP
#undef PG8_LDA
#undef PG8_LDB
#undef PG8_MMA
#undef PG8_WAIT_V
#undef PG8_WAIT_L
#undef PG8_BAR
#undef PG8_SCHED
}
}

struct Params { const float* in[31]; float* out; unsigned char* ws; int ph_lo, ph_hi; };

struct Ctx {
    LAS unsigned char* lds;
    int tid, lane, wave, G, bid, gw, ngw;
    unsigned char* ws; float* out;
};
DI Ctx relaunder(const Ctx& F0) {
    Ctx F = F0;
    asm volatile("" : "+v"(F.tid), "+v"(F.lane));
    asm volatile("" : "+s"(F.wave), "+s"(F.G), "+s"(F.bid), "+s"(F.gw), "+s"(F.ngw));
    asm volatile("" : "+s"(F.ws), "+s"(F.out));
    F.ws = as_global(F.ws); F.out = as_global(F.out);
    return F;
}

DI void dense_gemm(const Ctx& F, const bf16_t* A, int lda, const bf16_t* Bt, int ldb, int M, int N, int K, bf16_t* O, int ldc, int crot) {
    pg8::Gemm g{A, Bt, lda, ldb, K}; pg8::StaticOrder S; S.init(M, N, F.G, (F.bid + crot) % F.G);
    pg8::EpiStore E{O, ldc};
    for (int rep = 0; rep < REP_GEMM; ++rep) pg8::gemm_phase<pg8::EpiStore, pg8::StaticOrder>(F.lds, g, S, E);
}

struct TJob { const float* src; bf16_t* dst; int ldw, dld; };
DI void tr_load(const TJob& j, f32x4 (&r)[16], int lane) {
    const GAS float* p = (const GAS float*)(j.src + (size_t)(lane >> 4) * j.ldw + 4 * (lane & 15));
#pragma unroll
    for (int i = 0; i < 16; ++i) r[i] = *(const GAS f32x4*)(p + (size_t)(4 * i) * j.ldw);
}
DI void tr_store(const TJob& j, const f32x4 (&r)[16], LAS unsigned char* scr, int lane) {
#pragma unroll
    for (int i = 0; i < 16; ++i) { LAS unsigned* w = (LAS unsigned*)(scr + ((lane >> 4) + 4 * i) * 132 + (lane & 15) * 8); w[0] = cvt_pk_bf16(r[i].x, r[i].y); w[1] = cvt_pk_bf16(r[i].z, r[i].w); }
    LDS_WAIT();
    const int kc = lane & 7;
#pragma unroll
    for (int sgrp = 0; sgrp < 8; ++sgrp) { const int n = 8 * sgrp + (lane >> 3); const LAS unsigned short* c = (const LAS unsigned short*)(scr + (8 * kc) * 132 + n * 2);
        u32x4 o; o.x = (unsigned)c[0] | ((unsigned)c[66] << 16); o.y = (unsigned)c[2 * 66] | ((unsigned)c[3 * 66] << 16); o.z = (unsigned)c[4 * 66] | ((unsigned)c[5 * 66] << 16); o.w = (unsigned)c[6 * 66] | ((unsigned)c[7 * 66] << 16);
        *(GAS u32x4*)(j.dst + (size_t)n * j.dld + 8 * kc) = o; }
    LDS_WAIT();
}
template <class Dec> DI void tr_run(const Dec& D, int first, int count, int stride, LAS unsigned char* scr, int lane) {
    f32x4 A[16], B[16]; TJob ja, jb;
    int it = first; if (it >= count) return;
    ja = D(it); tr_load(ja, A, lane);
    for (;;) {
        const int it2 = it + stride; const bool h2 = it2 < count; if (h2) { jb = D(it2); tr_load(jb, B, lane); }
        tr_store(ja, A, scr, lane);
        if (!h2) break;
        const int it3 = it2 + stride; const bool h3 = it3 < count; if (h3) { ja = D(it3); tr_load(ja, A, lane); }
        tr_store(jb, B, scr, lane);
        if (!h3) break;
        it = it3;
    }
}
DI TJob mat_job(const float* W, int K, int N, bf16_t* WT, int item) {
    const int nblk = N / 64, kb = item / nblk, nb = item - kb * nblk;
    TJob j; j.src = W + (size_t)(64 * kb) * N + 64 * nb; j.dst = WT + (size_t)(64 * nb) * K + 64 * kb; j.ldw = N; j.dld = K; return j;
}
DI void row_to_bf16(const float* src, bf16_t* dst, int lane) {
    const GAS f32x4* s = (const GAS f32x4*)src + lane; GAS u32x2* o = (GAS u32x2*)dst + lane;
#pragma unroll
    for (int j = 0; j < 8; ++j) { const f32x4 v = s[64 * j]; u32x2 w; w.x = cvt_pk_bf16(v.x, v.y); w.y = cvt_pk_bf16(v.z, v.w); o[64 * j] = w; }
}

DI void phase_prologue(const Ctx& F, const Params& P) {
    unsigned char* const wsl = F.ws; float* const outl = F.out; (void)outl;
    LAS unsigned char* scr = F.lds + F.wave * 16384;
    unsigned char* ws = wsl;
    constexpr int I_RW = 32 * (RW_IN_COLS / 64), I_OT = 32 * (ZW_OTH / 64), I_WO = 32 * 32, I_KV = 32 * 8;
    constexpr int N_A = 2 * I_RW + 2 * I_OT, N_B = 4 * I_WO, N_C = 8 * I_KV, N_D = NTOK + NBATCH * MEML;
    struct ProDec { unsigned char* ws;
        DI TJob operator()(int it) const { int r = it;
            if (r < N_A) {
                if (r < I_RW) return mat_job(PIN(16), DM, RW_IN_COLS, (bf16_t*)(ws + WS_WIN), r); r -= I_RW;
                if (r < I_OT) return mat_job(PIN(28), DM, ZW_OTH, (bf16_t*)(ws + WS_WIN + WIN_STRIDE), r); r -= I_OT;
                if (r < I_OT) return mat_job(PIN(30), DM, ZW_OTH, (bf16_t*)(ws + WS_WIN + 2 * WIN_STRIDE), r); r -= I_OT;
                return mat_job(PIN(16) + (size_t)DM * RW_IN_COLS, DM, RW_IN_COLS, (bf16_t*)(ws + WS_WIN + 3 * WIN_STRIDE), r);
            }
            r -= N_A;
            if (r < N_B) { const int l = r / I_WO; return mat_job(PIN(2) + (size_t)l * DM * DM, DM, DM, (bf16_t*)(ws + WS_WOUT) + (size_t)l * DM * DM, r - l * I_WO); }
            r -= N_B;
            const int m = r / I_KV, l = m & 3; const bool isv = m >= 4;
            return mat_job(PIN(isv ? 4 : 3) + (size_t)l * DM * MEMW, DM, MEMW, (bf16_t*)(ws + (isv ? WS_WV : WS_WK)) + (size_t)l * MEMW * DM, r - m * I_KV);
        } };
    ProDec PD{ws};
    tr_run(PD, F.gw, N_A + N_B + N_C, F.ngw, scr, F.lane);
    for (int r = F.gw; r < N_D; r += F.ngw) {
        if (r < NTOK) row_to_bf16(PIN(0) + (size_t)r * DM, (bf16_t*)(ws + WS_XB) + (size_t)r * DM, F.lane);
        else row_to_bf16(PIN(1) + (size_t)(r - NTOK) * DM, (bf16_t*)(ws + WS_MEMB) + (size_t)(r - NTOK) * DM, F.lane);
    }
    const int gt = F.bid * NT + F.tid, ngt = F.G * NT;
    for (int idx = gt; idx < 2 * (3072 + 1536) * 256; idx += ngt) {
        const int j = idx / ((3072 + 1536) * 256); int r = idx - j * (3072 + 1536) * 256;
        bf16_t* base = (bf16_t*)(ws + WS_LORA + (size_t)j * LORA_STRIDE);
        const int n = r >> 8, k = r & 255; float v = 0.f;
        if (n < 1536) { if (k < 96) v = PIN(19)[((size_t)j * 96 + k) * CMIX + n]; }
        else if (n < 3072) { if (k >= 96 && k < 192) v = PIN(21)[((size_t)j * 96 + (k - 96)) * CMIX + (n - 1536)]; }
        else v = PIN(22)[((size_t)j * 256 + k) * CMIX + (n - 3072)];
        base[r] = (bf16_t)(cvt_pk_bf16(v, 0.f) & 0xffffu);
    }
    for (int idx = gt; idx < 2 * 64 * DM; idx += ngt) { const int j = idx / (64 * DM), r = idx - j * 64 * DM;
        ((bf16_t*)(ws + WS_WIN + (size_t)(j ? 3 : 0) * WIN_STRIDE))[(size_t)RW_IN_COLS * DM + r] = 0; }
    for (int idx = gt; idx < NLAYER * 48 * DM; idx += ngt) {
        const int l = idx / (48 * DM); int r = idx - l * 48 * DM; const int n = r / DM, k = r - n * DM;
        float v = 0.f;
        if (n < 4) v = PIN(9)[((size_t)l * DM + k) * 4 + n]; else if (n < 36) v = PIN(11)[((size_t)l * DM + k) * 32 + (n - 4)];
        const unsigned hi = cvt_pk_bf16(v, 0.f) & 0xffffu; const float rem = v - bf2f(hi); const unsigned lo = cvt_pk_bf16(rem, 0.f) & 0xffffu;
        bf16_t* base = (bf16_t*)(ws + WS_WSW + (size_t)l * WSW_STRIDE);
        base[r] = (bf16_t)hi; base[48 * DM + r] = (bf16_t)lo;
    }
}

DI void expert_convert(const Ctx& F, const Params& P, int l, int w, int nw) {
    unsigned char* const wsl = F.ws;
    LAS unsigned char* scr = F.lds + F.wave * 16384;
    constexpr int I_GU = NEXP * 32 * 8 * 2, I_DN = NEXP * 8 * 32;
    struct ExpDec { unsigned char* ws; int l;
        DI TJob operator()(int it) const { TJob j;
            if (it < I_GU) {
                const int isup = it / (I_GU / 2); int r = it - isup * (I_GU / 2);
                const int e = r / 256; r -= e * 256; const int kb = r >> 3, nb = r & 7;
                const float* W = PIN(isup ? 14 : 13) + ((size_t)l * NEXP + e) * DM * DEXP;
                const int n0 = 64 * nb, drow = 256 * (n0 >> 7) + (isup ? 128 : 0) + (n0 & 127);
                j.src = W + (size_t)(64 * kb) * DEXP + n0; j.ldw = DEXP; j.dst = (bf16_t*)(ws + WS_EXP1) + ((size_t)e * 1024 + drow) * DM + 64 * kb; j.dld = DM;
            } else {
                int r = it - I_GU; const int e = r / 256; r -= e * 256; const int kb = r >> 5, nb = r & 31;
                const float* W = PIN(15) + ((size_t)l * NEXP + e) * DEXP * DM;
                j.src = W + (size_t)(64 * kb) * DM + 64 * nb; j.ldw = DM; j.dst = (bf16_t*)(ws + WS_EXP2) + ((size_t)e * DM + 64 * nb) * DEXP + 64 * kb; j.dld = DEXP;
            }
            return j; } };
    ExpDec ED{wsl, l};
    tr_run(ED, w, I_GU + I_DN, nw, scr, F.lane);
}

DI void memattn_unit(const Ctx& F, int l, int unit, const bf16_t* z, int zw, int qcol) {
    unsigned char* const wsl = F.ws; float* const outl = F.out; (void)outl;
    const int b = unit >> 6, head = (unit >> 4) & 3, qblk = unit & 15;
    LAS unsigned char* Ks = F.lds; LAS unsigned char* Vs = F.lds + 69632;
    const bf16_t* Km = (const bf16_t*)(wsl + WS_KM); const bf16_t* VmT = (const bf16_t*)(wsl + WS_VMT);
    bf16_t* cat = (bf16_t*)(wsl + WS_CAT);
    __syncthreads();
#pragma unroll
    for (int i = 0; i < 8; ++i) { const int ch = F.tid + NT * i;
        { const int row = ch >> 4, c16 = ch & 15; const u32x4 v = *(const u32x4*)(Km + (size_t)(b * MEML + row) * 2048 + l * 512 + head * 128 + c16 * 8); *(LAS u32x4*)(Ks + row * 272 + c16 * 16) = v; }
        { const int d = ch >> 5, c = ch & 31; const u32x4 v = *(const u32x4*)(VmT + (size_t)(l * 512 + head * 128 + d) * 1024 + b * MEML + c * 8); *(LAS u32x4*)(Vs + d * 528 + c * 16) = v; } }
    __syncthreads();
    const int lane = F.lane, fr = lane & 15, fq = lane >> 4;
    for (int itq = 0; itq < 2; ++itq) {
        const int q0 = qblk * 256 + itq * 128 + F.wave * 16, tok0 = b * SEQ + q0;
        bf16x8 Qf[4];
#pragma unroll
        for (int ks = 0; ks < 4; ++ks) Qf[ks] = *(const bf16x8*)(z + (size_t)(tok0 + fr) * zw + qcol + head * 128 + ks * 32 + fq * 8);
        f32x4 acc[16];
#pragma unroll
        for (int t = 0; t < 16; ++t) { acc[t] = (f32x4){0.f, 0.f, 0.f, 0.f};
#pragma unroll
            for (int ks = 0; ks < 4; ++ks) { const bf16x8 kf = *(const LAS bf16x8*)(Ks + (16 * t + fr) * 272 + ks * 64 + fq * 16);
                acc[t] = __builtin_amdgcn_mfma_f32_16x16x32_bf16(kf, Qf[ks], acc[t], 0, 0, 0); } }
        const float sc = 0.08838834764831845f;
        float mx = -3.0e38f;
#pragma unroll
        for (int t = 0; t < 16; ++t)
#pragma unroll
            for (int j = 0; j < 4; ++j) { acc[t][j] *= sc; mx = fmaxf(mx, acc[t][j]); }
        mx = fmaxf(mx, __shfl_xor(mx, 16)); mx = fmaxf(mx, __shfl_xor(mx, 32));
        float sum = 0.f;
#pragma unroll
        for (int t = 0; t < 16; ++t)
#pragma unroll
            for (int j = 0; j < 4; ++j) { acc[t][j] = __expf(acc[t][j] - mx); sum += acc[t][j]; }
        sum += __shfl_xor(sum, 16); sum += __shfl_xor(sum, 32);
        const float inv = 1.f / sum;
        f32x4 o[8];
#pragma unroll
        for (int dt = 0; dt < 8; ++dt) o[dt] = (f32x4){0.f, 0.f, 0.f, 0.f};
#pragma unroll
        for (int s = 0; s < 8; ++s) {
            u32x4 pw; pw.x = cvt_pk_bf16(acc[2 * s][0], acc[2 * s][1]); pw.y = cvt_pk_bf16(acc[2 * s][2], acc[2 * s][3]);
            pw.z = cvt_pk_bf16(acc[2 * s + 1][0], acc[2 * s + 1][1]); pw.w = cvt_pk_bf16(acc[2 * s + 1][2], acc[2 * s + 1][3]);
            const bf16x8 pf = __builtin_bit_cast(bf16x8, pw);
#pragma unroll
            for (int dt = 0; dt < 8; ++dt) {
                const u32x2 v0 = *(const LAS u32x2*)(Vs + (16 * dt + fr) * 528 + (32 * s + 4 * fq) * 2);
                const u32x2 v1 = *(const LAS u32x2*)(Vs + (16 * dt + fr) * 528 + (32 * s + 16 + 4 * fq) * 2);
                u32x4 vw; vw.x = v0.x; vw.y = v0.y; vw.z = v1.x; vw.w = v1.y;
                o[dt] = __builtin_amdgcn_mfma_f32_16x16x32_bf16(__builtin_bit_cast(bf16x8, vw), pf, o[dt], 0, 0, 0);
            }
        }
        bf16_t* orow = cat + (size_t)(tok0 + fr) * DM + CMIX + head * 128 + 4 * fq;
#pragma unroll
        for (int dt = 0; dt < 8; ++dt) { u32x2 w; w.x = cvt_pk_bf16(o[dt][0] * inv, o[dt][1] * inv); w.y = cvt_pk_bf16(o[dt][2] * inv, o[dt][3] * inv); *(u32x2*)(orow + 16 * dt) = w; }
    }
}
DI void memattn_all(const Ctx& F, int l, const bf16_t* z, int zw, int qcol) {
    for (int u = F.bid; u < 256; u += F.G) memattn_unit(F, l, u, z, zw, qcol);
    __syncthreads();
}

DI void conv_mix(const Ctx& F, const Params& P, const bf16_t* z) {
    unsigned char* const wsl = F.ws; float* const outl = F.out; (void)outl;
    const float* cw = PIN(29);
    bf16_t* cat = (bf16_t*)(wsl + WS_CAT);
    const int gt = F.bid * NT + F.tid, ngt = F.G * NT;
    for (int idx = gt; idx < NTOK * 192; idx += ngt) {
        const int tok = idx / 192, c8 = idx - tok * 192, c = c8 * 8, t = tok & (SEQ - 1);
        const bf16_t* zr = z + (size_t)tok * ZW_OTH;
        const u32x4 bg = *(const u32x4*)(zr + c);
        float y[8];
#pragma unroll
        for (int j = 0; j < 8; ++j) y[j] = 0.f;
#pragma unroll
        for (int dt = 0; dt < 3; ++dt) {
            if (t - dt >= 0) {
                const u32x4 cg = *(const u32x4*)(zr - (size_t)dt * ZW_OTH + CMIX + c), hh = *(const u32x4*)(zr - (size_t)dt * ZW_OTH + 2 * CMIX + c);
                const f32x4 w0 = *(const f32x4*)(cw + (2 - dt) * CMIX + c), w1 = *(const f32x4*)(cw + (2 - dt) * CMIX + c + 4);
                y[0] += w0.x * bflo(cg.x) * bflo(hh.x); y[1] += w0.y * bfhi(cg.x) * bfhi(hh.x); y[2] += w0.z * bflo(cg.y) * bflo(hh.y); y[3] += w0.w * bfhi(cg.y) * bfhi(hh.y);
                y[4] += w1.x * bflo(cg.z) * bflo(hh.z); y[5] += w1.y * bfhi(cg.z) * bfhi(hh.z); y[6] += w1.z * bflo(cg.w) * bflo(hh.w); y[7] += w1.w * bfhi(cg.w) * bfhi(hh.w);
            }
        }
        u32x4 o; o.x = cvt_pk_bf16(bflo(bg.x) * y[0], bfhi(bg.x) * y[1]); o.y = cvt_pk_bf16(bflo(bg.y) * y[2], bfhi(bg.y) * y[3]);
        o.z = cvt_pk_bf16(bflo(bg.z) * y[4], bfhi(bg.z) * y[5]); o.w = cvt_pk_bf16(bflo(bg.w) * y[6], bfhi(bg.w) * y[7]);
        *(u32x4*)(cat + (size_t)tok * DM + c) = o;
    }
}

DI void sb_attention(const Ctx& F, const bf16_t* z) {
    unsigned char* const wsl = F.ws;
    const bf16_t* VT = (const bf16_t*)(wsl + WS_ACT);
    bf16_t* cat = (bf16_t*)(wsl + WS_CAT);
    LAS unsigned char* Ks = F.lds; LAS unsigned char* Vs = F.lds + 69632;
    const int lane = F.lane, fr = lane & 15, fq = lane >> 4;
    const float sc = 0.08838834764831845f;
    for (int u = F.bid; u < NBATCH * 12 * 32; u += F.G) {
        const int b = u / (12 * 32); int r = u - b * 12 * 32; const int head = r >> 5, qblk = r & 31;
        const int t0 = qblk * 128, kw0 = t0 - 128;
        __syncthreads();
#pragma unroll
        for (int i = 0; i < 8; ++i) { const int ch = F.tid + NT * i;
            { const int row = ch >> 4, c16 = ch & 15, key = kw0 + row;
              if (key >= 0) { const u32x4 v = *(const u32x4*)(z + (size_t)(b * SEQ + key) * ZW_OTH + CMIX + head * 128 + c16 * 8); *(LAS u32x4*)(Ks + row * 272 + c16 * 16) = v; } }
            { const int d = ch >> 5, c = ch & 31;
              if (kw0 + c * 8 >= 0) { const u32x4 v = *(const u32x4*)(VT + (size_t)(head * 128 + d) * NTOK + b * SEQ + kw0 + c * 8); *(LAS u32x4*)(Vs + d * 528 + c * 16) = v; } } }
        __syncthreads();
        const int tq0 = t0 + F.wave * 16, tq = tq0 + fr;
        bf16x8 Qf[4];
#pragma unroll
        for (int ks = 0; ks < 4; ++ks) Qf[ks] = *(const bf16x8*)(z + (size_t)(b * SEQ + tq) * ZW_OTH + head * 128 + ks * 32 + fq * 8);
        f32x4 o[8];
#pragma unroll
        for (int dt = 0; dt < 8; ++dt) o[dt] = (f32x4){0.f, 0.f, 0.f, 0.f};
        float R = 0.f;
        for (int kt = (tq0 + 14) >> 5; kt >= 0; --kt) {
            const int lk = 32 * kt - kw0;
            bf16x8 Kf[2][4]; u32x2 V0[8], V1[8];
            if (lk >= 0) {
#pragma unroll
                for (int tl = 0; tl < 2; ++tl)
#pragma unroll
                    for (int ks = 0; ks < 4; ++ks) Kf[tl][ks] = *(const LAS bf16x8*)(Ks + (lk + 16 * tl + fr) * 272 + ks * 64 + fq * 16);
#pragma unroll
                for (int dt = 0; dt < 8; ++dt) { V0[dt] = *(const LAS u32x2*)(Vs + (16 * dt + fr) * 528 + (lk + 4 * fq) * 2); V1[dt] = *(const LAS u32x2*)(Vs + (16 * dt + fr) * 528 + (lk + 16 + 4 * fq) * 2); }
            } else {
#pragma unroll
                for (int tl = 0; tl < 2; ++tl)
#pragma unroll
                    for (int ks = 0; ks < 4; ++ks) Kf[tl][ks] = *(const bf16x8*)(z + (size_t)(b * SEQ + 32 * kt + 16 * tl + fr) * ZW_OTH + CMIX + head * 128 + ks * 32 + fq * 8);
#pragma unroll
                for (int dt = 0; dt < 8; ++dt) { const bf16_t* vp = VT + (size_t)(head * 128 + 16 * dt + fr) * NTOK + b * SEQ + 32 * kt + 4 * fq; V0[dt] = *(const u32x2*)vp; V1[dt] = *(const u32x2*)(vp + 16); }
            }
            f32x4 s[2];
#pragma unroll
            for (int tl = 0; tl < 2; ++tl) { s[tl] = (f32x4){0.f, 0.f, 0.f, 0.f};
#pragma unroll
                for (int ks = 0; ks < 4; ++ks) s[tl] = __builtin_amdgcn_mfma_f32_16x16x32_bf16(Kf[tl][ks], Qf[ks], s[tl], 0, 0, 0); }
            float ln[2][4], lsg[2][4], tot[2];
#pragma unroll
            for (int tl = 0; tl < 2; ++tl) { tot[tl] = 0.f;
#pragma unroll
                for (int j = 0; j < 4; ++j) { const float x = s[tl][j] * sc; const int key = 32 * kt + 16 * tl + 4 * fq + j; const bool valid = key < tq;
                    const float sp = softplusf_(x); ln[tl][j] = valid ? -sp : 0.f; lsg[tl][j] = valid ? (x - sp) : -1.0e30f; tot[tl] += ln[tl][j]; } }
            const float a16_0 = __shfl_xor(tot[0], 16), a32_0 = __shfl_xor(tot[0], 32), a48_0 = __shfl_xor(tot[0], 48);
            const float a16_1 = __shfl_xor(tot[1], 16), a32_1 = __shfl_xor(tot[1], 32), a48_1 = __shfl_xor(tot[1], 48);
            float hi0 = 0.f, hi1 = 0.f;
            if ((fq ^ 1) > fq) { hi0 += a16_0; hi1 += a16_1; }
            if ((fq ^ 2) > fq) { hi0 += a32_0; hi1 += a32_1; }
            if ((fq ^ 3) > fq) { hi0 += a48_0; hi1 += a48_1; }
            const float all0 = tot[0] + a16_0 + a32_0 + a48_0, all1 = tot[1] + a16_1 + a32_1 + a48_1;
            const float E0 = R + hi0 + all1, E1 = R + hi1;
            float at[2][4];
#pragma unroll
            for (int tl = 0; tl < 2; ++tl) { float suf = 0.f; const float Eb = tl ? E1 : E0;
#pragma unroll
                for (int j = 3; j >= 0; --j) { at[tl][j] = __expf(lsg[tl][j] + Eb + suf); suf += ln[tl][j]; } }
            R += all0 + all1;
            u32x4 pw; pw.x = cvt_pk_bf16(at[0][0], at[0][1]); pw.y = cvt_pk_bf16(at[0][2], at[0][3]); pw.z = cvt_pk_bf16(at[1][0], at[1][1]); pw.w = cvt_pk_bf16(at[1][2], at[1][3]);
            const bf16x8 pf = __builtin_bit_cast(bf16x8, pw);
#pragma unroll
            for (int dt = 0; dt < 8; ++dt) {
                u32x4 vw; vw.x = V0[dt].x; vw.y = V0[dt].y; vw.z = V1[dt].x; vw.w = V1[dt].y;
                o[dt] = __builtin_amdgcn_mfma_f32_16x16x32_bf16(__builtin_bit_cast(bf16x8, vw), pf, o[dt], 0, 0, 0);
            }
            if (__all(R < -100.f)) break;
        }
        bf16_t* orow = cat + (size_t)(b * SEQ + tq) * DM + head * 128 + 4 * fq;
#pragma unroll
        for (int dt = 0; dt < 8; ++dt) { u32x2 w; w.x = cvt_pk_bf16(o[dt][0], o[dt][1]); w.y = cvt_pk_bf16(o[dt][2], o[dt][3]); *(u32x2*)(orow + 16 * dt) = w; }
    }
    __syncthreads();
}

DI void rwkv_prep1(const Ctx& F, const Params& P, int j, const bf16_t* z) {
    unsigned char* const wsl = F.ws; float* const outl = F.out; (void)outl;
    const float* mu = PIN(17) + (size_t)j * 5056;
    bf16_t* act = (bf16_t*)(wsl + WS_ACT);
    const int gt = F.bid * NT + F.tid, ngt = F.G * NT;
    for (int idx = gt; idx < NTOK * 64; idx += ngt) {
        const int tok = idx >> 6, ci = idx & 63, t = tok & (SEQ - 1);
        u32x4 o = (u32x4){0u, 0u, 0u, 0u};
        if (ci < 24 || ci >= 32) {
            const int sc = ci < 12 ? 4608 + 8 * ci : (ci < 24 ? 4704 + 8 * (ci - 12) : 4800 + 8 * (ci - 32));
            const u32x4 a = *(const u32x4*)(z + (size_t)tok * ZW_RWKV + sc);
            u32x4 p = (u32x4){0u, 0u, 0u, 0u}; if (t > 0) p = *(const u32x4*)(z + (size_t)(tok - 1) * ZW_RWKV + sc);
            const f32x4 m0 = *(const f32x4*)(mu + sc), m1 = *(const f32x4*)(mu + sc + 4);
            float v[8];
            v[0] = bflo(a.x) + (bflo(p.x) - bflo(a.x)) * m0.x; v[1] = bfhi(a.x) + (bfhi(p.x) - bfhi(a.x)) * m0.y;
            v[2] = bflo(a.y) + (bflo(p.y) - bflo(a.y)) * m0.z; v[3] = bfhi(a.y) + (bfhi(p.y) - bfhi(a.y)) * m0.w;
            v[4] = bflo(a.z) + (bflo(p.z) - bflo(a.z)) * m1.x; v[5] = bfhi(a.z) + (bfhi(p.z) - bfhi(a.z)) * m1.y;
            v[6] = bflo(a.w) + (bflo(p.w) - bflo(a.w)) * m1.z; v[7] = bfhi(a.w) + (bfhi(p.w) - bfhi(a.w)) * m1.w;
#pragma unroll
            for (int q = 0; q < 8; ++q) { if (ci < 12) v[q] = tanhf(v[q]); else if (ci >= 32) v[q] = sigmoidf_(v[q]); }
            o.x = cvt_pk_bf16(v[0], v[1]); o.y = cvt_pk_bf16(v[2], v[3]); o.z = cvt_pk_bf16(v[4], v[5]); o.w = cvt_pk_bf16(v[6], v[7]);
        }
        *(u32x4*)(act + (size_t)tok * 512 + ci * 8) = o;
    }
}

constexpr int CH = 64, NCH = SEQ / CH;
DI float* scan_rec(unsigned char* ws, int tok, int head) {
    return (float*)(ws + WS_SCAN) + ((size_t)((tok >> 12) * 24 + head) * SEQ + (tok & (SEQ - 1))) * 320;
}
DI float* gh_ptr(unsigned char* ws, int bh, int c, int which) { return (float*)(ws + WS_GH) + (((size_t)bh * NCH + c) * 2 + which) * 4096; }
struct RwPar { const float *mu, *w0, *a0, *kk, *ka, *rk, *gng, *gnb; };
struct PrepRaw { u32x2 zr, zk, zv, pr, pk, pv, lw, la; };
struct PrepOut { f32x4 dec, ld, bb, kp, r, nk, v; float bon; };
DI void prep_load(PrepRaw& R, const bf16_t* z, const bf16_t* LW, int tok, int c4) {
    tok = tok < NTOK ? tok : NTOK - 1;
    const bool hp = (tok & (SEQ - 1)) != 0;
    const GAS bf16_t* zc = (const GAS bf16_t*)(z + (size_t)tok * ZW_RWKV + c4); const GAS bf16_t* zp = hp ? zc - ZW_RWKV : zc;
    R.zr = *(const GAS u32x2*)zc; R.zk = *(const GAS u32x2*)(zc + CMIX); R.zv = *(const GAS u32x2*)(zc + 2 * CMIX);
    R.pr = *(const GAS u32x2*)zp; R.pk = *(const GAS u32x2*)(zp + CMIX); R.pv = *(const GAS u32x2*)(zp + 2 * CMIX);
    const GAS bf16_t* lp = (const GAS bf16_t*)(LW + (size_t)tok * 3072 + c4); R.lw = *(const GAS u32x2*)lp; R.la = *(const GAS u32x2*)(lp + CMIX);
}
DI f32x4 lerp_u(u32x2 a, u32x2 p, f32x4 m) {
    f32x4 r; r.x = bflo(a.x) + (bflo(p.x) - bflo(a.x)) * m.x; r.y = bfhi(a.x) + (bfhi(p.x) - bfhi(a.x)) * m.y;
    r.z = bflo(a.y) + (bflo(p.y) - bflo(a.y)) * m.z; r.w = bfhi(a.y) + (bfhi(p.y) - bfhi(a.y)) * m.w; return r;
}
struct PrepPar { f32x4 mur, muk, muv, w0, a0, kk, ka, rk; };
DI void par_load(PrepPar& P, const RwPar& Q, int c4) {
    P.mur = *(const GAS f32x4*)(Q.mu + c4); P.muk = *(const GAS f32x4*)(Q.mu + CMIX + c4); P.muv = *(const GAS f32x4*)(Q.mu + 2 * CMIX + c4);
    P.w0 = *(const GAS f32x4*)(Q.w0 + c4); P.a0 = *(const GAS f32x4*)(Q.a0 + c4); P.kk = *(const GAS f32x4*)(Q.kk + c4); P.ka = *(const GAS f32x4*)(Q.ka + c4); P.rk = *(const GAS f32x4*)(Q.rk + c4);
}
template <bool WANT_BON> DI void prep_compute(const PrepRaw& R, const PrepPar& P, bool hp, PrepOut& O) {
    const u32x2 z2 = (u32x2){0u, 0u};
    const f32x4 r = lerp_u(R.zr, hp ? R.pr : z2, P.mur), k = lerp_u(R.zk, hp ? R.pk : z2, P.muk);
    O.v = lerp_u(R.zv, hp ? R.pv : z2, P.muv); O.r = r;
    const f32x4 w0v = P.w0, a0v = P.a0, kkv = P.kk, kav = P.ka;
    f32x4 wr; wr.x = w0v.x + bflo(R.lw.x); wr.y = w0v.y + bfhi(R.lw.x); wr.z = w0v.z + bflo(R.lw.y); wr.w = w0v.w + bfhi(R.lw.y);
    f32x4 ar; ar.x = a0v.x + bflo(R.la.x); ar.y = a0v.y + bfhi(R.la.x); ar.z = a0v.z + bflo(R.la.y); ar.w = a0v.w + bfhi(R.la.y);
    f32x4 a, kk;
#pragma unroll
    for (int q = 0; q < 4; ++q) { const float wl = -softplusf_(-wr[q]) - 0.5f; O.ld[q] = -__expf(wl); O.dec[q] = __expf(O.ld[q]); a[q] = sigmoidf_(ar[q]); kk[q] = k[q] * kkv[q]; O.kp[q] = k[q] * (1.f + (a[q] - 1.f) * kav[q]); }
    const float n2 = sum16(kk.x * kk.x + kk.y * kk.y + kk.z * kk.z + kk.w * kk.w);
    const float inv = __builtin_amdgcn_rsqf(fmaxf(n2, 1e-24f));
#pragma unroll
    for (int q = 0; q < 4; ++q) { const float kn = kk[q] * inv; O.bb[q] = kn * a[q]; O.nk[q] = -kn; }
    if (WANT_BON) { const f32x4 rk = P.rk; O.bon = sum16(r.x * O.kp.x * rk.x + r.y * O.kp.y * rk.y + r.z * O.kp.z * rk.z + r.w * O.kp.w * rk.w); }
}
#define LO2(v) ((f32x2){(v).x, (v).y})
#define HI2(v) ((f32x2){(v).z, (v).w})
constexpr int WRS = 144;
constexpr int W_SLOT = 64 * WRS;
enum { SL_NT = 0, SL_RT, SL_BH, SL_KH, SL_BHT, SL_KHT, SL_VT, SL_MK, SL_NB, SL_NK, SL_W1T, SL_U0T };
constexpr int W_MB = 12 * W_SLOT, W_CL = W_MB + 16384, W_PL = W_CL + 16384;
DI bf16x8 wfrag(LAS unsigned char* L, int slot, int row, int ks, int q) { return *(const LAS bf16x8*)(L + slot * W_SLOT + row * WRS + ks * 64 + q * 16); }
DI void wput(LAS unsigned char* L, int slot, int row, int col, float v) { *(LAS bf16_t*)(L + slot * W_SLOT + row * WRS + col * 2) = (bf16_t)(cvt_pk_bf16(v, 0.f) & 0xffffu); }
DI void scan_w1(const Ctx& F, const RwPar& Q, const bf16_t* z) {
    unsigned char* const wsl = F.ws; LAS unsigned char* L = F.lds;
    const int wave = F.wave;
    const bf16_t* LW = (const bf16_t*)(wsl + WS_LW);
    LAS float* MB = (LAS float*)(L + W_MB); LAS float* CL = (LAS float*)(L + W_CL); LAS float* PL = (LAS float*)(L + W_PL);
    PrepPar PN;
    PrepRaw RN[2];
    if (F.bid < 96 * NCH) { const int bh = F.bid % 96, c = F.bid / 96, b = bh / 24, head = bh - b * 24, tokb = b * SEQ + c * CH, c4 = head * 64 + 4 * (F.lane & 15);
#pragma unroll
        for (int p = 0; p < 2; ++p) prep_load(RN[p], z, LW, tokb + p * 32 + wave * 4 + (F.lane >> 4), c4);
        par_load(PN, Q, c4); }
    for (int u = F.bid; u < 96 * NCH; u += F.G) {
        int lane = F.lane; asm volatile("" : "+v"(lane));
        const int tq = lane >> 4, li = lane & 15, fr = li, fq = tq;
        const int bh = u % 96, c = u / 96, b = bh / 24, head = bh - b * 24, tokb = b * SEQ + c * CH, c4 = head * 64 + 4 * li;
        LDS_BARRIER();
        PrepOut O[2];
#pragma unroll
        for (int p = 0; p < 2; ++p) {
            const int t = p * 32 + wave * 4 + tq; const PrepRaw R = RN[p];
            prep_compute<true>(R, PN, ((tokb + t) & (SEQ - 1)) != 0, O[p]);
            *(LAS f32x4*)(CL + t * 64 + 4 * li) = O[p].ld;
            u32x2 e; e.x = cvt_pk_bf16(O[p].bon * O[p].v.x, O[p].bon * O[p].v.y); e.y = cvt_pk_bf16(O[p].bon * O[p].v.z, O[p].bon * O[p].v.w);
            *(GAS u32x2*)((bf16_t*)(wsl + WS_E) + (size_t)(tokb + t) * CMIX + c4) = e;
        }
        LDS_BARRIER();
        if (wave == 0) {
            float xs[64];
#pragma unroll
            for (int t = 0; t < 64; ++t) xs[t] = CL[t * 64 + lane];
#pragma unroll
            for (int t = 1; t < 64; ++t) xs[t] += xs[t - 1];
#pragma unroll
            for (int t = 0; t < 64; ++t) CL[t * 64 + lane] = xs[t];
        }
        LDS_BARRIER();
#pragma unroll
        for (int p = 0; p < 2; ++p) {
            const int t = p * 32 + wave * 4 + tq;
            const f32x4 cl = *(const LAS f32x4*)(CL + t * 64 + 4 * li);
            f32x4 clm = (f32x4){0.f, 0.f, 0.f, 0.f}; if (t > 0) clm = *(const LAS f32x4*)(CL + (t - 1) * 64 + 4 * li);
            f32x4 nt, rt, bh4, kh4;
#pragma unroll
            for (int q = 0; q < 4; ++q) { const float P = __expf(cl[q]), Pm = __expf(clm[q]), iP = __expf(-cl[q]);
                nt[q] = O[p].nk[q] * Pm; rt[q] = O[p].r[q] * P; bh4[q] = O[p].bb[q] * iP; kh4[q] = O[p].kp[q] * iP;
                if (t == 63) PL[4 * li + q] = P; }
            u32x2 w;
            w.x = cvt_pk_bf16(nt.x, nt.y); w.y = cvt_pk_bf16(nt.z, nt.w); *(LAS u32x2*)(L + SL_NT * W_SLOT + t * WRS + 8 * li) = w;
            w.x = cvt_pk_bf16(rt.x, rt.y); w.y = cvt_pk_bf16(rt.z, rt.w); *(LAS u32x2*)(L + SL_RT * W_SLOT + t * WRS + 8 * li) = w;
            w.x = cvt_pk_bf16(bh4.x, bh4.y); w.y = cvt_pk_bf16(bh4.z, bh4.w); *(LAS u32x2*)(L + SL_BH * W_SLOT + t * WRS + 8 * li) = w;
            w.x = cvt_pk_bf16(kh4.x, kh4.y); w.y = cvt_pk_bf16(kh4.z, kh4.w); *(LAS u32x2*)(L + SL_KH * W_SLOT + t * WRS + 8 * li) = w;
#pragma unroll
            for (int q = 0; q < 4; ++q) { wput(L, SL_BHT, 4 * li + q, t, bh4[q]); wput(L, SL_KHT, 4 * li + q, t, kh4[q]); wput(L, SL_VT, 4 * li + q, t, O[p].v[q]); }
        }
        LDS_BARRIER();
        for (int reps = 0; reps < REP_WS; ++reps) {
            const int mt = wave >> 1, slotA = (mt < 2) ? SL_NT : SL_RT, slotB = (mt & 1) ? SL_KH : SL_BH, slotO = (mt == 1) ? SL_MK : (mt == 2 ? SL_NB : SL_NK), tt0 = (wave & 1) * 2;
            bf16x8 Af[2][2], Bf[4][2];
#pragma unroll
            for (int a2 = 0; a2 < 2; ++a2)
#pragma unroll
                for (int ks = 0; ks < 2; ++ks) Af[a2][ks] = wfrag(L, slotA, 16 * (tt0 + a2) + fr, ks, fq);
#pragma unroll
            for (int ss = 0; ss < 4; ++ss)
#pragma unroll
                for (int ks = 0; ks < 2; ++ks) Bf[ss][ks] = wfrag(L, slotB, 16 * ss + fr, ks, fq);
            f32x4 acc[2][4];
#pragma unroll
            for (int a2 = 0; a2 < 2; ++a2)
#pragma unroll
                for (int ss = 0; ss < 4; ++ss) { acc[a2][ss] = (f32x4){0.f, 0.f, 0.f, 0.f};
                    if (ss <= tt0 + a2) {
#pragma unroll
                        for (int ks = 0; ks < 2; ++ks) acc[a2][ss] = __builtin_amdgcn_mfma_f32_16x16x32_bf16(Af[a2][ks], Bf[ss][ks], acc[a2][ss], 0, 0, 0); } }
#pragma unroll
            for (int a2 = 0; a2 < 2; ++a2)
#pragma unroll
                for (int ss = 0; ss < 4; ++ss) { const int tt = tt0 + a2, sc = 16 * ss + fr;
#pragma unroll
                    for (int r = 0; r < 4; ++r) { const int t = 16 * tt + 4 * fq + r; const bool keep = (mt < 2) ? (sc < t) : (sc <= t); const float val = keep ? acc[a2][ss][r] : 0.f;
                        if (mt == 0) MB[t * 64 + sc] = val; else wput(L, slotO, t, sc, val); } }
        }
        LDS_BARRIER();
        { const int t = F.tid >> 3, s0 = (F.tid & 7) * 8; const f32x4 a0 = *(const LAS f32x4*)(MB + t * 64 + s0), a1 = *(const LAS f32x4*)(MB + t * 64 + s0 + 4);
          u32x4 w; w.x = cvt_pk_bf16(a0.x, a0.y); w.y = cvt_pk_bf16(a0.z, a0.w); w.z = cvt_pk_bf16(a1.x, a1.y); w.w = cvt_pk_bf16(a1.z, a1.w);
          *(LAS u32x4*)(L + SL_BH * W_SLOT + t * WRS + s0 * 2) = w; }
#pragma unroll
        for (int k2 = 0; k2 < 2; ++k2) {
            const int tile = wave * 2 + k2, tt = tile >> 2, it = tile & 3;
            f32x4 acc = (f32x4){0.f, 0.f, 0.f, 0.f};
#pragma unroll
            for (int ks = 0; ks < 2; ++ks) acc = __builtin_amdgcn_mfma_f32_16x16x32_bf16(wfrag(L, SL_MK, 16 * tt + fr, ks, fq), wfrag(L, SL_VT, 16 * it + fr, ks, fq), acc, 0, 0, 0);
#pragma unroll
            for (int r = 0; r < 4; ++r) CL[(16 * tt + 4 * fq + r) * 64 + 16 * it + fr] = acc[r];
        }
        if (wave >= 4) {
            const int I = wave - 4;
            float d[16], xb[16];
#pragma unroll
            for (int r = 0; r < 16; ++r) d[r] = (r == lane) ? 1.f : 0.f;
            const LAS float* mbv = MB; asm volatile("" : "+v"(mbv));
            const LAS float* mb = mbv + (16 * I) * 64 + 16 * I;
            f32x4 A[8][2], Bm[8][2];
#pragma unroll
            for (int tt = 0; tt < 8; ++tt) { A[tt][0] = *(const LAS f32x4*)(mb + tt * 64); A[tt][1] = *(const LAS f32x4*)(mb + tt * 64 + 4); }
#pragma unroll
            for (int tt = 0; tt < 8; ++tt) { Bm[tt][0] = *(const LAS f32x4*)(mb + (8 + tt) * 64); Bm[tt][1] = *(const LAS f32x4*)(mb + (8 + tt) * 64 + 4); }
#pragma unroll
            for (int sx = 0; sx < 8; ++sx) { xb[sx] = d[sx];
#pragma unroll
                for (int tt = sx + 1; tt < 8; ++tt) d[tt] = fma_s(A[tt][sx >> 2][sx & 3], xb[sx], d[tt]); }
#pragma unroll
            for (int sx = 0; sx < 8; ++sx)
#pragma unroll
                for (int tt = 0; tt < 8; ++tt) d[8 + tt] = fma_s(Bm[tt][sx >> 2][sx & 3], xb[sx], d[8 + tt]);
            asm volatile("" : "+v"(d[8]), "+v"(d[15]) :: "memory");
#pragma unroll
            for (int tt = 0; tt < 8; ++tt) { A[tt][0] = *(const LAS f32x4*)(mb + (8 + tt) * 64 + 8); A[tt][1] = *(const LAS f32x4*)(mb + (8 + tt) * 64 + 12); }
#pragma unroll
            for (int sx = 0; sx < 8; ++sx) { xb[8 + sx] = d[8 + sx];
#pragma unroll
                for (int tt = sx + 1; tt < 8; ++tt) d[8 + tt] = fma_s(A[tt][sx >> 2][sx & 3], xb[8 + sx], d[8 + tt]); }
            if (lane < 16) {
#pragma unroll
                for (int t = 0; t < 16; ++t) *(LAS bf16_t*)(L + SL_KH * W_SLOT + (16 * I + t) * 48 + lane * 2) = (bf16_t)(cvt_pk_bf16(xb[t], 0.f) & 0xffffu);
            }
        }
        LDS_BARRIER();
        asm volatile("" ::: "memory");
        { const int un = u + F.G; if (un < 96 * NCH) { const int bhn = un % 96, cn = un / 96, bn = bhn / 24, headn = bhn - bn * 24, tokbn = bn * SEQ + cn * CH, c4n = headn * 64 + 4 * li;
#pragma unroll
            for (int p = 0; p < 2; ++p) prep_load(RN[p], z, LW, tokbn + p * 32 + wave * 4 + tq, c4n);
            par_load(PN, Q, c4n); } }
        for (int repx = 0; repx < REP_WX; ++repx) if (wave < 2) {
            const int slotX = wave == 0 ? SL_W1T : SL_U0T;
            LAS unsigned char* TI = L + SL_KH * W_SLOT;
            LAS unsigned char* DT = TI + 3072 + wave * 3072;
            const bf16x8 zf = (bf16x8){0, 0, 0, 0, 0, 0, 0, 0};
#pragma unroll
            for (int I = 0; I < 4; ++I) {
                f32x4 acc[4];
                if (wave == 0) {
#pragma unroll
                    for (int ct = 0; ct < 4; ++ct)
#pragma unroll
                        for (int r = 0; r < 4; ++r) acc[ct][r] = bf2f(*(const LAS bf16_t*)(L + SL_NT * W_SLOT + (16 * I + 4 * fq + r) * WRS + (16 * ct + fr) * 2));
                } else {
#pragma unroll
                    for (int ct = 0; ct < 4; ++ct)
#pragma unroll
                        for (int r = 0; r < 4; ++r) acc[ct][r] = CL[(16 * I + 4 * fq + r) * 64 + 16 * ct + fr];
                }
                if (I > 0) {
#pragma unroll
                    for (int ks = 0; ks < (I + 1) / 2; ++ks) {
                        const bool half = (32 * ks + 16 == 16 * I);
                        bf16x8 af = wfrag(L, SL_BH, 16 * I + fr, ks, fq);
                        if (half && fq >= 2) af = zf;
#pragma unroll
                        for (int ct = 0; ct < 4; ++ct) { bf16x8 bfr = wfrag(L, slotX, 16 * ct + fr, ks, fq);
                            if (half && fq >= 2) bfr = zf;
                            acc[ct] = __builtin_amdgcn_mfma_f32_16x16x32_bf16(af, bfr, acc[ct], 0, 0, 0); }
                    }
                }
#pragma unroll
                for (int ct = 0; ct < 4; ++ct) { u32x2 w; w.x = cvt_pk_bf16(acc[ct][0], acc[ct][1]); w.y = cvt_pk_bf16(acc[ct][2], acc[ct][3]); *(LAS u32x2*)(DT + (16 * ct + fr) * 48 + 8 * fq) = w; }
                LDS_WAIT();
                bf16x8 af = *(const LAS bf16x8*)(TI + (16 * I + fr) * 48 + (fq & 1) * 16); if (fq >= 2) af = zf;
#pragma unroll
                for (int ct = 0; ct < 4; ++ct) { bf16x8 bfr = *(const LAS bf16x8*)(DT + (16 * ct + fr) * 48 + (fq & 1) * 16); if (fq >= 2) bfr = zf;
                    const f32x4 x = __builtin_amdgcn_mfma_f32_16x16x32_bf16(af, bfr, (f32x4){0.f, 0.f, 0.f, 0.f}, 0, 0, 0);
                    u32x2 w; w.x = cvt_pk_bf16(x[0], x[1]); w.y = cvt_pk_bf16(x[2], x[3]); *(LAS u32x2*)(L + slotX * W_SLOT + (16 * ct + fr) * WRS + (16 * I + 4 * fq) * 2) = w; }
                LDS_WAIT();
            }
        }
        LDS_BARRIER();
        for (int repo = 0; repo < REP_WO; ++repo) {
            const int kind = wave >> 1, ta0 = (wave & 1) * 2;
            float* gp = gh_ptr(wsl, bh, c, 0); float* hp = gh_ptr(wsl, bh, c, 1);
            bf16_t* qy = (bf16_t*)(wsl + WS_QY) + (size_t)u * 4096; float* y0t = (float*)(wsl + WS_Y0T) + (size_t)u * 4096;
            const int sA1 = kind == 0 ? SL_W1T : kind == 1 ? SL_BHT : kind == 2 ? SL_W1T : SL_NK, sB1 = kind == 0 ? SL_BHT : kind == 1 ? SL_U0T : kind == 2 ? SL_NB : SL_VT;
            const int sA2 = kind == 1 ? SL_KHT : SL_NB, sB2 = kind == 1 ? SL_VT : SL_U0T; const bool two = (kind & 1) != 0;
            bf16x8 Af[2][2], Bf[4][2];
#pragma unroll
            for (int a2 = 0; a2 < 2; ++a2)
#pragma unroll
                for (int ks = 0; ks < 2; ++ks) Af[a2][ks] = wfrag(L, sA1, 16 * (ta0 + a2) + fr, ks, fq);
#pragma unroll
            for (int tb = 0; tb < 4; ++tb)
#pragma unroll
                for (int ks = 0; ks < 2; ++ks) Bf[tb][ks] = wfrag(L, sB1, 16 * tb + fr, ks, fq);
            f32x4 acc[2][4];
#pragma unroll
            for (int a2 = 0; a2 < 2; ++a2)
#pragma unroll
                for (int tb = 0; tb < 4; ++tb) { acc[a2][tb] = (f32x4){0.f, 0.f, 0.f, 0.f};
#pragma unroll
                    for (int ks = 0; ks < 2; ++ks) acc[a2][tb] = __builtin_amdgcn_mfma_f32_16x16x32_bf16(Af[a2][ks], Bf[tb][ks], acc[a2][tb], 0, 0, 0); }
            if (two) {
#pragma unroll
                for (int a2 = 0; a2 < 2; ++a2)
#pragma unroll
                    for (int ks = 0; ks < 2; ++ks) Af[a2][ks] = wfrag(L, sA2, 16 * (ta0 + a2) + fr, ks, fq);
#pragma unroll
                for (int tb = 0; tb < 4; ++tb)
#pragma unroll
                    for (int ks = 0; ks < 2; ++ks) Bf[tb][ks] = wfrag(L, sB2, 16 * tb + fr, ks, fq);
#pragma unroll
                for (int a2 = 0; a2 < 2; ++a2)
#pragma unroll
                    for (int tb = 0; tb < 4; ++tb)
#pragma unroll
                        for (int ks = 0; ks < 2; ++ks) acc[a2][tb] = __builtin_amdgcn_mfma_f32_16x16x32_bf16(Af[a2][ks], Bf[tb][ks], acc[a2][tb], 0, 0, 0);
            }
#pragma unroll
            for (int a2 = 0; a2 < 2; ++a2)
#pragma unroll
                for (int tb = 0; tb < 4; ++tb) { const int ta = ta0 + a2; const f32x4 av = acc[a2][tb];
                    if (kind == 0) {
                        const int j = 16 * tb + fr; const float pl = PL[j];
                        f32x4 o;
#pragma unroll
                        for (int r = 0; r < 4; ++r) o[r] = pl * (av[r] + ((16 * ta + 4 * fq + r) == j ? 1.f : 0.f));
                        u32x2 w; w.x = cvt_pk_bf16(o[0], o[1]); w.y = cvt_pk_bf16(o[2], o[3]);
                        *(GAS u32x2*)((bf16_t*)gp + j * 64 + 16 * ta + 4 * fq) = w;
                    } else if (kind == 1) {
                        const f32x4 pl = *(const LAS f32x4*)(PL + 16 * ta + 4 * fq);
                        *(GAS f32x4*)(hp + (16 * tb + fr) * 64 + 16 * ta + 4 * fq) = pl * av;
                    } else if (kind == 2) {
                        const int t = 16 * tb + fr; const u32x2 rr = *(const LAS u32x2*)(L + SL_RT * W_SLOT + t * WRS + (16 * ta + 4 * fq) * 2);
                        u32x2 w; w.x = cvt_pk_bf16(av[0] + bflo(rr.x), av[1] + bfhi(rr.x)); w.y = cvt_pk_bf16(av[2] + bflo(rr.y), av[3] + bfhi(rr.y));
                        *(GAS u32x2*)(qy + t * 64 + 16 * ta + 4 * fq) = w;
                    } else {
                        *(GAS f32x4*)(y0t + (16 * tb + fr) * 64 + 16 * ta + 4 * fq) = av;
                    }
                }
        }
    }
    LDS_BARRIER();
}
DI void scan_w2(const Ctx& F, const RwPar& Q) {
    unsigned char* const wsl = F.ws; const int lane = F.lane, fr = lane & 15, fq = lane >> 4;
    LAS float* yb = (LAS float*)(F.lds + F.wave * 16384);
    const bf16_t* gate = (const bf16_t*)(wsl + WS_GATE); const bf16_t* Eb = (const bf16_t*)(wsl + WS_E); bf16_t* cat = (bf16_t*)(wsl + WS_CAT);
    for (int u = F.gw; u < 96 * NCH; u += F.ngw) {
        const int bh = u % 96, c = u / 96, b = bh / 24, head = bh - b * 24, tokb = b * SEQ + c * CH;
        const bf16_t* qy = (const bf16_t*)(wsl + WS_QY) + (size_t)u * 4096; const float* y0t = (const float*)(wsl + WS_Y0T) + (size_t)u * 4096;
        f32x4 acc[4][4];
#pragma unroll
        for (int tt = 0; tt < 4; ++tt)
#pragma unroll
            for (int it = 0; it < 4; ++it) acc[tt][it] = *(const GAS f32x4*)(y0t + (16 * it + fr) * 64 + 16 * tt + 4 * fq);
        if (c > 0) {
            const bf16_t* sp = (const bf16_t*)gh_ptr(wsl, bh, c - 1, 0) + 4096;
            bf16x8 Bf[4][2];
#pragma unroll
            for (int it = 0; it < 4; ++it)
#pragma unroll
                for (int ks = 0; ks < 2; ++ks) Bf[it][ks] = *(const GAS bf16x8*)(sp + (16 * it + fr) * 64 + 32 * ks + 8 * fq);
#pragma unroll
            for (int tt = 0; tt < 4; ++tt)
#pragma unroll
                for (int ks = 0; ks < 2; ++ks) { const bf16x8 Af = *(const GAS bf16x8*)(qy + (16 * tt + fr) * 64 + 32 * ks + 8 * fq);
#pragma unroll
                    for (int it = 0; it < 4; ++it) acc[tt][it] = __builtin_amdgcn_mfma_f32_16x16x32_bf16(Af, Bf[it][ks], acc[tt][it], 0, 0, 0); }
        }
#pragma unroll
        for (int tt = 0; tt < 4; ++tt)
#pragma unroll
            for (int it = 0; it < 4; ++it)
#pragma unroll
                for (int r = 0; r < 4; ++r) yb[(16 * tt + 4 * fq + r) * 64 + 16 * it + fr] = acc[tt][it][r];
        LDS_WAIT();
#pragma unroll 4
        for (int k = 0; k < 16; ++k) {
            const int slot = k * 64 + lane, t = slot >> 4, li = slot & 15, c4 = head * 64 + 4 * li, tok = tokb + t;
            const f32x4 y = *(const LAS f32x4*)(yb + t * 64 + 4 * li);
            const u32x2 ev = *(const GAS u32x2*)(Eb + (size_t)tok * CMIX + c4), gt = *(const GAS u32x2*)(gate + (size_t)tok * CMIX + c4);
            const float mean = sum16(y.x + y.y + y.z + y.w) * (1.f / 64.f);
            const f32x4 d = y - mean;
            const float var = sum16(d.x * d.x + d.y * d.y + d.z * d.z + d.w * d.w) * (1.f / 64.f);
            const float rstd = rsqrtf(var + GN_EPS);
            const f32x4 g4 = *(const GAS f32x4*)(Q.gng + c4), b4 = *(const GAS f32x4*)(Q.gnb + c4);
            f32x4 o = d * rstd * g4 + b4; o.x += bflo(ev.x); o.y += bfhi(ev.x); o.z += bflo(ev.y); o.w += bfhi(ev.y);
            u32x2 w; w.x = cvt_pk_bf16(o.x * bflo(gt.x), o.y * bfhi(gt.x)); w.y = cvt_pk_bf16(o.z * bflo(gt.y), o.w * bfhi(gt.y));
            *(GAS u32x2*)(cat + (size_t)tok * DM + c4) = w;
        }
        LDS_WAIT();
    }
}
DI void scan_passB(const Ctx& F) {
    unsigned char* const wsl = F.ws; const int lane = F.lane, fr = lane & 15, fq = lane >> 4, hsel = F.wave >> 2, q = F.wave & 3, bh = F.bid * 2 + hsel;
    LAS unsigned char* Sx0 = F.lds + hsel * 2 * W_SLOT;
    bf16x8 ga[7][2]; f32x4 hq[7][4];
#define PB_LOAD(set, cc) do { const GAS bf16_t* _gp = (const GAS bf16_t*)gh_ptr(wsl, bh, (cc), 0) + (16 * q + fr) * 64 + 8 * fq; const GAS float* _hp = (const GAS float*)(gh_ptr(wsl, bh, (cc), 1) + fr * 64 + 16 * q + 4 * fq); \
        ga[set][0] = *(const GAS bf16x8*)_gp; ga[set][1] = *(const GAS bf16x8*)(_gp + 32); \
        _Pragma("unroll") for (int _r = 0; _r < 4; ++_r) hq[set][_r] = *(const GAS f32x4*)(_hp + (16 * _r) * 64); } while (0)
    PB_LOAD(0, 0); PB_LOAD(1, 1); PB_LOAD(2, 2); PB_LOAD(3, 3); PB_LOAD(4, 4); PB_LOAD(5, 5);
    for (int c7 = 0; c7 < NCH - 1; c7 += 7) {
#pragma unroll
        for (int u7 = 0; u7 < 7; ++u7) {
            const int c = c7 + u7;
            f32x4 acc[4];
#pragma unroll
            for (int it = 0; it < 4; ++it) acc[it] = hq[u7][it];
            const bf16x8 a0 = ga[u7][0], a1 = ga[u7][1];
            PB_LOAD((u7 + 6) % 7, (c + 6 < NCH - 1) ? c + 6 : NCH - 2);
            if (c > 0) {
#pragma unroll
                for (int it = 0; it < 4; ++it) {
                    acc[it] = __builtin_amdgcn_mfma_f32_16x16x32_bf16(a0, *(const LAS bf16x8*)(Sx0 + (c & 1) * W_SLOT + (16 * it + fr) * WRS + fq * 16), acc[it], 0, 0, 0);
                    acc[it] = __builtin_amdgcn_mfma_f32_16x16x32_bf16(a1, *(const LAS bf16x8*)(Sx0 + (c & 1) * W_SLOT + (16 * it + fr) * WRS + 64 + fq * 16), acc[it], 0, 0, 0); }
            }
            GAS bf16_t* op = (GAS bf16_t*)gh_ptr(wsl, bh, c, 0) + 4096 + fr * 64 + 16 * q + 4 * fq;
#pragma unroll
            for (int it = 0; it < 4; ++it) { u32x2 w; w.x = cvt_pk_bf16(acc[it].x, acc[it].y); w.y = cvt_pk_bf16(acc[it].z, acc[it].w);
                *(GAS u32x2*)(op + (16 * it) * 64) = w; *(LAS u32x2*)(Sx0 + ((c + 1) & 1) * W_SLOT + (16 * it + fr) * WRS + (16 * q + 4 * fq) * 2) = w; }
            LDS_BARRIER();
        }
    }
#undef PB_LOAD
}

DI void ln1_router(const Ctx& F, const Params& P, int l, const float* xin) {
    unsigned char* const wsl = F.ws; float* const outl = F.out; (void)outl;
    const float* g = PIN(5) + (size_t)l * DM; const float* bta = PIN(6) + (size_t)l * DM;
    const float* gb = PIN(10) + l * 4; const float* eb = PIN(12) + l * 32;
    const bf16_t* hb = (const bf16_t*)(wsl + WS_HB); bf16_t* xb = (bf16_t*)(wsl + WS_XB); float* xo = outl;
    const bf16_t* wrt = (const bf16_t*)(wsl + WS_WSW + (size_t)l * WSW_STRIDE);
    unsigned* cnt = (unsigned*)(wsl + WS_CTL) + CW_CNT + l * 32 * 64;
    int* ltok = (int*)(wsl + WS_LTOK); float* lgate = (float*)(wsl + WS_LGATE); int* lslot = (int*)(wsl + WS_LSLOT);
    const int lane = F.lane, fr = lane & 15, fq = lane >> 4, wave = F.wave;
    LAS float* lg = (LAS float*)(F.lds + (wave & 3) * 4096);
    LAS float* lgp = (LAS float*)(F.lds + 16384 + (wave & 3) * 4096);
    LAS int* cntl = (LAS int*)(F.lds + 32768); LAS int* basel = cntl + 32;
    if (F.tid < NEXP) cntl[F.tid] = 0;
    __syncthreads();
    for (int blk = F.bid; blk < NTOK / 64; blk += F.G) {
#pragma unroll 1
        for (int pass = 0; pass < 4; ++pass) {
            int lno = lane; asm volatile("" : "+v"(lno));
            const int hr2 = lno >> 5, l32 = lno & 31;
            const size_t ro = (size_t)(blk * 64 + wave * 8 + pass * 2 + hr2) * DM + 8 * l32;
            u32x4 xr[8], hr[8];
#pragma unroll
            for (int i = 0; i < 8; ++i) { xr[i] = *(const GAS u32x4*)(xb + ro + 256 * i); hr[i] = *(const GAS u32x4*)(hb + ro + 256 * i); }
            float s = 0.f, s2 = 0.f;
#pragma unroll
            for (int i = 0; i < 8; ++i) {
#pragma unroll
                for (int e = 0; e < 4; ++e) { const float v0 = ALPHA * bflo(xr[i][e]) + bflo(hr[i][e]), v1 = ALPHA * bfhi(xr[i][e]) + bfhi(hr[i][e]); s += v0 + v1; s2 += v0 * v0 + v1 * v1; } }
            s = sum16(s); s2 = sum16(s2); s += __shfl_xor(s, 16); s2 += __shfl_xor(s2, 16);
            const float mean = s * (1.f / DM), rstd = rsqrtf(fmaxf(s2 * (1.f / DM) - mean * mean, 0.f) + LN_EPS);
#pragma unroll
            for (int i = 0; i < 8; ++i) { const int col = 256 * i + 8 * l32;
                const f32x4 g0 = *(const GAS f32x4*)(g + col), g1 = *(const GAS f32x4*)(g + col + 4), b0 = *(const GAS f32x4*)(bta + col), b1 = *(const GAS f32x4*)(bta + col + 4);
                u32x4 w;
#pragma unroll
                for (int e = 0; e < 4; ++e) { const float v0 = ALPHA * bflo(xr[i][e]) + bflo(hr[i][e]), v1 = ALPHA * bfhi(xr[i][e]) + bfhi(hr[i][e]);
                    const float gg0 = e < 2 ? g0[2 * e] : g1[2 * e - 4], gg1 = e < 2 ? g0[2 * e + 1] : g1[2 * e - 3], bb0 = e < 2 ? b0[2 * e] : b1[2 * e - 4], bb1 = e < 2 ? b0[2 * e + 1] : b1[2 * e - 3];
                    w[e] = cvt_pk_bf16((v0 - mean) * rstd * gg0 + bb0, (v1 - mean) * rstd * gg1 + bb1); }
                *(GAS u32x4*)(xb + ro + 256 * i) = w;
                asm volatile("" ::: "memory"); }
        }
        VM_WAIT();
        __syncthreads();
        __builtin_amdgcn_fence(__ATOMIC_ACQUIRE, "agent");
        VM_WAIT();
        const int row0 = blk * 64 + (wave & 3) * 16, kh = wave >> 2, krot = (F.bid * 5 + wave * 3) & 31;
        f32x4 acc[3];
#pragma unroll
        for (int ct = 0; ct < 3; ++ct) acc[ct] = (f32x4){0.f, 0.f, 0.f, 0.f};
        const bf16_t* arow = xb + (size_t)(row0 + fr) * DM + 8 * fq + kh * 1024;
        LAS unsigned char* wst = F.lds + 36864;
        u32x4 wreg[6];
        { const int st = F.bid & 7;
#pragma unroll
          for (int i = 0; i < 6; ++i) { const int ch = F.tid + NT * i, row = ch >> 4, c16 = ch & 15, rkh = row / 96, rr = row - rkh * 96;
              wreg[i] = *(const GAS u32x4*)(wrt + (size_t)rr * DM + rkh * 1024 + st * 128 + c16 * 8); } }
#pragma unroll 1
        for (int si = 0; si < 8; ++si) {
            const int st = (si + F.bid) & 7;
            LAS unsigned char* wb = wst + (si & 1) * 52224;
#pragma unroll
            for (int i = 0; i < 6; ++i) { const int ch = F.tid + NT * i, row = ch >> 4, c16 = ch & 15; *(LAS u32x4*)(wb + row * 272 + c16 * 16) = wreg[i]; }
            if (si + 1 < 8) { const int stn = (si + 1 + F.bid) & 7;
#pragma unroll
                for (int i = 0; i < 6; ++i) { const int ch = F.tid + NT * i, row = ch >> 4, c16 = ch & 15, rkh = row / 96, rr = row - rkh * 96;
                    wreg[i] = *(const GAS u32x4*)(wrt + (size_t)rr * DM + rkh * 1024 + stn * 128 + c16 * 8); } }
            bf16x8 af[4];
#pragma unroll
            for (int ksl = 0; ksl < 4; ++ksl) af[ksl] = *(const GAS bf16x8*)(arow + st * 128 + ksl * 32);
            LDS_BARRIER();
#pragma unroll
            for (int ksl = 0; ksl < 4; ++ksl)
#pragma unroll
                for (int ct = 0; ct < 3; ++ct) {
                    acc[ct] = __builtin_amdgcn_mfma_f32_16x16x32_bf16(af[ksl], *(const LAS bf16x8*)(wb + (kh * 96 + 16 * ct + fr) * 272 + ksl * 64 + fq * 16), acc[ct], 0, 0, 0);
                    acc[ct] = __builtin_amdgcn_mfma_f32_16x16x32_bf16(af[ksl], *(const LAS bf16x8*)(wb + (kh * 96 + 48 + 16 * ct + fr) * 272 + ksl * 64 + fq * 16), acc[ct], 0, 0, 0);
                }
        }
        if (kh == 1) {
#pragma unroll
            for (int ct = 0; ct < 3; ++ct)
#pragma unroll
                for (int jj = 0; jj < 4; ++jj) lgp[(4 * fq + jj) * 48 + 16 * ct + fr] = acc[ct][jj];
        }
        __syncthreads();
        if (kh == 0) {
#pragma unroll
            for (int ct = 0; ct < 3; ++ct)
#pragma unroll
                for (int jj = 0; jj < 4; ++jj) lg[(4 * fq + jj) * 48 + 16 * ct + fr] = acc[ct][jj] + lgp[(4 * fq + jj) * 48 + 16 * ct + fr];
        }
        LDS_WAIT();
        int se0 = 0, se1 = 0, sr0 = 0, sr1 = 0, stok = 0; float sg0 = 0.f, sg1 = 0.f;
        if (kh == 0 && lane < 16) {
            const LAS float* L = lg + lane * 48; const int tok = row0 + lane;
            float gl[4]; int grp_i = 0; float gmx;
#pragma unroll
            for (int q = 0; q < 4; ++q) gl[q] = L[q] + gb[q];
            gmx = gl[0];
#pragma unroll
            for (int q = 1; q < 4; ++q) if (gl[q] > gmx) { gmx = gl[q]; grp_i = q; }
            float gs = 0.f;
#pragma unroll
            for (int q = 0; q < 4; ++q) gs += __expf(gl[q] - gmx);
            const float pg = 1.f / gs;
            float el[8];
#pragma unroll
            for (int q = 0; q < 8; ++q) el[q] = L[4 + 8 * grp_i + q] + eb[8 * grp_i + q];
            int i0 = 0; float m0 = el[0];
#pragma unroll
            for (int q = 1; q < 8; ++q) if (el[q] > m0) { m0 = el[q]; i0 = q; }
            int i1 = -1; float m1 = -3.0e38f;
#pragma unroll
            for (int q = 0; q < 8; ++q) if (q != i0 && el[q] > m1) { m1 = el[q]; i1 = q; }
            if (i1 < 0) { i1 = (i0 == 0) ? 1 : 0; m1 = m0; }
            const float p1 = __expf(m1 - m0), den = 1.f / (1.f + p1);
            const float g0 = pg * den, g1 = pg * p1 * den;
            se0 = grp_i * 8 + i0; se1 = grp_i * 8 + i1; sg0 = g0; sg1 = g1; stok = tok;
            sr0 = __hip_atomic_fetch_add(cntl + se0, 1, __ATOMIC_RELAXED, __HIP_MEMORY_SCOPE_WORKGROUP);
            sr1 = __hip_atomic_fetch_add(cntl + se1, 1, __ATOMIC_RELAXED, __HIP_MEMORY_SCOPE_WORKGROUP);
        }
        __syncthreads();
        if (wave == 0 && lane < NEXP) { const int n = cntl[lane]; basel[lane] = n ? (int)__hip_atomic_fetch_add(cnt + lane * 64, (unsigned)n, __ATOMIC_RELAXED, __HIP_MEMORY_SCOPE_AGENT) : 0; }
        __syncthreads();
        if (kh == 0 && lane < 16) {
            const int pos0 = basel[se0] + sr0, pos1 = basel[se1] + sr1;
            ltok[se0 * LISTCAP + pos0] = stok; lgate[se0 * LISTCAP + pos0] = sg0; lslot[se0 * LISTCAP + pos0] = 2 * stok;
            ltok[se1 * LISTCAP + pos1] = stok; lgate[se1 * LISTCAP + pos1] = sg1; lslot[se1 * LISTCAP + pos1] = 2 * stok + 1;
        }
        __syncthreads();
        if (F.tid < NEXP) cntl[F.tid] = 0;
        __syncthreads();
    }
}

DI void ln2_phase(const Ctx& F, const Params& P, int l) {
    unsigned char* const wsl = F.ws; float* const outl = F.out;
    const float* g = PIN(7) + (size_t)l * DM; const float* bta = PIN(8) + (size_t)l * DM;
    const bf16_t* ys = (const bf16_t*)(wsl + WS_YS); bf16_t* xb = (bf16_t*)(wsl + WS_XB); float* xo = outl;
#pragma unroll 1
    for (int rp = F.gw; rp < NTOK / 2; rp += F.ngw) {
        int lno = F.lane; asm volatile("" : "+v"(lno));
        const int hr2 = lno >> 5, l32 = lno & 31, row = 2 * rp + hr2;
        const size_t ro = (size_t)row * DM + 8 * l32;
        u32x4 xr[8], y0[8], y1[8];
#pragma unroll
        for (int i = 0; i < 8; ++i) { xr[i] = *(const GAS u32x4*)(xb + ro + 256 * i); y0[i] = *(const GAS u32x4*)(ys + 2 * (size_t)row * DM + 8 * l32 + 256 * i); y1[i] = *(const GAS u32x4*)(ys + (2 * (size_t)row + 1) * DM + 8 * l32 + 256 * i); }
        float s = 0.f, s2 = 0.f;
#pragma unroll
        for (int i = 0; i < 8; ++i) {
#pragma unroll
            for (int e = 0; e < 4; ++e) { const float v0 = ALPHA * bflo(xr[i][e]) + (bflo(y0[i][e]) + bflo(y1[i][e])), v1 = ALPHA * bfhi(xr[i][e]) + (bfhi(y0[i][e]) + bfhi(y1[i][e])); s += v0 + v1; s2 += v0 * v0 + v1 * v1; } }
        s = sum16(s); s2 = sum16(s2); s += __shfl_xor(s, 16); s2 += __shfl_xor(s2, 16);
        const float mean = s * (1.f / DM), rstd = rsqrtf(fmaxf(s2 * (1.f / DM) - mean * mean, 0.f) + LN_EPS);
#pragma unroll
        for (int i = 0; i < 8; ++i) { const int col = 256 * i + 8 * l32;
            const f32x4 g0 = *(const GAS f32x4*)(g + col), g1 = *(const GAS f32x4*)(g + col + 4), b0 = *(const GAS f32x4*)(bta + col), b1 = *(const GAS f32x4*)(bta + col + 4);
            float o[8];
#pragma unroll
            for (int e = 0; e < 4; ++e) { const float v0 = ALPHA * bflo(xr[i][e]) + (bflo(y0[i][e]) + bflo(y1[i][e])), v1 = ALPHA * bfhi(xr[i][e]) + (bfhi(y0[i][e]) + bfhi(y1[i][e]));
                const float gg0 = e < 2 ? g0[2 * e] : g1[2 * e - 4], gg1 = e < 2 ? g0[2 * e + 1] : g1[2 * e - 3], bb0 = e < 2 ? b0[2 * e] : b1[2 * e - 4], bb1 = e < 2 ? b0[2 * e + 1] : b1[2 * e - 3];
                o[2 * e] = (v0 - mean) * rstd * gg0 + bb0; o[2 * e + 1] = (v1 - mean) * rstd * gg1 + bb1; }
            if (l == NLAYER - 1) { *(GAS f32x4*)(xo + (size_t)row * DM + col) = (f32x4){o[0], o[1], o[2], o[3]}; *(GAS f32x4*)(xo + (size_t)row * DM + col + 4) = (f32x4){o[4], o[5], o[6], o[7]}; }
            else { u32x4 w; w.x = cvt_pk_bf16(o[0], o[1]); w.y = cvt_pk_bf16(o[2], o[3]); w.z = cvt_pk_bf16(o[4], o[5]); w.w = cvt_pk_bf16(o[6], o[7]); *(GAS u32x4*)(xb + ro + 256 * i) = w; }
            asm volatile("" ::: "memory"); }
    }
}

DI int moe_table(const Ctx& F, int l) {
    unsigned char* const wsl = F.ws; float* const outl = F.out; (void)outl;
    LAS int* tb = (LAS int*)(F.lds + LDS_CTL_OFF) + 16;
    const unsigned* cnt = (const unsigned*)(wsl + WS_CTL) + CW_CNT + l * 32 * 64;
    __syncthreads();
    if (F.tid == 0) { int acc = 0;
        for (int e = 0; e < NEXP; ++e) { tb[e] = acc; const int n = (int)__hip_atomic_load(cnt + e * 64, __ATOMIC_RELAXED, __HIP_MEMORY_SCOPE_AGENT); acc += (n + 255) >> 8; }
        tb[NEXP] = acc; }
    __syncthreads();
    return tb[NEXP];
}


#ifdef MK_DEBUG
constexpr int CW_DBG = 40960;
DI void dbg_count_bf16(const Ctx& F, const bf16_t* p, size_t n, int k) {
    unsigned bad = 0; const size_t gt = (size_t)F.bid * NT + F.tid, ngt = (size_t)F.G * NT;
    for (size_t i = gt; i < n; i += ngt) { const unsigned b = p[i]; const float v = bf2f(b); if ((b & 0x7f80u) == 0x7f80u || fabsf(v) > 1.0e6f) ++bad; }
    if (bad) atomicAdd((unsigned*)(F.ws + WS_CTL) + CW_DBG + k * 64, bad);
}
DI void dbg_count_f32(const Ctx& F, const float* p, size_t n, int k) {
    unsigned bad = 0; const size_t gt = (size_t)F.bid * NT + F.tid, ngt = (size_t)F.G * NT;
    for (size_t i = gt; i < n; i += ngt) { const float v = p[i]; if (!(fabsf(v) <= 1.0e6f)) ++bad; }
    if (bad) atomicAdd((unsigned*)(F.ws + WS_CTL) + CW_DBG + k * 64, bad);
}
#endif
constexpr int PH_PER_LAYER = 11, N_PHASES = 1 + NLAYER * PH_PER_LAYER;

__global__ void __launch_bounds__(NT, 2) mega_fwd(Params P) {
    extern __shared__ __attribute__((aligned(16))) unsigned char lds_raw[];
    Ctx F0;
    F0.lds = (LAS unsigned char*)lds_raw;
    F0.tid = threadIdx.x; F0.lane = F0.tid & 63; F0.wave = __builtin_amdgcn_readfirstlane(F0.tid >> 6);
    F0.G = gridDim.x; F0.bid = blockIdx.x; F0.gw = F0.bid * NWAVES + F0.wave; F0.ngw = F0.G * NWAVES;
    F0.ws = P.ws; F0.out = P.out;
    for (int u = F0.tid; u < (LDS_BYTES - LDS_CTL_OFF) / 4; u += NT) ((LAS unsigned*)(F0.lds + LDS_CTL_OFF))[u] = 0u;
    __syncthreads();
    XcdBarrier bar; bar.bar = (unsigned*)(F0.ws + WS_CTL) + CW_BAR; bar.x = 0; bar.st = nullptr;
#if !MK_PER_PHASE
    bar = xcd_barrier_post((unsigned*)(F0.ws + WS_CTL) + CW_BAR, (volatile LAS unsigned*)(F0.lds + LDS_CTL_OFF));
#endif
    const int lo = P.ph_lo, hi = P.ph_hi;
#define IN(k) (lo <= (k) && (k) < hi)
#if MK_PER_PHASE
#define SEAM(k) do { } while (0)
#else
#define SEAM(k) do { if ((k) + 1 < hi) { XcdBarrier _b = bar; asm volatile("" : "+s"(_b.bar), "+s"(_b.x)); xcd_barrier(_b); } } while (0)
#endif
#define WSL const Ctx F = relaunder(F0); unsigned char* const ws = F.ws; bf16_t* const xb = (bf16_t*)(ws + WS_XB); bf16_t* const zb = (bf16_t*)(ws + WS_Z); bf16_t* const cat = (bf16_t*)(ws + WS_CAT); (void)xb; (void)zb; (void)cat

    if (IN(0)) { WSL; phase_prologue(F, P); SEAM(0); }

    for (int l = 0; l < NLAYER; ++l) {
        const int kind = l % 3, j = l / 3, pb = 1 + l * PH_PER_LAYER;
        const int zw = (kind == 0) ? ZW_RWKV : ZW_OTH, qcol = (kind == 0) ? 5056 : 4608;
        if (IN(pb + 0)) {
            WSL; const bf16_t* winT = (const bf16_t*)(ws + WS_WIN + (size_t)l * WIN_STRIDE);
            if (kind != 2) dense_gemm(F, xb, DM, winT, DM, NTOK, zw, DM, zb, zw, 0);
            else {
                dense_gemm(F, xb, DM, winT, DM, NTOK, 3072, DM, zb, zw, 0);
                dense_gemm(F, xb, DM, winT + (size_t)4608 * DM, DM, NTOK, 512, DM, zb + 4608, zw, 0);
                dense_gemm(F, winT + (size_t)3072 * DM, DM, xb, DM, CMIX, NTOK, DM, (bf16_t*)(ws + WS_ACT), NTOK, 128);
            }
            if (l == 0) {
                dense_gemm(F, (const bf16_t*)(ws + WS_MEMB), DM, (const bf16_t*)(ws + WS_WK), DM, NBATCH * MEML, 2048, DM, (bf16_t*)(ws + WS_KM), 2048, 128);
                dense_gemm(F, (const bf16_t*)(ws + WS_WV), DM, (const bf16_t*)(ws + WS_MEMB), DM, 2048, NBATCH * MEML, DM, (bf16_t*)(ws + WS_VMT), 1024, 192);
            }
            SEAM(pb + 0);
        }
        if (IN(pb + 1)) {
            WSL;
            if (kind == 0) { for (int rep = 0; rep < REP_PREP; ++rep) rwkv_prep1(F, P, j, zb); for (int rep = 0; rep < REP_MIX * REP_MA; ++rep) memattn_all(F, l, zb, zw, qcol); }
            else if (kind == 1) { for (int rep = 0; rep < REP_MIX; ++rep) conv_mix(F, P, zb); for (int rep = 0; rep < REP_MIX * REP_MA; ++rep) memattn_all(F, l, zb, zw, qcol); for (int rep = 0; rep < REP_CONV; ++rep) expert_convert(F, P, l, F.gw, F.ngw); }
            else { for (int rep = 0; rep < REP_MIX * REP_SB; ++rep) sb_attention(F, zb); for (int rep = 0; rep < REP_MIX * REP_MA; ++rep) memattn_all(F, l, zb, zw, qcol); for (int rep = 0; rep < REP_CONV; ++rep) expert_convert(F, P, l, F.gw, F.ngw); }
            SEAM(pb + 1);
        }
        if (kind == 0) {
            if (IN(pb + 2)) {
                WSL; const bf16_t* act = (const bf16_t*)(ws + WS_ACT); const bf16_t* wa = (const bf16_t*)(ws + WS_LORA + (size_t)j * LORA_STRIDE);
                dense_gemm(F, act, 512, wa, 256, NTOK, 3072, 256, (bf16_t*)(ws + WS_LW), 3072, 0);
                dense_gemm(F, act + 256, 512, wa + (size_t)3072 * 256, 256, NTOK, CMIX, 256, (bf16_t*)(ws + WS_GATE), CMIX, 0);
                SEAM(pb + 2);
            }
            if (IN(pb + 3)) { WSL; const RwPar Q{PIN(17) + (size_t)j * 5056, PIN(18) + j * CMIX, PIN(20) + j * CMIX, PIN(23) + j * CMIX, PIN(24) + j * CMIX, PIN(25) + j * CMIX, PIN(26) + j * CMIX, PIN(27) + j * CMIX};
                for (int rep = 0; rep < REP_SCAN; ++rep) scan_w1(F, Q, zb); SEAM(pb + 3); }
            if (IN(pb + 4)) {
                WSL;
                if (F.bid < 48) scan_passB(F);
                else expert_convert(F, P, l, (F.bid - 48) * NWAVES + F.wave, (F.G - 48) * NWAVES);
                SEAM(pb + 4);
            }
            if (IN(pb + 5)) { WSL; const RwPar Q{PIN(17) + (size_t)j * 5056, PIN(18) + j * CMIX, PIN(20) + j * CMIX, PIN(23) + j * CMIX, PIN(24) + j * CMIX, PIN(25) + j * CMIX, PIN(26) + j * CMIX, PIN(27) + j * CMIX};
                for (int rep = 0; rep < REP_SCAN * REP_W2; ++rep) scan_w2(F, Q); SEAM(pb + 5); }
        }
        if (IN(pb + 6)) { WSL; dense_gemm(F, cat, DM, (const bf16_t*)(ws + WS_WOUT) + (size_t)l * DM * DM, DM, NTOK, DM, DM, (bf16_t*)(ws + WS_HB), DM, 0); SEAM(pb + 6); }
        if (IN(pb + 7)) { WSL; ln1_router(F, P, l, l == 0 ? PIN(0) : (const float*)P.out); SEAM(pb + 7); }
        if (IN(pb + 8)) {
            WSL; const int ntiles = moe_table(F, l);
            pg8::Gemm g{xb, (const bf16_t*)(ws + WS_EXP1), DM, DM, DM};
            pg8::MoeOrder<true> S; S.G = F.G; S.c = F.bid; S.npn = 4; S.total = ntiles * 4; S.tb = (const LAS int*)(F.lds + LDS_CTL_OFF) + 16; S.estride = (size_t)1024 * DM * 2;
            S.ltok = (const int*)(ws + WS_LTOK); S.cnt = (const unsigned*)(ws + WS_CTL) + CW_CNT + l * 32 * 64;
            pg8::EpiSwiGLU E{(bf16_t*)(ws + WS_HE)};
            for (int rep = 0; rep < REP_MOE; ++rep) pg8::gemm_phase<pg8::EpiSwiGLU, pg8::MoeOrder<true>>(F.lds, g, S, E);
            SEAM(pb + 8);
        }
        if (IN(pb + 9)) {
            WSL; const int ntiles = moe_table(F, l);
            pg8::Gemm g{(const bf16_t*)(ws + WS_HE), (const bf16_t*)(ws + WS_EXP2), DEXP, DEXP, DEXP};
            pg8::MoeOrder<false> S; S.G = F.G; S.c = F.bid; S.npn = 8; S.total = ntiles * 8; S.tb = (const LAS int*)(F.lds + LDS_CTL_OFF) + 16; S.estride = (size_t)DM * DEXP * 2;
            S.ltok = (const int*)(ws + WS_LTOK); S.cnt = (const unsigned*)(ws + WS_CTL) + CW_CNT + l * 32 * 64;
            pg8::EpiScatter E{(bf16_t*)(ws + WS_YS), (const int*)(ws + WS_LSLOT), (const float*)(ws + WS_LGATE), S.cnt};
            for (int rep = 0; rep < REP_MOE; ++rep) pg8::gemm_phase<pg8::EpiScatter, pg8::MoeOrder<false>>(F.lds, g, S, E);
            SEAM(pb + 9);
        }
        if (IN(pb + 10)) { WSL; ln2_phase(F, P, l); SEAM(pb + 10); }
    }
#ifdef MK_DEBUG
    {
        WSL;
        xcd_barrier(bar);
        dbg_count_bf16(F, (const bf16_t*)(ws + WS_CAT), (size_t)NTOK * DM, 0);
        dbg_count_bf16(F, (const bf16_t*)(ws + WS_HB), (size_t)NTOK * DM, 1);
        dbg_count_f32(F, (const float*)(ws + WS_LGATE), (size_t)32 * 16384, 2);
        dbg_count_bf16(F, (const bf16_t*)(ws + WS_YS), (size_t)32768 * 2048, 3);
        dbg_count_f32(F, (const float*)F.out, (size_t)NTOK * DM, 4);
        dbg_count_bf16(F, (const bf16_t*)(ws + WS_XB), (size_t)NTOK * DM, 5);
        xcd_barrier(bar);
        int first = 13;
        for (int k = 12; k >= 0; --k) if (__hip_atomic_load((unsigned*)(ws + WS_CTL) + CW_DBG + k * 64, __ATOMIC_RELAXED, __HIP_MEMORY_SCOPE_AGENT) != 0u) first = k;
        const float val = 1000.f * (float)(first + 1);
        for (size_t i = (size_t)F.bid * NT + F.tid; i < (size_t)NTOK * DM; i += (size_t)F.G * NT) F.out[i] = val;
    }
#endif
#undef IN
#undef SEAM
}

extern "C" void kernel_launch(void* const* d_in, const int* in_sizes, int n_in, void* d_out, int out_size, void* d_ws, size_t ws_size, hipStream_t stream) {
    static int grid = 0;
    if (grid == 0) {
        if (n_in != 31 || ws_size < WS_END) { fprintf(stderr, "kernel_launch: expected 31 inputs and >= %zu bytes of workspace, got %d / %zu\n", (size_t)WS_END, n_in, ws_size); grid = -1; return; }
        int dev = 0, cus = 0, per_cu = 0;
        if (hipGetDevice(&dev) != hipSuccess || hipDeviceGetAttribute(&cus, hipDeviceAttributeMultiprocessorCount, dev) != hipSuccess) { grid = -1; return; }
        if (hipFuncSetAttribute((const void*)mega_fwd, hipFuncAttributeMaxDynamicSharedMemorySize, LDS_BYTES) != hipSuccess) { fprintf(stderr, "kernel_launch: hipFuncSetAttribute failed\n"); grid = -1; return; }
        if (hipOccupancyMaxActiveBlocksPerMultiprocessor(&per_cu, (const void*)mega_fwd, NT, LDS_BYTES) != hipSuccess || per_cu < 1)
            fprintf(stderr, "kernel_launch: occupancy query reports %d workgroups per CU\n", per_cu);
        (void)hipGetLastError();
        grid = cus;
    }
    if (grid < 0) return;
    (void)hipMemsetAsync((char*)d_ws + WS_CTL, 0, CTL_BYTES, stream);
    Params p{};
    for (int i = 0; i < 31; ++i) p.in[i] = (const float*)d_in[i];
    p.out = (float*)d_out; p.ws = (unsigned char*)d_ws;
#if MK_PER_PHASE
    for (int ph = 0; ph < N_PHASES; ++ph) {
        if (ph > 0) { const int l = (ph - 1) / PH_PER_LAYER, loc = (ph - 1) % PH_PER_LAYER; if ((l % 3) != 0 && loc >= 2 && loc <= 5) continue; }
        p.ph_lo = ph; p.ph_hi = ph + 1;
        hipLaunchKernelGGL(mega_fwd, dim3(grid), dim3(NT), LDS_BYTES, stream, p);
    }
#else
#ifndef MK_PH_HI
#define MK_PH_HI N_PHASES
#endif
    p.ph_lo = 0; p.ph_hi = MK_PH_HI;
    hipLaunchKernelGGL(mega_fwd, dim3(grid), dim3(NT), LDS_BYTES, stream, p);
#endif
    const hipError_t le = hipPeekAtLastError();
    if (le != hipSuccess) fprintf(stderr, "kernel_launch: launch failed: %s\n", hipGetErrorName(le));
}
```

```cpp
#include <hip/hip_runtime.h>
#include <cstdio>
#include <cstdint>

#ifndef MK_PER_PHASE
#define MK_PER_PHASE 0
#endif
#ifndef MK_PH_HI
#define MK_PH_HI N_PHASES
#endif
#ifndef REP_GEMM
#define REP_GEMM 1
#endif
#ifndef REP_MOE
#define REP_MOE 1
#endif
#ifndef REP_SCAN
#define REP_SCAN 1
#endif
#ifndef REP_PREP
#define REP_PREP 1
#endif
#ifndef REP_MIX
#define REP_MIX 1
#endif
#ifndef REP_CONV
#define REP_CONV 1
#endif
#ifndef REP_SB
#define REP_SB 1
#endif
#ifndef REP_MA
#define REP_MA 1
#endif
#ifndef REP_WX
#define REP_WX 1
#endif
#ifndef REP_WS
#define REP_WS 1
#endif
#ifndef REP_WO
#define REP_WO 1
#endif
#ifndef REP_W2
#define REP_W2 1
#endif

#define LAS __attribute__((address_space(3)))
#define GAS __attribute__((address_space(1)))
#define DI __device__ __forceinline__
typedef unsigned short bf16_t;
typedef short bf16x8 __attribute__((ext_vector_type(8)));
typedef short s16x4 __attribute__((ext_vector_type(4)));
typedef float f32x2 __attribute__((ext_vector_type(2)));
typedef float f32x4 __attribute__((ext_vector_type(4)));
typedef float f32x8 __attribute__((ext_vector_type(8)));
typedef float f32x16 __attribute__((ext_vector_type(16)));
typedef unsigned u32x2 __attribute__((ext_vector_type(2)));
typedef unsigned u32x4 __attribute__((ext_vector_type(4)));

constexpr int NTOK = 16384, DM = 2048, SEQ = 4096, NBATCH = 4, CMIX = 1536, MEMW = 512, MEML = 256, NLAYER = 4;
constexpr int ZW_RWKV = 5632  , ZW_OTH = 5120, RW_IN_COLS = 5568;
constexpr int NEXP = 32, DEXP = 512, LISTCAP = 16384, MAXTILES = 160;
constexpr float LN_EPS = 1e-5f, ALPHA = 1.681792830507429f, GN_EPS = 64e-5f;
constexpr int NT = 512, NWAVES = 8;

constexpr size_t MiB = (size_t)1 << 20;
constexpr size_t WS_CTL = 0, CTL_BYTES = 1 * MiB;
constexpr size_t WS_WIN = 2 * MiB;
constexpr size_t WIN_STRIDE = 22 * MiB;
constexpr size_t WS_WOUT = 90 * MiB;
constexpr size_t WS_WK = 122 * MiB;
constexpr size_t WS_WV = 130 * MiB;
constexpr size_t WS_MEMB = 138 * MiB;
constexpr size_t WS_KM = 142 * MiB;
constexpr size_t WS_VMT = 146 * MiB;
constexpr size_t WS_LORA = 150 * MiB;
constexpr size_t LORA_STRIDE = 3 * MiB;
constexpr size_t WS_WSW = 156 * MiB;
constexpr size_t WSW_STRIDE = 393216;
constexpr size_t WS_EXP1 = 160 * MiB;
constexpr size_t WS_EXP2 = 288 * MiB;
constexpr size_t WS_XB = 352 * MiB;
constexpr size_t WS_Z = 416 * MiB;
constexpr size_t WS_CAT = 592 * MiB;
constexpr size_t WS_HB = 656 * MiB;
constexpr size_t WS_LTOK = 720 * MiB;
constexpr size_t WS_LGATE = 722 * MiB;
constexpr size_t WS_LSLOT = 724 * MiB;
constexpr size_t WS_HE = 728 * MiB;
constexpr size_t WS_YS = 768 * MiB;
constexpr size_t WS_ACT = 896 * MiB;
constexpr size_t WS_LW = 944 * MiB;
constexpr size_t WS_GATE = 1040 * MiB;
constexpr size_t WS_SCAN = 1088 * MiB;
constexpr size_t WS_V = 1568 * MiB;
constexpr size_t WS_Y = 1664 * MiB;
constexpr size_t WS_GH = 1760 * MiB;
constexpr size_t WS_QY = 1088 * MiB;
constexpr size_t WS_Y0T = 1152 * MiB;
constexpr size_t WS_E = 1280 * MiB;
constexpr size_t WS_END = 1952 * MiB;
constexpr int CW_BAR = 4096;
constexpr int CW_CNT = 16384;

constexpr int LDS_BYTES = 147456;
constexpr int LDS_CTL_OFF = 146432;

DI float bf2f(unsigned b) { return __uint_as_float(b << 16); }
typedef float cvt_f32x2 __attribute__((ext_vector_type(2)));
typedef __bf16 cvt_bf16x2 __attribute__((ext_vector_type(2)));
DI unsigned cvt_pk_bf16(float lo, float hi) { const cvt_f32x2 v = {lo, hi}; return __builtin_bit_cast(unsigned, __builtin_convertvector(v, cvt_bf16x2)); }
DI float bflo(unsigned w) { return __uint_as_float(w << 16); }
DI float bfhi(unsigned w) { return __uint_as_float(w & 0xffff0000u); }
DI float wave_sum(float v) {
#pragma unroll
    for (int o = 1; o < 64; o <<= 1) v += __shfl_xor(v, o);
    return v;
}
DI float sum16(float v) {
    v += __builtin_bit_cast(float, __builtin_amdgcn_update_dpp(0, __builtin_bit_cast(int, v), 0x128, 0xf, 0xf, false));
    v += __builtin_bit_cast(float, __builtin_amdgcn_update_dpp(0, __builtin_bit_cast(int, v), 0x124, 0xf, 0xf, false));
    v += __builtin_bit_cast(float, __builtin_amdgcn_update_dpp(0, __builtin_bit_cast(int, v), 0x122, 0xf, 0xf, false));
    v += __builtin_bit_cast(float, __builtin_amdgcn_update_dpp(0, __builtin_bit_cast(int, v), 0x121, 0xf, 0xf, false));
    return v;
}
DI float fma_s(float a, float b, float c) { float d; asm("v_fma_f32 %0, %1, %2, %3" : "=v"(d) : "v"(a), "v"(b), "v"(c)); return d; }
DI float sigmoidf_(float x) { return __builtin_amdgcn_rcpf(1.f + __expf(-x)); }
DI float softplusf_(float x) { return fmaxf(x, 0.f) + __logf(1.f + __expf(-fabsf(x))); }
#define LDS_WAIT() asm volatile("s_waitcnt lgkmcnt(0)" ::: "memory")
#define VM_WAIT() asm volatile("s_waitcnt vmcnt(0)" ::: "memory")
#define LDS_BARRIER() do { asm volatile("s_waitcnt lgkmcnt(0)" ::: "memory"); __builtin_amdgcn_s_barrier(); asm volatile("" ::: "memory"); } while (0)

template <class T> DI T* as_global(T* p) { return p; }
DI const float* kin_ptr(int i) { int off = i * 8; asm volatile("" : "+v"(off)); const char* ka = (const char*)__builtin_amdgcn_kernarg_segment_ptr();
    const unsigned long long p = *(const unsigned long long*)(ka + off);
    const unsigned lo = __builtin_amdgcn_readfirstlane((unsigned)p), hi = __builtin_amdgcn_readfirstlane((unsigned)(p >> 32));
    return as_global((const float*)(((unsigned long long)hi << 32) | lo)); }
#define PIN(i) kin_ptr(i)
DI unsigned char* opq(unsigned char* p) { asm volatile("" : "+s"(p)); return p; }
DI float* opqf(float* p) { asm volatile("" : "+s"(p)); return p; }

#define XB_TMO      128
#define XB_XCNT(j)  (256  + 64 * (j))
#define XB_XSUB(j)  (1280 + 64 * (j))
#define XB_XGEN(j)  (2304 + 64 * (j))
#define XB_TOP      3328
#define XB_TOPGEN   3392
#define XCD_BAR_WORDS 3456
#define XB_SPIN_CAP (1u << 20)

__device__ __forceinline__ unsigned xb_ld(unsigned* p)              { return __hip_atomic_load(p, __ATOMIC_RELAXED, __HIP_MEMORY_SCOPE_AGENT); }
__device__ __forceinline__ unsigned xb_add(unsigned* p, unsigned v) { return __hip_atomic_fetch_add(p, v, __ATOMIC_RELAXED, __HIP_MEMORY_SCOPE_AGENT); }
__device__ __forceinline__ unsigned xb_xcc_id() { return (unsigned)__builtin_amdgcn_s_getreg((3 << 11) | 20) & 0xFu; }
#define XB_SPIN(cond, bar) do { unsigned _sp = 0; while (cond) { __builtin_amdgcn_s_sleep(1); \
    if ((++_sp & 255u) == 0u) { if (xb_ld(&(bar)[XB_TMO])) break; if (_sp > XB_SPIN_CAP) { atomicAdd(&(bar)[XB_TMO], 1u); break; } } } } while (0)

struct XcdBarrier { unsigned* bar; unsigned x; volatile LAS unsigned* st; };

__device__ __forceinline__ XcdBarrier xcd_barrier_post(unsigned* bar, volatile LAS unsigned* st) {
    XcdBarrier b; b.bar = bar; b.x = xb_xcc_id(); b.st = st;
    if (threadIdx.x == 0) (void)xb_add(&bar[XB_XCNT(b.x)], 1u);
    return b;
}
__device__ __forceinline__ void xcd_barrier_complete(unsigned* bar, unsigned x, unsigned& nloc, unsigned& nx) {
    const unsigned G = gridDim.x * gridDim.y * gridDim.z;
    unsigned sum, cnt, mine, sp = 0u;
    for (;;) {
        sum = 0u; cnt = 0u; mine = 0u;
#pragma unroll
        for (unsigned j = 0; j < 16; ++j) { const unsigned c = xb_ld(&bar[XB_XCNT(j)]); sum += c; cnt += (c > 0u) ? 1u : 0u; mine = (j == x) ? c : mine; }
        if (sum == G) break;
        __builtin_amdgcn_s_sleep(1);
        if ((++sp & 255u) == 0u) { if (xb_ld(&bar[XB_TMO])) break; if (sp > XB_SPIN_CAP) { atomicAdd(&bar[XB_TMO], 1u); break; } }
    }
    nloc = mine > 0u ? mine : 1u; nx = cnt > 0u ? cnt : 1u;
}
__device__ __forceinline__ void xcd_barrier(const XcdBarrier& b) {
    asm volatile("s_waitcnt vmcnt(0)" ::: "memory");
    __syncthreads();
    if (threadIdx.x == 0) {
        unsigned* bar = b.bar;
        __builtin_amdgcn_s_waitcnt(0);
        unsigned nloc = b.st[0], nx = b.st[1];
        if (nloc == 0u) { xcd_barrier_complete(bar, b.x, nloc, nx); b.st[0] = nloc; b.st[1] = nx; }
        const unsigned old = xb_add(&bar[XB_XSUB(b.x)], 1u);
        const unsigned gen = old / nloc;
        if (old + 1u == (gen + 1u) * nloc) {
            __builtin_amdgcn_fence(__ATOMIC_RELEASE, "agent");
            asm volatile("s_waitcnt vmcnt(0)" ::: "memory");
            const unsigned og = xb_add(&bar[XB_TOP], 1u);
            const unsigned tg = og / nx;
            if (og + 1u == (tg + 1u) * nx) xb_add(&bar[XB_TOPGEN], 1u);
            else XB_SPIN(xb_ld(&bar[XB_TOPGEN]) == tg, bar);
            __builtin_amdgcn_fence(__ATOMIC_ACQUIRE, "agent");
            xb_add(&bar[XB_XGEN(b.x)], 1u);
            asm volatile("s_waitcnt vmcnt(0)" ::: "memory");
        } else {
            XB_SPIN(xb_ld(&bar[XB_XGEN(b.x)]) == gen, bar);
            __builtin_amdgcn_fence(__ATOMIC_ACQUIRE, "agent");
            asm volatile("s_waitcnt vmcnt(0)" ::: "memory");
        }
    }
    __syncthreads();
}

namespace pg8 {
constexpr int BM = 256, BK = 64, HALF = 128, HTB = HALF * BK * 2, STAGE_BYTES = 8 * HTB, NXCD = 8, WGM = 8;
DI int lds_byte(int r, int c) { const int st = (r >> 4) * 2 + (c >> 5), rr = r & 15, cc = c & 31, ob = rr * 64 + cc * 2; return st * 1024 + (ob ^ (((ob >> 9) & 1) << 5)); }
DI void stage_rc(int b, int& R, int& C) { const int st = b / 1024, sb = b % 1024, swz = sb ^ (((sb >> 9) & 1) << 5); R = (st >> 1) * 16 + swz / 64; C = (st & 1) * 32 + (swz % 64) / 2; }
DI int perm32(int rho) { const int n = rho >> 4, i = rho & 15; return 8 * (i >> 2) + 4 * n + (i & 3); }

struct Unit { int pm, pn, e, rt; };
struct Gemm { const bf16_t* A; const bf16_t* Bt; int lda, ldb, K; };

struct StaticOrder {
    static constexpr bool GATHER = false;
    int nM, nN, nwg, G, c;
    DI void init(int M, int N, int G_, int c_) { nM = M / BM; nN = N / BM; nwg = nM * nN; G = G_; c = c_; }
    DI bool next(int i, Unit& u) const {
        const long L = (long)i * G + c; if (L >= nwg) return false;
        int wgid = (int)L; { const int q = nwg / NXCD, r = nwg % NXCD, xcd = wgid % NXCD, off = wgid / NXCD; wgid = (xcd < r ? xcd * (q + 1) : r * (q + 1) + (xcd - r) * q) + off; }
        const int nig = WGM * nN, gid = wgid / nig, fm = gid * WGM, gsz = (nM - fm) < WGM ? (nM - fm) : WGM;
        u.pm = fm + ((wgid % nig) % gsz); u.pn = (wgid % nig) / gsz; u.e = 0; u.rt = 0; return true;
    }
    DI const char* a_base(const Gemm& g, const Unit& u) const { return (const char*)g.A + (size_t)u.pm * BM * g.lda * 2; }
    DI const char* b_base(const Gemm& g, const Unit& u) const { return (const char*)g.Bt + (size_t)u.pn * BM * g.ldb * 2; }
    DI unsigned gather_voff(const Unit&, int, int, int) const { return 0u; }
};

template <bool GATH> struct MoeOrder {
    static constexpr bool GATHER = GATH;
    int G, c, npn, total; const LAS int* tb; size_t estride; const int* ltok; const unsigned* cnt;
    DI bool next(int i, Unit& u) const {
        if ((G & 7) == 0) {
            const int x = c & 7, r = c >> 3, W = G >> 3, idx = i * W + r;
            const int q = idx / npn, pn = idx - q * npn; int base = 0;
#pragma unroll
            for (int k = 0; k < 4; ++k) { const int e = x + 8 * k, nt = tb[e + 1] - tb[e];
                if (q < base + nt) { u.e = e; u.rt = q - base; u.pm = tb[e] + u.rt; u.pn = pn; return true; }
                base += nt; }
            return false;
        }
        const int L = i * G + c; if (L >= total) return false;
        const int q = L / npn; u.pn = L - q * npn; u.pm = q;
        int e = 0; while (e < NEXP - 1 && tb[e + 1] <= q) ++e;
        u.e = e; u.rt = q - tb[e]; return true;
    }
    DI const char* a_base(const Gemm& g, const Unit& u) const { return (const char*)g.A + (size_t)u.pm * BM * g.lda * 2; }
    DI const char* b_base(const Gemm& g, const Unit& u) const { return (const char*)g.Bt + (size_t)u.e * estride + (size_t)u.pn * BM * g.ldb * 2; }
    DI unsigned gather_voff(const Unit& u, int r, int C, int lda) const {
        const int pos = u.rt * BM + r; const int n = (int)__hip_atomic_load(cnt + u.e * 64, __ATOMIC_RELAXED, __HIP_MEMORY_SCOPE_AGENT);
        const int tok = pos < n ? ltok[u.e * LISTCAP + pos] : 0;
        return (unsigned)(tok * lda + C) * 2u;
    }
};

struct EpiStore {
    bf16_t* O; int ldc;
    DI void operator()(const f32x4 (&acc)[2][2][4][2], const Unit& u, int wr, int wc, int fr, int fq) const {
        const int row0 = u.pm * BM + wr * 64 + fr, col0 = u.pn * BM + wc * 32 + 8 * fq;
#pragma unroll
        for (int ai = 0; ai < 2; ++ai)
#pragma unroll
            for (int m = 0; m < 4; ++m) { bf16_t* rowp = O + (size_t)(row0 + ai * HALF + m * 16) * ldc + col0;
#pragma unroll
                for (int bj = 0; bj < 2; ++bj) { const f32x4 v0 = acc[ai][bj][m][0], v1 = acc[ai][bj][m][1];
                    u32x4 w; w.x = cvt_pk_bf16(v0[0], v0[1]); w.y = cvt_pk_bf16(v0[2], v0[3]); w.z = cvt_pk_bf16(v1[0], v1[1]); w.w = cvt_pk_bf16(v1[2], v1[3]);
                    *(GAS u32x4*)(rowp + bj * HALF) = w; } }
    }
};
struct EpiSwiGLU {
    bf16_t* H;
    DI void operator()(const f32x4 (&acc)[2][2][4][2], const Unit& u, int wr, int wc, int fr, int fq) const {
        const int row0 = u.pm * BM + wr * 64 + fr, col0 = u.pn * HALF + wc * 32 + 8 * fq;
#pragma unroll
        for (int ai = 0; ai < 2; ++ai)
#pragma unroll
            for (int m = 0; m < 4; ++m) { bf16_t* rowp = H + (size_t)(row0 + ai * HALF + m * 16) * DEXP + col0;
                float h[8];
#pragma unroll
                for (int n = 0; n < 2; ++n)
#pragma unroll
                    for (int j = 0; j < 4; ++j) { const float gt = acc[ai][0][m][n][j], up = acc[ai][1][m][n][j]; h[n * 4 + j] = gt * __builtin_amdgcn_rcpf(1.f + __expf(-gt)) * up; }
                u32x4 w; w.x = cvt_pk_bf16(h[0], h[1]); w.y = cvt_pk_bf16(h[2], h[3]); w.z = cvt_pk_bf16(h[4], h[5]); w.w = cvt_pk_bf16(h[6], h[7]);
                *(GAS u32x4*)rowp = w; }
    }
};
struct EpiScatter {
    bf16_t* YS; const int* lslot; const float* lgate; const unsigned* cnt;
    DI void operator()(const f32x4 (&acc)[2][2][4][2], const Unit& u, int wr, int wc, int fr, int fq) const {
        const int n = (int)__hip_atomic_load(cnt + u.e * 64, __ATOMIC_RELAXED, __HIP_MEMORY_SCOPE_AGENT);
        const int col0 = u.pn * BM + wc * 32 + 8 * fq;
#pragma unroll
        for (int ai = 0; ai < 2; ++ai)
#pragma unroll
            for (int m = 0; m < 4; ++m) { const int pos = u.rt * BM + ai * HALF + wr * 64 + m * 16 + fr;
                if (pos < n) { const int slot = lslot[u.e * LISTCAP + pos]; const float gt = lgate[u.e * LISTCAP + pos];
                    bf16_t* rowp = YS + (size_t)slot * DM + col0;
#pragma unroll
                    for (int bj = 0; bj < 2; ++bj) { const f32x4 v0 = acc[ai][bj][m][0] * gt, v1 = acc[ai][bj][m][1] * gt;
                        u32x4 w; w.x = cvt_pk_bf16(v0[0], v0[1]); w.y = cvt_pk_bf16(v0[2], v0[3]); w.z = cvt_pk_bf16(v1[0], v1[1]); w.w = cvt_pk_bf16(v1[2], v1[3]);
                        *(GAS u32x4*)(rowp + bj * HALF) = w; } } }
    }
};

template <class Epi, class Sched>
DI void gemm_phase(LAS unsigned char* lds, const Gemm g, const Sched& S, const Epi& E) {
    int tid = threadIdx.x; asm volatile("" : "+v"(tid));
    const int wid = __builtin_amdgcn_readfirstlane(tid >> 6), lane = tid & 63, wr = wid >> 2, wc = wid & 3, fr = lane & 15, fq = lane >> 4;
    const int K = g.K, nt = K / BK;
    unsigned voffA[2], voffB[2];
#pragma unroll
    for (int i = 0; i < 2; ++i) { int R, C; stage_rc(tid * 16 + i * 8192, R, C); const int Rb = (R & ~31) + perm32(R & 31);
        voffA[i] = (unsigned)(R * g.lda + C) * 2u; voffB[i] = (unsigned)(Rb * g.ldb + C) * 2u; }
    const size_t kstep = (size_t)(BK * 2);
    const size_t hstepA = (size_t)HALF * g.lda * 2, hstepB = (size_t)HALF * g.ldb * 2;
    const unsigned ldsw = (unsigned)wid * 1024u;
    const int aoff = lds_byte(wr * 64 + fr, fq * 8), boff = lds_byte(wc * 32 + fr, fq * 8);
    unsigned gvC[2][2], gvN[2][2];
#define PG8_SA(b, h) (((b) * 2 + (h)) * HTB)
#define PG8_SB(b, h) ((4 + (b) * 2 + (h)) * HTB)
#define PG8_STAGE(bufoff, gbase, voff) do { _Pragma("unroll") for (int _i = 0; _i < 2; ++_i) \
        __builtin_amdgcn_global_load_lds((const unsigned*)((const char*)(gbase) + (voff)[_i]), (LAS unsigned*)(lds + (bufoff) + ldsw + _i * 8192), 16, 0, 0); } while (0)
#define PG8_STAGE_A(bufoff, h, nxtsel, kt) do { \
        if constexpr (Sched::GATHER) { const char* _gb = (const char*)g.A + (size_t)(kt) * kstep; unsigned _vo[2]; _vo[0] = (nxtsel) ? gvN[h][0] : gvC[h][0]; _vo[1] = (nxtsel) ? gvN[h][1] : gvC[h][1]; PG8_STAGE(bufoff, _gb, _vo); } \
        else { const char* _gb = ((nxtsel) ? nA : cA) + (size_t)(h) * hstepA + (size_t)(kt) * kstep; PG8_STAGE(bufoff, _gb, voffA); } } while (0)
#define PG8_GSETUP(dst, u) do { if constexpr (Sched::GATHER) { _Pragma("unroll") for (int _h = 0; _h < 2; ++_h) _Pragma("unroll") for (int _i = 0; _i < 2; ++_i) { int _R, _C; stage_rc(tid * 16 + _i * 8192, _R, _C); \
        dst[_h][_i] = S.gather_voff(u, _h * HALF + _R, _C, g.lda); } asm volatile("s_waitcnt vmcnt(0)" : "+v"(dst[0][0]), "+v"(dst[0][1]), "+v"(dst[1][0]), "+v"(dst[1][1]) :: "memory"); } } while (0)
#define PG8_LDA(dst, b, h) do { _Pragma("unroll") for (int m = 0; m < 4; ++m) _Pragma("unroll") for (int k = 0; k < 2; ++k) dst[m][k] = *(const LAS bf16x8*)(lds + PG8_SA(b, h) + aoff + m * 2048 + k * 1024); } while (0)
#define PG8_LDB(dst, b, h) do { _Pragma("unroll") for (int n = 0; n < 2; ++n) _Pragma("unroll") for (int k = 0; k < 2; ++k) dst[n][k] = *(const LAS bf16x8*)(lds + PG8_SB(b, h) + boff + n * 2048 + k * 1024); } while (0)
#define PG8_MMA(ai, bj, At, Bt) do { __builtin_amdgcn_s_setprio(1); _Pragma("unroll") for (int m = 0; m < 4; ++m) _Pragma("unroll") for (int n = 0; n < 2; ++n) _Pragma("unroll") for (int k = 0; k < 2; ++k) \
        acc[ai][bj][m][n] = __builtin_amdgcn_mfma_f32_16x16x32_bf16(Bt[n][k], At[m][k], acc[ai][bj][m][n], 0, 0, 0); __builtin_amdgcn_s_setprio(0); } while (0)
#define PG8_WAIT_V(n) asm volatile("s_waitcnt vmcnt(" #n ")" ::: "memory")
#define PG8_WAIT_L(n) asm volatile("s_waitcnt lgkmcnt(" #n ")" ::: "memory")
#define PG8_BAR __builtin_amdgcn_s_barrier()
#define PG8_SCHED __builtin_amdgcn_sched_barrier(0)
    Unit cur, nxt; int ui = 0;
    if (!S.next(0, cur)) return;
    f32x4 acc[2][2][4][2];
#pragma unroll
    for (int a = 0; a < 2; ++a)
#pragma unroll
        for (int b = 0; b < 2; ++b)
#pragma unroll
            for (int m = 0; m < 4; ++m)
#pragma unroll
                for (int n = 0; n < 2; ++n) acc[a][b][m][n] = (f32x4){0.f, 0.f, 0.f, 0.f};
    bf16x8 At[4][2], B0[2][2], B1[2][2];
    const char* cA = S.a_base(g, cur); const char* cB = S.b_base(g, cur);
    const char* nA = cA;
    PG8_GSETUP(gvC, cur);
    PG8_STAGE(PG8_SB(0, 0), cB, voffB); PG8_STAGE_A(PG8_SA(0, 0), 0, false, 0); PG8_STAGE(PG8_SB(0, 1), cB + hstepB, voffB); PG8_STAGE_A(PG8_SA(0, 1), 1, false, 0);
    if (wr == 1) PG8_BAR;
    PG8_WAIT_V(4); PG8_BAR;
    PG8_STAGE(PG8_SB(1, 0), cB + kstep, voffB); PG8_STAGE_A(PG8_SA(1, 0), 0, false, 1); PG8_STAGE(PG8_SB(1, 1), cB + hstepB + kstep, voffB);
    PG8_WAIT_V(6); PG8_BAR;
    for (;;) {
        const bool has_next = S.next(ui + 1, nxt);
        nA = has_next ? S.a_base(g, nxt) : cA; const char* nB = has_next ? S.b_base(g, nxt) : cB;
        if constexpr (Sched::GATHER) { if (has_next) { PG8_GSETUP(gvN, nxt); } else {
#pragma unroll
            for (int _h = 0; _h < 2; ++_h) { gvN[_h][0] = gvC[_h][0]; gvN[_h][1] = gvC[_h][1]; } } }
        for (int t = 0; t < nt; t += 2) {
            const bool last = (t == nt - 2);
            const int kt2 = last ? 0 : t + 2;
            const char* b2 = last ? nB : cB + (size_t)(t + 2) * kstep;
            const char* b3 = b2 + kstep;
            PG8_LDB(B0, 0, 0); PG8_SCHED; PG8_LDA(At, 0, 0); PG8_STAGE_A(PG8_SA(1, 1), 1, false, t + 1);
            PG8_WAIT_L(8); PG8_BAR; PG8_WAIT_L(0); PG8_MMA(0, 0, At, B0); PG8_BAR; PG8_SCHED;
            PG8_LDB(B1, 0, 1); PG8_STAGE(PG8_SB(0, 0), b2, voffB);
            PG8_BAR; PG8_WAIT_L(0); PG8_MMA(0, 1, At, B1); PG8_BAR;
            PG8_LDA(At, 0, 1); PG8_STAGE_A(PG8_SA(0, 0), 0, last, kt2);
            PG8_BAR; PG8_WAIT_L(0); PG8_MMA(1, 0, At, B0); PG8_BAR; PG8_SCHED;
            PG8_STAGE(PG8_SB(0, 1), b2 + hstepB, voffB);
            PG8_WAIT_V(6); PG8_BAR; PG8_MMA(1, 1, At, B1); PG8_BAR;
            PG8_LDB(B0, 1, 0); PG8_SCHED; PG8_LDA(At, 1, 0); PG8_STAGE_A(PG8_SA(0, 1), 1, last, kt2);
            PG8_WAIT_L(8); PG8_BAR; PG8_WAIT_L(0); PG8_MMA(0, 0, At, B0); PG8_BAR; PG8_SCHED;
            PG8_LDB(B1, 1, 1); PG8_STAGE(PG8_SB(1, 0), b3, voffB);
            PG8_BAR; PG8_WAIT_L(0); PG8_MMA(0, 1, At, B1); PG8_BAR;
            PG8_LDA(At, 1, 1); PG8_STAGE_A(PG8_SA(1, 0), 0, last, kt2 + 1);
            PG8_BAR; PG8_WAIT_L(0); PG8_MMA(1, 0, At, B0); PG8_BAR; PG8_SCHED;
            PG8_STAGE(PG8_SB(1, 1), b3 + hstepB, voffB);
            PG8_WAIT_V(6); PG8_BAR; PG8_MMA(1, 1, At, B1); PG8_BAR;
        }
        E(acc, cur, wr, wc, fr, fq);
        if (!has_next) break;
#pragma unroll
        for (int a = 0; a < 2; ++a)
#pragma unroll
            for (int b = 0; b < 2; ++b)
#pragma unroll
                for (int m = 0; m < 4; ++m)
#pragma unroll
                    for (int n = 0; n < 2; ++n) acc[a][b][m][n] = (f32x4){0.f, 0.f, 0.f, 0.f};
        cur = nxt; cA = nA; cB = nB; ++ui;
        if constexpr (Sched::GATHER) {
#pragma unroll
            for (int _h = 0; _h < 2; ++_h) { gvC[_h][0] = gvN[_h][0]; gvC[_h][1] = gvN[_h][1]; } }
    }
    PG8_WAIT_V(0);
    if (wr == 0) PG8_BAR;
    PG8_BAR;
#undef PG8_SA
#undef PG8_SB
#undef PG8_STAGE
#undef PG8_STAGE_A
#undef PG8_GSETUP
#undef PG8_LDA
#undef PG8_LDB
#undef PG8_MMA
#undef PG8_WAIT_V
#undef PG8_WAIT_L
#undef PG8_BAR
#undef PG8_SCHED
}
}

struct Params { const float* in[31]; float* out; unsigned char* ws; int ph_lo, ph_hi; };

struct Ctx {
    LAS unsigned char* lds;
    int tid, lane, wave, G, bid, gw, ngw;
    unsigned char* ws; float* out;
};
DI Ctx relaunder(const Ctx& F0) {
    Ctx F = F0;
    asm volatile("" : "+v"(F.tid), "+v"(F.lane));
    asm volatile("" : "+s"(F.wave), "+s"(F.G), "+s"(F.bid), "+s"(F.gw), "+s"(F.ngw));
    asm volatile("" : "+s"(F.ws), "+s"(F.out));
    F.ws = as_global(F.ws); F.out = as_global(F.out);
    return F;
}

DI void dense_gemm(const Ctx& F, const bf16_t* A, int lda, const bf16_t* Bt, int ldb, int M, int N, int K, bf16_t* O, int ldc, int crot) {
    pg8::Gemm g{A, Bt, lda, ldb, K}; pg8::StaticOrder S; S.init(M, N, F.G, (F.bid + crot) % F.G);
    pg8::EpiStore E{O, ldc};
    for (int rep = 0; rep < REP_GEMM; ++rep) pg8::gemm_phase<pg8::EpiStore, pg8::StaticOrder>(F.lds, g, S, E);
}

struct TJob { const float* src; bf16_t* dst; int ldw, dld; };
DI void tr_load(const TJob& j, f32x4 (&r)[16], int lane) {
    const GAS float* p = (const GAS float*)(j.src + (size_t)(lane >> 4) * j.ldw + 4 * (lane & 15));
#pragma unroll
    for (int i = 0; i < 16; ++i) r[i] = *(const GAS f32x4*)(p + (size_t)(4 * i) * j.ldw);
}
DI void tr_store(const TJob& j, const f32x4 (&r)[16], LAS unsigned char* scr, int lane) {
#pragma unroll
    for (int i = 0; i < 16; ++i) { LAS unsigned* w = (LAS unsigned*)(scr + ((lane >> 4) + 4 * i) * 132 + (lane & 15) * 8); w[0] = cvt_pk_bf16(r[i].x, r[i].y); w[1] = cvt_pk_bf16(r[i].z, r[i].w); }
    LDS_WAIT();
    const int kc = lane & 7;
#pragma unroll
    for (int sgrp = 0; sgrp < 8; ++sgrp) { const int n = 8 * sgrp + (lane >> 3); const LAS unsigned short* c = (const LAS unsigned short*)(scr + (8 * kc) * 132 + n * 2);
        u32x4 o; o.x = (unsigned)c[0] | ((unsigned)c[66] << 16); o.y = (unsigned)c[2 * 66] | ((unsigned)c[3 * 66] << 16); o.z = (unsigned)c[4 * 66] | ((unsigned)c[5 * 66] << 16); o.w = (unsigned)c[6 * 66] | ((unsigned)c[7 * 66] << 16);
        *(GAS u32x4*)(j.dst + (size_t)n * j.dld + 8 * kc) = o; }
    LDS_WAIT();
}
template <class Dec> DI void tr_run(const Dec& D, int first, int count, int stride, LAS unsigned char* scr, int lane) {
    f32x4 A[16], B[16]; TJob ja, jb;
    int it = first; if (it >= count) return;
    ja = D(it); tr_load(ja, A, lane);
    for (;;) {
        const int it2 = it + stride; const bool h2 = it2 < count; if (h2) { jb = D(it2); tr_load(jb, B, lane); }
        tr_store(ja, A, scr, lane);
        if (!h2) break;
        const int it3 = it2 + stride; const bool h3 = it3 < count; if (h3) { ja = D(it3); tr_load(ja, A, lane); }
        tr_store(jb, B, scr, lane);
        if (!h3) break;
        it = it3;
    }
}
DI TJob mat_job(const float* W, int K, int N, bf16_t* WT, int item) {
    const int nblk = N / 64, kb = item / nblk, nb = item - kb * nblk;
    TJob j; j.src = W + (size_t)(64 * kb) * N + 64 * nb; j.dst = WT + (size_t)(64 * nb) * K + 64 * kb; j.ldw = N; j.dld = K; return j;
}
DI void row_to_bf16(const float* src, bf16_t* dst, int lane) {
    const GAS f32x4* s = (const GAS f32x4*)src + lane; GAS u32x2* o = (GAS u32x2*)dst + lane;
#pragma unroll
    for (int j = 0; j < 8; ++j) { const f32x4 v = s[64 * j]; u32x2 w; w.x = cvt_pk_bf16(v.x, v.y); w.y = cvt_pk_bf16(v.z, v.w); o[64 * j] = w; }
}

DI void phase_prologue(const Ctx& F, const Params& P) {
    unsigned char* const wsl = F.ws; float* const outl = F.out; (void)outl;
    LAS unsigned char* scr = F.lds + F.wave * 16384;
    unsigned char* ws = wsl;
    constexpr int I_RW = 32 * (RW_IN_COLS / 64), I_OT = 32 * (ZW_OTH / 64), I_WO = 32 * 32, I_KV = 32 * 8;
    constexpr int N_A = 2 * I_RW + 2 * I_OT, N_B = 4 * I_WO, N_C = 8 * I_KV, N_D = NTOK + NBATCH * MEML;
    struct ProDec { unsigned char* ws;
        DI TJob operator()(int it) const { int r = it;
            if (r < N_A) {
                if (r < I_RW) return mat_job(PIN(16), DM, RW_IN_COLS, (bf16_t*)(ws + WS_WIN), r); r -= I_RW;
                if (r < I_OT) return mat_job(PIN(28), DM, ZW_OTH, (bf16_t*)(ws + WS_WIN + WIN_STRIDE), r); r -= I_OT;
                if (r < I_OT) return mat_job(PIN(30), DM, ZW_OTH, (bf16_t*)(ws + WS_WIN + 2 * WIN_STRIDE), r); r -= I_OT;
                return mat_job(PIN(16) + (size_t)DM * RW_IN_COLS, DM, RW_IN_COLS, (bf16_t*)(ws + WS_WIN + 3 * WIN_STRIDE), r);
            }
            r -= N_A;
            if (r < N_B) { const int l = r / I_WO; return mat_job(PIN(2) + (size_t)l * DM * DM, DM, DM, (bf16_t*)(ws + WS_WOUT) + (size_t)l * DM * DM, r - l * I_WO); }
            r -= N_B;
            const int m = r / I_KV, l = m & 3; const bool isv = m >= 4;
            return mat_job(PIN(isv ? 4 : 3) + (size_t)l * DM * MEMW, DM, MEMW, (bf16_t*)(ws + (isv ? WS_WV : WS_WK)) + (size_t)l * MEMW * DM, r - m * I_KV);
        } };
    ProDec PD{ws};
    tr_run(PD, F.gw, N_A + N_B + N_C, F.ngw, scr, F.lane);
    for (int r = F.gw; r < N_D; r += F.ngw) {
        if (r < NTOK) row_to_bf16(PIN(0) + (size_t)r * DM, (bf16_t*)(ws + WS_XB) + (size_t)r * DM, F.lane);
        else row_to_bf16(PIN(1) + (size_t)(r - NTOK) * DM, (bf16_t*)(ws + WS_MEMB) + (size_t)(r - NTOK) * DM, F.lane);
    }
    const int gt = F.bid * NT + F.tid, ngt = F.G * NT;
    for (int idx = gt; idx < 2 * (3072 + 1536) * 256; idx += ngt) {
        const int j = idx / ((3072 + 1536) * 256); int r = idx - j * (3072 + 1536) * 256;
        bf16_t* base = (bf16_t*)(ws + WS_LORA + (size_t)j * LORA_STRIDE);
        const int n = r >> 8, k = r & 255; float v = 0.f;
        if (n < 1536) { if (k < 96) v = PIN(19)[((size_t)j * 96 + k) * CMIX + n]; }
        else if (n < 3072) { if (k >= 96 && k < 192) v = PIN(21)[((size_t)j * 96 + (k - 96)) * CMIX + (n - 1536)]; }
        else v = PIN(22)[((size_t)j * 256 + k) * CMIX + (n - 3072)];
        base[r] = (bf16_t)(cvt_pk_bf16(v, 0.f) & 0xffffu);
    }
    for (int idx = gt; idx < 2 * 64 * DM; idx += ngt) { const int j = idx / (64 * DM), r = idx - j * 64 * DM;
        ((bf16_t*)(ws + WS_WIN + (size_t)(j ? 3 : 0) * WIN_STRIDE))[(size_t)RW_IN_COLS * DM + r] = 0; }
    for (int idx = gt; idx < NLAYER * 48 * DM; idx += ngt) {
        const int l = idx / (48 * DM); int r = idx - l * 48 * DM; const int n = r / DM, k = r - n * DM;
        float v = 0.f;
        if (n < 4) v = PIN(9)[((size_t)l * DM + k) * 4 + n]; else if (n < 36) v = PIN(11)[((size_t)l * DM + k) * 32 + (n - 4)];
        const unsigned hi = cvt_pk_bf16(v, 0.f) & 0xffffu; const float rem = v - bf2f(hi); const unsigned lo = cvt_pk_bf16(rem, 0.f) & 0xffffu;
        bf16_t* base = (bf16_t*)(ws + WS_WSW + (size_t)l * WSW_STRIDE);
        base[r] = (bf16_t)hi; base[48 * DM + r] = (bf16_t)lo;
    }
}

DI void expert_convert(const Ctx& F, const Params& P, int l, int w, int nw) {
    unsigned char* const wsl = F.ws;
    LAS unsigned char* scr = F.lds + F.wave * 16384;
    constexpr int I_GU = NEXP * 32 * 8 * 2, I_DN = NEXP * 8 * 32;
    struct ExpDec { unsigned char* ws; int l;
        DI TJob operator()(int it) const { TJob j;
            if (it < I_GU) {
                const int isup = it / (I_GU / 2); int r = it - isup * (I_GU / 2);
                const int e = r / 256; r -= e * 256; const int kb = r >> 3, nb = r & 7;
                const float* W = PIN(isup ? 14 : 13) + ((size_t)l * NEXP + e) * DM * DEXP;
                const int n0 = 64 * nb, drow = 256 * (n0 >> 7) + (isup ? 128 : 0) + (n0 & 127);
                j.src = W + (size_t)(64 * kb) * DEXP + n0; j.ldw = DEXP; j.dst = (bf16_t*)(ws + WS_EXP1) + ((size_t)e * 1024 + drow) * DM + 64 * kb; j.dld = DM;
            } else {
                int r = it - I_GU; const int e = r / 256; r -= e * 256; const int kb = r >> 5, nb = r & 31;
                const float* W = PIN(15) + ((size_t)l * NEXP + e) * DEXP * DM;
                j.src = W + (size_t)(64 * kb) * DM + 64 * nb; j.ldw = DM; j.dst = (bf16_t*)(ws + WS_EXP2) + ((size_t)e * DM + 64 * nb) * DEXP + 64 * kb; j.dld = DEXP;
            }
            return j; } };
    ExpDec ED{wsl, l};
    tr_run(ED, w, I_GU + I_DN, nw, scr, F.lane);
}

DI void memattn_unit(const Ctx& F, int l, int unit, const bf16_t* z, int zw, int qcol) {
    unsigned char* const wsl = F.ws; float* const outl = F.out; (void)outl;
    const int b = unit >> 6, head = (unit >> 4) & 3, qblk = unit & 15;
    LAS unsigned char* Ks = F.lds; LAS unsigned char* Vs = F.lds + 69632;
    const bf16_t* Km = (const bf16_t*)(wsl + WS_KM); const bf16_t* VmT = (const bf16_t*)(wsl + WS_VMT);
    bf16_t* cat = (bf16_t*)(wsl + WS_CAT);
    __syncthreads();
#pragma unroll
    for (int i = 0; i < 8; ++i) { const int ch = F.tid + NT * i;
        { const int row = ch >> 4, c16 = ch & 15; const u32x4 v = *(const u32x4*)(Km + (size_t)(b * MEML + row) * 2048 + l * 512 + head * 128 + c16 * 8); *(LAS u32x4*)(Ks + row * 272 + c16 * 16) = v; }
        { const int d = ch >> 5, c = ch & 31; const u32x4 v = *(const u32x4*)(VmT + (size_t)(l * 512 + head * 128 + d) * 1024 + b * MEML + c * 8); *(LAS u32x4*)(Vs + d * 528 + c * 16) = v; } }
    __syncthreads();
    const int lane = F.lane, fr = lane & 15, fq = lane >> 4;
    for (int itq = 0; itq < 2; ++itq) {
        const int q0 = qblk * 256 + itq * 128 + F.wave * 16, tok0 = b * SEQ + q0;
        bf16x8 Qf[4];
#pragma unroll
        for (int ks = 0; ks < 4; ++ks) Qf[ks] = *(const bf16x8*)(z + (size_t)(tok0 + fr) * zw + qcol + head * 128 + ks * 32 + fq * 8);
        f32x4 acc[16];
#pragma unroll
        for (int t = 0; t < 16; ++t) { acc[t] = (f32x4){0.f, 0.f, 0.f, 0.f};
#pragma unroll
            for (int ks = 0; ks < 4; ++ks) { const bf16x8 kf = *(const LAS bf16x8*)(Ks + (16 * t + fr) * 272 + ks * 64 + fq * 16);
                acc[t] = __builtin_amdgcn_mfma_f32_16x16x32_bf16(kf, Qf[ks], acc[t], 0, 0, 0); } }
        const float sc = 0.08838834764831845f;
        float mx = -3.0e38f;
#pragma unroll
        for (int t = 0; t < 16; ++t)
#pragma unroll
            for (int j = 0; j < 4; ++j) { acc[t][j] *= sc; mx = fmaxf(mx, acc[t][j]); }
        mx = fmaxf(mx, __shfl_xor(mx, 16)); mx = fmaxf(mx, __shfl_xor(mx, 32));
        float sum = 0.f;
#pragma unroll
        for (int t = 0; t < 16; ++t)
#pragma unroll
            for (int j = 0; j < 4; ++j) { acc[t][j] = __expf(acc[t][j] - mx); sum += acc[t][j]; }
        sum += __shfl_xor(sum, 16); sum += __shfl_xor(sum, 32);
        const float inv = 1.f / sum;
        f32x4 o[8];
#pragma unroll
        for (int dt = 0; dt < 8; ++dt) o[dt] = (f32x4){0.f, 0.f, 0.f, 0.f};
#pragma unroll
        for (int s = 0; s < 8; ++s) {
            u32x4 pw; pw.x = cvt_pk_bf16(acc[2 * s][0], acc[2 * s][1]); pw.y = cvt_pk_bf16(acc[2 * s][2], acc[2 * s][3]);
            pw.z = cvt_pk_bf16(acc[2 * s + 1][0], acc[2 * s + 1][1]); pw.w = cvt_pk_bf16(acc[2 * s + 1][2], acc[2 * s + 1][3]);
            const bf16x8 pf = __builtin_bit_cast(bf16x8, pw);
#pragma unroll
            for (int dt = 0; dt < 8; ++dt) {
                const u32x2 v0 = *(const LAS u32x2*)(Vs + (16 * dt + fr) * 528 + (32 * s + 4 * fq) * 2);
                const u32x2 v1 = *(const LAS u32x2*)(Vs + (16 * dt + fr) * 528 + (32 * s + 16 + 4 * fq) * 2);
                u32x4 vw; vw.x = v0.x; vw.y = v0.y; vw.z = v1.x; vw.w = v1.y;
                o[dt] = __builtin_amdgcn_mfma_f32_16x16x32_bf16(__builtin_bit_cast(bf16x8, vw), pf, o[dt], 0, 0, 0);
            }
        }
        bf16_t* orow = cat + (size_t)(tok0 + fr) * DM + CMIX + head * 128 + 4 * fq;
#pragma unroll
        for (int dt = 0; dt < 8; ++dt) { u32x2 w; w.x = cvt_pk_bf16(o[dt][0] * inv, o[dt][1] * inv); w.y = cvt_pk_bf16(o[dt][2] * inv, o[dt][3] * inv); *(u32x2*)(orow + 16 * dt) = w; }
    }
}
DI void memattn_all(const Ctx& F, int l, const bf16_t* z, int zw, int qcol) {
    for (int u = F.bid; u < 256; u += F.G) memattn_unit(F, l, u, z, zw, qcol);
    __syncthreads();
}

DI void conv_mix(const Ctx& F, const Params& P, const bf16_t* z) {
    unsigned char* const wsl = F.ws; float* const outl = F.out; (void)outl;
    const float* cw = PIN(29);
    bf16_t* cat = (bf16_t*)(wsl + WS_CAT);
    const int gt = F.bid * NT + F.tid, ngt = F.G * NT;
    for (int idx = gt; idx < NTOK * 192; idx += ngt) {
        const int tok = idx / 192, c8 = idx - tok * 192, c = c8 * 8, t = tok & (SEQ - 1);
        const bf16_t* zr = z + (size_t)tok * ZW_OTH;
        const u32x4 bg = *(const u32x4*)(zr + c);
        float y[8];
#pragma unroll
        for (int j = 0; j < 8; ++j) y[j] = 0.f;
#pragma unroll
        for (int dt = 0; dt < 3; ++dt) {
            if (t - dt >= 0) {
                const u32x4 cg = *(const u32x4*)(zr - (size_t)dt * ZW_OTH + CMIX + c), hh = *(const u32x4*)(zr - (size_t)dt * ZW_OTH + 2 * CMIX + c);
                const f32x4 w0 = *(const f32x4*)(cw + (2 - dt) * CMIX + c), w1 = *(const f32x4*)(cw + (2 - dt) * CMIX + c + 4);
                y[0] += w0.x * bflo(cg.x) * bflo(hh.x); y[1] += w0.y * bfhi(cg.x) * bfhi(hh.x); y[2] += w0.z * bflo(cg.y) * bflo(hh.y); y[3] += w0.w * bfhi(cg.y) * bfhi(hh.y);
                y[4] += w1.x * bflo(cg.z) * bflo(hh.z); y[5] += w1.y * bfhi(cg.z) * bfhi(hh.z); y[6] += w1.z * bflo(cg.w) * bflo(hh.w); y[7] += w1.w * bfhi(cg.w) * bfhi(hh.w);
            }
        }
        u32x4 o; o.x = cvt_pk_bf16(bflo(bg.x) * y[0], bfhi(bg.x) * y[1]); o.y = cvt_pk_bf16(bflo(bg.y) * y[2], bfhi(bg.y) * y[3]);
        o.z = cvt_pk_bf16(bflo(bg.z) * y[4], bfhi(bg.z) * y[5]); o.w = cvt_pk_bf16(bflo(bg.w) * y[6], bfhi(bg.w) * y[7]);
        *(u32x4*)(cat + (size_t)tok * DM + c) = o;
    }
}

DI void sb_attention(const Ctx& F, const bf16_t* z) {
    unsigned char* const wsl = F.ws;
    const bf16_t* VT = (const bf16_t*)(wsl + WS_ACT);
    bf16_t* cat = (bf16_t*)(wsl + WS_CAT);
    LAS unsigned char* Ks = F.lds; LAS unsigned char* Vs = F.lds + 69632;
    const int lane = F.lane, fr = lane & 15, fq = lane >> 4;
    const float sc = 0.08838834764831845f;
    for (int u = F.bid; u < NBATCH * 12 * 32; u += F.G) {
        const int b = u / (12 * 32); int r = u - b * 12 * 32; const int head = r >> 5, qblk = r & 31;
        const int t0 = qblk * 128, kw0 = t0 - 128;
        __syncthreads();
#pragma unroll
        for (int i = 0; i < 8; ++i) { const int ch = F.tid + NT * i;
            { const int row = ch >> 4, c16 = ch & 15, key = kw0 + row;
              if (key >= 0) { const u32x4 v = *(const u32x4*)(z + (size_t)(b * SEQ + key) * ZW_OTH + CMIX + head * 128 + c16 * 8); *(LAS u32x4*)(Ks + row * 272 + c16 * 16) = v; } }
            { const int d = ch >> 5, c = ch & 31;
              if (kw0 + c * 8 >= 0) { const u32x4 v = *(const u32x4*)(VT + (size_t)(head * 128 + d) * NTOK + b * SEQ + kw0 + c * 8); *(LAS u32x4*)(Vs + d * 528 + c * 16) = v; } } }
        __syncthreads();
        const int tq0 = t0 + F.wave * 16, tq = tq0 + fr;
        bf16x8 Qf[4];
#pragma unroll
        for (int ks = 0; ks < 4; ++ks) Qf[ks] = *(const bf16x8*)(z + (size_t)(b * SEQ + tq) * ZW_OTH + head * 128 + ks * 32 + fq * 8);
        f32x4 o[8];
#pragma unroll
        for (int dt = 0; dt < 8; ++dt) o[dt] = (f32x4){0.f, 0.f, 0.f, 0.f};
        float R = 0.f;
        for (int kt = (tq0 + 14) >> 5; kt >= 0; --kt) {
            const int lk = 32 * kt - kw0;
            bf16x8 Kf[2][4]; u32x2 V0[8], V1[8];
            if (lk >= 0) {
#pragma unroll
                for (int tl = 0; tl < 2; ++tl)
#pragma unroll
                    for (int ks = 0; ks < 4; ++ks) Kf[tl][ks] = *(const LAS bf16x8*)(Ks + (lk + 16 * tl + fr) * 272 + ks * 64 + fq * 16);
#pragma unroll
                for (int dt = 0; dt < 8; ++dt) { V0[dt] = *(const LAS u32x2*)(Vs + (16 * dt + fr) * 528 + (lk + 4 * fq) * 2); V1[dt] = *(const LAS u32x2*)(Vs + (16 * dt + fr) * 528 + (lk + 16 + 4 * fq) * 2); }
            } else {
#pragma unroll
                for (int tl = 0; tl < 2; ++tl)
#pragma unroll
                    for (int ks = 0; ks < 4; ++ks) Kf[tl][ks] = *(const bf16x8*)(z + (size_t)(b * SEQ + 32 * kt + 16 * tl + fr) * ZW_OTH + CMIX + head * 128 + ks * 32 + fq * 8);
#pragma unroll
                for (int dt = 0; dt < 8; ++dt) { const bf16_t* vp = VT + (size_t)(head * 128 + 16 * dt + fr) * NTOK + b * SEQ + 32 * kt + 4 * fq; V0[dt] = *(const u32x2*)vp; V1[dt] = *(const u32x2*)(vp + 16); }
            }
            f32x4 s[2];
#pragma unroll
            for (int tl = 0; tl < 2; ++tl) { s[tl] = (f32x4){0.f, 0.f, 0.f, 0.f};
#pragma unroll
                for (int ks = 0; ks < 4; ++ks) s[tl] = __builtin_amdgcn_mfma_f32_16x16x32_bf16(Kf[tl][ks], Qf[ks], s[tl], 0, 0, 0); }
            float ln[2][4], lsg[2][4], tot[2];
#pragma unroll
            for (int tl = 0; tl < 2; ++tl) { tot[tl] = 0.f;
#pragma unroll
                for (int j = 0; j < 4; ++j) { const float x = s[tl][j] * sc; const int key = 32 * kt + 16 * tl + 4 * fq + j; const bool valid = key < tq;
                    const float sp = softplusf_(x); ln[tl][j] = valid ? -sp : 0.f; lsg[tl][j] = valid ? (x - sp) : -1.0e30f; tot[tl] += ln[tl][j]; } }
            const float a16_0 = __shfl_xor(tot[0], 16), a32_0 = __shfl_xor(tot[0], 32), a48_0 = __shfl_xor(tot[0], 48);
            const float a16_1 = __shfl_xor(tot[1], 16), a32_1 = __shfl_xor(tot[1], 32), a48_1 = __shfl_xor(tot[1], 48);
            float hi0 = 0.f, hi1 = 0.f;
            if ((fq ^ 1) > fq) { hi0 += a16_0; hi1 += a16_1; }
            if ((fq ^ 2) > fq) { hi0 += a32_0; hi1 += a32_1; }
            if ((fq ^ 3) > fq) { hi0 += a48_0; hi1 += a48_1; }
            const float all0 = tot[0] + a16_0 + a32_0 + a48_0, all1 = tot[1] + a16_1 + a32_1 + a48_1;
            const float E0 = R + hi0 + all1, E1 = R + hi1;
            float at[2][4];
#pragma unroll
            for (int tl = 0; tl < 2; ++tl) { float suf = 0.f; const float Eb = tl ? E1 : E0;
#pragma unroll
                for (int j = 3; j >= 0; --j) { at[tl][j] = __expf(lsg[tl][j] + Eb + suf); suf += ln[tl][j]; } }
            R += all0 + all1;
            u32x4 pw; pw.x = cvt_pk_bf16(at[0][0], at[0][1]); pw.y = cvt_pk_bf16(at[0][2], at[0][3]); pw.z = cvt_pk_bf16(at[1][0], at[1][1]); pw.w = cvt_pk_bf16(at[1][2], at[1][3]);
            const bf16x8 pf = __builtin_bit_cast(bf16x8, pw);
#pragma unroll
            for (int dt = 0; dt < 8; ++dt) {
                u32x4 vw; vw.x = V0[dt].x; vw.y = V0[dt].y; vw.z = V1[dt].x; vw.w = V1[dt].y;
                o[dt] = __builtin_amdgcn_mfma_f32_16x16x32_bf16(__builtin_bit_cast(bf16x8, vw), pf, o[dt], 0, 0, 0);
            }
            if (__all(R < -100.f)) break;
        }
        bf16_t* orow = cat + (size_t)(b * SEQ + tq) * DM + head * 128 + 4 * fq;
#pragma unroll
        for (int dt = 0; dt < 8; ++dt) { u32x2 w; w.x = cvt_pk_bf16(o[dt][0], o[dt][1]); w.y = cvt_pk_bf16(o[dt][2], o[dt][3]); *(u32x2*)(orow + 16 * dt) = w; }
    }
    __syncthreads();
}

DI void rwkv_prep1(const Ctx& F, const Params& P, int j, const bf16_t* z) {
    unsigned char* const wsl = F.ws; float* const outl = F.out; (void)outl;
    const float* mu = PIN(17) + (size_t)j * 5056;
    bf16_t* act = (bf16_t*)(wsl + WS_ACT);
    const int gt = F.bid * NT + F.tid, ngt = F.G * NT;
    for (int idx = gt; idx < NTOK * 64; idx += ngt) {
        const int tok = idx >> 6, ci = idx & 63, t = tok & (SEQ - 1);
        u32x4 o = (u32x4){0u, 0u, 0u, 0u};
        if (ci < 24 || ci >= 32) {
            const int sc = ci < 12 ? 4608 + 8 * ci : (ci < 24 ? 4704 + 8 * (ci - 12) : 4800 + 8 * (ci - 32));
            const u32x4 a = *(const u32x4*)(z + (size_t)tok * ZW_RWKV + sc);
            u32x4 p = (u32x4){0u, 0u, 0u, 0u}; if (t > 0) p = *(const u32x4*)(z + (size_t)(tok - 1) * ZW_RWKV + sc);
            const f32x4 m0 = *(const f32x4*)(mu + sc), m1 = *(const f32x4*)(mu + sc + 4);
            float v[8];
            v[0] = bflo(a.x) + (bflo(p.x) - bflo(a.x)) * m0.x; v[1] = bfhi(a.x) + (bfhi(p.x) - bfhi(a.x)) * m0.y;
            v[2] = bflo(a.y) + (bflo(p.y) - bflo(a.y)) * m0.z; v[3] = bfhi(a.y) + (bfhi(p.y) - bfhi(a.y)) * m0.w;
            v[4] = bflo(a.z) + (bflo(p.z) - bflo(a.z)) * m1.x; v[5] = bfhi(a.z) + (bfhi(p.z) - bfhi(a.z)) * m1.y;
            v[6] = bflo(a.w) + (bflo(p.w) - bflo(a.w)) * m1.z; v[7] = bfhi(a.w) + (bfhi(p.w) - bfhi(a.w)) * m1.w;
#pragma unroll
            for (int q = 0; q < 8; ++q) { if (ci < 12) v[q] = tanhf(v[q]); else if (ci >= 32) v[q] = sigmoidf_(v[q]); }
            o.x = cvt_pk_bf16(v[0], v[1]); o.y = cvt_pk_bf16(v[2], v[3]); o.z = cvt_pk_bf16(v[4], v[5]); o.w = cvt_pk_bf16(v[6], v[7]);
        }
        *(u32x4*)(act + (size_t)tok * 512 + ci * 8) = o;
    }
}

constexpr int CH = 64, NCH = SEQ / CH;
DI float* scan_rec(unsigned char* ws, int tok, int head) {
    return (float*)(ws + WS_SCAN) + ((size_t)((tok >> 12) * 24 + head) * SEQ + (tok & (SEQ - 1))) * 320;
}
DI float* gh_ptr(unsigned char* ws, int bh, int c, int which) { return (float*)(ws + WS_GH) + (((size_t)bh * NCH + c) * 2 + which) * 4096; }
struct RwPar { const float *mu, *w0, *a0, *kk, *ka, *rk, *gng, *gnb; };
struct PrepRaw { u32x2 zr, zk, zv, pr, pk, pv, lw, la; };
struct PrepOut { f32x4 dec, ld, bb, kp, r, nk, v; float bon; };
DI void prep_load(PrepRaw& R, const bf16_t* z, const bf16_t* LW, int tok, int c4) {
    tok = tok < NTOK ? tok : NTOK - 1;
    const bool hp = (tok & (SEQ - 1)) != 0;
    const GAS bf16_t* zc = (const GAS bf16_t*)(z + (size_t)tok * ZW_RWKV + c4); const GAS bf16_t* zp = hp ? zc - ZW_RWKV : zc;
    R.zr = *(const GAS u32x2*)zc; R.zk = *(const GAS u32x2*)(zc + CMIX); R.zv = *(const GAS u32x2*)(zc + 2 * CMIX);
    R.pr = *(const GAS u32x2*)zp; R.pk = *(const GAS u32x2*)(zp + CMIX); R.pv = *(const GAS u32x2*)(zp + 2 * CMIX);
    const GAS bf16_t* lp = (const GAS bf16_t*)(LW + (size_t)tok * 3072 + c4); R.lw = *(const GAS u32x2*)lp; R.la = *(const GAS u32x2*)(lp + CMIX);
}
DI f32x4 lerp_u(u32x2 a, u32x2 p, f32x4 m) {
    f32x4 r; r.x = bflo(a.x) + (bflo(p.x) - bflo(a.x)) * m.x; r.y = bfhi(a.x) + (bfhi(p.x) - bfhi(a.x)) * m.y;
    r.z = bflo(a.y) + (bflo(p.y) - bflo(a.y)) * m.z; r.w = bfhi(a.y) + (bfhi(p.y) - bfhi(a.y)) * m.w; return r;
}
struct PrepPar { f32x4 mur, muk, muv, w0, a0, kk, ka, rk; };
DI void par_load(PrepPar& P, const RwPar& Q, int c4) {
    P.mur = *(const GAS f32x4*)(Q.mu + c4); P.muk = *(const GAS f32x4*)(Q.mu + CMIX + c4); P.muv = *(const GAS f32x4*)(Q.mu + 2 * CMIX + c4);
    P.w0 = *(const GAS f32x4*)(Q.w0 + c4); P.a0 = *(const GAS f32x4*)(Q.a0 + c4); P.kk = *(const GAS f32x4*)(Q.kk + c4); P.ka = *(const GAS f32x4*)(Q.ka + c4); P.rk = *(const GAS f32x4*)(Q.rk + c4);
}
template <bool WANT_BON> DI void prep_compute(const PrepRaw& R, const PrepPar& P, bool hp, PrepOut& O) {
    const u32x2 z2 = (u32x2){0u, 0u};
    const f32x4 r = lerp_u(R.zr, hp ? R.pr : z2, P.mur), k = lerp_u(R.zk, hp ? R.pk : z2, P.muk);
    O.v = lerp_u(R.zv, hp ? R.pv : z2, P.muv); O.r = r;
    const f32x4 w0v = P.w0, a0v = P.a0, kkv = P.kk, kav = P.ka;
    f32x4 wr; wr.x = w0v.x + bflo(R.lw.x); wr.y = w0v.y + bfhi(R.lw.x); wr.z = w0v.z + bflo(R.lw.y); wr.w = w0v.w + bfhi(R.lw.y);
    f32x4 ar; ar.x = a0v.x + bflo(R.la.x); ar.y = a0v.y + bfhi(R.la.x); ar.z = a0v.z + bflo(R.la.y); ar.w = a0v.w + bfhi(R.la.y);
    f32x4 a, kk;
#pragma unroll
    for (int q = 0; q < 4; ++q) { const float wl = -softplusf_(-wr[q]) - 0.5f; O.ld[q] = -__expf(wl); O.dec[q] = __expf(O.ld[q]); a[q] = sigmoidf_(ar[q]); kk[q] = k[q] * kkv[q]; O.kp[q] = k[q] * (1.f + (a[q] - 1.f) * kav[q]); }
    const float n2 = sum16(kk.x * kk.x + kk.y * kk.y + kk.z * kk.z + kk.w * kk.w);
    const float inv = __builtin_amdgcn_rsqf(fmaxf(n2, 1e-24f));
#pragma unroll
    for (int q = 0; q < 4; ++q) { const float kn = kk[q] * inv; O.bb[q] = kn * a[q]; O.nk[q] = -kn; }
    if (WANT_BON) { const f32x4 rk = P.rk; O.bon = sum16(r.x * O.kp.x * rk.x + r.y * O.kp.y * rk.y + r.z * O.kp.z * rk.z + r.w * O.kp.w * rk.w); }
}
#define LO2(v) ((f32x2){(v).x, (v).y})
#define HI2(v) ((f32x2){(v).z, (v).w})
constexpr int WRS = 144;
constexpr int W_SLOT = 64 * WRS;
enum { SL_NT = 0, SL_RT, SL_BH, SL_KH, SL_BHT, SL_KHT, SL_VT, SL_MK, SL_NB, SL_NK, SL_W1T, SL_U0T };
constexpr int W_MB = 12 * W_SLOT, W_CL = W_MB + 16384, W_PL = W_CL + 16384;
DI bf16x8 wfrag(LAS unsigned char* L, int slot, int row, int ks, int q) { return *(const LAS bf16x8*)(L + slot * W_SLOT + row * WRS + ks * 64 + q * 16); }
DI void wput(LAS unsigned char* L, int slot, int row, int col, float v) { *(LAS bf16_t*)(L + slot * W_SLOT + row * WRS + col * 2) = (bf16_t)(cvt_pk_bf16(v, 0.f) & 0xffffu); }
DI void scan_w1(const Ctx& F, const RwPar& Q, const bf16_t* z) {
    unsigned char* const wsl = F.ws; LAS unsigned char* L = F.lds;
    const int wave = F.wave;
    const bf16_t* LW = (const bf16_t*)(wsl + WS_LW);
    LAS float* MB = (LAS float*)(L + W_MB); LAS float* CL = (LAS float*)(L + W_CL); LAS float* PL = (LAS float*)(L + W_PL);
    PrepPar PN;
    PrepRaw RN[2];
    if (F.bid < 96 * NCH) { const int bh = F.bid % 96, c = F.bid / 96, b = bh / 24, head = bh - b * 24, tokb = b * SEQ + c * CH, c4 = head * 64 + 4 * (F.lane & 15);
#pragma unroll
        for (int p = 0; p < 2; ++p) prep_load(RN[p], z, LW, tokb + p * 32 + wave * 4 + (F.lane >> 4), c4);
        par_load(PN, Q, c4); }
    for (int u = F.bid; u < 96 * NCH; u += F.G) {
        int lane = F.lane; asm volatile("" : "+v"(lane));
        const int tq = lane >> 4, li = lane & 15, fr = li, fq = tq;
        const int bh = u % 96, c = u / 96, b = bh / 24, head = bh - b * 24, tokb = b * SEQ + c * CH, c4 = head * 64 + 4 * li;
        LDS_BARRIER();
        PrepOut O[2];
#pragma unroll
        for (int p = 0; p < 2; ++p) {
            const int t = p * 32 + wave * 4 + tq; const PrepRaw R = RN[p];
            prep_compute<true>(R, PN, ((tokb + t) & (SEQ - 1)) != 0, O[p]);
            *(LAS f32x4*)(CL + t * 64 + 4 * li) = O[p].ld;
            u32x2 e; e.x = cvt_pk_bf16(O[p].bon * O[p].v.x, O[p].bon * O[p].v.y); e.y = cvt_pk_bf16(O[p].bon * O[p].v.z, O[p].bon * O[p].v.w);
            *(GAS u32x2*)((bf16_t*)(wsl + WS_E) + (size_t)(tokb + t) * CMIX + c4) = e;
        }
        LDS_BARRIER();
        if (wave == 0) {
            float xs[64];
#pragma unroll
            for (int t = 0; t < 64; ++t) xs[t] = CL[t * 64 + lane];
#pragma unroll
            for (int t = 1; t < 64; ++t) xs[t] += xs[t - 1];
#pragma unroll
            for (int t = 0; t < 64; ++t) CL[t * 64 + lane] = xs[t];
        }
        LDS_BARRIER();
#pragma unroll
        for (int p = 0; p < 2; ++p) {
            const int t = p * 32 + wave * 4 + tq;
            const f32x4 cl = *(const LAS f32x4*)(CL + t * 64 + 4 * li);
            f32x4 clm = (f32x4){0.f, 0.f, 0.f, 0.f}; if (t > 0) clm = *(const LAS f32x4*)(CL + (t - 1) * 64 + 4 * li);
            f32x4 nt, rt, bh4, kh4;
#pragma unroll
            for (int q = 0; q < 4; ++q) { const float P = __expf(cl[q]), Pm = __expf(clm[q]), iP = __expf(-cl[q]);
                nt[q] = O[p].nk[q] * Pm; rt[q] = O[p].r[q] * P; bh4[q] = O[p].bb[q] * iP; kh4[q] = O[p].kp[q] * iP;
                if (t == 63) PL[4 * li + q] = P; }
            u32x2 w;
            w.x = cvt_pk_bf16(nt.x, nt.y); w.y = cvt_pk_bf16(nt.z, nt.w); *(LAS u32x2*)(L + SL_NT * W_SLOT + t * WRS + 8 * li) = w;
            w.x = cvt_pk_bf16(rt.x, rt.y); w.y = cvt_pk_bf16(rt.z, rt.w); *(LAS u32x2*)(L + SL_RT * W_SLOT + t * WRS + 8 * li) = w;
            w.x = cvt_pk_bf16(bh4.x, bh4.y); w.y = cvt_pk_bf16(bh4.z, bh4.w); *(LAS u32x2*)(L + SL_BH * W_SLOT + t * WRS + 8 * li) = w;
            w.x = cvt_pk_bf16(kh4.x, kh4.y); w.y = cvt_pk_bf16(kh4.z, kh4.w); *(LAS u32x2*)(L + SL_KH * W_SLOT + t * WRS + 8 * li) = w;
#pragma unroll
            for (int q = 0; q < 4; ++q) { wput(L, SL_BHT, 4 * li + q, t, bh4[q]); wput(L, SL_KHT, 4 * li + q, t, kh4[q]); wput(L, SL_VT, 4 * li + q, t, O[p].v[q]); }
        }
        LDS_BARRIER();
        for (int reps = 0; reps < REP_WS; ++reps) {
            const int mt = wave >> 1, slotA = (mt < 2) ? SL_NT : SL_RT, slotB = (mt & 1) ? SL_KH : SL_BH, slotO = (mt == 1) ? SL_MK : (mt == 2 ? SL_NB : SL_NK), tt0 = (wave & 1) * 2;
            bf16x8 Af[2][2], Bf[4][2];
#pragma unroll
            for (int a2 = 0; a2 < 2; ++a2)
#pragma unroll
                for (int ks = 0; ks < 2; ++ks) Af[a2][ks] = wfrag(L, slotA, 16 * (tt0 + a2) + fr, ks, fq);
#pragma unroll
            for (int ss = 0; ss < 4; ++ss)
#pragma unroll
                for (int ks = 0; ks < 2; ++ks) Bf[ss][ks] = wfrag(L, slotB, 16 * ss + fr, ks, fq);
            f32x4 acc[2][4];
#pragma unroll
            for (int a2 = 0; a2 < 2; ++a2)
#pragma unroll
                for (int ss = 0; ss < 4; ++ss) { acc[a2][ss] = (f32x4){0.f, 0.f, 0.f, 0.f};
                    if (ss <= tt0 + a2) {
#pragma unroll
                        for (int ks = 0; ks < 2; ++ks) acc[a2][ss] = __builtin_amdgcn_mfma_f32_16x16x32_bf16(Af[a2][ks], Bf[ss][ks], acc[a2][ss], 0, 0, 0); } }
#pragma unroll
            for (int a2 = 0; a2 < 2; ++a2)
#pragma unroll
                for (int ss = 0; ss < 4; ++ss) { const int tt = tt0 + a2, sc = 16 * ss + fr;
#pragma unroll
                    for (int r = 0; r < 4; ++r) { const int t = 16 * tt + 4 * fq + r; const bool keep = (mt < 2) ? (sc < t) : (sc <= t); const float val = keep ? acc[a2][ss][r] : 0.f;
                        if (mt == 0) MB[t * 64 + sc] = val; else wput(L, slotO, t, sc, val); } }
        }
        LDS_BARRIER();
        { const int t = F.tid >> 3, s0 = (F.tid & 7) * 8; const f32x4 a0 = *(const LAS f32x4*)(MB + t * 64 + s0), a1 = *(const LAS f32x4*)(MB + t * 64 + s0 + 4);
          u32x4 w; w.x = cvt_pk_bf16(a0.x, a0.y); w.y = cvt_pk_bf16(a0.z, a0.w); w.z = cvt_pk_bf16(a1.x, a1.y); w.w = cvt_pk_bf16(a1.z, a1.w);
          *(LAS u32x4*)(L + SL_BH * W_SLOT + t * WRS + s0 * 2) = w; }
#pragma unroll
        for (int k2 = 0; k2 < 2; ++k2) {
            const int tile = wave * 2 + k2, tt = tile >> 2, it = tile & 3;
            f32x4 acc = (f32x4){0.f, 0.f, 0.f, 0.f};
#pragma unroll
            for (int ks = 0; ks < 2; ++ks) acc = __builtin_amdgcn_mfma_f32_16x16x32_bf16(wfrag(L, SL_MK, 16 * tt + fr, ks, fq), wfrag(L, SL_VT, 16 * it + fr, ks, fq), acc, 0, 0, 0);
#pragma unroll
            for (int r = 0; r < 4; ++r) CL[(16 * tt + 4 * fq + r) * 64 + 16 * it + fr] = acc[r];
        }
        if (wave >= 4) {
            const int I = wave - 4;
            float d[16], xb[16];
#pragma unroll
            for (int r = 0; r < 16; ++r) d[r] = (r == lane) ? 1.f : 0.f;
            const LAS float* mbv = MB; asm volatile("" : "+v"(mbv));
            const LAS float* mb = mbv + (16 * I) * 64 + 16 * I;
            f32x4 A[8][2], Bm[8][2];
#pragma unroll
            for (int tt = 0; tt < 8; ++tt) { A[tt][0] = *(const LAS f32x4*)(mb + tt * 64); A[tt][1] = *(const LAS f32x4*)(mb + tt * 64 + 4); }
#pragma unroll
            for (int tt = 0; tt < 8; ++tt) { Bm[tt][0] = *(const LAS f32x4*)(mb + (8 + tt) * 64); Bm[tt][1] = *(const LAS f32x4*)(mb + (8 + tt) * 64 + 4); }
#pragma unroll
            for (int sx = 0; sx < 8; ++sx) { xb[sx] = d[sx];
#pragma unroll
                for (int tt = sx + 1; tt < 8; ++tt) d[tt] = fma_s(A[tt][sx >> 2][sx & 3], xb[sx], d[tt]); }
#pragma unroll
            for (int sx = 0; sx < 8; ++sx)
#pragma unroll
                for (int tt = 0; tt < 8; ++tt) d[8 + tt] = fma_s(Bm[tt][sx >> 2][sx & 3], xb[sx], d[8 + tt]);
            asm volatile("" : "+v"(d[8]), "+v"(d[15]) :: "memory");
#pragma unroll
            for (int tt = 0; tt < 8; ++tt) { A[tt][0] = *(const LAS f32x4*)(mb + (8 + tt) * 64 + 8); A[tt][1] = *(const LAS f32x4*)(mb + (8 + tt) * 64 + 12); }
#pragma unroll
            for (int sx = 0; sx < 8; ++sx) { xb[8 + sx] = d[8 + sx];
#pragma unroll
                for (int tt = sx + 1; tt < 8; ++tt) d[8 + tt] = fma_s(A[tt][sx >> 2][sx & 3], xb[8 + sx], d[8 + tt]); }
            if (lane < 16) {
#pragma unroll
                for (int t = 0; t < 16; ++t) *(LAS bf16_t*)(L + SL_KH * W_SLOT + (16 * I + t) * 48 + lane * 2) = (bf16_t)(cvt_pk_bf16(xb[t], 0.f) & 0xffffu);
            }
        }
        LDS_BARRIER();
        asm volatile("" ::: "memory");
        { const int un = u + F.G; if (un < 96 * NCH) { const int bhn = un % 96, cn = un / 96, bn = bhn / 24, headn = bhn - bn * 24, tokbn = bn * SEQ + cn * CH, c4n = headn * 64 + 4 * li;
#pragma unroll
            for (int p = 0; p < 2; ++p) prep_load(RN[p], z, LW, tokbn + p * 32 + wave * 4 + tq, c4n);
            par_load(PN, Q, c4n); } }
        for (int repx = 0; repx < REP_WX; ++repx) if (wave < 2) {
            const int slotX = wave == 0 ? SL_W1T : SL_U0T;
            LAS unsigned char* TI = L + SL_KH * W_SLOT;
            LAS unsigned char* DT = TI + 3072 + wave * 3072;
            const bf16x8 zf = (bf16x8){0, 0, 0, 0, 0, 0, 0, 0};
#pragma unroll
            for (int I = 0; I < 4; ++I) {
                f32x4 acc[4];
                if (wave == 0) {
#pragma unroll
                    for (int ct = 0; ct < 4; ++ct)
#pragma unroll
                        for (int r = 0; r < 4; ++r) acc[ct][r] = bf2f(*(const LAS bf16_t*)(L + SL_NT * W_SLOT + (16 * I + 4 * fq + r) * WRS + (16 * ct + fr) * 2));
                } else {
#pragma unroll
                    for (int ct = 0; ct < 4; ++ct)
#pragma unroll
                        for (int r = 0; r < 4; ++r) acc[ct][r] = CL[(16 * I + 4 * fq + r) * 64 + 16 * ct + fr];
                }
                if (I > 0) {
#pragma unroll
                    for (int ks = 0; ks < (I + 1) / 2; ++ks) {
                        const bool half = (32 * ks + 16 == 16 * I);
                        bf16x8 af = wfrag(L, SL_BH, 16 * I + fr, ks, fq);
                        if (half && fq >= 2) af = zf;
#pragma unroll
                        for (int ct = 0; ct < 4; ++ct) { bf16x8 bfr = wfrag(L, slotX, 16 * ct + fr, ks, fq);
                            if (half && fq >= 2) bfr = zf;
                            acc[ct] = __builtin_amdgcn_mfma_f32_16x16x32_bf16(af, bfr, acc[ct], 0, 0, 0); }
                    }
                }
#pragma unroll
                for (int ct = 0; ct < 4; ++ct) { u32x2 w; w.x = cvt_pk_bf16(acc[ct][0], acc[ct][1]); w.y = cvt_pk_bf16(acc[ct][2], acc[ct][3]); *(LAS u32x2*)(DT + (16 * ct + fr) * 48 + 8 * fq) = w; }
                LDS_WAIT();
                bf16x8 af = *(const LAS bf16x8*)(TI + (16 * I + fr) * 48 + (fq & 1) * 16); if (fq >= 2) af = zf;
#pragma unroll
                for (int ct = 0; ct < 4; ++ct) { bf16x8 bfr = *(const LAS bf16x8*)(DT + (16 * ct + fr) * 48 + (fq & 1) * 16); if (fq >= 2) bfr = zf;
                    const f32x4 x = __builtin_amdgcn_mfma_f32_16x16x32_bf16(af, bfr, (f32x4){0.f, 0.f, 0.f, 0.f}, 0, 0, 0);
                    u32x2 w; w.x = cvt_pk_bf16(x[0], x[1]); w.y = cvt_pk_bf16(x[2], x[3]); *(LAS u32x2*)(L + slotX * W_SLOT + (16 * ct + fr) * WRS + (16 * I + 4 * fq) * 2) = w; }
                LDS_WAIT();
            }
        }
        LDS_BARRIER();
        for (int repo = 0; repo < REP_WO; ++repo) {
            const int kind = wave >> 1, ta0 = (wave & 1) * 2;
            float* gp = gh_ptr(wsl, bh, c, 0); float* hp = gh_ptr(wsl, bh, c, 1);
            bf16_t* qy = (bf16_t*)(wsl + WS_QY) + (size_t)u * 4096; float* y0t = (float*)(wsl + WS_Y0T) + (size_t)u * 4096;
            const int sA1 = kind == 0 ? SL_W1T : kind == 1 ? SL_BHT : kind == 2 ? SL_W1T : SL_NK, sB1 = kind == 0 ? SL_BHT : kind == 1 ? SL_U0T : kind == 2 ? SL_NB : SL_VT;
            const int sA2 = kind == 1 ? SL_KHT : SL_NB, sB2 = kind == 1 ? SL_VT : SL_U0T; const bool two = (kind & 1) != 0;
            bf16x8 Af[2][2], Bf[4][2];
#pragma unroll
            for (int a2 = 0; a2 < 2; ++a2)
#pragma unroll
                for (int ks = 0; ks < 2; ++ks) Af[a2][ks] = wfrag(L, sA1, 16 * (ta0 + a2) + fr, ks, fq);
#pragma unroll
            for (int tb = 0; tb < 4; ++tb)
#pragma unroll
                for (int ks = 0; ks < 2; ++ks) Bf[tb][ks] = wfrag(L, sB1, 16 * tb + fr, ks, fq);
            f32x4 acc[2][4];
#pragma unroll
            for (int a2 = 0; a2 < 2; ++a2)
#pragma unroll
                for (int tb = 0; tb < 4; ++tb) { acc[a2][tb] = (f32x4){0.f, 0.f, 0.f, 0.f};
#pragma unroll
                    for (int ks = 0; ks < 2; ++ks) acc[a2][tb] = __builtin_amdgcn_mfma_f32_16x16x32_bf16(Af[a2][ks], Bf[tb][ks], acc[a2][tb], 0, 0, 0); }
            if (two) {
#pragma unroll
                for (int a2 = 0; a2 < 2; ++a2)
#pragma unroll
                    for (int ks = 0; ks < 2; ++ks) Af[a2][ks] = wfrag(L, sA2, 16 * (ta0 + a2) + fr, ks, fq);
#pragma unroll
                for (int tb = 0; tb < 4; ++tb)
#pragma unroll
                    for (int ks = 0; ks < 2; ++ks) Bf[tb][ks] = wfrag(L, sB2, 16 * tb + fr, ks, fq);
#pragma unroll
                for (int a2 = 0; a2 < 2; ++a2)
#pragma unroll
                    for (int tb = 0; tb < 4; ++tb)
#pragma unroll
                        for (int ks = 0; ks < 2; ++ks) acc[a2][tb] = __builtin_amdgcn_mfma_f32_16x16x32_bf16(Af[a2][ks], Bf[tb][ks], acc[a2][tb], 0, 0, 0);
            }
#pragma unroll
            for (int a2 = 0; a2 < 2; ++a2)
#pragma unroll
                for (int tb = 0; tb < 4; ++tb) { const int ta = ta0 + a2; const f32x4 av = acc[a2][tb];
                    if (kind == 0) {
                        const int j = 16 * tb + fr; const float pl = PL[j];
                        f32x4 o;
#pragma unroll
                        for (int r = 0; r < 4; ++r) o[r] = pl * (av[r] + ((16 * ta + 4 * fq + r) == j ? 1.f : 0.f));
                        u32x2 w; w.x = cvt_pk_bf16(o[0], o[1]); w.y = cvt_pk_bf16(o[2], o[3]);
                        *(GAS u32x2*)((bf16_t*)gp + j * 64 + 16 * ta + 4 * fq) = w;
                    } else if (kind == 1) {
                        const f32x4 pl = *(const LAS f32x4*)(PL + 16 * ta + 4 * fq);
                        *(GAS f32x4*)(hp + (16 * tb + fr) * 64 + 16 * ta + 4 * fq) = pl * av;
                    } else if (kind == 2) {
                        const int t = 16 * tb + fr; const u32x2 rr = *(const LAS u32x2*)(L + SL_RT * W_SLOT + t * WRS + (16 * ta + 4 * fq) * 2);
                        u32x2 w; w.x = cvt_pk_bf16(av[0] + bflo(rr.x), av[1] + bfhi(rr.x)); w.y = cvt_pk_bf16(av[2] + bflo(rr.y), av[3] + bfhi(rr.y));
                        *(GAS u32x2*)(qy + t * 64 + 16 * ta + 4 * fq) = w;
                    } else {
                        *(GAS f32x4*)(y0t + (16 * tb + fr) * 64 + 16 * ta + 4 * fq) = av;
                    }
                }
        }
    }
    LDS_BARRIER();
}
DI void scan_w2(const Ctx& F, const RwPar& Q) {
    unsigned char* const wsl = F.ws; const int lane = F.lane, fr = lane & 15, fq = lane >> 4;
    LAS float* yb = (LAS float*)(F.lds + F.wave * 16384);
    const bf16_t* gate = (const bf16_t*)(wsl + WS_GATE); const bf16_t* Eb = (const bf16_t*)(wsl + WS_E); bf16_t* cat = (bf16_t*)(wsl + WS_CAT);
    for (int u = F.gw; u < 96 * NCH; u += F.ngw) {
        const int bh = u % 96, c = u / 96, b = bh / 24, head = bh - b * 24, tokb = b * SEQ + c * CH;
        const bf16_t* qy = (const bf16_t*)(wsl + WS_QY) + (size_t)u * 4096; const float* y0t = (const float*)(wsl + WS_Y0T) + (size_t)u * 4096;
        f32x4 acc[4][4];
#pragma unroll
        for (int tt = 0; tt < 4; ++tt)
#pragma unroll
            for (int it = 0; it < 4; ++it) acc[tt][it] = *(const GAS f32x4*)(y0t + (16 * it + fr) * 64 + 16 * tt + 4 * fq);
        if (c > 0) {
            const bf16_t* sp = (const bf16_t*)gh_ptr(wsl, bh, c - 1, 0) + 4096;
            bf16x8 Bf[4][2];
#pragma unroll
            for (int it = 0; it < 4; ++it)
#pragma unroll
                for (int ks = 0; ks < 2; ++ks) Bf[it][ks] = *(const GAS bf16x8*)(sp + (16 * it + fr) * 64 + 32 * ks + 8 * fq);
#pragma unroll
            for (int tt = 0; tt < 4; ++tt)
#pragma unroll
                for (int ks = 0; ks < 2; ++ks) { const bf16x8 Af = *(const GAS bf16x8*)(qy + (16 * tt + fr) * 64 + 32 * ks + 8 * fq);
#pragma unroll
                    for (int it = 0; it < 4; ++it) acc[tt][it] = __builtin_amdgcn_mfma_f32_16x16x32_bf16(Af, Bf[it][ks], acc[tt][it], 0, 0, 0); }
        }
#pragma unroll
        for (int tt = 0; tt < 4; ++tt)
#pragma unroll
            for (int it = 0; it < 4; ++it)
#pragma unroll
                for (int r = 0; r < 4; ++r) yb[(16 * tt + 4 * fq + r) * 64 + 16 * it + fr] = acc[tt][it][r];
        LDS_WAIT();
#pragma unroll 4
        for (int k = 0; k < 16; ++k) {
            const int slot = k * 64 + lane, t = slot >> 4, li = slot & 15, c4 = head * 64 + 4 * li, tok = tokb + t;
            const f32x4 y = *(const LAS f32x4*)(yb + t * 64 + 4 * li);
            const u32x2 ev = *(const GAS u32x2*)(Eb + (size_t)tok * CMIX + c4), gt = *(const GAS u32x2*)(gate + (size_t)tok * CMIX + c4);
            const float mean = sum16(y.x + y.y + y.z + y.w) * (1.f / 64.f);
            const f32x4 d = y - mean;
            const float var = sum16(d.x * d.x + d.y * d.y + d.z * d.z + d.w * d.w) * (1.f / 64.f);
            const float rstd = rsqrtf(var + GN_EPS);
            const f32x4 g4 = *(const GAS f32x4*)(Q.gng + c4), b4 = *(const GAS f32x4*)(Q.gnb + c4);
            f32x4 o = d * rstd * g4 + b4; o.x += bflo(ev.x); o.y += bfhi(ev.x); o.z += bflo(ev.y); o.w += bfhi(ev.y);
            u32x2 w; w.x = cvt_pk_bf16(o.x * bflo(gt.x), o.y * bfhi(gt.x)); w.y = cvt_pk_bf16(o.z * bflo(gt.y), o.w * bfhi(gt.y));
            *(GAS u32x2*)(cat + (size_t)tok * DM + c4) = w;
        }
        LDS_WAIT();
    }
}
DI void scan_passB(const Ctx& F) {
    unsigned char* const wsl = F.ws; const int lane = F.lane, fr = lane & 15, fq = lane >> 4, ih = F.wave >> 2, q = F.wave & 3, bh = F.bid;
    LAS unsigned char* Sx0 = F.lds;
    bf16x8 ga[7][2]; f32x4 hq[7][2];
#define PB_LOAD(set, cc) do { const GAS bf16_t* _gp = (const GAS bf16_t*)gh_ptr(wsl, bh, (cc), 0) + (16 * q + fr) * 64 + 8 * fq; const GAS float* _hp = (const GAS float*)(gh_ptr(wsl, bh, (cc), 1) + (32 * ih + fr) * 64 + 16 * q + 4 * fq); \
        ga[set][0] = *(const GAS bf16x8*)_gp; ga[set][1] = *(const GAS bf16x8*)(_gp + 32); \
        _Pragma("unroll") for (int _r = 0; _r < 2; ++_r) hq[set][_r] = *(const GAS f32x4*)(_hp + (16 * _r) * 64); } while (0)
    PB_LOAD(0, 0); PB_LOAD(1, 1); PB_LOAD(2, 2); PB_LOAD(3, 3); PB_LOAD(4, 4); PB_LOAD(5, 5);
    for (int c7 = 0; c7 < NCH - 1; c7 += 7) {
#pragma unroll
        for (int u7 = 0; u7 < 7; ++u7) {
            const int c = c7 + u7;
            f32x4 acc[2];
#pragma unroll
            for (int it = 0; it < 2; ++it) acc[it] = hq[u7][it];
            const bf16x8 a0 = ga[u7][0], a1 = ga[u7][1];
            PB_LOAD((u7 + 6) % 7, (c + 6 < NCH - 1) ? c + 6 : NCH - 2);
            if (c > 0) {
#pragma unroll
                for (int it = 0; it < 2; ++it) {
                    acc[it] = __builtin_amdgcn_mfma_f32_16x16x32_bf16(a0, *(const LAS bf16x8*)(Sx0 + (c & 1) * W_SLOT + (32 * ih + 16 * it + fr) * WRS + fq * 16), acc[it], 0, 0, 0);
                    acc[it] = __builtin_amdgcn_mfma_f32_16x16x32_bf16(a1, *(const LAS bf16x8*)(Sx0 + (c & 1) * W_SLOT + (32 * ih + 16 * it + fr) * WRS + 64 + fq * 16), acc[it], 0, 0, 0); }
            }
            GAS bf16_t* op = (GAS bf16_t*)gh_ptr(wsl, bh, c, 0) + 4096 + (32 * ih + fr) * 64 + 16 * q + 4 * fq;
#pragma unroll
            for (int it = 0; it < 2; ++it) { u32x2 w; w.x = cvt_pk_bf16(acc[it].x, acc[it].y); w.y = cvt_pk_bf16(acc[it].z, acc[it].w);
                *(GAS u32x2*)(op + (16 * it) * 64) = w; *(LAS u32x2*)(Sx0 + ((c + 1) & 1) * W_SLOT + (32 * ih + 16 * it + fr) * WRS + (16 * q + 4 * fq) * 2) = w; }
            LDS_BARRIER();
        }
    }
#undef PB_LOAD
}

DI void ln1_router(const Ctx& F, const Params& P, int l, const float* xin) {
    unsigned char* const wsl = F.ws; float* const outl = F.out; (void)outl;
    const float* g = PIN(5) + (size_t)l * DM; const float* bta = PIN(6) + (size_t)l * DM;
    const float* gb = PIN(10) + l * 4; const float* eb = PIN(12) + l * 32;
    const bf16_t* hb = (const bf16_t*)(wsl + WS_HB); bf16_t* xb = (bf16_t*)(wsl + WS_XB); float* xo = outl;
    const bf16_t* wrt = (const bf16_t*)(wsl + WS_WSW + (size_t)l * WSW_STRIDE);
    unsigned* cnt = (unsigned*)(wsl + WS_CTL) + CW_CNT + l * 32 * 64;
    int* ltok = (int*)(wsl + WS_LTOK); float* lgate = (float*)(wsl + WS_LGATE); int* lslot = (int*)(wsl + WS_LSLOT);
    const int lane = F.lane, fr = lane & 15, fq = lane >> 4, wave = F.wave;
    LAS float* lg = (LAS float*)(F.lds + (wave & 3) * 4096);
    LAS float* lgp = (LAS float*)(F.lds + 16384 + (wave & 3) * 4096);
    LAS int* cntl = (LAS int*)(F.lds + 32768); LAS int* basel = cntl + 32;
    if (F.tid < NEXP) cntl[F.tid] = 0;
    __syncthreads();
    for (int blk = F.bid; blk < NTOK / 64; blk += F.G) {
#pragma unroll 1
        for (int pass = 0; pass < 4; ++pass) {
            int lno = lane; asm volatile("" : "+v"(lno));
            const int hr2 = lno >> 5, l32 = lno & 31;
            const size_t ro = (size_t)(blk * 64 + wave * 8 + pass * 2 + hr2) * DM + 8 * l32;
            u32x4 xr[8], hr[8];
#pragma unroll
            for (int i = 0; i < 8; ++i) { xr[i] = *(const GAS u32x4*)(xb + ro + 256 * i); hr[i] = *(const GAS u32x4*)(hb + ro + 256 * i); }
            float s = 0.f, s2 = 0.f;
#pragma unroll
            for (int i = 0; i < 8; ++i) {
#pragma unroll
                for (int e = 0; e < 4; ++e) { const float v0 = ALPHA * bflo(xr[i][e]) + bflo(hr[i][e]), v1 = ALPHA * bfhi(xr[i][e]) + bfhi(hr[i][e]); s += v0 + v1; s2 += v0 * v0 + v1 * v1; } }
            s = sum16(s); s2 = sum16(s2); s += __shfl_xor(s, 16); s2 += __shfl_xor(s2, 16);
            const float mean = s * (1.f / DM), rstd = rsqrtf(fmaxf(s2 * (1.f / DM) - mean * mean, 0.f) + LN_EPS);
#pragma unroll
            for (int i = 0; i < 8; ++i) { const int col = 256 * i + 8 * l32;
                const f32x4 g0 = *(const GAS f32x4*)(g + col), g1 = *(const GAS f32x4*)(g + col + 4), b0 = *(const GAS f32x4*)(bta + col), b1 = *(const GAS f32x4*)(bta + col + 4);
                u32x4 w;
#pragma unroll
                for (int e = 0; e < 4; ++e) { const float v0 = ALPHA * bflo(xr[i][e]) + bflo(hr[i][e]), v1 = ALPHA * bfhi(xr[i][e]) + bfhi(hr[i][e]);
                    const float gg0 = e < 2 ? g0[2 * e] : g1[2 * e - 4], gg1 = e < 2 ? g0[2 * e + 1] : g1[2 * e - 3], bb0 = e < 2 ? b0[2 * e] : b1[2 * e - 4], bb1 = e < 2 ? b0[2 * e + 1] : b1[2 * e - 3];
                    w[e] = cvt_pk_bf16((v0 - mean) * rstd * gg0 + bb0, (v1 - mean) * rstd * gg1 + bb1); }
                *(GAS u32x4*)(xb + ro + 256 * i) = w;
                asm volatile("" ::: "memory"); }
        }
        VM_WAIT();
        __syncthreads();
        __builtin_amdgcn_fence(__ATOMIC_ACQUIRE, "agent");
        VM_WAIT();
        const int row0 = blk * 64 + (wave & 3) * 16, kh = wave >> 2, krot = (F.bid * 5 + wave * 3) & 31;
        f32x4 acc[3];
#pragma unroll
        for (int ct = 0; ct < 3; ++ct) acc[ct] = (f32x4){0.f, 0.f, 0.f, 0.f};
        const bf16_t* arow = xb + (size_t)(row0 + fr) * DM + 8 * fq + kh * 1024;
        LAS unsigned char* wst = F.lds + 36864;
        u32x4 wreg[6];
        { const int st = F.bid & 7;
#pragma unroll
          for (int i = 0; i < 6; ++i) { const int ch = F.tid + NT * i, row = ch >> 4, c16 = ch & 15, rkh = row / 96, rr = row - rkh * 96;
              wreg[i] = *(const GAS u32x4*)(wrt + (size_t)rr * DM + rkh * 1024 + st * 128 + c16 * 8); } }
#pragma unroll 1
        for (int si = 0; si < 8; ++si) {
            const int st = (si + F.bid) & 7;
            LAS unsigned char* wb = wst + (si & 1) * 52224;
#pragma unroll
            for (int i = 0; i < 6; ++i) { const int ch = F.tid + NT * i, row = ch >> 4, c16 = ch & 15; *(LAS u32x4*)(wb + row * 272 + c16 * 16) = wreg[i]; }
            if (si + 1 < 8) { const int stn = (si + 1 + F.bid) & 7;
#pragma unroll
                for (int i = 0; i < 6; ++i) { const int ch = F.tid + NT * i, row = ch >> 4, c16 = ch & 15, rkh = row / 96, rr = row - rkh * 96;
                    wreg[i] = *(const GAS u32x4*)(wrt + (size_t)rr * DM + rkh * 1024 + stn * 128 + c16 * 8); } }
            bf16x8 af[4];
#pragma unroll
            for (int ksl = 0; ksl < 4; ++ksl) af[ksl] = *(const GAS bf16x8*)(arow + st * 128 + ksl * 32);
            LDS_BARRIER();
#pragma unroll
            for (int ksl = 0; ksl < 4; ++ksl)
#pragma unroll
                for (int ct = 0; ct < 3; ++ct) {
                    acc[ct] = __builtin_amdgcn_mfma_f32_16x16x32_bf16(af[ksl], *(const LAS bf16x8*)(wb + (kh * 96 + 16 * ct + fr) * 272 + ksl * 64 + fq * 16), acc[ct], 0, 0, 0);
                    acc[ct] = __builtin_amdgcn_mfma_f32_16x16x32_bf16(af[ksl], *(const LAS bf16x8*)(wb + (kh * 96 + 48 + 16 * ct + fr) * 272 + ksl * 64 + fq * 16), acc[ct], 0, 0, 0);
                }
        }
        if (kh == 1) {
#pragma unroll
            for (int ct = 0; ct < 3; ++ct)
#pragma unroll
                for (int jj = 0; jj < 4; ++jj) lgp[(4 * fq + jj) * 48 + 16 * ct + fr] = acc[ct][jj];
        }
        __syncthreads();
        if (kh == 0) {
#pragma unroll
            for (int ct = 0; ct < 3; ++ct)
#pragma unroll
                for (int jj = 0; jj < 4; ++jj) lg[(4 * fq + jj) * 48 + 16 * ct + fr] = acc[ct][jj] + lgp[(4 * fq + jj) * 48 + 16 * ct + fr];
        }
        LDS_WAIT();
        int se0 = 0, se1 = 0, sr0 = 0, sr1 = 0, stok = 0; float sg0 = 0.f, sg1 = 0.f;
        if (kh == 0 && lane < 16) {
            const LAS float* L = lg + lane * 48; const int tok = row0 + lane;
            float gl[4]; int grp_i = 0; float gmx;
#pragma unroll
            for (int q = 0; q < 4; ++q) gl[q] = L[q] + gb[q];
            gmx = gl[0];
#pragma unroll
            for (int q = 1; q < 4; ++q) if (gl[q] > gmx) { gmx = gl[q]; grp_i = q; }
            float gs = 0.f;
#pragma unroll
            for (int q = 0; q < 4; ++q) gs += __expf(gl[q] - gmx);
            const float pg = 1.f / gs;
            float el[8];
#pragma unroll
            for (int q = 0; q < 8; ++q) el[q] = L[4 + 8 * grp_i + q] + eb[8 * grp_i + q];
            int i0 = 0; float m0 = el[0];
#pragma unroll
            for (int q = 1; q < 8; ++q) if (el[q] > m0) { m0 = el[q]; i0 = q; }
            int i1 = -1; float m1 = -3.0e38f;
#pragma unroll
            for (int q = 0; q < 8; ++q) if (q != i0 && el[q] > m1) { m1 = el[q]; i1 = q; }
            if (i1 < 0) { i1 = (i0 == 0) ? 1 : 0; m1 = m0; }
            const float p1 = __expf(m1 - m0), den = 1.f / (1.f + p1);
            const float g0 = pg * den, g1 = pg * p1 * den;
            se0 = grp_i * 8 + i0; se1 = grp_i * 8 + i1; sg0 = g0; sg1 = g1; stok = tok;
            sr0 = __hip_atomic_fetch_add(cntl + se0, 1, __ATOMIC_RELAXED, __HIP_MEMORY_SCOPE_WORKGROUP);
            sr1 = __hip_atomic_fetch_add(cntl + se1, 1, __ATOMIC_RELAXED, __HIP_MEMORY_SCOPE_WORKGROUP);
        }
        __syncthreads();
        if (wave == 0 && lane < NEXP) { const int n = cntl[lane]; basel[lane] = n ? (int)__hip_atomic_fetch_add(cnt + lane * 64, (unsigned)n, __ATOMIC_RELAXED, __HIP_MEMORY_SCOPE_AGENT) : 0; }
        __syncthreads();
        if (kh == 0 && lane < 16) {
            const int pos0 = basel[se0] + sr0, pos1 = basel[se1] + sr1;
            ltok[se0 * LISTCAP + pos0] = stok; lgate[se0 * LISTCAP + pos0] = sg0; lslot[se0 * LISTCAP + pos0] = 2 * stok;
            ltok[se1 * LISTCAP + pos1] = stok; lgate[se1 * LISTCAP + pos1] = sg1; lslot[se1 * LISTCAP + pos1] = 2 * stok + 1;
        }
        __syncthreads();
        if (F.tid < NEXP) cntl[F.tid] = 0;
        __syncthreads();
    }
}

DI void ln2_phase(const Ctx& F, const Params& P, int l) {
    unsigned char* const wsl = F.ws; float* const outl = F.out;
    const float* g = PIN(7) + (size_t)l * DM; const float* bta = PIN(8) + (size_t)l * DM;
    const bf16_t* ys = (const bf16_t*)(wsl + WS_YS); bf16_t* xb = (bf16_t*)(wsl + WS_XB); float* xo = outl;
#pragma unroll 1
    for (int rp = F.gw; rp < NTOK / 2; rp += F.ngw) {
        int lno = F.lane; asm volatile("" : "+v"(lno));
        const int hr2 = lno >> 5, l32 = lno & 31, row = 2 * rp + hr2;
        const size_t ro = (size_t)row * DM + 8 * l32;
        u32x4 xr[8], y0[8], y1[8];
#pragma unroll
        for (int i = 0; i < 8; ++i) { xr[i] = *(const GAS u32x4*)(xb + ro + 256 * i); y0[i] = *(const GAS u32x4*)(ys + 2 * (size_t)row * DM + 8 * l32 + 256 * i); y1[i] = *(const GAS u32x4*)(ys + (2 * (size_t)row + 1) * DM + 8 * l32 + 256 * i); }
        float s = 0.f, s2 = 0.f;
#pragma unroll
        for (int i = 0; i < 8; ++i) {
#pragma unroll
            for (int e = 0; e < 4; ++e) { const float v0 = ALPHA * bflo(xr[i][e]) + (bflo(y0[i][e]) + bflo(y1[i][e])), v1 = ALPHA * bfhi(xr[i][e]) + (bfhi(y0[i][e]) + bfhi(y1[i][e])); s += v0 + v1; s2 += v0 * v0 + v1 * v1; } }
        s = sum16(s); s2 = sum16(s2); s += __shfl_xor(s, 16); s2 += __shfl_xor(s2, 16);
        const float mean = s * (1.f / DM), rstd = rsqrtf(fmaxf(s2 * (1.f / DM) - mean * mean, 0.f) + LN_EPS);
#pragma unroll
        for (int i = 0; i < 8; ++i) { const int col = 256 * i + 8 * l32;
            const f32x4 g0 = *(const GAS f32x4*)(g + col), g1 = *(const GAS f32x4*)(g + col + 4), b0 = *(const GAS f32x4*)(bta + col), b1 = *(const GAS f32x4*)(bta + col + 4);
            float o[8];
#pragma unroll
            for (int e = 0; e < 4; ++e) { const float v0 = ALPHA * bflo(xr[i][e]) + (bflo(y0[i][e]) + bflo(y1[i][e])), v1 = ALPHA * bfhi(xr[i][e]) + (bfhi(y0[i][e]) + bfhi(y1[i][e]));
                const float gg0 = e < 2 ? g0[2 * e] : g1[2 * e - 4], gg1 = e < 2 ? g0[2 * e + 1] : g1[2 * e - 3], bb0 = e < 2 ? b0[2 * e] : b1[2 * e - 4], bb1 = e < 2 ? b0[2 * e + 1] : b1[2 * e - 3];
                o[2 * e] = (v0 - mean) * rstd * gg0 + bb0; o[2 * e + 1] = (v1 - mean) * rstd * gg1 + bb1; }
            if (l == NLAYER - 1) { *(GAS f32x4*)(xo + (size_t)row * DM + col) = (f32x4){o[0], o[1], o[2], o[3]}; *(GAS f32x4*)(xo + (size_t)row * DM + col + 4) = (f32x4){o[4], o[5], o[6], o[7]}; }
            else { u32x4 w; w.x = cvt_pk_bf16(o[0], o[1]); w.y = cvt_pk_bf16(o[2], o[3]); w.z = cvt_pk_bf16(o[4], o[5]); w.w = cvt_pk_bf16(o[6], o[7]); *(GAS u32x4*)(xb + ro + 256 * i) = w; }
            asm volatile("" ::: "memory"); }
    }
}

DI int moe_table(const Ctx& F, int l) {
    unsigned char* const wsl = F.ws; float* const outl = F.out; (void)outl;
    LAS int* tb = (LAS int*)(F.lds + LDS_CTL_OFF) + 16;
    const unsigned* cnt = (const unsigned*)(wsl + WS_CTL) + CW_CNT + l * 32 * 64;
    __syncthreads();
    if (F.tid == 0) { int acc = 0;
        for (int e = 0; e < NEXP; ++e) { tb[e] = acc; const int n = (int)__hip_atomic_load(cnt + e * 64, __ATOMIC_RELAXED, __HIP_MEMORY_SCOPE_AGENT); acc += (n + 255) >> 8; }
        tb[NEXP] = acc; }
    __syncthreads();
    return tb[NEXP];
}


#ifdef MK_DEBUG
constexpr int CW_DBG = 40960;
DI void dbg_count_bf16(const Ctx& F, const bf16_t* p, size_t n, int k) {
    unsigned bad = 0; const size_t gt = (size_t)F.bid * NT + F.tid, ngt = (size_t)F.G * NT;
    for (size_t i = gt; i < n; i += ngt) { const unsigned b = p[i]; const float v = bf2f(b); if ((b & 0x7f80u) == 0x7f80u || fabsf(v) > 1.0e6f) ++bad; }
    if (bad) atomicAdd((unsigned*)(F.ws + WS_CTL) + CW_DBG + k * 64, bad);
}
DI void dbg_count_f32(const Ctx& F, const float* p, size_t n, int k) {
    unsigned bad = 0; const size_t gt = (size_t)F.bid * NT + F.tid, ngt = (size_t)F.G * NT;
    for (size_t i = gt; i < n; i += ngt) { const float v = p[i]; if (!(fabsf(v) <= 1.0e6f)) ++bad; }
    if (bad) atomicAdd((unsigned*)(F.ws + WS_CTL) + CW_DBG + k * 64, bad);
}
#endif
constexpr int PH_PER_LAYER = 11, N_PHASES = 1 + NLAYER * PH_PER_LAYER;

__global__ void __launch_bounds__(NT, 2) mega_fwd(Params P) {
    extern __shared__ __attribute__((aligned(16))) unsigned char lds_raw[];
    Ctx F0;
    F0.lds = (LAS unsigned char*)lds_raw;
    F0.tid = threadIdx.x; F0.lane = F0.tid & 63; F0.wave = __builtin_amdgcn_readfirstlane(F0.tid >> 6);
    F0.G = gridDim.x; F0.bid = blockIdx.x; F0.gw = F0.bid * NWAVES + F0.wave; F0.ngw = F0.G * NWAVES;
    F0.ws = P.ws; F0.out = P.out;
    for (int u = F0.tid; u < (LDS_BYTES - LDS_CTL_OFF) / 4; u += NT) ((LAS unsigned*)(F0.lds + LDS_CTL_OFF))[u] = 0u;
    __syncthreads();
    XcdBarrier bar; bar.bar = (unsigned*)(F0.ws + WS_CTL) + CW_BAR; bar.x = 0; bar.st = nullptr;
#if !MK_PER_PHASE
    bar = xcd_barrier_post((unsigned*)(F0.ws + WS_CTL) + CW_BAR, (volatile LAS unsigned*)(F0.lds + LDS_CTL_OFF));
#endif
    const int lo = P.ph_lo, hi = P.ph_hi;
#define IN(k) (lo <= (k) && (k) < hi)
#if MK_PER_PHASE
#define SEAM(k) do { } while (0)
#else
#define SEAM(k) do { if ((k) + 1 < hi) { XcdBarrier _b = bar; asm volatile("" : "+s"(_b.bar), "+s"(_b.x)); xcd_barrier(_b); } } while (0)
#endif
#define WSL const Ctx F = relaunder(F0); unsigned char* const ws = F.ws; bf16_t* const xb = (bf16_t*)(ws + WS_XB); bf16_t* const zb = (bf16_t*)(ws + WS_Z); bf16_t* const cat = (bf16_t*)(ws + WS_CAT); (void)xb; (void)zb; (void)cat

    if (IN(0)) { WSL; phase_prologue(F, P); SEAM(0); }

    for (int l = 0; l < NLAYER; ++l) {
        const int kind = l % 3, j = l / 3, pb = 1 + l * PH_PER_LAYER;
        const int zw = (kind == 0) ? ZW_RWKV : ZW_OTH, qcol = (kind == 0) ? 5056 : 4608;
        if (IN(pb + 0)) {
            WSL; const bf16_t* winT = (const bf16_t*)(ws + WS_WIN + (size_t)l * WIN_STRIDE);
            if (kind != 2) dense_gemm(F, xb, DM, winT, DM, NTOK, zw, DM, zb, zw, 0);
            else {
                dense_gemm(F, xb, DM, winT, DM, NTOK, 3072, DM, zb, zw, 0);
                dense_gemm(F, xb, DM, winT + (size_t)4608 * DM, DM, NTOK, 512, DM, zb + 4608, zw, 0);
                dense_gemm(F, winT + (size_t)3072 * DM, DM, xb, DM, CMIX, NTOK, DM, (bf16_t*)(ws + WS_ACT), NTOK, 128);
            }
            if (l == 0) {
                dense_gemm(F, (const bf16_t*)(ws + WS_MEMB), DM, (const bf16_t*)(ws + WS_WK), DM, NBATCH * MEML, 2048, DM, (bf16_t*)(ws + WS_KM), 2048, 128);
                dense_gemm(F, (const bf16_t*)(ws + WS_WV), DM, (const bf16_t*)(ws + WS_MEMB), DM, 2048, NBATCH * MEML, DM, (bf16_t*)(ws + WS_VMT), 1024, 192);
            }
            SEAM(pb + 0);
        }
        if (IN(pb + 1)) {
            WSL;
            if (kind == 0) { for (int rep = 0; rep < REP_PREP; ++rep) rwkv_prep1(F, P, j, zb); for (int rep = 0; rep < REP_MIX * REP_MA; ++rep) memattn_all(F, l, zb, zw, qcol); }
            else if (kind == 1) { for (int rep = 0; rep < REP_MIX; ++rep) conv_mix(F, P, zb); for (int rep = 0; rep < REP_MIX * REP_MA; ++rep) memattn_all(F, l, zb, zw, qcol); for (int rep = 0; rep < REP_CONV; ++rep) expert_convert(F, P, l, F.gw, F.ngw); }
            else { for (int rep = 0; rep < REP_MIX * REP_SB; ++rep) sb_attention(F, zb); for (int rep = 0; rep < REP_MIX * REP_MA; ++rep) memattn_all(F, l, zb, zw, qcol); for (int rep = 0; rep < REP_CONV; ++rep) expert_convert(F, P, l, F.gw, F.ngw); }
            SEAM(pb + 1);
        }
        if (kind == 0) {
            if (IN(pb + 2)) {
                WSL; const bf16_t* act = (const bf16_t*)(ws + WS_ACT); const bf16_t* wa = (const bf16_t*)(ws + WS_LORA + (size_t)j * LORA_STRIDE);
                dense_gemm(F, act, 512, wa, 256, NTOK, 3072, 256, (bf16_t*)(ws + WS_LW), 3072, 0);
                dense_gemm(F, act + 256, 512, wa + (size_t)3072 * 256, 256, NTOK, CMIX, 256, (bf16_t*)(ws + WS_GATE), CMIX, 0);
                SEAM(pb + 2);
            }
            if (IN(pb + 3)) { WSL; const RwPar Q{PIN(17) + (size_t)j * 5056, PIN(18) + j * CMIX, PIN(20) + j * CMIX, PIN(23) + j * CMIX, PIN(24) + j * CMIX, PIN(25) + j * CMIX, PIN(26) + j * CMIX, PIN(27) + j * CMIX};
                for (int rep = 0; rep < REP_SCAN; ++rep) scan_w1(F, Q, zb); SEAM(pb + 3); }
            if (IN(pb + 4)) {
                WSL;
                if (F.bid < 96) scan_passB(F);
                else expert_convert(F, P, l, (F.bid - 96) * NWAVES + F.wave, (F.G - 96) * NWAVES);
                SEAM(pb + 4);
            }
            if (IN(pb + 5)) { WSL; const RwPar Q{PIN(17) + (size_t)j * 5056, PIN(18) + j * CMIX, PIN(20) + j * CMIX, PIN(23) + j * CMIX, PIN(24) + j * CMIX, PIN(25) + j * CMIX, PIN(26) + j * CMIX, PIN(27) + j * CMIX};
                for (int rep = 0; rep < REP_SCAN * REP_W2; ++rep) scan_w2(F, Q); SEAM(pb + 5); }
        }
        if (IN(pb + 6)) { WSL; dense_gemm(F, cat, DM, (const bf16_t*)(ws + WS_WOUT) + (size_t)l * DM * DM, DM, NTOK, DM, DM, (bf16_t*)(ws + WS_HB), DM, 0); SEAM(pb + 6); }
        if (IN(pb + 7)) { WSL; ln1_router(F, P, l, l == 0 ? PIN(0) : (const float*)P.out); SEAM(pb + 7); }
        if (IN(pb + 8)) {
            WSL; const int ntiles = moe_table(F, l);
            pg8::Gemm g{xb, (const bf16_t*)(ws + WS_EXP1), DM, DM, DM};
            pg8::MoeOrder<true> S; S.G = F.G; S.c = F.bid; S.npn = 4; S.total = ntiles * 4; S.tb = (const LAS int*)(F.lds + LDS_CTL_OFF) + 16; S.estride = (size_t)1024 * DM * 2;
            S.ltok = (const int*)(ws + WS_LTOK); S.cnt = (const unsigned*)(ws + WS_CTL) + CW_CNT + l * 32 * 64;
            pg8::EpiSwiGLU E{(bf16_t*)(ws + WS_HE)};
            for (int rep = 0; rep < REP_MOE; ++rep) pg8::gemm_phase<pg8::EpiSwiGLU, pg8::MoeOrder<true>>(F.lds, g, S, E);
            SEAM(pb + 8);
        }
        if (IN(pb + 9)) {
            WSL; const int ntiles = moe_table(F, l);
            pg8::Gemm g{(const bf16_t*)(ws + WS_HE), (const bf16_t*)(ws + WS_EXP2), DEXP, DEXP, DEXP};
            pg8::MoeOrder<false> S; S.G = F.G; S.c = F.bid; S.npn = 8; S.total = ntiles * 8; S.tb = (const LAS int*)(F.lds + LDS_CTL_OFF) + 16; S.estride = (size_t)DM * DEXP * 2;
            S.ltok = (const int*)(ws + WS_LTOK); S.cnt = (const unsigned*)(ws + WS_CTL) + CW_CNT + l * 32 * 64;
            pg8::EpiScatter E{(bf16_t*)(ws + WS_YS), (const int*)(ws + WS_LSLOT), (const float*)(ws + WS_LGATE), S.cnt};
            for (int rep = 0; rep < REP_MOE; ++rep) pg8::gemm_phase<pg8::EpiScatter, pg8::MoeOrder<false>>(F.lds, g, S, E);
            SEAM(pb + 9);
        }
        if (IN(pb + 10)) { WSL; ln2_phase(F, P, l); SEAM(pb + 10); }
    }
#ifdef MK_DEBUG
    {
        WSL;
        xcd_barrier(bar);
        dbg_count_bf16(F, (const bf16_t*)(ws + WS_CAT), (size_t)NTOK * DM, 0);
        dbg_count_bf16(F, (const bf16_t*)(ws + WS_HB), (size_t)NTOK * DM, 1);
        dbg_count_f32(F, (const float*)(ws + WS_LGATE), (size_t)32 * 16384, 2);
        dbg_count_bf16(F, (const bf16_t*)(ws + WS_YS), (size_t)32768 * 2048, 3);
        dbg_count_f32(F, (const float*)F.out, (size_t)NTOK * DM, 4);
        dbg_count_bf16(F, (const bf16_t*)(ws + WS_XB), (size_t)NTOK * DM, 5);
        xcd_barrier(bar);
        int first = 13;
        for (int k = 12; k >= 0; --k) if (__hip_atomic_load((unsigned*)(ws + WS_CTL) + CW_DBG + k * 64, __ATOMIC_RELAXED, __HIP_MEMORY_SCOPE_AGENT) != 0u) first = k;
        const float val = 1000.f * (float)(first + 1);
        for (size_t i = (size_t)F.bid * NT + F.tid; i < (size_t)NTOK * DM; i += (size_t)F.G * NT) F.out[i] = val;
    }
#endif
#undef IN
#undef SEAM
}

extern "C" void kernel_launch(void* const* d_in, const int* in_sizes, int n_in, void* d_out, int out_size, void* d_ws, size_t ws_size, hipStream_t stream) {
    static int grid = 0;
    if (grid == 0) {
        if (n_in != 31 || ws_size < WS_END) { fprintf(stderr, "kernel_launch: expected 31 inputs and >= %zu bytes of workspace, got %d / %zu\n", (size_t)WS_END, n_in, ws_size); grid = -1; return; }
        int dev = 0, cus = 0, per_cu = 0;
        if (hipGetDevice(&dev) != hipSuccess || hipDeviceGetAttribute(&cus, hipDeviceAttributeMultiprocessorCount, dev) != hipSuccess) { grid = -1; return; }
        if (hipFuncSetAttribute((const void*)mega_fwd, hipFuncAttributeMaxDynamicSharedMemorySize, LDS_BYTES) != hipSuccess) { fprintf(stderr, "kernel_launch: hipFuncSetAttribute failed\n"); grid = -1; return; }
        if (hipOccupancyMaxActiveBlocksPerMultiprocessor(&per_cu, (const void*)mega_fwd, NT, LDS_BYTES) != hipSuccess || per_cu < 1)
            fprintf(stderr, "kernel_launch: occupancy query reports %d workgroups per CU\n", per_cu);
        (void)hipGetLastError();
        grid = cus;
    }
    if (grid < 0) return;
    (void)hipMemsetAsync((char*)d_ws + WS_CTL, 0, CTL_BYTES, stream);
    Params p{};
    for (int i = 0; i < 31; ++i) p.in[i] = (const float*)d_in[i];
    p.out = (float*)d_out; p.ws = (unsigned char*)d_ws;
#if MK_PER_PHASE
    for (int ph = 0; ph < N_PHASES; ++ph) {
        if (ph > 0) { const int l = (ph - 1) / PH_PER_LAYER, loc = (ph - 1) % PH_PER_LAYER; if ((l % 3) != 0 && loc >= 2 && loc <= 5) continue; }
        p.ph_lo = ph; p.ph_hi = ph + 1;
        hipLaunchKernelGGL(mega_fwd, dim3(grid), dim3(NT), LDS_BYTES, stream, p);
    }
#else
#ifndef MK_PH_HI
#define MK_PH_HI N_PHASES
#endif
    p.ph_lo = 0; p.ph_hi = MK_PH_HI;
    hipLaunchKernelGGL(mega_fwd, dim3(grid), dim3(NT), LDS_BYTES, stream, p);
#endif
    const hipError_t le = hipPeekAtLastError();
    if (le != hipSuccess) fprintf(stderr, "kernel_launch: launch failed: %s\n", hipGetErrorName(le));
}
```

```cpp
#include <hip/hip_runtime.h>
#include <cstdio>
#include <cstdint>

#ifndef MK_PER_PHASE
#define MK_PER_PHASE 0
#endif
#ifndef MK_PH_HI
#define MK_PH_HI N_PHASES
#endif
#ifndef REP_GEMM
#define REP_GEMM 1
#endif
#ifndef REP_MOE
#define REP_MOE 1
#endif
#ifndef REP_SCAN
#define REP_SCAN 1
#endif
#ifndef REP_PREP
#define REP_PREP 1
#endif
#ifndef REP_MIX
#define REP_MIX 1
#endif
#ifndef REP_CONV
#define REP_CONV 1
#endif
#ifndef REP_SB
#define REP_SB 1
#endif
#ifndef REP_MA
#define REP_MA 1
#endif
#ifndef REP_WX
#define REP_WX 1
#endif
#ifndef REP_WS
#define REP_WS 1
#endif
#ifndef REP_WO
#define REP_WO 1
#endif
#ifndef REP_W2
#define REP_W2 1
#endif

#define LAS __attribute__((address_space(3)))
#define GAS __attribute__((address_space(1)))
#define DI __device__ __forceinline__
typedef unsigned short bf16_t;
typedef short bf16x8 __attribute__((ext_vector_type(8)));
typedef short s16x4 __attribute__((ext_vector_type(4)));
typedef float f32x2 __attribute__((ext_vector_type(2)));
typedef float f32x4 __attribute__((ext_vector_type(4)));
typedef float f32x8 __attribute__((ext_vector_type(8)));
typedef float f32x16 __attribute__((ext_vector_type(16)));
typedef unsigned u32x2 __attribute__((ext_vector_type(2)));
typedef unsigned u32x4 __attribute__((ext_vector_type(4)));

constexpr int NTOK = 16384, DM = 2048, SEQ = 4096, NBATCH = 4, CMIX = 1536, MEMW = 512, MEML = 256, NLAYER = 4;
constexpr int ZW_RWKV = 5632  , ZW_OTH = 5120, RW_IN_COLS = 5568;
constexpr int NEXP = 32, DEXP = 512, LISTCAP = 16384, MAXTILES = 160;
constexpr float LN_EPS = 1e-5f, ALPHA = 1.681792830507429f, GN_EPS = 64e-5f;
constexpr int NT = 512, NWAVES = 8;

constexpr size_t MiB = (size_t)1 << 20;
constexpr size_t WS_CTL = 0, CTL_BYTES = 1 * MiB;
constexpr size_t WS_WIN = 2 * MiB;
constexpr size_t WIN_STRIDE = 22 * MiB;
constexpr size_t WS_WOUT = 90 * MiB;
constexpr size_t WS_WK = 122 * MiB;
constexpr size_t WS_WV = 130 * MiB;
constexpr size_t WS_MEMB = 138 * MiB;
constexpr size_t WS_KM = 142 * MiB;
constexpr size_t WS_VMT = 146 * MiB;
constexpr size_t WS_LORA = 150 * MiB;
constexpr size_t LORA_STRIDE = 3 * MiB;
constexpr size_t WS_WSW = 156 * MiB;
constexpr size_t WSW_STRIDE = 393216;
constexpr size_t WS_EXP1 = 160 * MiB;
constexpr size_t WS_EXP2 = 288 * MiB;
constexpr size_t WS_XB = 352 * MiB;
constexpr size_t WS_Z = 416 * MiB;
constexpr size_t WS_CAT = 592 * MiB;
constexpr size_t WS_HB = 656 * MiB;
constexpr size_t WS_LTOK = 720 * MiB;
constexpr size_t WS_LGATE = 722 * MiB;
constexpr size_t WS_LSLOT = 724 * MiB;
constexpr size_t WS_HE = 728 * MiB;
constexpr size_t WS_YS = 768 * MiB;
constexpr size_t WS_ACT = 896 * MiB;
constexpr size_t WS_LW = 944 * MiB;
constexpr size_t WS_GATE = 1040 * MiB;
constexpr size_t WS_SCAN = 1088 * MiB;
constexpr size_t WS_V = 1568 * MiB;
constexpr size_t WS_Y = 1664 * MiB;
constexpr size_t WS_GH = 1760 * MiB;
constexpr size_t WS_QY = 1088 * MiB;
constexpr size_t WS_Y0T = 1152 * MiB;
constexpr size_t WS_E = 1280 * MiB;
constexpr size_t WS_END = 1952 * MiB;
constexpr int CW_BAR = 4096;
constexpr int CW_CNT = 16384;

constexpr int LDS_BYTES = 147456;
constexpr int LDS_CTL_OFF = 146432;

DI float bf2f(unsigned b) { return __uint_as_float(b << 16); }
typedef float cvt_f32x2 __attribute__((ext_vector_type(2)));
typedef __bf16 cvt_bf16x2 __attribute__((ext_vector_type(2)));
DI unsigned cvt_pk_bf16(float lo, float hi) { const cvt_f32x2 v = {lo, hi}; return __builtin_bit_cast(unsigned, __builtin_convertvector(v, cvt_bf16x2)); }
DI float bflo(unsigned w) { return __uint_as_float(w << 16); }
DI float bfhi(unsigned w) { return __uint_as_float(w & 0xffff0000u); }
DI float wave_sum(float v) {
#pragma unroll
    for (int o = 1; o < 64; o <<= 1) v += __shfl_xor(v, o);
    return v;
}
DI float sum16(float v) {
    v += __builtin_bit_cast(float, __builtin_amdgcn_update_dpp(0, __builtin_bit_cast(int, v), 0x128, 0xf, 0xf, false));
    v += __builtin_bit_cast(float, __builtin_amdgcn_update_dpp(0, __builtin_bit_cast(int, v), 0x124, 0xf, 0xf, false));
    v += __builtin_bit_cast(float, __builtin_amdgcn_update_dpp(0, __builtin_bit_cast(int, v), 0x122, 0xf, 0xf, false));
    v += __builtin_bit_cast(float, __builtin_amdgcn_update_dpp(0, __builtin_bit_cast(int, v), 0x121, 0xf, 0xf, false));
    return v;
}
DI float fma_s(float a, float b, float c) { float d; asm("v_fma_f32 %0, %1, %2, %3" : "=v"(d) : "v"(a), "v"(b), "v"(c)); return d; }
DI float sigmoidf_(float x) { return __builtin_amdgcn_rcpf(1.f + __expf(-x)); }
DI float softplusf_(float x) { return fmaxf(x, 0.f) + __logf(1.f + __expf(-fabsf(x))); }
#define LDS_WAIT() asm volatile("s_waitcnt lgkmcnt(0)" ::: "memory")
#define VM_WAIT() asm volatile("s_waitcnt vmcnt(0)" ::: "memory")
#define LDS_BARRIER() do { asm volatile("s_waitcnt lgkmcnt(0)" ::: "memory"); __builtin_amdgcn_s_barrier(); asm volatile("" ::: "memory"); } while (0)

template <class T> DI T* as_global(T* p) { return p; }
DI const float* kin_ptr(int i) { int off = i * 8; asm volatile("" : "+v"(off)); const char* ka = (const char*)__builtin_amdgcn_kernarg_segment_ptr();
    const unsigned long long p = *(const unsigned long long*)(ka + off);
    const unsigned lo = __builtin_amdgcn_readfirstlane((unsigned)p), hi = __builtin_amdgcn_readfirstlane((unsigned)(p >> 32));
    return as_global((const float*)(((unsigned long long)hi << 32) | lo)); }
#define PIN(i) kin_ptr(i)
DI unsigned char* opq(unsigned char* p) { asm volatile("" : "+s"(p)); return p; }
DI float* opqf(float* p) { asm volatile("" : "+s"(p)); return p; }

#define XB_TMO      128
#define XB_XCNT(j)  (256  + 64 * (j))
#define XB_XSUB(j)  (1280 + 64 * (j))
#define XB_XGEN(j)  (2304 + 64 * (j))
#define XB_TOP      3328
#define XB_TOPGEN   3392
#define XCD_BAR_WORDS 3456
#define XB_SPIN_CAP (1u << 20)

__device__ __forceinline__ unsigned xb_ld(unsigned* p)              { return __hip_atomic_load(p, __ATOMIC_RELAXED, __HIP_MEMORY_SCOPE_AGENT); }
__device__ __forceinline__ unsigned xb_add(unsigned* p, unsigned v) { return __hip_atomic_fetch_add(p, v, __ATOMIC_RELAXED, __HIP_MEMORY_SCOPE_AGENT); }
__device__ __forceinline__ unsigned xb_xcc_id() { return (unsigned)__builtin_amdgcn_s_getreg((3 << 11) | 20) & 0xFu; }
#define XB_SPIN(cond, bar) do { unsigned _sp = 0; while (cond) { __builtin_amdgcn_s_sleep(1); \
    if ((++_sp & 255u) == 0u) { if (xb_ld(&(bar)[XB_TMO])) break; if (_sp > XB_SPIN_CAP) { atomicAdd(&(bar)[XB_TMO], 1u); break; } } } } while (0)

struct XcdBarrier { unsigned* bar; unsigned x; volatile LAS unsigned* st; };

__device__ __forceinline__ XcdBarrier xcd_barrier_post(unsigned* bar, volatile LAS unsigned* st) {
    XcdBarrier b; b.bar = bar; b.x = xb_xcc_id(); b.st = st;
    if (threadIdx.x == 0) (void)xb_add(&bar[XB_XCNT(b.x)], 1u);
    return b;
}
__device__ __forceinline__ void xcd_barrier_complete(unsigned* bar, unsigned x, unsigned& nloc, unsigned& nx) {
    const unsigned G = gridDim.x * gridDim.y * gridDim.z;
    unsigned sum, cnt, mine, sp = 0u;
    for (;;) {
        sum = 0u; cnt = 0u; mine = 0u;
#pragma unroll
        for (unsigned j = 0; j < 16; ++j) { const unsigned c = xb_ld(&bar[XB_XCNT(j)]); sum += c; cnt += (c > 0u) ? 1u : 0u; mine = (j == x) ? c : mine; }
        if (sum == G) break;
        __builtin_amdgcn_s_sleep(1);
        if ((++sp & 255u) == 0u) { if (xb_ld(&bar[XB_TMO])) break; if (sp > XB_SPIN_CAP) { atomicAdd(&bar[XB_TMO], 1u); break; } }
    }
    nloc = mine > 0u ? mine : 1u; nx = cnt > 0u ? cnt : 1u;
}
__device__ __forceinline__ void xcd_barrier(const XcdBarrier& b) {
    asm volatile("s_waitcnt vmcnt(0)" ::: "memory");
    __syncthreads();
    if (threadIdx.x == 0) {
        unsigned* bar = b.bar;
        __builtin_amdgcn_s_waitcnt(0);
        unsigned nloc = b.st[0], nx = b.st[1];
        if (nloc == 0u) { xcd_barrier_complete(bar, b.x, nloc, nx); b.st[0] = nloc; b.st[1] = nx; }
        const unsigned old = xb_add(&bar[XB_XSUB(b.x)], 1u);
        const unsigned gen = old / nloc;
        if (old + 1u == (gen + 1u) * nloc) {
            __builtin_amdgcn_fence(__ATOMIC_RELEASE, "agent");
            asm volatile("s_waitcnt vmcnt(0)" ::: "memory");
            const unsigned og = xb_add(&bar[XB_TOP], 1u);
            const unsigned tg = og / nx;
            if (og + 1u == (tg + 1u) * nx) xb_add(&bar[XB_TOPGEN], 1u);
            else XB_SPIN(xb_ld(&bar[XB_TOPGEN]) == tg, bar);
            __builtin_amdgcn_fence(__ATOMIC_ACQUIRE, "agent");
            xb_add(&bar[XB_XGEN(b.x)], 1u);
            asm volatile("s_waitcnt vmcnt(0)" ::: "memory");
        } else {
            XB_SPIN(xb_ld(&bar[XB_XGEN(b.x)]) == gen, bar);
            __builtin_amdgcn_fence(__ATOMIC_ACQUIRE, "agent");
            asm volatile("s_waitcnt vmcnt(0)" ::: "memory");
        }
    }
    __syncthreads();
}

namespace pg8 {
constexpr int BM = 256, BK = 64, HALF = 128, HTB = HALF * BK * 2, STAGE_BYTES = 8 * HTB, NXCD = 8, WGM = 8;
DI int lds_byte(int r, int c) { const int st = (r >> 4) * 2 + (c >> 5), rr = r & 15, cc = c & 31, ob = rr * 64 + cc * 2; return st * 1024 + (ob ^ (((ob >> 9) & 1) << 5)); }
DI void stage_rc(int b, int& R, int& C) { const int st = b / 1024, sb = b % 1024, swz = sb ^ (((sb >> 9) & 1) << 5); R = (st >> 1) * 16 + swz / 64; C = (st & 1) * 32 + (swz % 64) / 2; }
DI int perm32(int rho) { const int n = rho >> 4, i = rho & 15; return 8 * (i >> 2) + 4 * n + (i & 3); }

struct Unit { int pm, pn, e, rt; };
struct Gemm { const bf16_t* A; const bf16_t* Bt; int lda, ldb, K; };

struct StaticOrder {
    static constexpr bool GATHER = false;
    int nM, nN, nwg, G, c;
    DI void init(int M, int N, int G_, int c_) { nM = M / BM; nN = N / BM; nwg = nM * nN; G = G_; c = c_; }
    DI bool next(int i, Unit& u) const {
        const long L = (long)i * G + c; if (L >= nwg) return false;
        int wgid = (int)L; { const int q = nwg / NXCD, r = nwg % NXCD, xcd = wgid % NXCD, off = wgid / NXCD; wgid = (xcd < r ? xcd * (q + 1) : r * (q + 1) + (xcd - r) * q) + off; }
        const int nig = WGM * nN, gid = wgid / nig, fm = gid * WGM, gsz = (nM - fm) < WGM ? (nM - fm) : WGM;
        u.pm = fm + ((wgid % nig) % gsz); u.pn = (wgid % nig) / gsz; u.e = 0; u.rt = 0; return true;
    }
    DI const char* a_base(const Gemm& g, const Unit& u) const { return (const char*)g.A + (size_t)u.pm * BM * g.lda * 2; }
    DI const char* b_base(const Gemm& g, const Unit& u) const { return (const char*)g.Bt + (size_t)u.pn * BM * g.ldb * 2; }
    DI unsigned gather_voff(const Unit&, int, int, int) const { return 0u; }
};

template <bool GATH> struct MoeOrder {
    static constexpr bool GATHER = GATH;
    int G, c, npn, total; const LAS int* tb; size_t estride; const int* ltok; const unsigned* cnt;
    DI bool next(int i, Unit& u) const {
        if ((G & 7) == 0) {
            const int x = c & 7, r = c >> 3, W = G >> 3, idx = i * W + r;
            const int q = idx / npn, pn = idx - q * npn; int base = 0;
#pragma unroll
            for (int k = 0; k < 4; ++k) { const int e = x + 8 * k, nt = tb[e + 1] - tb[e];
                if (q < base + nt) { u.e = e; u.rt = q - base; u.pm = tb[e] + u.rt; u.pn = pn; return true; }
                base += nt; }
            return false;
        }
        const int L = i * G + c; if (L >= total) return false;
        const int q = L / npn; u.pn = L - q * npn; u.pm = q;
        int e = 0; while (e < NEXP - 1 && tb[e + 1] <= q) ++e;
        u.e = e; u.rt = q - tb[e]; return true;
    }
    DI const char* a_base(const Gemm& g, const Unit& u) const { return (const char*)g.A + (size_t)u.pm * BM * g.lda * 2; }
    DI const char* b_base(const Gemm& g, const Unit& u) const { return (const char*)g.Bt + (size_t)u.e * estride + (size_t)u.pn * BM * g.ldb * 2; }
    DI unsigned gather_voff(const Unit& u, int r, int C, int lda) const {
        const int pos = u.rt * BM + r; const int n = (int)__hip_atomic_load(cnt + u.e * 64, __ATOMIC_RELAXED, __HIP_MEMORY_SCOPE_AGENT);
        const int tok = pos < n ? ltok[u.e * LISTCAP + pos] : 0;
        return (unsigned)(tok * lda + C) * 2u;
    }
};

struct EpiStore {
    bf16_t* O; int ldc;
    DI void operator()(const f32x4 (&acc)[2][2][4][2], const Unit& u, int wr, int wc, int fr, int fq) const {
        const int row0 = u.pm * BM + wr * 64 + fr, col0 = u.pn * BM + wc * 32 + 8 * fq;
#pragma unroll
        for (int ai = 0; ai < 2; ++ai)
#pragma unroll
            for (int m = 0; m < 4; ++m) { bf16_t* rowp = O + (size_t)(row0 + ai * HALF + m * 16) * ldc + col0;
#pragma unroll
                for (int bj = 0; bj < 2; ++bj) { const f32x4 v0 = acc[ai][bj][m][0], v1 = acc[ai][bj][m][1];
                    u32x4 w; w.x = cvt_pk_bf16(v0[0], v0[1]); w.y = cvt_pk_bf16(v0[2], v0[3]); w.z = cvt_pk_bf16(v1[0], v1[1]); w.w = cvt_pk_bf16(v1[2], v1[3]);
                    *(GAS u32x4*)(rowp + bj * HALF) = w; } }
    }
};
struct EpiSwiGLU {
    bf16_t* H;
    DI void operator()(const f32x4 (&acc)[2][2][4][2], const Unit& u, int wr, int wc, int fr, int fq) const {
        const int row0 = u.pm * BM + wr * 64 + fr, col0 = u.pn * HALF + wc * 32 + 8 * fq;
#pragma unroll
        for (int ai = 0; ai < 2; ++ai)
#pragma unroll
            for (int m = 0; m < 4; ++m) { bf16_t* rowp = H + (size_t)(row0 + ai * HALF + m * 16) * DEXP + col0;
                float h[8];
#pragma unroll
                for (int n = 0; n < 2; ++n)
#pragma unroll
                    for (int j = 0; j < 4; ++j) { const float gt = acc[ai][0][m][n][j], up = acc[ai][1][m][n][j]; h[n * 4 + j] = gt * __builtin_amdgcn_rcpf(1.f + __expf(-gt)) * up; }
                u32x4 w; w.x = cvt_pk_bf16(h[0], h[1]); w.y = cvt_pk_bf16(h[2], h[3]); w.z = cvt_pk_bf16(h[4], h[5]); w.w = cvt_pk_bf16(h[6], h[7]);
                *(GAS u32x4*)rowp = w; }
    }
};
struct EpiScatter {
    bf16_t* YS; const int* lslot; const float* lgate; const unsigned* cnt;
    DI void operator()(const f32x4 (&acc)[2][2][4][2], const Unit& u, int wr, int wc, int fr, int fq) const {
        const int n = (int)__hip_atomic_load(cnt + u.e * 64, __ATOMIC_RELAXED, __HIP_MEMORY_SCOPE_AGENT);
        const int col0 = u.pn * BM + wc * 32 + 8 * fq;
#pragma unroll
        for (int ai = 0; ai < 2; ++ai)
#pragma unroll
            for (int m = 0; m < 4; ++m) { const int pos = u.rt * BM + ai * HALF + wr * 64 + m * 16 + fr;
                if (pos < n) { const int slot = lslot[u.e * LISTCAP + pos]; const float gt = lgate[u.e * LISTCAP + pos];
                    bf16_t* rowp = YS + (size_t)slot * DM + col0;
#pragma unroll
                    for (int bj = 0; bj < 2; ++bj) { const f32x4 v0 = acc[ai][bj][m][0] * gt, v1 = acc[ai][bj][m][1] * gt;
                        u32x4 w; w.x = cvt_pk_bf16(v0[0], v0[1]); w.y = cvt_pk_bf16(v0[2], v0[3]); w.z = cvt_pk_bf16(v1[0], v1[1]); w.w = cvt_pk_bf16(v1[2], v1[3]);
                        *(GAS u32x4*)(rowp + bj * HALF) = w; } } }
    }
};

template <class Epi, class Sched>
DI void gemm_phase(LAS unsigned char* lds, const Gemm g, const Sched& S, const Epi& E) {
    int tid = threadIdx.x; asm volatile("" : "+v"(tid));
    const int wid = __builtin_amdgcn_readfirstlane(tid >> 6), lane = tid & 63, wr = wid >> 2, wc = wid & 3, fr = lane & 15, fq = lane >> 4;
    const int K = g.K, nt = K / BK;
    unsigned voffA[2], voffB[2];
#pragma unroll
    for (int i = 0; i < 2; ++i) { int R, C; stage_rc(tid * 16 + i * 8192, R, C); const int Rb = (R & ~31) + perm32(R & 31);
        voffA[i] = (unsigned)(R * g.lda + C) * 2u; voffB[i] = (unsigned)(Rb * g.ldb + C) * 2u; }
    const size_t kstep = (size_t)(BK * 2);
    const size_t hstepA = (size_t)HALF * g.lda * 2, hstepB = (size_t)HALF * g.ldb * 2;
    const unsigned ldsw = (unsigned)wid * 1024u;
    const int aoff = lds_byte(wr * 64 + fr, fq * 8), boff = lds_byte(wc * 32 + fr, fq * 8);
    unsigned gvC[2][2], gvN[2][2];
#define PG8_SA(b, h) (((b) * 2 + (h)) * HTB)
#define PG8_SB(b, h) ((4 + (b) * 2 + (h)) * HTB)
#define PG8_STAGE(bufoff, gbase, voff) do { _Pragma("unroll") for (int _i = 0; _i < 2; ++_i) \
        __builtin_amdgcn_global_load_lds((const unsigned*)((const char*)(gbase) + (voff)[_i]), (LAS unsigned*)(lds + (bufoff) + ldsw + _i * 8192), 16, 0, 0); } while (0)
#define PG8_STAGE_A(bufoff, h, nxtsel, kt) do { \
        if constexpr (Sched::GATHER) { const char* _gb = (const char*)g.A + (size_t)(kt) * kstep; unsigned _vo[2]; _vo[0] = (nxtsel) ? gvN[h][0] : gvC[h][0]; _vo[1] = (nxtsel) ? gvN[h][1] : gvC[h][1]; PG8_STAGE(bufoff, _gb, _vo); } \
        else { const char* _gb = ((nxtsel) ? nA : cA) + (size_t)(h) * hstepA + (size_t)(kt) * kstep; PG8_STAGE(bufoff, _gb, voffA); } } while (0)
#define PG8_GSETUP(dst, u) do { if constexpr (Sched::GATHER) { _Pragma("unroll") for (int _h = 0; _h < 2; ++_h) _Pragma("unroll") for (int _i = 0; _i < 2; ++_i) { int _R, _C; stage_rc(tid * 16 + _i * 8192, _R, _C); \
        dst[_h][_i] = S.gather_voff(u, _h * HALF + _R, _C, g.lda); } asm volatile("s_waitcnt vmcnt(0)" : "+v"(dst[0][0]), "+v"(dst[0][1]), "+v"(dst[1][0]), "+v"(dst[1][1]) :: "memory"); } } while (0)
#define PG8_LDA(dst, b, h) do { _Pragma("unroll") for (int m = 0; m < 4; ++m) _Pragma("unroll") for (int k = 0; k < 2; ++k) dst[m][k] = *(const LAS bf16x8*)(lds + PG8_SA(b, h) + aoff + m * 2048 + k * 1024); } while (0)
#define PG8_LDB(dst, b, h) do { _Pragma("unroll") for (int n = 0; n < 2; ++n) _Pragma("unroll") for (int k = 0; k < 2; ++k) dst[n][k] = *(const LAS bf16x8*)(lds + PG8_SB(b, h) + boff + n * 2048 + k * 1024); } while (0)
#define PG8_MMA(ai, bj, At, Bt) do { __builtin_amdgcn_s_setprio(1); _Pragma("unroll") for (int m = 0; m < 4; ++m) _Pragma("unroll") for (int n = 0; n < 2; ++n) _Pragma("unroll") for (int k = 0; k < 2; ++k) \
        acc[ai][bj][m][n] = __builtin_amdgcn_mfma_f32_16x16x32_bf16(Bt[n][k], At[m][k], acc[ai][bj][m][n], 0, 0, 0); __builtin_amdgcn_s_setprio(0); } while (0)
#define PG8_WAIT_V(n) asm volatile("s_waitcnt vmcnt(" #n ")" ::: "memory")
#define PG8_WAIT_L(n) asm volatile("s_waitcnt lgkmcnt(" #n ")" ::: "memory")
#define PG8_BAR __builtin_amdgcn_s_barrier()
#define PG8_SCHED __builtin_amdgcn_sched_barrier(0)
    Unit cur, nxt; int ui = 0;
    if (!S.next(0, cur)) return;
    f32x4 acc[2][2][4][2];
#pragma unroll
    for (int a = 0; a < 2; ++a)
#pragma unroll
        for (int b = 0; b < 2; ++b)
#pragma unroll
            for (int m = 0; m < 4; ++m)
#pragma unroll
                for (int n = 0; n < 2; ++n) acc[a][b][m][n] = (f32x4){0.f, 0.f, 0.f, 0.f};
    bf16x8 At[4][2], B0[2][2], B1[2][2];
    const char* cA = S.a_base(g, cur); const char* cB = S.b_base(g, cur);
    const char* nA = cA;
    PG8_GSETUP(gvC, cur);
    PG8_STAGE(PG8_SB(0, 0), cB, voffB); PG8_STAGE_A(PG8_SA(0, 0), 0, false, 0); PG8_STAGE(PG8_SB(0, 1), cB + hstepB, voffB); PG8_STAGE_A(PG8_SA(0, 1), 1, false, 0);
    if (wr == 1) PG8_BAR;
    PG8_WAIT_V(4); PG8_BAR;
    PG8_STAGE(PG8_SB(1, 0), cB + kstep, voffB); PG8_STAGE_A(PG8_SA(1, 0), 0, false, 1); PG8_STAGE(PG8_SB(1, 1), cB + hstepB + kstep, voffB);
    PG8_WAIT_V(6); PG8_BAR;
    for (;;) {
        const bool has_next = S.next(ui + 1, nxt);
        nA = has_next ? S.a_base(g, nxt) : cA; const char* nB = has_next ? S.b_base(g, nxt) : cB;
        if constexpr (Sched::GATHER) { if (has_next) { PG8_GSETUP(gvN, nxt); } else {
#pragma unroll
            for (int _h = 0; _h < 2; ++_h) { gvN[_h][0] = gvC[_h][0]; gvN[_h][1] = gvC[_h][1]; } } }
        for (int t = 0; t < nt; t += 2) {
            const bool last = (t == nt - 2);
            const int kt2 = last ? 0 : t + 2;
            const char* b2 = last ? nB : cB + (size_t)(t + 2) * kstep;
            const char* b3 = b2 + kstep;
            PG8_LDB(B0, 0, 0); PG8_SCHED; PG8_LDA(At, 0, 0); PG8_STAGE_A(PG8_SA(1, 1), 1, false, t + 1);
            PG8_WAIT_L(8); PG8_BAR; PG8_WAIT_L(0); PG8_MMA(0, 0, At, B0); PG8_BAR; PG8_SCHED;
            PG8_LDB(B1, 0, 1); PG8_STAGE(PG8_SB(0, 0), b2, voffB);
            PG8_BAR; PG8_WAIT_L(0); PG8_MMA(0, 1, At, B1); PG8_BAR;
            PG8_LDA(At, 0, 1); PG8_STAGE_A(PG8_SA(0, 0), 0, last, kt2);
            PG8_BAR; PG8_WAIT_L(0); PG8_MMA(1, 0, At, B0); PG8_BAR; PG8_SCHED;
            PG8_STAGE(PG8_SB(0, 1), b2 + hstepB, voffB);
            PG8_WAIT_V(6); PG8_BAR; PG8_MMA(1, 1, At, B1); PG8_BAR;
            PG8_LDB(B0, 1, 0); PG8_SCHED; PG8_LDA(At, 1, 0); PG8_STAGE_A(PG8_SA(0, 1), 1, last, kt2);
            PG8_WAIT_L(8); PG8_BAR; PG8_WAIT_L(0); PG8_MMA(0, 0, At, B0); PG8_BAR; PG8_SCHED;
            PG8_LDB(B1, 1, 1); PG8_STAGE(PG8_SB(1, 0), b3, voffB);
            PG8_BAR; PG8_WAIT_L(0); PG8_MMA(0, 1, At, B1); PG8_BAR;
            PG8_LDA(At, 1, 1); PG8_STAGE_A(PG8_SA(1, 0), 0, last, kt2 + 1);
            PG8_BAR; PG8_WAIT_L(0); PG8_MMA(1, 0, At, B0); PG8_BAR; PG8_SCHED;
            PG8_STAGE(PG8_SB(1, 1), b3 + hstepB, voffB);
            PG8_WAIT_V(6); PG8_BAR; PG8_MMA(1, 1, At, B1); PG8_BAR;
        }
        E(acc, cur, wr, wc, fr, fq);
        if (!has_next) break;
#pragma unroll
        for (int a = 0; a < 2; ++a)
#pragma unroll
            for (int b = 0; b < 2; ++b)
#pragma unroll
                for (int m = 0; m < 4; ++m)
#pragma unroll
                    for (int n = 0; n < 2; ++n) acc[a][b][m][n] = (f32x4){0.f, 0.f, 0.f, 0.f};
        cur = nxt; cA = nA; cB = nB; ++ui;
        if constexpr (Sched::GATHER) {
#pragma unroll
            for (int _h = 0; _h < 2; ++_h) { gvC[_h][0] = gvN[_h][0]; gvC[_h][1] = gvN[_h][1]; } }
    }
    PG8_WAIT_V(0);
    if (wr == 0) PG8_BAR;
    PG8_BAR;
#undef PG8_SA
#undef PG8_SB
#undef PG8_STAGE
#undef PG8_STAGE_A
#undef PG8_GSETUP
#undef PG8_LDA
#undef PG8_LDB
#undef PG8_MMA
#undef PG8_WAIT_V
#undef PG8_WAIT_L
#undef PG8_BAR
#undef PG8_SCHED
}
}

struct Params { const float* in[31]; float* out; unsigned char* ws; int ph_lo, ph_hi; };

struct Ctx {
    LAS unsigned char* lds;
    int tid, lane, wave, G, bid, gw, ngw;
    unsigned char* ws; float* out;
};
DI Ctx relaunder(const Ctx& F0) {
    Ctx F = F0;
    asm volatile("" : "+v"(F.tid), "+v"(F.lane));
    asm volatile("" : "+s"(F.wave), "+s"(F.G), "+s"(F.bid), "+s"(F.gw), "+s"(F.ngw));
    asm volatile("" : "+s"(F.ws), "+s"(F.out));
    F.ws = as_global(F.ws); F.out = as_global(F.out);
    return F;
}

DI void dense_gemm(const Ctx& F, const bf16_t* A, int lda, const bf16_t* Bt, int ldb, int M, int N, int K, bf16_t* O, int ldc, int crot) {
    pg8::Gemm g{A, Bt, lda, ldb, K}; pg8::StaticOrder S; S.init(M, N, F.G, (F.bid + crot) % F.G);
    pg8::EpiStore E{O, ldc};
    for (int rep = 0; rep < REP_GEMM; ++rep) pg8::gemm_phase<pg8::EpiStore, pg8::StaticOrder>(F.lds, g, S, E);
}

struct TJob { const float* src; bf16_t* dst; int ldw, dld; };
DI void tr_load(const TJob& j, f32x4 (&r)[16], int lane) {
    const GAS float* p = (const GAS float*)(j.src + (size_t)(lane >> 4) * j.ldw + 4 * (lane & 15));
#pragma unroll
    for (int i = 0; i < 16; ++i) r[i] = *(const GAS f32x4*)(p + (size_t)(4 * i) * j.ldw);
}
DI void tr_store(const TJob& j, const f32x4 (&r)[16], LAS unsigned char* scr, int lane) {
#pragma unroll
    for (int i = 0; i < 16; ++i) { LAS unsigned* w = (LAS unsigned*)(scr + ((lane >> 4) + 4 * i) * 132 + (lane & 15) * 8); w[0] = cvt_pk_bf16(r[i].x, r[i].y); w[1] = cvt_pk_bf16(r[i].z, r[i].w); }
    LDS_WAIT();
    const int kc = lane & 7;
#pragma unroll
    for (int sgrp = 0; sgrp < 8; ++sgrp) { const int n = 8 * sgrp + (lane >> 3); const LAS unsigned short* c = (const LAS unsigned short*)(scr + (8 * kc) * 132 + n * 2);
        u32x4 o; o.x = (unsigned)c[0] | ((unsigned)c[66] << 16); o.y = (unsigned)c[2 * 66] | ((unsigned)c[3 * 66] << 16); o.z = (unsigned)c[4 * 66] | ((unsigned)c[5 * 66] << 16); o.w = (unsigned)c[6 * 66] | ((unsigned)c[7 * 66] << 16);
        *(GAS u32x4*)(j.dst + (size_t)n * j.dld + 8 * kc) = o; }
    LDS_WAIT();
}
template <class Dec> DI void tr_run(const Dec& D, int first, int count, int stride, LAS unsigned char* scr, int lane) {
    f32x4 A[16], B[16]; TJob ja, jb;
    int it = first; if (it >= count) return;
    ja = D(it); tr_load(ja, A, lane);
    for (;;) {
        const int it2 = it + stride; const bool h2 = it2 < count; if (h2) { jb = D(it2); tr_load(jb, B, lane); }
        tr_store(ja, A, scr, lane);
        if (!h2) break;
        const int it3 = it2 + stride; const bool h3 = it3 < count; if (h3) { ja = D(it3); tr_load(ja, A, lane); }
        tr_store(jb, B, scr, lane);
        if (!h3) break;
        it = it3;
    }
}
DI TJob mat_job(const float* W, int K, int N, bf16_t* WT, int item) {
    const int nblk = N / 64, kb = item / nblk, nb = item - kb * nblk;
    TJob j; j.src = W + (size_t)(64 * kb) * N + 64 * nb; j.dst = WT + (size_t)(64 * nb) * K + 64 * kb; j.ldw = N; j.dld = K; return j;
}
DI void row_to_bf16(const float* src, bf16_t* dst, int lane) {
    const GAS f32x4* s = (const GAS f32x4*)src + lane; GAS u32x2* o = (GAS u32x2*)dst + lane;
#pragma unroll
    for (int j = 0; j < 8; ++j) { const f32x4 v = s[64 * j]; u32x2 w; w.x = cvt_pk_bf16(v.x, v.y); w.y = cvt_pk_bf16(v.z, v.w); o[64 * j] = w; }
}

DI void phase_prologue(const Ctx& F, const Params& P) {
    unsigned char* const wsl = F.ws; float* const outl = F.out; (void)outl;
    LAS unsigned char* scr = F.lds + F.wave * 16384;
    unsigned char* ws = wsl;
    constexpr int I_RW = 32 * (RW_IN_COLS / 64), I_OT = 32 * (ZW_OTH / 64), I_WO = 32 * 32, I_KV = 32 * 8;
    constexpr int N_A = 2 * I_RW + 2 * I_OT, N_B = 4 * I_WO, N_C = 8 * I_KV, N_D = NTOK + NBATCH * MEML;
    struct ProDec { unsigned char* ws;
        DI TJob operator()(int it) const { int r = it;
            if (r < N_A) {
                if (r < I_RW) return mat_job(PIN(16), DM, RW_IN_COLS, (bf16_t*)(ws + WS_WIN), r); r -= I_RW;
                if (r < I_OT) return mat_job(PIN(28), DM, ZW_OTH, (bf16_t*)(ws + WS_WIN + WIN_STRIDE), r); r -= I_OT;
                if (r < I_OT) return mat_job(PIN(30), DM, ZW_OTH, (bf16_t*)(ws + WS_WIN + 2 * WIN_STRIDE), r); r -= I_OT;
                return mat_job(PIN(16) + (size_t)DM * RW_IN_COLS, DM, RW_IN_COLS, (bf16_t*)(ws + WS_WIN + 3 * WIN_STRIDE), r);
            }
            r -= N_A;
            if (r < N_B) { const int l = r / I_WO; return mat_job(PIN(2) + (size_t)l * DM * DM, DM, DM, (bf16_t*)(ws + WS_WOUT) + (size_t)l * DM * DM, r - l * I_WO); }
            r -= N_B;
            const int m = r / I_KV, l = m & 3; const bool isv = m >= 4;
            return mat_job(PIN(isv ? 4 : 3) + (size_t)l * DM * MEMW, DM, MEMW, (bf16_t*)(ws + (isv ? WS_WV : WS_WK)) + (size_t)l * MEMW * DM, r - m * I_KV);
        } };
    ProDec PD{ws};
    tr_run(PD, F.gw, N_A + N_B + N_C, F.ngw, scr, F.lane);
    for (int r = F.gw; r < N_D; r += F.ngw) {
        if (r < NTOK) row_to_bf16(PIN(0) + (size_t)r * DM, (bf16_t*)(ws + WS_XB) + (size_t)r * DM, F.lane);
        else row_to_bf16(PIN(1) + (size_t)(r - NTOK) * DM, (bf16_t*)(ws + WS_MEMB) + (size_t)(r - NTOK) * DM, F.lane);
    }
    const int gt = F.bid * NT + F.tid, ngt = F.G * NT;
    for (int idx = gt; idx < 2 * (3072 + 1536) * 256; idx += ngt) {
        const int j = idx / ((3072 + 1536) * 256); int r = idx - j * (3072 + 1536) * 256;
        bf16_t* base = (bf16_t*)(ws + WS_LORA + (size_t)j * LORA_STRIDE);
        const int n = r >> 8, k = r & 255; float v = 0.f;
        if (n < 1536) { if (k < 96) v = PIN(19)[((size_t)j * 96 + k) * CMIX + n]; }
        else if (n < 3072) { if (k >= 96 && k < 192) v = PIN(21)[((size_t)j * 96 + (k - 96)) * CMIX + (n - 1536)]; }
        else v = PIN(22)[((size_t)j * 256 + k) * CMIX + (n - 3072)];
        base[r] = (bf16_t)(cvt_pk_bf16(v, 0.f) & 0xffffu);
    }
    for (int idx = gt; idx < 2 * 64 * DM; idx += ngt) { const int j = idx / (64 * DM), r = idx - j * 64 * DM;
        ((bf16_t*)(ws + WS_WIN + (size_t)(j ? 3 : 0) * WIN_STRIDE))[(size_t)RW_IN_COLS * DM + r] = 0; }
    for (int idx = gt; idx < NLAYER * 48 * DM; idx += ngt) {
        const int l = idx / (48 * DM); int r = idx - l * 48 * DM; const int n = r / DM, k = r - n * DM;
        float v = 0.f;
        if (n < 4) v = PIN(9)[((size_t)l * DM + k) * 4 + n]; else if (n < 36) v = PIN(11)[((size_t)l * DM + k) * 32 + (n - 4)];
        const unsigned hi = cvt_pk_bf16(v, 0.f) & 0xffffu; const float rem = v - bf2f(hi); const unsigned lo = cvt_pk_bf16(rem, 0.f) & 0xffffu;
        bf16_t* base = (bf16_t*)(ws + WS_WSW + (size_t)l * WSW_STRIDE);
        base[r] = (bf16_t)hi; base[48 * DM + r] = (bf16_t)lo;
    }
}

DI void expert_convert(const Ctx& F, const Params& P, int l, int w, int nw) {
    unsigned char* const wsl = F.ws;
    LAS unsigned char* scr = F.lds + F.wave * 16384;
    constexpr int I_GU = NEXP * 32 * 8 * 2, I_DN = NEXP * 8 * 32;
    struct ExpDec { unsigned char* ws; int l;
        DI TJob operator()(int it) const { TJob j;
            if (it < I_GU) {
                const int isup = it / (I_GU / 2); int r = it - isup * (I_GU / 2);
                const int e = r / 256; r -= e * 256; const int kb = r >> 3, nb = r & 7;
                const float* W = PIN(isup ? 14 : 13) + ((size_t)l * NEXP + e) * DM * DEXP;
                const int n0 = 64 * nb, drow = 256 * (n0 >> 7) + (isup ? 128 : 0) + (n0 & 127);
                j.src = W + (size_t)(64 * kb) * DEXP + n0; j.ldw = DEXP; j.dst = (bf16_t*)(ws + WS_EXP1) + ((size_t)e * 1024 + drow) * DM + 64 * kb; j.dld = DM;
            } else {
                int r = it - I_GU; const int e = r / 256; r -= e * 256; const int kb = r >> 5, nb = r & 31;
                const float* W = PIN(15) + ((size_t)l * NEXP + e) * DEXP * DM;
                j.src = W + (size_t)(64 * kb) * DM + 64 * nb; j.ldw = DM; j.dst = (bf16_t*)(ws + WS_EXP2) + ((size_t)e * DM + 64 * nb) * DEXP + 64 * kb; j.dld = DEXP;
            }
            return j; } };
    ExpDec ED{wsl, l};
    tr_run(ED, w, I_GU + I_DN, nw, scr, F.lane);
}

DI void memattn_unit(const Ctx& F, int l, int unit, const bf16_t* z, int zw, int qcol) {
    unsigned char* const wsl = F.ws; float* const outl = F.out; (void)outl;
    const int b = unit >> 6, head = (unit >> 4) & 3, qblk = unit & 15;
    LAS unsigned char* Ks = F.lds; LAS unsigned char* Vs = F.lds + 69632;
    const bf16_t* Km = (const bf16_t*)(wsl + WS_KM); const bf16_t* VmT = (const bf16_t*)(wsl + WS_VMT);
    bf16_t* cat = (bf16_t*)(wsl + WS_CAT);
    __syncthreads();
#pragma unroll
    for (int i = 0; i < 8; ++i) { const int ch = F.tid + NT * i;
        { const int row = ch >> 4, c16 = ch & 15; const u32x4 v = *(const u32x4*)(Km + (size_t)(b * MEML + row) * 2048 + l * 512 + head * 128 + c16 * 8); *(LAS u32x4*)(Ks + row * 272 + c16 * 16) = v; }
        { const int d = ch >> 5, c = ch & 31; const u32x4 v = *(const u32x4*)(VmT + (size_t)(l * 512 + head * 128 + d) * 1024 + b * MEML + c * 8); *(LAS u32x4*)(Vs + d * 528 + c * 16) = v; } }
    __syncthreads();
    const int lane = F.lane, fr = lane & 15, fq = lane >> 4;
    for (int itq = 0; itq < 2; ++itq) {
        const int q0 = qblk * 256 + itq * 128 + F.wave * 16, tok0 = b * SEQ + q0;
        bf16x8 Qf[4];
#pragma unroll
        for (int ks = 0; ks < 4; ++ks) Qf[ks] = *(const bf16x8*)(z + (size_t)(tok0 + fr) * zw + qcol + head * 128 + ks * 32 + fq * 8);
        f32x4 acc[16];
#pragma unroll
        for (int t = 0; t < 16; ++t) { acc[t] = (f32x4){0.f, 0.f, 0.f, 0.f};
#pragma unroll
            for (int ks = 0; ks < 4; ++ks) { const bf16x8 kf = *(const LAS bf16x8*)(Ks + (16 * t + fr) * 272 + ks * 64 + fq * 16);
                acc[t] = __builtin_amdgcn_mfma_f32_16x16x32_bf16(kf, Qf[ks], acc[t], 0, 0, 0); } }
        const float sc = 0.08838834764831845f;
        float mx = -3.0e38f;
#pragma unroll
        for (int t = 0; t < 16; ++t)
#pragma unroll
            for (int j = 0; j < 4; ++j) { acc[t][j] *= sc; mx = fmaxf(mx, acc[t][j]); }
        mx = fmaxf(mx, __shfl_xor(mx, 16)); mx = fmaxf(mx, __shfl_xor(mx, 32));
        float sum = 0.f;
#pragma unroll
        for (int t = 0; t < 16; ++t)
#pragma unroll
            for (int j = 0; j < 4; ++j) { acc[t][j] = __expf(acc[t][j] - mx); sum += acc[t][j]; }
        sum += __shfl_xor(sum, 16); sum += __shfl_xor(sum, 32);
        const float inv = 1.f / sum;
        f32x4 o[8];
#pragma unroll
        for (int dt = 0; dt < 8; ++dt) o[dt] = (f32x4){0.f, 0.f, 0.f, 0.f};
#pragma unroll
        for (int s = 0; s < 8; ++s) {
            u32x4 pw; pw.x = cvt_pk_bf16(acc[2 * s][0], acc[2 * s][1]); pw.y = cvt_pk_bf16(acc[2 * s][2], acc[2 * s][3]);
            pw.z = cvt_pk_bf16(acc[2 * s + 1][0], acc[2 * s + 1][1]); pw.w = cvt_pk_bf16(acc[2 * s + 1][2], acc[2 * s + 1][3]);
            const bf16x8 pf = __builtin_bit_cast(bf16x8, pw);
#pragma unroll
            for (int dt = 0; dt < 8; ++dt) {
                const u32x2 v0 = *(const LAS u32x2*)(Vs + (16 * dt + fr) * 528 + (32 * s + 4 * fq) * 2);
                const u32x2 v1 = *(const LAS u32x2*)(Vs + (16 * dt + fr) * 528 + (32 * s + 16 + 4 * fq) * 2);
                u32x4 vw; vw.x = v0.x; vw.y = v0.y; vw.z = v1.x; vw.w = v1.y;
                o[dt] = __builtin_amdgcn_mfma_f32_16x16x32_bf16(__builtin_bit_cast(bf16x8, vw), pf, o[dt], 0, 0, 0);
            }
        }
        bf16_t* orow = cat + (size_t)(tok0 + fr) * DM + CMIX + head * 128 + 4 * fq;
#pragma unroll
        for (int dt = 0; dt < 8; ++dt) { u32x2 w; w.x = cvt_pk_bf16(o[dt][0] * inv, o[dt][1] * inv); w.y = cvt_pk_bf16(o[dt][2] * inv, o[dt][3] * inv); *(u32x2*)(orow + 16 * dt) = w; }
    }
}
DI void memattn_all(const Ctx& F, int l, const bf16_t* z, int zw, int qcol) {
    for (int u = F.bid; u < 256; u += F.G) memattn_unit(F, l, u, z, zw, qcol);
    __syncthreads();
}

DI void conv_mix(const Ctx& F, const Params& P, const bf16_t* z) {
    unsigned char* const wsl = F.ws; float* const outl = F.out; (void)outl;
    const float* cw = PIN(29);
    bf16_t* cat = (bf16_t*)(wsl + WS_CAT);
    const int gt = F.bid * NT + F.tid, ngt = F.G * NT;
    for (int idx = gt; idx < NTOK * 192; idx += ngt) {
        const int tok = idx / 192, c8 = idx - tok * 192, c = c8 * 8, t = tok & (SEQ - 1);
        const bf16_t* zr = z + (size_t)tok * ZW_OTH;
        const u32x4 bg = *(const u32x4*)(zr + c);
        float y[8];
#pragma unroll
        for (int j = 0; j < 8; ++j) y[j] = 0.f;
#pragma unroll
        for (int dt = 0; dt < 3; ++dt) {
            if (t - dt >= 0) {
                const u32x4 cg = *(const u32x4*)(zr - (size_t)dt * ZW_OTH + CMIX + c), hh = *(const u32x4*)(zr - (size_t)dt * ZW_OTH + 2 * CMIX + c);
                const f32x4 w0 = *(const f32x4*)(cw + (2 - dt) * CMIX + c), w1 = *(const f32x4*)(cw + (2 - dt) * CMIX + c + 4);
                y[0] += w0.x * bflo(cg.x) * bflo(hh.x); y[1] += w0.y * bfhi(cg.x) * bfhi(hh.x); y[2] += w0.z * bflo(cg.y) * bflo(hh.y); y[3] += w0.w * bfhi(cg.y) * bfhi(hh.y);
                y[4] += w1.x * bflo(cg.z) * bflo(hh.z); y[5] += w1.y * bfhi(cg.z) * bfhi(hh.z); y[6] += w1.z * bflo(cg.w) * bflo(hh.w); y[7] += w1.w * bfhi(cg.w) * bfhi(hh.w);
            }
        }
        u32x4 o; o.x = cvt_pk_bf16(bflo(bg.x) * y[0], bfhi(bg.x) * y[1]); o.y = cvt_pk_bf16(bflo(bg.y) * y[2], bfhi(bg.y) * y[3]);
        o.z = cvt_pk_bf16(bflo(bg.z) * y[4], bfhi(bg.z) * y[5]); o.w = cvt_pk_bf16(bflo(bg.w) * y[6], bfhi(bg.w) * y[7]);
        *(u32x4*)(cat + (size_t)tok * DM + c) = o;
    }
}

DI void sb_attention(const Ctx& F, const bf16_t* z) {
    unsigned char* const wsl = F.ws;
    const bf16_t* VT = (const bf16_t*)(wsl + WS_ACT);
    bf16_t* cat = (bf16_t*)(wsl + WS_CAT);
    LAS unsigned char* Ks = F.lds; LAS unsigned char* Vs = F.lds + 69632;
    const int lane = F.lane, fr = lane & 15, fq = lane >> 4;
    const float sc = 0.08838834764831845f;
    for (int u = F.bid; u < NBATCH * 12 * 32; u += F.G) {
        const int b = u / (12 * 32); int r = u - b * 12 * 32; const int head = r >> 5, qblk = r & 31;
        const int t0 = qblk * 128, kw0 = t0 - 128;
        __syncthreads();
#pragma unroll
        for (int i = 0; i < 8; ++i) { const int ch = F.tid + NT * i;
            { const int row = ch >> 4, c16 = ch & 15, key = kw0 + row;
              if (key >= 0) { const u32x4 v = *(const u32x4*)(z + (size_t)(b * SEQ + key) * ZW_OTH + CMIX + head * 128 + c16 * 8); *(LAS u32x4*)(Ks + row * 272 + c16 * 16) = v; } }
            { const int d = ch >> 5, c = ch & 31;
              if (kw0 + c * 8 >= 0) { const u32x4 v = *(const u32x4*)(VT + (size_t)(head * 128 + d) * NTOK + b * SEQ + kw0 + c * 8); *(LAS u32x4*)(Vs + d * 528 + c * 16) = v; } } }
        __syncthreads();
        const int tq0 = t0 + F.wave * 16, tq = tq0 + fr;
        bf16x8 Qf[4];
#pragma unroll
        for (int ks = 0; ks < 4; ++ks) Qf[ks] = *(const bf16x8*)(z + (size_t)(b * SEQ + tq) * ZW_OTH + head * 128 + ks * 32 + fq * 8);
        f32x4 o[8];
#pragma unroll
        for (int dt = 0; dt < 8; ++dt) o[dt] = (f32x4){0.f, 0.f, 0.f, 0.f};
        float R = 0.f;
        for (int kt = (tq0 + 14) >> 5; kt >= 0; --kt) {
            const int lk = 32 * kt - kw0;
            bf16x8 Kf[2][4]; u32x2 V0[8], V1[8];
            if (lk >= 0) {
#pragma unroll
                for (int tl = 0; tl < 2; ++tl)
#pragma unroll
                    for (int ks = 0; ks < 4; ++ks) Kf[tl][ks] = *(const LAS bf16x8*)(Ks + (lk + 16 * tl + fr) * 272 + ks * 64 + fq * 16);
#pragma unroll
                for (int dt = 0; dt < 8; ++dt) { V0[dt] = *(const LAS u32x2*)(Vs + (16 * dt + fr) * 528 + (lk + 4 * fq) * 2); V1[dt] = *(const LAS u32x2*)(Vs + (16 * dt + fr) * 528 + (lk + 16 + 4 * fq) * 2); }
            } else {
#pragma unroll
                for (int tl = 0; tl < 2; ++tl)
#pragma unroll
                    for (int ks = 0; ks < 4; ++ks) Kf[tl][ks] = *(const bf16x8*)(z + (size_t)(b * SEQ + 32 * kt + 16 * tl + fr) * ZW_OTH + CMIX + head * 128 + ks * 32 + fq * 8);
#pragma unroll
                for (int dt = 0; dt < 8; ++dt) { const bf16_t* vp = VT + (size_t)(head * 128 + 16 * dt + fr) * NTOK + b * SEQ + 32 * kt + 4 * fq; V0[dt] = *(const u32x2*)vp; V1[dt] = *(const u32x2*)(vp + 16); }
            }
            f32x4 s[2];
#pragma unroll
            for (int tl = 0; tl < 2; ++tl) { s[tl] = (f32x4){0.f, 0.f, 0.f, 0.f};
#pragma unroll
                for (int ks = 0; ks < 4; ++ks) s[tl] = __builtin_amdgcn_mfma_f32_16x16x32_bf16(Kf[tl][ks], Qf[ks], s[tl], 0, 0, 0); }
            float ln[2][4], lsg[2][4], tot[2];
#pragma unroll
            for (int tl = 0; tl < 2; ++tl) { tot[tl] = 0.f;
#pragma unroll
                for (int j = 0; j < 4; ++j) { const float x = s[tl][j] * sc; const int key = 32 * kt + 16 * tl + 4 * fq + j; const bool valid = key < tq;
                    const float sp = softplusf_(x); ln[tl][j] = valid ? -sp : 0.f; lsg[tl][j] = valid ? (x - sp) : -1.0e30f; tot[tl] += ln[tl][j]; } }
            const float a16_0 = __shfl_xor(tot[0], 16), a32_0 = __shfl_xor(tot[0], 32), a48_0 = __shfl_xor(tot[0], 48);
            const float a16_1 = __shfl_xor(tot[1], 16), a32_1 = __shfl_xor(tot[1], 32), a48_1 = __shfl_xor(tot[1], 48);
            float hi0 = 0.f, hi1 = 0.f;
            if ((fq ^ 1) > fq) { hi0 += a16_0; hi1 += a16_1; }
            if ((fq ^ 2) > fq) { hi0 += a32_0; hi1 += a32_1; }
            if ((fq ^ 3) > fq) { hi0 += a48_0; hi1 += a48_1; }
            const float all0 = tot[0] + a16_0 + a32_0 + a48_0, all1 = tot[1] + a16_1 + a32_1 + a48_1;
            const float E0 = R + hi0 + all1, E1 = R + hi1;
            float at[2][4];
#pragma unroll
            for (int tl = 0; tl < 2; ++tl) { float suf = 0.f; const float Eb = tl ? E1 : E0;
#pragma unroll
                for (int j = 3; j >= 0; --j) { at[tl][j] = __expf(lsg[tl][j] + Eb + suf); suf += ln[tl][j]; } }
            R += all0 + all1;
            u32x4 pw; pw.x = cvt_pk_bf16(at[0][0], at[0][1]); pw.y = cvt_pk_bf16(at[0][2], at[0][3]); pw.z = cvt_pk_bf16(at[1][0], at[1][1]); pw.w = cvt_pk_bf16(at[1][2], at[1][3]);
            const bf16x8 pf = __builtin_bit_cast(bf16x8, pw);
#pragma unroll
            for (int dt = 0; dt < 8; ++dt) {
                u32x4 vw; vw.x = V0[dt].x; vw.y = V0[dt].y; vw.z = V1[dt].x; vw.w = V1[dt].y;
                o[dt] = __builtin_amdgcn_mfma_f32_16x16x32_bf16(__builtin_bit_cast(bf16x8, vw), pf, o[dt], 0, 0, 0);
            }
            if (__all(R < -100.f)) break;
        }
        bf16_t* orow = cat + (size_t)(b * SEQ + tq) * DM + head * 128 + 4 * fq;
#pragma unroll
        for (int dt = 0; dt < 8; ++dt) { u32x2 w; w.x = cvt_pk_bf16(o[dt][0], o[dt][1]); w.y = cvt_pk_bf16(o[dt][2], o[dt][3]); *(u32x2*)(orow + 16 * dt) = w; }
    }
    __syncthreads();
}

DI void rwkv_prep1(const Ctx& F, const Params& P, int j, const bf16_t* z) {
    unsigned char* const wsl = F.ws; float* const outl = F.out; (void)outl;
    const float* mu = PIN(17) + (size_t)j * 5056;
    bf16_t* act = (bf16_t*)(wsl + WS_ACT);
    const int gt = F.bid * NT + F.tid, ngt = F.G * NT;
    for (int idx = gt; idx < NTOK * 64; idx += ngt) {
        const int tok = idx >> 6, ci = idx & 63, t = tok & (SEQ - 1);
        u32x4 o = (u32x4){0u, 0u, 0u, 0u};
        if (ci < 24 || ci >= 32) {
            const int sc = ci < 12 ? 4608 + 8 * ci : (ci < 24 ? 4704 + 8 * (ci - 12) : 4800 + 8 * (ci - 32));
            const u32x4 a = *(const u32x4*)(z + (size_t)tok * ZW_RWKV + sc);
            u32x4 p = (u32x4){0u, 0u, 0u, 0u}; if (t > 0) p = *(const u32x4*)(z + (size_t)(tok - 1) * ZW_RWKV + sc);
            const f32x4 m0 = *(const f32x4*)(mu + sc), m1 = *(const f32x4*)(mu + sc + 4);
            float v[8];
            v[0] = bflo(a.x) + (bflo(p.x) - bflo(a.x)) * m0.x; v[1] = bfhi(a.x) + (bfhi(p.x) - bfhi(a.x)) * m0.y;
            v[2] = bflo(a.y) + (bflo(p.y) - bflo(a.y)) * m0.z; v[3] = bfhi(a.y) + (bfhi(p.y) - bfhi(a.y)) * m0.w;
            v[4] = bflo(a.z) + (bflo(p.z) - bflo(a.z)) * m1.x; v[5] = bfhi(a.z) + (bfhi(p.z) - bfhi(a.z)) * m1.y;
            v[6] = bflo(a.w) + (bflo(p.w) - bflo(a.w)) * m1.z; v[7] = bfhi(a.w) + (bfhi(p.w) - bfhi(a.w)) * m1.w;
#pragma unroll
            for (int q = 0; q < 8; ++q) { if (ci < 12) v[q] = tanhf(v[q]); else if (ci >= 32) v[q] = sigmoidf_(v[q]); }
            o.x = cvt_pk_bf16(v[0], v[1]); o.y = cvt_pk_bf16(v[2], v[3]); o.z = cvt_pk_bf16(v[4], v[5]); o.w = cvt_pk_bf16(v[6], v[7]);
        }
        *(u32x4*)(act + (size_t)tok * 512 + ci * 8) = o;
    }
}

constexpr int CH = 64, NCH = SEQ / CH;
DI float* scan_rec(unsigned char* ws, int tok, int head) {
    return (float*)(ws + WS_SCAN) + ((size_t)((tok >> 12) * 24 + head) * SEQ + (tok & (SEQ - 1))) * 320;
}
DI float* gh_ptr(unsigned char* ws, int bh, int c, int which) { return (float*)(ws + WS_GH) + (((size_t)bh * NCH + c) * 2 + which) * 4096; }
struct RwPar { const float *mu, *w0, *a0, *kk, *ka, *rk, *gng, *gnb; };
struct PrepRaw { u32x2 zr, zk, zv, pr, pk, pv, lw, la; };
struct PrepOut { f32x4 dec, ld, bb, kp, r, nk, v; float bon; };
DI void prep_load(PrepRaw& R, const bf16_t* z, const bf16_t* LW, int tok, int c4) {
    tok = tok < NTOK ? tok : NTOK - 1;
    const bool hp = (tok & (SEQ - 1)) != 0;
    const GAS bf16_t* zc = (const GAS bf16_t*)(z + (size_t)tok * ZW_RWKV + c4); const GAS bf16_t* zp = hp ? zc - ZW_RWKV : zc;
    R.zr = *(const GAS u32x2*)zc; R.zk = *(const GAS u32x2*)(zc + CMIX); R.zv = *(const GAS u32x2*)(zc + 2 * CMIX);
    R.pr = *(const GAS u32x2*)zp; R.pk = *(const GAS u32x2*)(zp + CMIX); R.pv = *(const GAS u32x2*)(zp + 2 * CMIX);
    const GAS bf16_t* lp = (const GAS bf16_t*)(LW + (size_t)tok * 3072 + c4); R.lw = *(const GAS u32x2*)lp; R.la = *(const GAS u32x2*)(lp + CMIX);
}
DI f32x4 lerp_u(u32x2 a, u32x2 p, f32x4 m) {
    f32x4 r; r.x = bflo(a.x) + (bflo(p.x) - bflo(a.x)) * m.x; r.y = bfhi(a.x) + (bfhi(p.x) - bfhi(a.x)) * m.y;
    r.z = bflo(a.y) + (bflo(p.y) - bflo(a.y)) * m.z; r.w = bfhi(a.y) + (bfhi(p.y) - bfhi(a.y)) * m.w; return r;
}
struct PrepPar { f32x4 mur, muk, muv, w0, a0, kk, ka, rk; };
DI void par_load(PrepPar& P, const RwPar& Q, int c4) {
    P.mur = *(const GAS f32x4*)(Q.mu + c4); P.muk = *(const GAS f32x4*)(Q.mu + CMIX + c4); P.muv = *(const GAS f32x4*)(Q.mu + 2 * CMIX + c4);
    P.w0 = *(const GAS f32x4*)(Q.w0 + c4); P.a0 = *(const GAS f32x4*)(Q.a0 + c4); P.kk = *(const GAS f32x4*)(Q.kk + c4); P.ka = *(const GAS f32x4*)(Q.ka + c4); P.rk = *(const GAS f32x4*)(Q.rk + c4);
}
template <bool WANT_BON> DI void prep_compute(const PrepRaw& R, const PrepPar& P, bool hp, PrepOut& O) {
    const u32x2 z2 = (u32x2){0u, 0u};
    const f32x4 r = lerp_u(R.zr, hp ? R.pr : z2, P.mur), k = lerp_u(R.zk, hp ? R.pk : z2, P.muk);
    O.v = lerp_u(R.zv, hp ? R.pv : z2, P.muv); O.r = r;
    const f32x4 w0v = P.w0, a0v = P.a0, kkv = P.kk, kav = P.ka;
    f32x4 wr; wr.x = w0v.x + bflo(R.lw.x); wr.y = w0v.y + bfhi(R.lw.x); wr.z = w0v.z + bflo(R.lw.y); wr.w = w0v.w + bfhi(R.lw.y);
    f32x4 ar; ar.x = a0v.x + bflo(R.la.x); ar.y = a0v.y + bfhi(R.la.x); ar.z = a0v.z + bflo(R.la.y); ar.w = a0v.w + bfhi(R.la.y);
    f32x4 a, kk;
#pragma unroll
    for (int q = 0; q < 4; ++q) { const float wl = -softplusf_(-wr[q]) - 0.5f; O.ld[q] = -__expf(wl); O.dec[q] = __expf(O.ld[q]); a[q] = sigmoidf_(ar[q]); kk[q] = k[q] * kkv[q]; O.kp[q] = k[q] * (1.f + (a[q] - 1.f) * kav[q]); }
    const float n2 = sum16(kk.x * kk.x + kk.y * kk.y + kk.z * kk.z + kk.w * kk.w);
    const float inv = __builtin_amdgcn_rsqf(fmaxf(n2, 1e-24f));
#pragma unroll
    for (int q = 0; q < 4; ++q) { const float kn = kk[q] * inv; O.bb[q] = kn * a[q]; O.nk[q] = -kn; }
    if (WANT_BON) { const f32x4 rk = P.rk; O.bon = sum16(r.x * O.kp.x * rk.x + r.y * O.kp.y * rk.y + r.z * O.kp.z * rk.z + r.w * O.kp.w * rk.w); }
}
#define LO2(v) ((f32x2){(v).x, (v).y})
#define HI2(v) ((f32x2){(v).z, (v).w})
constexpr int WRS = 144;
constexpr int W_SLOT = 64 * WRS;
enum { SL_NT = 0, SL_RT, SL_BH, SL_KH, SL_BHT, SL_KHT, SL_VT, SL_MK, SL_NB, SL_NK, SL_W1T, SL_U0T };
constexpr int W_MB = 12 * W_SLOT, W_CL = W_MB + 16384, W_PL = W_CL + 16384;
DI bf16x8 wfrag(LAS unsigned char* L, int slot, int row, int ks, int q) { return *(const LAS bf16x8*)(L + slot * W_SLOT + row * WRS + ks * 64 + q * 16); }
DI void wput(LAS unsigned char* L, int slot, int row, int col, float v) { *(LAS bf16_t*)(L + slot * W_SLOT + row * WRS + col * 2) = (bf16_t)(cvt_pk_bf16(v, 0.f) & 0xffffu); }
DI void scan_w1(const Ctx& F, const RwPar& Q, const bf16_t* z) {
    unsigned char* const wsl = F.ws; LAS unsigned char* L = F.lds;
    const int wave = F.wave;
    const bf16_t* LW = (const bf16_t*)(wsl + WS_LW);
    LAS float* MB = (LAS float*)(L + W_MB); LAS float* CL = (LAS float*)(L + W_CL); LAS float* PL = (LAS float*)(L + W_PL);
    PrepPar PN;
    PrepRaw RN[2];
    if (F.bid < 96 * NCH) { const int bh = F.bid % 96, c = F.bid / 96, b = bh / 24, head = bh - b * 24, tokb = b * SEQ + c * CH, c4 = head * 64 + 4 * (F.lane & 15);
#pragma unroll
        for (int p = 0; p < 2; ++p) prep_load(RN[p], z, LW, tokb + p * 32 + wave * 4 + (F.lane >> 4), c4);
        par_load(PN, Q, c4); }
    for (int u = F.bid; u < 96 * NCH; u += F.G) {
        int lane = F.lane; asm volatile("" : "+v"(lane));
        const int tq = lane >> 4, li = lane & 15, fr = li, fq = tq;
        const int bh = u % 96, c = u / 96, b = bh / 24, head = bh - b * 24, tokb = b * SEQ + c * CH, c4 = head * 64 + 4 * li;
        LDS_BARRIER();
        PrepOut O[2];
#pragma unroll
        for (int p = 0; p < 2; ++p) {
            const int t = p * 32 + wave * 4 + tq; const PrepRaw R = RN[p];
            prep_compute<true>(R, PN, ((tokb + t) & (SEQ - 1)) != 0, O[p]);
            *(LAS f32x4*)(CL + t * 64 + 4 * li) = O[p].ld;
            u32x2 e; e.x = cvt_pk_bf16(O[p].bon * O[p].v.x, O[p].bon * O[p].v.y); e.y = cvt_pk_bf16(O[p].bon * O[p].v.z, O[p].bon * O[p].v.w);
            *(GAS u32x2*)((bf16_t*)(wsl + WS_E) + (size_t)(tokb + t) * CMIX + c4) = e;
        }
        LDS_BARRIER();
        if (wave == 0) {
            float xs[64];
#pragma unroll
            for (int t = 0; t < 64; ++t) xs[t] = CL[t * 64 + lane];
#pragma unroll
            for (int t = 1; t < 64; ++t) xs[t] += xs[t - 1];
#pragma unroll
            for (int t = 0; t < 64; ++t) CL[t * 64 + lane] = xs[t];
        }
        LDS_BARRIER();
#pragma unroll
        for (int p = 0; p < 2; ++p) {
            const int t = p * 32 + wave * 4 + tq;
            const f32x4 cl = *(const LAS f32x4*)(CL + t * 64 + 4 * li);
            f32x4 clm = (f32x4){0.f, 0.f, 0.f, 0.f}; if (t > 0) clm = *(const LAS f32x4*)(CL + (t - 1) * 64 + 4 * li);
            f32x4 nt, rt, bh4, kh4;
#pragma unroll
            for (int q = 0; q < 4; ++q) { const float P = __expf(cl[q]), Pm = __expf(clm[q]), iP = __expf(-cl[q]);
                nt[q] = O[p].nk[q] * Pm; rt[q] = O[p].r[q] * P; bh4[q] = O[p].bb[q] * iP; kh4[q] = O[p].kp[q] * iP;
                if (t == 63) PL[4 * li + q] = P; }
            u32x2 w;
            w.x = cvt_pk_bf16(nt.x, nt.y); w.y = cvt_pk_bf16(nt.z, nt.w); *(LAS u32x2*)(L + SL_NT * W_SLOT + t * WRS + 8 * li) = w;
            w.x = cvt_pk_bf16(rt.x, rt.y); w.y = cvt_pk_bf16(rt.z, rt.w); *(LAS u32x2*)(L + SL_RT * W_SLOT + t * WRS + 8 * li) = w;
            w.x = cvt_pk_bf16(bh4.x, bh4.y); w.y = cvt_pk_bf16(bh4.z, bh4.w); *(LAS u32x2*)(L + SL_BH * W_SLOT + t * WRS + 8 * li) = w;
            w.x = cvt_pk_bf16(kh4.x, kh4.y); w.y = cvt_pk_bf16(kh4.z, kh4.w); *(LAS u32x2*)(L + SL_KH * W_SLOT + t * WRS + 8 * li) = w;
#pragma unroll
            for (int q = 0; q < 4; ++q) { wput(L, SL_BHT, 4 * li + q, t, bh4[q]); wput(L, SL_KHT, 4 * li + q, t, kh4[q]); wput(L, SL_VT, 4 * li + q, t, O[p].v[q]); }
        }
        LDS_BARRIER();
        for (int reps = 0; reps < REP_WS; ++reps) {
            const int mt = wave >> 1, slotA = (mt < 2) ? SL_NT : SL_RT, slotB = (mt & 1) ? SL_KH : SL_BH, slotO = (mt == 1) ? SL_MK : (mt == 2 ? SL_NB : SL_NK), tt0 = (wave & 1) * 2;
            bf16x8 Af[2][2], Bf[4][2];
#pragma unroll
            for (int a2 = 0; a2 < 2; ++a2)
#pragma unroll
                for (int ks = 0; ks < 2; ++ks) Af[a2][ks] = wfrag(L, slotA, 16 * (tt0 + a2) + fr, ks, fq);
#pragma unroll
            for (int ss = 0; ss < 4; ++ss)
#pragma unroll
                for (int ks = 0; ks < 2; ++ks) Bf[ss][ks] = wfrag(L, slotB, 16 * ss + fr, ks, fq);
            float zf = 0.f; asm volatile("" : "+v"(zf));
            const unsigned zu = __builtin_bit_cast(unsigned, zf);
            const int strict = (mt < 2) ? 1 : 0; LAS unsigned char* ob = L + slotO * W_SLOT;
#pragma unroll
            for (int a2 = 0; a2 < 2; ++a2)
#pragma unroll
                for (int ss = 0; ss < 4; ++ss) { const int t = 16 * (tt0 + a2) + fr, s0 = 16 * ss + 4 * fq;
                    if (ss <= tt0 + a2) {
                        f32x4 acc = __builtin_amdgcn_mfma_f32_16x16x32_bf16(Bf[ss][0], Af[a2][0], (f32x4){0.f, 0.f, 0.f, 0.f}, 0, 0, 0);
                        acc = __builtin_amdgcn_mfma_f32_16x16x32_bf16(Bf[ss][1], Af[a2][1], acc, 0, 0, 0);
                        f32x4 o;
#pragma unroll
                        for (int r = 0; r < 4; ++r) o[r] = (s0 + r + strict <= t) ? acc[r] : 0.f;
                        if (mt == 0) *(LAS f32x4*)(MB + t * 64 + s0) = o;
                        else { u32x2 w; w.x = cvt_pk_bf16(o[0], o[1]); w.y = cvt_pk_bf16(o[2], o[3]); *(LAS u32x2*)(ob + t * WRS + s0 * 2) = w; }
                    } else {
                        if (mt == 0) *(LAS f32x4*)(MB + t * 64 + s0) = (f32x4){zf, zf, zf, zf};
                        else *(LAS u32x2*)(ob + t * WRS + s0 * 2) = (u32x2){zu, zu};
                    }
                }
        }
        LDS_BARRIER();
        { const int t = F.tid >> 3, s0 = (F.tid & 7) * 8; const f32x4 a0 = *(const LAS f32x4*)(MB + t * 64 + s0), a1 = *(const LAS f32x4*)(MB + t * 64 + s0 + 4);
          u32x4 w; w.x = cvt_pk_bf16(a0.x, a0.y); w.y = cvt_pk_bf16(a0.z, a0.w); w.z = cvt_pk_bf16(a1.x, a1.y); w.w = cvt_pk_bf16(a1.z, a1.w);
          *(LAS u32x4*)(L + SL_BH * W_SLOT + t * WRS + s0 * 2) = w; }
#pragma unroll
        for (int k2 = 0; k2 < 2; ++k2) {
            const int tile = wave * 2 + k2, tt = tile >> 2, it = tile & 3;
            f32x4 acc = (f32x4){0.f, 0.f, 0.f, 0.f};
#pragma unroll
            for (int ks = 0; ks < 2; ++ks) acc = __builtin_amdgcn_mfma_f32_16x16x32_bf16(wfrag(L, SL_MK, 16 * tt + fr, ks, fq), wfrag(L, SL_VT, 16 * it + fr, ks, fq), acc, 0, 0, 0);
#pragma unroll
            for (int r = 0; r < 4; ++r) CL[(16 * tt + 4 * fq + r) * 64 + 16 * it + fr] = acc[r];
        }
        if (wave >= 4) {
            const int I = wave - 4;
            float d[16], xb[16];
#pragma unroll
            for (int r = 0; r < 16; ++r) d[r] = (r == lane) ? 1.f : 0.f;
            const LAS float* mbv = MB; asm volatile("" : "+v"(mbv));
            const LAS float* mb = mbv + (16 * I) * 64 + 16 * I;
            f32x4 A[8][2], Bm[8][2];
#pragma unroll
            for (int tt = 0; tt < 8; ++tt) { A[tt][0] = *(const LAS f32x4*)(mb + tt * 64); A[tt][1] = *(const LAS f32x4*)(mb + tt * 64 + 4); }
#pragma unroll
            for (int tt = 0; tt < 8; ++tt) { Bm[tt][0] = *(const LAS f32x4*)(mb + (8 + tt) * 64); Bm[tt][1] = *(const LAS f32x4*)(mb + (8 + tt) * 64 + 4); }
#pragma unroll
            for (int sx = 0; sx < 8; ++sx) { xb[sx] = d[sx];
#pragma unroll
                for (int tt = sx + 1; tt < 8; ++tt) d[tt] = fma_s(A[tt][sx >> 2][sx & 3], xb[sx], d[tt]); }
#pragma unroll
            for (int sx = 0; sx < 8; ++sx)
#pragma unroll
                for (int tt = 0; tt < 8; ++tt) d[8 + tt] = fma_s(Bm[tt][sx >> 2][sx & 3], xb[sx], d[8 + tt]);
            asm volatile("" : "+v"(d[8]), "+v"(d[15]) :: "memory");
#pragma unroll
            for (int tt = 0; tt < 8; ++tt) { A[tt][0] = *(const LAS f32x4*)(mb + (8 + tt) * 64 + 8); A[tt][1] = *(const LAS f32x4*)(mb + (8 + tt) * 64 + 12); }
#pragma unroll
            for (int sx = 0; sx < 8; ++sx) { xb[8 + sx] = d[8 + sx];
#pragma unroll
                for (int tt = sx + 1; tt < 8; ++tt) d[8 + tt] = fma_s(A[tt][sx >> 2][sx & 3], xb[8 + sx], d[8 + tt]); }
            if (lane < 16) {
#pragma unroll
                for (int t = 0; t < 16; ++t) *(LAS bf16_t*)(L + SL_KH * W_SLOT + (16 * I + t) * 48 + lane * 2) = (bf16_t)(cvt_pk_bf16(xb[t], 0.f) & 0xffffu);
            }
        }
        LDS_BARRIER();
        asm volatile("" ::: "memory");
        { const int un = u + F.G; if (un < 96 * NCH) { const int bhn = un % 96, cn = un / 96, bn = bhn / 24, headn = bhn - bn * 24, tokbn = bn * SEQ + cn * CH, c4n = headn * 64 + 4 * li;
#pragma unroll
            for (int p = 0; p < 2; ++p) prep_load(RN[p], z, LW, tokbn + p * 32 + wave * 4 + tq, c4n);
            par_load(PN, Q, c4n); } }
        for (int repx = 0; repx < REP_WX; ++repx) if (wave < 2) {
            const int slotX = wave == 0 ? SL_W1T : SL_U0T;
            LAS unsigned char* TI = L + SL_KH * W_SLOT;
            LAS unsigned char* DT = TI + 3072 + wave * 3072;
            const bf16x8 zf = (bf16x8){0, 0, 0, 0, 0, 0, 0, 0};
#pragma unroll
            for (int I = 0; I < 4; ++I) {
                f32x4 acc[4];
                if (wave == 0) {
#pragma unroll
                    for (int ct = 0; ct < 4; ++ct)
#pragma unroll
                        for (int r = 0; r < 4; ++r) acc[ct][r] = bf2f(*(const LAS bf16_t*)(L + SL_NT * W_SLOT + (16 * I + 4 * fq + r) * WRS + (16 * ct + fr) * 2));
                } else {
#pragma unroll
                    for (int ct = 0; ct < 4; ++ct)
#pragma unroll
                        for (int r = 0; r < 4; ++r) acc[ct][r] = CL[(16 * I + 4 * fq + r) * 64 + 16 * ct + fr];
                }
                if (I > 0) {
#pragma unroll
                    for (int ks = 0; ks < (I + 1) / 2; ++ks) {
                        const bool half = (32 * ks + 16 == 16 * I);
                        bf16x8 af = wfrag(L, SL_BH, 16 * I + fr, ks, fq);
                        if (half && fq >= 2) af = zf;
#pragma unroll
                        for (int ct = 0; ct < 4; ++ct) { bf16x8 bfr = wfrag(L, slotX, 16 * ct + fr, ks, fq);
                            if (half && fq >= 2) bfr = zf;
                            acc[ct] = __builtin_amdgcn_mfma_f32_16x16x32_bf16(af, bfr, acc[ct], 0, 0, 0); }
                    }
                }
#pragma unroll
                for (int ct = 0; ct < 4; ++ct) { u32x2 w; w.x = cvt_pk_bf16(acc[ct][0], acc[ct][1]); w.y = cvt_pk_bf16(acc[ct][2], acc[ct][3]); *(LAS u32x2*)(DT + (16 * ct + fr) * 48 + 8 * fq) = w; }
                LDS_WAIT();
                bf16x8 af = *(const LAS bf16x8*)(TI + (16 * I + fr) * 48 + (fq & 1) * 16); if (fq >= 2) af = zf;
#pragma unroll
                for (int ct = 0; ct < 4; ++ct) { bf16x8 bfr = *(const LAS bf16x8*)(DT + (16 * ct + fr) * 48 + (fq & 1) * 16); if (fq >= 2) bfr = zf;
                    const f32x4 x = __builtin_amdgcn_mfma_f32_16x16x32_bf16(af, bfr, (f32x4){0.f, 0.f, 0.f, 0.f}, 0, 0, 0);
                    u32x2 w; w.x = cvt_pk_bf16(x[0], x[1]); w.y = cvt_pk_bf16(x[2], x[3]); *(LAS u32x2*)(L + slotX * W_SLOT + (16 * ct + fr) * WRS + (16 * I + 4 * fq) * 2) = w; }
                LDS_WAIT();
            }
        }
        LDS_BARRIER();
        for (int repo = 0; repo < REP_WO; ++repo) {
            const int kind = wave >> 1, ta0 = (wave & 1) * 2;
            float* gp = gh_ptr(wsl, bh, c, 0); float* hp = gh_ptr(wsl, bh, c, 1);
            bf16_t* qy = (bf16_t*)(wsl + WS_QY) + (size_t)u * 4096; float* y0t = (float*)(wsl + WS_Y0T) + (size_t)u * 4096;
            const int sA1 = kind == 0 ? SL_W1T : kind == 1 ? SL_BHT : kind == 2 ? SL_W1T : SL_NK, sB1 = kind == 0 ? SL_BHT : kind == 1 ? SL_U0T : kind == 2 ? SL_NB : SL_VT;
            const int sA2 = kind == 1 ? SL_KHT : SL_NB, sB2 = kind == 1 ? SL_VT : SL_U0T; const bool two = (kind & 1) != 0;
            bf16x8 Af[2][2], Bf[4][2];
#pragma unroll
            for (int a2 = 0; a2 < 2; ++a2)
#pragma unroll
                for (int ks = 0; ks < 2; ++ks) Af[a2][ks] = wfrag(L, sA1, 16 * (ta0 + a2) + fr, ks, fq);
#pragma unroll
            for (int tb = 0; tb < 4; ++tb)
#pragma unroll
                for (int ks = 0; ks < 2; ++ks) Bf[tb][ks] = wfrag(L, sB1, 16 * tb + fr, ks, fq);
            f32x4 acc[2][4];
#pragma unroll
            for (int a2 = 0; a2 < 2; ++a2)
#pragma unroll
                for (int tb = 0; tb < 4; ++tb) { acc[a2][tb] = (f32x4){0.f, 0.f, 0.f, 0.f};
#pragma unroll
                    for (int ks = 0; ks < 2; ++ks) acc[a2][tb] = __builtin_amdgcn_mfma_f32_16x16x32_bf16(Af[a2][ks], Bf[tb][ks], acc[a2][tb], 0, 0, 0); }
            if (two) {
#pragma unroll
                for (int a2 = 0; a2 < 2; ++a2)
#pragma unroll
                    for (int ks = 0; ks < 2; ++ks) Af[a2][ks] = wfrag(L, sA2, 16 * (ta0 + a2) + fr, ks, fq);
#pragma unroll
                for (int tb = 0; tb < 4; ++tb)
#pragma unroll
                    for (int ks = 0; ks < 2; ++ks) Bf[tb][ks] = wfrag(L, sB2, 16 * tb + fr, ks, fq);
#pragma unroll
                for (int a2 = 0; a2 < 2; ++a2)
#pragma unroll
                    for (int tb = 0; tb < 4; ++tb)
#pragma unroll
                        for (int ks = 0; ks < 2; ++ks) acc[a2][tb] = __builtin_amdgcn_mfma_f32_16x16x32_bf16(Af[a2][ks], Bf[tb][ks], acc[a2][tb], 0, 0, 0);
            }
#pragma unroll
            for (int a2 = 0; a2 < 2; ++a2)
#pragma unroll
                for (int tb = 0; tb < 4; ++tb) { const int ta = ta0 + a2; const f32x4 av = acc[a2][tb];
                    if (kind == 0) {
                        const int j = 16 * tb + fr; const float pl = PL[j];
                        f32x4 o;
#pragma unroll
                        for (int r = 0; r < 4; ++r) o[r] = pl * (av[r] + ((16 * ta + 4 * fq + r) == j ? 1.f : 0.f));
                        u32x2 w; w.x = cvt_pk_bf16(o[0], o[1]); w.y = cvt_pk_bf16(o[2], o[3]);
                        *(GAS u32x2*)((bf16_t*)gp + j * 64 + 16 * ta + 4 * fq) = w;
                    } else if (kind == 1) {
                        const f32x4 pl = *(const LAS f32x4*)(PL + 16 * ta + 4 * fq);
                        *(GAS f32x4*)(hp + (16 * tb + fr) * 64 + 16 * ta + 4 * fq) = pl * av;
                    } else if (kind == 2) {
                        const int t = 16 * tb + fr; const u32x2 rr = *(const LAS u32x2*)(L + SL_RT * W_SLOT + t * WRS + (16 * ta + 4 * fq) * 2);
                        u32x2 w; w.x = cvt_pk_bf16(av[0] + bflo(rr.x), av[1] + bfhi(rr.x)); w.y = cvt_pk_bf16(av[2] + bflo(rr.y), av[3] + bfhi(rr.y));
                        *(GAS u32x2*)(qy + t * 64 + 16 * ta + 4 * fq) = w;
                    } else {
                        *(GAS f32x4*)(y0t + (16 * tb + fr) * 64 + 16 * ta + 4 * fq) = av;
                    }
                }
        }
    }
    LDS_BARRIER();
}
DI void scan_w2(const Ctx& F, const RwPar& Q) {
    unsigned char* const wsl = F.ws; const int lane = F.lane, fr = lane & 15, fq = lane >> 4;
    LAS float* yb = (LAS float*)(F.lds + F.wave * 16384);
    const bf16_t* gate = (const bf16_t*)(wsl + WS_GATE); const bf16_t* Eb = (const bf16_t*)(wsl + WS_E); bf16_t* cat = (bf16_t*)(wsl + WS_CAT);
    for (int u = F.gw; u < 96 * NCH; u += F.ngw) {
        const int bh = u % 96, c = u / 96, b = bh / 24, head = bh - b * 24, tokb = b * SEQ + c * CH;
        const bf16_t* qy = (const bf16_t*)(wsl + WS_QY) + (size_t)u * 4096; const float* y0t = (const float*)(wsl + WS_Y0T) + (size_t)u * 4096;
        f32x4 acc[4][4];
#pragma unroll
        for (int tt = 0; tt < 4; ++tt)
#pragma unroll
            for (int it = 0; it < 4; ++it) acc[tt][it] = *(const GAS f32x4*)(y0t + (16 * it + fr) * 64 + 16 * tt + 4 * fq);
        if (c > 0) {
            const bf16_t* sp = (const bf16_t*)gh_ptr(wsl, bh, c - 1, 0) + 4096;
            bf16x8 Bf[4][2];
#pragma unroll
            for (int it = 0; it < 4; ++it)
#pragma unroll
                for (int ks = 0; ks < 2; ++ks) Bf[it][ks] = *(const GAS bf16x8*)(sp + (16 * it + fr) * 64 + 32 * ks + 8 * fq);
#pragma unroll
            for (int tt = 0; tt < 4; ++tt)
#pragma unroll
                for (int ks = 0; ks < 2; ++ks) { const bf16x8 Af = *(const GAS bf16x8*)(qy + (16 * tt + fr) * 64 + 32 * ks + 8 * fq);
#pragma unroll
                    for (int it = 0; it < 4; ++it) acc[tt][it] = __builtin_amdgcn_mfma_f32_16x16x32_bf16(Af, Bf[it][ks], acc[tt][it], 0, 0, 0); }
        }
#pragma unroll
        for (int tt = 0; tt < 4; ++tt)
#pragma unroll
            for (int it = 0; it < 4; ++it)
#pragma unroll
                for (int r = 0; r < 4; ++r) yb[(16 * tt + 4 * fq + r) * 64 + 16 * it + fr] = acc[tt][it][r];
        LDS_WAIT();
#pragma unroll 4
        for (int k = 0; k < 16; ++k) {
            const int slot = k * 64 + lane, t = slot >> 4, li = slot & 15, c4 = head * 64 + 4 * li, tok = tokb + t;
            const f32x4 y = *(const LAS f32x4*)(yb + t * 64 + 4 * li);
            const u32x2 ev = *(const GAS u32x2*)(Eb + (size_t)tok * CMIX + c4), gt = *(const GAS u32x2*)(gate + (size_t)tok * CMIX + c4);
            const float mean = sum16(y.x + y.y + y.z + y.w) * (1.f / 64.f);
            const f32x4 d = y - mean;
            const float var = sum16(d.x * d.x + d.y * d.y + d.z * d.z + d.w * d.w) * (1.f / 64.f);
            const float rstd = rsqrtf(var + GN_EPS);
            const f32x4 g4 = *(const GAS f32x4*)(Q.gng + c4), b4 = *(const GAS f32x4*)(Q.gnb + c4);
            f32x4 o = d * rstd * g4 + b4; o.x += bflo(ev.x); o.y += bfhi(ev.x); o.z += bflo(ev.y); o.w += bfhi(ev.y);
            u32x2 w; w.x = cvt_pk_bf16(o.x * bflo(gt.x), o.y * bfhi(gt.x)); w.y = cvt_pk_bf16(o.z * bflo(gt.y), o.w * bfhi(gt.y));
            *(GAS u32x2*)(cat + (size_t)tok * DM + c4) = w;
        }
        LDS_WAIT();
    }
}
DI void scan_passB(const Ctx& F) {
    unsigned char* const wsl = F.ws; const int lane = F.lane, fr = lane & 15, fq = lane >> 4, ih = F.wave >> 2, q = F.wave & 3, bh = F.bid;
    LAS unsigned char* Sx0 = F.lds;
    bf16x8 ga[7][2]; f32x4 hq[7][2];
#define PB_LOAD(set, cc) do { const GAS bf16_t* _gp = (const GAS bf16_t*)gh_ptr(wsl, bh, (cc), 0) + (16 * q + fr) * 64 + 8 * fq; const GAS float* _hp = (const GAS float*)(gh_ptr(wsl, bh, (cc), 1) + (32 * ih + fr) * 64 + 16 * q + 4 * fq); \
        ga[set][0] = *(const GAS bf16x8*)_gp; ga[set][1] = *(const GAS bf16x8*)(_gp + 32); \
        _Pragma("unroll") for (int _r = 0; _r < 2; ++_r) hq[set][_r] = *(const GAS f32x4*)(_hp + (16 * _r) * 64); } while (0)
    PB_LOAD(0, 0); PB_LOAD(1, 1); PB_LOAD(2, 2); PB_LOAD(3, 3); PB_LOAD(4, 4); PB_LOAD(5, 5);
    for (int c7 = 0; c7 < NCH - 1; c7 += 7) {
#pragma unroll
        for (int u7 = 0; u7 < 7; ++u7) {
            const int c = c7 + u7;
            f32x4 acc[2];
#pragma unroll
            for (int it = 0; it < 2; ++it) acc[it] = hq[u7][it];
            const bf16x8 a0 = ga[u7][0], a1 = ga[u7][1];
            PB_LOAD((u7 + 6) % 7, (c + 6 < NCH - 1) ? c + 6 : NCH - 2);
            if (c > 0) {
#pragma unroll
                for (int it = 0; it < 2; ++it) {
                    acc[it] = __builtin_amdgcn_mfma_f32_16x16x32_bf16(a0, *(const LAS bf16x8*)(Sx0 + (c & 1) * W_SLOT + (32 * ih + 16 * it + fr) * WRS + fq * 16), acc[it], 0, 0, 0);
                    acc[it] = __builtin_amdgcn_mfma_f32_16x16x32_bf16(a1, *(const LAS bf16x8*)(Sx0 + (c & 1) * W_SLOT + (32 * ih + 16 * it + fr) * WRS + 64 + fq * 16), acc[it], 0, 0, 0); }
            }
            GAS bf16_t* op = (GAS bf16_t*)gh_ptr(wsl, bh, c, 0) + 4096 + (32 * ih + fr) * 64 + 16 * q + 4 * fq;
#pragma unroll
            for (int it = 0; it < 2; ++it) { u32x2 w; w.x = cvt_pk_bf16(acc[it].x, acc[it].y); w.y = cvt_pk_bf16(acc[it].z, acc[it].w);
                *(GAS u32x2*)(op + (16 * it) * 64) = w; *(LAS u32x2*)(Sx0 + ((c + 1) & 1) * W_SLOT + (32 * ih + 16 * it + fr) * WRS + (16 * q + 4 * fq) * 2) = w; }
            LDS_BARRIER();
        }
    }
#undef PB_LOAD
}

DI void ln1_router(const Ctx& F, const Params& P, int l, const float* xin) {
    unsigned char* const wsl = F.ws; float* const outl = F.out; (void)outl;
    const float* g = PIN(5) + (size_t)l * DM; const float* bta = PIN(6) + (size_t)l * DM;
    const float* gb = PIN(10) + l * 4; const float* eb = PIN(12) + l * 32;
    const bf16_t* hb = (const bf16_t*)(wsl + WS_HB); bf16_t* xb = (bf16_t*)(wsl + WS_XB); float* xo = outl;
    const bf16_t* wrt = (const bf16_t*)(wsl + WS_WSW + (size_t)l * WSW_STRIDE);
    unsigned* cnt = (unsigned*)(wsl + WS_CTL) + CW_CNT + l * 32 * 64;
    int* ltok = (int*)(wsl + WS_LTOK); float* lgate = (float*)(wsl + WS_LGATE); int* lslot = (int*)(wsl + WS_LSLOT);
    const int lane = F.lane, fr = lane & 15, fq = lane >> 4, wave = F.wave;
    LAS float* lg = (LAS float*)(F.lds + (wave & 3) * 4096);
    LAS float* lgp = (LAS float*)(F.lds + 16384 + (wave & 3) * 4096);
    LAS int* cntl = (LAS int*)(F.lds + 32768); LAS int* basel = cntl + 32;
    if (F.tid < NEXP) cntl[F.tid] = 0;
    __syncthreads();
    for (int blk = F.bid; blk < NTOK / 64; blk += F.G) {
#pragma unroll 1
        for (int pass = 0; pass < 4; ++pass) {
            int lno = lane; asm volatile("" : "+v"(lno));
            const int hr2 = lno >> 5, l32 = lno & 31;
            const size_t ro = (size_t)(blk * 64 + wave * 8 + pass * 2 + hr2) * DM + 8 * l32;
            u32x4 xr[8], hr[8];
#pragma unroll
            for (int i = 0; i < 8; ++i) { xr[i] = *(const GAS u32x4*)(xb + ro + 256 * i); hr[i] = *(const GAS u32x4*)(hb + ro + 256 * i); }
            float s = 0.f, s2 = 0.f;
#pragma unroll
            for (int i = 0; i < 8; ++i) {
#pragma unroll
                for (int e = 0; e < 4; ++e) { const float v0 = ALPHA * bflo(xr[i][e]) + bflo(hr[i][e]), v1 = ALPHA * bfhi(xr[i][e]) + bfhi(hr[i][e]); s += v0 + v1; s2 += v0 * v0 + v1 * v1; } }
            s = sum16(s); s2 = sum16(s2); s += __shfl_xor(s, 16); s2 += __shfl_xor(s2, 16);
            const float mean = s * (1.f / DM), rstd = rsqrtf(fmaxf(s2 * (1.f / DM) - mean * mean, 0.f) + LN_EPS);
#pragma unroll
            for (int i = 0; i < 8; ++i) { const int col = 256 * i + 8 * l32;
                const f32x4 g0 = *(const GAS f32x4*)(g + col), g1 = *(const GAS f32x4*)(g + col + 4), b0 = *(const GAS f32x4*)(bta + col), b1 = *(const GAS f32x4*)(bta + col + 4);
                u32x4 w;
#pragma unroll
                for (int e = 0; e < 4; ++e) { const float v0 = ALPHA * bflo(xr[i][e]) + bflo(hr[i][e]), v1 = ALPHA * bfhi(xr[i][e]) + bfhi(hr[i][e]);
                    const float gg0 = e < 2 ? g0[2 * e] : g1[2 * e - 4], gg1 = e < 2 ? g0[2 * e + 1] : g1[2 * e - 3], bb0 = e < 2 ? b0[2 * e] : b1[2 * e - 4], bb1 = e < 2 ? b0[2 * e + 1] : b1[2 * e - 3];
                    w[e] = cvt_pk_bf16((v0 - mean) * rstd * gg0 + bb0, (v1 - mean) * rstd * gg1 + bb1); }
                *(GAS u32x4*)(xb + ro + 256 * i) = w;
                asm volatile("" ::: "memory"); }
        }
        VM_WAIT();
        __syncthreads();
        __builtin_amdgcn_fence(__ATOMIC_ACQUIRE, "agent");
        VM_WAIT();
        const int row0 = blk * 64 + (wave & 3) * 16, kh = wave >> 2, krot = (F.bid * 5 + wave * 3) & 31;
        f32x4 acc[3];
#pragma unroll
        for (int ct = 0; ct < 3; ++ct) acc[ct] = (f32x4){0.f, 0.f, 0.f, 0.f};
        const bf16_t* arow = xb + (size_t)(row0 + fr) * DM + 8 * fq + kh * 1024;
        LAS unsigned char* wst = F.lds + 36864;
        u32x4 wreg[6];
        { const int st = F.bid & 7;
#pragma unroll
          for (int i = 0; i < 6; ++i) { const int ch = F.tid + NT * i, row = ch >> 4, c16 = ch & 15, rkh = row / 96, rr = row - rkh * 96;
              wreg[i] = *(const GAS u32x4*)(wrt + (size_t)rr * DM + rkh * 1024 + st * 128 + c16 * 8); } }
#pragma unroll 1
        for (int si = 0; si < 8; ++si) {
            const int st = (si + F.bid) & 7;
            LAS unsigned char* wb = wst + (si & 1) * 52224;
#pragma unroll
            for (int i = 0; i < 6; ++i) { const int ch = F.tid + NT * i, row = ch >> 4, c16 = ch & 15; *(LAS u32x4*)(wb + row * 272 + c16 * 16) = wreg[i]; }
            if (si + 1 < 8) { const int stn = (si + 1 + F.bid) & 7;
#pragma unroll
                for (int i = 0; i < 6; ++i) { const int ch = F.tid + NT * i, row = ch >> 4, c16 = ch & 15, rkh = row / 96, rr = row - rkh * 96;
                    wreg[i] = *(const GAS u32x4*)(wrt + (size_t)rr * DM + rkh * 1024 + stn * 128 + c16 * 8); } }
            bf16x8 af[4];
#pragma unroll
            for (int ksl = 0; ksl < 4; ++ksl) af[ksl] = *(const GAS bf16x8*)(arow + st * 128 + ksl * 32);
            LDS_BARRIER();
#pragma unroll
            for (int ksl = 0; ksl < 4; ++ksl)
#pragma unroll
                for (int ct = 0; ct < 3; ++ct) {
                    acc[ct] = __builtin_amdgcn_mfma_f32_16x16x32_bf16(af[ksl], *(const LAS bf16x8*)(wb + (kh * 96 + 16 * ct + fr) * 272 + ksl * 64 + fq * 16), acc[ct], 0, 0, 0);
                    acc[ct] = __builtin_amdgcn_mfma_f32_16x16x32_bf16(af[ksl], *(const LAS bf16x8*)(wb + (kh * 96 + 48 + 16 * ct + fr) * 272 + ksl * 64 + fq * 16), acc[ct], 0, 0, 0);
                }
        }
        if (kh == 1) {
#pragma unroll
            for (int ct = 0; ct < 3; ++ct)
#pragma unroll
                for (int jj = 0; jj < 4; ++jj) lgp[(4 * fq + jj) * 48 + 16 * ct + fr] = acc[ct][jj];
        }
        __syncthreads();
        if (kh == 0) {
#pragma unroll
            for (int ct = 0; ct < 3; ++ct)
#pragma unroll
                for (int jj = 0; jj < 4; ++jj) lg[(4 * fq + jj) * 48 + 16 * ct + fr] = acc[ct][jj] + lgp[(4 * fq + jj) * 48 + 16 * ct + fr];
        }
        LDS_WAIT();
        int se0 = 0, se1 = 0, sr0 = 0, sr1 = 0, stok = 0; float sg0 = 0.f, sg1 = 0.f;
        if (kh == 0 && lane < 16) {
            const LAS float* L = lg + lane * 48; const int tok = row0 + lane;
            float gl[4]; int grp_i = 0; float gmx;
#pragma unroll
            for (int q = 0; q < 4; ++q) gl[q] = L[q] + gb[q];
            gmx = gl[0];
#pragma unroll
            for (int q = 1; q < 4; ++q) if (gl[q] > gmx) { gmx = gl[q]; grp_i = q; }
            float gs = 0.f;
#pragma unroll
            for (int q = 0; q < 4; ++q) gs += __expf(gl[q] - gmx);
            const float pg = 1.f / gs;
            float el[8];
#pragma unroll
            for (int q = 0; q < 8; ++q) el[q] = L[4 + 8 * grp_i + q] + eb[8 * grp_i + q];
            int i0 = 0; float m0 = el[0];
#pragma unroll
            for (int q = 1; q < 8; ++q) if (el[q] > m0) { m0 = el[q]; i0 = q; }
            int i1 = -1; float m1 = -3.0e38f;
#pragma unroll
            for (int q = 0; q < 8; ++q) if (q != i0 && el[q] > m1) { m1 = el[q]; i1 = q; }
            if (i1 < 0) { i1 = (i0 == 0) ? 1 : 0; m1 = m0; }
            const float p1 = __expf(m1 - m0), den = 1.f / (1.f + p1);
            const float g0 = pg * den, g1 = pg * p1 * den;
            se0 = grp_i * 8 + i0; se1 = grp_i * 8 + i1; sg0 = g0; sg1 = g1; stok = tok;
            sr0 = __hip_atomic_fetch_add(cntl + se0, 1, __ATOMIC_RELAXED, __HIP_MEMORY_SCOPE_WORKGROUP);
            sr1 = __hip_atomic_fetch_add(cntl + se1, 1, __ATOMIC_RELAXED, __HIP_MEMORY_SCOPE_WORKGROUP);
        }
        __syncthreads();
        if (wave == 0 && lane < NEXP) { const int n = cntl[lane]; basel[lane] = n ? (int)__hip_atomic_fetch_add(cnt + lane * 64, (unsigned)n, __ATOMIC_RELAXED, __HIP_MEMORY_SCOPE_AGENT) : 0; }
        __syncthreads();
        if (kh == 0 && lane < 16) {
            const int pos0 = basel[se0] + sr0, pos1 = basel[se1] + sr1;
            ltok[se0 * LISTCAP + pos0] = stok; lgate[se0 * LISTCAP + pos0] = sg0; lslot[se0 * LISTCAP + pos0] = 2 * stok;
            ltok[se1 * LISTCAP + pos1] = stok; lgate[se1 * LISTCAP + pos1] = sg1; lslot[se1 * LISTCAP + pos1] = 2 * stok + 1;
        }
        __syncthreads();
        if (F.tid < NEXP) cntl[F.tid] = 0;
        __syncthreads();
    }
}

DI void ln2_phase(const Ctx& F, const Params& P, int l) {
    unsigned char* const wsl = F.ws; float* const outl = F.out;
    const float* g = PIN(7) + (size_t)l * DM; const float* bta = PIN(8) + (size_t)l * DM;
    const bf16_t* ys = (const bf16_t*)(wsl + WS_YS); bf16_t* xb = (bf16_t*)(wsl + WS_XB); float* xo = outl;
#pragma unroll 1
    for (int rp = F.gw; rp < NTOK / 2; rp += F.ngw) {
        int lno = F.lane; asm volatile("" : "+v"(lno));
        const int hr2 = lno >> 5, l32 = lno & 31, row = 2 * rp + hr2;
        const size_t ro = (size_t)row * DM + 8 * l32;
        u32x4 xr[8], y0[8], y1[8];
#pragma unroll
        for (int i = 0; i < 8; ++i) { xr[i] = *(const GAS u32x4*)(xb + ro + 256 * i); y0[i] = *(const GAS u32x4*)(ys + 2 * (size_t)row * DM + 8 * l32 + 256 * i); y1[i] = *(const GAS u32x4*)(ys + (2 * (size_t)row + 1) * DM + 8 * l32 + 256 * i); }
        float s = 0.f, s2 = 0.f;
#pragma unroll
        for (int i = 0; i < 8; ++i) {
#pragma unroll
            for (int e = 0; e < 4; ++e) { const float v0 = ALPHA * bflo(xr[i][e]) + (bflo(y0[i][e]) + bflo(y1[i][e])), v1 = ALPHA * bfhi(xr[i][e]) + (bfhi(y0[i][e]) + bfhi(y1[i][e])); s += v0 + v1; s2 += v0 * v0 + v1 * v1; } }
        s = sum16(s); s2 = sum16(s2); s += __shfl_xor(s, 16); s2 += __shfl_xor(s2, 16);
        const float mean = s * (1.f / DM), rstd = rsqrtf(fmaxf(s2 * (1.f / DM) - mean * mean, 0.f) + LN_EPS);
#pragma unroll
        for (int i = 0; i < 8; ++i) { const int col = 256 * i + 8 * l32;
            const f32x4 g0 = *(const GAS f32x4*)(g + col), g1 = *(const GAS f32x4*)(g + col + 4), b0 = *(const GAS f32x4*)(bta + col), b1 = *(const GAS f32x4*)(bta + col + 4);
            float o[8];
#pragma unroll
            for (int e = 0; e < 4; ++e) { const float v0 = ALPHA * bflo(xr[i][e]) + (bflo(y0[i][e]) + bflo(y1[i][e])), v1 = ALPHA * bfhi(xr[i][e]) + (bfhi(y0[i][e]) + bfhi(y1[i][e]));
                const float gg0 = e < 2 ? g0[2 * e] : g1[2 * e - 4], gg1 = e < 2 ? g0[2 * e + 1] : g1[2 * e - 3], bb0 = e < 2 ? b0[2 * e] : b1[2 * e - 4], bb1 = e < 2 ? b0[2 * e + 1] : b1[2 * e - 3];
                o[2 * e] = (v0 - mean) * rstd * gg0 + bb0; o[2 * e + 1] = (v1 - mean) * rstd * gg1 + bb1; }
            if (l == NLAYER - 1) { *(GAS f32x4*)(xo + (size_t)row * DM + col) = (f32x4){o[0], o[1], o[2], o[3]}; *(GAS f32x4*)(xo + (size_t)row * DM + col + 4) = (f32x4){o[4], o[5], o[6], o[7]}; }
            else { u32x4 w; w.x = cvt_pk_bf16(o[0], o[1]); w.y = cvt_pk_bf16(o[2], o[3]); w.z = cvt_pk_bf16(o[4], o[5]); w.w = cvt_pk_bf16(o[6], o[7]); *(GAS u32x4*)(xb + ro + 256 * i) = w; }
            asm volatile("" ::: "memory"); }
    }
}

DI int moe_table(const Ctx& F, int l) {
    unsigned char* const wsl = F.ws; float* const outl = F.out; (void)outl;
    LAS int* tb = (LAS int*)(F.lds + LDS_CTL_OFF) + 16;
    const unsigned* cnt = (const unsigned*)(wsl + WS_CTL) + CW_CNT + l * 32 * 64;
    __syncthreads();
    if (F.tid == 0) { int acc = 0;
        for (int e = 0; e < NEXP; ++e) { tb[e] = acc; const int n = (int)__hip_atomic_load(cnt + e * 64, __ATOMIC_RELAXED, __HIP_MEMORY_SCOPE_AGENT); acc += (n + 255) >> 8; }
        tb[NEXP] = acc; }
    __syncthreads();
    return tb[NEXP];
}


#ifdef MK_DEBUG
constexpr int CW_DBG = 40960;
DI void dbg_count_bf16(const Ctx& F, const bf16_t* p, size_t n, int k) {
    unsigned bad = 0; const size_t gt = (size_t)F.bid * NT + F.tid, ngt = (size_t)F.G * NT;
    for (size_t i = gt; i < n; i += ngt) { const unsigned b = p[i]; const float v = bf2f(b); if ((b & 0x7f80u) == 0x7f80u || fabsf(v) > 1.0e6f) ++bad; }
    if (bad) atomicAdd((unsigned*)(F.ws + WS_CTL) + CW_DBG + k * 64, bad);
}
DI void dbg_count_f32(const Ctx& F, const float* p, size_t n, int k) {
    unsigned bad = 0; const size_t gt = (size_t)F.bid * NT + F.tid, ngt = (size_t)F.G * NT;
    for (size_t i = gt; i < n; i += ngt) { const float v = p[i]; if (!(fabsf(v) <= 1.0e6f)) ++bad; }
    if (bad) atomicAdd((unsigned*)(F.ws + WS_CTL) + CW_DBG + k * 64, bad);
}
#endif
constexpr int PH_PER_LAYER = 11, N_PHASES = 1 + NLAYER * PH_PER_LAYER;

__global__ void __launch_bounds__(NT, 2) mega_fwd(Params P) {
    extern __shared__ __attribute__((aligned(16))) unsigned char lds_raw[];
    Ctx F0;
    F0.lds = (LAS unsigned char*)lds_raw;
    F0.tid = threadIdx.x; F0.lane = F0.tid & 63; F0.wave = __builtin_amdgcn_readfirstlane(F0.tid >> 6);
    F0.G = gridDim.x; F0.bid = blockIdx.x; F0.gw = F0.bid * NWAVES + F0.wave; F0.ngw = F0.G * NWAVES;
    F0.ws = P.ws; F0.out = P.out;
    for (int u = F0.tid; u < (LDS_BYTES - LDS_CTL_OFF) / 4; u += NT) ((LAS unsigned*)(F0.lds + LDS_CTL_OFF))[u] = 0u;
    __syncthreads();
    XcdBarrier bar; bar.bar = (unsigned*)(F0.ws + WS_CTL) + CW_BAR; bar.x = 0; bar.st = nullptr;
#if !MK_PER_PHASE
    bar = xcd_barrier_post((unsigned*)(F0.ws + WS_CTL) + CW_BAR, (volatile LAS unsigned*)(F0.lds + LDS_CTL_OFF));
#endif
    const int lo = P.ph_lo, hi = P.ph_hi;
#define IN(k) (lo <= (k) && (k) < hi)
#if MK_PER_PHASE
#define SEAM(k) do { } while (0)
#else
#define SEAM(k) do { if ((k) + 1 < hi) { XcdBarrier _b = bar; asm volatile("" : "+s"(_b.bar), "+s"(_b.x)); xcd_barrier(_b); } } while (0)
#endif
#define WSL const Ctx F = relaunder(F0); unsigned char* const ws = F.ws; bf16_t* const xb = (bf16_t*)(ws + WS_XB); bf16_t* const zb = (bf16_t*)(ws + WS_Z); bf16_t* const cat = (bf16_t*)(ws + WS_CAT); (void)xb; (void)zb; (void)cat

    if (IN(0)) { WSL; phase_prologue(F, P); SEAM(0); }

    for (int l = 0; l < NLAYER; ++l) {
        const int kind = l % 3, j = l / 3, pb = 1 + l * PH_PER_LAYER;
        const int zw = (kind == 0) ? ZW_RWKV : ZW_OTH, qcol = (kind == 0) ? 5056 : 4608;
        if (IN(pb + 0)) {
            WSL; const bf16_t* winT = (const bf16_t*)(ws + WS_WIN + (size_t)l * WIN_STRIDE);
            if (kind != 2) dense_gemm(F, xb, DM, winT, DM, NTOK, zw, DM, zb, zw, 0);
            else {
                dense_gemm(F, xb, DM, winT, DM, NTOK, 3072, DM, zb, zw, 0);
                dense_gemm(F, xb, DM, winT + (size_t)4608 * DM, DM, NTOK, 512, DM, zb + 4608, zw, 0);
                dense_gemm(F, winT + (size_t)3072 * DM, DM, xb, DM, CMIX, NTOK, DM, (bf16_t*)(ws + WS_ACT), NTOK, 128);
            }
            if (l == 0) {
                dense_gemm(F, (const bf16_t*)(ws + WS_MEMB), DM, (const bf16_t*)(ws + WS_WK), DM, NBATCH * MEML, 2048, DM, (bf16_t*)(ws + WS_KM), 2048, 128);
                dense_gemm(F, (const bf16_t*)(ws + WS_WV), DM, (const bf16_t*)(ws + WS_MEMB), DM, 2048, NBATCH * MEML, DM, (bf16_t*)(ws + WS_VMT), 1024, 192);
            }
            SEAM(pb + 0);
        }
        if (IN(pb + 1)) {
            WSL;
            if (kind == 0) { for (int rep = 0; rep < REP_PREP; ++rep) rwkv_prep1(F, P, j, zb); for (int rep = 0; rep < REP_MIX * REP_MA; ++rep) memattn_all(F, l, zb, zw, qcol); }
            else if (kind == 1) { for (int rep = 0; rep < REP_MIX; ++rep) conv_mix(F, P, zb); for (int rep = 0; rep < REP_MIX * REP_MA; ++rep) memattn_all(F, l, zb, zw, qcol); for (int rep = 0; rep < REP_CONV; ++rep) expert_convert(F, P, l, F.gw, F.ngw); }
            else { for (int rep = 0; rep < REP_MIX * REP_SB; ++rep) sb_attention(F, zb); for (int rep = 0; rep < REP_MIX * REP_MA; ++rep) memattn_all(F, l, zb, zw, qcol); for (int rep = 0; rep < REP_CONV; ++rep) expert_convert(F, P, l, F.gw, F.ngw); }
            SEAM(pb + 1);
        }
        if (kind == 0) {
            if (IN(pb + 2)) {
                WSL; const bf16_t* act = (const bf16_t*)(ws + WS_ACT); const bf16_t* wa = (const bf16_t*)(ws + WS_LORA + (size_t)j * LORA_STRIDE);
                dense_gemm(F, act, 512, wa, 256, NTOK, 3072, 256, (bf16_t*)(ws + WS_LW), 3072, 0);
                dense_gemm(F, act + 256, 512, wa + (size_t)3072 * 256, 256, NTOK, CMIX, 256, (bf16_t*)(ws + WS_GATE), CMIX, 0);
                SEAM(pb + 2);
            }
            if (IN(pb + 3)) { WSL; const RwPar Q{PIN(17) + (size_t)j * 5056, PIN(18) + j * CMIX, PIN(20) + j * CMIX, PIN(23) + j * CMIX, PIN(24) + j * CMIX, PIN(25) + j * CMIX, PIN(26) + j * CMIX, PIN(27) + j * CMIX};
                for (int rep = 0; rep < REP_SCAN; ++rep) scan_w1(F, Q, zb); SEAM(pb + 3); }
            if (IN(pb + 4)) {
                WSL;
                if (F.bid < 96) scan_passB(F);
                else expert_convert(F, P, l, (F.bid - 96) * NWAVES + F.wave, (F.G - 96) * NWAVES);
                SEAM(pb + 4);
            }
            if (IN(pb + 5)) { WSL; const RwPar Q{PIN(17) + (size_t)j * 5056, PIN(18) + j * CMIX, PIN(20) + j * CMIX, PIN(23) + j * CMIX, PIN(24) + j * CMIX, PIN(25) + j * CMIX, PIN(26) + j * CMIX, PIN(27) + j * CMIX};
                for (int rep = 0; rep < REP_SCAN * REP_W2; ++rep) scan_w2(F, Q); SEAM(pb + 5); }
        }
        if (IN(pb + 6)) { WSL; dense_gemm(F, cat, DM, (const bf16_t*)(ws + WS_WOUT) + (size_t)l * DM * DM, DM, NTOK, DM, DM, (bf16_t*)(ws + WS_HB), DM, 0); SEAM(pb + 6); }
        if (IN(pb + 7)) { WSL; ln1_router(F, P, l, l == 0 ? PIN(0) : (const float*)P.out); SEAM(pb + 7); }
        if (IN(pb + 8)) {
            WSL; const int ntiles = moe_table(F, l);
            pg8::Gemm g{xb, (const bf16_t*)(ws + WS_EXP1), DM, DM, DM};
            pg8::MoeOrder<true> S; S.G = F.G; S.c = F.bid; S.npn = 4; S.total = ntiles * 4; S.tb = (const LAS int*)(F.lds + LDS_CTL_OFF) + 16; S.estride = (size_t)1024 * DM * 2;
            S.ltok = (const int*)(ws + WS_LTOK); S.cnt = (const unsigned*)(ws + WS_CTL) + CW_CNT + l * 32 * 64;
            pg8::EpiSwiGLU E{(bf16_t*)(ws + WS_HE)};
            for (int rep = 0; rep < REP_MOE; ++rep) pg8::gemm_phase<pg8::EpiSwiGLU, pg8::MoeOrder<true>>(F.lds, g, S, E);
            SEAM(pb + 8);
        }
        if (IN(pb + 9)) {
            WSL; const int ntiles = moe_table(F, l);
            pg8::Gemm g{(const bf16_t*)(ws + WS_HE), (const bf16_t*)(ws + WS_EXP2), DEXP, DEXP, DEXP};
            pg8::MoeOrder<false> S; S.G = F.G; S.c = F.bid; S.npn = 8; S.total = ntiles * 8; S.tb = (const LAS int*)(F.lds + LDS_CTL_OFF) + 16; S.estride = (size_t)DM * DEXP * 2;
            S.ltok = (const int*)(ws + WS_LTOK); S.cnt = (const unsigned*)(ws + WS_CTL) + CW_CNT + l * 32 * 64;
            pg8::EpiScatter E{(bf16_t*)(ws + WS_YS), (const int*)(ws + WS_LSLOT), (const float*)(ws + WS_LGATE), S.cnt};
            for (int rep = 0; rep < REP_MOE; ++rep) pg8::gemm_phase<pg8::EpiScatter, pg8::MoeOrder<false>>(F.lds, g, S, E);
            SEAM(pb + 9);
        }
        if (IN(pb + 10)) { WSL; ln2_phase(F, P, l); SEAM(pb + 10); }
    }
#ifdef MK_DEBUG
    {
        WSL;
        xcd_barrier(bar);
        dbg_count_bf16(F, (const bf16_t*)(ws + WS_CAT), (size_t)NTOK * DM, 0);
        dbg_count_bf16(F, (const bf16_t*)(ws + WS_HB), (size_t)NTOK * DM, 1);
        dbg_count_f32(F, (const float*)(ws + WS_LGATE), (size_t)32 * 16384, 2);
        dbg_count_bf16(F, (const bf16_t*)(ws + WS_YS), (size_t)32768 * 2048, 3);
        dbg_count_f32(F, (const float*)F.out, (size_t)NTOK * DM, 4);
        dbg_count_bf16(F, (const bf16_t*)(ws + WS_XB), (size_t)NTOK * DM, 5);
        xcd_barrier(bar);
        int first = 13;
        for (int k = 12; k >= 0; --k) if (__hip_atomic_load((unsigned*)(ws + WS_CTL) + CW_DBG + k * 64, __ATOMIC_RELAXED, __HIP_MEMORY_SCOPE_AGENT) != 0u) first = k;
        const float val = 1000.f * (float)(first + 1);
        for (size_t i = (size_t)F.bid * NT + F.tid; i < (size_t)NTOK * DM; i += (size_t)F.G * NT) F.out[i] = val;
    }
#endif
#undef IN
#undef SEAM
}

extern "C" void kernel_launch(void* const* d_in, const int* in_sizes, int n_in, void* d_out, int out_size, void* d_ws, size_t ws_size, hipStream_t stream) {
    static int grid = 0;
    if (grid == 0) {
        if (n_in != 31 || ws_size < WS_END) { fprintf(stderr, "kernel_launch: expected 31 inputs and >= %zu bytes of workspace, got %d / %zu\n", (size_t)WS_END, n_in, ws_size); grid = -1; return; }
        int dev = 0, cus = 0, per_cu = 0;
        if (hipGetDevice(&dev) != hipSuccess || hipDeviceGetAttribute(&cus, hipDeviceAttributeMultiprocessorCount, dev) != hipSuccess) { grid = -1; return; }
        if (hipFuncSetAttribute((const void*)mega_fwd, hipFuncAttributeMaxDynamicSharedMemorySize, LDS_BYTES) != hipSuccess) { fprintf(stderr, "kernel_launch: hipFuncSetAttribute failed\n"); grid = -1; return; }
        if (hipOccupancyMaxActiveBlocksPerMultiprocessor(&per_cu, (const void*)mega_fwd, NT, LDS_BYTES) != hipSuccess || per_cu < 1)
            fprintf(stderr, "kernel_launch: occupancy query reports %d workgroups per CU\n", per_cu);
        (void)hipGetLastError();
        grid = cus;
    }
    if (grid < 0) return;
    (void)hipMemsetAsync((char*)d_ws + WS_CTL, 0, CTL_BYTES, stream);
    Params p{};
    for (int i = 0; i < 31; ++i) p.in[i] = (const float*)d_in[i];
    p.out = (float*)d_out; p.ws = (unsigned char*)d_ws;
#if MK_PER_PHASE
    for (int ph = 0; ph < N_PHASES; ++ph) {
        if (ph > 0) { const int l = (ph - 1) / PH_PER_LAYER, loc = (ph - 1) % PH_PER_LAYER; if ((l % 3) != 0 && loc >= 2 && loc <= 5) continue; }
        p.ph_lo = ph; p.ph_hi = ph + 1;
        hipLaunchKernelGGL(mega_fwd, dim3(grid), dim3(NT), LDS_BYTES, stream, p);
    }
#else
#ifndef MK_PH_HI
#define MK_PH_HI N_PHASES
#endif
    p.ph_lo = 0; p.ph_hi = MK_PH_HI;
    hipLaunchKernelGGL(mega_fwd, dim3(grid), dim3(NT), LDS_BYTES, stream, p);
#endif
    const hipError_t le = hipPeekAtLastError();
    if (le != hipSuccess) fprintf(stderr, "kernel_launch: launch failed: %s\n", hipGetErrorName(le));
}
```

```cpp
#include <hip/hip_runtime.h>
#include <cstdio>
#include <cstdint>

#ifndef MK_PER_PHASE
#define MK_PER_PHASE 0
#endif
#ifndef MK_PH_HI
#define MK_PH_HI N_PHASES
#endif
#ifndef REP_GEMM
#define REP_GEMM 1
#endif
#ifndef REP_MOE
#define REP_MOE 1
#endif
#ifndef REP_SCAN
#define REP_SCAN 1
#endif
#ifndef REP_PREP
#define REP_PREP 1
#endif
#ifndef REP_MIX
#define REP_MIX 1
#endif
#ifndef REP_CONV
#define REP_CONV 1
#endif
#ifndef REP_SB
#define REP_SB 1
#endif
#ifndef REP_MA
#define REP_MA 1
#endif
#ifndef REP_WX
#define REP_WX 1
#endif
#ifndef REP_WS
#define REP_WS 1
#endif
#ifndef REP_WO
#define REP_WO 1
#endif
#ifndef REP_W2
#define REP_W2 1
#endif

#define LAS __attribute__((address_space(3)))
#define GAS __attribute__((address_space(1)))
#define DI __device__ __forceinline__
typedef unsigned short bf16_t;
typedef short bf16x8 __attribute__((ext_vector_type(8)));
typedef short s16x4 __attribute__((ext_vector_type(4)));
typedef float f32x2 __attribute__((ext_vector_type(2)));
typedef float f32x4 __attribute__((ext_vector_type(4)));
typedef float f32x8 __attribute__((ext_vector_type(8)));
typedef float f32x16 __attribute__((ext_vector_type(16)));
typedef unsigned u32x2 __attribute__((ext_vector_type(2)));
typedef unsigned u32x4 __attribute__((ext_vector_type(4)));

constexpr int NTOK = 16384, DM = 2048, SEQ = 4096, NBATCH = 4, CMIX = 1536, MEMW = 512, MEML = 256, NLAYER = 4;
constexpr int ZW_RWKV = 5632  , ZW_OTH = 5120, RW_IN_COLS = 5568;
constexpr int NEXP = 32, DEXP = 512, LISTCAP = 16384, MAXTILES = 160;
constexpr float LN_EPS = 1e-5f, ALPHA = 1.681792830507429f, GN_EPS = 64e-5f;
constexpr int NT = 512, NWAVES = 8;

constexpr size_t MiB = (size_t)1 << 20;
constexpr size_t WS_CTL = 0, CTL_BYTES = 1 * MiB;
constexpr size_t WS_WIN = 2 * MiB;
constexpr size_t WIN_STRIDE = 22 * MiB;
constexpr size_t WS_WOUT = 90 * MiB;
constexpr size_t WS_WK = 122 * MiB;
constexpr size_t WS_WV = 130 * MiB;
constexpr size_t WS_MEMB = 138 * MiB;
constexpr size_t WS_KM = 142 * MiB;
constexpr size_t WS_VMT = 146 * MiB;
constexpr size_t WS_LORA = 150 * MiB;
constexpr size_t LORA_STRIDE = 3 * MiB;
constexpr size_t WS_WSW = 156 * MiB;
constexpr size_t WSW_STRIDE = 393216;
constexpr size_t WS_EXP1 = 160 * MiB;
constexpr size_t WS_EXP2 = 288 * MiB;
constexpr size_t WS_XB = 352 * MiB;
constexpr size_t WS_Z = 416 * MiB;
constexpr size_t WS_CAT = 592 * MiB;
constexpr size_t WS_HB = 656 * MiB;
constexpr size_t WS_LTOK = 720 * MiB;
constexpr size_t WS_LGATE = 722 * MiB;
constexpr size_t WS_LSLOT = 724 * MiB;
constexpr size_t WS_HE = 728 * MiB;
constexpr size_t WS_YS = 768 * MiB;
constexpr size_t WS_ACT = 896 * MiB;
constexpr size_t WS_LW = 944 * MiB;
constexpr size_t WS_GATE = 1040 * MiB;
constexpr size_t WS_SCAN = 1088 * MiB;
constexpr size_t WS_V = 1568 * MiB;
constexpr size_t WS_Y = 1664 * MiB;
constexpr size_t WS_GH = 1760 * MiB;
constexpr size_t WS_QY = 1088 * MiB;
constexpr size_t WS_Y0T = 1152 * MiB;
constexpr size_t WS_E = 1280 * MiB;
constexpr size_t WS_END = 1952 * MiB;
constexpr int CW_BAR = 4096;
constexpr int CW_CNT = 16384;

constexpr int LDS_BYTES = 147456;
constexpr int LDS_CTL_OFF = 146432;

DI float bf2f(unsigned b) { return __uint_as_float(b << 16); }
typedef float cvt_f32x2 __attribute__((ext_vector_type(2)));
typedef __bf16 cvt_bf16x2 __attribute__((ext_vector_type(2)));
DI unsigned cvt_pk_bf16(float lo, float hi) { const cvt_f32x2 v = {lo, hi}; return __builtin_bit_cast(unsigned, __builtin_convertvector(v, cvt_bf16x2)); }
DI float bflo(unsigned w) { return __uint_as_float(w << 16); }
DI float bfhi(unsigned w) { return __uint_as_float(w & 0xffff0000u); }
DI float wave_sum(float v) {
#pragma unroll
    for (int o = 1; o < 64; o <<= 1) v += __shfl_xor(v, o);
    return v;
}
DI float sum16(float v) {
    v += __builtin_bit_cast(float, __builtin_amdgcn_update_dpp(0, __builtin_bit_cast(int, v), 0x128, 0xf, 0xf, false));
    v += __builtin_bit_cast(float, __builtin_amdgcn_update_dpp(0, __builtin_bit_cast(int, v), 0x124, 0xf, 0xf, false));
    v += __builtin_bit_cast(float, __builtin_amdgcn_update_dpp(0, __builtin_bit_cast(int, v), 0x122, 0xf, 0xf, false));
    v += __builtin_bit_cast(float, __builtin_amdgcn_update_dpp(0, __builtin_bit_cast(int, v), 0x121, 0xf, 0xf, false));
    return v;
}
DI float fma_s(float a, float b, float c) { float d; asm("v_fma_f32 %0, %1, %2, %3" : "=v"(d) : "v"(a), "v"(b), "v"(c)); return d; }
DI float sigmoidf_(float x) { return __builtin_amdgcn_rcpf(1.f + __expf(-x)); }
DI float softplusf_(float x) { return fmaxf(x, 0.f) + __logf(1.f + __expf(-fabsf(x))); }
#define LDS_WAIT() asm volatile("s_waitcnt lgkmcnt(0)" ::: "memory")
#define VM_WAIT() asm volatile("s_waitcnt vmcnt(0)" ::: "memory")
#define LDS_BARRIER() do { asm volatile("s_waitcnt lgkmcnt(0)" ::: "memory"); __builtin_amdgcn_s_barrier(); asm volatile("" ::: "memory"); } while (0)

template <class T> DI T* as_global(T* p) { return p; }
DI const float* kin_ptr(int i) { int off = i * 8; asm volatile("" : "+v"(off)); const char* ka = (const char*)__builtin_amdgcn_kernarg_segment_ptr();
    const unsigned long long p = *(const unsigned long long*)(ka + off);
    const unsigned lo = __builtin_amdgcn_readfirstlane((unsigned)p), hi = __builtin_amdgcn_readfirstlane((unsigned)(p >> 32));
    return as_global((const float*)(((unsigned long long)hi << 32) | lo)); }
#define PIN(i) kin_ptr(i)
DI unsigned char* opq(unsigned char* p) { asm volatile("" : "+s"(p)); return p; }
DI float* opqf(float* p) { asm volatile("" : "+s"(p)); return p; }

#define XB_TMO      128
#define XB_XCNT(j)  (256  + 64 * (j))
#define XB_XSUB(j)  (1280 + 64 * (j))
#define XB_XGEN(j)  (2304 + 64 * (j))
#define XB_TOP      3328
#define XB_TOPGEN   3392
#define XCD_BAR_WORDS 3456
#define XB_SPIN_CAP (1u << 20)

__device__ __forceinline__ unsigned xb_ld(unsigned* p)              { return __hip_atomic_load(p, __ATOMIC_RELAXED, __HIP_MEMORY_SCOPE_AGENT); }
__device__ __forceinline__ unsigned xb_add(unsigned* p, unsigned v) { return __hip_atomic_fetch_add(p, v, __ATOMIC_RELAXED, __HIP_MEMORY_SCOPE_AGENT); }
__device__ __forceinline__ unsigned xb_xcc_id() { return (unsigned)__builtin_amdgcn_s_getreg((3 << 11) | 20) & 0xFu; }
#define XB_SPIN(cond, bar) do { unsigned _sp = 0; while (cond) { __builtin_amdgcn_s_sleep(1); \
    if ((++_sp & 255u) == 0u) { if (xb_ld(&(bar)[XB_TMO])) break; if (_sp > XB_SPIN_CAP) { atomicAdd(&(bar)[XB_TMO], 1u); break; } } } } while (0)

struct XcdBarrier { unsigned* bar; unsigned x; volatile LAS unsigned* st; };

__device__ __forceinline__ XcdBarrier xcd_barrier_post(unsigned* bar, volatile LAS unsigned* st) {
    XcdBarrier b; b.bar = bar; b.x = xb_xcc_id(); b.st = st;
    if (threadIdx.x == 0) (void)xb_add(&bar[XB_XCNT(b.x)], 1u);
    return b;
}
__device__ __forceinline__ void xcd_barrier_complete(unsigned* bar, unsigned x, unsigned& nloc, unsigned& nx) {
    const unsigned G = gridDim.x * gridDim.y * gridDim.z;
    unsigned sum, cnt, mine, sp = 0u;
    for (;;) {
        sum = 0u; cnt = 0u; mine = 0u;
#pragma unroll
        for (unsigned j = 0; j < 16; ++j) { const unsigned c = xb_ld(&bar[XB_XCNT(j)]); sum += c; cnt += (c > 0u) ? 1u : 0u; mine = (j == x) ? c : mine; }
        if (sum == G) break;
        __builtin_amdgcn_s_sleep(1);
        if ((++sp & 255u) == 0u) { if (xb_ld(&bar[XB_TMO])) break; if (sp > XB_SPIN_CAP) { atomicAdd(&bar[XB_TMO], 1u); break; } }
    }
    nloc = mine > 0u ? mine : 1u; nx = cnt > 0u ? cnt : 1u;
}
__device__ __forceinline__ void xcd_barrier(const XcdBarrier& b) {
    asm volatile("s_waitcnt vmcnt(0)" ::: "memory");
    __syncthreads();
    if (threadIdx.x == 0) {
        unsigned* bar = b.bar;
        __builtin_amdgcn_s_waitcnt(0);
        unsigned nloc = b.st[0], nx = b.st[1];
        if (nloc == 0u) { xcd_barrier_complete(bar, b.x, nloc, nx); b.st[0] = nloc; b.st[1] = nx; }
        const unsigned old = xb_add(&bar[XB_XSUB(b.x)], 1u);
        const unsigned gen = old / nloc;
        if (old + 1u == (gen + 1u) * nloc) {
            __builtin_amdgcn_fence(__ATOMIC_RELEASE, "agent");
            asm volatile("s_waitcnt vmcnt(0)" ::: "memory");
            const unsigned og = xb_add(&bar[XB_TOP], 1u);
            const unsigned tg = og / nx;
            if (og + 1u == (tg + 1u) * nx) xb_add(&bar[XB_TOPGEN], 1u);
            else XB_SPIN(xb_ld(&bar[XB_TOPGEN]) == tg, bar);
            __builtin_amdgcn_fence(__ATOMIC_ACQUIRE, "agent");
            xb_add(&bar[XB_XGEN(b.x)], 1u);
            asm volatile("s_waitcnt vmcnt(0)" ::: "memory");
        } else {
            XB_SPIN(xb_ld(&bar[XB_XGEN(b.x)]) == gen, bar);
            __builtin_amdgcn_fence(__ATOMIC_ACQUIRE, "agent");
            asm volatile("s_waitcnt vmcnt(0)" ::: "memory");
        }
    }
    __syncthreads();
}

namespace pg8 {
constexpr int BM = 256, BK = 64, HALF = 128, HTB = HALF * BK * 2, STAGE_BYTES = 8 * HTB, NXCD = 8, WGM = 8;
DI int lds_byte(int r, int c) { const int st = (r >> 4) * 2 + (c >> 5), rr = r & 15, cc = c & 31, ob = rr * 64 + cc * 2; return st * 1024 + (ob ^ (((ob >> 9) & 1) << 5)); }
DI void stage_rc(int b, int& R, int& C) { const int st = b / 1024, sb = b % 1024, swz = sb ^ (((sb >> 9) & 1) << 5); R = (st >> 1) * 16 + swz / 64; C = (st & 1) * 32 + (swz % 64) / 2; }
DI int perm32(int rho) { const int n = rho >> 4, i = rho & 15; return 8 * (i >> 2) + 4 * n + (i & 3); }

struct Unit { int pm, pn, e, rt; };
struct Gemm { const bf16_t* A; const bf16_t* Bt; int lda, ldb, K; };

struct StaticOrder {
    static constexpr bool GATHER = false;
    int nM, nN, nwg, G, c;
    DI void init(int M, int N, int G_, int c_) { nM = M / BM; nN = N / BM; nwg = nM * nN; G = G_; c = c_; }
    DI bool next(int i, Unit& u) const {
        const long L = (long)i * G + c; if (L >= nwg) return false;
        int wgid = (int)L; { const int q = nwg / NXCD, r = nwg % NXCD, xcd = wgid % NXCD, off = wgid / NXCD; wgid = (xcd < r ? xcd * (q + 1) : r * (q + 1) + (xcd - r) * q) + off; }
        const int nig = WGM * nN, gid = wgid / nig, fm = gid * WGM, gsz = (nM - fm) < WGM ? (nM - fm) : WGM;
        u.pm = fm + ((wgid % nig) % gsz); u.pn = (wgid % nig) / gsz; u.e = 0; u.rt = 0; return true;
    }
    DI const char* a_base(const Gemm& g, const Unit& u) const { return (const char*)g.A + (size_t)u.pm * BM * g.lda * 2; }
    DI const char* b_base(const Gemm& g, const Unit& u) const { return (const char*)g.Bt + (size_t)u.pn * BM * g.ldb * 2; }
    DI unsigned gather_voff(const Unit&, int, int, int) const { return 0u; }
};

template <bool GATH> struct MoeOrder {
    static constexpr bool GATHER = GATH;
    int G, c, npn, total; const LAS int* tb; size_t estride; const int* ltok; const unsigned* cnt;
    DI bool next(int i, Unit& u) const {
        if ((G & 7) == 0) {
            const int x = c & 7, r = c >> 3, W = G >> 3, idx = i * W + r;
            const int q = idx / npn, pn = idx - q * npn; int base = 0;
#pragma unroll
            for (int k = 0; k < 4; ++k) { const int e = x + 8 * k, nt = tb[e + 1] - tb[e];
                if (q < base + nt) { u.e = e; u.rt = q - base; u.pm = tb[e] + u.rt; u.pn = pn; return true; }
                base += nt; }
            return false;
        }
        const int L = i * G + c; if (L >= total) return false;
        const int q = L / npn; u.pn = L - q * npn; u.pm = q;
        int e = 0; while (e < NEXP - 1 && tb[e + 1] <= q) ++e;
        u.e = e; u.rt = q - tb[e]; return true;
    }
    DI const char* a_base(const Gemm& g, const Unit& u) const { return (const char*)g.A + (size_t)u.pm * BM * g.lda * 2; }
    DI const char* b_base(const Gemm& g, const Unit& u) const { return (const char*)g.Bt + (size_t)u.e * estride + (size_t)u.pn * BM * g.ldb * 2; }
    DI unsigned gather_voff(const Unit& u, int r, int C, int lda) const {
        const int pos = u.rt * BM + r; const int n = (int)__hip_atomic_load(cnt + u.e * 64, __ATOMIC_RELAXED, __HIP_MEMORY_SCOPE_AGENT);
        const int tok = pos < n ? ltok[u.e * LISTCAP + pos] : 0;
        return (unsigned)(tok * lda + C) * 2u;
    }
};

struct EpiStore {
    bf16_t* O; int ldc;
    DI void operator()(const f32x4 (&acc)[2][2][4][2], const Unit& u, int wr, int wc, int fr, int fq) const {
        const int row0 = u.pm * BM + wr * 64 + fr, col0 = u.pn * BM + wc * 32 + 8 * fq;
#pragma unroll
        for (int ai = 0; ai < 2; ++ai)
#pragma unroll
            for (int m = 0; m < 4; ++m) { bf16_t* rowp = O + (size_t)(row0 + ai * HALF + m * 16) * ldc + col0;
#pragma unroll
                for (int bj = 0; bj < 2; ++bj) { const f32x4 v0 = acc[ai][bj][m][0], v1 = acc[ai][bj][m][1];
                    u32x4 w; w.x = cvt_pk_bf16(v0[0], v0[1]); w.y = cvt_pk_bf16(v0[2], v0[3]); w.z = cvt_pk_bf16(v1[0], v1[1]); w.w = cvt_pk_bf16(v1[2], v1[3]);
                    *(GAS u32x4*)(rowp + bj * HALF) = w; } }
    }
};
struct EpiSwiGLU {
    bf16_t* H;
    DI void operator()(const f32x4 (&acc)[2][2][4][2], const Unit& u, int wr, int wc, int fr, int fq) const {
        const int row0 = u.pm * BM + wr * 64 + fr, col0 = u.pn * HALF + wc * 32 + 8 * fq;
#pragma unroll
        for (int ai = 0; ai < 2; ++ai)
#pragma unroll
            for (int m = 0; m < 4; ++m) { bf16_t* rowp = H + (size_t)(row0 + ai * HALF + m * 16) * DEXP + col0;
                float h[8];
#pragma unroll
                for (int n = 0; n < 2; ++n)
#pragma unroll
                    for (int j = 0; j < 4; ++j) { const float gt = acc[ai][0][m][n][j], up = acc[ai][1][m][n][j]; h[n * 4 + j] = gt * __builtin_amdgcn_rcpf(1.f + __expf(-gt)) * up; }
                u32x4 w; w.x = cvt_pk_bf16(h[0], h[1]); w.y = cvt_pk_bf16(h[2], h[3]); w.z = cvt_pk_bf16(h[4], h[5]); w.w = cvt_pk_bf16(h[6], h[7]);
                *(GAS u32x4*)rowp = w; }
    }
};
struct EpiScatter {
    bf16_t* YS; const int* lslot; const float* lgate; const unsigned* cnt;
    DI void operator()(const f32x4 (&acc)[2][2][4][2], const Unit& u, int wr, int wc, int fr, int fq) const {
        const int n = (int)__hip_atomic_load(cnt + u.e * 64, __ATOMIC_RELAXED, __HIP_MEMORY_SCOPE_AGENT);
        const int col0 = u.pn * BM + wc * 32 + 8 * fq;
#pragma unroll
        for (int ai = 0; ai < 2; ++ai)
#pragma unroll
            for (int m = 0; m < 4; ++m) { const int pos = u.rt * BM + ai * HALF + wr * 64 + m * 16 + fr;
                if (pos < n) { const int slot = lslot[u.e * LISTCAP + pos]; const float gt = lgate[u.e * LISTCAP + pos];
                    bf16_t* rowp = YS + (size_t)slot * DM + col0;
#pragma unroll
                    for (int bj = 0; bj < 2; ++bj) { const f32x4 v0 = acc[ai][bj][m][0] * gt, v1 = acc[ai][bj][m][1] * gt;
                        u32x4 w; w.x = cvt_pk_bf16(v0[0], v0[1]); w.y = cvt_pk_bf16(v0[2], v0[3]); w.z = cvt_pk_bf16(v1[0], v1[1]); w.w = cvt_pk_bf16(v1[2], v1[3]);
                        *(GAS u32x4*)(rowp + bj * HALF) = w; } } }
    }
};

template <class Epi, class Sched>
DI void gemm_phase(LAS unsigned char* lds, const Gemm g, const Sched& S, const Epi& E) {
    int tid = threadIdx.x; asm volatile("" : "+v"(tid));
    const int wid = __builtin_amdgcn_readfirstlane(tid >> 6), lane = tid & 63, wr = wid >> 2, wc = wid & 3, fr = lane & 15, fq = lane >> 4;
    const int K = g.K, nt = K / BK;
    unsigned voffA[2], voffB[2];
#pragma unroll
    for (int i = 0; i < 2; ++i) { int R, C; stage_rc(tid * 16 + i * 8192, R, C); const int Rb = (R & ~31) + perm32(R & 31);
        voffA[i] = (unsigned)(R * g.lda + C) * 2u; voffB[i] = (unsigned)(Rb * g.ldb + C) * 2u; }
    const size_t kstep = (size_t)(BK * 2);
    const size_t hstepA = (size_t)HALF * g.lda * 2, hstepB = (size_t)HALF * g.ldb * 2;
    const unsigned ldsw = (unsigned)wid * 1024u;
    const int aoff = lds_byte(wr * 64 + fr, fq * 8), boff = lds_byte(wc * 32 + fr, fq * 8);
    unsigned gvC[2][2], gvN[2][2];
#define PG8_SA(b, h) (((b) * 2 + (h)) * HTB)
#define PG8_SB(b, h) ((4 + (b) * 2 + (h)) * HTB)
#define PG8_STAGE(bufoff, gbase, voff) do { _Pragma("unroll") for (int _i = 0; _i < 2; ++_i) \
        __builtin_amdgcn_global_load_lds((const unsigned*)((const char*)(gbase) + (voff)[_i]), (LAS unsigned*)(lds + (bufoff) + ldsw + _i * 8192), 16, 0, 0); } while (0)
#define PG8_STAGE_A(bufoff, h, nxtsel, kt) do { \
        if constexpr (Sched::GATHER) { const char* _gb = (const char*)g.A + (size_t)(kt) * kstep; unsigned _vo[2]; _vo[0] = (nxtsel) ? gvN[h][0] : gvC[h][0]; _vo[1] = (nxtsel) ? gvN[h][1] : gvC[h][1]; PG8_STAGE(bufoff, _gb, _vo); } \
        else { const char* _gb = ((nxtsel) ? nA : cA) + (size_t)(h) * hstepA + (size_t)(kt) * kstep; PG8_STAGE(bufoff, _gb, voffA); } } while (0)
#define PG8_GSETUP(dst, u) do { if constexpr (Sched::GATHER) { _Pragma("unroll") for (int _h = 0; _h < 2; ++_h) _Pragma("unroll") for (int _i = 0; _i < 2; ++_i) { int _R, _C; stage_rc(tid * 16 + _i * 8192, _R, _C); \
        dst[_h][_i] = S.gather_voff(u, _h * HALF + _R, _C, g.lda); } asm volatile("s_waitcnt vmcnt(0)" : "+v"(dst[0][0]), "+v"(dst[0][1]), "+v"(dst[1][0]), "+v"(dst[1][1]) :: "memory"); } } while (0)
#define PG8_LDA(dst, b, h) do { _Pragma("unroll") for (int m = 0; m < 4; ++m) _Pragma("unroll") for (int k = 0; k < 2; ++k) dst[m][k] = *(const LAS bf16x8*)(lds + PG8_SA(b, h) + aoff + m * 2048 + k * 1024); } while (0)
#define PG8_LDB(dst, b, h) do { _Pragma("unroll") for (int n = 0; n < 2; ++n) _Pragma("unroll") for (int k = 0; k < 2; ++k) dst[n][k] = *(const LAS bf16x8*)(lds + PG8_SB(b, h) + boff + n * 2048 + k * 1024); } while (0)
#define PG8_MMA(ai, bj, At, Bt) do { __builtin_amdgcn_s_setprio(1); _Pragma("unroll") for (int m = 0; m < 4; ++m) _Pragma("unroll") for (int n = 0; n < 2; ++n) _Pragma("unroll") for (int k = 0; k < 2; ++k) \
        acc[ai][bj][m][n] = __builtin_amdgcn_mfma_f32_16x16x32_bf16(Bt[n][k], At[m][k], acc[ai][bj][m][n], 0, 0, 0); __builtin_amdgcn_s_setprio(0); } while (0)
#define PG8_WAIT_V(n) asm volatile("s_waitcnt vmcnt(" #n ")" ::: "memory")
#define PG8_WAIT_L(n) asm volatile("s_waitcnt lgkmcnt(" #n ")" ::: "memory")
#define PG8_BAR __builtin_amdgcn_s_barrier()
#define PG8_SCHED __builtin_amdgcn_sched_barrier(0)
    Unit cur, nxt; int ui = 0;
    if (!S.next(0, cur)) return;
    f32x4 acc[2][2][4][2];
#pragma unroll
    for (int a = 0; a < 2; ++a)
#pragma unroll
        for (int b = 0; b < 2; ++b)
#pragma unroll
            for (int m = 0; m < 4; ++m)
#pragma unroll
                for (int n = 0; n < 2; ++n) acc[a][b][m][n] = (f32x4){0.f, 0.f, 0.f, 0.f};
    bf16x8 At[4][2], B0[2][2], B1[2][2];
    const char* cA = S.a_base(g, cur); const char* cB = S.b_base(g, cur);
    const char* nA = cA;
    PG8_GSETUP(gvC, cur);
    PG8_STAGE(PG8_SB(0, 0), cB, voffB); PG8_STAGE_A(PG8_SA(0, 0), 0, false, 0); PG8_STAGE(PG8_SB(0, 1), cB + hstepB, voffB); PG8_STAGE_A(PG8_SA(0, 1), 1, false, 0);
    if (wr == 1) PG8_BAR;
    PG8_WAIT_V(4); PG8_BAR;
    PG8_STAGE(PG8_SB(1, 0), cB + kstep, voffB); PG8_STAGE_A(PG8_SA(1, 0), 0, false, 1); PG8_STAGE(PG8_SB(1, 1), cB + hstepB + kstep, voffB);
    PG8_WAIT_V(6); PG8_BAR;
    for (;;) {
        const bool has_next = S.next(ui + 1, nxt);
        nA = has_next ? S.a_base(g, nxt) : cA; const char* nB = has_next ? S.b_base(g, nxt) : cB;
        if constexpr (Sched::GATHER) { if (has_next) { PG8_GSETUP(gvN, nxt); } else {
#pragma unroll
            for (int _h = 0; _h < 2; ++_h) { gvN[_h][0] = gvC[_h][0]; gvN[_h][1] = gvC[_h][1]; } } }
        for (int t = 0; t < nt; t += 2) {
            const bool last = (t == nt - 2);
            const int kt2 = last ? 0 : t + 2;
            const char* b2 = last ? nB : cB + (size_t)(t + 2) * kstep;
            const char* b3 = b2 + kstep;
            PG8_LDB(B0, 0, 0); PG8_SCHED; PG8_LDA(At, 0, 0); PG8_STAGE_A(PG8_SA(1, 1), 1, false, t + 1);
            PG8_WAIT_L(8); PG8_BAR; PG8_WAIT_L(0); PG8_MMA(0, 0, At, B0); PG8_BAR; PG8_SCHED;
            PG8_LDB(B1, 0, 1); PG8_STAGE(PG8_SB(0, 0), b2, voffB);
            PG8_BAR; PG8_WAIT_L(0); PG8_MMA(0, 1, At, B1); PG8_BAR;
            PG8_LDA(At, 0, 1); PG8_STAGE_A(PG8_SA(0, 0), 0, last, kt2);
            PG8_BAR; PG8_WAIT_L(0); PG8_MMA(1, 0, At, B0); PG8_BAR; PG8_SCHED;
            PG8_STAGE(PG8_SB(0, 1), b2 + hstepB, voffB);
            PG8_WAIT_V(6); PG8_BAR; PG8_MMA(1, 1, At, B1); PG8_BAR;
            PG8_LDB(B0, 1, 0); PG8_SCHED; PG8_LDA(At, 1, 0); PG8_STAGE_A(PG8_SA(0, 1), 1, last, kt2);
            PG8_WAIT_L(8); PG8_BAR; PG8_WAIT_L(0); PG8_MMA(0, 0, At, B0); PG8_BAR; PG8_SCHED;
            PG8_LDB(B1, 1, 1); PG8_STAGE(PG8_SB(1, 0), b3, voffB);
            PG8_BAR; PG8_WAIT_L(0); PG8_MMA(0, 1, At, B1); PG8_BAR;
            PG8_LDA(At, 1, 1); PG8_STAGE_A(PG8_SA(1, 0), 0, last, kt2 + 1);
            PG8_BAR; PG8_WAIT_L(0); PG8_MMA(1, 0, At, B0); PG8_BAR; PG8_SCHED;
            PG8_STAGE(PG8_SB(1, 1), b3 + hstepB, voffB);
            PG8_WAIT_V(6); PG8_BAR; PG8_MMA(1, 1, At, B1); PG8_BAR;
        }
        E(acc, cur, wr, wc, fr, fq);
        if (!has_next) break;
#pragma unroll
        for (int a = 0; a < 2; ++a)
#pragma unroll
            for (int b = 0; b < 2; ++b)
#pragma unroll
                for (int m = 0; m < 4; ++m)
#pragma unroll
                    for (int n = 0; n < 2; ++n) acc[a][b][m][n] = (f32x4){0.f, 0.f, 0.f, 0.f};
        cur = nxt; cA = nA; cB = nB; ++ui;
        if constexpr (Sched::GATHER) {
#pragma unroll
            for (int _h = 0; _h < 2; ++_h) { gvC[_h][0] = gvN[_h][0]; gvC[_h][1] = gvN[_h][1]; } }
    }
    PG8_WAIT_V(0);
    if (wr == 0) PG8_BAR;
    PG8_BAR;
#undef PG8_SA
#undef PG8_SB
#undef PG8_STAGE
#undef PG8_STAGE_A
#undef PG8_GSETUP
#undef PG8_LDA
#undef PG8_LDB
#undef PG8_MMA
#undef PG8_WAIT_V
#undef PG8_WAIT_L
#undef PG8_BAR
#undef PG8_SCHED
}
}

struct Params { const float* in[31]; float* out; unsigned char* ws; int ph_lo, ph_hi; };

struct Ctx {
    LAS unsigned char* lds;
    int tid, lane, wave, G, bid, gw, ngw;
    unsigned char* ws; float* out;
};
DI Ctx relaunder(const Ctx& F0) {
    Ctx F = F0;
    asm volatile("" : "+v"(F.tid), "+v"(F.lane));
    asm volatile("" : "+s"(F.wave), "+s"(F.G), "+s"(F.bid), "+s"(F.gw), "+s"(F.ngw));
    asm volatile("" : "+s"(F.ws), "+s"(F.out));
    F.ws = as_global(F.ws); F.out = as_global(F.out);
    return F;
}

DI void dense_gemm(const Ctx& F, const bf16_t* A, int lda, const bf16_t* Bt, int ldb, int M, int N, int K, bf16_t* O, int ldc, int crot) {
    pg8::Gemm g{A, Bt, lda, ldb, K}; pg8::StaticOrder S; S.init(M, N, F.G, (F.bid + crot) % F.G);
    pg8::EpiStore E{O, ldc};
    for (int rep = 0; rep < REP_GEMM; ++rep) pg8::gemm_phase<pg8::EpiStore, pg8::StaticOrder>(F.lds, g, S, E);
}

struct TJob { const float* src; bf16_t* dst; int ldw, dld; };
DI void tr_load(const TJob& j, f32x4 (&r)[16], int lane) {
    const GAS float* p = (const GAS float*)(j.src + (size_t)(lane >> 4) * j.ldw + 4 * (lane & 15));
#pragma unroll
    for (int i = 0; i < 16; ++i) r[i] = *(const GAS f32x4*)(p + (size_t)(4 * i) * j.ldw);
}
DI void tr_store(const TJob& j, const f32x4 (&r)[16], LAS unsigned char* scr, int lane) {
#pragma unroll
    for (int i = 0; i < 16; ++i) { LAS unsigned* w = (LAS unsigned*)(scr + ((lane >> 4) + 4 * i) * 132 + (lane & 15) * 8); w[0] = cvt_pk_bf16(r[i].x, r[i].y); w[1] = cvt_pk_bf16(r[i].z, r[i].w); }
    LDS_WAIT();
    const int kc = lane & 7;
#pragma unroll
    for (int sgrp = 0; sgrp < 8; ++sgrp) { const int n = 8 * sgrp + (lane >> 3); const LAS unsigned short* c = (const LAS unsigned short*)(scr + (8 * kc) * 132 + n * 2);
        u32x4 o; o.x = (unsigned)c[0] | ((unsigned)c[66] << 16); o.y = (unsigned)c[2 * 66] | ((unsigned)c[3 * 66] << 16); o.z = (unsigned)c[4 * 66] | ((unsigned)c[5 * 66] << 16); o.w = (unsigned)c[6 * 66] | ((unsigned)c[7 * 66] << 16);
        *(GAS u32x4*)(j.dst + (size_t)n * j.dld + 8 * kc) = o; }
    LDS_WAIT();
}
template <class Dec> DI void tr_run(const Dec& D, int first, int count, int stride, LAS unsigned char* scr, int lane) {
    f32x4 A[16], B[16]; TJob ja, jb;
    int it = first; if (it >= count) return;
    ja = D(it); tr_load(ja, A, lane);
    for (;;) {
        const int it2 = it + stride; const bool h2 = it2 < count; if (h2) { jb = D(it2); tr_load(jb, B, lane); }
        tr_store(ja, A, scr, lane);
        if (!h2) break;
        const int it3 = it2 + stride; const bool h3 = it3 < count; if (h3) { ja = D(it3); tr_load(ja, A, lane); }
        tr_store(jb, B, scr, lane);
        if (!h3) break;
        it = it3;
    }
}
DI TJob mat_job(const float* W, int K, int N, bf16_t* WT, int item) {
    const int nblk = N / 64, kb = item / nblk, nb = item - kb * nblk;
    TJob j; j.src = W + (size_t)(64 * kb) * N + 64 * nb; j.dst = WT + (size_t)(64 * nb) * K + 64 * kb; j.ldw = N; j.dld = K; return j;
}
DI void row_to_bf16(const float* src, bf16_t* dst, int lane) {
    const GAS f32x4* s = (const GAS f32x4*)src + lane; GAS u32x2* o = (GAS u32x2*)dst + lane;
#pragma unroll
    for (int j = 0; j < 8; ++j) { const f32x4 v = s[64 * j]; u32x2 w; w.x = cvt_pk_bf16(v.x, v.y); w.y = cvt_pk_bf16(v.z, v.w); o[64 * j] = w; }
}

DI void phase_prologue(const Ctx& F, const Params& P) {
    unsigned char* const wsl = F.ws; float* const outl = F.out; (void)outl;
    LAS unsigned char* scr = F.lds + F.wave * 16384;
    unsigned char* ws = wsl;
    constexpr int I_RW = 32 * (RW_IN_COLS / 64), I_OT = 32 * (ZW_OTH / 64), I_WO = 32 * 32, I_KV = 32 * 8;
    constexpr int N_A = 2 * I_RW + 2 * I_OT, N_B = 4 * I_WO, N_C = 8 * I_KV, N_D = NTOK + NBATCH * MEML;
    struct ProDec { unsigned char* ws;
        DI TJob operator()(int it) const { int r = it;
            if (r < N_A) {
                if (r < I_RW) return mat_job(PIN(16), DM, RW_IN_COLS, (bf16_t*)(ws + WS_WIN), r); r -= I_RW;
                if (r < I_OT) return mat_job(PIN(28), DM, ZW_OTH, (bf16_t*)(ws + WS_WIN + WIN_STRIDE), r); r -= I_OT;
                if (r < I_OT) return mat_job(PIN(30), DM, ZW_OTH, (bf16_t*)(ws + WS_WIN + 2 * WIN_STRIDE), r); r -= I_OT;
                return mat_job(PIN(16) + (size_t)DM * RW_IN_COLS, DM, RW_IN_COLS, (bf16_t*)(ws + WS_WIN + 3 * WIN_STRIDE), r);
            }
            r -= N_A;
            if (r < N_B) { const int l = r / I_WO; return mat_job(PIN(2) + (size_t)l * DM * DM, DM, DM, (bf16_t*)(ws + WS_WOUT) + (size_t)l * DM * DM, r - l * I_WO); }
            r -= N_B;
            const int m = r / I_KV, l = m & 3; const bool isv = m >= 4;
            return mat_job(PIN(isv ? 4 : 3) + (size_t)l * DM * MEMW, DM, MEMW, (bf16_t*)(ws + (isv ? WS_WV : WS_WK)) + (size_t)l * MEMW * DM, r - m * I_KV);
        } };
    ProDec PD{ws};
    tr_run(PD, F.gw, N_A + N_B + N_C, F.ngw, scr, F.lane);
    for (int r = F.gw; r < N_D; r += F.ngw) {
        if (r < NTOK) row_to_bf16(PIN(0) + (size_t)r * DM, (bf16_t*)(ws + WS_XB) + (size_t)r * DM, F.lane);
        else row_to_bf16(PIN(1) + (size_t)(r - NTOK) * DM, (bf16_t*)(ws + WS_MEMB) + (size_t)(r - NTOK) * DM, F.lane);
    }
    const int gt = F.bid * NT + F.tid, ngt = F.G * NT;
    for (int idx = gt; idx < 2 * (3072 + 1536) * 256; idx += ngt) {
        const int j = idx / ((3072 + 1536) * 256); int r = idx - j * (3072 + 1536) * 256;
        bf16_t* base = (bf16_t*)(ws + WS_LORA + (size_t)j * LORA_STRIDE);
        const int n = r >> 8, k = r & 255; float v = 0.f;
        if (n < 1536) { if (k < 96) v = PIN(19)[((size_t)j * 96 + k) * CMIX + n]; }
        else if (n < 3072) { if (k >= 96 && k < 192) v = PIN(21)[((size_t)j * 96 + (k - 96)) * CMIX + (n - 1536)]; }
        else v = PIN(22)[((size_t)j * 256 + k) * CMIX + (n - 3072)];
        base[r] = (bf16_t)(cvt_pk_bf16(v, 0.f) & 0xffffu);
    }
    for (int idx = gt; idx < 2 * 64 * DM; idx += ngt) { const int j = idx / (64 * DM), r = idx - j * 64 * DM;
        ((bf16_t*)(ws + WS_WIN + (size_t)(j ? 3 : 0) * WIN_STRIDE))[(size_t)RW_IN_COLS * DM + r] = 0; }
    for (int idx = gt; idx < NLAYER * 48 * DM; idx += ngt) {
        const int l = idx / (48 * DM); int r = idx - l * 48 * DM; const int n = r / DM, k = r - n * DM;
        float v = 0.f;
        if (n < 4) v = PIN(9)[((size_t)l * DM + k) * 4 + n]; else if (n < 36) v = PIN(11)[((size_t)l * DM + k) * 32 + (n - 4)];
        const unsigned hi = cvt_pk_bf16(v, 0.f) & 0xffffu; const float rem = v - bf2f(hi); const unsigned lo = cvt_pk_bf16(rem, 0.f) & 0xffffu;
        bf16_t* base = (bf16_t*)(ws + WS_WSW + (size_t)l * WSW_STRIDE);
        base[r] = (bf16_t)hi; base[48 * DM + r] = (bf16_t)lo;
    }
}

DI void expert_convert(const Ctx& F, const Params& P, int l, int w, int nw) {
    unsigned char* const wsl = F.ws;
    LAS unsigned char* scr = F.lds + F.wave * 16384;
    constexpr int I_GU = NEXP * 32 * 8 * 2, I_DN = NEXP * 8 * 32;
    struct ExpDec { unsigned char* ws; int l;
        DI TJob operator()(int it) const { TJob j;
            if (it < I_GU) {
                const int isup = it / (I_GU / 2); int r = it - isup * (I_GU / 2);
                const int e = r / 256; r -= e * 256; const int kb = r >> 3, nb = r & 7;
                const float* W = PIN(isup ? 14 : 13) + ((size_t)l * NEXP + e) * DM * DEXP;
                const int n0 = 64 * nb, drow = 256 * (n0 >> 7) + (isup ? 128 : 0) + (n0 & 127);
                j.src = W + (size_t)(64 * kb) * DEXP + n0; j.ldw = DEXP; j.dst = (bf16_t*)(ws + WS_EXP1) + ((size_t)e * 1024 + drow) * DM + 64 * kb; j.dld = DM;
            } else {
                int r = it - I_GU; const int e = r / 256; r -= e * 256; const int kb = r >> 5, nb = r & 31;
                const float* W = PIN(15) + ((size_t)l * NEXP + e) * DEXP * DM;
                j.src = W + (size_t)(64 * kb) * DM + 64 * nb; j.ldw = DM; j.dst = (bf16_t*)(ws + WS_EXP2) + ((size_t)e * DM + 64 * nb) * DEXP + 64 * kb; j.dld = DEXP;
            }
            return j; } };
    ExpDec ED{wsl, l};
    tr_run(ED, w, I_GU + I_DN, nw, scr, F.lane);
}

DI void memattn_unit(const Ctx& F, int l, int unit, const bf16_t* z, int zw, int qcol) {
    unsigned char* const wsl = F.ws; float* const outl = F.out; (void)outl;
    const int b = unit >> 6, head = (unit >> 4) & 3, qblk = unit & 15;
    LAS unsigned char* Ks = F.lds; LAS unsigned char* Vs = F.lds + 69632;
    const bf16_t* Km = (const bf16_t*)(wsl + WS_KM); const bf16_t* VmT = (const bf16_t*)(wsl + WS_VMT);
    bf16_t* cat = (bf16_t*)(wsl + WS_CAT);
    __syncthreads();
#pragma unroll
    for (int i = 0; i < 8; ++i) { const int ch = F.tid + NT * i;
        { const int row = ch >> 4, c16 = ch & 15; const u32x4 v = *(const u32x4*)(Km + (size_t)(b * MEML + row) * 2048 + l * 512 + head * 128 + c16 * 8); *(LAS u32x4*)(Ks + row * 272 + c16 * 16) = v; }
        { const int d = ch >> 5, c = ch & 31; const u32x4 v = *(const u32x4*)(VmT + (size_t)(l * 512 + head * 128 + d) * 1024 + b * MEML + c * 8); *(LAS u32x4*)(Vs + d * 528 + c * 16) = v; } }
    __syncthreads();
    const int lane = F.lane, fr = lane & 15, fq = lane >> 4;
    for (int itq = 0; itq < 2; ++itq) {
        const int q0 = qblk * 256 + itq * 128 + F.wave * 16, tok0 = b * SEQ + q0;
        bf16x8 Qf[4];
#pragma unroll
        for (int ks = 0; ks < 4; ++ks) Qf[ks] = *(const bf16x8*)(z + (size_t)(tok0 + fr) * zw + qcol + head * 128 + ks * 32 + fq * 8);
        f32x4 acc[16];
#pragma unroll
        for (int t = 0; t < 16; ++t) { acc[t] = (f32x4){0.f, 0.f, 0.f, 0.f};
#pragma unroll
            for (int ks = 0; ks < 4; ++ks) { const bf16x8 kf = *(const LAS bf16x8*)(Ks + (16 * t + fr) * 272 + ks * 64 + fq * 16);
                acc[t] = __builtin_amdgcn_mfma_f32_16x16x32_bf16(kf, Qf[ks], acc[t], 0, 0, 0); } }
        const float sc = 0.08838834764831845f;
        float mx = -3.0e38f;
#pragma unroll
        for (int t = 0; t < 16; ++t)
#pragma unroll
            for (int j = 0; j < 4; ++j) { acc[t][j] *= sc; mx = fmaxf(mx, acc[t][j]); }
        mx = fmaxf(mx, __shfl_xor(mx, 16)); mx = fmaxf(mx, __shfl_xor(mx, 32));
        float sum = 0.f;
#pragma unroll
        for (int t = 0; t < 16; ++t)
#pragma unroll
            for (int j = 0; j < 4; ++j) { acc[t][j] = __expf(acc[t][j] - mx); sum += acc[t][j]; }
        sum += __shfl_xor(sum, 16); sum += __shfl_xor(sum, 32);
        const float inv = 1.f / sum;
        f32x4 o[8];
#pragma unroll
        for (int dt = 0; dt < 8; ++dt) o[dt] = (f32x4){0.f, 0.f, 0.f, 0.f};
#pragma unroll
        for (int s = 0; s < 8; ++s) {
            u32x4 pw; pw.x = cvt_pk_bf16(acc[2 * s][0], acc[2 * s][1]); pw.y = cvt_pk_bf16(acc[2 * s][2], acc[2 * s][3]);
            pw.z = cvt_pk_bf16(acc[2 * s + 1][0], acc[2 * s + 1][1]); pw.w = cvt_pk_bf16(acc[2 * s + 1][2], acc[2 * s + 1][3]);
            const bf16x8 pf = __builtin_bit_cast(bf16x8, pw);
#pragma unroll
            for (int dt = 0; dt < 8; ++dt) {
                const u32x2 v0 = *(const LAS u32x2*)(Vs + (16 * dt + fr) * 528 + (32 * s + 4 * fq) * 2);
                const u32x2 v1 = *(const LAS u32x2*)(Vs + (16 * dt + fr) * 528 + (32 * s + 16 + 4 * fq) * 2);
                u32x4 vw; vw.x = v0.x; vw.y = v0.y; vw.z = v1.x; vw.w = v1.y;
                o[dt] = __builtin_amdgcn_mfma_f32_16x16x32_bf16(__builtin_bit_cast(bf16x8, vw), pf, o[dt], 0, 0, 0);
            }
        }
        bf16_t* orow = cat + (size_t)(tok0 + fr) * DM + CMIX + head * 128 + 4 * fq;
#pragma unroll
        for (int dt = 0; dt < 8; ++dt) { u32x2 w; w.x = cvt_pk_bf16(o[dt][0] * inv, o[dt][1] * inv); w.y = cvt_pk_bf16(o[dt][2] * inv, o[dt][3] * inv); *(u32x2*)(orow + 16 * dt) = w; }
    }
}
DI void memattn_all(const Ctx& F, int l, const bf16_t* z, int zw, int qcol) {
    for (int u = F.bid; u < 256; u += F.G) memattn_unit(F, l, u, z, zw, qcol);
    __syncthreads();
}

DI void conv_mix(const Ctx& F, const Params& P, const bf16_t* z) {
    unsigned char* const wsl = F.ws; float* const outl = F.out; (void)outl;
    const float* cw = PIN(29);
    bf16_t* cat = (bf16_t*)(wsl + WS_CAT);
    const int gt = F.bid * NT + F.tid, ngt = F.G * NT;
    for (int idx = gt; idx < NTOK * 192; idx += ngt) {
        const int tok = idx / 192, c8 = idx - tok * 192, c = c8 * 8, t = tok & (SEQ - 1);
        const bf16_t* zr = z + (size_t)tok * ZW_OTH;
        const u32x4 bg = *(const u32x4*)(zr + c);
        float y[8];
#pragma unroll
        for (int j = 0; j < 8; ++j) y[j] = 0.f;
#pragma unroll
        for (int dt = 0; dt < 3; ++dt) {
            if (t - dt >= 0) {
                const u32x4 cg = *(const u32x4*)(zr - (size_t)dt * ZW_OTH + CMIX + c), hh = *(const u32x4*)(zr - (size_t)dt * ZW_OTH + 2 * CMIX + c);
                const f32x4 w0 = *(const f32x4*)(cw + (2 - dt) * CMIX + c), w1 = *(const f32x4*)(cw + (2 - dt) * CMIX + c + 4);
                y[0] += w0.x * bflo(cg.x) * bflo(hh.x); y[1] += w0.y * bfhi(cg.x) * bfhi(hh.x); y[2] += w0.z * bflo(cg.y) * bflo(hh.y); y[3] += w0.w * bfhi(cg.y) * bfhi(hh.y);
                y[4] += w1.x * bflo(cg.z) * bflo(hh.z); y[5] += w1.y * bfhi(cg.z) * bfhi(hh.z); y[6] += w1.z * bflo(cg.w) * bflo(hh.w); y[7] += w1.w * bfhi(cg.w) * bfhi(hh.w);
            }
        }
        u32x4 o; o.x = cvt_pk_bf16(bflo(bg.x) * y[0], bfhi(bg.x) * y[1]); o.y = cvt_pk_bf16(bflo(bg.y) * y[2], bfhi(bg.y) * y[3]);
        o.z = cvt_pk_bf16(bflo(bg.z) * y[4], bfhi(bg.z) * y[5]); o.w = cvt_pk_bf16(bflo(bg.w) * y[6], bfhi(bg.w) * y[7]);
        *(u32x4*)(cat + (size_t)tok * DM + c) = o;
    }
}

DI void sb_attention(const Ctx& F, const bf16_t* z) {
    unsigned char* const wsl = F.ws;
    const bf16_t* VT = (const bf16_t*)(wsl + WS_ACT);
    bf16_t* cat = (bf16_t*)(wsl + WS_CAT);
    LAS unsigned char* Ks = F.lds; LAS unsigned char* Vs = F.lds + 69632;
    const int lane = F.lane, fr = lane & 15, fq = lane >> 4;
    const float sc = 0.08838834764831845f;
    for (int u = F.bid; u < NBATCH * 12 * 32; u += F.G) {
        const int b = u / (12 * 32); int r = u - b * 12 * 32; const int head = r >> 5, qblk = r & 31;
        const int t0 = qblk * 128, kw0 = t0 - 128;
        __syncthreads();
#pragma unroll
        for (int i = 0; i < 8; ++i) { const int ch = F.tid + NT * i;
            { const int row = ch >> 4, c16 = ch & 15, key = kw0 + row;
              if (key >= 0) { const u32x4 v = *(const u32x4*)(z + (size_t)(b * SEQ + key) * ZW_OTH + CMIX + head * 128 + c16 * 8); *(LAS u32x4*)(Ks + row * 272 + c16 * 16) = v; } }
            { const int d = ch >> 5, c = ch & 31;
              if (kw0 + c * 8 >= 0) { const u32x4 v = *(const u32x4*)(VT + (size_t)(head * 128 + d) * NTOK + b * SEQ + kw0 + c * 8); *(LAS u32x4*)(Vs + d * 528 + c * 16) = v; } } }
        __syncthreads();
        const int tq0 = t0 + F.wave * 16, tq = tq0 + fr;
        bf16x8 Qf[4];
#pragma unroll
        for (int ks = 0; ks < 4; ++ks) Qf[ks] = *(const bf16x8*)(z + (size_t)(b * SEQ + tq) * ZW_OTH + head * 128 + ks * 32 + fq * 8);
        f32x4 o[8];
#pragma unroll
        for (int dt = 0; dt < 8; ++dt) o[dt] = (f32x4){0.f, 0.f, 0.f, 0.f};
        float R = 0.f;
        for (int kt = (tq0 + 14) >> 5; kt >= 0; --kt) {
            const int lk = 32 * kt - kw0;
            bf16x8 Kf[2][4]; u32x2 V0[8], V1[8];
            if (lk >= 0) {
#pragma unroll
                for (int tl = 0; tl < 2; ++tl)
#pragma unroll
                    for (int ks = 0; ks < 4; ++ks) Kf[tl][ks] = *(const LAS bf16x8*)(Ks + (lk + 16 * tl + fr) * 272 + ks * 64 + fq * 16);
#pragma unroll
                for (int dt = 0; dt < 8; ++dt) { V0[dt] = *(const LAS u32x2*)(Vs + (16 * dt + fr) * 528 + (lk + 4 * fq) * 2); V1[dt] = *(const LAS u32x2*)(Vs + (16 * dt + fr) * 528 + (lk + 16 + 4 * fq) * 2); }
            } else {
#pragma unroll
                for (int tl = 0; tl < 2; ++tl)
#pragma unroll
                    for (int ks = 0; ks < 4; ++ks) Kf[tl][ks] = *(const bf16x8*)(z + (size_t)(b * SEQ + 32 * kt + 16 * tl + fr) * ZW_OTH + CMIX + head * 128 + ks * 32 + fq * 8);
#pragma unroll
                for (int dt = 0; dt < 8; ++dt) { const bf16_t* vp = VT + (size_t)(head * 128 + 16 * dt + fr) * NTOK + b * SEQ + 32 * kt + 4 * fq; V0[dt] = *(const u32x2*)vp; V1[dt] = *(const u32x2*)(vp + 16); }
            }
            f32x4 s[2];
#pragma unroll
            for (int tl = 0; tl < 2; ++tl) { s[tl] = (f32x4){0.f, 0.f, 0.f, 0.f};
#pragma unroll
                for (int ks = 0; ks < 4; ++ks) s[tl] = __builtin_amdgcn_mfma_f32_16x16x32_bf16(Kf[tl][ks], Qf[ks], s[tl], 0, 0, 0); }
            float ln[2][4], lsg[2][4], tot[2];
#pragma unroll
            for (int tl = 0; tl < 2; ++tl) { tot[tl] = 0.f;
#pragma unroll
                for (int j = 0; j < 4; ++j) { const float x = s[tl][j] * sc; const int key = 32 * kt + 16 * tl + 4 * fq + j; const bool valid = key < tq;
                    const float sp = softplusf_(x); ln[tl][j] = valid ? -sp : 0.f; lsg[tl][j] = valid ? (x - sp) : -1.0e30f; tot[tl] += ln[tl][j]; } }
            const float a16_0 = __shfl_xor(tot[0], 16), a32_0 = __shfl_xor(tot[0], 32), a48_0 = __shfl_xor(tot[0], 48);
            const float a16_1 = __shfl_xor(tot[1], 16), a32_1 = __shfl_xor(tot[1], 32), a48_1 = __shfl_xor(tot[1], 48);
            float hi0 = 0.f, hi1 = 0.f;
            if ((fq ^ 1) > fq) { hi0 += a16_0; hi1 += a16_1; }
            if ((fq ^ 2) > fq) { hi0 += a32_0; hi1 += a32_1; }
            if ((fq ^ 3) > fq) { hi0 += a48_0; hi1 += a48_1; }
            const float all0 = tot[0] + a16_0 + a32_0 + a48_0, all1 = tot[1] + a16_1 + a32_1 + a48_1;
            const float E0 = R + hi0 + all1, E1 = R + hi1;
            float at[2][4];
#pragma unroll
            for (int tl = 0; tl < 2; ++tl) { float suf = 0.f; const float Eb = tl ? E1 : E0;
#pragma unroll
                for (int j = 3; j >= 0; --j) { at[tl][j] = __expf(lsg[tl][j] + Eb + suf); suf += ln[tl][j]; } }
            R += all0 + all1;
            u32x4 pw; pw.x = cvt_pk_bf16(at[0][0], at[0][1]); pw.y = cvt_pk_bf16(at[0][2], at[0][3]); pw.z = cvt_pk_bf16(at[1][0], at[1][1]); pw.w = cvt_pk_bf16(at[1][2], at[1][3]);
            const bf16x8 pf = __builtin_bit_cast(bf16x8, pw);
#pragma unroll
            for (int dt = 0; dt < 8; ++dt) {
                u32x4 vw; vw.x = V0[dt].x; vw.y = V0[dt].y; vw.z = V1[dt].x; vw.w = V1[dt].y;
                o[dt] = __builtin_amdgcn_mfma_f32_16x16x32_bf16(__builtin_bit_cast(bf16x8, vw), pf, o[dt], 0, 0, 0);
            }
            if (__all(R < -100.f)) break;
        }
        bf16_t* orow = cat + (size_t)(b * SEQ + tq) * DM + head * 128 + 4 * fq;
#pragma unroll
        for (int dt = 0; dt < 8; ++dt) { u32x2 w; w.x = cvt_pk_bf16(o[dt][0], o[dt][1]); w.y = cvt_pk_bf16(o[dt][2], o[dt][3]); *(u32x2*)(orow + 16 * dt) = w; }
    }
    __syncthreads();
}

DI void rwkv_prep1(const Ctx& F, const Params& P, int j, const bf16_t* z) {
    unsigned char* const wsl = F.ws; float* const outl = F.out; (void)outl;
    const float* mu = PIN(17) + (size_t)j * 5056;
    bf16_t* act = (bf16_t*)(wsl + WS_ACT);
    const int gt = F.bid * NT + F.tid, ngt = F.G * NT;
    for (int idx = gt; idx < NTOK * 64; idx += ngt) {
        const int tok = idx >> 6, ci = idx & 63, t = tok & (SEQ - 1);
        u32x4 o = (u32x4){0u, 0u, 0u, 0u};
        if (ci < 24 || ci >= 32) {
            const int sc = ci < 12 ? 4608 + 8 * ci : (ci < 24 ? 4704 + 8 * (ci - 12) : 4800 + 8 * (ci - 32));
            const u32x4 a = *(const u32x4*)(z + (size_t)tok * ZW_RWKV + sc);
            u32x4 p = (u32x4){0u, 0u, 0u, 0u}; if (t > 0) p = *(const u32x4*)(z + (size_t)(tok - 1) * ZW_RWKV + sc);
            const f32x4 m0 = *(const f32x4*)(mu + sc), m1 = *(const f32x4*)(mu + sc + 4);
            float v[8];
            v[0] = bflo(a.x) + (bflo(p.x) - bflo(a.x)) * m0.x; v[1] = bfhi(a.x) + (bfhi(p.x) - bfhi(a.x)) * m0.y;
            v[2] = bflo(a.y) + (bflo(p.y) - bflo(a.y)) * m0.z; v[3] = bfhi(a.y) + (bfhi(p.y) - bfhi(a.y)) * m0.w;
            v[4] = bflo(a.z) + (bflo(p.z) - bflo(a.z)) * m1.x; v[5] = bfhi(a.z) + (bfhi(p.z) - bfhi(a.z)) * m1.y;
            v[6] = bflo(a.w) + (bflo(p.w) - bflo(a.w)) * m1.z; v[7] = bfhi(a.w) + (bfhi(p.w) - bfhi(a.w)) * m1.w;
#pragma unroll
            for (int q = 0; q < 8; ++q) { if (ci < 12) v[q] = tanhf(v[q]); else if (ci >= 32) v[q] = sigmoidf_(v[q]); }
            o.x = cvt_pk_bf16(v[0], v[1]); o.y = cvt_pk_bf16(v[2], v[3]); o.z = cvt_pk_bf16(v[4], v[5]); o.w = cvt_pk_bf16(v[6], v[7]);
        }
        *(u32x4*)(act + (size_t)tok * 512 + ci * 8) = o;
    }
}

constexpr int CH = 64, NCH = SEQ / CH;
DI float* scan_rec(unsigned char* ws, int tok, int head) {
    return (float*)(ws + WS_SCAN) + ((size_t)((tok >> 12) * 24 + head) * SEQ + (tok & (SEQ - 1))) * 320;
}
DI float* gh_ptr(unsigned char* ws, int bh, int c, int which) { return (float*)(ws + WS_GH) + (((size_t)bh * NCH + c) * 2 + which) * 4096; }
struct RwPar { const float *mu, *w0, *a0, *kk, *ka, *rk, *gng, *gnb; };
struct PrepRaw { u32x2 zr, zk, zv, pr, pk, pv, lw, la; };
struct PrepOut { f32x4 dec, ld, bb, kp, r, nk, v; float bon; };
DI void prep_load(PrepRaw& R, const bf16_t* z, const bf16_t* LW, int tok, int c4) {
    tok = tok < NTOK ? tok : NTOK - 1;
    const bool hp = (tok & (SEQ - 1)) != 0;
    const GAS bf16_t* zc = (const GAS bf16_t*)(z + (size_t)tok * ZW_RWKV + c4); const GAS bf16_t* zp = hp ? zc - ZW_RWKV : zc;
    R.zr = *(const GAS u32x2*)zc; R.zk = *(const GAS u32x2*)(zc + CMIX); R.zv = *(const GAS u32x2*)(zc + 2 * CMIX);
    R.pr = *(const GAS u32x2*)zp; R.pk = *(const GAS u32x2*)(zp + CMIX); R.pv = *(const GAS u32x2*)(zp + 2 * CMIX);
    const GAS bf16_t* lp = (const GAS bf16_t*)(LW + (size_t)tok * 3072 + c4); R.lw = *(const GAS u32x2*)lp; R.la = *(const GAS u32x2*)(lp + CMIX);
}
DI f32x4 lerp_u(u32x2 a, u32x2 p, f32x4 m) {
    f32x4 r; r.x = bflo(a.x) + (bflo(p.x) - bflo(a.x)) * m.x; r.y = bfhi(a.x) + (bfhi(p.x) - bfhi(a.x)) * m.y;
    r.z = bflo(a.y) + (bflo(p.y) - bflo(a.y)) * m.z; r.w = bfhi(a.y) + (bfhi(p.y) - bfhi(a.y)) * m.w; return r;
}
struct PrepPar { f32x4 mur, muk, muv, w0, a0, kk, ka, rk; };
DI void par_load(PrepPar& P, const RwPar& Q, int c4) {
    P.mur = *(const GAS f32x4*)(Q.mu + c4); P.muk = *(const GAS f32x4*)(Q.mu + CMIX + c4); P.muv = *(const GAS f32x4*)(Q.mu + 2 * CMIX + c4);
    P.w0 = *(const GAS f32x4*)(Q.w0 + c4); P.a0 = *(const GAS f32x4*)(Q.a0 + c4); P.kk = *(const GAS f32x4*)(Q.kk + c4); P.ka = *(const GAS f32x4*)(Q.ka + c4); P.rk = *(const GAS f32x4*)(Q.rk + c4);
}
template <bool WANT_BON> DI void prep_compute(const PrepRaw& R, const PrepPar& P, bool hp, PrepOut& O) {
    const u32x2 z2 = (u32x2){0u, 0u};
    const f32x4 r = lerp_u(R.zr, hp ? R.pr : z2, P.mur), k = lerp_u(R.zk, hp ? R.pk : z2, P.muk);
    O.v = lerp_u(R.zv, hp ? R.pv : z2, P.muv); O.r = r;
    const f32x4 w0v = P.w0, a0v = P.a0, kkv = P.kk, kav = P.ka;
    f32x4 wr; wr.x = w0v.x + bflo(R.lw.x); wr.y = w0v.y + bfhi(R.lw.x); wr.z = w0v.z + bflo(R.lw.y); wr.w = w0v.w + bfhi(R.lw.y);
    f32x4 ar; ar.x = a0v.x + bflo(R.la.x); ar.y = a0v.y + bfhi(R.la.x); ar.z = a0v.z + bflo(R.la.y); ar.w = a0v.w + bfhi(R.la.y);
    f32x4 a, kk;
#pragma unroll
    for (int q = 0; q < 4; ++q) { const float wl = -softplusf_(-wr[q]) - 0.5f; O.ld[q] = -__expf(wl); O.dec[q] = __expf(O.ld[q]); a[q] = sigmoidf_(ar[q]); kk[q] = k[q] * kkv[q]; O.kp[q] = k[q] * (1.f + (a[q] - 1.f) * kav[q]); }
    const float n2 = sum16(kk.x * kk.x + kk.y * kk.y + kk.z * kk.z + kk.w * kk.w);
    const float inv = __builtin_amdgcn_rsqf(fmaxf(n2, 1e-24f));
#pragma unroll
    for (int q = 0; q < 4; ++q) { const float kn = kk[q] * inv; O.bb[q] = kn * a[q]; O.nk[q] = -kn; }
    if (WANT_BON) { const f32x4 rk = P.rk; O.bon = sum16(r.x * O.kp.x * rk.x + r.y * O.kp.y * rk.y + r.z * O.kp.z * rk.z + r.w * O.kp.w * rk.w); }
}
#define LO2(v) ((f32x2){(v).x, (v).y})
#define HI2(v) ((f32x2){(v).z, (v).w})
constexpr int WRS = 144;
constexpr int W_SLOT = 64 * WRS;
enum { SL_NT = 0, SL_RT, SL_BH, SL_KH, SL_BHT, SL_KHT, SL_VT, SL_MK, SL_NB, SL_NK, SL_W1T, SL_U0T };
constexpr int W_MB = 12 * W_SLOT, W_CL = W_MB + 16384, W_PL = W_CL + 16384;
DI bf16x8 wfrag(LAS unsigned char* L, int slot, int row, int ks, int q) { return *(const LAS bf16x8*)(L + slot * W_SLOT + row * WRS + ks * 64 + q * 16); }
DI void wput(LAS unsigned char* L, int slot, int row, int col, float v) { *(LAS bf16_t*)(L + slot * W_SLOT + row * WRS + col * 2) = (bf16_t)(cvt_pk_bf16(v, 0.f) & 0xffffu); }
DI void tr4x4_rows(f32x4& x) {
    const float f0 = x.x, f1 = x.y, f2 = x.z, f3 = x.w;
    const unsigned u0 = __builtin_bit_cast(unsigned, f0), u1 = __builtin_bit_cast(unsigned, f1), u2 = __builtin_bit_cast(unsigned, f2), u3 = __builtin_bit_cast(unsigned, f3);
    const auto s02 = __builtin_amdgcn_permlane32_swap(u0, u2, false, false); const auto s13 = __builtin_amdgcn_permlane32_swap(u1, u3, false, false);
    const auto t01 = __builtin_amdgcn_permlane16_swap(s02[0], s13[0], false, false); const auto t23 = __builtin_amdgcn_permlane16_swap(s02[1], s13[1], false, false);
    x[0] = __builtin_bit_cast(float, (unsigned)t01[0]); x[1] = __builtin_bit_cast(float, (unsigned)t01[1]); x[2] = __builtin_bit_cast(float, (unsigned)t23[0]); x[3] = __builtin_bit_cast(float, (unsigned)t23[1]);
}
DI void scan_w1(const Ctx& F, const RwPar& Q, const bf16_t* z) {
    unsigned char* const wsl = F.ws; LAS unsigned char* L = F.lds;
    const int wave = F.wave;
    const bf16_t* LW = (const bf16_t*)(wsl + WS_LW);
    LAS float* MB = (LAS float*)(L + W_MB); LAS float* CL = (LAS float*)(L + W_CL); LAS float* PL = (LAS float*)(L + W_PL);
    PrepPar PN;
    PrepRaw RN[2];
    if (F.bid < 96 * NCH) { const int bh = F.bid % 96, c = F.bid / 96, b = bh / 24, head = bh - b * 24, tokb = b * SEQ + c * CH, c4 = head * 64 + 4 * (F.lane & 15);
#pragma unroll
        for (int p = 0; p < 2; ++p) prep_load(RN[p], z, LW, tokb + p * 32 + wave * 4 + (F.lane >> 4), c4);
        par_load(PN, Q, c4); }
    for (int u = F.bid; u < 96 * NCH; u += F.G) {
        int lane = F.lane; asm volatile("" : "+v"(lane));
        const int tq = lane >> 4, li = lane & 15, fr = li, fq = tq;
        const int bh = u % 96, c = u / 96, b = bh / 24, head = bh - b * 24, tokb = b * SEQ + c * CH, c4 = head * 64 + 4 * li;
        LDS_BARRIER();
        PrepOut O[2];
#pragma unroll
        for (int p = 0; p < 2; ++p) {
            const int t = p * 32 + wave * 4 + tq; const PrepRaw R = RN[p];
            prep_compute<true>(R, PN, ((tokb + t) & (SEQ - 1)) != 0, O[p]);
            *(LAS f32x4*)(CL + t * 64 + 4 * li) = O[p].ld;
            u32x2 e; e.x = cvt_pk_bf16(O[p].bon * O[p].v.x, O[p].bon * O[p].v.y); e.y = cvt_pk_bf16(O[p].bon * O[p].v.z, O[p].bon * O[p].v.w);
            *(GAS u32x2*)((bf16_t*)(wsl + WS_E) + (size_t)(tokb + t) * CMIX + c4) = e;
        }
        LDS_BARRIER();
        if (wave == 0) {
            float xs[64];
#pragma unroll
            for (int t = 0; t < 64; ++t) xs[t] = CL[t * 64 + lane];
#pragma unroll
            for (int t = 1; t < 64; ++t) xs[t] += xs[t - 1];
#pragma unroll
            for (int t = 0; t < 64; ++t) CL[t * 64 + lane] = xs[t];
        }
        LDS_BARRIER();
#pragma unroll
        for (int p = 0; p < 2; ++p) {
            const int t = p * 32 + wave * 4 + tq;
            const f32x4 cl = *(const LAS f32x4*)(CL + t * 64 + 4 * li);
            f32x4 clm = (f32x4){0.f, 0.f, 0.f, 0.f}; if (t > 0) clm = *(const LAS f32x4*)(CL + (t - 1) * 64 + 4 * li);
            f32x4 nt, rt, bh4, kh4;
#pragma unroll
            for (int q = 0; q < 4; ++q) { const float P = __expf(cl[q]), Pm = __expf(clm[q]), iP = __expf(-cl[q]);
                nt[q] = O[p].nk[q] * Pm; rt[q] = O[p].r[q] * P; bh4[q] = O[p].bb[q] * iP; kh4[q] = O[p].kp[q] * iP;
                if (t == 63) PL[4 * li + q] = P; }
            u32x2 w;
            w.x = cvt_pk_bf16(nt.x, nt.y); w.y = cvt_pk_bf16(nt.z, nt.w); *(LAS u32x2*)(L + SL_NT * W_SLOT + t * WRS + 8 * li) = w;
            w.x = cvt_pk_bf16(rt.x, rt.y); w.y = cvt_pk_bf16(rt.z, rt.w); *(LAS u32x2*)(L + SL_RT * W_SLOT + t * WRS + 8 * li) = w;
            w.x = cvt_pk_bf16(bh4.x, bh4.y); w.y = cvt_pk_bf16(bh4.z, bh4.w); *(LAS u32x2*)(L + SL_BH * W_SLOT + t * WRS + 8 * li) = w;
            w.x = cvt_pk_bf16(kh4.x, kh4.y); w.y = cvt_pk_bf16(kh4.z, kh4.w); *(LAS u32x2*)(L + SL_KH * W_SLOT + t * WRS + 8 * li) = w;
            { f32x4 vv = O[p].v; tr4x4_rows(bh4); tr4x4_rows(kh4); tr4x4_rows(vv);
              const int off = (4 * li + tq) * WRS + (p * 32 + wave * 4) * 2;
              w.x = cvt_pk_bf16(bh4.x, bh4.y); w.y = cvt_pk_bf16(bh4.z, bh4.w); *(LAS u32x2*)(L + SL_BHT * W_SLOT + off) = w;
              w.x = cvt_pk_bf16(kh4.x, kh4.y); w.y = cvt_pk_bf16(kh4.z, kh4.w); *(LAS u32x2*)(L + SL_KHT * W_SLOT + off) = w;
              w.x = cvt_pk_bf16(vv.x, vv.y); w.y = cvt_pk_bf16(vv.z, vv.w); *(LAS u32x2*)(L + SL_VT * W_SLOT + off) = w; }
        }
        LDS_BARRIER();
        for (int reps = 0; reps < REP_WS; ++reps) {
            const int mt = wave >> 1, slotA = (mt < 2) ? SL_NT : SL_RT, slotB = (mt & 1) ? SL_KH : SL_BH, slotO = (mt == 1) ? SL_MK : (mt == 2 ? SL_NB : SL_NK), tt0 = (wave & 1) * 2;
            bf16x8 Af[2][2], Bf[4][2];
#pragma unroll
            for (int a2 = 0; a2 < 2; ++a2)
#pragma unroll
                for (int ks = 0; ks < 2; ++ks) Af[a2][ks] = wfrag(L, slotA, 16 * (tt0 + a2) + fr, ks, fq);
#pragma unroll
            for (int ss = 0; ss < 4; ++ss)
#pragma unroll
                for (int ks = 0; ks < 2; ++ks) Bf[ss][ks] = wfrag(L, slotB, 16 * ss + fr, ks, fq);
            float zf = 0.f; asm volatile("" : "+v"(zf));
            const unsigned zu = __builtin_bit_cast(unsigned, zf);
            const int strict = (mt < 2) ? 1 : 0; LAS unsigned char* ob = L + slotO * W_SLOT;
#pragma unroll
            for (int a2 = 0; a2 < 2; ++a2)
#pragma unroll
                for (int ss = 0; ss < 4; ++ss) { const int t = 16 * (tt0 + a2) + fr, s0 = 16 * ss + 4 * fq;
                    if (ss <= tt0 + a2) {
                        f32x4 acc = __builtin_amdgcn_mfma_f32_16x16x32_bf16(Bf[ss][0], Af[a2][0], (f32x4){0.f, 0.f, 0.f, 0.f}, 0, 0, 0);
                        acc = __builtin_amdgcn_mfma_f32_16x16x32_bf16(Bf[ss][1], Af[a2][1], acc, 0, 0, 0);
                        f32x4 o;
#pragma unroll
                        for (int r = 0; r < 4; ++r) o[r] = (s0 + r + strict <= t) ? acc[r] : 0.f;
                        if (mt == 0) *(LAS f32x4*)(MB + t * 64 + s0) = o;
                        else { u32x2 w; w.x = cvt_pk_bf16(o[0], o[1]); w.y = cvt_pk_bf16(o[2], o[3]); *(LAS u32x2*)(ob + t * WRS + s0 * 2) = w; }
                    } else {
                        if (mt == 0) *(LAS f32x4*)(MB + t * 64 + s0) = (f32x4){zf, zf, zf, zf};
                        else *(LAS u32x2*)(ob + t * WRS + s0 * 2) = (u32x2){zu, zu};
                    }
                }
        }
        LDS_BARRIER();
        { const int t = F.tid >> 3, s0 = (F.tid & 7) * 8; const f32x4 a0 = *(const LAS f32x4*)(MB + t * 64 + s0), a1 = *(const LAS f32x4*)(MB + t * 64 + s0 + 4);
          u32x4 w; w.x = cvt_pk_bf16(a0.x, a0.y); w.y = cvt_pk_bf16(a0.z, a0.w); w.z = cvt_pk_bf16(a1.x, a1.y); w.w = cvt_pk_bf16(a1.z, a1.w);
          *(LAS u32x4*)(L + SL_BH * W_SLOT + t * WRS + s0 * 2) = w; }
#pragma unroll
        for (int k2 = 0; k2 < 2; ++k2) {
            const int tile = wave * 2 + k2, tt = tile >> 2, it = tile & 3;
            f32x4 acc = (f32x4){0.f, 0.f, 0.f, 0.f};
#pragma unroll
            for (int ks = 0; ks < 2; ++ks) acc = __builtin_amdgcn_mfma_f32_16x16x32_bf16(wfrag(L, SL_MK, 16 * tt + fr, ks, fq), wfrag(L, SL_VT, 16 * it + fr, ks, fq), acc, 0, 0, 0);
#pragma unroll
            for (int r = 0; r < 4; ++r) CL[(16 * tt + 4 * fq + r) * 64 + 16 * it + fr] = acc[r];
        }
        if (wave >= 4) {
            const int I = wave - 4;
            float d[16], xb[16];
#pragma unroll
            for (int r = 0; r < 16; ++r) d[r] = (r == lane) ? 1.f : 0.f;
            const LAS float* mbv = MB; asm volatile("" : "+v"(mbv));
            const LAS float* mb = mbv + (16 * I) * 64 + 16 * I;
            f32x4 A[8][2], Bm[8][2];
#pragma unroll
            for (int tt = 0; tt < 8; ++tt) { A[tt][0] = *(const LAS f32x4*)(mb + tt * 64); A[tt][1] = *(const LAS f32x4*)(mb + tt * 64 + 4); }
#pragma unroll
            for (int tt = 0; tt < 8; ++tt) { Bm[tt][0] = *(const LAS f32x4*)(mb + (8 + tt) * 64); Bm[tt][1] = *(const LAS f32x4*)(mb + (8 + tt) * 64 + 4); }
#pragma unroll
            for (int sx = 0; sx < 8; ++sx) { xb[sx] = d[sx];
#pragma unroll
                for (int tt = sx + 1; tt < 8; ++tt) d[tt] = fma_s(A[tt][sx >> 2][sx & 3], xb[sx], d[tt]); }
#pragma unroll
            for (int sx = 0; sx < 8; ++sx)
#pragma unroll
                for (int tt = 0; tt < 8; ++tt) d[8 + tt] = fma_s(Bm[tt][sx >> 2][sx & 3], xb[sx], d[8 + tt]);
            asm volatile("" : "+v"(d[8]), "+v"(d[15]) :: "memory");
#pragma unroll
            for (int tt = 0; tt < 8; ++tt) { A[tt][0] = *(const LAS f32x4*)(mb + (8 + tt) * 64 + 8); A[tt][1] = *(const LAS f32x4*)(mb + (8 + tt) * 64 + 12); }
#pragma unroll
            for (int sx = 0; sx < 8; ++sx) { xb[8 + sx] = d[8 + sx];
#pragma unroll
                for (int tt = sx + 1; tt < 8; ++tt) d[8 + tt] = fma_s(A[tt][sx >> 2][sx & 3], xb[8 + sx], d[8 + tt]); }
            if (lane < 16) {
#pragma unroll
                for (int t = 0; t < 16; ++t) *(LAS bf16_t*)(L + SL_KH * W_SLOT + (16 * I + t) * 48 + lane * 2) = (bf16_t)(cvt_pk_bf16(xb[t], 0.f) & 0xffffu);
            }
        }
        LDS_BARRIER();
        asm volatile("" ::: "memory");
        { const int un = u + F.G; if (un < 96 * NCH) { const int bhn = un % 96, cn = un / 96, bn = bhn / 24, headn = bhn - bn * 24, tokbn = bn * SEQ + cn * CH, c4n = headn * 64 + 4 * li;
#pragma unroll
            for (int p = 0; p < 2; ++p) prep_load(RN[p], z, LW, tokbn + p * 32 + wave * 4 + tq, c4n);
            par_load(PN, Q, c4n); } }
        for (int repx = 0; repx < REP_WX; ++repx) if (wave < 2) {
            const int slotX = wave == 0 ? SL_W1T : SL_U0T;
            LAS unsigned char* TI = L + SL_KH * W_SLOT;
            LAS unsigned char* DT = TI + 3072 + wave * 3072;
            const bf16x8 zf = (bf16x8){0, 0, 0, 0, 0, 0, 0, 0};
#pragma unroll
            for (int I = 0; I < 4; ++I) {
                f32x4 acc[4];
                if (wave == 0) {
#pragma unroll
                    for (int ct = 0; ct < 4; ++ct)
#pragma unroll
                        for (int r = 0; r < 4; ++r) acc[ct][r] = bf2f(*(const LAS bf16_t*)(L + SL_NT * W_SLOT + (16 * I + 4 * fq + r) * WRS + (16 * ct + fr) * 2));
                } else {
#pragma unroll
                    for (int ct = 0; ct < 4; ++ct)
#pragma unroll
                        for (int r = 0; r < 4; ++r) acc[ct][r] = CL[(16 * I + 4 * fq + r) * 64 + 16 * ct + fr];
                }
                if (I > 0) {
#pragma unroll
                    for (int ks = 0; ks < (I + 1) / 2; ++ks) {
                        const bool half = (32 * ks + 16 == 16 * I);
                        bf16x8 af = wfrag(L, SL_BH, 16 * I + fr, ks, fq);
                        if (half && fq >= 2) af = zf;
#pragma unroll
                        for (int ct = 0; ct < 4; ++ct) { bf16x8 bfr = wfrag(L, slotX, 16 * ct + fr, ks, fq);
                            if (half && fq >= 2) bfr = zf;
                            acc[ct] = __builtin_amdgcn_mfma_f32_16x16x32_bf16(af, bfr, acc[ct], 0, 0, 0); }
                    }
                }
#pragma unroll
                for (int ct = 0; ct < 4; ++ct) { u32x2 w; w.x = cvt_pk_bf16(acc[ct][0], acc[ct][1]); w.y = cvt_pk_bf16(acc[ct][2], acc[ct][3]); *(LAS u32x2*)(DT + (16 * ct + fr) * 48 + 8 * fq) = w; }
                LDS_WAIT();
                bf16x8 af = *(const LAS bf16x8*)(TI + (16 * I + fr) * 48 + (fq & 1) * 16); if (fq >= 2) af = zf;
#pragma unroll
                for (int ct = 0; ct < 4; ++ct) { bf16x8 bfr = *(const LAS bf16x8*)(DT + (16 * ct + fr) * 48 + (fq & 1) * 16); if (fq >= 2) bfr = zf;
                    const f32x4 x = __builtin_amdgcn_mfma_f32_16x16x32_bf16(af, bfr, (f32x4){0.f, 0.f, 0.f, 0.f}, 0, 0, 0);
                    u32x2 w; w.x = cvt_pk_bf16(x[0], x[1]); w.y = cvt_pk_bf16(x[2], x[3]); *(LAS u32x2*)(L + slotX * W_SLOT + (16 * ct + fr) * WRS + (16 * I + 4 * fq) * 2) = w; }
                LDS_WAIT();
            }
        }
        LDS_BARRIER();
        for (int repo = 0; repo < REP_WO; ++repo) {
            const int kind = wave >> 1, ta0 = (wave & 1) * 2;
            float* gp = gh_ptr(wsl, bh, c, 0); float* hp = gh_ptr(wsl, bh, c, 1);
            bf16_t* qy = (bf16_t*)(wsl + WS_QY) + (size_t)u * 4096; float* y0t = (float*)(wsl + WS_Y0T) + (size_t)u * 4096;
            const int sA1 = kind == 0 ? SL_W1T : kind == 1 ? SL_BHT : kind == 2 ? SL_W1T : SL_NK, sB1 = kind == 0 ? SL_BHT : kind == 1 ? SL_U0T : kind == 2 ? SL_NB : SL_VT;
            const int sA2 = kind == 1 ? SL_KHT : SL_NB, sB2 = kind == 1 ? SL_VT : SL_U0T; const bool two = (kind & 1) != 0;
            bf16x8 Af[2][2], Bf[4][2];
#pragma unroll
            for (int a2 = 0; a2 < 2; ++a2)
#pragma unroll
                for (int ks = 0; ks < 2; ++ks) Af[a2][ks] = wfrag(L, sA1, 16 * (ta0 + a2) + fr, ks, fq);
#pragma unroll
            for (int tb = 0; tb < 4; ++tb)
#pragma unroll
                for (int ks = 0; ks < 2; ++ks) Bf[tb][ks] = wfrag(L, sB1, 16 * tb + fr, ks, fq);
            f32x4 acc[2][4];
#pragma unroll
            for (int a2 = 0; a2 < 2; ++a2)
#pragma unroll
                for (int tb = 0; tb < 4; ++tb) { acc[a2][tb] = (f32x4){0.f, 0.f, 0.f, 0.f};
#pragma unroll
                    for (int ks = 0; ks < 2; ++ks) acc[a2][tb] = __builtin_amdgcn_mfma_f32_16x16x32_bf16(Af[a2][ks], Bf[tb][ks], acc[a2][tb], 0, 0, 0); }
            if (two) {
#pragma unroll
                for (int a2 = 0; a2 < 2; ++a2)
#pragma unroll
                    for (int ks = 0; ks < 2; ++ks) Af[a2][ks] = wfrag(L, sA2, 16 * (ta0 + a2) + fr, ks, fq);
#pragma unroll
                for (int tb = 0; tb < 4; ++tb)
#pragma unroll
                    for (int ks = 0; ks < 2; ++ks) Bf[tb][ks] = wfrag(L, sB2, 16 * tb + fr, ks, fq);
#pragma unroll
                for (int a2 = 0; a2 < 2; ++a2)
#pragma unroll
                    for (int tb = 0; tb < 4; ++tb)
#pragma unroll
                        for (int ks = 0; ks < 2; ++ks) acc[a2][tb] = __builtin_amdgcn_mfma_f32_16x16x32_bf16(Af[a2][ks], Bf[tb][ks], acc[a2][tb], 0, 0, 0);
            }
#pragma unroll
            for (int a2 = 0; a2 < 2; ++a2)
#pragma unroll
                for (int tb = 0; tb < 4; ++tb) { const int ta = ta0 + a2; const f32x4 av = acc[a2][tb];
                    if (kind == 0) {
                        const int j = 16 * tb + fr; const float pl = PL[j];
                        f32x4 o;
#pragma unroll
                        for (int r = 0; r < 4; ++r) o[r] = pl * (av[r] + ((16 * ta + 4 * fq + r) == j ? 1.f : 0.f));
                        u32x2 w; w.x = cvt_pk_bf16(o[0], o[1]); w.y = cvt_pk_bf16(o[2], o[3]);
                        *(GAS u32x2*)((bf16_t*)gp + j * 64 + 16 * ta + 4 * fq) = w;
                    } else if (kind == 1) {
                        const f32x4 pl = *(const LAS f32x4*)(PL + 16 * ta + 4 * fq);
                        *(GAS f32x4*)(hp + (16 * tb + fr) * 64 + 16 * ta + 4 * fq) = pl * av;
                    } else if (kind == 2) {
                        const int t = 16 * tb + fr; const u32x2 rr = *(const LAS u32x2*)(L + SL_RT * W_SLOT + t * WRS + (16 * ta + 4 * fq) * 2);
                        u32x2 w; w.x = cvt_pk_bf16(av[0] + bflo(rr.x), av[1] + bfhi(rr.x)); w.y = cvt_pk_bf16(av[2] + bflo(rr.y), av[3] + bfhi(rr.y));
                        *(GAS u32x2*)(qy + t * 64 + 16 * ta + 4 * fq) = w;
                    } else {
                        *(GAS f32x4*)(y0t + (16 * tb + fr) * 64 + 16 * ta + 4 * fq) = av;
                    }
                }
        }
    }
    LDS_BARRIER();
}
DI void scan_w2(const Ctx& F, const RwPar& Q) {
    unsigned char* const wsl = F.ws; const int lane = F.lane, fr = lane & 15, fq = lane >> 4;
    LAS float* yb = (LAS float*)(F.lds + F.wave * 16384);
    const bf16_t* gate = (const bf16_t*)(wsl + WS_GATE); const bf16_t* Eb = (const bf16_t*)(wsl + WS_E); bf16_t* cat = (bf16_t*)(wsl + WS_CAT);
    for (int u = F.gw; u < 96 * NCH; u += F.ngw) {
        const int bh = u % 96, c = u / 96, b = bh / 24, head = bh - b * 24, tokb = b * SEQ + c * CH;
        const bf16_t* qy = (const bf16_t*)(wsl + WS_QY) + (size_t)u * 4096; const float* y0t = (const float*)(wsl + WS_Y0T) + (size_t)u * 4096;
        f32x4 acc[4][4];
#pragma unroll
        for (int tt = 0; tt < 4; ++tt)
#pragma unroll
            for (int it = 0; it < 4; ++it) acc[tt][it] = *(const GAS f32x4*)(y0t + (16 * it + fr) * 64 + 16 * tt + 4 * fq);
        if (c > 0) {
            const bf16_t* sp = (const bf16_t*)gh_ptr(wsl, bh, c - 1, 0) + 4096;
            bf16x8 Bf[4][2];
#pragma unroll
            for (int it = 0; it < 4; ++it)
#pragma unroll
                for (int ks = 0; ks < 2; ++ks) Bf[it][ks] = *(const GAS bf16x8*)(sp + (16 * it + fr) * 64 + 32 * ks + 8 * fq);
#pragma unroll
            for (int tt = 0; tt < 4; ++tt)
#pragma unroll
                for (int ks = 0; ks < 2; ++ks) { const bf16x8 Af = *(const GAS bf16x8*)(qy + (16 * tt + fr) * 64 + 32 * ks + 8 * fq);
#pragma unroll
                    for (int it = 0; it < 4; ++it) acc[tt][it] = __builtin_amdgcn_mfma_f32_16x16x32_bf16(Af, Bf[it][ks], acc[tt][it], 0, 0, 0); }
        }
#pragma unroll
        for (int tt = 0; tt < 4; ++tt)
#pragma unroll
            for (int it = 0; it < 4; ++it)
#pragma unroll
                for (int r = 0; r < 4; ++r) yb[(16 * tt + 4 * fq + r) * 64 + 16 * it + fr] = acc[tt][it][r];
        LDS_WAIT();
#pragma unroll 4
        for (int k = 0; k < 16; ++k) {
            const int slot = k * 64 + lane, t = slot >> 4, li = slot & 15, c4 = head * 64 + 4 * li, tok = tokb + t;
            const f32x4 y = *(const LAS f32x4*)(yb + t * 64 + 4 * li);
            const u32x2 ev = *(const GAS u32x2*)(Eb + (size_t)tok * CMIX + c4), gt = *(const GAS u32x2*)(gate + (size_t)tok * CMIX + c4);
            const float mean = sum16(y.x + y.y + y.z + y.w) * (1.f / 64.f);
            const f32x4 d = y - mean;
            const float var = sum16(d.x * d.x + d.y * d.y + d.z * d.z + d.w * d.w) * (1.f / 64.f);
            const float rstd = rsqrtf(var + GN_EPS);
            const f32x4 g4 = *(const GAS f32x4*)(Q.gng + c4), b4 = *(const GAS f32x4*)(Q.gnb + c4);
            f32x4 o = d * rstd * g4 + b4; o.x += bflo(ev.x); o.y += bfhi(ev.x); o.z += bflo(ev.y); o.w += bfhi(ev.y);
            u32x2 w; w.x = cvt_pk_bf16(o.x * bflo(gt.x), o.y * bfhi(gt.x)); w.y = cvt_pk_bf16(o.z * bflo(gt.y), o.w * bfhi(gt.y));
            *(GAS u32x2*)(cat + (size_t)tok * DM + c4) = w;
        }
        LDS_WAIT();
    }
}
DI void scan_passB(const Ctx& F) {
    unsigned char* const wsl = F.ws; const int lane = F.lane, fr = lane & 15, fq = lane >> 4, ih = F.wave >> 2, q = F.wave & 3, bh = F.bid;
    LAS unsigned char* Sx0 = F.lds;
    bf16x8 ga[7][2]; f32x4 hq[7][2];
#define PB_LOAD(set, cc) do { const GAS bf16_t* _gp = (const GAS bf16_t*)gh_ptr(wsl, bh, (cc), 0) + (16 * q + fr) * 64 + 8 * fq; const GAS float* _hp = (const GAS float*)(gh_ptr(wsl, bh, (cc), 1) + (32 * ih + fr) * 64 + 16 * q + 4 * fq); \
        ga[set][0] = *(const GAS bf16x8*)_gp; ga[set][1] = *(const GAS bf16x8*)(_gp + 32); \
        _Pragma("unroll") for (int _r = 0; _r < 2; ++_r) hq[set][_r] = *(const GAS f32x4*)(_hp + (16 * _r) * 64); } while (0)
    PB_LOAD(0, 0); PB_LOAD(1, 1); PB_LOAD(2, 2); PB_LOAD(3, 3); PB_LOAD(4, 4); PB_LOAD(5, 5);
    for (int c7 = 0; c7 < NCH - 1; c7 += 7) {
#pragma unroll
        for (int u7 = 0; u7 < 7; ++u7) {
            const int c = c7 + u7;
            f32x4 acc[2];
#pragma unroll
            for (int it = 0; it < 2; ++it) acc[it] = hq[u7][it];
            const bf16x8 a0 = ga[u7][0], a1 = ga[u7][1];
            PB_LOAD((u7 + 6) % 7, (c + 6 < NCH - 1) ? c + 6 : NCH - 2);
            if (c > 0) {
#pragma unroll
                for (int it = 0; it < 2; ++it) {
                    acc[it] = __builtin_amdgcn_mfma_f32_16x16x32_bf16(a0, *(const LAS bf16x8*)(Sx0 + (c & 1) * W_SLOT + (32 * ih + 16 * it + fr) * WRS + fq * 16), acc[it], 0, 0, 0);
                    acc[it] = __builtin_amdgcn_mfma_f32_16x16x32_bf16(a1, *(const LAS bf16x8*)(Sx0 + (c & 1) * W_SLOT + (32 * ih + 16 * it + fr) * WRS + 64 + fq * 16), acc[it], 0, 0, 0); }
            }
            GAS bf16_t* op = (GAS bf16_t*)gh_ptr(wsl, bh, c, 0) + 4096 + (32 * ih + fr) * 64 + 16 * q + 4 * fq;
#pragma unroll
            for (int it = 0; it < 2; ++it) { u32x2 w; w.x = cvt_pk_bf16(acc[it].x, acc[it].y); w.y = cvt_pk_bf16(acc[it].z, acc[it].w);
                *(GAS u32x2*)(op + (16 * it) * 64) = w; *(LAS u32x2*)(Sx0 + ((c + 1) & 1) * W_SLOT + (32 * ih + 16 * it + fr) * WRS + (16 * q + 4 * fq) * 2) = w; }
            LDS_BARRIER();
        }
    }
#undef PB_LOAD
}

DI void ln1_router(const Ctx& F, const Params& P, int l, const float* xin) {
    unsigned char* const wsl = F.ws; float* const outl = F.out; (void)outl;
    const float* g = PIN(5) + (size_t)l * DM; const float* bta = PIN(6) + (size_t)l * DM;
    const float* gb = PIN(10) + l * 4; const float* eb = PIN(12) + l * 32;
    const bf16_t* hb = (const bf16_t*)(wsl + WS_HB); bf16_t* xb = (bf16_t*)(wsl + WS_XB); float* xo = outl;
    const bf16_t* wrt = (const bf16_t*)(wsl + WS_WSW + (size_t)l * WSW_STRIDE);
    unsigned* cnt = (unsigned*)(wsl + WS_CTL) + CW_CNT + l * 32 * 64;
    int* ltok = (int*)(wsl + WS_LTOK); float* lgate = (float*)(wsl + WS_LGATE); int* lslot = (int*)(wsl + WS_LSLOT);
    const int lane = F.lane, fr = lane & 15, fq = lane >> 4, wave = F.wave;
    LAS float* lg = (LAS float*)(F.lds + (wave & 3) * 4096);
    LAS float* lgp = (LAS float*)(F.lds + 16384 + (wave & 3) * 4096);
    LAS int* cntl = (LAS int*)(F.lds + 32768); LAS int* basel = cntl + 32;
    if (F.tid < NEXP) cntl[F.tid] = 0;
    __syncthreads();
    for (int blk = F.bid; blk < NTOK / 64; blk += F.G) {
#pragma unroll 1
        for (int pass = 0; pass < 4; ++pass) {
            int lno = lane; asm volatile("" : "+v"(lno));
            const int hr2 = lno >> 5, l32 = lno & 31;
            const size_t ro = (size_t)(blk * 64 + wave * 8 + pass * 2 + hr2) * DM + 8 * l32;
            u32x4 xr[8], hr[8];
#pragma unroll
            for (int i = 0; i < 8; ++i) { xr[i] = *(const GAS u32x4*)(xb + ro + 256 * i); hr[i] = *(const GAS u32x4*)(hb + ro + 256 * i); }
            float s = 0.f, s2 = 0.f;
#pragma unroll
            for (int i = 0; i < 8; ++i) {
#pragma unroll
                for (int e = 0; e < 4; ++e) { const float v0 = ALPHA * bflo(xr[i][e]) + bflo(hr[i][e]), v1 = ALPHA * bfhi(xr[i][e]) + bfhi(hr[i][e]); s += v0 + v1; s2 += v0 * v0 + v1 * v1; } }
            s = sum16(s); s2 = sum16(s2); s += __shfl_xor(s, 16); s2 += __shfl_xor(s2, 16);
            const float mean = s * (1.f / DM), rstd = rsqrtf(fmaxf(s2 * (1.f / DM) - mean * mean, 0.f) + LN_EPS);
#pragma unroll
            for (int i = 0; i < 8; ++i) { const int col = 256 * i + 8 * l32;
                const f32x4 g0 = *(const GAS f32x4*)(g + col), g1 = *(const GAS f32x4*)(g + col + 4), b0 = *(const GAS f32x4*)(bta + col), b1 = *(const GAS f32x4*)(bta + col + 4);
                u32x4 w;
#pragma unroll
                for (int e = 0; e < 4; ++e) { const float v0 = ALPHA * bflo(xr[i][e]) + bflo(hr[i][e]), v1 = ALPHA * bfhi(xr[i][e]) + bfhi(hr[i][e]);
                    const float gg0 = e < 2 ? g0[2 * e] : g1[2 * e - 4], gg1 = e < 2 ? g0[2 * e + 1] : g1[2 * e - 3], bb0 = e < 2 ? b0[2 * e] : b1[2 * e - 4], bb1 = e < 2 ? b0[2 * e + 1] : b1[2 * e - 3];
                    w[e] = cvt_pk_bf16((v0 - mean) * rstd * gg0 + bb0, (v1 - mean) * rstd * gg1 + bb1); }
                *(GAS u32x4*)(xb + ro + 256 * i) = w;
                asm volatile("" ::: "memory"); }
        }
        VM_WAIT();
        __syncthreads();
        __builtin_amdgcn_fence(__ATOMIC_ACQUIRE, "agent");
        VM_WAIT();
        const int row0 = blk * 64 + (wave & 3) * 16, kh = wave >> 2, krot = (F.bid * 5 + wave * 3) & 31;
        f32x4 acc[3];
#pragma unroll
        for (int ct = 0; ct < 3; ++ct) acc[ct] = (f32x4){0.f, 0.f, 0.f, 0.f};
        const bf16_t* arow = xb + (size_t)(row0 + fr) * DM + 8 * fq + kh * 1024;
        LAS unsigned char* wst = F.lds + 36864;
        u32x4 wreg[6];
        { const int st = F.bid & 7;
#pragma unroll
          for (int i = 0; i < 6; ++i) { const int ch = F.tid + NT * i, row = ch >> 4, c16 = ch & 15, rkh = row / 96, rr = row - rkh * 96;
              wreg[i] = *(const GAS u32x4*)(wrt + (size_t)rr * DM + rkh * 1024 + st * 128 + c16 * 8); } }
#pragma unroll 1
        for (int si = 0; si < 8; ++si) {
            const int st = (si + F.bid) & 7;
            LAS unsigned char* wb = wst + (si & 1) * 52224;
#pragma unroll
            for (int i = 0; i < 6; ++i) { const int ch = F.tid + NT * i, row = ch >> 4, c16 = ch & 15; *(LAS u32x4*)(wb + row * 272 + c16 * 16) = wreg[i]; }
            if (si + 1 < 8) { const int stn = (si + 1 + F.bid) & 7;
#pragma unroll
                for (int i = 0; i < 6; ++i) { const int ch = F.tid + NT * i, row = ch >> 4, c16 = ch & 15, rkh = row / 96, rr = row - rkh * 96;
                    wreg[i] = *(const GAS u32x4*)(wrt + (size_t)rr * DM + rkh * 1024 + stn * 128 + c16 * 8); } }
            bf16x8 af[4];
#pragma unroll
            for (int ksl = 0; ksl < 4; ++ksl) af[ksl] = *(const GAS bf16x8*)(arow + st * 128 + ksl * 32);
            LDS_BARRIER();
#pragma unroll
            for (int ksl = 0; ksl < 4; ++ksl)
#pragma unroll
                for (int ct = 0; ct < 3; ++ct) {
                    acc[ct] = __builtin_amdgcn_mfma_f32_16x16x32_bf16(af[ksl], *(const LAS bf16x8*)(wb + (kh * 96 + 16 * ct + fr) * 272 + ksl * 64 + fq * 16), acc[ct], 0, 0, 0);
                    acc[ct] = __builtin_amdgcn_mfma_f32_16x16x32_bf16(af[ksl], *(const LAS bf16x8*)(wb + (kh * 96 + 48 + 16 * ct + fr) * 272 + ksl * 64 + fq * 16), acc[ct], 0, 0, 0);
                }
        }
        if (kh == 1) {
#pragma unroll
            for (int ct = 0; ct < 3; ++ct)
#pragma unroll
                for (int jj = 0; jj < 4; ++jj) lgp[(4 * fq + jj) * 48 + 16 * ct + fr] = acc[ct][jj];
        }
        __syncthreads();
        if (kh == 0) {
#pragma unroll
            for (int ct = 0; ct < 3; ++ct)
#pragma unroll
                for (int jj = 0; jj < 4; ++jj) lg[(4 * fq + jj) * 48 + 16 * ct + fr] = acc[ct][jj] + lgp[(4 * fq + jj) * 48 + 16 * ct + fr];
        }
        LDS_WAIT();
        int se0 = 0, se1 = 0, sr0 = 0, sr1 = 0, stok = 0; float sg0 = 0.f, sg1 = 0.f;
        if (kh == 0 && lane < 16) {
            const LAS float* L = lg + lane * 48; const int tok = row0 + lane;
            float gl[4]; int grp_i = 0; float gmx;
#pragma unroll
            for (int q = 0; q < 4; ++q) gl[q] = L[q] + gb[q];
            gmx = gl[0];
#pragma unroll
            for (int q = 1; q < 4; ++q) if (gl[q] > gmx) { gmx = gl[q]; grp_i = q; }
            float gs = 0.f;
#pragma unroll
            for (int q = 0; q < 4; ++q) gs += __expf(gl[q] - gmx);
            const float pg = 1.f / gs;
            float el[8];
#pragma unroll
            for (int q = 0; q < 8; ++q) el[q] = L[4 + 8 * grp_i + q] + eb[8 * grp_i + q];
            int i0 = 0; float m0 = el[0];
#pragma unroll
            for (int q = 1; q < 8; ++q) if (el[q] > m0) { m0 = el[q]; i0 = q; }
            int i1 = -1; float m1 = -3.0e38f;
#pragma unroll
            for (int q = 0; q < 8; ++q) if (q != i0 && el[q] > m1) { m1 = el[q]; i1 = q; }
            if (i1 < 0) { i1 = (i0 == 0) ? 1 : 0; m1 = m0; }
            const float p1 = __expf(m1 - m0), den = 1.f / (1.f + p1);
            const float g0 = pg * den, g1 = pg * p1 * den;
            se0 = grp_i * 8 + i0; se1 = grp_i * 8 + i1; sg0 = g0; sg1 = g1; stok = tok;
            sr0 = __hip_atomic_fetch_add(cntl + se0, 1, __ATOMIC_RELAXED, __HIP_MEMORY_SCOPE_WORKGROUP);
            sr1 = __hip_atomic_fetch_add(cntl + se1, 1, __ATOMIC_RELAXED, __HIP_MEMORY_SCOPE_WORKGROUP);
        }
        __syncthreads();
        if (wave == 0 && lane < NEXP) { const int n = cntl[lane]; basel[lane] = n ? (int)__hip_atomic_fetch_add(cnt + lane * 64, (unsigned)n, __ATOMIC_RELAXED, __HIP_MEMORY_SCOPE_AGENT) : 0; }
        __syncthreads();
        if (kh == 0 && lane < 16) {
            const int pos0 = basel[se0] + sr0, pos1 = basel[se1] + sr1;
            ltok[se0 * LISTCAP + pos0] = stok; lgate[se0 * LISTCAP + pos0] = sg0; lslot[se0 * LISTCAP + pos0] = 2 * stok;
            ltok[se1 * LISTCAP + pos1] = stok; lgate[se1 * LISTCAP + pos1] = sg1; lslot[se1 * LISTCAP + pos1] = 2 * stok + 1;
        }
        __syncthreads();
        if (F.tid < NEXP) cntl[F.tid] = 0;
        __syncthreads();
    }
}

DI void ln2_phase(const Ctx& F, const Params& P, int l) {
    unsigned char* const wsl = F.ws; float* const outl = F.out;
    const float* g = PIN(7) + (size_t)l * DM; const float* bta = PIN(8) + (size_t)l * DM;
    const bf16_t* ys = (const bf16_t*)(wsl + WS_YS); bf16_t* xb = (bf16_t*)(wsl + WS_XB); float* xo = outl;
#pragma unroll 1
    for (int rp = F.gw; rp < NTOK / 2; rp += F.ngw) {
        int lno = F.lane; asm volatile("" : "+v"(lno));
        const int hr2 = lno >> 5, l32 = lno & 31, row = 2 * rp + hr2;
        const size_t ro = (size_t)row * DM + 8 * l32;
        u32x4 xr[8], y0[8], y1[8];
#pragma unroll
        for (int i = 0; i < 8; ++i) { xr[i] = *(const GAS u32x4*)(xb + ro + 256 * i); y0[i] = *(const GAS u32x4*)(ys + 2 * (size_t)row * DM + 8 * l32 + 256 * i); y1[i] = *(const GAS u32x4*)(ys + (2 * (size_t)row + 1) * DM + 8 * l32 + 256 * i); }
        float s = 0.f, s2 = 0.f;
#pragma unroll
        for (int i = 0; i < 8; ++i) {
#pragma unroll
            for (int e = 0; e < 4; ++e) { const float v0 = ALPHA * bflo(xr[i][e]) + (bflo(y0[i][e]) + bflo(y1[i][e])), v1 = ALPHA * bfhi(xr[i][e]) + (bfhi(y0[i][e]) + bfhi(y1[i][e])); s += v0 + v1; s2 += v0 * v0 + v1 * v1; } }
        s = sum16(s); s2 = sum16(s2); s += __shfl_xor(s, 16); s2 += __shfl_xor(s2, 16);
        const float mean = s * (1.f / DM), rstd = rsqrtf(fmaxf(s2 * (1.f / DM) - mean * mean, 0.f) + LN_EPS);
#pragma unroll
        for (int i = 0; i < 8; ++i) { const int col = 256 * i + 8 * l32;
            const f32x4 g0 = *(const GAS f32x4*)(g + col), g1 = *(const GAS f32x4*)(g + col + 4), b0 = *(const GAS f32x4*)(bta + col), b1 = *(const GAS f32x4*)(bta + col + 4);
            float o[8];
#pragma unroll
            for (int e = 0; e < 4; ++e) { const float v0 = ALPHA * bflo(xr[i][e]) + (bflo(y0[i][e]) + bflo(y1[i][e])), v1 = ALPHA * bfhi(xr[i][e]) + (bfhi(y0[i][e]) + bfhi(y1[i][e]));
                const float gg0 = e < 2 ? g0[2 * e] : g1[2 * e - 4], gg1 = e < 2 ? g0[2 * e + 1] : g1[2 * e - 3], bb0 = e < 2 ? b0[2 * e] : b1[2 * e - 4], bb1 = e < 2 ? b0[2 * e + 1] : b1[2 * e - 3];
                o[2 * e] = (v0 - mean) * rstd * gg0 + bb0; o[2 * e + 1] = (v1 - mean) * rstd * gg1 + bb1; }
            if (l == NLAYER - 1) { *(GAS f32x4*)(xo + (size_t)row * DM + col) = (f32x4){o[0], o[1], o[2], o[3]}; *(GAS f32x4*)(xo + (size_t)row * DM + col + 4) = (f32x4){o[4], o[5], o[6], o[7]}; }
            else { u32x4 w; w.x = cvt_pk_bf16(o[0], o[1]); w.y = cvt_pk_bf16(o[2], o[3]); w.z = cvt_pk_bf16(o[4], o[5]); w.w = cvt_pk_bf16(o[6], o[7]); *(GAS u32x4*)(xb + ro + 256 * i) = w; }
            asm volatile("" ::: "memory"); }
    }
}

DI int moe_table(const Ctx& F, int l) {
    unsigned char* const wsl = F.ws; float* const outl = F.out; (void)outl;
    LAS int* tb = (LAS int*)(F.lds + LDS_CTL_OFF) + 16;
    const unsigned* cnt = (const unsigned*)(wsl + WS_CTL) + CW_CNT + l * 32 * 64;
    __syncthreads();
    if (F.tid == 0) { int acc = 0;
        for (int e = 0; e < NEXP; ++e) { tb[e] = acc; const int n = (int)__hip_atomic_load(cnt + e * 64, __ATOMIC_RELAXED, __HIP_MEMORY_SCOPE_AGENT); acc += (n + 255) >> 8; }
        tb[NEXP] = acc; }
    __syncthreads();
    return tb[NEXP];
}


#ifdef MK_DEBUG
constexpr int CW_DBG = 40960;
DI void dbg_count_bf16(const Ctx& F, const bf16_t* p, size_t n, int k) {
    unsigned bad = 0; const size_t gt = (size_t)F.bid * NT + F.tid, ngt = (size_t)F.G * NT;
    for (size_t i = gt; i < n; i += ngt) { const unsigned b = p[i]; const float v = bf2f(b); if ((b & 0x7f80u) == 0x7f80u || fabsf(v) > 1.0e6f) ++bad; }
    if (bad) atomicAdd((unsigned*)(F.ws + WS_CTL) + CW_DBG + k * 64, bad);
}
DI void dbg_count_f32(const Ctx& F, const float* p, size_t n, int k) {
    unsigned bad = 0; const size_t gt = (size_t)F.bid * NT + F.tid, ngt = (size_t)F.G * NT;
    for (size_t i = gt; i < n; i += ngt) { const float v = p[i]; if (!(fabsf(v) <= 1.0e6f)) ++bad; }
    if (bad) atomicAdd((unsigned*)(F.ws + WS_CTL) + CW_DBG + k * 64, bad);
}
#endif
constexpr int PH_PER_LAYER = 11, N_PHASES = 1 + NLAYER * PH_PER_LAYER;

__global__ void __launch_bounds__(NT, 2) mega_fwd(Params P) {
    extern __shared__ __attribute__((aligned(16))) unsigned char lds_raw[];
    Ctx F0;
    F0.lds = (LAS unsigned char*)lds_raw;
    F0.tid = threadIdx.x; F0.lane = F0.tid & 63; F0.wave = __builtin_amdgcn_readfirstlane(F0.tid >> 6);
    F0.G = gridDim.x; F0.bid = blockIdx.x; F0.gw = F0.bid * NWAVES + F0.wave; F0.ngw = F0.G * NWAVES;
    F0.ws = P.ws; F0.out = P.out;
    for (int u = F0.tid; u < (LDS_BYTES - LDS_CTL_OFF) / 4; u += NT) ((LAS unsigned*)(F0.lds + LDS_CTL_OFF))[u] = 0u;
    __syncthreads();
    XcdBarrier bar; bar.bar = (unsigned*)(F0.ws + WS_CTL) + CW_BAR; bar.x = 0; bar.st = nullptr;
#if !MK_PER_PHASE
    bar = xcd_barrier_post((unsigned*)(F0.ws + WS_CTL) + CW_BAR, (volatile LAS unsigned*)(F0.lds + LDS_CTL_OFF));
#endif
    const int lo = P.ph_lo, hi = P.ph_hi;
#define IN(k) (lo <= (k) && (k) < hi)
#if MK_PER_PHASE
#define SEAM(k) do { } while (0)
#else
#define SEAM(k) do { if ((k) + 1 < hi) { XcdBarrier _b = bar; asm volatile("" : "+s"(_b.bar), "+s"(_b.x)); xcd_barrier(_b); } } while (0)
#endif
#define WSL const Ctx F = relaunder(F0); unsigned char* const ws = F.ws; bf16_t* const xb = (bf16_t*)(ws + WS_XB); bf16_t* const zb = (bf16_t*)(ws + WS_Z); bf16_t* const cat = (bf16_t*)(ws + WS_CAT); (void)xb; (void)zb; (void)cat

    if (IN(0)) { WSL; phase_prologue(F, P); SEAM(0); }

    for (int l = 0; l < NLAYER; ++l) {
        const int kind = l % 3, j = l / 3, pb = 1 + l * PH_PER_LAYER;
        const int zw = (kind == 0) ? ZW_RWKV : ZW_OTH, qcol = (kind == 0) ? 5056 : 4608;
        if (IN(pb + 0)) {
            WSL; const bf16_t* winT = (const bf16_t*)(ws + WS_WIN + (size_t)l * WIN_STRIDE);
            if (kind != 2) dense_gemm(F, xb, DM, winT, DM, NTOK, zw, DM, zb, zw, 0);
            else {
                dense_gemm(F, xb, DM, winT, DM, NTOK, 3072, DM, zb, zw, 0);
                dense_gemm(F, xb, DM, winT + (size_t)4608 * DM, DM, NTOK, 512, DM, zb + 4608, zw, 0);
                dense_gemm(F, winT + (size_t)3072 * DM, DM, xb, DM, CMIX, NTOK, DM, (bf16_t*)(ws + WS_ACT), NTOK, 128);
            }
            if (l == 0) {
                dense_gemm(F, (const bf16_t*)(ws + WS_MEMB), DM, (const bf16_t*)(ws + WS_WK), DM, NBATCH * MEML, 2048, DM, (bf16_t*)(ws + WS_KM), 2048, 128);
                dense_gemm(F, (const bf16_t*)(ws + WS_WV), DM, (const bf16_t*)(ws + WS_MEMB), DM, 2048, NBATCH * MEML, DM, (bf16_t*)(ws + WS_VMT), 1024, 192);
            }
            SEAM(pb + 0);
        }
        if (IN(pb + 1)) {
            WSL;
            if (kind == 0) { for (int rep = 0; rep < REP_PREP; ++rep) rwkv_prep1(F, P, j, zb); for (int rep = 0; rep < REP_MIX * REP_MA; ++rep) memattn_all(F, l, zb, zw, qcol); }
            else if (kind == 1) { for (int rep = 0; rep < REP_MIX; ++rep) conv_mix(F, P, zb); for (int rep = 0; rep < REP_MIX * REP_MA; ++rep) memattn_all(F, l, zb, zw, qcol); for (int rep = 0; rep < REP_CONV; ++rep) expert_convert(F, P, l, F.gw, F.ngw); }
            else { for (int rep = 0; rep < REP_MIX * REP_SB; ++rep) sb_attention(F, zb); for (int rep = 0; rep < REP_MIX * REP_MA; ++rep) memattn_all(F, l, zb, zw, qcol); for (int rep = 0; rep < REP_CONV; ++rep) expert_convert(F, P, l, F.gw, F.ngw); }
            SEAM(pb + 1);
        }
        if (kind == 0) {
            if (IN(pb + 2)) {
                WSL; const bf16_t* act = (const bf16_t*)(ws + WS_ACT); const bf16_t* wa = (const bf16_t*)(ws + WS_LORA + (size_t)j * LORA_STRIDE);
                dense_gemm(F, act, 512, wa, 256, NTOK, 3072, 256, (bf16_t*)(ws + WS_LW), 3072, 0);
                dense_gemm(F, act + 256, 512, wa + (size_t)3072 * 256, 256, NTOK, CMIX, 256, (bf16_t*)(ws + WS_GATE), CMIX, 0);
                SEAM(pb + 2);
            }
            if (IN(pb + 3)) { WSL; const RwPar Q{PIN(17) + (size_t)j * 5056, PIN(18) + j * CMIX, PIN(20) + j * CMIX, PIN(23) + j * CMIX, PIN(24) + j * CMIX, PIN(25) + j * CMIX, PIN(26) + j * CMIX, PIN(27) + j * CMIX};
                for (int rep = 0; rep < REP_SCAN; ++rep) scan_w1(F, Q, zb); SEAM(pb + 3); }
            if (IN(pb + 4)) {
                WSL;
                if (F.bid < 96) scan_passB(F);
                else expert_convert(F, P, l, (F.bid - 96) * NWAVES + F.wave, (F.G - 96) * NWAVES);
                SEAM(pb + 4);
            }
            if (IN(pb + 5)) { WSL; const RwPar Q{PIN(17) + (size_t)j * 5056, PIN(18) + j * CMIX, PIN(20) + j * CMIX, PIN(23) + j * CMIX, PIN(24) + j * CMIX, PIN(25) + j * CMIX, PIN(26) + j * CMIX, PIN(27) + j * CMIX};
                for (int rep = 0; rep < REP_SCAN * REP_W2; ++rep) scan_w2(F, Q); SEAM(pb + 5); }
        }
        if (IN(pb + 6)) { WSL; dense_gemm(F, cat, DM, (const bf16_t*)(ws + WS_WOUT) + (size_t)l * DM * DM, DM, NTOK, DM, DM, (bf16_t*)(ws + WS_HB), DM, 0); SEAM(pb + 6); }
        if (IN(pb + 7)) { WSL; ln1_router(F, P, l, l == 0 ? PIN(0) : (const float*)P.out); SEAM(pb + 7); }
        if (IN(pb + 8)) {
            WSL; const int ntiles = moe_table(F, l);
            pg8::Gemm g{xb, (const bf16_t*)(ws + WS_EXP1), DM, DM, DM};
            pg8::MoeOrder<true> S; S.G = F.G; S.c = F.bid; S.npn = 4; S.total = ntiles * 4; S.tb = (const LAS int*)(F.lds + LDS_CTL_OFF) + 16; S.estride = (size_t)1024 * DM * 2;
            S.ltok = (const int*)(ws + WS_LTOK); S.cnt = (const unsigned*)(ws + WS_CTL) + CW_CNT + l * 32 * 64;
            pg8::EpiSwiGLU E{(bf16_t*)(ws + WS_HE)};
            for (int rep = 0; rep < REP_MOE; ++rep) pg8::gemm_phase<pg8::EpiSwiGLU, pg8::MoeOrder<true>>(F.lds, g, S, E);
            SEAM(pb + 8);
        }
        if (IN(pb + 9)) {
            WSL; const int ntiles = moe_table(F, l);
            pg8::Gemm g{(const bf16_t*)(ws + WS_HE), (const bf16_t*)(ws + WS_EXP2), DEXP, DEXP, DEXP};
            pg8::MoeOrder<false> S; S.G = F.G; S.c = F.bid; S.npn = 8; S.total = ntiles * 8; S.tb = (const LAS int*)(F.lds + LDS_CTL_OFF) + 16; S.estride = (size_t)DM * DEXP * 2;
            S.ltok = (const int*)(ws + WS_LTOK); S.cnt = (const unsigned*)(ws + WS_CTL) + CW_CNT + l * 32 * 64;
            pg8::EpiScatter E{(bf16_t*)(ws + WS_YS), (const int*)(ws + WS_LSLOT), (const float*)(ws + WS_LGATE), S.cnt};
            for (int rep = 0; rep < REP_MOE; ++rep) pg8::gemm_phase<pg8::EpiScatter, pg8::MoeOrder<false>>(F.lds, g, S, E);
            SEAM(pb + 9);
        }
        if (IN(pb + 10)) { WSL; ln2_phase(F, P, l); SEAM(pb + 10); }
    }
#ifdef MK_DEBUG
    {
        WSL;
        xcd_barrier(bar);
        dbg_count_bf16(F, (const bf16_t*)(ws + WS_CAT), (size_t)NTOK * DM, 0);
        dbg_count_bf16(F, (const bf16_t*)(ws + WS_HB), (size_t)NTOK * DM, 1);
        dbg_count_f32(F, (const float*)(ws + WS_LGATE), (size_t)32 * 16384, 2);
        dbg_count_bf16(F, (const bf16_t*)(ws + WS_YS), (size_t)32768 * 2048, 3);
        dbg_count_f32(F, (const float*)F.out, (size_t)NTOK * DM, 4);
        dbg_count_bf16(F, (const bf16_t*)(ws + WS_XB), (size_t)NTOK * DM, 5);
        xcd_barrier(bar);
        int first = 13;
        for (int k = 12; k >= 0; --k) if (__hip_atomic_load((unsigned*)(ws + WS_CTL) + CW_DBG + k * 64, __ATOMIC_RELAXED, __HIP_MEMORY_SCOPE_AGENT) != 0u) first = k;
        const float val = 1000.f * (float)(first + 1);
        for (size_t i = (size_t)F.bid * NT + F.tid; i < (size_t)NTOK * DM; i += (size_t)F.G * NT) F.out[i] = val;
    }
#endif
#undef IN
#undef SEAM
}

extern "C" void kernel_launch(void* const* d_in, const int* in_sizes, int n_in, void* d_out, int out_size, void* d_ws, size_t ws_size, hipStream_t stream) {
    static int grid = 0;
    if (grid == 0) {
        if (n_in != 31 || ws_size < WS_END) { fprintf(stderr, "kernel_launch: expected 31 inputs and >= %zu bytes of workspace, got %d / %zu\n", (size_t)WS_END, n_in, ws_size); grid = -1; return; }
        int dev = 0, cus = 0, per_cu = 0;
        if (hipGetDevice(&dev) != hipSuccess || hipDeviceGetAttribute(&cus, hipDeviceAttributeMultiprocessorCount, dev) != hipSuccess) { grid = -1; return; }
        if (hipFuncSetAttribute((const void*)mega_fwd, hipFuncAttributeMaxDynamicSharedMemorySize, LDS_BYTES) != hipSuccess) { fprintf(stderr, "kernel_launch: hipFuncSetAttribute failed\n"); grid = -1; return; }
        if (hipOccupancyMaxActiveBlocksPerMultiprocessor(&per_cu, (const void*)mega_fwd, NT, LDS_BYTES) != hipSuccess || per_cu < 1)
            fprintf(stderr, "kernel_launch: occupancy query reports %d workgroups per CU\n", per_cu);
        (void)hipGetLastError();
        grid = cus;
    }
    if (grid < 0) return;
    (void)hipMemsetAsync((char*)d_ws + WS_CTL, 0, CTL_BYTES, stream);
    Params p{};
    for (int i = 0; i < 31; ++i) p.in[i] = (const float*)d_in[i];
    p.out = (float*)d_out; p.ws = (unsigned char*)d_ws;
#if MK_PER_PHASE
    for (int ph = 0; ph < N_PHASES; ++ph) {
        if (ph > 0) { const int l = (ph - 1) / PH_PER_LAYER, loc = (ph - 1) % PH_PER_LAYER; if ((l % 3) != 0 && loc >= 2 && loc <= 5) continue; }
        p.ph_lo = ph; p.ph_hi = ph + 1;
        hipLaunchKernelGGL(mega_fwd, dim3(grid), dim3(NT), LDS_BYTES, stream, p);
    }
#else
#ifndef MK_PH_HI
#define MK_PH_HI N_PHASES
#endif
    p.ph_lo = 0; p.ph_hi = MK_PH_HI;
    hipLaunchKernelGGL(mega_fwd, dim3(grid), dim3(NT), LDS_BYTES, stream, p);
#endif
    const hipError_t le = hipPeekAtLastError();
    if (le != hipSuccess) fprintf(stderr, "kernel_launch: launch failed: %s\n", hipGetErrorName(le));
}
```

```cpp
#include <hip/hip_runtime.h>
#include <cstdio>
#include <cstdint>

#ifndef MK_PER_PHASE
#define MK_PER_PHASE 0
#endif
#ifndef MK_PH_HI
#define MK_PH_HI N_PHASES
#endif
#ifndef REP_GEMM
#define REP_GEMM 1
#endif
#ifndef REP_MOE
#define REP_MOE 1
#endif
#ifndef REP_SCAN
#define REP_SCAN 1
#endif
#ifndef REP_PREP
#define REP_PREP 1
#endif
#ifndef REP_MIX
#define REP_MIX 1
#endif
#ifndef REP_CONV
#define REP_CONV 1
#endif
#ifndef REP_SB
#define REP_SB 1
#endif
#ifndef REP_MA
#define REP_MA 1
#endif
#ifndef REP_WX
#define REP_WX 1
#endif
#ifndef REP_WS
#define REP_WS 1
#endif
#ifndef REP_WO
#define REP_WO 1
#endif
#ifndef REP_W2
#define REP_W2 1
#endif

#define LAS __attribute__((address_space(3)))
#define GAS __attribute__((address_space(1)))
#define DI __device__ __forceinline__
typedef unsigned short bf16_t;
typedef short bf16x8 __attribute__((ext_vector_type(8)));
typedef short s16x4 __attribute__((ext_vector_type(4)));
typedef float f32x2 __attribute__((ext_vector_type(2)));
typedef float f32x4 __attribute__((ext_vector_type(4)));
typedef float f32x8 __attribute__((ext_vector_type(8)));
typedef float f32x16 __attribute__((ext_vector_type(16)));
typedef unsigned u32x2 __attribute__((ext_vector_type(2)));
typedef unsigned u32x4 __attribute__((ext_vector_type(4)));

constexpr int NTOK = 16384, DM = 2048, SEQ = 4096, NBATCH = 4, CMIX = 1536, MEMW = 512, MEML = 256, NLAYER = 4;
constexpr int ZW_RWKV = 5632  , ZW_OTH = 5120, RW_IN_COLS = 5568;
constexpr int NEXP = 32, DEXP = 512, LISTCAP = 16384, MAXTILES = 160;
constexpr float LN_EPS = 1e-5f, ALPHA = 1.681792830507429f, GN_EPS = 64e-5f;
constexpr int NT = 512, NWAVES = 8;

constexpr size_t MiB = (size_t)1 << 20;
constexpr size_t WS_CTL = 0, CTL_BYTES = 1 * MiB;
constexpr size_t WS_WIN = 2 * MiB;
constexpr size_t WIN_STRIDE = 22 * MiB;
constexpr size_t WS_WOUT = 90 * MiB;
constexpr size_t WS_WK = 122 * MiB;
constexpr size_t WS_WV = 130 * MiB;
constexpr size_t WS_MEMB = 138 * MiB;
constexpr size_t WS_KM = 142 * MiB;
constexpr size_t WS_VMT = 146 * MiB;
constexpr size_t WS_LORA = 150 * MiB;
constexpr size_t LORA_STRIDE = 3 * MiB;
constexpr size_t WS_WSW = 156 * MiB;
constexpr size_t WSW_STRIDE = 393216;
constexpr size_t WS_EXP1 = 160 * MiB;
constexpr size_t WS_EXP2 = 288 * MiB;
constexpr size_t WS_XB = 352 * MiB;
constexpr size_t WS_Z = 416 * MiB;
constexpr size_t WS_CAT = 592 * MiB;
constexpr size_t WS_HB = 656 * MiB;
constexpr size_t WS_LTOK = 720 * MiB;
constexpr size_t WS_LGATE = 722 * MiB;
constexpr size_t WS_LSLOT = 724 * MiB;
constexpr size_t WS_HE = 728 * MiB;
constexpr size_t WS_YS = 768 * MiB;
constexpr size_t WS_ACT = 896 * MiB;
constexpr size_t WS_LW = 944 * MiB;
constexpr size_t WS_GATE = 1040 * MiB;
constexpr size_t WS_SCAN = 1088 * MiB;
constexpr size_t WS_V = 1568 * MiB;
constexpr size_t WS_Y = 1664 * MiB;
constexpr size_t WS_GH = 1760 * MiB;
constexpr size_t WS_QY = 1088 * MiB;
constexpr size_t WS_Y0T = 1152 * MiB;
constexpr size_t WS_E = 1280 * MiB;
constexpr size_t WS_END = 1952 * MiB;
constexpr int CW_BAR = 4096;
constexpr int CW_CNT = 16384;

constexpr int LDS_BYTES = 147456;
constexpr int LDS_CTL_OFF = 146432;

DI float bf2f(unsigned b) { return __uint_as_float(b << 16); }
typedef float cvt_f32x2 __attribute__((ext_vector_type(2)));
typedef __bf16 cvt_bf16x2 __attribute__((ext_vector_type(2)));
DI unsigned cvt_pk_bf16(float lo, float hi) { const cvt_f32x2 v = {lo, hi}; return __builtin_bit_cast(unsigned, __builtin_convertvector(v, cvt_bf16x2)); }
DI float bflo(unsigned w) { return __uint_as_float(w << 16); }
DI float bfhi(unsigned w) { return __uint_as_float(w & 0xffff0000u); }
DI float wave_sum(float v) {
#pragma unroll
    for (int o = 1; o < 64; o <<= 1) v += __shfl_xor(v, o);
    return v;
}
DI float sum16(float v) {
    v += __builtin_bit_cast(float, __builtin_amdgcn_update_dpp(0, __builtin_bit_cast(int, v), 0x128, 0xf, 0xf, false));
    v += __builtin_bit_cast(float, __builtin_amdgcn_update_dpp(0, __builtin_bit_cast(int, v), 0x124, 0xf, 0xf, false));
    v += __builtin_bit_cast(float, __builtin_amdgcn_update_dpp(0, __builtin_bit_cast(int, v), 0x122, 0xf, 0xf, false));
    v += __builtin_bit_cast(float, __builtin_amdgcn_update_dpp(0, __builtin_bit_cast(int, v), 0x121, 0xf, 0xf, false));
    return v;
}
DI float fma_s(float a, float b, float c) { float d; asm("v_fma_f32 %0, %1, %2, %3" : "=v"(d) : "v"(a), "v"(b), "v"(c)); return d; }
DI float sigmoidf_(float x) { return __builtin_amdgcn_rcpf(1.f + __expf(-x)); }
DI float softplusf_(float x) { return fmaxf(x, 0.f) + __logf(1.f + __expf(-fabsf(x))); }
#define LDS_WAIT() asm volatile("s_waitcnt lgkmcnt(0)" ::: "memory")
#define VM_WAIT() asm volatile("s_waitcnt vmcnt(0)" ::: "memory")
#define LDS_BARRIER() do { asm volatile("s_waitcnt lgkmcnt(0)" ::: "memory"); __builtin_amdgcn_s_barrier(); asm volatile("" ::: "memory"); } while (0)

template <class T> DI T* as_global(T* p) { return p; }
DI const float* kin_ptr(int i) { int off = i * 8; asm volatile("" : "+v"(off)); const char* ka = (const char*)__builtin_amdgcn_kernarg_segment_ptr();
    const unsigned long long p = *(const unsigned long long*)(ka + off);
    const unsigned lo = __builtin_amdgcn_readfirstlane((unsigned)p), hi = __builtin_amdgcn_readfirstlane((unsigned)(p >> 32));
    return as_global((const float*)(((unsigned long long)hi << 32) | lo)); }
#define PIN(i) kin_ptr(i)
DI unsigned char* opq(unsigned char* p) { asm volatile("" : "+s"(p)); return p; }
DI float* opqf(float* p) { asm volatile("" : "+s"(p)); return p; }

#define XB_TMO      128
#define XB_XCNT(j)  (256  + 64 * (j))
#define XB_XSUB(j)  (1280 + 64 * (j))
#define XB_XGEN(j)  (2304 + 64 * (j))
#define XB_TOP      3328
#define XB_TOPGEN   3392
#define XCD_BAR_WORDS 3456
#define XB_SPIN_CAP (1u << 20)

__device__ __forceinline__ unsigned xb_ld(unsigned* p)              { return __hip_atomic_load(p, __ATOMIC_RELAXED, __HIP_MEMORY_SCOPE_AGENT); }
__device__ __forceinline__ unsigned xb_add(unsigned* p, unsigned v) { return __hip_atomic_fetch_add(p, v, __ATOMIC_RELAXED, __HIP_MEMORY_SCOPE_AGENT); }
__device__ __forceinline__ unsigned xb_xcc_id() { return (unsigned)__builtin_amdgcn_s_getreg((3 << 11) | 20) & 0xFu; }
#define XB_SPIN(cond, bar) do { unsigned _sp = 0; while (cond) { __builtin_amdgcn_s_sleep(1); \
    if ((++_sp & 255u) == 0u) { if (xb_ld(&(bar)[XB_TMO])) break; if (_sp > XB_SPIN_CAP) { atomicAdd(&(bar)[XB_TMO], 1u); break; } } } } while (0)

struct XcdBarrier { unsigned* bar; unsigned x; volatile LAS unsigned* st; };

__device__ __forceinline__ XcdBarrier xcd_barrier_post(unsigned* bar, volatile LAS unsigned* st) {
    XcdBarrier b; b.bar = bar; b.x = xb_xcc_id(); b.st = st;
    if (threadIdx.x == 0) (void)xb_add(&bar[XB_XCNT(b.x)], 1u);
    return b;
}
__device__ __forceinline__ void xcd_barrier_complete(unsigned* bar, unsigned x, unsigned& nloc, unsigned& nx) {
    const unsigned G = gridDim.x * gridDim.y * gridDim.z;
    unsigned sum, cnt, mine, sp = 0u;
    for (;;) {
        sum = 0u; cnt = 0u; mine = 0u;
#pragma unroll
        for (unsigned j = 0; j < 16; ++j) { const unsigned c = xb_ld(&bar[XB_XCNT(j)]); sum += c; cnt += (c > 0u) ? 1u : 0u; mine = (j == x) ? c : mine; }
        if (sum == G) break;
        __builtin_amdgcn_s_sleep(1);
        if ((++sp & 255u) == 0u) { if (xb_ld(&bar[XB_TMO])) break; if (sp > XB_SPIN_CAP) { atomicAdd(&bar[XB_TMO], 1u); break; } }
    }
    nloc = mine > 0u ? mine : 1u; nx = cnt > 0u ? cnt : 1u;
}
__device__ __forceinline__ void xcd_barrier(const XcdBarrier& b) {
    asm volatile("s_waitcnt vmcnt(0)" ::: "memory");
    __syncthreads();
    if (threadIdx.x == 0) {
        unsigned* bar = b.bar;
        __builtin_amdgcn_s_waitcnt(0);
        unsigned nloc = b.st[0], nx = b.st[1];
        if (nloc == 0u) { xcd_barrier_complete(bar, b.x, nloc, nx); b.st[0] = nloc; b.st[1] = nx; }
        const unsigned old = xb_add(&bar[XB_XSUB(b.x)], 1u);
        const unsigned gen = old / nloc;
        if (old + 1u == (gen + 1u) * nloc) {
            __builtin_amdgcn_fence(__ATOMIC_RELEASE, "agent");
            asm volatile("s_waitcnt vmcnt(0)" ::: "memory");
            const unsigned og = xb_add(&bar[XB_TOP], 1u);
            const unsigned tg = og / nx;
            if (og + 1u == (tg + 1u) * nx) xb_add(&bar[XB_TOPGEN], 1u);
            else XB_SPIN(xb_ld(&bar[XB_TOPGEN]) == tg, bar);
            __builtin_amdgcn_fence(__ATOMIC_ACQUIRE, "agent");
            xb_add(&bar[XB_XGEN(b.x)], 1u);
            asm volatile("s_waitcnt vmcnt(0)" ::: "memory");
        } else {
            XB_SPIN(xb_ld(&bar[XB_XGEN(b.x)]) == gen, bar);
            __builtin_amdgcn_fence(__ATOMIC_ACQUIRE, "agent");
            asm volatile("s_waitcnt vmcnt(0)" ::: "memory");
        }
    }
    __syncthreads();
}

namespace pg8 {
constexpr int BM = 256, BK = 64, HALF = 128, HTB = HALF * BK * 2, STAGE_BYTES = 8 * HTB, NXCD = 8, WGM = 8;
DI int lds_byte(int r, int c) { const int st = (r >> 4) * 2 + (c >> 5), rr = r & 15, cc = c & 31, ob = rr * 64 + cc * 2; return st * 1024 + (ob ^ (((ob >> 9) & 1) << 5)); }
DI void stage_rc(int b, int& R, int& C) { const int st = b / 1024, sb = b % 1024, swz = sb ^ (((sb >> 9) & 1) << 5); R = (st >> 1) * 16 + swz / 64; C = (st & 1) * 32 + (swz % 64) / 2; }
DI int perm32(int rho) { const int n = rho >> 4, i = rho & 15; return 8 * (i >> 2) + 4 * n + (i & 3); }

struct Unit { int pm, pn, e, rt; };
struct Gemm { const bf16_t* A; const bf16_t* Bt; int lda, ldb, K; };

struct StaticOrder {
    static constexpr bool GATHER = false;
    int nM, nN, nwg, G, c;
    DI void init(int M, int N, int G_, int c_) { nM = M / BM; nN = N / BM; nwg = nM * nN; G = G_; c = c_; }
    DI bool next(int i, Unit& u) const {
        const long L = (long)i * G + c; if (L >= nwg) return false;
        int wgid = (int)L; { const int q = nwg / NXCD, r = nwg % NXCD, xcd = wgid % NXCD, off = wgid / NXCD; wgid = (xcd < r ? xcd * (q + 1) : r * (q + 1) + (xcd - r) * q) + off; }
        const int nig = WGM * nN, gid = wgid / nig, fm = gid * WGM, gsz = (nM - fm) < WGM ? (nM - fm) : WGM;
        u.pm = fm + ((wgid % nig) % gsz); u.pn = (wgid % nig) / gsz; u.e = 0; u.rt = 0; return true;
    }
    DI const char* a_base(const Gemm& g, const Unit& u) const { return (const char*)g.A + (size_t)u.pm * BM * g.lda * 2; }
    DI const char* b_base(const Gemm& g, const Unit& u) const { return (const char*)g.Bt + (size_t)u.pn * BM * g.ldb * 2; }
    DI unsigned gather_voff(const Unit&, int, int, int) const { return 0u; }
};

template <bool GATH> struct MoeOrder {
    static constexpr bool GATHER = GATH;
    int G, c, npn, total; const LAS int* tb; size_t estride; const int* ltok; const unsigned* cnt;
    DI bool next(int i, Unit& u) const {
        if ((G & 7) == 0) {
            const int x = c & 7, r = c >> 3, W = G >> 3, idx = i * W + r;
            const int q = idx / npn, pn = idx - q * npn; int base = 0;
#pragma unroll
            for (int k = 0; k < 4; ++k) { const int e = x + 8 * k, nt = tb[e + 1] - tb[e];
                if (q < base + nt) { u.e = e; u.rt = q - base; u.pm = tb[e] + u.rt; u.pn = pn; return true; }
                base += nt; }
            return false;
        }
        const int L = i * G + c; if (L >= total) return false;
        const int q = L / npn; u.pn = L - q * npn; u.pm = q;
        int e = 0; while (e < NEXP - 1 && tb[e + 1] <= q) ++e;
        u.e = e; u.rt = q - tb[e]; return true;
    }
    DI const char* a_base(const Gemm& g, const Unit& u) const { return (const char*)g.A + (size_t)u.pm * BM * g.lda * 2; }
    DI const char* b_base(const Gemm& g, const Unit& u) const { return (const char*)g.Bt + (size_t)u.e * estride + (size_t)u.pn * BM * g.ldb * 2; }
    DI unsigned gather_voff(const Unit& u, int r, int C, int lda) const {
        const int pos = u.rt * BM + r; const int n = (int)__hip_atomic_load(cnt + u.e * 64, __ATOMIC_RELAXED, __HIP_MEMORY_SCOPE_AGENT);
        const int tok = pos < n ? ltok[u.e * LISTCAP + pos] : 0;
        return (unsigned)(tok * lda + C) * 2u;
    }
};

struct EpiStore {
    bf16_t* O; int ldc;
    DI void operator()(const f32x4 (&acc)[2][2][4][2], const Unit& u, int wr, int wc, int fr, int fq) const {
        const int row0 = u.pm * BM + wr * 64 + fr, col0 = u.pn * BM + wc * 32 + 8 * fq;
#pragma unroll
        for (int ai = 0; ai < 2; ++ai)
#pragma unroll
            for (int m = 0; m < 4; ++m) { bf16_t* rowp = O + (size_t)(row0 + ai * HALF + m * 16) * ldc + col0;
#pragma unroll
                for (int bj = 0; bj < 2; ++bj) { const f32x4 v0 = acc[ai][bj][m][0], v1 = acc[ai][bj][m][1];
                    u32x4 w; w.x = cvt_pk_bf16(v0[0], v0[1]); w.y = cvt_pk_bf16(v0[2], v0[3]); w.z = cvt_pk_bf16(v1[0], v1[1]); w.w = cvt_pk_bf16(v1[2], v1[3]);
                    *(GAS u32x4*)(rowp + bj * HALF) = w; } }
    }
};
struct EpiSwiGLU {
    bf16_t* H;
    DI void operator()(const f32x4 (&acc)[2][2][4][2], const Unit& u, int wr, int wc, int fr, int fq) const {
        const int row0 = u.pm * BM + wr * 64 + fr, col0 = u.pn * HALF + wc * 32 + 8 * fq;
#pragma unroll
        for (int ai = 0; ai < 2; ++ai)
#pragma unroll
            for (int m = 0; m < 4; ++m) { bf16_t* rowp = H + (size_t)(row0 + ai * HALF + m * 16) * DEXP + col0;
                float h[8];
#pragma unroll
                for (int n = 0; n < 2; ++n)
#pragma unroll
                    for (int j = 0; j < 4; ++j) { const float gt = acc[ai][0][m][n][j], up = acc[ai][1][m][n][j]; h[n * 4 + j] = gt * __builtin_amdgcn_rcpf(1.f + __expf(-gt)) * up; }
                u32x4 w; w.x = cvt_pk_bf16(h[0], h[1]); w.y = cvt_pk_bf16(h[2], h[3]); w.z = cvt_pk_bf16(h[4], h[5]); w.w = cvt_pk_bf16(h[6], h[7]);
                *(GAS u32x4*)rowp = w; }
    }
};
struct EpiScatter {
    bf16_t* YS; const int* lslot; const float* lgate; const unsigned* cnt;
    DI void operator()(const f32x4 (&acc)[2][2][4][2], const Unit& u, int wr, int wc, int fr, int fq) const {
        const int n = (int)__hip_atomic_load(cnt + u.e * 64, __ATOMIC_RELAXED, __HIP_MEMORY_SCOPE_AGENT);
        const int col0 = u.pn * BM + wc * 32 + 8 * fq;
#pragma unroll
        for (int ai = 0; ai < 2; ++ai)
#pragma unroll
            for (int m = 0; m < 4; ++m) { const int pos = u.rt * BM + ai * HALF + wr * 64 + m * 16 + fr;
                if (pos < n) { const int slot = lslot[u.e * LISTCAP + pos]; const float gt = lgate[u.e * LISTCAP + pos];
                    bf16_t* rowp = YS + (size_t)slot * DM + col0;
#pragma unroll
                    for (int bj = 0; bj < 2; ++bj) { const f32x4 v0 = acc[ai][bj][m][0] * gt, v1 = acc[ai][bj][m][1] * gt;
                        u32x4 w; w.x = cvt_pk_bf16(v0[0], v0[1]); w.y = cvt_pk_bf16(v0[2], v0[3]); w.z = cvt_pk_bf16(v1[0], v1[1]); w.w = cvt_pk_bf16(v1[2], v1[3]);
                        *(GAS u32x4*)(rowp + bj * HALF) = w; } } }
    }
};

template <class Epi, class Sched>
DI void gemm_phase(LAS unsigned char* lds, const Gemm g, const Sched& S, const Epi& E) {
    int tid = threadIdx.x; asm volatile("" : "+v"(tid));
    const int wid = __builtin_amdgcn_readfirstlane(tid >> 6), lane = tid & 63, wr = wid >> 2, wc = wid & 3, fr = lane & 15, fq = lane >> 4;
    const int K = g.K, nt = K / BK;
    unsigned voffA[2], voffB[2];
#pragma unroll
    for (int i = 0; i < 2; ++i) { int R, C; stage_rc(tid * 16 + i * 8192, R, C); const int Rb = (R & ~31) + perm32(R & 31);
        voffA[i] = (unsigned)(R * g.lda + C) * 2u; voffB[i] = (unsigned)(Rb * g.ldb + C) * 2u; }
    const size_t kstep = (size_t)(BK * 2);
    const size_t hstepA = (size_t)HALF * g.lda * 2, hstepB = (size_t)HALF * g.ldb * 2;
    const unsigned ldsw = (unsigned)wid * 1024u;
    const int aoff = lds_byte(wr * 64 + fr, fq * 8), boff = lds_byte(wc * 32 + fr, fq * 8);
    unsigned gvC[2][2], gvN[2][2];
#define PG8_SA(b, h) (((b) * 2 + (h)) * HTB)
#define PG8_SB(b, h) ((4 + (b) * 2 + (h)) * HTB)
#define PG8_STAGE(bufoff, gbase, voff) do { _Pragma("unroll") for (int _i = 0; _i < 2; ++_i) \
        __builtin_amdgcn_global_load_lds((const unsigned*)((const char*)(gbase) + (voff)[_i]), (LAS unsigned*)(lds + (bufoff) + ldsw + _i * 8192), 16, 0, 0); } while (0)
#define PG8_STAGE_A(bufoff, h, nxtsel, kt) do { \
        if constexpr (Sched::GATHER) { const char* _gb = (const char*)g.A + (size_t)(kt) * kstep; unsigned _vo[2]; _vo[0] = (nxtsel) ? gvN[h][0] : gvC[h][0]; _vo[1] = (nxtsel) ? gvN[h][1] : gvC[h][1]; PG8_STAGE(bufoff, _gb, _vo); } \
        else { const char* _gb = ((nxtsel) ? nA : cA) + (size_t)(h) * hstepA + (size_t)(kt) * kstep; PG8_STAGE(bufoff, _gb, voffA); } } while (0)
#define PG8_GSETUP(dst, u) do { if constexpr (Sched::GATHER) { _Pragma("unroll") for (int _h = 0; _h < 2; ++_h) _Pragma("unroll") for (int _i = 0; _i < 2; ++_i) { int _R, _C; stage_rc(tid * 16 + _i * 8192, _R, _C); \
        dst[_h][_i] = S.gather_voff(u, _h * HALF + _R, _C, g.lda); } asm volatile("s_waitcnt vmcnt(0)" : "+v"(dst[0][0]), "+v"(dst[0][1]), "+v"(dst[1][0]), "+v"(dst[1][1]) :: "memory"); } } while (0)
#define PG8_LDA(dst, b, h) do { _Pragma("unroll") for (int m = 0; m < 4; ++m) _Pragma("unroll") for (int k = 0; k < 2; ++k) dst[m][k] = *(const LAS bf16x8*)(lds + PG8_SA(b, h) + aoff + m * 2048 + k * 1024); } while (0)
#define PG8_LDB(dst, b, h) do { _Pragma("unroll") for (int n = 0; n < 2; ++n) _Pragma("unroll") for (int k = 0; k < 2; ++k) dst[n][k] = *(const LAS bf16x8*)(lds + PG8_SB(b, h) + boff + n * 2048 + k * 1024); } while (0)
#define PG8_MMA(ai, bj, At, Bt) do { __builtin_amdgcn_s_setprio(1); _Pragma("unroll") for (int m = 0; m < 4; ++m) _Pragma("unroll") for (int n = 0; n < 2; ++n) _Pragma("unroll") for (int k = 0; k < 2; ++k) \
        acc[ai][bj][m][n] = __builtin_amdgcn_mfma_f32_16x16x32_bf16(Bt[n][k], At[m][k], acc[ai][bj][m][n], 0, 0, 0); __builtin_amdgcn_s_setprio(0); } while (0)
#define PG8_WAIT_V(n) asm volatile("s_waitcnt vmcnt(" #n ")" ::: "memory")
#define PG8_WAIT_L(n) asm volatile("s_waitcnt lgkmcnt(" #n ")" ::: "memory")
#define PG8_BAR __builtin_amdgcn_s_barrier()
#define PG8_SCHED __builtin_amdgcn_sched_barrier(0)
    Unit cur, nxt; int ui = 0;
    if (!S.next(0, cur)) return;
    f32x4 acc[2][2][4][2];
#pragma unroll
    for (int a = 0; a < 2; ++a)
#pragma unroll
        for (int b = 0; b < 2; ++b)
#pragma unroll
            for (int m = 0; m < 4; ++m)
#pragma unroll
                for (int n = 0; n < 2; ++n) acc[a][b][m][n] = (f32x4){0.f, 0.f, 0.f, 0.f};
    bf16x8 At[4][2], B0[2][2], B1[2][2];
    const char* cA = S.a_base(g, cur); const char* cB = S.b_base(g, cur);
    const char* nA = cA;
    PG8_GSETUP(gvC, cur);
    PG8_STAGE(PG8_SB(0, 0), cB, voffB); PG8_STAGE_A(PG8_SA(0, 0), 0, false, 0); PG8_STAGE(PG8_SB(0, 1), cB + hstepB, voffB); PG8_STAGE_A(PG8_SA(0, 1), 1, false, 0);
    if (wr == 1) PG8_BAR;
    PG8_WAIT_V(4); PG8_BAR;
    PG8_STAGE(PG8_SB(1, 0), cB + kstep, voffB); PG8_STAGE_A(PG8_SA(1, 0), 0, false, 1); PG8_STAGE(PG8_SB(1, 1), cB + hstepB + kstep, voffB);
    PG8_WAIT_V(6); PG8_BAR;
    for (;;) {
        const bool has_next = S.next(ui + 1, nxt);
        nA = has_next ? S.a_base(g, nxt) : cA; const char* nB = has_next ? S.b_base(g, nxt) : cB;
        if constexpr (Sched::GATHER) { if (has_next) { PG8_GSETUP(gvN, nxt); } else {
#pragma unroll
            for (int _h = 0; _h < 2; ++_h) { gvN[_h][0] = gvC[_h][0]; gvN[_h][1] = gvC[_h][1]; } } }
        for (int t = 0; t < nt; t += 2) {
            const bool last = (t == nt - 2);
            const int kt2 = last ? 0 : t + 2;
            const char* b2 = last ? nB : cB + (size_t)(t + 2) * kstep;
            const char* b3 = b2 + kstep;
            PG8_LDB(B0, 0, 0); PG8_SCHED; PG8_LDA(At, 0, 0); PG8_STAGE_A(PG8_SA(1, 1), 1, false, t + 1);
            PG8_WAIT_L(8); PG8_BAR; PG8_WAIT_L(0); PG8_MMA(0, 0, At, B0); PG8_BAR; PG8_SCHED;
            PG8_LDB(B1, 0, 1); PG8_STAGE(PG8_SB(0, 0), b2, voffB);
            PG8_BAR; PG8_WAIT_L(0); PG8_MMA(0, 1, At, B1); PG8_BAR;
            PG8_LDA(At, 0, 1); PG8_STAGE_A(PG8_SA(0, 0), 0, last, kt2);
            PG8_BAR; PG8_WAIT_L(0); PG8_MMA(1, 0, At, B0); PG8_BAR; PG8_SCHED;
            PG8_STAGE(PG8_SB(0, 1), b2 + hstepB, voffB);
            PG8_WAIT_V(6); PG8_BAR; PG8_MMA(1, 1, At, B1); PG8_BAR;
            PG8_LDB(B0, 1, 0); PG8_SCHED; PG8_LDA(At, 1, 0); PG8_STAGE_A(PG8_SA(0, 1), 1, last, kt2);
            PG8_WAIT_L(8); PG8_BAR; PG8_WAIT_L(0); PG8_MMA(0, 0, At, B0); PG8_BAR; PG8_SCHED;
            PG8_LDB(B1, 1, 1); PG8_STAGE(PG8_SB(1, 0), b3, voffB);
            PG8_BAR; PG8_WAIT_L(0); PG8_MMA(0, 1, At, B1); PG8_BAR;
            PG8_LDA(At, 1, 1); PG8_STAGE_A(PG8_SA(1, 0), 0, last, kt2 + 1);
            PG8_BAR; PG8_WAIT_L(0); PG8_MMA(1, 0, At, B0); PG8_BAR; PG8_SCHED;
            PG8_STAGE(PG8_SB(1, 1), b3 + hstepB, voffB);
            PG8_WAIT_V(6); PG8_BAR; PG8_MMA(1, 1, At, B1); PG8_BAR;
        }
        E(acc, cur, wr, wc, fr, fq);
        if (!has_next) break;
#pragma unroll
        for (int a = 0; a < 2; ++a)
#pragma unroll
            for (int b = 0; b < 2; ++b)
#pragma unroll
                for (int m = 0; m < 4; ++m)
#pragma unroll
                    for (int n = 0; n < 2; ++n) acc[a][b][m][n] = (f32x4){0.f, 0.f, 0.f, 0.f};
        cur = nxt; cA = nA; cB = nB; ++ui;
        if constexpr (Sched::GATHER) {
#pragma unroll
            for (int _h = 0; _h < 2; ++_h) { gvC[_h][0] = gvN[_h][0]; gvC[_h][1] = gvN[_h][1]; } }
    }
    PG8_WAIT_V(0);
    if (wr == 0) PG8_BAR;
    PG8_BAR;
#undef PG8_SA
#undef PG8_SB
#undef PG8_STAGE
#undef PG8_STAGE_A
#undef PG8_GSETUP
#undef PG8_LDA
#undef PG8_LDB
#undef PG8_MMA
#undef PG8_WAIT_V
#undef PG8_WAIT_L
#undef PG8_BAR
#undef PG8_SCHED
}
}

struct Params { const float* in[31]; float* out; unsigned char* ws; int ph_lo, ph_hi; };

struct Ctx {
    LAS unsigned char* lds;
    int tid, lane, wave, G, bid, gw, ngw;
    unsigned char* ws; float* out;
};
DI Ctx relaunder(const Ctx& F0) {
    Ctx F = F0;
    asm volatile("" : "+v"(F.tid), "+v"(F.lane));
    asm volatile("" : "+s"(F.wave), "+s"(F.G), "+s"(F.bid), "+s"(F.gw), "+s"(F.ngw));
    asm volatile("" : "+s"(F.ws), "+s"(F.out));
    F.ws = as_global(F.ws); F.out = as_global(F.out);
    return F;
}

DI void dense_gemm(const Ctx& F, const bf16_t* A, int lda, const bf16_t* Bt, int ldb, int M, int N, int K, bf16_t* O, int ldc, int crot) {
    pg8::Gemm g{A, Bt, lda, ldb, K}; pg8::StaticOrder S; S.init(M, N, F.G, (F.bid + crot) % F.G);
    pg8::EpiStore E{O, ldc};
    for (int rep = 0; rep < REP_GEMM; ++rep) pg8::gemm_phase<pg8::EpiStore, pg8::StaticOrder>(F.lds, g, S, E);
}

struct TJob { const float* src; bf16_t* dst; int ldw, dld; };
DI void tr_load(const TJob& j, f32x4 (&r)[16], int lane) {
    const GAS float* p = (const GAS float*)(j.src + (size_t)(lane >> 4) * j.ldw + 4 * (lane & 15));
#pragma unroll
    for (int i = 0; i < 16; ++i) r[i] = *(const GAS f32x4*)(p + (size_t)(4 * i) * j.ldw);
}
DI void tr_store(const TJob& j, const f32x4 (&r)[16], LAS unsigned char* scr, int lane) {
#pragma unroll
    for (int i = 0; i < 16; ++i) { LAS unsigned* w = (LAS unsigned*)(scr + ((lane >> 4) + 4 * i) * 132 + (lane & 15) * 8); w[0] = cvt_pk_bf16(r[i].x, r[i].y); w[1] = cvt_pk_bf16(r[i].z, r[i].w); }
    LDS_WAIT();
    const int kc = lane & 7;
#pragma unroll
    for (int sgrp = 0; sgrp < 8; ++sgrp) { const int n = 8 * sgrp + (lane >> 3); const LAS unsigned short* c = (const LAS unsigned short*)(scr + (8 * kc) * 132 + n * 2);
        u32x4 o; o.x = (unsigned)c[0] | ((unsigned)c[66] << 16); o.y = (unsigned)c[2 * 66] | ((unsigned)c[3 * 66] << 16); o.z = (unsigned)c[4 * 66] | ((unsigned)c[5 * 66] << 16); o.w = (unsigned)c[6 * 66] | ((unsigned)c[7 * 66] << 16);
        *(GAS u32x4*)(j.dst + (size_t)n * j.dld + 8 * kc) = o; }
    LDS_WAIT();
}
template <class Dec> DI void tr_run(const Dec& D, int first, int count, int stride, LAS unsigned char* scr, int lane) {
    f32x4 A[16], B[16]; TJob ja, jb;
    int it = first; if (it >= count) return;
    ja = D(it); tr_load(ja, A, lane);
    for (;;) {
        const int it2 = it + stride; const bool h2 = it2 < count; if (h2) { jb = D(it2); tr_load(jb, B, lane); }
        tr_store(ja, A, scr, lane);
        if (!h2) break;
        const int it3 = it2 + stride; const bool h3 = it3 < count; if (h3) { ja = D(it3); tr_load(ja, A, lane); }
        tr_store(jb, B, scr, lane);
        if (!h3) break;
        it = it3;
    }
}
DI TJob mat_job(const float* W, int K, int N, bf16_t* WT, int item) {
    const int nblk = N / 64, kb = item / nblk, nb = item - kb * nblk;
    TJob j; j.src = W + (size_t)(64 * kb) * N + 64 * nb; j.dst = WT + (size_t)(64 * nb) * K + 64 * kb; j.ldw = N; j.dld = K; return j;
}
DI void row_to_bf16(const float* src, bf16_t* dst, int lane) {
    const GAS f32x4* s = (const GAS f32x4*)src + lane; GAS u32x2* o = (GAS u32x2*)dst + lane;
#pragma unroll
    for (int j = 0; j < 8; ++j) { const f32x4 v = s[64 * j]; u32x2 w; w.x = cvt_pk_bf16(v.x, v.y); w.y = cvt_pk_bf16(v.z, v.w); o[64 * j] = w; }
}

DI void phase_prologue(const Ctx& F, const Params& P) {
    unsigned char* const wsl = F.ws; float* const outl = F.out; (void)outl;
    LAS unsigned char* scr = F.lds + F.wave * 16384;
    unsigned char* ws = wsl;
    constexpr int I_RW = 32 * (RW_IN_COLS / 64), I_OT = 32 * (ZW_OTH / 64), I_WO = 32 * 32, I_KV = 32 * 8;
    constexpr int N_A = 2 * I_RW + 2 * I_OT, N_B = 4 * I_WO, N_C = 8 * I_KV, N_D = NTOK + NBATCH * MEML;
    struct ProDec { unsigned char* ws;
        DI TJob operator()(int it) const { int r = it;
            if (r < N_A) {
                if (r < I_RW) return mat_job(PIN(16), DM, RW_IN_COLS, (bf16_t*)(ws + WS_WIN), r); r -= I_RW;
                if (r < I_OT) return mat_job(PIN(28), DM, ZW_OTH, (bf16_t*)(ws + WS_WIN + WIN_STRIDE), r); r -= I_OT;
                if (r < I_OT) return mat_job(PIN(30), DM, ZW_OTH, (bf16_t*)(ws + WS_WIN + 2 * WIN_STRIDE), r); r -= I_OT;
                return mat_job(PIN(16) + (size_t)DM * RW_IN_COLS, DM, RW_IN_COLS, (bf16_t*)(ws + WS_WIN + 3 * WIN_STRIDE), r);
            }
            r -= N_A;
            if (r < N_B) { const int l = r / I_WO; return mat_job(PIN(2) + (size_t)l * DM * DM, DM, DM, (bf16_t*)(ws + WS_WOUT) + (size_t)l * DM * DM, r - l * I_WO); }
            r -= N_B;
            const int m = r / I_KV, l = m & 3; const bool isv = m >= 4;
            return mat_job(PIN(isv ? 4 : 3) + (size_t)l * DM * MEMW, DM, MEMW, (bf16_t*)(ws + (isv ? WS_WV : WS_WK)) + (size_t)l * MEMW * DM, r - m * I_KV);
        } };
    ProDec PD{ws};
    tr_run(PD, F.gw, N_A + N_B + N_C, F.ngw, scr, F.lane);
    for (int r = F.gw; r < N_D; r += F.ngw) {
        if (r < NTOK) row_to_bf16(PIN(0) + (size_t)r * DM, (bf16_t*)(ws + WS_XB) + (size_t)r * DM, F.lane);
        else row_to_bf16(PIN(1) + (size_t)(r - NTOK) * DM, (bf16_t*)(ws + WS_MEMB) + (size_t)(r - NTOK) * DM, F.lane);
    }
    const int gt = F.bid * NT + F.tid, ngt = F.G * NT;
    for (int idx = gt; idx < 2 * (3072 + 1536) * 256; idx += ngt) {
        const int j = idx / ((3072 + 1536) * 256); int r = idx - j * (3072 + 1536) * 256;
        bf16_t* base = (bf16_t*)(ws + WS_LORA + (size_t)j * LORA_STRIDE);
        const int n = r >> 8, k = r & 255; float v = 0.f;
        if (n < 1536) { if (k < 96) v = PIN(19)[((size_t)j * 96 + k) * CMIX + n]; }
        else if (n < 3072) { if (k >= 96 && k < 192) v = PIN(21)[((size_t)j * 96 + (k - 96)) * CMIX + (n - 1536)]; }
        else v = PIN(22)[((size_t)j * 256 + k) * CMIX + (n - 3072)];
        base[r] = (bf16_t)(cvt_pk_bf16(v, 0.f) & 0xffffu);
    }
    for (int idx = gt; idx < 2 * 64 * DM; idx += ngt) { const int j = idx / (64 * DM), r = idx - j * 64 * DM;
        ((bf16_t*)(ws + WS_WIN + (size_t)(j ? 3 : 0) * WIN_STRIDE))[(size_t)RW_IN_COLS * DM + r] = 0; }
    for (int idx = gt; idx < NLAYER * 48 * DM; idx += ngt) {
        const int l = idx / (48 * DM); int r = idx - l * 48 * DM; const int n = r / DM, k = r - n * DM;
        float v = 0.f;
        if (n < 4) v = PIN(9)[((size_t)l * DM + k) * 4 + n]; else if (n < 36) v = PIN(11)[((size_t)l * DM + k) * 32 + (n - 4)];
        const unsigned hi = cvt_pk_bf16(v, 0.f) & 0xffffu; const float rem = v - bf2f(hi); const unsigned lo = cvt_pk_bf16(rem, 0.f) & 0xffffu;
        bf16_t* base = (bf16_t*)(ws + WS_WSW + (size_t)l * WSW_STRIDE);
        base[r] = (bf16_t)hi; base[48 * DM + r] = (bf16_t)lo;
    }
}

DI void expert_convert(const Ctx& F, const Params& P, int l, int w, int nw) {
    unsigned char* const wsl = F.ws;
    LAS unsigned char* scr = F.lds + F.wave * 16384;
    constexpr int I_GU = NEXP * 32 * 8 * 2, I_DN = NEXP * 8 * 32;
    struct ExpDec { unsigned char* ws; int l;
        DI TJob operator()(int it) const { TJob j;
            if (it < I_GU) {
                const int isup = it / (I_GU / 2); int r = it - isup * (I_GU / 2);
                const int e = r / 256; r -= e * 256; const int kb = r >> 3, nb = r & 7;
                const float* W = PIN(isup ? 14 : 13) + ((size_t)l * NEXP + e) * DM * DEXP;
                const int n0 = 64 * nb, drow = 256 * (n0 >> 7) + (isup ? 128 : 0) + (n0 & 127);
                j.src = W + (size_t)(64 * kb) * DEXP + n0; j.ldw = DEXP; j.dst = (bf16_t*)(ws + WS_EXP1) + ((size_t)e * 1024 + drow) * DM + 64 * kb; j.dld = DM;
            } else {
                int r = it - I_GU; const int e = r / 256; r -= e * 256; const int kb = r >> 5, nb = r & 31;
                const float* W = PIN(15) + ((size_t)l * NEXP + e) * DEXP * DM;
                j.src = W + (size_t)(64 * kb) * DM + 64 * nb; j.ldw = DM; j.dst = (bf16_t*)(ws + WS_EXP2) + ((size_t)e * DM + 64 * nb) * DEXP + 64 * kb; j.dld = DEXP;
            }
            return j; } };
    ExpDec ED{wsl, l};
    tr_run(ED, w, I_GU + I_DN, nw, scr, F.lane);
}

DI void memattn_unit(const Ctx& F, int l, int unit, const bf16_t* z, int zw, int qcol) {
    unsigned char* const wsl = F.ws; float* const outl = F.out; (void)outl;
    const int b = unit >> 6, head = (unit >> 4) & 3, qblk = unit & 15;
    LAS unsigned char* Ks = F.lds; LAS unsigned char* Vs = F.lds + 69632;
    const bf16_t* Km = (const bf16_t*)(wsl + WS_KM); const bf16_t* VmT = (const bf16_t*)(wsl + WS_VMT);
    bf16_t* cat = (bf16_t*)(wsl + WS_CAT);
    __syncthreads();
#pragma unroll
    for (int i = 0; i < 8; ++i) { const int ch = F.tid + NT * i;
        { const int row = ch >> 4, c16 = ch & 15; const u32x4 v = *(const u32x4*)(Km + (size_t)(b * MEML + row) * 2048 + l * 512 + head * 128 + c16 * 8); *(LAS u32x4*)(Ks + row * 272 + c16 * 16) = v; }
        { const int d = ch >> 5, c = ch & 31; const u32x4 v = *(const u32x4*)(VmT + (size_t)(l * 512 + head * 128 + d) * 1024 + b * MEML + c * 8); *(LAS u32x4*)(Vs + d * 528 + c * 16) = v; } }
    __syncthreads();
    const int lane = F.lane, fr = lane & 15, fq = lane >> 4;
    for (int itq = 0; itq < 2; ++itq) {
        const int q0 = qblk * 256 + itq * 128 + F.wave * 16, tok0 = b * SEQ + q0;
        bf16x8 Qf[4];
#pragma unroll
        for (int ks = 0; ks < 4; ++ks) Qf[ks] = *(const bf16x8*)(z + (size_t)(tok0 + fr) * zw + qcol + head * 128 + ks * 32 + fq * 8);
        f32x4 acc[16];
#pragma unroll
        for (int t = 0; t < 16; ++t) { acc[t] = (f32x4){0.f, 0.f, 0.f, 0.f};
#pragma unroll
            for (int ks = 0; ks < 4; ++ks) { const bf16x8 kf = *(const LAS bf16x8*)(Ks + (16 * t + fr) * 272 + ks * 64 + fq * 16);
                acc[t] = __builtin_amdgcn_mfma_f32_16x16x32_bf16(kf, Qf[ks], acc[t], 0, 0, 0); } }
        const float sc = 0.08838834764831845f;
        float mx = -3.0e38f;
#pragma unroll
        for (int t = 0; t < 16; ++t)
#pragma unroll
            for (int j = 0; j < 4; ++j) { acc[t][j] *= sc; mx = fmaxf(mx, acc[t][j]); }
        mx = fmaxf(mx, __shfl_xor(mx, 16)); mx = fmaxf(mx, __shfl_xor(mx, 32));
        float sum = 0.f;
#pragma unroll
        for (int t = 0; t < 16; ++t)
#pragma unroll
            for (int j = 0; j < 4; ++j) { acc[t][j] = __expf(acc[t][j] - mx); sum += acc[t][j]; }
        sum += __shfl_xor(sum, 16); sum += __shfl_xor(sum, 32);
        const float inv = 1.f / sum;
        f32x4 o[8];
#pragma unroll
        for (int dt = 0; dt < 8; ++dt) o[dt] = (f32x4){0.f, 0.f, 0.f, 0.f};
#pragma unroll
        for (int s = 0; s < 8; ++s) {
            u32x4 pw; pw.x = cvt_pk_bf16(acc[2 * s][0], acc[2 * s][1]); pw.y = cvt_pk_bf16(acc[2 * s][2], acc[2 * s][3]);
            pw.z = cvt_pk_bf16(acc[2 * s + 1][0], acc[2 * s + 1][1]); pw.w = cvt_pk_bf16(acc[2 * s + 1][2], acc[2 * s + 1][3]);
            const bf16x8 pf = __builtin_bit_cast(bf16x8, pw);
#pragma unroll
            for (int dt = 0; dt < 8; ++dt) {
                const u32x2 v0 = *(const LAS u32x2*)(Vs + (16 * dt + fr) * 528 + (32 * s + 4 * fq) * 2);
                const u32x2 v1 = *(const LAS u32x2*)(Vs + (16 * dt + fr) * 528 + (32 * s + 16 + 4 * fq) * 2);
                u32x4 vw; vw.x = v0.x; vw.y = v0.y; vw.z = v1.x; vw.w = v1.y;
                o[dt] = __builtin_amdgcn_mfma_f32_16x16x32_bf16(__builtin_bit_cast(bf16x8, vw), pf, o[dt], 0, 0, 0);
            }
        }
        bf16_t* orow = cat + (size_t)(tok0 + fr) * DM + CMIX + head * 128 + 4 * fq;
#pragma unroll
        for (int dt = 0; dt < 8; ++dt) { u32x2 w; w.x = cvt_pk_bf16(o[dt][0] * inv, o[dt][1] * inv); w.y = cvt_pk_bf16(o[dt][2] * inv, o[dt][3] * inv); *(u32x2*)(orow + 16 * dt) = w; }
    }
}
DI void memattn_all(const Ctx& F, int l, const bf16_t* z, int zw, int qcol) {
    for (int u = F.bid; u < 256; u += F.G) memattn_unit(F, l, u, z, zw, qcol);
    __syncthreads();
}

DI void conv_mix(const Ctx& F, const Params& P, const bf16_t* z) {
    unsigned char* const wsl = F.ws; float* const outl = F.out; (void)outl;
    const float* cw = PIN(29);
    bf16_t* cat = (bf16_t*)(wsl + WS_CAT);
    const int gt = F.bid * NT + F.tid, ngt = F.G * NT;
    for (int idx = gt; idx < NTOK * 192; idx += ngt) {
        const int tok = idx / 192, c8 = idx - tok * 192, c = c8 * 8, t = tok & (SEQ - 1);
        const bf16_t* zr = z + (size_t)tok * ZW_OTH;
        const u32x4 bg = *(const u32x4*)(zr + c);
        float y[8];
#pragma unroll
        for (int j = 0; j < 8; ++j) y[j] = 0.f;
#pragma unroll
        for (int dt = 0; dt < 3; ++dt) {
            if (t - dt >= 0) {
                const u32x4 cg = *(const u32x4*)(zr - (size_t)dt * ZW_OTH + CMIX + c), hh = *(const u32x4*)(zr - (size_t)dt * ZW_OTH + 2 * CMIX + c);
                const f32x4 w0 = *(const f32x4*)(cw + (2 - dt) * CMIX + c), w1 = *(const f32x4*)(cw + (2 - dt) * CMIX + c + 4);
                y[0] += w0.x * bflo(cg.x) * bflo(hh.x); y[1] += w0.y * bfhi(cg.x) * bfhi(hh.x); y[2] += w0.z * bflo(cg.y) * bflo(hh.y); y[3] += w0.w * bfhi(cg.y) * bfhi(hh.y);
                y[4] += w1.x * bflo(cg.z) * bflo(hh.z); y[5] += w1.y * bfhi(cg.z) * bfhi(hh.z); y[6] += w1.z * bflo(cg.w) * bflo(hh.w); y[7] += w1.w * bfhi(cg.w) * bfhi(hh.w);
            }
        }
        u32x4 o; o.x = cvt_pk_bf16(bflo(bg.x) * y[0], bfhi(bg.x) * y[1]); o.y = cvt_pk_bf16(bflo(bg.y) * y[2], bfhi(bg.y) * y[3]);
        o.z = cvt_pk_bf16(bflo(bg.z) * y[4], bfhi(bg.z) * y[5]); o.w = cvt_pk_bf16(bflo(bg.w) * y[6], bfhi(bg.w) * y[7]);
        *(u32x4*)(cat + (size_t)tok * DM + c) = o;
    }
}

DI void sb_attention(const Ctx& F, const bf16_t* z) {
    unsigned char* const wsl = F.ws;
    const bf16_t* VT = (const bf16_t*)(wsl + WS_ACT);
    bf16_t* cat = (bf16_t*)(wsl + WS_CAT);
    LAS unsigned char* Ks = F.lds; LAS unsigned char* Vs = F.lds + 69632;
    const int lane = F.lane, fr = lane & 15, fq = lane >> 4;
    const float sc = 0.08838834764831845f;
    for (int u = F.bid; u < NBATCH * 12 * 32; u += F.G) {
        const int b = u / (12 * 32); int r = u - b * 12 * 32; const int head = r >> 5, qblk = r & 31;
        const int t0 = qblk * 128, kw0 = t0 - 128;
        __syncthreads();
#pragma unroll
        for (int i = 0; i < 8; ++i) { const int ch = F.tid + NT * i;
            { const int row = ch >> 4, c16 = ch & 15, key = kw0 + row;
              if (key >= 0) { const u32x4 v = *(const u32x4*)(z + (size_t)(b * SEQ + key) * ZW_OTH + CMIX + head * 128 + c16 * 8); *(LAS u32x4*)(Ks + row * 272 + c16 * 16) = v; } }
            { const int d = ch >> 5, c = ch & 31;
              if (kw0 + c * 8 >= 0) { const u32x4 v = *(const u32x4*)(VT + (size_t)(head * 128 + d) * NTOK + b * SEQ + kw0 + c * 8); *(LAS u32x4*)(Vs + d * 528 + c * 16) = v; } } }
        __syncthreads();
        const int tq0 = t0 + F.wave * 16, tq = tq0 + fr;
        bf16x8 Qf[4];
#pragma unroll
        for (int ks = 0; ks < 4; ++ks) Qf[ks] = *(const bf16x8*)(z + (size_t)(b * SEQ + tq) * ZW_OTH + head * 128 + ks * 32 + fq * 8);
        f32x4 o[8];
#pragma unroll
        for (int dt = 0; dt < 8; ++dt) o[dt] = (f32x4){0.f, 0.f, 0.f, 0.f};
        float R = 0.f;
        for (int kt = (tq0 + 14) >> 5; kt >= 0; --kt) {
            const int lk = 32 * kt - kw0;
            bf16x8 Kf[2][4]; u32x2 V0[8], V1[8];
            if (lk >= 0) {
#pragma unroll
                for (int tl = 0; tl < 2; ++tl)
#pragma unroll
                    for (int ks = 0; ks < 4; ++ks) Kf[tl][ks] = *(const LAS bf16x8*)(Ks + (lk + 16 * tl + fr) * 272 + ks * 64 + fq * 16);
#pragma unroll
                for (int dt = 0; dt < 8; ++dt) { V0[dt] = *(const LAS u32x2*)(Vs + (16 * dt + fr) * 528 + (lk + 4 * fq) * 2); V1[dt] = *(const LAS u32x2*)(Vs + (16 * dt + fr) * 528 + (lk + 16 + 4 * fq) * 2); }
            } else {
#pragma unroll
                for (int tl = 0; tl < 2; ++tl)
#pragma unroll
                    for (int ks = 0; ks < 4; ++ks) Kf[tl][ks] = *(const bf16x8*)(z + (size_t)(b * SEQ + 32 * kt + 16 * tl + fr) * ZW_OTH + CMIX + head * 128 + ks * 32 + fq * 8);
#pragma unroll
                for (int dt = 0; dt < 8; ++dt) { const bf16_t* vp = VT + (size_t)(head * 128 + 16 * dt + fr) * NTOK + b * SEQ + 32 * kt + 4 * fq; V0[dt] = *(const u32x2*)vp; V1[dt] = *(const u32x2*)(vp + 16); }
            }
            f32x4 s[2];
#pragma unroll
            for (int tl = 0; tl < 2; ++tl) { s[tl] = (f32x4){0.f, 0.f, 0.f, 0.f};
#pragma unroll
                for (int ks = 0; ks < 4; ++ks) s[tl] = __builtin_amdgcn_mfma_f32_16x16x32_bf16(Kf[tl][ks], Qf[ks], s[tl], 0, 0, 0); }
            float ln[2][4], lsg[2][4], tot[2];
#pragma unroll
            for (int tl = 0; tl < 2; ++tl) { tot[tl] = 0.f;
#pragma unroll
                for (int j = 0; j < 4; ++j) { const float x = s[tl][j] * sc; const int key = 32 * kt + 16 * tl + 4 * fq + j; const bool valid = key < tq;
                    const float sp = softplusf_(x); ln[tl][j] = valid ? -sp : 0.f; lsg[tl][j] = valid ? (x - sp) : -1.0e30f; tot[tl] += ln[tl][j]; } }
            const float a16_0 = __shfl_xor(tot[0], 16), a32_0 = __shfl_xor(tot[0], 32), a48_0 = __shfl_xor(tot[0], 48);
            const float a16_1 = __shfl_xor(tot[1], 16), a32_1 = __shfl_xor(tot[1], 32), a48_1 = __shfl_xor(tot[1], 48);
            float hi0 = 0.f, hi1 = 0.f;
            if ((fq ^ 1) > fq) { hi0 += a16_0; hi1 += a16_1; }
            if ((fq ^ 2) > fq) { hi0 += a32_0; hi1 += a32_1; }
            if ((fq ^ 3) > fq) { hi0 += a48_0; hi1 += a48_1; }
            const float all0 = tot[0] + a16_0 + a32_0 + a48_0, all1 = tot[1] + a16_1 + a32_1 + a48_1;
            const float E0 = R + hi0 + all1, E1 = R + hi1;
            float at[2][4];
#pragma unroll
            for (int tl = 0; tl < 2; ++tl) { float suf = 0.f; const float Eb = tl ? E1 : E0;
#pragma unroll
                for (int j = 3; j >= 0; --j) { at[tl][j] = __expf(lsg[tl][j] + Eb + suf); suf += ln[tl][j]; } }
            R += all0 + all1;
            u32x4 pw; pw.x = cvt_pk_bf16(at[0][0], at[0][1]); pw.y = cvt_pk_bf16(at[0][2], at[0][3]); pw.z = cvt_pk_bf16(at[1][0], at[1][1]); pw.w = cvt_pk_bf16(at[1][2], at[1][3]);
            const bf16x8 pf = __builtin_bit_cast(bf16x8, pw);
#pragma unroll
            for (int dt = 0; dt < 8; ++dt) {
                u32x4 vw; vw.x = V0[dt].x; vw.y = V0[dt].y; vw.z = V1[dt].x; vw.w = V1[dt].y;
                o[dt] = __builtin_amdgcn_mfma_f32_16x16x32_bf16(__builtin_bit_cast(bf16x8, vw), pf, o[dt], 0, 0, 0);
            }
            if (__all(R < -100.f)) break;
        }
        bf16_t* orow = cat + (size_t)(b * SEQ + tq) * DM + head * 128 + 4 * fq;
#pragma unroll
        for (int dt = 0; dt < 8; ++dt) { u32x2 w; w.x = cvt_pk_bf16(o[dt][0], o[dt][1]); w.y = cvt_pk_bf16(o[dt][2], o[dt][3]); *(u32x2*)(orow + 16 * dt) = w; }
    }
    __syncthreads();
}

DI void rwkv_prep1(const Ctx& F, const Params& P, int j, const bf16_t* z) {
    unsigned char* const wsl = F.ws; float* const outl = F.out; (void)outl;
    const float* mu = PIN(17) + (size_t)j * 5056;
    bf16_t* act = (bf16_t*)(wsl + WS_ACT);
    const int gt = F.bid * NT + F.tid, ngt = F.G * NT;
    for (int idx = gt; idx < NTOK * 64; idx += ngt) {
        const int tok = idx >> 6, ci = idx & 63, t = tok & (SEQ - 1);
        u32x4 o = (u32x4){0u, 0u, 0u, 0u};
        if (ci < 24 || ci >= 32) {
            const int sc = ci < 12 ? 4608 + 8 * ci : (ci < 24 ? 4704 + 8 * (ci - 12) : 4800 + 8 * (ci - 32));
            const u32x4 a = *(const u32x4*)(z + (size_t)tok * ZW_RWKV + sc);
            u32x4 p = (u32x4){0u, 0u, 0u, 0u}; if (t > 0) p = *(const u32x4*)(z + (size_t)(tok - 1) * ZW_RWKV + sc);
            const f32x4 m0 = *(const f32x4*)(mu + sc), m1 = *(const f32x4*)(mu + sc + 4);
            float v[8];
            v[0] = bflo(a.x) + (bflo(p.x) - bflo(a.x)) * m0.x; v[1] = bfhi(a.x) + (bfhi(p.x) - bfhi(a.x)) * m0.y;
            v[2] = bflo(a.y) + (bflo(p.y) - bflo(a.y)) * m0.z; v[3] = bfhi(a.y) + (bfhi(p.y) - bfhi(a.y)) * m0.w;
            v[4] = bflo(a.z) + (bflo(p.z) - bflo(a.z)) * m1.x; v[5] = bfhi(a.z) + (bfhi(p.z) - bfhi(a.z)) * m1.y;
            v[6] = bflo(a.w) + (bflo(p.w) - bflo(a.w)) * m1.z; v[7] = bfhi(a.w) + (bfhi(p.w) - bfhi(a.w)) * m1.w;
#pragma unroll
            for (int q = 0; q < 8; ++q) { if (ci < 12) v[q] = tanhf(v[q]); else if (ci >= 32) v[q] = sigmoidf_(v[q]); }
            o.x = cvt_pk_bf16(v[0], v[1]); o.y = cvt_pk_bf16(v[2], v[3]); o.z = cvt_pk_bf16(v[4], v[5]); o.w = cvt_pk_bf16(v[6], v[7]);
        }
        *(u32x4*)(act + (size_t)tok * 512 + ci * 8) = o;
    }
}

constexpr int CH = 64, NCH = SEQ / CH;
DI float* scan_rec(unsigned char* ws, int tok, int head) {
    return (float*)(ws + WS_SCAN) + ((size_t)((tok >> 12) * 24 + head) * SEQ + (tok & (SEQ - 1))) * 320;
}
DI float* gh_ptr(unsigned char* ws, int bh, int c, int which) { return (float*)(ws + WS_GH) + (((size_t)bh * NCH + c) * 2 + which) * 4096; }
struct RwPar { const float *mu, *w0, *a0, *kk, *ka, *rk, *gng, *gnb; };
struct PrepRaw { u32x2 zr, zk, zv, pr, pk, pv, lw, la; };
struct PrepOut { f32x4 dec, ld, bb, kp, r, nk, v; float bon; };
DI void prep_load(PrepRaw& R, const bf16_t* z, const bf16_t* LW, int tok, int c4) {
    tok = tok < NTOK ? tok : NTOK - 1;
    const bool hp = (tok & (SEQ - 1)) != 0;
    const GAS bf16_t* zc = (const GAS bf16_t*)(z + (size_t)tok * ZW_RWKV + c4); const GAS bf16_t* zp = hp ? zc - ZW_RWKV : zc;
    R.zr = *(const GAS u32x2*)zc; R.zk = *(const GAS u32x2*)(zc + CMIX); R.zv = *(const GAS u32x2*)(zc + 2 * CMIX);
    R.pr = *(const GAS u32x2*)zp; R.pk = *(const GAS u32x2*)(zp + CMIX); R.pv = *(const GAS u32x2*)(zp + 2 * CMIX);
    const GAS bf16_t* lp = (const GAS bf16_t*)(LW + (size_t)tok * 3072 + c4); R.lw = *(const GAS u32x2*)lp; R.la = *(const GAS u32x2*)(lp + CMIX);
}
DI f32x4 lerp_u(u32x2 a, u32x2 p, f32x4 m) {
    f32x4 r; r.x = bflo(a.x) + (bflo(p.x) - bflo(a.x)) * m.x; r.y = bfhi(a.x) + (bfhi(p.x) - bfhi(a.x)) * m.y;
    r.z = bflo(a.y) + (bflo(p.y) - bflo(a.y)) * m.z; r.w = bfhi(a.y) + (bfhi(p.y) - bfhi(a.y)) * m.w; return r;
}
struct PrepPar { f32x4 mur, muk, muv, w0, a0, kk, ka, rk; };
DI void par_load(PrepPar& P, const RwPar& Q, int c4) {
    P.mur = *(const GAS f32x4*)(Q.mu + c4); P.muk = *(const GAS f32x4*)(Q.mu + CMIX + c4); P.muv = *(const GAS f32x4*)(Q.mu + 2 * CMIX + c4);
    P.w0 = *(const GAS f32x4*)(Q.w0 + c4); P.a0 = *(const GAS f32x4*)(Q.a0 + c4); P.kk = *(const GAS f32x4*)(Q.kk + c4); P.ka = *(const GAS f32x4*)(Q.ka + c4); P.rk = *(const GAS f32x4*)(Q.rk + c4);
}
template <bool WANT_BON> DI void prep_compute(const PrepRaw& R, const PrepPar& P, bool hp, PrepOut& O) {
    const u32x2 z2 = (u32x2){0u, 0u};
    const f32x4 r = lerp_u(R.zr, hp ? R.pr : z2, P.mur), k = lerp_u(R.zk, hp ? R.pk : z2, P.muk);
    O.v = lerp_u(R.zv, hp ? R.pv : z2, P.muv); O.r = r;
    const f32x4 w0v = P.w0, a0v = P.a0, kkv = P.kk, kav = P.ka;
    f32x4 wr; wr.x = w0v.x + bflo(R.lw.x); wr.y = w0v.y + bfhi(R.lw.x); wr.z = w0v.z + bflo(R.lw.y); wr.w = w0v.w + bfhi(R.lw.y);
    f32x4 ar; ar.x = a0v.x + bflo(R.la.x); ar.y = a0v.y + bfhi(R.la.x); ar.z = a0v.z + bflo(R.la.y); ar.w = a0v.w + bfhi(R.la.y);
    f32x4 a, kk;
#pragma unroll
    for (int q = 0; q < 4; ++q) { const float wl = -softplusf_(-wr[q]) - 0.5f; O.ld[q] = -__expf(wl); O.dec[q] = __expf(O.ld[q]); a[q] = sigmoidf_(ar[q]); kk[q] = k[q] * kkv[q]; O.kp[q] = k[q] * (1.f + (a[q] - 1.f) * kav[q]); }
    const float n2 = sum16(kk.x * kk.x + kk.y * kk.y + kk.z * kk.z + kk.w * kk.w);
    const float inv = __builtin_amdgcn_rsqf(fmaxf(n2, 1e-24f));
#pragma unroll
    for (int q = 0; q < 4; ++q) { const float kn = kk[q] * inv; O.bb[q] = kn * a[q]; O.nk[q] = -kn; }
    if (WANT_BON) { const f32x4 rk = P.rk; O.bon = sum16(r.x * O.kp.x * rk.x + r.y * O.kp.y * rk.y + r.z * O.kp.z * rk.z + r.w * O.kp.w * rk.w); }
}
#define LO2(v) ((f32x2){(v).x, (v).y})
#define HI2(v) ((f32x2){(v).z, (v).w})
constexpr int WRS = 144;
constexpr int W_SLOT = 64 * WRS;
enum { SL_NT = 0, SL_RT, SL_BH, SL_KH, SL_BHT, SL_KHT, SL_VT, SL_MK, SL_NB, SL_NK, SL_W1T, SL_U0T };
constexpr int W_MB = 12 * W_SLOT, W_CL = W_MB + 16384, W_PL = W_CL + 16384;
DI bf16x8 wfrag(LAS unsigned char* L, int slot, int row, int ks, int q) { return *(const LAS bf16x8*)(L + slot * W_SLOT + row * WRS + ks * 64 + q * 16); }
DI void wput(LAS unsigned char* L, int slot, int row, int col, float v) { *(LAS bf16_t*)(L + slot * W_SLOT + row * WRS + col * 2) = (bf16_t)(cvt_pk_bf16(v, 0.f) & 0xffffu); }
DI void tr4x4_rows(f32x4& x) {
    const float f0 = x.x, f1 = x.y, f2 = x.z, f3 = x.w;
    const unsigned u0 = __builtin_bit_cast(unsigned, f0), u1 = __builtin_bit_cast(unsigned, f1), u2 = __builtin_bit_cast(unsigned, f2), u3 = __builtin_bit_cast(unsigned, f3);
    const auto s02 = __builtin_amdgcn_permlane32_swap(u0, u2, false, false); const auto s13 = __builtin_amdgcn_permlane32_swap(u1, u3, false, false);
    const auto t01 = __builtin_amdgcn_permlane16_swap(s02[0], s13[0], false, false); const auto t23 = __builtin_amdgcn_permlane16_swap(s02[1], s13[1], false, false);
    x[0] = __builtin_bit_cast(float, (unsigned)t01[0]); x[1] = __builtin_bit_cast(float, (unsigned)t01[1]); x[2] = __builtin_bit_cast(float, (unsigned)t23[0]); x[3] = __builtin_bit_cast(float, (unsigned)t23[1]);
}
DI void scan_w1(const Ctx& F, const RwPar& Q, const bf16_t* z) {
    unsigned char* const wsl = F.ws; LAS unsigned char* L = F.lds;
    const int wave = F.wave;
    const bf16_t* LW = (const bf16_t*)(wsl + WS_LW);
    LAS float* MB = (LAS float*)(L + W_MB); LAS float* CL = (LAS float*)(L + W_CL); LAS float* PL = (LAS float*)(L + W_PL);
    PrepPar PN;
    PrepRaw RN[2];
    if (F.bid < 96 * NCH) { const int bh = F.bid % 96, c = F.bid / 96, b = bh / 24, head = bh - b * 24, tokb = b * SEQ + c * CH, c4 = head * 64 + 4 * (F.lane & 15);
#pragma unroll
        for (int p = 0; p < 2; ++p) prep_load(RN[p], z, LW, tokb + p * 32 + wave * 4 + (F.lane >> 4), c4);
        par_load(PN, Q, c4); }
    for (int u = F.bid; u < 96 * NCH; u += F.G) {
        int lane = F.lane; asm volatile("" : "+v"(lane));
        const int tq = lane >> 4, li = lane & 15, fr = li, fq = tq;
        const int bh = u % 96, c = u / 96, b = bh / 24, head = bh - b * 24, tokb = b * SEQ + c * CH, c4 = head * 64 + 4 * li;
        LDS_BARRIER();
        PrepOut O[2];
#pragma unroll
        for (int p = 0; p < 2; ++p) {
            const int t = p * 32 + wave * 4 + tq; const PrepRaw R = RN[p];
            prep_compute<true>(R, PN, ((tokb + t) & (SEQ - 1)) != 0, O[p]);
            *(LAS f32x4*)(CL + t * 64 + 4 * li) = O[p].ld;
            u32x2 e; e.x = cvt_pk_bf16(O[p].bon * O[p].v.x, O[p].bon * O[p].v.y); e.y = cvt_pk_bf16(O[p].bon * O[p].v.z, O[p].bon * O[p].v.w);
            *(GAS u32x2*)((bf16_t*)(wsl + WS_E) + (size_t)(tokb + t) * CMIX + c4) = e;
        }
        LDS_BARRIER();
        if (wave == 0) {
            float xs[64];
#pragma unroll
            for (int t = 0; t < 64; ++t) xs[t] = CL[t * 64 + lane];
#pragma unroll
            for (int t = 1; t < 64; ++t) xs[t] += xs[t - 1];
#pragma unroll
            for (int t = 0; t < 64; ++t) CL[t * 64 + lane] = xs[t];
        }
        LDS_BARRIER();
#pragma unroll
        for (int p = 0; p < 2; ++p) {
            const int t = p * 32 + wave * 4 + tq;
            const f32x4 cl = *(const LAS f32x4*)(CL + t * 64 + 4 * li);
            f32x4 clm = (f32x4){0.f, 0.f, 0.f, 0.f}; if (t > 0) clm = *(const LAS f32x4*)(CL + (t - 1) * 64 + 4 * li);
            f32x4 nt, rt, bh4, kh4;
#pragma unroll
            for (int q = 0; q < 4; ++q) { const float P = __expf(cl[q]), Pm = __expf(clm[q]), iP = __expf(-cl[q]);
                nt[q] = O[p].nk[q] * Pm; rt[q] = O[p].r[q] * P; bh4[q] = O[p].bb[q] * iP; kh4[q] = O[p].kp[q] * iP;
                if (t == 63) PL[4 * li + q] = P; }
            u32x2 w;
            w.x = cvt_pk_bf16(nt.x, nt.y); w.y = cvt_pk_bf16(nt.z, nt.w); *(LAS u32x2*)(L + SL_NT * W_SLOT + t * WRS + 8 * li) = w;
            w.x = cvt_pk_bf16(rt.x, rt.y); w.y = cvt_pk_bf16(rt.z, rt.w); *(LAS u32x2*)(L + SL_RT * W_SLOT + t * WRS + 8 * li) = w;
            w.x = cvt_pk_bf16(bh4.x, bh4.y); w.y = cvt_pk_bf16(bh4.z, bh4.w); *(LAS u32x2*)(L + SL_BH * W_SLOT + t * WRS + 8 * li) = w;
            w.x = cvt_pk_bf16(kh4.x, kh4.y); w.y = cvt_pk_bf16(kh4.z, kh4.w); *(LAS u32x2*)(L + SL_KH * W_SLOT + t * WRS + 8 * li) = w;
            { f32x4 vv = O[p].v; tr4x4_rows(bh4); tr4x4_rows(kh4); tr4x4_rows(vv);
              const int off = (4 * li + tq) * WRS + (p * 32 + wave * 4) * 2;
              w.x = cvt_pk_bf16(bh4.x, bh4.y); w.y = cvt_pk_bf16(bh4.z, bh4.w); *(LAS u32x2*)(L + SL_BHT * W_SLOT + off) = w;
              w.x = cvt_pk_bf16(kh4.x, kh4.y); w.y = cvt_pk_bf16(kh4.z, kh4.w); *(LAS u32x2*)(L + SL_KHT * W_SLOT + off) = w;
              w.x = cvt_pk_bf16(vv.x, vv.y); w.y = cvt_pk_bf16(vv.z, vv.w); *(LAS u32x2*)(L + SL_VT * W_SLOT + off) = w; }
        }
        LDS_BARRIER();
        for (int reps = 0; reps < REP_WS; ++reps) {
            const int mt = wave >> 1, slotA = (mt < 2) ? SL_NT : SL_RT, slotB = (mt & 1) ? SL_KH : SL_BH, slotO = (mt == 1) ? SL_MK : (mt == 2 ? SL_NB : SL_NK), tt0 = (wave & 1) * 2;
            bf16x8 Af[2][2], Bf[4][2];
#pragma unroll
            for (int a2 = 0; a2 < 2; ++a2)
#pragma unroll
                for (int ks = 0; ks < 2; ++ks) Af[a2][ks] = wfrag(L, slotA, 16 * (tt0 + a2) + fr, ks, fq);
#pragma unroll
            for (int ss = 0; ss < 4; ++ss)
#pragma unroll
                for (int ks = 0; ks < 2; ++ks) Bf[ss][ks] = wfrag(L, slotB, 16 * ss + fr, ks, fq);
            float zf = 0.f; asm volatile("" : "+v"(zf));
            const unsigned zu = __builtin_bit_cast(unsigned, zf);
            const int strict = (mt < 2) ? 1 : 0; LAS unsigned char* ob = L + slotO * W_SLOT;
#pragma unroll
            for (int a2 = 0; a2 < 2; ++a2)
#pragma unroll
                for (int ss = 0; ss < 4; ++ss) { const int t = 16 * (tt0 + a2) + fr, s0 = 16 * ss + 4 * fq;
                    if (ss <= tt0 + a2) {
                        f32x4 acc = __builtin_amdgcn_mfma_f32_16x16x32_bf16(Bf[ss][0], Af[a2][0], (f32x4){0.f, 0.f, 0.f, 0.f}, 0, 0, 0);
                        acc = __builtin_amdgcn_mfma_f32_16x16x32_bf16(Bf[ss][1], Af[a2][1], acc, 0, 0, 0);
                        f32x4 o;
#pragma unroll
                        for (int r = 0; r < 4; ++r) o[r] = (s0 + r + strict <= t) ? acc[r] : 0.f;
                        if (mt == 0) *(LAS f32x4*)(MB + t * 64 + s0) = o;
                        else { u32x2 w; w.x = cvt_pk_bf16(o[0], o[1]); w.y = cvt_pk_bf16(o[2], o[3]); *(LAS u32x2*)(ob + t * WRS + s0 * 2) = w; }
                    } else {
                        if (mt == 0) *(LAS f32x4*)(MB + t * 64 + s0) = (f32x4){zf, zf, zf, zf};
                        else *(LAS u32x2*)(ob + t * WRS + s0 * 2) = (u32x2){zu, zu};
                    }
                }
        }
        LDS_BARRIER();
        { const int t = F.tid >> 3, s0 = (F.tid & 7) * 8; const f32x4 a0 = *(const LAS f32x4*)(MB + t * 64 + s0), a1 = *(const LAS f32x4*)(MB + t * 64 + s0 + 4);
          u32x4 w; w.x = cvt_pk_bf16(a0.x, a0.y); w.y = cvt_pk_bf16(a0.z, a0.w); w.z = cvt_pk_bf16(a1.x, a1.y); w.w = cvt_pk_bf16(a1.z, a1.w);
          *(LAS u32x4*)(L + SL_BH * W_SLOT + t * WRS + s0 * 2) = w; }
#pragma unroll
        for (int k2 = 0; k2 < 2; ++k2) {
            const int tile = wave * 2 + k2, tt = tile >> 2, it = tile & 3;
            f32x4 acc = (f32x4){0.f, 0.f, 0.f, 0.f};
#pragma unroll
            for (int ks = 0; ks < 2; ++ks) acc = __builtin_amdgcn_mfma_f32_16x16x32_bf16(wfrag(L, SL_MK, 16 * tt + fr, ks, fq), wfrag(L, SL_VT, 16 * it + fr, ks, fq), acc, 0, 0, 0);
#pragma unroll
            for (int r = 0; r < 4; ++r) CL[(16 * tt + 4 * fq + r) * 64 + 16 * it + fr] = acc[r];
        }
        if (wave >= 4) {
            const int I = wave - 4;
            float d[16], xb[16];
#pragma unroll
            for (int r = 0; r < 16; ++r) d[r] = (r == lane) ? 1.f : 0.f;
            const LAS float* mbv = MB; asm volatile("" : "+v"(mbv));
            const LAS float* mb = mbv + (16 * I) * 64 + 16 * I;
            f32x4 A[8][2], Bm[8][2];
#pragma unroll
            for (int tt = 0; tt < 8; ++tt) { A[tt][0] = *(const LAS f32x4*)(mb + tt * 64); A[tt][1] = *(const LAS f32x4*)(mb + tt * 64 + 4); }
#pragma unroll
            for (int tt = 0; tt < 8; ++tt) { Bm[tt][0] = *(const LAS f32x4*)(mb + (8 + tt) * 64); Bm[tt][1] = *(const LAS f32x4*)(mb + (8 + tt) * 64 + 4); }
#pragma unroll
            for (int sx = 0; sx < 8; ++sx) { xb[sx] = d[sx];
#pragma unroll
                for (int tt = sx + 1; tt < 8; ++tt) d[tt] = fma_s(A[tt][sx >> 2][sx & 3], xb[sx], d[tt]); }
#pragma unroll
            for (int sx = 0; sx < 8; ++sx)
#pragma unroll
                for (int tt = 0; tt < 8; ++tt) d[8 + tt] = fma_s(Bm[tt][sx >> 2][sx & 3], xb[sx], d[8 + tt]);
            asm volatile("" : "+v"(d[8]), "+v"(d[15]) :: "memory");
#pragma unroll
            for (int tt = 0; tt < 8; ++tt) { A[tt][0] = *(const LAS f32x4*)(mb + (8 + tt) * 64 + 8); A[tt][1] = *(const LAS f32x4*)(mb + (8 + tt) * 64 + 12); }
#pragma unroll
            for (int sx = 0; sx < 8; ++sx) { xb[8 + sx] = d[8 + sx];
#pragma unroll
                for (int tt = sx + 1; tt < 8; ++tt) d[8 + tt] = fma_s(A[tt][sx >> 2][sx & 3], xb[8 + sx], d[8 + tt]); }
            if (lane < 16) {
#pragma unroll
                for (int t = 0; t < 16; ++t) *(LAS bf16_t*)(L + SL_KH * W_SLOT + (16 * I + t) * 48 + lane * 2) = (bf16_t)(cvt_pk_bf16(xb[t], 0.f) & 0xffffu);
            }
        }
        LDS_BARRIER();
        asm volatile("" ::: "memory");
        { const int un = u + F.G; if (un < 96 * NCH) { const int bhn = un % 96, cn = un / 96, bn = bhn / 24, headn = bhn - bn * 24, tokbn = bn * SEQ + cn * CH, c4n = headn * 64 + 4 * li;
#pragma unroll
            for (int p = 0; p < 2; ++p) prep_load(RN[p], z, LW, tokbn + p * 32 + wave * 4 + tq, c4n);
            par_load(PN, Q, c4n); } }
        for (int repx = 0; repx < REP_WX; ++repx) {
            const int sys = wave >> 2, ct = wave & 3, slotX = sys == 0 ? SL_W1T : SL_U0T;
            LAS unsigned char* TI = L + SL_KH * W_SLOT;
            f32x4 rhs[4];
            if (sys == 0) {
#pragma unroll
                for (int I = 0; I < 4; ++I)
#pragma unroll
                    for (int r = 0; r < 4; ++r) rhs[I][r] = bf2f(*(const LAS bf16_t*)(L + SL_NT * W_SLOT + (16 * I + 4 * fq + r) * WRS + (16 * ct + fr) * 2));
            } else {
#pragma unroll
                for (int I = 0; I < 4; ++I)
#pragma unroll
                    for (int r = 0; r < 4; ++r) rhs[I][r] = CL[(16 * I + 4 * fq + r) * 64 + 16 * ct + fr];
            }
            u32x2 ta[4], ma[6];
#pragma unroll
            for (int I = 0; I < 4; ++I) ta[I] = *(const LAS u32x2*)(TI + (16 * I + fr) * 48 + 8 * fq);
#pragma unroll
            for (int I = 1; I < 4; ++I)
#pragma unroll
                for (int Ip = 0; Ip < I; ++Ip) ma[I * (I - 1) / 2 + Ip] = *(const LAS u32x2*)(L + SL_BH * W_SLOT + (16 * I + fr) * WRS + (16 * Ip + 4 * fq) * 2);
            u32x2 xk[4];
#pragma unroll
            for (int I = 0; I < 4; ++I) {
                f32x4 acc = rhs[I];
#pragma unroll
                for (int Ip = 0; Ip < I; ++Ip) { const u32x2 m = ma[I * (I - 1) / 2 + Ip];
                    acc = __builtin_amdgcn_mfma_f32_16x16x32_bf16(__builtin_bit_cast(bf16x8, (u32x4){m.x, m.y, 0u, 0u}), __builtin_bit_cast(bf16x8, (u32x4){xk[Ip].x, xk[Ip].y, 0u, 0u}), acc, 0, 0, 0); }
                const unsigned d0 = cvt_pk_bf16(acc[0], acc[1]), d1 = cvt_pk_bf16(acc[2], acc[3]);
                const f32x4 x = __builtin_amdgcn_mfma_f32_16x16x32_bf16(__builtin_bit_cast(bf16x8, (u32x4){ta[I].x, ta[I].y, 0u, 0u}), __builtin_bit_cast(bf16x8, (u32x4){d0, d1, 0u, 0u}), (f32x4){0.f, 0.f, 0.f, 0.f}, 0, 0, 0);
                xk[I].x = cvt_pk_bf16(x[0], x[1]); xk[I].y = cvt_pk_bf16(x[2], x[3]);
                *(LAS u32x2*)(L + slotX * W_SLOT + (16 * ct + fr) * WRS + (16 * I + 4 * fq) * 2) = xk[I];
            }
        }
        LDS_BARRIER();
        for (int repo = 0; repo < REP_WO; ++repo) {
            const int kind = wave >> 1, ta0 = (wave & 1) * 2;
            float* gp = gh_ptr(wsl, bh, c, 0); float* hp = gh_ptr(wsl, bh, c, 1);
            bf16_t* qy = (bf16_t*)(wsl + WS_QY) + (size_t)u * 4096; float* y0t = (float*)(wsl + WS_Y0T) + (size_t)u * 4096;
            const int sA1 = kind == 0 ? SL_W1T : kind == 1 ? SL_BHT : kind == 2 ? SL_W1T : SL_NK, sB1 = kind == 0 ? SL_BHT : kind == 1 ? SL_U0T : kind == 2 ? SL_NB : SL_VT;
            const int sA2 = kind == 1 ? SL_KHT : SL_NB, sB2 = kind == 1 ? SL_VT : SL_U0T; const bool two = (kind & 1) != 0;
            bf16x8 Af[2][2], Bf[4][2];
#pragma unroll
            for (int a2 = 0; a2 < 2; ++a2)
#pragma unroll
                for (int ks = 0; ks < 2; ++ks) Af[a2][ks] = wfrag(L, sA1, 16 * (ta0 + a2) + fr, ks, fq);
#pragma unroll
            for (int tb = 0; tb < 4; ++tb)
#pragma unroll
                for (int ks = 0; ks < 2; ++ks) Bf[tb][ks] = wfrag(L, sB1, 16 * tb + fr, ks, fq);
            f32x4 acc[2][4];
#pragma unroll
            for (int a2 = 0; a2 < 2; ++a2)
#pragma unroll
                for (int tb = 0; tb < 4; ++tb) { acc[a2][tb] = (f32x4){0.f, 0.f, 0.f, 0.f};
#pragma unroll
                    for (int ks = 0; ks < 2; ++ks) acc[a2][tb] = __builtin_amdgcn_mfma_f32_16x16x32_bf16(Af[a2][ks], Bf[tb][ks], acc[a2][tb], 0, 0, 0); }
            if (two) {
#pragma unroll
                for (int a2 = 0; a2 < 2; ++a2)
#pragma unroll
                    for (int ks = 0; ks < 2; ++ks) Af[a2][ks] = wfrag(L, sA2, 16 * (ta0 + a2) + fr, ks, fq);
#pragma unroll
                for (int tb = 0; tb < 4; ++tb)
#pragma unroll
                    for (int ks = 0; ks < 2; ++ks) Bf[tb][ks] = wfrag(L, sB2, 16 * tb + fr, ks, fq);
#pragma unroll
                for (int a2 = 0; a2 < 2; ++a2)
#pragma unroll
                    for (int tb = 0; tb < 4; ++tb)
#pragma unroll
                        for (int ks = 0; ks < 2; ++ks) acc[a2][tb] = __builtin_amdgcn_mfma_f32_16x16x32_bf16(Af[a2][ks], Bf[tb][ks], acc[a2][tb], 0, 0, 0);
            }
#pragma unroll
            for (int a2 = 0; a2 < 2; ++a2)
#pragma unroll
                for (int tb = 0; tb < 4; ++tb) { const int ta = ta0 + a2; const f32x4 av = acc[a2][tb];
                    if (kind == 0) {
                        const int j = 16 * tb + fr; const float pl = PL[j];
                        f32x4 o;
#pragma unroll
                        for (int r = 0; r < 4; ++r) o[r] = pl * (av[r] + ((16 * ta + 4 * fq + r) == j ? 1.f : 0.f));
                        u32x2 w; w.x = cvt_pk_bf16(o[0], o[1]); w.y = cvt_pk_bf16(o[2], o[3]);
                        *(GAS u32x2*)((bf16_t*)gp + j * 64 + 16 * ta + 4 * fq) = w;
                    } else if (kind == 1) {
                        const f32x4 pl = *(const LAS f32x4*)(PL + 16 * ta + 4 * fq);
                        *(GAS f32x4*)(hp + (16 * tb + fr) * 64 + 16 * ta + 4 * fq) = pl * av;
                    } else if (kind == 2) {
                        const int t = 16 * tb + fr; const u32x2 rr = *(const LAS u32x2*)(L + SL_RT * W_SLOT + t * WRS + (16 * ta + 4 * fq) * 2);
                        u32x2 w; w.x = cvt_pk_bf16(av[0] + bflo(rr.x), av[1] + bfhi(rr.x)); w.y = cvt_pk_bf16(av[2] + bflo(rr.y), av[3] + bfhi(rr.y));
                        *(GAS u32x2*)(qy + t * 64 + 16 * ta + 4 * fq) = w;
                    } else {
                        *(GAS f32x4*)(y0t + (16 * tb + fr) * 64 + 16 * ta + 4 * fq) = av;
                    }
                }
        }
    }
    LDS_BARRIER();
}
DI void scan_w2(const Ctx& F, const RwPar& Q) {
    unsigned char* const wsl = F.ws; const int lane = F.lane, fr = lane & 15, fq = lane >> 4;
    LAS float* yb = (LAS float*)(F.lds + F.wave * 16384);
    const bf16_t* gate = (const bf16_t*)(wsl + WS_GATE); const bf16_t* Eb = (const bf16_t*)(wsl + WS_E); bf16_t* cat = (bf16_t*)(wsl + WS_CAT);
    for (int u = F.gw; u < 96 * NCH; u += F.ngw) {
        const int bh = u % 96, c = u / 96, b = bh / 24, head = bh - b * 24, tokb = b * SEQ + c * CH;
        const bf16_t* qy = (const bf16_t*)(wsl + WS_QY) + (size_t)u * 4096; const float* y0t = (const float*)(wsl + WS_Y0T) + (size_t)u * 4096;
        f32x4 acc[4][4];
#pragma unroll
        for (int tt = 0; tt < 4; ++tt)
#pragma unroll
            for (int it = 0; it < 4; ++it) acc[tt][it] = *(const GAS f32x4*)(y0t + (16 * it + fr) * 64 + 16 * tt + 4 * fq);
        if (c > 0) {
            const bf16_t* sp = (const bf16_t*)gh_ptr(wsl, bh, c - 1, 0) + 4096;
            bf16x8 Bf[4][2];
#pragma unroll
            for (int it = 0; it < 4; ++it)
#pragma unroll
                for (int ks = 0; ks < 2; ++ks) Bf[it][ks] = *(const GAS bf16x8*)(sp + (16 * it + fr) * 64 + 32 * ks + 8 * fq);
#pragma unroll
            for (int tt = 0; tt < 4; ++tt)
#pragma unroll
                for (int ks = 0; ks < 2; ++ks) { const bf16x8 Af = *(const GAS bf16x8*)(qy + (16 * tt + fr) * 64 + 32 * ks + 8 * fq);
#pragma unroll
                    for (int it = 0; it < 4; ++it) acc[tt][it] = __builtin_amdgcn_mfma_f32_16x16x32_bf16(Af, Bf[it][ks], acc[tt][it], 0, 0, 0); }
        }
#pragma unroll
        for (int tt = 0; tt < 4; ++tt)
#pragma unroll
            for (int it = 0; it < 4; ++it)
#pragma unroll
                for (int r = 0; r < 4; ++r) yb[(16 * tt + 4 * fq + r) * 64 + 16 * it + fr] = acc[tt][it][r];
        LDS_WAIT();
#pragma unroll 4
        for (int k = 0; k < 16; ++k) {
            const int slot = k * 64 + lane, t = slot >> 4, li = slot & 15, c4 = head * 64 + 4 * li, tok = tokb + t;
            const f32x4 y = *(const LAS f32x4*)(yb + t * 64 + 4 * li);
            const u32x2 ev = *(const GAS u32x2*)(Eb + (size_t)tok * CMIX + c4), gt = *(const GAS u32x2*)(gate + (size_t)tok * CMIX + c4);
            const float mean = sum16(y.x + y.y + y.z + y.w) * (1.f / 64.f);
            const f32x4 d = y - mean;
            const float var = sum16(d.x * d.x + d.y * d.y + d.z * d.z + d.w * d.w) * (1.f / 64.f);
            const float rstd = rsqrtf(var + GN_EPS);
            const f32x4 g4 = *(const GAS f32x4*)(Q.gng + c4), b4 = *(const GAS f32x4*)(Q.gnb + c4);
            f32x4 o = d * rstd * g4 + b4; o.x += bflo(ev.x); o.y += bfhi(ev.x); o.z += bflo(ev.y); o.w += bfhi(ev.y);
            u32x2 w; w.x = cvt_pk_bf16(o.x * bflo(gt.x), o.y * bfhi(gt.x)); w.y = cvt_pk_bf16(o.z * bflo(gt.y), o.w * bfhi(gt.y));
            *(GAS u32x2*)(cat + (size_t)tok * DM + c4) = w;
        }
        LDS_WAIT();
    }
}
DI void scan_passB(const Ctx& F) {
    unsigned char* const wsl = F.ws; const int lane = F.lane, fr = lane & 15, fq = lane >> 4, ih = F.wave >> 2, q = F.wave & 3, bh = F.bid;
    LAS unsigned char* Sx0 = F.lds;
    bf16x8 ga[7][2]; f32x4 hq[7][2];
#define PB_LOAD(set, cc) do { const GAS bf16_t* _gp = (const GAS bf16_t*)gh_ptr(wsl, bh, (cc), 0) + (16 * q + fr) * 64 + 8 * fq; const GAS float* _hp = (const GAS float*)(gh_ptr(wsl, bh, (cc), 1) + (32 * ih + fr) * 64 + 16 * q + 4 * fq); \
        ga[set][0] = *(const GAS bf16x8*)_gp; ga[set][1] = *(const GAS bf16x8*)(_gp + 32); \
        _Pragma("unroll") for (int _r = 0; _r < 2; ++_r) hq[set][_r] = *(const GAS f32x4*)(_hp + (16 * _r) * 64); } while (0)
    PB_LOAD(0, 0); PB_LOAD(1, 1); PB_LOAD(2, 2); PB_LOAD(3, 3); PB_LOAD(4, 4); PB_LOAD(5, 5);
    for (int c7 = 0; c7 < NCH - 1; c7 += 7) {
#pragma unroll
        for (int u7 = 0; u7 < 7; ++u7) {
            const int c = c7 + u7;
            f32x4 acc[2];
#pragma unroll
            for (int it = 0; it < 2; ++it) acc[it] = hq[u7][it];
            const bf16x8 a0 = ga[u7][0], a1 = ga[u7][1];
            PB_LOAD((u7 + 6) % 7, (c + 6 < NCH - 1) ? c + 6 : NCH - 2);
            if (c > 0) {
#pragma unroll
                for (int it = 0; it < 2; ++it) {
                    acc[it] = __builtin_amdgcn_mfma_f32_16x16x32_bf16(a0, *(const LAS bf16x8*)(Sx0 + (c & 1) * W_SLOT + (32 * ih + 16 * it + fr) * WRS + fq * 16), acc[it], 0, 0, 0);
                    acc[it] = __builtin_amdgcn_mfma_f32_16x16x32_bf16(a1, *(const LAS bf16x8*)(Sx0 + (c & 1) * W_SLOT + (32 * ih + 16 * it + fr) * WRS + 64 + fq * 16), acc[it], 0, 0, 0); }
            }
            GAS bf16_t* op = (GAS bf16_t*)gh_ptr(wsl, bh, c, 0) + 4096 + (32 * ih + fr) * 64 + 16 * q + 4 * fq;
#pragma unroll
            for (int it = 0; it < 2; ++it) { u32x2 w; w.x = cvt_pk_bf16(acc[it].x, acc[it].y); w.y = cvt_pk_bf16(acc[it].z, acc[it].w);
                *(GAS u32x2*)(op + (16 * it) * 64) = w; *(LAS u32x2*)(Sx0 + ((c + 1) & 1) * W_SLOT + (32 * ih + 16 * it + fr) * WRS + (16 * q + 4 * fq) * 2) = w; }
            LDS_BARRIER();
        }
    }
#undef PB_LOAD
}

DI void ln1_router(const Ctx& F, const Params& P, int l, const float* xin) {
    unsigned char* const wsl = F.ws; float* const outl = F.out; (void)outl;
    const float* g = PIN(5) + (size_t)l * DM; const float* bta = PIN(6) + (size_t)l * DM;
    const float* gb = PIN(10) + l * 4; const float* eb = PIN(12) + l * 32;
    const bf16_t* hb = (const bf16_t*)(wsl + WS_HB); bf16_t* xb = (bf16_t*)(wsl + WS_XB); float* xo = outl;
    const bf16_t* wrt = (const bf16_t*)(wsl + WS_WSW + (size_t)l * WSW_STRIDE);
    unsigned* cnt = (unsigned*)(wsl + WS_CTL) + CW_CNT + l * 32 * 64;
    int* ltok = (int*)(wsl + WS_LTOK); float* lgate = (float*)(wsl + WS_LGATE); int* lslot = (int*)(wsl + WS_LSLOT);
    const int lane = F.lane, fr = lane & 15, fq = lane >> 4, wave = F.wave;
    LAS float* lg = (LAS float*)(F.lds + (wave & 3) * 4096);
    LAS float* lgp = (LAS float*)(F.lds + 16384 + (wave & 3) * 4096);
    LAS int* cntl = (LAS int*)(F.lds + 32768); LAS int* basel = cntl + 32;
    if (F.tid < NEXP) cntl[F.tid] = 0;
    __syncthreads();
    for (int blk = F.bid; blk < NTOK / 64; blk += F.G) {
#pragma unroll 1
        for (int pass = 0; pass < 4; ++pass) {
            int lno = lane; asm volatile("" : "+v"(lno));
            const int hr2 = lno >> 5, l32 = lno & 31;
            const size_t ro = (size_t)(blk * 64 + wave * 8 + pass * 2 + hr2) * DM + 8 * l32;
            u32x4 xr[8], hr[8];
#pragma unroll
            for (int i = 0; i < 8; ++i) { xr[i] = *(const GAS u32x4*)(xb + ro + 256 * i); hr[i] = *(const GAS u32x4*)(hb + ro + 256 * i); }
            float s = 0.f, s2 = 0.f;
#pragma unroll
            for (int i = 0; i < 8; ++i) {
#pragma unroll
                for (int e = 0; e < 4; ++e) { const float v0 = ALPHA * bflo(xr[i][e]) + bflo(hr[i][e]), v1 = ALPHA * bfhi(xr[i][e]) + bfhi(hr[i][e]); s += v0 + v1; s2 += v0 * v0 + v1 * v1; } }
            s = sum16(s); s2 = sum16(s2); s += __shfl_xor(s, 16); s2 += __shfl_xor(s2, 16);
            const float mean = s * (1.f / DM), rstd = rsqrtf(fmaxf(s2 * (1.f / DM) - mean * mean, 0.f) + LN_EPS);
#pragma unroll
            for (int i = 0; i < 8; ++i) { const int col = 256 * i + 8 * l32;
                const f32x4 g0 = *(const GAS f32x4*)(g + col), g1 = *(const GAS f32x4*)(g + col + 4), b0 = *(const GAS f32x4*)(bta + col), b1 = *(const GAS f32x4*)(bta + col + 4);
                u32x4 w;
#pragma unroll
                for (int e = 0; e < 4; ++e) { const float v0 = ALPHA * bflo(xr[i][e]) + bflo(hr[i][e]), v1 = ALPHA * bfhi(xr[i][e]) + bfhi(hr[i][e]);
                    const float gg0 = e < 2 ? g0[2 * e] : g1[2 * e - 4], gg1 = e < 2 ? g0[2 * e + 1] : g1[2 * e - 3], bb0 = e < 2 ? b0[2 * e] : b1[2 * e - 4], bb1 = e < 2 ? b0[2 * e + 1] : b1[2 * e - 3];
                    w[e] = cvt_pk_bf16((v0 - mean) * rstd * gg0 + bb0, (v1 - mean) * rstd * gg1 + bb1); }
                *(GAS u32x4*)(xb + ro + 256 * i) = w;
                asm volatile("" ::: "memory"); }
        }
        VM_WAIT();
        __syncthreads();
        __builtin_amdgcn_fence(__ATOMIC_ACQUIRE, "agent");
        VM_WAIT();
        const int row0 = blk * 64 + (wave & 3) * 16, kh = wave >> 2, krot = (F.bid * 5 + wave * 3) & 31;
        f32x4 acc[3];
#pragma unroll
        for (int ct = 0; ct < 3; ++ct) acc[ct] = (f32x4){0.f, 0.f, 0.f, 0.f};
        const bf16_t* arow = xb + (size_t)(row0 + fr) * DM + 8 * fq + kh * 1024;
        LAS unsigned char* wst = F.lds + 36864;
        u32x4 wreg[6];
        { const int st = F.bid & 7;
#pragma unroll
          for (int i = 0; i < 6; ++i) { const int ch = F.tid + NT * i, row = ch >> 4, c16 = ch & 15, rkh = row / 96, rr = row - rkh * 96;
              wreg[i] = *(const GAS u32x4*)(wrt + (size_t)rr * DM + rkh * 1024 + st * 128 + c16 * 8); } }
#pragma unroll 1
        for (int si = 0; si < 8; ++si) {
            const int st = (si + F.bid) & 7;
            LAS unsigned char* wb = wst + (si & 1) * 52224;
#pragma unroll
            for (int i = 0; i < 6; ++i) { const int ch = F.tid + NT * i, row = ch >> 4, c16 = ch & 15; *(LAS u32x4*)(wb + row * 272 + c16 * 16) = wreg[i]; }
            if (si + 1 < 8) { const int stn = (si + 1 + F.bid) & 7;
#pragma unroll
                for (int i = 0; i < 6; ++i) { const int ch = F.tid + NT * i, row = ch >> 4, c16 = ch & 15, rkh = row / 96, rr = row - rkh * 96;
                    wreg[i] = *(const GAS u32x4*)(wrt + (size_t)rr * DM + rkh * 1024 + stn * 128 + c16 * 8); } }
            bf16x8 af[4];
#pragma unroll
            for (int ksl = 0; ksl < 4; ++ksl) af[ksl] = *(const GAS bf16x8*)(arow + st * 128 + ksl * 32);
            LDS_BARRIER();
#pragma unroll
            for (int ksl = 0; ksl < 4; ++ksl)
#pragma unroll
                for (int ct = 0; ct < 3; ++ct) {
                    acc[ct] = __builtin_amdgcn_mfma_f32_16x16x32_bf16(af[ksl], *(const LAS bf16x8*)(wb + (kh * 96 + 16 * ct + fr) * 272 + ksl * 64 + fq * 16), acc[ct], 0, 0, 0);
                    acc[ct] = __builtin_amdgcn_mfma_f32_16x16x32_bf16(af[ksl], *(const LAS bf16x8*)(wb + (kh * 96 + 48 + 16 * ct + fr) * 272 + ksl * 64 + fq * 16), acc[ct], 0, 0, 0);
                }
        }
        if (kh == 1) {
#pragma unroll
            for (int ct = 0; ct < 3; ++ct)
#pragma unroll
                for (int jj = 0; jj < 4; ++jj) lgp[(4 * fq + jj) * 48 + 16 * ct + fr] = acc[ct][jj];
        }
        __syncthreads();
        if (kh == 0) {
#pragma unroll
            for (int ct = 0; ct < 3; ++ct)
#pragma unroll
                for (int jj = 0; jj < 4; ++jj) lg[(4 * fq + jj) * 48 + 16 * ct + fr] = acc[ct][jj] + lgp[(4 * fq + jj) * 48 + 16 * ct + fr];
        }
        LDS_WAIT();
        int se0 = 0, se1 = 0, sr0 = 0, sr1 = 0, stok = 0; float sg0 = 0.f, sg1 = 0.f;
        if (kh == 0 && lane < 16) {
            const LAS float* L = lg + lane * 48; const int tok = row0 + lane;
            float gl[4]; int grp_i = 0; float gmx;
#pragma unroll
            for (int q = 0; q < 4; ++q) gl[q] = L[q] + gb[q];
            gmx = gl[0];
#pragma unroll
            for (int q = 1; q < 4; ++q) if (gl[q] > gmx) { gmx = gl[q]; grp_i = q; }
            float gs = 0.f;
#pragma unroll
            for (int q = 0; q < 4; ++q) gs += __expf(gl[q] - gmx);
            const float pg = 1.f / gs;
            float el[8];
#pragma unroll
            for (int q = 0; q < 8; ++q) el[q] = L[4 + 8 * grp_i + q] + eb[8 * grp_i + q];
            int i0 = 0; float m0 = el[0];
#pragma unroll
            for (int q = 1; q < 8; ++q) if (el[q] > m0) { m0 = el[q]; i0 = q; }
            int i1 = -1; float m1 = -3.0e38f;
#pragma unroll
            for (int q = 0; q < 8; ++q) if (q != i0 && el[q] > m1) { m1 = el[q]; i1 = q; }
            if (i1 < 0) { i1 = (i0 == 0) ? 1 : 0; m1 = m0; }
            const float p1 = __expf(m1 - m0), den = 1.f / (1.f + p1);
            const float g0 = pg * den, g1 = pg * p1 * den;
            se0 = grp_i * 8 + i0; se1 = grp_i * 8 + i1; sg0 = g0; sg1 = g1; stok = tok;
            sr0 = __hip_atomic_fetch_add(cntl + se0, 1, __ATOMIC_RELAXED, __HIP_MEMORY_SCOPE_WORKGROUP);
            sr1 = __hip_atomic_fetch_add(cntl + se1, 1, __ATOMIC_RELAXED, __HIP_MEMORY_SCOPE_WORKGROUP);
        }
        __syncthreads();
        if (wave == 0 && lane < NEXP) { const int n = cntl[lane]; basel[lane] = n ? (int)__hip_atomic_fetch_add(cnt + lane * 64, (unsigned)n, __ATOMIC_RELAXED, __HIP_MEMORY_SCOPE_AGENT) : 0; }
        __syncthreads();
        if (kh == 0 && lane < 16) {
            const int pos0 = basel[se0] + sr0, pos1 = basel[se1] + sr1;
            ltok[se0 * LISTCAP + pos0] = stok; lgate[se0 * LISTCAP + pos0] = sg0; lslot[se0 * LISTCAP + pos0] = 2 * stok;
            ltok[se1 * LISTCAP + pos1] = stok; lgate[se1 * LISTCAP + pos1] = sg1; lslot[se1 * LISTCAP + pos1] = 2 * stok + 1;
        }
        __syncthreads();
        if (F.tid < NEXP) cntl[F.tid] = 0;
        __syncthreads();
    }
}

DI void ln2_phase(const Ctx& F, const Params& P, int l) {
    unsigned char* const wsl = F.ws; float* const outl = F.out;
    const float* g = PIN(7) + (size_t)l * DM; const float* bta = PIN(8) + (size_t)l * DM;
    const bf16_t* ys = (const bf16_t*)(wsl + WS_YS); bf16_t* xb = (bf16_t*)(wsl + WS_XB); float* xo = outl;
#pragma unroll 1
    for (int rp = F.gw; rp < NTOK / 2; rp += F.ngw) {
        int lno = F.lane; asm volatile("" : "+v"(lno));
        const int hr2 = lno >> 5, l32 = lno & 31, row = 2 * rp + hr2;
        const size_t ro = (size_t)row * DM + 8 * l32;
        u32x4 xr[8], y0[8], y1[8];
#pragma unroll
        for (int i = 0; i < 8; ++i) { xr[i] = *(const GAS u32x4*)(xb + ro + 256 * i); y0[i] = *(const GAS u32x4*)(ys + 2 * (size_t)row * DM + 8 * l32 + 256 * i); y1[i] = *(const GAS u32x4*)(ys + (2 * (size_t)row + 1) * DM + 8 * l32 + 256 * i); }
        float s = 0.f, s2 = 0.f;
#pragma unroll
        for (int i = 0; i < 8; ++i) {
#pragma unroll
            for (int e = 0; e < 4; ++e) { const float v0 = ALPHA * bflo(xr[i][e]) + (bflo(y0[i][e]) + bflo(y1[i][e])), v1 = ALPHA * bfhi(xr[i][e]) + (bfhi(y0[i][e]) + bfhi(y1[i][e])); s += v0 + v1; s2 += v0 * v0 + v1 * v1; } }
        s = sum16(s); s2 = sum16(s2); s += __shfl_xor(s, 16); s2 += __shfl_xor(s2, 16);
        const float mean = s * (1.f / DM), rstd = rsqrtf(fmaxf(s2 * (1.f / DM) - mean * mean, 0.f) + LN_EPS);
#pragma unroll
        for (int i = 0; i < 8; ++i) { const int col = 256 * i + 8 * l32;
            const f32x4 g0 = *(const GAS f32x4*)(g + col), g1 = *(const GAS f32x4*)(g + col + 4), b0 = *(const GAS f32x4*)(bta + col), b1 = *(const GAS f32x4*)(bta + col + 4);
            float o[8];
#pragma unroll
            for (int e = 0; e < 4; ++e) { const float v0 = ALPHA * bflo(xr[i][e]) + (bflo(y0[i][e]) + bflo(y1[i][e])), v1 = ALPHA * bfhi(xr[i][e]) + (bfhi(y0[i][e]) + bfhi(y1[i][e]));
                const float gg0 = e < 2 ? g0[2 * e] : g1[2 * e - 4], gg1 = e < 2 ? g0[2 * e + 1] : g1[2 * e - 3], bb0 = e < 2 ? b0[2 * e] : b1[2 * e - 4], bb1 = e < 2 ? b0[2 * e + 1] : b1[2 * e - 3];
                o[2 * e] = (v0 - mean) * rstd * gg0 + bb0; o[2 * e + 1] = (v1 - mean) * rstd * gg1 + bb1; }
            if (l == NLAYER - 1) { *(GAS f32x4*)(xo + (size_t)row * DM + col) = (f32x4){o[0], o[1], o[2], o[3]}; *(GAS f32x4*)(xo + (size_t)row * DM + col + 4) = (f32x4){o[4], o[5], o[6], o[7]}; }
            else { u32x4 w; w.x = cvt_pk_bf16(o[0], o[1]); w.y = cvt_pk_bf16(o[2], o[3]); w.z = cvt_pk_bf16(o[4], o[5]); w.w = cvt_pk_bf16(o[6], o[7]); *(GAS u32x4*)(xb + ro + 256 * i) = w; }
            asm volatile("" ::: "memory"); }
    }
}

DI int moe_table(const Ctx& F, int l) {
    unsigned char* const wsl = F.ws; float* const outl = F.out; (void)outl;
    LAS int* tb = (LAS int*)(F.lds + LDS_CTL_OFF) + 16;
    const unsigned* cnt = (const unsigned*)(wsl + WS_CTL) + CW_CNT + l * 32 * 64;
    __syncthreads();
    if (F.tid == 0) { int acc = 0;
        for (int e = 0; e < NEXP; ++e) { tb[e] = acc; const int n = (int)__hip_atomic_load(cnt + e * 64, __ATOMIC_RELAXED, __HIP_MEMORY_SCOPE_AGENT); acc += (n + 255) >> 8; }
        tb[NEXP] = acc; }
    __syncthreads();
    return tb[NEXP];
}


#ifdef MK_DEBUG
constexpr int CW_DBG = 40960;
DI void dbg_count_bf16(const Ctx& F, const bf16_t* p, size_t n, int k) {
    unsigned bad = 0; const size_t gt = (size_t)F.bid * NT + F.tid, ngt = (size_t)F.G * NT;
    for (size_t i = gt; i < n; i += ngt) { const unsigned b = p[i]; const float v = bf2f(b); if ((b & 0x7f80u) == 0x7f80u || fabsf(v) > 1.0e6f) ++bad; }
    if (bad) atomicAdd((unsigned*)(F.ws + WS_CTL) + CW_DBG + k * 64, bad);
}
DI void dbg_count_f32(const Ctx& F, const float* p, size_t n, int k) {
    unsigned bad = 0; const size_t gt = (size_t)F.bid * NT + F.tid, ngt = (size_t)F.G * NT;
    for (size_t i = gt; i < n; i += ngt) { const float v = p[i]; if (!(fabsf(v) <= 1.0e6f)) ++bad; }
    if (bad) atomicAdd((unsigned*)(F.ws + WS_CTL) + CW_DBG + k * 64, bad);
}
#endif
constexpr int PH_PER_LAYER = 11, N_PHASES = 1 + NLAYER * PH_PER_LAYER;

__global__ void __launch_bounds__(NT, 2) mega_fwd(Params P) {
    extern __shared__ __attribute__((aligned(16))) unsigned char lds_raw[];
    Ctx F0;
    F0.lds = (LAS unsigned char*)lds_raw;
    F0.tid = threadIdx.x; F0.lane = F0.tid & 63; F0.wave = __builtin_amdgcn_readfirstlane(F0.tid >> 6);
    F0.G = gridDim.x; F0.bid = blockIdx.x; F0.gw = F0.bid * NWAVES + F0.wave; F0.ngw = F0.G * NWAVES;
    F0.ws = P.ws; F0.out = P.out;
    for (int u = F0.tid; u < (LDS_BYTES - LDS_CTL_OFF) / 4; u += NT) ((LAS unsigned*)(F0.lds + LDS_CTL_OFF))[u] = 0u;
    __syncthreads();
    XcdBarrier bar; bar.bar = (unsigned*)(F0.ws + WS_CTL) + CW_BAR; bar.x = 0; bar.st = nullptr;
#if !MK_PER_PHASE
    bar = xcd_barrier_post((unsigned*)(F0.ws + WS_CTL) + CW_BAR, (volatile LAS unsigned*)(F0.lds + LDS_CTL_OFF));
#endif
    const int lo = P.ph_lo, hi = P.ph_hi;
#define IN(k) (lo <= (k) && (k) < hi)
#if MK_PER_PHASE
#define SEAM(k) do { } while (0)
#else
#define SEAM(k) do { if ((k) + 1 < hi) { XcdBarrier _b = bar; asm volatile("" : "+s"(_b.bar), "+s"(_b.x)); xcd_barrier(_b); } } while (0)
#endif
#define WSL const Ctx F = relaunder(F0); unsigned char* const ws = F.ws; bf16_t* const xb = (bf16_t*)(ws + WS_XB); bf16_t* const zb = (bf16_t*)(ws + WS_Z); bf16_t* const cat = (bf16_t*)(ws + WS_CAT); (void)xb; (void)zb; (void)cat

    if (IN(0)) { WSL; phase_prologue(F, P); SEAM(0); }

    for (int l = 0; l < NLAYER; ++l) {
        const int kind = l % 3, j = l / 3, pb = 1 + l * PH_PER_LAYER;
        const int zw = (kind == 0) ? ZW_RWKV : ZW_OTH, qcol = (kind == 0) ? 5056 : 4608;
        if (IN(pb + 0)) {
            WSL; const bf16_t* winT = (const bf16_t*)(ws + WS_WIN + (size_t)l * WIN_STRIDE);
            if (kind != 2) dense_gemm(F, xb, DM, winT, DM, NTOK, zw, DM, zb, zw, 0);
            else {
                dense_gemm(F, xb, DM, winT, DM, NTOK, 3072, DM, zb, zw, 0);
                dense_gemm(F, xb, DM, winT + (size_t)4608 * DM, DM, NTOK, 512, DM, zb + 4608, zw, 0);
                dense_gemm(F, winT + (size_t)3072 * DM, DM, xb, DM, CMIX, NTOK, DM, (bf16_t*)(ws + WS_ACT), NTOK, 128);
            }
            if (l == 0) {
                dense_gemm(F, (const bf16_t*)(ws + WS_MEMB), DM, (const bf16_t*)(ws + WS_WK), DM, NBATCH * MEML, 2048, DM, (bf16_t*)(ws + WS_KM), 2048, 128);
                dense_gemm(F, (const bf16_t*)(ws + WS_WV), DM, (const bf16_t*)(ws + WS_MEMB), DM, 2048, NBATCH * MEML, DM, (bf16_t*)(ws + WS_VMT), 1024, 192);
            }
            SEAM(pb + 0);
        }
        if (IN(pb + 1)) {
            WSL;
            if (kind == 0) { for (int rep = 0; rep < REP_PREP; ++rep) rwkv_prep1(F, P, j, zb); for (int rep = 0; rep < REP_MIX * REP_MA; ++rep) memattn_all(F, l, zb, zw, qcol); }
            else if (kind == 1) { for (int rep = 0; rep < REP_MIX; ++rep) conv_mix(F, P, zb); for (int rep = 0; rep < REP_MIX * REP_MA; ++rep) memattn_all(F, l, zb, zw, qcol); for (int rep = 0; rep < REP_CONV; ++rep) expert_convert(F, P, l, F.gw, F.ngw); }
            else { for (int rep = 0; rep < REP_MIX * REP_SB; ++rep) sb_attention(F, zb); for (int rep = 0; rep < REP_MIX * REP_MA; ++rep) memattn_all(F, l, zb, zw, qcol); for (int rep = 0; rep < REP_CONV; ++rep) expert_convert(F, P, l, F.gw, F.ngw); }
            SEAM(pb + 1);
        }
        if (kind == 0) {
            if (IN(pb + 2)) {
                WSL; const bf16_t* act = (const bf16_t*)(ws + WS_ACT); const bf16_t* wa = (const bf16_t*)(ws + WS_LORA + (size_t)j * LORA_STRIDE);
                dense_gemm(F, act, 512, wa, 256, NTOK, 3072, 256, (bf16_t*)(ws + WS_LW), 3072, 0);
                dense_gemm(F, act + 256, 512, wa + (size_t)3072 * 256, 256, NTOK, CMIX, 256, (bf16_t*)(ws + WS_GATE), CMIX, 0);
                SEAM(pb + 2);
            }
            if (IN(pb + 3)) { WSL; const RwPar Q{PIN(17) + (size_t)j * 5056, PIN(18) + j * CMIX, PIN(20) + j * CMIX, PIN(23) + j * CMIX, PIN(24) + j * CMIX, PIN(25) + j * CMIX, PIN(26) + j * CMIX, PIN(27) + j * CMIX};
                for (int rep = 0; rep < REP_SCAN; ++rep) scan_w1(F, Q, zb); SEAM(pb + 3); }
            if (IN(pb + 4)) {
                WSL;
                if (F.bid < 96) scan_passB(F);
                else expert_convert(F, P, l, (F.bid - 96) * NWAVES + F.wave, (F.G - 96) * NWAVES);
                SEAM(pb + 4);
            }
            if (IN(pb + 5)) { WSL; const RwPar Q{PIN(17) + (size_t)j * 5056, PIN(18) + j * CMIX, PIN(20) + j * CMIX, PIN(23) + j * CMIX, PIN(24) + j * CMIX, PIN(25) + j * CMIX, PIN(26) + j * CMIX, PIN(27) + j * CMIX};
                for (int rep = 0; rep < REP_SCAN * REP_W2; ++rep) scan_w2(F, Q); SEAM(pb + 5); }
        }
        if (IN(pb + 6)) { WSL; dense_gemm(F, cat, DM, (const bf16_t*)(ws + WS_WOUT) + (size_t)l * DM * DM, DM, NTOK, DM, DM, (bf16_t*)(ws + WS_HB), DM, 0); SEAM(pb + 6); }
        if (IN(pb + 7)) { WSL; ln1_router(F, P, l, l == 0 ? PIN(0) : (const float*)P.out); SEAM(pb + 7); }
        if (IN(pb + 8)) {
            WSL; const int ntiles = moe_table(F, l);
            pg8::Gemm g{xb, (const bf16_t*)(ws + WS_EXP1), DM, DM, DM};
            pg8::MoeOrder<true> S; S.G = F.G; S.c = F.bid; S.npn = 4; S.total = ntiles * 4; S.tb = (const LAS int*)(F.lds + LDS_CTL_OFF) + 16; S.estride = (size_t)1024 * DM * 2;
            S.ltok = (const int*)(ws + WS_LTOK); S.cnt = (const unsigned*)(ws + WS_CTL) + CW_CNT + l * 32 * 64;
            pg8::EpiSwiGLU E{(bf16_t*)(ws + WS_HE)};
            for (int rep = 0; rep < REP_MOE; ++rep) pg8::gemm_phase<pg8::EpiSwiGLU, pg8::MoeOrder<true>>(F.lds, g, S, E);
            SEAM(pb + 8);
        }
        if (IN(pb + 9)) {
            WSL; const int ntiles = moe_table(F, l);
            pg8::Gemm g{(const bf16_t*)(ws + WS_HE), (const bf16_t*)(ws + WS_EXP2), DEXP, DEXP, DEXP};
            pg8::MoeOrder<false> S; S.G = F.G; S.c = F.bid; S.npn = 8; S.total = ntiles * 8; S.tb = (const LAS int*)(F.lds + LDS_CTL_OFF) + 16; S.estride = (size_t)DM * DEXP * 2;
            S.ltok = (const int*)(ws + WS_LTOK); S.cnt = (const unsigned*)(ws + WS_CTL) + CW_CNT + l * 32 * 64;
            pg8::EpiScatter E{(bf16_t*)(ws + WS_YS), (const int*)(ws + WS_LSLOT), (const float*)(ws + WS_LGATE), S.cnt};
            for (int rep = 0; rep < REP_MOE; ++rep) pg8::gemm_phase<pg8::EpiScatter, pg8::MoeOrder<false>>(F.lds, g, S, E);
            SEAM(pb + 9);
        }
        if (IN(pb + 10)) { WSL; ln2_phase(F, P, l); SEAM(pb + 10); }
    }
#ifdef MK_DEBUG
    {
        WSL;
        xcd_barrier(bar);
        dbg_count_bf16(F, (const bf16_t*)(ws + WS_CAT), (size_t)NTOK * DM, 0);
        dbg_count_bf16(F, (const bf16_t*)(ws + WS_HB), (size_t)NTOK * DM, 1);
        dbg_count_f32(F, (const float*)(ws + WS_LGATE), (size_t)32 * 16384, 2);
        dbg_count_bf16(F, (const bf16_t*)(ws + WS_YS), (size_t)32768 * 2048, 3);
        dbg_count_f32(F, (const float*)F.out, (size_t)NTOK * DM, 4);
        dbg_count_bf16(F, (const bf16_t*)(ws + WS_XB), (size_t)NTOK * DM, 5);
        xcd_barrier(bar);
        int first = 13;
        for (int k = 12; k >= 0; --k) if (__hip_atomic_load((unsigned*)(ws + WS_CTL) + CW_DBG + k * 64, __ATOMIC_RELAXED, __HIP_MEMORY_SCOPE_AGENT) != 0u) first = k;
        const float val = 1000.f * (float)(first + 1);
        for (size_t i = (size_t)F.bid * NT + F.tid; i < (size_t)NTOK * DM; i += (size_t)F.G * NT) F.out[i] = val;
    }
#endif
#undef IN
#undef SEAM
}

extern "C" void kernel_launch(void* const* d_in, const int* in_sizes, int n_in, void* d_out, int out_size, void* d_ws, size_t ws_size, hipStream_t stream) {
    static int grid = 0;
    if (grid == 0) {
        if (n_in != 31 || ws_size < WS_END) { fprintf(stderr, "kernel_launch: expected 31 inputs and >= %zu bytes of workspace, got %d / %zu\n", (size_t)WS_END, n_in, ws_size); grid = -1; return; }
        int dev = 0, cus = 0, per_cu = 0;
        if (hipGetDevice(&dev) != hipSuccess || hipDeviceGetAttribute(&cus, hipDeviceAttributeMultiprocessorCount, dev) != hipSuccess) { grid = -1; return; }
        if (hipFuncSetAttribute((const void*)mega_fwd, hipFuncAttributeMaxDynamicSharedMemorySize, LDS_BYTES) != hipSuccess) { fprintf(stderr, "kernel_launch: hipFuncSetAttribute failed\n"); grid = -1; return; }
        if (hipOccupancyMaxActiveBlocksPerMultiprocessor(&per_cu, (const void*)mega_fwd, NT, LDS_BYTES) != hipSuccess || per_cu < 1)
            fprintf(stderr, "kernel_launch: occupancy query reports %d workgroups per CU\n", per_cu);
        (void)hipGetLastError();
        grid = cus;
    }
    if (grid < 0) return;
    (void)hipMemsetAsync((char*)d_ws + WS_CTL, 0, CTL_BYTES, stream);
    Params p{};
    for (int i = 0; i < 31; ++i) p.in[i] = (const float*)d_in[i];
    p.out = (float*)d_out; p.ws = (unsigned char*)d_ws;
#if MK_PER_PHASE
    for (int ph = 0; ph < N_PHASES; ++ph) {
        if (ph > 0) { const int l = (ph - 1) / PH_PER_LAYER, loc = (ph - 1) % PH_PER_LAYER; if ((l % 3) != 0 && loc >= 2 && loc <= 5) continue; }
        p.ph_lo = ph; p.ph_hi = ph + 1;
        hipLaunchKernelGGL(mega_fwd, dim3(grid), dim3(NT), LDS_BYTES, stream, p);
    }
#else
#ifndef MK_PH_HI
#define MK_PH_HI N_PHASES
#endif
    p.ph_lo = 0; p.ph_hi = MK_PH_HI;
    hipLaunchKernelGGL(mega_fwd, dim3(grid), dim3(NT), LDS_BYTES, stream, p);
#endif
    const hipError_t le = hipPeekAtLastError();
    if (le != hipSuccess) fprintf(stderr, "kernel_launch: launch failed: %s\n", hipGetErrorName(le));
}
```

```cpp
#include <hip/hip_runtime.h>
#include <cstdio>
#include <cstdint>

#ifndef MK_PER_PHASE
#define MK_PER_PHASE 0
#endif
#ifndef MK_PH_HI
#define MK_PH_HI N_PHASES
#endif
#ifndef REP_GEMM
#define REP_GEMM 1
#endif
#ifndef REP_MOE
#define REP_MOE 1
#endif
#ifndef REP_SCAN
#define REP_SCAN 1
#endif
#ifndef REP_PREP
#define REP_PREP 1
#endif
#ifndef REP_MIX
#define REP_MIX 1
#endif
#ifndef REP_CONV
#define REP_CONV 1
#endif
#ifndef REP_SB
#define REP_SB 1
#endif
#ifndef REP_MA
#define REP_MA 1
#endif
#ifndef REP_WX
#define REP_WX 1
#endif
#ifndef REP_WS
#define REP_WS 1
#endif
#ifndef REP_WO
#define REP_WO 1
#endif
#ifndef REP_W2
#define REP_W2 1
#endif

#define LAS __attribute__((address_space(3)))
#define GAS __attribute__((address_space(1)))
#define DI __device__ __forceinline__
typedef unsigned short bf16_t;
typedef short bf16x8 __attribute__((ext_vector_type(8)));
typedef short s16x4 __attribute__((ext_vector_type(4)));
typedef float f32x2 __attribute__((ext_vector_type(2)));
typedef float f32x4 __attribute__((ext_vector_type(4)));
typedef float f32x8 __attribute__((ext_vector_type(8)));
typedef float f32x16 __attribute__((ext_vector_type(16)));
typedef unsigned u32x2 __attribute__((ext_vector_type(2)));
typedef unsigned u32x4 __attribute__((ext_vector_type(4)));

constexpr int NTOK = 16384, DM = 2048, SEQ = 4096, NBATCH = 4, CMIX = 1536, MEMW = 512, MEML = 256, NLAYER = 4;
constexpr int ZW_RWKV = 5632  , ZW_OTH = 5120, RW_IN_COLS = 5568;
constexpr int NEXP = 32, DEXP = 512, LISTCAP = 16384, MAXTILES = 160;
constexpr float LN_EPS = 1e-5f, ALPHA = 1.681792830507429f, GN_EPS = 64e-5f;
constexpr int NT = 512, NWAVES = 8;

constexpr size_t MiB = (size_t)1 << 20;
constexpr size_t WS_CTL = 0, CTL_BYTES = 1 * MiB;
constexpr size_t WS_WIN = 2 * MiB;
constexpr size_t WIN_STRIDE = 22 * MiB;
constexpr size_t WS_WOUT = 90 * MiB;
constexpr size_t WS_WK = 122 * MiB;
constexpr size_t WS_WV = 130 * MiB;
constexpr size_t WS_MEMB = 138 * MiB;
constexpr size_t WS_KM = 142 * MiB;
constexpr size_t WS_VMT = 146 * MiB;
constexpr size_t WS_LORA = 150 * MiB;
constexpr size_t LORA_STRIDE = 3 * MiB;
constexpr size_t WS_WSW = 156 * MiB;
constexpr size_t WSW_STRIDE = 393216;
constexpr size_t WS_EXP1 = 160 * MiB;
constexpr size_t WS_EXP2 = 288 * MiB;
constexpr size_t WS_XB = 352 * MiB;
constexpr size_t WS_Z = 416 * MiB;
constexpr size_t WS_CAT = 592 * MiB;
constexpr size_t WS_HB = 656 * MiB;
constexpr size_t WS_LTOK = 720 * MiB;
constexpr size_t WS_LGATE = 722 * MiB;
constexpr size_t WS_LSLOT = 724 * MiB;
constexpr size_t WS_HE = 728 * MiB;
constexpr size_t WS_YS = 768 * MiB;
constexpr size_t WS_ACT = 896 * MiB;
constexpr size_t WS_LW = 944 * MiB;
constexpr size_t WS_GATE = 1040 * MiB;
constexpr size_t WS_SCAN = 1088 * MiB;
constexpr size_t WS_V = 1568 * MiB;
constexpr size_t WS_Y = 1664 * MiB;
constexpr size_t WS_GH = 1760 * MiB;
constexpr size_t WS_QY = 1088 * MiB;
constexpr size_t WS_Y0T = 1152 * MiB;
constexpr size_t WS_E = 1280 * MiB;
constexpr size_t WS_END = 1952 * MiB;
constexpr int CW_BAR = 4096;
constexpr int CW_CNT = 16384;

constexpr int LDS_BYTES = 147456;
constexpr int LDS_CTL_OFF = 146432;

DI float bf2f(unsigned b) { return __uint_as_float(b << 16); }
typedef float cvt_f32x2 __attribute__((ext_vector_type(2)));
typedef __bf16 cvt_bf16x2 __attribute__((ext_vector_type(2)));
DI unsigned cvt_pk_bf16(float lo, float hi) { const cvt_f32x2 v = {lo, hi}; return __builtin_bit_cast(unsigned, __builtin_convertvector(v, cvt_bf16x2)); }
DI float bflo(unsigned w) { return __uint_as_float(w << 16); }
DI float bfhi(unsigned w) { return __uint_as_float(w & 0xffff0000u); }
DI float wave_sum(float v) {
#pragma unroll
    for (int o = 1; o < 64; o <<= 1) v += __shfl_xor(v, o);
    return v;
}
DI float sum16(float v) {
    v += __builtin_bit_cast(float, __builtin_amdgcn_update_dpp(0, __builtin_bit_cast(int, v), 0x128, 0xf, 0xf, false));
    v += __builtin_bit_cast(float, __builtin_amdgcn_update_dpp(0, __builtin_bit_cast(int, v), 0x124, 0xf, 0xf, false));
    v += __builtin_bit_cast(float, __builtin_amdgcn_update_dpp(0, __builtin_bit_cast(int, v), 0x122, 0xf, 0xf, false));
    v += __builtin_bit_cast(float, __builtin_amdgcn_update_dpp(0, __builtin_bit_cast(int, v), 0x121, 0xf, 0xf, false));
    return v;
}
DI float fma_s(float a, float b, float c) { float d; asm("v_fma_f32 %0, %1, %2, %3" : "=v"(d) : "v"(a), "v"(b), "v"(c)); return d; }
DI float sigmoidf_(float x) { return __builtin_amdgcn_rcpf(1.f + __expf(-x)); }
DI float softplusf_(float x) { return fmaxf(x, 0.f) + __logf(1.f + __expf(-fabsf(x))); }
#define LDS_WAIT() asm volatile("s_waitcnt lgkmcnt(0)" ::: "memory")
#define VM_WAIT() asm volatile("s_waitcnt vmcnt(0)" ::: "memory")
#define LDS_BARRIER() do { asm volatile("s_waitcnt lgkmcnt(0)" ::: "memory"); __builtin_amdgcn_s_barrier(); asm volatile("" ::: "memory"); } while (0)

template <class T> DI T* as_global(T* p) { return p; }
DI const float* kin_ptr(int i) { int off = i * 8; asm volatile("" : "+v"(off)); const char* ka = (const char*)__builtin_amdgcn_kernarg_segment_ptr();
    const unsigned long long p = *(const unsigned long long*)(ka + off);
    const unsigned lo = __builtin_amdgcn_readfirstlane((unsigned)p), hi = __builtin_amdgcn_readfirstlane((unsigned)(p >> 32));
    return as_global((const float*)(((unsigned long long)hi << 32) | lo)); }
#define PIN(i) kin_ptr(i)
DI unsigned char* opq(unsigned char* p) { asm volatile("" : "+s"(p)); return p; }
DI float* opqf(float* p) { asm volatile("" : "+s"(p)); return p; }

#define XB_TMO      128
#define XB_XCNT(j)  (256  + 64 * (j))
#define XB_XSUB(j)  (1280 + 64 * (j))
#define XB_XGEN(j)  (2304 + 64 * (j))
#define XB_TOP      3328
#define XB_TOPGEN   3392
#define XCD_BAR_WORDS 3456
#define XB_SPIN_CAP (1u << 20)

__device__ __forceinline__ unsigned xb_ld(unsigned* p)              { return __hip_atomic_load(p, __ATOMIC_RELAXED, __HIP_MEMORY_SCOPE_AGENT); }
__device__ __forceinline__ unsigned xb_add(unsigned* p, unsigned v) { return __hip_atomic_fetch_add(p, v, __ATOMIC_RELAXED, __HIP_MEMORY_SCOPE_AGENT); }
__device__ __forceinline__ unsigned xb_xcc_id() { return (unsigned)__builtin_amdgcn_s_getreg((3 << 11) | 20) & 0xFu; }
#define XB_SPIN(cond, bar) do { unsigned _sp = 0; while (cond) { __builtin_amdgcn_s_sleep(1); \
    if ((++_sp & 255u) == 0u) { if (xb_ld(&(bar)[XB_TMO])) break; if (_sp > XB_SPIN_CAP) { atomicAdd(&(bar)[XB_TMO], 1u); break; } } } } while (0)

struct XcdBarrier { unsigned* bar; unsigned x; volatile LAS unsigned* st; };

__device__ __forceinline__ XcdBarrier xcd_barrier_post(unsigned* bar, volatile LAS unsigned* st) {
    XcdBarrier b; b.bar = bar; b.x = xb_xcc_id(); b.st = st;
    if (threadIdx.x == 0) (void)xb_add(&bar[XB_XCNT(b.x)], 1u);
    return b;
}
__device__ __forceinline__ void xcd_barrier_complete(unsigned* bar, unsigned x, unsigned& nloc, unsigned& nx) {
    const unsigned G = gridDim.x * gridDim.y * gridDim.z;
    unsigned sum, cnt, mine, sp = 0u;
    for (;;) {
        sum = 0u; cnt = 0u; mine = 0u;
#pragma unroll
        for (unsigned j = 0; j < 16; ++j) { const unsigned c = xb_ld(&bar[XB_XCNT(j)]); sum += c; cnt += (c > 0u) ? 1u : 0u; mine = (j == x) ? c : mine; }
        if (sum == G) break;
        __builtin_amdgcn_s_sleep(1);
        if ((++sp & 255u) == 0u) { if (xb_ld(&bar[XB_TMO])) break; if (sp > XB_SPIN_CAP) { atomicAdd(&bar[XB_TMO], 1u); break; } }
    }
    nloc = mine > 0u ? mine : 1u; nx = cnt > 0u ? cnt : 1u;
}
__device__ __forceinline__ void xcd_barrier(const XcdBarrier& b) {
    asm volatile("s_waitcnt vmcnt(0)" ::: "memory");
    __syncthreads();
    if (threadIdx.x == 0) {
        unsigned* bar = b.bar;
        __builtin_amdgcn_s_waitcnt(0);
        unsigned nloc = b.st[0], nx = b.st[1];
        if (nloc == 0u) { xcd_barrier_complete(bar, b.x, nloc, nx); b.st[0] = nloc; b.st[1] = nx; }
        const unsigned old = xb_add(&bar[XB_XSUB(b.x)], 1u);
        const unsigned gen = old / nloc;
        if (old + 1u == (gen + 1u) * nloc) {
            __builtin_amdgcn_fence(__ATOMIC_RELEASE, "agent");
            asm volatile("s_waitcnt vmcnt(0)" ::: "memory");
            const unsigned og = xb_add(&bar[XB_TOP], 1u);
            const unsigned tg = og / nx;
            if (og + 1u == (tg + 1u) * nx) xb_add(&bar[XB_TOPGEN], 1u);
            else XB_SPIN(xb_ld(&bar[XB_TOPGEN]) == tg, bar);
            __builtin_amdgcn_fence(__ATOMIC_ACQUIRE, "agent");
            xb_add(&bar[XB_XGEN(b.x)], 1u);
            asm volatile("s_waitcnt vmcnt(0)" ::: "memory");
        } else {
            XB_SPIN(xb_ld(&bar[XB_XGEN(b.x)]) == gen, bar);
            __builtin_amdgcn_fence(__ATOMIC_ACQUIRE, "agent");
            asm volatile("s_waitcnt vmcnt(0)" ::: "memory");
        }
    }
    __syncthreads();
}

namespace pg8 {
constexpr int BM = 256, BK = 64, HALF = 128, HTB = HALF * BK * 2, STAGE_BYTES = 8 * HTB, NXCD = 8, WGM = 8;
DI int lds_byte(int r, int c) { const int st = (r >> 4) * 2 + (c >> 5), rr = r & 15, cc = c & 31, ob = rr * 64 + cc * 2; return st * 1024 + (ob ^ (((ob >> 9) & 1) << 5)); }
DI void stage_rc(int b, int& R, int& C) { const int st = b / 1024, sb = b % 1024, swz = sb ^ (((sb >> 9) & 1) << 5); R = (st >> 1) * 16 + swz / 64; C = (st & 1) * 32 + (swz % 64) / 2; }
DI int perm32(int rho) { const int n = rho >> 4, i = rho & 15; return 8 * (i >> 2) + 4 * n + (i & 3); }

struct Unit { int pm, pn, e, rt; };
struct Gemm { const bf16_t* A; const bf16_t* Bt; int lda, ldb, K; };

struct StaticOrder {
    static constexpr bool GATHER = false;
    int nM, nN, nwg, G, c;
    DI void init(int M, int N, int G_, int c_) { nM = M / BM; nN = N / BM; nwg = nM * nN; G = G_; c = c_; }
    DI bool next(int i, Unit& u) const {
        const long L = (long)i * G + c; if (L >= nwg) return false;
        int wgid = (int)L; { const int q = nwg / NXCD, r = nwg % NXCD, xcd = wgid % NXCD, off = wgid / NXCD; wgid = (xcd < r ? xcd * (q + 1) : r * (q + 1) + (xcd - r) * q) + off; }
        const int nig = WGM * nN, gid = wgid / nig, fm = gid * WGM, gsz = (nM - fm) < WGM ? (nM - fm) : WGM;
        u.pm = fm + ((wgid % nig) % gsz); u.pn = (wgid % nig) / gsz; u.e = 0; u.rt = 0; return true;
    }
    DI const char* a_base(const Gemm& g, const Unit& u) const { return (const char*)g.A + (size_t)u.pm * BM * g.lda * 2; }
    DI const char* b_base(const Gemm& g, const Unit& u) const { return (const char*)g.Bt + (size_t)u.pn * BM * g.ldb * 2; }
    DI unsigned gather_voff(const Unit&, int, int, int) const { return 0u; }
};

template <bool GATH> struct MoeOrder {
    static constexpr bool GATHER = GATH;
    int G, c, npn, total; const LAS int* tb; size_t estride; const int* ltok; const unsigned* cnt;
    DI bool next(int i, Unit& u) const {
        if ((G & 7) == 0) {
            const int x = c & 7, r = c >> 3, W = G >> 3, idx = i * W + r;
            const int q = idx / npn, pn = idx - q * npn; int base = 0;
#pragma unroll
            for (int k = 0; k < 4; ++k) { const int e = x + 8 * k, nt = tb[e + 1] - tb[e];
                if (q < base + nt) { u.e = e; u.rt = q - base; u.pm = tb[e] + u.rt; u.pn = pn; return true; }
                base += nt; }
            return false;
        }
        const int L = i * G + c; if (L >= total) return false;
        const int q = L / npn; u.pn = L - q * npn; u.pm = q;
        int e = 0; while (e < NEXP - 1 && tb[e + 1] <= q) ++e;
        u.e = e; u.rt = q - tb[e]; return true;
    }
    DI const char* a_base(const Gemm& g, const Unit& u) const { return (const char*)g.A + (size_t)u.pm * BM * g.lda * 2; }
    DI const char* b_base(const Gemm& g, const Unit& u) const { return (const char*)g.Bt + (size_t)u.e * estride + (size_t)u.pn * BM * g.ldb * 2; }
    DI unsigned gather_voff(const Unit& u, int r, int C, int lda) const {
        const int pos = u.rt * BM + r; const int n = (int)__hip_atomic_load(cnt + u.e * 64, __ATOMIC_RELAXED, __HIP_MEMORY_SCOPE_AGENT);
        const int tok = pos < n ? ltok[u.e * LISTCAP + pos] : 0;
        return (unsigned)(tok * lda + C) * 2u;
    }
};

struct EpiStore {
    bf16_t* O; int ldc;
    DI void operator()(const f32x4 (&acc)[2][2][4][2], const Unit& u, int wr, int wc, int fr, int fq) const {
        const int row0 = u.pm * BM + wr * 64 + fr, col0 = u.pn * BM + wc * 32 + 8 * fq;
#pragma unroll
        for (int ai = 0; ai < 2; ++ai)
#pragma unroll
            for (int m = 0; m < 4; ++m) { bf16_t* rowp = O + (size_t)(row0 + ai * HALF + m * 16) * ldc + col0;
#pragma unroll
                for (int bj = 0; bj < 2; ++bj) { const f32x4 v0 = acc[ai][bj][m][0], v1 = acc[ai][bj][m][1];
                    u32x4 w; w.x = cvt_pk_bf16(v0[0], v0[1]); w.y = cvt_pk_bf16(v0[2], v0[3]); w.z = cvt_pk_bf16(v1[0], v1[1]); w.w = cvt_pk_bf16(v1[2], v1[3]);
                    *(GAS u32x4*)(rowp + bj * HALF) = w; } }
    }
};
struct EpiSwiGLU {
    bf16_t* H;
    DI void operator()(const f32x4 (&acc)[2][2][4][2], const Unit& u, int wr, int wc, int fr, int fq) const {
        const int row0 = u.pm * BM + wr * 64 + fr, col0 = u.pn * HALF + wc * 32 + 8 * fq;
#pragma unroll
        for (int ai = 0; ai < 2; ++ai)
#pragma unroll
            for (int m = 0; m < 4; ++m) { bf16_t* rowp = H + (size_t)(row0 + ai * HALF + m * 16) * DEXP + col0;
                float h[8];
#pragma unroll
                for (int n = 0; n < 2; ++n)
#pragma unroll
                    for (int j = 0; j < 4; ++j) { const float gt = acc[ai][0][m][n][j], up = acc[ai][1][m][n][j]; h[n * 4 + j] = gt * __builtin_amdgcn_rcpf(1.f + __expf(-gt)) * up; }
                u32x4 w; w.x = cvt_pk_bf16(h[0], h[1]); w.y = cvt_pk_bf16(h[2], h[3]); w.z = cvt_pk_bf16(h[4], h[5]); w.w = cvt_pk_bf16(h[6], h[7]);
                *(GAS u32x4*)rowp = w; }
    }
};
struct EpiScatter {
    bf16_t* YS; const int* lslot; const float* lgate; const unsigned* cnt;
    DI void operator()(const f32x4 (&acc)[2][2][4][2], const Unit& u, int wr, int wc, int fr, int fq) const {
        const int n = (int)__hip_atomic_load(cnt + u.e * 64, __ATOMIC_RELAXED, __HIP_MEMORY_SCOPE_AGENT);
        const int col0 = u.pn * BM + wc * 32 + 8 * fq;
#pragma unroll
        for (int ai = 0; ai < 2; ++ai)
#pragma unroll
            for (int m = 0; m < 4; ++m) { const int pos = u.rt * BM + ai * HALF + wr * 64 + m * 16 + fr;
                if (pos < n) { const int slot = lslot[u.e * LISTCAP + pos]; const float gt = lgate[u.e * LISTCAP + pos];
                    bf16_t* rowp = YS + (size_t)slot * DM + col0;
#pragma unroll
                    for (int bj = 0; bj < 2; ++bj) { const f32x4 v0 = acc[ai][bj][m][0] * gt, v1 = acc[ai][bj][m][1] * gt;
                        u32x4 w; w.x = cvt_pk_bf16(v0[0], v0[1]); w.y = cvt_pk_bf16(v0[2], v0[3]); w.z = cvt_pk_bf16(v1[0], v1[1]); w.w = cvt_pk_bf16(v1[2], v1[3]);
                        *(GAS u32x4*)(rowp + bj * HALF) = w; } } }
    }
};

template <class Epi, class Sched>
DI void gemm_phase(LAS unsigned char* lds, const Gemm g, const Sched& S, const Epi& E) {
    int tid = threadIdx.x; asm volatile("" : "+v"(tid));
    const int wid = __builtin_amdgcn_readfirstlane(tid >> 6), lane = tid & 63, wr = wid >> 2, wc = wid & 3, fr = lane & 15, fq = lane >> 4;
    const int K = g.K, nt = K / BK;
    unsigned voffA[2], voffB[2];
#pragma unroll
    for (int i = 0; i < 2; ++i) { int R, C; stage_rc(tid * 16 + i * 8192, R, C); const int Rb = (R & ~31) + perm32(R & 31);
        voffA[i] = (unsigned)(R * g.lda + C) * 2u; voffB[i] = (unsigned)(Rb * g.ldb + C) * 2u; }
    const size_t kstep = (size_t)(BK * 2);
    const size_t hstepA = (size_t)HALF * g.lda * 2, hstepB = (size_t)HALF * g.ldb * 2;
    const unsigned ldsw = (unsigned)wid * 1024u;
    const int aoff = lds_byte(wr * 64 + fr, fq * 8), boff = lds_byte(wc * 32 + fr, fq * 8);
    unsigned gvC[2][2], gvN[2][2];
#define PG8_SA(b, h) (((b) * 2 + (h)) * HTB)
#define PG8_SB(b, h) ((4 + (b) * 2 + (h)) * HTB)
#define PG8_STAGE(bufoff, gbase, voff) do { _Pragma("unroll") for (int _i = 0; _i < 2; ++_i) \
        __builtin_amdgcn_global_load_lds((const unsigned*)((const char*)(gbase) + (voff)[_i]), (LAS unsigned*)(lds + (bufoff) + ldsw + _i * 8192), 16, 0, 0); } while (0)
#define PG8_STAGE_A(bufoff, h, nxtsel, kt) do { \
        if constexpr (Sched::GATHER) { const char* _gb = (const char*)g.A + (size_t)(kt) * kstep; unsigned _vo[2]; _vo[0] = (nxtsel) ? gvN[h][0] : gvC[h][0]; _vo[1] = (nxtsel) ? gvN[h][1] : gvC[h][1]; PG8_STAGE(bufoff, _gb, _vo); } \
        else { const char* _gb = ((nxtsel) ? nA : cA) + (size_t)(h) * hstepA + (size_t)(kt) * kstep; PG8_STAGE(bufoff, _gb, voffA); } } while (0)
#define PG8_GSETUP(dst, u) do { if constexpr (Sched::GATHER) { _Pragma("unroll") for (int _h = 0; _h < 2; ++_h) _Pragma("unroll") for (int _i = 0; _i < 2; ++_i) { int _R, _C; stage_rc(tid * 16 + _i * 8192, _R, _C); \
        dst[_h][_i] = S.gather_voff(u, _h * HALF + _R, _C, g.lda); } asm volatile("s_waitcnt vmcnt(0)" : "+v"(dst[0][0]), "+v"(dst[0][1]), "+v"(dst[1][0]), "+v"(dst[1][1]) :: "memory"); } } while (0)
#define PG8_LDA(dst, b, h) do { _Pragma("unroll") for (int m = 0; m < 4; ++m) _Pragma("unroll") for (int k = 0; k < 2; ++k) dst[m][k] = *(const LAS bf16x8*)(lds + PG8_SA(b, h) + aoff + m * 2048 + k * 1024); } while (0)
#define PG8_LDB(dst, b, h) do { _Pragma("unroll") for (int n = 0; n < 2; ++n) _Pragma("unroll") for (int k = 0; k < 2; ++k) dst[n][k] = *(const LAS bf16x8*)(lds + PG8_SB(b, h) + boff + n * 2048 + k * 1024); } while (0)
#define PG8_MMA(ai, bj, At, Bt) do { __builtin_amdgcn_s_setprio(1); _Pragma("unroll") for (int m = 0; m < 4; ++m) _Pragma("unroll") for (int n = 0; n < 2; ++n) _Pragma("unroll") for (int k = 0; k < 2; ++k) \
        acc[ai][bj][m][n] = __builtin_amdgcn_mfma_f32_16x16x32_bf16(Bt[n][k], At[m][k], acc[ai][bj][m][n], 0, 0, 0); __builtin_amdgcn_s_setprio(0); } while (0)
#define PG8_WAIT_V(n) asm volatile("s_waitcnt vmcnt(" #n ")" ::: "memory")
#define PG8_WAIT_L(n) asm volatile("s_waitcnt lgkmcnt(" #n ")" ::: "memory")
#define PG8_BAR __builtin_amdgcn_s_barrier()
#define PG8_SCHED __builtin_amdgcn_sched_barrier(0)
    Unit cur, nxt; int ui = 0;
    if (!S.next(0, cur)) return;
    f32x4 acc[2][2][4][2];
#pragma unroll
    for (int a = 0; a < 2; ++a)
#pragma unroll
        for (int b = 0; b < 2; ++b)
#pragma unroll
            for (int m = 0; m < 4; ++m)
#pragma unroll
                for (int n = 0; n < 2; ++n) acc[a][b][m][n] = (f32x4){0.f, 0.f, 0.f, 0.f};
    bf16x8 At[4][2], B0[2][2], B1[2][2];
    const char* cA = S.a_base(g, cur); const char* cB = S.b_base(g, cur);
    const char* nA = cA;
    PG8_GSETUP(gvC, cur);
    PG8_STAGE(PG8_SB(0, 0), cB, voffB); PG8_STAGE_A(PG8_SA(0, 0), 0, false, 0); PG8_STAGE(PG8_SB(0, 1), cB + hstepB, voffB); PG8_STAGE_A(PG8_SA(0, 1), 1, false, 0);
    if (wr == 1) PG8_BAR;
    PG8_WAIT_V(4); PG8_BAR;
    PG8_STAGE(PG8_SB(1, 0), cB + kstep, voffB); PG8_STAGE_A(PG8_SA(1, 0), 0, false, 1); PG8_STAGE(PG8_SB(1, 1), cB + hstepB + kstep, voffB);
    PG8_WAIT_V(6); PG8_BAR;
    for (;;) {
        const bool has_next = S.next(ui + 1, nxt);
        nA = has_next ? S.a_base(g, nxt) : cA; const char* nB = has_next ? S.b_base(g, nxt) : cB;
        if constexpr (Sched::GATHER) { if (has_next) { PG8_GSETUP(gvN, nxt); } else {
#pragma unroll
            for (int _h = 0; _h < 2; ++_h) { gvN[_h][0] = gvC[_h][0]; gvN[_h][1] = gvC[_h][1]; } } }
        for (int t = 0; t < nt; t += 2) {
            const bool last = (t == nt - 2);
            const int kt2 = last ? 0 : t + 2;
            const char* b2 = last ? nB : cB + (size_t)(t + 2) * kstep;
            const char* b3 = b2 + kstep;
            PG8_LDB(B0, 0, 0); PG8_SCHED; PG8_LDA(At, 0, 0); PG8_STAGE_A(PG8_SA(1, 1), 1, false, t + 1);
            PG8_WAIT_L(8); PG8_BAR; PG8_WAIT_L(0); PG8_MMA(0, 0, At, B0); PG8_BAR; PG8_SCHED;
            PG8_LDB(B1, 0, 1); PG8_STAGE(PG8_SB(0, 0), b2, voffB);
            PG8_BAR; PG8_WAIT_L(0); PG8_MMA(0, 1, At, B1); PG8_BAR;
            PG8_LDA(At, 0, 1); PG8_STAGE_A(PG8_SA(0, 0), 0, last, kt2);
            PG8_BAR; PG8_WAIT_L(0); PG8_MMA(1, 0, At, B0); PG8_BAR; PG8_SCHED;
            PG8_STAGE(PG8_SB(0, 1), b2 + hstepB, voffB);
            PG8_WAIT_V(6); PG8_BAR; PG8_MMA(1, 1, At, B1); PG8_BAR;
            PG8_LDB(B0, 1, 0); PG8_SCHED; PG8_LDA(At, 1, 0); PG8_STAGE_A(PG8_SA(0, 1), 1, last, kt2);
            PG8_WAIT_L(8); PG8_BAR; PG8_WAIT_L(0); PG8_MMA(0, 0, At, B0); PG8_BAR; PG8_SCHED;
            PG8_LDB(B1, 1, 1); PG8_STAGE(PG8_SB(1, 0), b3, voffB);
            PG8_BAR; PG8_WAIT_L(0); PG8_MMA(0, 1, At, B1); PG8_BAR;
            PG8_LDA(At, 1, 1); PG8_STAGE_A(PG8_SA(1, 0), 0, last, kt2 + 1);
            PG8_BAR; PG8_WAIT_L(0); PG8_MMA(1, 0, At, B0); PG8_BAR; PG8_SCHED;
            PG8_STAGE(PG8_SB(1, 1), b3 + hstepB, voffB);
            PG8_WAIT_V(6); PG8_BAR; PG8_MMA(1, 1, At, B1); PG8_BAR;
        }
        E(acc, cur, wr, wc, fr, fq);
        if (!has_next) break;
#pragma unroll
        for (int a = 0; a < 2; ++a)
#pragma unroll
            for (int b = 0; b < 2; ++b)
#pragma unroll
                for (int m = 0; m < 4; ++m)
#pragma unroll
                    for (int n = 0; n < 2; ++n) acc[a][b][m][n] = (f32x4){0.f, 0.f, 0.f, 0.f};
        cur = nxt; cA = nA; cB = nB; ++ui;
        if constexpr (Sched::GATHER) {
#pragma unroll
            for (int _h = 0; _h < 2; ++_h) { gvC[_h][0] = gvN[_h][0]; gvC[_h][1] = gvN[_h][1]; } }
    }
    PG8_WAIT_V(0);
    if (wr == 0) PG8_BAR;
    PG8_BAR;
#undef PG8_SA
#undef PG8_SB
#undef PG8_STAGE
#undef PG8_STAGE_A
#undef PG8_GSETUP
#undef PG8_LDA
#undef PG8_LDB
#undef PG8_MMA
#undef PG8_WAIT_V
#undef PG8_WAIT_L
#undef PG8_BAR
#undef PG8_SCHED
}
}

struct Params { const float* in[31]; float* out; unsigned char* ws; int ph_lo, ph_hi; };

struct Ctx {
    LAS unsigned char* lds;
    int tid, lane, wave, G, bid, gw, ngw;
    unsigned char* ws; float* out;
};
DI Ctx relaunder(const Ctx& F0) {
    Ctx F = F0;
    asm volatile("" : "+v"(F.tid), "+v"(F.lane));
    asm volatile("" : "+s"(F.wave), "+s"(F.G), "+s"(F.bid), "+s"(F.gw), "+s"(F.ngw));
    asm volatile("" : "+s"(F.ws), "+s"(F.out));
    F.ws = as_global(F.ws); F.out = as_global(F.out);
    return F;
}

DI void dense_gemm(const Ctx& F, const bf16_t* A, int lda, const bf16_t* Bt, int ldb, int M, int N, int K, bf16_t* O, int ldc, int crot) {
    pg8::Gemm g{A, Bt, lda, ldb, K}; pg8::StaticOrder S; S.init(M, N, F.G, (F.bid + crot) % F.G);
    pg8::EpiStore E{O, ldc};
    for (int rep = 0; rep < REP_GEMM; ++rep) pg8::gemm_phase<pg8::EpiStore, pg8::StaticOrder>(F.lds, g, S, E);
}

struct TJob { const float* src; bf16_t* dst; int ldw, dld; };
DI void tr_load(const TJob& j, f32x4 (&r)[16], int lane) {
    const GAS float* p = (const GAS float*)(j.src + (size_t)(lane >> 4) * j.ldw + 4 * (lane & 15));
#pragma unroll
    for (int i = 0; i < 16; ++i) r[i] = *(const GAS f32x4*)(p + (size_t)(4 * i) * j.ldw);
}
DI void tr_store(const TJob& j, const f32x4 (&r)[16], LAS unsigned char* scr, int lane) {
#pragma unroll
    for (int i = 0; i < 16; ++i) { LAS unsigned* w = (LAS unsigned*)(scr + ((lane >> 4) + 4 * i) * 132 + (lane & 15) * 8); w[0] = cvt_pk_bf16(r[i].x, r[i].y); w[1] = cvt_pk_bf16(r[i].z, r[i].w); }
    LDS_WAIT();
    const int kc = lane & 7;
#pragma unroll
    for (int sgrp = 0; sgrp < 8; ++sgrp) { const int n = 8 * sgrp + (lane >> 3); const LAS unsigned short* c = (const LAS unsigned short*)(scr + (8 * kc) * 132 + n * 2);
        u32x4 o; o.x = (unsigned)c[0] | ((unsigned)c[66] << 16); o.y = (unsigned)c[2 * 66] | ((unsigned)c[3 * 66] << 16); o.z = (unsigned)c[4 * 66] | ((unsigned)c[5 * 66] << 16); o.w = (unsigned)c[6 * 66] | ((unsigned)c[7 * 66] << 16);
        *(GAS u32x4*)(j.dst + (size_t)n * j.dld + 8 * kc) = o; }
    LDS_WAIT();
}
template <class Dec> DI void tr_run(const Dec& D, int first, int count, int stride, LAS unsigned char* scr, int lane) {
    f32x4 A[16], B[16]; TJob ja, jb;
    int it = first; if (it >= count) return;
    ja = D(it); tr_load(ja, A, lane);
    for (;;) {
        const int it2 = it + stride; const bool h2 = it2 < count; if (h2) { jb = D(it2); tr_load(jb, B, lane); }
        tr_store(ja, A, scr, lane);
        if (!h2) break;
        const int it3 = it2 + stride; const bool h3 = it3 < count; if (h3) { ja = D(it3); tr_load(ja, A, lane); }
        tr_store(jb, B, scr, lane);
        if (!h3) break;
        it = it3;
    }
}
DI TJob mat_job(const float* W, int K, int N, bf16_t* WT, int item) {
    const int nblk = N / 64, kb = item / nblk, nb = item - kb * nblk;
    TJob j; j.src = W + (size_t)(64 * kb) * N + 64 * nb; j.dst = WT + (size_t)(64 * nb) * K + 64 * kb; j.ldw = N; j.dld = K; return j;
}
DI void row_to_bf16(const float* src, bf16_t* dst, int lane) {
    const GAS f32x4* s = (const GAS f32x4*)src + lane; GAS u32x2* o = (GAS u32x2*)dst + lane;
#pragma unroll
    for (int j = 0; j < 8; ++j) { const f32x4 v = s[64 * j]; u32x2 w; w.x = cvt_pk_bf16(v.x, v.y); w.y = cvt_pk_bf16(v.z, v.w); o[64 * j] = w; }
}

DI void phase_prologue(const Ctx& F, const Params& P) {
    unsigned char* const wsl = F.ws; float* const outl = F.out; (void)outl;
    LAS unsigned char* scr = F.lds + F.wave * 16384;
    unsigned char* ws = wsl;
    constexpr int I_RW = 32 * (RW_IN_COLS / 64), I_OT = 32 * (ZW_OTH / 64), I_WO = 32 * 32, I_KV = 32 * 8;
    constexpr int N_A = 2 * I_RW + 2 * I_OT, N_B = 4 * I_WO, N_C = 8 * I_KV, N_D = NTOK + NBATCH * MEML;
    struct ProDec { unsigned char* ws;
        DI TJob operator()(int it) const { int r = it;
            if (r < N_A) {
                if (r < I_RW) return mat_job(PIN(16), DM, RW_IN_COLS, (bf16_t*)(ws + WS_WIN), r); r -= I_RW;
                if (r < I_OT) return mat_job(PIN(28), DM, ZW_OTH, (bf16_t*)(ws + WS_WIN + WIN_STRIDE), r); r -= I_OT;
                if (r < I_OT) return mat_job(PIN(30), DM, ZW_OTH, (bf16_t*)(ws + WS_WIN + 2 * WIN_STRIDE), r); r -= I_OT;
                return mat_job(PIN(16) + (size_t)DM * RW_IN_COLS, DM, RW_IN_COLS, (bf16_t*)(ws + WS_WIN + 3 * WIN_STRIDE), r);
            }
            r -= N_A;
            if (r < N_B) { const int l = r / I_WO; return mat_job(PIN(2) + (size_t)l * DM * DM, DM, DM, (bf16_t*)(ws + WS_WOUT) + (size_t)l * DM * DM, r - l * I_WO); }
            r -= N_B;
            const int m = r / I_KV, l = m & 3; const bool isv = m >= 4;
            return mat_job(PIN(isv ? 4 : 3) + (size_t)l * DM * MEMW, DM, MEMW, (bf16_t*)(ws + (isv ? WS_WV : WS_WK)) + (size_t)l * MEMW * DM, r - m * I_KV);
        } };
    ProDec PD{ws};
    tr_run(PD, F.gw, N_A + N_B + N_C, F.ngw, scr, F.lane);
    for (int r = F.gw; r < N_D; r += F.ngw) {
        if (r < NTOK) row_to_bf16(PIN(0) + (size_t)r * DM, (bf16_t*)(ws + WS_XB) + (size_t)r * DM, F.lane);
        else row_to_bf16(PIN(1) + (size_t)(r - NTOK) * DM, (bf16_t*)(ws + WS_MEMB) + (size_t)(r - NTOK) * DM, F.lane);
    }
    const int gt = F.bid * NT + F.tid, ngt = F.G * NT;
    for (int idx = gt; idx < 2 * (3072 + 1536) * 256; idx += ngt) {
        const int j = idx / ((3072 + 1536) * 256); int r = idx - j * (3072 + 1536) * 256;
        bf16_t* base = (bf16_t*)(ws + WS_LORA + (size_t)j * LORA_STRIDE);
        const int n = r >> 8, k = r & 255; float v = 0.f;
        if (n < 1536) { if (k < 96) v = PIN(19)[((size_t)j * 96 + k) * CMIX + n]; }
        else if (n < 3072) { if (k >= 96 && k < 192) v = PIN(21)[((size_t)j * 96 + (k - 96)) * CMIX + (n - 1536)]; }
        else v = PIN(22)[((size_t)j * 256 + k) * CMIX + (n - 3072)];
        base[r] = (bf16_t)(cvt_pk_bf16(v, 0.f) & 0xffffu);
    }
    for (int idx = gt; idx < 2 * 64 * DM; idx += ngt) { const int j = idx / (64 * DM), r = idx - j * 64 * DM;
        ((bf16_t*)(ws + WS_WIN + (size_t)(j ? 3 : 0) * WIN_STRIDE))[(size_t)RW_IN_COLS * DM + r] = 0; }
    for (int idx = gt; idx < NLAYER * 48 * DM; idx += ngt) {
        const int l = idx / (48 * DM); int r = idx - l * 48 * DM; const int n = r / DM, k = r - n * DM;
        float v = 0.f;
        if (n < 4) v = PIN(9)[((size_t)l * DM + k) * 4 + n]; else if (n < 36) v = PIN(11)[((size_t)l * DM + k) * 32 + (n - 4)];
        const unsigned hi = cvt_pk_bf16(v, 0.f) & 0xffffu; const float rem = v - bf2f(hi); const unsigned lo = cvt_pk_bf16(rem, 0.f) & 0xffffu;
        bf16_t* base = (bf16_t*)(ws + WS_WSW + (size_t)l * WSW_STRIDE);
        base[r] = (bf16_t)hi; base[48 * DM + r] = (bf16_t)lo;
    }
}

DI void expert_convert(const Ctx& F, const Params& P, int l, int w, int nw) {
    unsigned char* const wsl = F.ws;
    LAS unsigned char* scr = F.lds + F.wave * 16384;
    constexpr int I_GU = NEXP * 32 * 8 * 2, I_DN = NEXP * 8 * 32;
    struct ExpDec { unsigned char* ws; int l;
        DI TJob operator()(int it) const { TJob j;
            if (it < I_GU) {
                const int isup = it / (I_GU / 2); int r = it - isup * (I_GU / 2);
                const int e = r / 256; r -= e * 256; const int kb = r >> 3, nb = r & 7;
                const float* W = PIN(isup ? 14 : 13) + ((size_t)l * NEXP + e) * DM * DEXP;
                const int n0 = 64 * nb, drow = 256 * (n0 >> 7) + (isup ? 128 : 0) + (n0 & 127);
                j.src = W + (size_t)(64 * kb) * DEXP + n0; j.ldw = DEXP; j.dst = (bf16_t*)(ws + WS_EXP1) + ((size_t)e * 1024 + drow) * DM + 64 * kb; j.dld = DM;
            } else {
                int r = it - I_GU; const int e = r / 256; r -= e * 256; const int kb = r >> 5, nb = r & 31;
                const float* W = PIN(15) + ((size_t)l * NEXP + e) * DEXP * DM;
                j.src = W + (size_t)(64 * kb) * DM + 64 * nb; j.ldw = DM; j.dst = (bf16_t*)(ws + WS_EXP2) + ((size_t)e * DM + 64 * nb) * DEXP + 64 * kb; j.dld = DEXP;
            }
            return j; } };
    ExpDec ED{wsl, l};
    tr_run(ED, w, I_GU + I_DN, nw, scr, F.lane);
}

DI void memattn_unit(const Ctx& F, int l, int unit, const bf16_t* z, int zw, int qcol) {
    unsigned char* const wsl = F.ws; float* const outl = F.out; (void)outl;
    const int b = unit >> 6, head = (unit >> 4) & 3, qblk = unit & 15;
    LAS unsigned char* Ks = F.lds; LAS unsigned char* Vs = F.lds + 69632;
    const bf16_t* Km = (const bf16_t*)(wsl + WS_KM); const bf16_t* VmT = (const bf16_t*)(wsl + WS_VMT);
    bf16_t* cat = (bf16_t*)(wsl + WS_CAT);
    __syncthreads();
#pragma unroll
    for (int h = 0; h < 2; ++h) {
        u32x4 kv[4], vv[4];
#pragma unroll
        for (int i = 0; i < 4; ++i) { const int ch = F.tid + NT * (4 * h + i);
            { const int row = ch >> 4, c16 = ch & 15; kv[i] = *(const GAS u32x4*)(Km + (size_t)(b * MEML + row) * 2048 + l * 512 + head * 128 + c16 * 8); }
            { const int d = ch >> 5, c = ch & 31; vv[i] = *(const GAS u32x4*)(VmT + (size_t)(l * 512 + head * 128 + d) * 1024 + b * MEML + c * 8); } }
#pragma unroll
        for (int i = 0; i < 4; ++i) { const int ch = F.tid + NT * (4 * h + i);
            { const int row = ch >> 4, c16 = ch & 15; *(LAS u32x4*)(Ks + row * 272 + c16 * 16) = kv[i]; }
            { const int d = ch >> 5, c = ch & 31; *(LAS u32x4*)(Vs + d * 528 + c * 16) = vv[i]; } }
        asm volatile("" ::: "memory");
    }
    __syncthreads();
    int lane = F.lane; asm volatile("" : "+v"(lane) :: "memory");
    const int fr = lane & 15, fq = lane >> 4;
    for (int itq = 0; itq < 2; ++itq) {
        asm volatile("" : "+v"(lane) :: "memory");
        const int q0 = qblk * 256 + itq * 128 + F.wave * 16, tok0 = b * SEQ + q0;
        bf16x8 Qf[4];
#pragma unroll
        for (int ks = 0; ks < 4; ++ks) Qf[ks] = *(const GAS bf16x8*)(z + (size_t)(tok0 + (lane & 15)) * zw + qcol + head * 128 + ks * 32 + (lane >> 4) * 8);
        f32x4 acc[16];
#pragma unroll
        for (int t = 0; t < 16; ++t) { acc[t] = (f32x4){0.f, 0.f, 0.f, 0.f};
#pragma unroll
            for (int ks = 0; ks < 4; ++ks) { const bf16x8 kf = *(const LAS bf16x8*)(Ks + (16 * t + fr) * 272 + ks * 64 + fq * 16);
                acc[t] = __builtin_amdgcn_mfma_f32_16x16x32_bf16(kf, Qf[ks], acc[t], 0, 0, 0); } }
        const float sc = 0.08838834764831845f;
        float mx = -3.0e38f;
#pragma unroll
        for (int t = 0; t < 16; ++t)
#pragma unroll
            for (int j = 0; j < 4; ++j) { acc[t][j] *= sc; mx = fmaxf(mx, acc[t][j]); }
        mx = fmaxf(mx, __shfl_xor(mx, 16)); mx = fmaxf(mx, __shfl_xor(mx, 32));
        float sum = 0.f;
#pragma unroll
        for (int t = 0; t < 16; ++t)
#pragma unroll
            for (int j = 0; j < 4; ++j) { acc[t][j] = __expf(acc[t][j] - mx); sum += acc[t][j]; }
        sum += __shfl_xor(sum, 16); sum += __shfl_xor(sum, 32);
        const float inv = 1.f / sum;
        f32x4 o[8];
#pragma unroll
        for (int dt = 0; dt < 8; ++dt) o[dt] = (f32x4){0.f, 0.f, 0.f, 0.f};
#pragma unroll
        for (int s = 0; s < 8; ++s) {
            u32x4 pw; pw.x = cvt_pk_bf16(acc[2 * s][0], acc[2 * s][1]); pw.y = cvt_pk_bf16(acc[2 * s][2], acc[2 * s][3]);
            pw.z = cvt_pk_bf16(acc[2 * s + 1][0], acc[2 * s + 1][1]); pw.w = cvt_pk_bf16(acc[2 * s + 1][2], acc[2 * s + 1][3]);
            const bf16x8 pf = __builtin_bit_cast(bf16x8, pw);
#pragma unroll
            for (int dt = 0; dt < 8; ++dt) {
                const u32x2 v0 = *(const LAS u32x2*)(Vs + (16 * dt + fr) * 528 + (32 * s + 4 * fq) * 2);
                const u32x2 v1 = *(const LAS u32x2*)(Vs + (16 * dt + fr) * 528 + (32 * s + 16 + 4 * fq) * 2);
                u32x4 vw; vw.x = v0.x; vw.y = v0.y; vw.z = v1.x; vw.w = v1.y;
                o[dt] = __builtin_amdgcn_mfma_f32_16x16x32_bf16(__builtin_bit_cast(bf16x8, vw), pf, o[dt], 0, 0, 0);
            }
        }
        bf16_t* orow = cat + (size_t)(tok0 + fr) * DM + CMIX + head * 128 + 4 * fq;
#pragma unroll
        for (int dt = 0; dt < 8; ++dt) { u32x2 w; w.x = cvt_pk_bf16(o[dt][0] * inv, o[dt][1] * inv); w.y = cvt_pk_bf16(o[dt][2] * inv, o[dt][3] * inv); *(GAS u32x2*)(orow + 16 * dt) = w; }
    }
}
DI void memattn_all(const Ctx& F, int l, const bf16_t* z, int zw, int qcol) {
    for (int u = F.bid; u < 256; u += F.G) memattn_unit(F, l, u, z, zw, qcol);
    __syncthreads();
}

DI void conv_mix(const Ctx& F, const Params& P, const bf16_t* z) {
    unsigned char* const wsl = F.ws; float* const outl = F.out; (void)outl;
    const float* cw = PIN(29);
    bf16_t* cat = (bf16_t*)(wsl + WS_CAT);
    const int gt = F.bid * NT + F.tid, ngt = F.G * NT;
    for (int idx = gt; idx < NTOK * 192; idx += ngt) {
        const int tok = idx / 192, c8 = idx - tok * 192, c = c8 * 8, t = tok & (SEQ - 1);
        const bf16_t* zr = z + (size_t)tok * ZW_OTH;
        const u32x4 bg = *(const u32x4*)(zr + c);
        float y[8];
#pragma unroll
        for (int j = 0; j < 8; ++j) y[j] = 0.f;
#pragma unroll
        for (int dt = 0; dt < 3; ++dt) {
            if (t - dt >= 0) {
                const u32x4 cg = *(const u32x4*)(zr - (size_t)dt * ZW_OTH + CMIX + c), hh = *(const u32x4*)(zr - (size_t)dt * ZW_OTH + 2 * CMIX + c);
                const f32x4 w0 = *(const f32x4*)(cw + (2 - dt) * CMIX + c), w1 = *(const f32x4*)(cw + (2 - dt) * CMIX + c + 4);
                y[0] += w0.x * bflo(cg.x) * bflo(hh.x); y[1] += w0.y * bfhi(cg.x) * bfhi(hh.x); y[2] += w0.z * bflo(cg.y) * bflo(hh.y); y[3] += w0.w * bfhi(cg.y) * bfhi(hh.y);
                y[4] += w1.x * bflo(cg.z) * bflo(hh.z); y[5] += w1.y * bfhi(cg.z) * bfhi(hh.z); y[6] += w1.z * bflo(cg.w) * bflo(hh.w); y[7] += w1.w * bfhi(cg.w) * bfhi(hh.w);
            }
        }
        u32x4 o; o.x = cvt_pk_bf16(bflo(bg.x) * y[0], bfhi(bg.x) * y[1]); o.y = cvt_pk_bf16(bflo(bg.y) * y[2], bfhi(bg.y) * y[3]);
        o.z = cvt_pk_bf16(bflo(bg.z) * y[4], bfhi(bg.z) * y[5]); o.w = cvt_pk_bf16(bflo(bg.w) * y[6], bfhi(bg.w) * y[7]);
        *(u32x4*)(cat + (size_t)tok * DM + c) = o;
    }
}

DI void sb_attention(const Ctx& F, const bf16_t* z) {
    unsigned char* const wsl = F.ws;
    const bf16_t* VT = (const bf16_t*)(wsl + WS_ACT);
    bf16_t* cat = (bf16_t*)(wsl + WS_CAT);
    LAS unsigned char* Ks = F.lds; LAS unsigned char* Vs = F.lds + 69632;
    const int lane = F.lane, fr = lane & 15, fq = lane >> 4;
    const float sc = 0.08838834764831845f;
    for (int u = F.bid; u < NBATCH * 12 * 32; u += F.G) {
        const int b = u / (12 * 32); int r = u - b * 12 * 32; const int head = r >> 5, qblk = r & 31;
        const int t0 = qblk * 128, kw0 = t0 - 128;
        __syncthreads();
#pragma unroll
        for (int h = 0; h < 2; ++h) {
            u32x4 kv[4], vv[4];
#pragma unroll
            for (int i = 0; i < 4; ++i) { const int ch = F.tid + NT * (4 * h + i);
                { const int row = ch >> 4, c16 = ch & 15, key = kw0 + row, keyc = key < 0 ? 0 : key; kv[i] = *(const GAS u32x4*)(z + (size_t)(b * SEQ + keyc) * ZW_OTH + CMIX + head * 128 + c16 * 8); }
                { const int d = ch >> 5, c = ch & 31, k8 = kw0 + c * 8, k8c = k8 < 0 ? 0 : k8; vv[i] = *(const GAS u32x4*)(VT + (size_t)(head * 128 + d) * NTOK + b * SEQ + k8c); } }
#pragma unroll
            for (int i = 0; i < 4; ++i) { const int ch = F.tid + NT * (4 * h + i);
                { const int row = ch >> 4, c16 = ch & 15; *(LAS u32x4*)(Ks + row * 272 + c16 * 16) = kv[i]; }
                { const int d = ch >> 5, c = ch & 31; *(LAS u32x4*)(Vs + d * 528 + c * 16) = vv[i]; } }
            asm volatile("" ::: "memory");
        }
        __syncthreads();
        int lq = F.lane; asm volatile("" : "+v"(lq) :: "memory");
        const int tq0 = t0 + F.wave * 16, tq = tq0 + fr;
        bf16x8 Qf[4];
#pragma unroll
        for (int ks = 0; ks < 4; ++ks) Qf[ks] = *(const GAS bf16x8*)(z + (size_t)(b * SEQ + tq0 + (lq & 15)) * ZW_OTH + head * 128 + ks * 32 + (lq >> 4) * 8);
        f32x4 o[8];
#pragma unroll
        for (int dt = 0; dt < 8; ++dt) o[dt] = (f32x4){0.f, 0.f, 0.f, 0.f};
        float R = 0.f;
        for (int kt = (tq0 + 14) >> 5; kt >= 0; --kt) {
            const int lk = 32 * kt - kw0;
            bf16x8 Kf[2][4]; u32x2 V0[8], V1[8];
            if (lk >= 0) {
#pragma unroll
                for (int tl = 0; tl < 2; ++tl)
#pragma unroll
                    for (int ks = 0; ks < 4; ++ks) Kf[tl][ks] = *(const LAS bf16x8*)(Ks + (lk + 16 * tl + fr) * 272 + ks * 64 + fq * 16);
#pragma unroll
                for (int dt = 0; dt < 8; ++dt) { V0[dt] = *(const LAS u32x2*)(Vs + (16 * dt + fr) * 528 + (lk + 4 * fq) * 2); V1[dt] = *(const LAS u32x2*)(Vs + (16 * dt + fr) * 528 + (lk + 16 + 4 * fq) * 2); }
            } else {
#pragma unroll
                for (int tl = 0; tl < 2; ++tl)
#pragma unroll
                    for (int ks = 0; ks < 4; ++ks) Kf[tl][ks] = *(const GAS bf16x8*)(z + (size_t)(b * SEQ + 32 * kt + 16 * tl + fr) * ZW_OTH + CMIX + head * 128 + ks * 32 + fq * 8);
#pragma unroll
                for (int dt = 0; dt < 8; ++dt) { const bf16_t* vp = VT + (size_t)(head * 128 + 16 * dt + fr) * NTOK + b * SEQ + 32 * kt + 4 * fq; V0[dt] = *(const GAS u32x2*)vp; V1[dt] = *(const GAS u32x2*)(vp + 16); }
            }
            f32x4 s[2];
#pragma unroll
            for (int tl = 0; tl < 2; ++tl) { s[tl] = (f32x4){0.f, 0.f, 0.f, 0.f};
#pragma unroll
                for (int ks = 0; ks < 4; ++ks) s[tl] = __builtin_amdgcn_mfma_f32_16x16x32_bf16(Kf[tl][ks], Qf[ks], s[tl], 0, 0, 0); }
            float ln[2][4], lsg[2][4], tot[2];
#pragma unroll
            for (int tl = 0; tl < 2; ++tl) { tot[tl] = 0.f;
#pragma unroll
                for (int j = 0; j < 4; ++j) { const float x = s[tl][j] * sc; const int key = 32 * kt + 16 * tl + 4 * fq + j; const bool valid = key < tq;
                    const float sp = softplusf_(x); ln[tl][j] = valid ? -sp : 0.f; lsg[tl][j] = valid ? (x - sp) : -1.0e30f; tot[tl] += ln[tl][j]; } }
            const float a16_0 = __shfl_xor(tot[0], 16), a32_0 = __shfl_xor(tot[0], 32), a48_0 = __shfl_xor(tot[0], 48);
            const float a16_1 = __shfl_xor(tot[1], 16), a32_1 = __shfl_xor(tot[1], 32), a48_1 = __shfl_xor(tot[1], 48);
            float hi0 = 0.f, hi1 = 0.f;
            if ((fq ^ 1) > fq) { hi0 += a16_0; hi1 += a16_1; }
            if ((fq ^ 2) > fq) { hi0 += a32_0; hi1 += a32_1; }
            if ((fq ^ 3) > fq) { hi0 += a48_0; hi1 += a48_1; }
            const float all0 = tot[0] + a16_0 + a32_0 + a48_0, all1 = tot[1] + a16_1 + a32_1 + a48_1;
            const float E0 = R + hi0 + all1, E1 = R + hi1;
            float at[2][4];
#pragma unroll
            for (int tl = 0; tl < 2; ++tl) { float suf = 0.f; const float Eb = tl ? E1 : E0;
#pragma unroll
                for (int j = 3; j >= 0; --j) { at[tl][j] = __expf(lsg[tl][j] + Eb + suf); suf += ln[tl][j]; } }
            R += all0 + all1;
            u32x4 pw; pw.x = cvt_pk_bf16(at[0][0], at[0][1]); pw.y = cvt_pk_bf16(at[0][2], at[0][3]); pw.z = cvt_pk_bf16(at[1][0], at[1][1]); pw.w = cvt_pk_bf16(at[1][2], at[1][3]);
            const bf16x8 pf = __builtin_bit_cast(bf16x8, pw);
#pragma unroll
            for (int dt = 0; dt < 8; ++dt) {
                u32x4 vw; vw.x = V0[dt].x; vw.y = V0[dt].y; vw.z = V1[dt].x; vw.w = V1[dt].y;
                o[dt] = __builtin_amdgcn_mfma_f32_16x16x32_bf16(__builtin_bit_cast(bf16x8, vw), pf, o[dt], 0, 0, 0);
            }
            if (__all(R < -100.f)) break;
        }
        bf16_t* orow = cat + (size_t)(b * SEQ + tq) * DM + head * 128 + 4 * fq;
#pragma unroll
        for (int dt = 0; dt < 8; ++dt) { u32x2 w; w.x = cvt_pk_bf16(o[dt][0], o[dt][1]); w.y = cvt_pk_bf16(o[dt][2], o[dt][3]); *(GAS u32x2*)(orow + 16 * dt) = w; }
    }
    __syncthreads();
}

DI void rwkv_prep1(const Ctx& F, const Params& P, int j, const bf16_t* z) {
    unsigned char* const wsl = F.ws; float* const outl = F.out; (void)outl;
    const float* mu = PIN(17) + (size_t)j * 5056;
    bf16_t* act = (bf16_t*)(wsl + WS_ACT);
    const int gt = F.bid * NT + F.tid, ngt = F.G * NT;
    for (int idx = gt; idx < NTOK * 64; idx += ngt) {
        const int tok = idx >> 6, ci = idx & 63, t = tok & (SEQ - 1);
        u32x4 o = (u32x4){0u, 0u, 0u, 0u};
        if (ci < 24 || ci >= 32) {
            const int sc = ci < 12 ? 4608 + 8 * ci : (ci < 24 ? 4704 + 8 * (ci - 12) : 4800 + 8 * (ci - 32));
            const u32x4 a = *(const u32x4*)(z + (size_t)tok * ZW_RWKV + sc);
            u32x4 p = (u32x4){0u, 0u, 0u, 0u}; if (t > 0) p = *(const u32x4*)(z + (size_t)(tok - 1) * ZW_RWKV + sc);
            const f32x4 m0 = *(const f32x4*)(mu + sc), m1 = *(const f32x4*)(mu + sc + 4);
            float v[8];
            v[0] = bflo(a.x) + (bflo(p.x) - bflo(a.x)) * m0.x; v[1] = bfhi(a.x) + (bfhi(p.x) - bfhi(a.x)) * m0.y;
            v[2] = bflo(a.y) + (bflo(p.y) - bflo(a.y)) * m0.z; v[3] = bfhi(a.y) + (bfhi(p.y) - bfhi(a.y)) * m0.w;
            v[4] = bflo(a.z) + (bflo(p.z) - bflo(a.z)) * m1.x; v[5] = bfhi(a.z) + (bfhi(p.z) - bfhi(a.z)) * m1.y;
            v[6] = bflo(a.w) + (bflo(p.w) - bflo(a.w)) * m1.z; v[7] = bfhi(a.w) + (bfhi(p.w) - bfhi(a.w)) * m1.w;
#pragma unroll
            for (int q = 0; q < 8; ++q) { if (ci < 12) v[q] = tanhf(v[q]); else if (ci >= 32) v[q] = sigmoidf_(v[q]); }
            o.x = cvt_pk_bf16(v[0], v[1]); o.y = cvt_pk_bf16(v[2], v[3]); o.z = cvt_pk_bf16(v[4], v[5]); o.w = cvt_pk_bf16(v[6], v[7]);
        }
        *(u32x4*)(act + (size_t)tok * 512 + ci * 8) = o;
    }
}

constexpr int CH = 64, NCH = SEQ / CH;
DI float* scan_rec(unsigned char* ws, int tok, int head) {
    return (float*)(ws + WS_SCAN) + ((size_t)((tok >> 12) * 24 + head) * SEQ + (tok & (SEQ - 1))) * 320;
}
DI float* gh_ptr(unsigned char* ws, int bh, int c, int which) { return (float*)(ws + WS_GH) + (((size_t)bh * NCH + c) * 2 + which) * 4096; }
struct RwPar { const float *mu, *w0, *a0, *kk, *ka, *rk, *gng, *gnb; };
struct PrepRaw { u32x2 zr, zk, zv, pr, pk, pv, lw, la; };
struct PrepOut { f32x4 dec, ld, bb, kp, r, nk, v; float bon; };
DI void prep_load(PrepRaw& R, const bf16_t* z, const bf16_t* LW, int tok, int c4) {
    tok = tok < NTOK ? tok : NTOK - 1;
    const bool hp = (tok & (SEQ - 1)) != 0;
    const GAS bf16_t* zc = (const GAS bf16_t*)(z + (size_t)tok * ZW_RWKV + c4); const GAS bf16_t* zp = hp ? zc - ZW_RWKV : zc;
    R.zr = *(const GAS u32x2*)zc; R.zk = *(const GAS u32x2*)(zc + CMIX); R.zv = *(const GAS u32x2*)(zc + 2 * CMIX);
    R.pr = *(const GAS u32x2*)zp; R.pk = *(const GAS u32x2*)(zp + CMIX); R.pv = *(const GAS u32x2*)(zp + 2 * CMIX);
    const GAS bf16_t* lp = (const GAS bf16_t*)(LW + (size_t)tok * 3072 + c4); R.lw = *(const GAS u32x2*)lp; R.la = *(const GAS u32x2*)(lp + CMIX);
}
DI f32x4 lerp_u(u32x2 a, u32x2 p, f32x4 m) {
    f32x4 r; r.x = bflo(a.x) + (bflo(p.x) - bflo(a.x)) * m.x; r.y = bfhi(a.x) + (bfhi(p.x) - bfhi(a.x)) * m.y;
    r.z = bflo(a.y) + (bflo(p.y) - bflo(a.y)) * m.z; r.w = bfhi(a.y) + (bfhi(p.y) - bfhi(a.y)) * m.w; return r;
}
struct PrepPar { f32x4 mur, muk, muv, w0, a0, kk, ka, rk; };
DI void par_load(PrepPar& P, const RwPar& Q, int c4) {
    P.mur = *(const GAS f32x4*)(Q.mu + c4); P.muk = *(const GAS f32x4*)(Q.mu + CMIX + c4); P.muv = *(const GAS f32x4*)(Q.mu + 2 * CMIX + c4);
    P.w0 = *(const GAS f32x4*)(Q.w0 + c4); P.a0 = *(const GAS f32x4*)(Q.a0 + c4); P.kk = *(const GAS f32x4*)(Q.kk + c4); P.ka = *(const GAS f32x4*)(Q.ka + c4); P.rk = *(const GAS f32x4*)(Q.rk + c4);
}
template <bool WANT_BON> DI void prep_compute(const PrepRaw& R, const PrepPar& P, bool hp, PrepOut& O) {
    const u32x2 z2 = (u32x2){0u, 0u};
    const f32x4 r = lerp_u(R.zr, hp ? R.pr : z2, P.mur), k = lerp_u(R.zk, hp ? R.pk : z2, P.muk);
    O.v = lerp_u(R.zv, hp ? R.pv : z2, P.muv); O.r = r;
    const f32x4 w0v = P.w0, a0v = P.a0, kkv = P.kk, kav = P.ka;
    f32x4 wr; wr.x = w0v.x + bflo(R.lw.x); wr.y = w0v.y + bfhi(R.lw.x); wr.z = w0v.z + bflo(R.lw.y); wr.w = w0v.w + bfhi(R.lw.y);
    f32x4 ar; ar.x = a0v.x + bflo(R.la.x); ar.y = a0v.y + bfhi(R.la.x); ar.z = a0v.z + bflo(R.la.y); ar.w = a0v.w + bfhi(R.la.y);
    f32x4 a, kk;
#pragma unroll
    for (int q = 0; q < 4; ++q) { const float wl = -softplusf_(-wr[q]) - 0.5f; O.ld[q] = -__expf(wl); O.dec[q] = __expf(O.ld[q]); a[q] = sigmoidf_(ar[q]); kk[q] = k[q] * kkv[q]; O.kp[q] = k[q] * (1.f + (a[q] - 1.f) * kav[q]); }
    const float n2 = sum16(kk.x * kk.x + kk.y * kk.y + kk.z * kk.z + kk.w * kk.w);
    const float inv = __builtin_amdgcn_rsqf(fmaxf(n2, 1e-24f));
#pragma unroll
    for (int q = 0; q < 4; ++q) { const float kn = kk[q] * inv; O.bb[q] = kn * a[q]; O.nk[q] = -kn; }
    if (WANT_BON) { const f32x4 rk = P.rk; O.bon = sum16(r.x * O.kp.x * rk.x + r.y * O.kp.y * rk.y + r.z * O.kp.z * rk.z + r.w * O.kp.w * rk.w); }
}
#define LO2(v) ((f32x2){(v).x, (v).y})
#define HI2(v) ((f32x2){(v).z, (v).w})
constexpr int WRS = 144;
constexpr int W_SLOT = 64 * WRS;
enum { SL_NT = 0, SL_RT, SL_BH, SL_KH, SL_BHT, SL_KHT, SL_VT, SL_MK, SL_NB, SL_NK, SL_W1T, SL_U0T };
constexpr int W_MB = 12 * W_SLOT, W_CL = W_MB + 16384, W_PL = W_CL + 16384;
DI bf16x8 wfrag(LAS unsigned char* L, int slot, int row, int ks, int q) { return *(const LAS bf16x8*)(L + slot * W_SLOT + row * WRS + ks * 64 + q * 16); }
DI void wput(LAS unsigned char* L, int slot, int row, int col, float v) { *(LAS bf16_t*)(L + slot * W_SLOT + row * WRS + col * 2) = (bf16_t)(cvt_pk_bf16(v, 0.f) & 0xffffu); }
DI void tr4x4_rows(f32x4& x) {
    const float f0 = x.x, f1 = x.y, f2 = x.z, f3 = x.w;
    const unsigned u0 = __builtin_bit_cast(unsigned, f0), u1 = __builtin_bit_cast(unsigned, f1), u2 = __builtin_bit_cast(unsigned, f2), u3 = __builtin_bit_cast(unsigned, f3);
    const auto s02 = __builtin_amdgcn_permlane32_swap(u0, u2, false, false); const auto s13 = __builtin_amdgcn_permlane32_swap(u1, u3, false, false);
    const auto t01 = __builtin_amdgcn_permlane16_swap(s02[0], s13[0], false, false); const auto t23 = __builtin_amdgcn_permlane16_swap(s02[1], s13[1], false, false);
    x[0] = __builtin_bit_cast(float, (unsigned)t01[0]); x[1] = __builtin_bit_cast(float, (unsigned)t01[1]); x[2] = __builtin_bit_cast(float, (unsigned)t23[0]); x[3] = __builtin_bit_cast(float, (unsigned)t23[1]);
}
DI void scan_w1(const Ctx& F, const RwPar& Q, const bf16_t* z) {
    unsigned char* const wsl = F.ws; LAS unsigned char* L = F.lds;
    const int wave = F.wave;
    const bf16_t* LW = (const bf16_t*)(wsl + WS_LW);
    LAS float* MB = (LAS float*)(L + W_MB); LAS float* CL = (LAS float*)(L + W_CL); LAS float* PL = (LAS float*)(L + W_PL);
    PrepPar PN;
    PrepRaw RN[2];
    if (F.bid < 96 * NCH) { const int bh = F.bid % 96, c = F.bid / 96, b = bh / 24, head = bh - b * 24, tokb = b * SEQ + c * CH, c4 = head * 64 + 4 * (F.lane & 15);
#pragma unroll
        for (int p = 0; p < 2; ++p) prep_load(RN[p], z, LW, tokb + p * 32 + wave * 4 + (F.lane >> 4), c4);
        par_load(PN, Q, c4); }
    for (int u = F.bid; u < 96 * NCH; u += F.G) {
        int lane = F.lane; asm volatile("" : "+v"(lane));
        const int tq = lane >> 4, li = lane & 15, fr = li, fq = tq;
        const int bh = u % 96, c = u / 96, b = bh / 24, head = bh - b * 24, tokb = b * SEQ + c * CH, c4 = head * 64 + 4 * li;
        LDS_BARRIER();
        PrepOut O[2];
#pragma unroll
        for (int p = 0; p < 2; ++p) {
            const int t = p * 32 + wave * 4 + tq; const PrepRaw R = RN[p];
            prep_compute<true>(R, PN, ((tokb + t) & (SEQ - 1)) != 0, O[p]);
            *(LAS f32x4*)(CL + t * 64 + 4 * li) = O[p].ld;
            u32x2 e; e.x = cvt_pk_bf16(O[p].bon * O[p].v.x, O[p].bon * O[p].v.y); e.y = cvt_pk_bf16(O[p].bon * O[p].v.z, O[p].bon * O[p].v.w);
            *(GAS u32x2*)((bf16_t*)(wsl + WS_E) + (size_t)(tokb + t) * CMIX + c4) = e;
        }
        LDS_BARRIER();
        if (wave == 0) {
            float xs[64];
#pragma unroll
            for (int t = 0; t < 64; ++t) xs[t] = CL[t * 64 + lane];
#pragma unroll
            for (int t = 1; t < 64; ++t) xs[t] += xs[t - 1];
#pragma unroll
            for (int t = 0; t < 64; ++t) CL[t * 64 + lane] = xs[t];
        }
        LDS_BARRIER();
#pragma unroll
        for (int p = 0; p < 2; ++p) {
            const int t = p * 32 + wave * 4 + tq;
            const f32x4 cl = *(const LAS f32x4*)(CL + t * 64 + 4 * li);
            f32x4 clm = (f32x4){0.f, 0.f, 0.f, 0.f}; if (t > 0) clm = *(const LAS f32x4*)(CL + (t - 1) * 64 + 4 * li);
            f32x4 nt, rt, bh4, kh4;
#pragma unroll
            for (int q = 0; q < 4; ++q) { const float P = __expf(cl[q]), Pm = __expf(clm[q]), iP = __expf(-cl[q]);
                nt[q] = O[p].nk[q] * Pm; rt[q] = O[p].r[q] * P; bh4[q] = O[p].bb[q] * iP; kh4[q] = O[p].kp[q] * iP;
                if (t == 63) PL[4 * li + q] = P; }
            u32x2 w;
            w.x = cvt_pk_bf16(nt.x, nt.y); w.y = cvt_pk_bf16(nt.z, nt.w); *(LAS u32x2*)(L + SL_NT * W_SLOT + t * WRS + 8 * li) = w;
            w.x = cvt_pk_bf16(rt.x, rt.y); w.y = cvt_pk_bf16(rt.z, rt.w); *(LAS u32x2*)(L + SL_RT * W_SLOT + t * WRS + 8 * li) = w;
            w.x = cvt_pk_bf16(bh4.x, bh4.y); w.y = cvt_pk_bf16(bh4.z, bh4.w); *(LAS u32x2*)(L + SL_BH * W_SLOT + t * WRS + 8 * li) = w;
            w.x = cvt_pk_bf16(kh4.x, kh4.y); w.y = cvt_pk_bf16(kh4.z, kh4.w); *(LAS u32x2*)(L + SL_KH * W_SLOT + t * WRS + 8 * li) = w;
            { f32x4 vv = O[p].v; tr4x4_rows(bh4); tr4x4_rows(kh4); tr4x4_rows(vv);
              const int off = (4 * li + tq) * WRS + (p * 32 + wave * 4) * 2;
              w.x = cvt_pk_bf16(bh4.x, bh4.y); w.y = cvt_pk_bf16(bh4.z, bh4.w); *(LAS u32x2*)(L + SL_BHT * W_SLOT + off) = w;
              w.x = cvt_pk_bf16(kh4.x, kh4.y); w.y = cvt_pk_bf16(kh4.z, kh4.w); *(LAS u32x2*)(L + SL_KHT * W_SLOT + off) = w;
              w.x = cvt_pk_bf16(vv.x, vv.y); w.y = cvt_pk_bf16(vv.z, vv.w); *(LAS u32x2*)(L + SL_VT * W_SLOT + off) = w; }
        }
        LDS_BARRIER();
        asm volatile("" ::: "memory");
        { const int un = u + F.G; if (un < 96 * NCH) { const int bhn = un % 96, cn = un / 96, bn = bhn / 24, headn = bhn - bn * 24, tokbn = bn * SEQ + cn * CH, c4n = headn * 64 + 4 * li;
#pragma unroll
            for (int p = 0; p < 2; ++p) prep_load(RN[p], z, LW, tokbn + p * 32 + wave * 4 + tq, c4n);
            par_load(PN, Q, c4n); } }
        for (int reps = 0; reps < REP_WS; ++reps) {
            const int mt = wave >> 1, slotA = (mt < 2) ? SL_NT : SL_RT, slotB = (mt & 1) ? SL_KH : SL_BH, slotO = (mt == 1) ? SL_MK : (mt == 2 ? SL_NB : SL_NK), tt0 = (wave & 1) * 2;
            bf16x8 Af[2][2], Bf[4][2];
#pragma unroll
            for (int a2 = 0; a2 < 2; ++a2)
#pragma unroll
                for (int ks = 0; ks < 2; ++ks) Af[a2][ks] = wfrag(L, slotA, 16 * (tt0 + a2) + fr, ks, fq);
#pragma unroll
            for (int ss = 0; ss < 4; ++ss)
#pragma unroll
                for (int ks = 0; ks < 2; ++ks) Bf[ss][ks] = wfrag(L, slotB, 16 * ss + fr, ks, fq);
            float zf = 0.f; asm volatile("" : "+v"(zf));
            const unsigned zu = __builtin_bit_cast(unsigned, zf);
            const int strict = (mt < 2) ? 1 : 0; LAS unsigned char* ob = L + slotO * W_SLOT;
#pragma unroll
            for (int a2 = 0; a2 < 2; ++a2)
#pragma unroll
                for (int ss = 0; ss < 4; ++ss) { const int t = 16 * (tt0 + a2) + fr, s0 = 16 * ss + 4 * fq;
                    if (ss <= tt0 + a2) {
                        f32x4 acc = __builtin_amdgcn_mfma_f32_16x16x32_bf16(Bf[ss][0], Af[a2][0], (f32x4){0.f, 0.f, 0.f, 0.f}, 0, 0, 0);
                        acc = __builtin_amdgcn_mfma_f32_16x16x32_bf16(Bf[ss][1], Af[a2][1], acc, 0, 0, 0);
                        f32x4 o;
#pragma unroll
                        for (int r = 0; r < 4; ++r) o[r] = (s0 + r + strict <= t) ? acc[r] : 0.f;
                        if (mt == 0) *(LAS f32x4*)(MB + t * 64 + s0) = o;
                        else { u32x2 w; w.x = cvt_pk_bf16(o[0], o[1]); w.y = cvt_pk_bf16(o[2], o[3]); *(LAS u32x2*)(ob + t * WRS + s0 * 2) = w; }
                    } else {
                        if (mt == 0) *(LAS f32x4*)(MB + t * 64 + s0) = (f32x4){zf, zf, zf, zf};
                        else *(LAS u32x2*)(ob + t * WRS + s0 * 2) = (u32x2){zu, zu};
                    }
                }
        }
        LDS_BARRIER();
        { const int t = F.tid >> 3, s0 = (F.tid & 7) * 8; const f32x4 a0 = *(const LAS f32x4*)(MB + t * 64 + s0), a1 = *(const LAS f32x4*)(MB + t * 64 + s0 + 4);
          u32x4 w; w.x = cvt_pk_bf16(a0.x, a0.y); w.y = cvt_pk_bf16(a0.z, a0.w); w.z = cvt_pk_bf16(a1.x, a1.y); w.w = cvt_pk_bf16(a1.z, a1.w);
          *(LAS u32x4*)(L + SL_BH * W_SLOT + t * WRS + s0 * 2) = w; }
#pragma unroll
        for (int k2 = 0; k2 < 2; ++k2) {
            const int tile = wave * 2 + k2, tt = tile >> 2, it = tile & 3;
            f32x4 acc = (f32x4){0.f, 0.f, 0.f, 0.f};
#pragma unroll
            for (int ks = 0; ks < 2; ++ks) acc = __builtin_amdgcn_mfma_f32_16x16x32_bf16(wfrag(L, SL_MK, 16 * tt + fr, ks, fq), wfrag(L, SL_VT, 16 * it + fr, ks, fq), acc, 0, 0, 0);
#pragma unroll
            for (int r = 0; r < 4; ++r) CL[(16 * tt + 4 * fq + r) * 64 + 16 * it + fr] = acc[r];
        }
        if (wave >= 4) {
            const int I = wave - 4;
            float d[16], xb[16];
#pragma unroll
            for (int r = 0; r < 16; ++r) d[r] = (r == lane) ? 1.f : 0.f;
            const LAS float* mbv = MB; asm volatile("" : "+v"(mbv));
            const LAS float* mb = mbv + (16 * I) * 64 + 16 * I;
            f32x4 A[8][2], Bm[8][2];
#pragma unroll
            for (int tt = 0; tt < 8; ++tt) { A[tt][0] = *(const LAS f32x4*)(mb + tt * 64); A[tt][1] = *(const LAS f32x4*)(mb + tt * 64 + 4); }
#pragma unroll
            for (int tt = 0; tt < 8; ++tt) { Bm[tt][0] = *(const LAS f32x4*)(mb + (8 + tt) * 64); Bm[tt][1] = *(const LAS f32x4*)(mb + (8 + tt) * 64 + 4); }
#pragma unroll
            for (int sx = 0; sx < 8; ++sx) { xb[sx] = d[sx];
#pragma unroll
                for (int tt = sx + 1; tt < 8; ++tt) d[tt] = fma_s(A[tt][sx >> 2][sx & 3], xb[sx], d[tt]); }
#pragma unroll
            for (int sx = 0; sx < 8; ++sx)
#pragma unroll
                for (int tt = 0; tt < 8; ++tt) d[8 + tt] = fma_s(Bm[tt][sx >> 2][sx & 3], xb[sx], d[8 + tt]);
            asm volatile("" : "+v"(d[8]), "+v"(d[15]) :: "memory");
#pragma unroll
            for (int tt = 0; tt < 8; ++tt) { A[tt][0] = *(const LAS f32x4*)(mb + (8 + tt) * 64 + 8); A[tt][1] = *(const LAS f32x4*)(mb + (8 + tt) * 64 + 12); }
#pragma unroll
            for (int sx = 0; sx < 8; ++sx) { xb[8 + sx] = d[8 + sx];
#pragma unroll
                for (int tt = sx + 1; tt < 8; ++tt) d[8 + tt] = fma_s(A[tt][sx >> 2][sx & 3], xb[8 + sx], d[8 + tt]); }
            if (lane < 16) {
#pragma unroll
                for (int t = 0; t < 16; ++t) *(LAS bf16_t*)(L + SL_KH * W_SLOT + (16 * I + t) * 48 + lane * 2) = (bf16_t)(cvt_pk_bf16(xb[t], 0.f) & 0xffffu);
            }
        }
        LDS_BARRIER();
        asm volatile("" ::: "memory");
        for (int repx = 0; repx < REP_WX; ++repx) {
            const int sys = wave >> 2, ct = wave & 3, slotX = sys == 0 ? SL_W1T : SL_U0T;
            LAS unsigned char* TI = L + SL_KH * W_SLOT;
            f32x4 rhs[4];
            if (sys == 0) {
#pragma unroll
                for (int I = 0; I < 4; ++I)
#pragma unroll
                    for (int r = 0; r < 4; ++r) rhs[I][r] = bf2f(*(const LAS bf16_t*)(L + SL_NT * W_SLOT + (16 * I + 4 * fq + r) * WRS + (16 * ct + fr) * 2));
            } else {
#pragma unroll
                for (int I = 0; I < 4; ++I)
#pragma unroll
                    for (int r = 0; r < 4; ++r) rhs[I][r] = CL[(16 * I + 4 * fq + r) * 64 + 16 * ct + fr];
            }
            u32x2 ta[4], ma[6];
#pragma unroll
            for (int I = 0; I < 4; ++I) ta[I] = *(const LAS u32x2*)(TI + (16 * I + fr) * 48 + 8 * fq);
#pragma unroll
            for (int I = 1; I < 4; ++I)
#pragma unroll
                for (int Ip = 0; Ip < I; ++Ip) ma[I * (I - 1) / 2 + Ip] = *(const LAS u32x2*)(L + SL_BH * W_SLOT + (16 * I + fr) * WRS + (16 * Ip + 4 * fq) * 2);
            u32x2 xk[4];
#pragma unroll
            for (int I = 0; I < 4; ++I) {
                f32x4 acc = rhs[I];
#pragma unroll
                for (int Ip = 0; Ip < I; ++Ip) { const u32x2 m = ma[I * (I - 1) / 2 + Ip];
                    acc = __builtin_amdgcn_mfma_f32_16x16x32_bf16(__builtin_bit_cast(bf16x8, (u32x4){m.x, m.y, 0u, 0u}), __builtin_bit_cast(bf16x8, (u32x4){xk[Ip].x, xk[Ip].y, 0u, 0u}), acc, 0, 0, 0); }
                const unsigned d0 = cvt_pk_bf16(acc[0], acc[1]), d1 = cvt_pk_bf16(acc[2], acc[3]);
                const f32x4 x = __builtin_amdgcn_mfma_f32_16x16x32_bf16(__builtin_bit_cast(bf16x8, (u32x4){ta[I].x, ta[I].y, 0u, 0u}), __builtin_bit_cast(bf16x8, (u32x4){d0, d1, 0u, 0u}), (f32x4){0.f, 0.f, 0.f, 0.f}, 0, 0, 0);
                xk[I].x = cvt_pk_bf16(x[0], x[1]); xk[I].y = cvt_pk_bf16(x[2], x[3]);
                *(LAS u32x2*)(L + slotX * W_SLOT + (16 * ct + fr) * WRS + (16 * I + 4 * fq) * 2) = xk[I];
            }
        }
        LDS_BARRIER();
        for (int repo = 0; repo < REP_WO; ++repo) {
            const int kind = wave >> 1, ta0 = (wave & 1) * 2;
            float* gp = gh_ptr(wsl, bh, c, 0); float* hp = gh_ptr(wsl, bh, c, 1);
            bf16_t* qy = (bf16_t*)(wsl + WS_QY) + (size_t)u * 4096; float* y0t = (float*)(wsl + WS_Y0T) + (size_t)u * 4096;
            const int sA1 = kind == 0 ? SL_W1T : kind == 1 ? SL_BHT : kind == 2 ? SL_W1T : SL_NK, sB1 = kind == 0 ? SL_BHT : kind == 1 ? SL_U0T : kind == 2 ? SL_NB : SL_VT;
            const int sA2 = kind == 1 ? SL_KHT : SL_NB, sB2 = kind == 1 ? SL_VT : SL_U0T; const bool two = (kind & 1) != 0;
            bf16x8 Af[2][2], Bf[4][2];
#pragma unroll
            for (int a2 = 0; a2 < 2; ++a2)
#pragma unroll
                for (int ks = 0; ks < 2; ++ks) Af[a2][ks] = wfrag(L, sA1, 16 * (ta0 + a2) + fr, ks, fq);
#pragma unroll
            for (int tb = 0; tb < 4; ++tb)
#pragma unroll
                for (int ks = 0; ks < 2; ++ks) Bf[tb][ks] = wfrag(L, sB1, 16 * tb + fr, ks, fq);
            f32x4 acc[2][4];
#pragma unroll
            for (int a2 = 0; a2 < 2; ++a2)
#pragma unroll
                for (int tb = 0; tb < 4; ++tb) { acc[a2][tb] = (f32x4){0.f, 0.f, 0.f, 0.f};
#pragma unroll
                    for (int ks = 0; ks < 2; ++ks) acc[a2][tb] = __builtin_amdgcn_mfma_f32_16x16x32_bf16(Af[a2][ks], Bf[tb][ks], acc[a2][tb], 0, 0, 0); }
            if (two) {
#pragma unroll
                for (int a2 = 0; a2 < 2; ++a2)
#pragma unroll
                    for (int ks = 0; ks < 2; ++ks) Af[a2][ks] = wfrag(L, sA2, 16 * (ta0 + a2) + fr, ks, fq);
#pragma unroll
                for (int tb = 0; tb < 4; ++tb)
#pragma unroll
                    for (int ks = 0; ks < 2; ++ks) Bf[tb][ks] = wfrag(L, sB2, 16 * tb + fr, ks, fq);
#pragma unroll
                for (int a2 = 0; a2 < 2; ++a2)
#pragma unroll
                    for (int tb = 0; tb < 4; ++tb)
#pragma unroll
                        for (int ks = 0; ks < 2; ++ks) acc[a2][tb] = __builtin_amdgcn_mfma_f32_16x16x32_bf16(Af[a2][ks], Bf[tb][ks], acc[a2][tb], 0, 0, 0);
            }
#pragma unroll
            for (int a2 = 0; a2 < 2; ++a2)
#pragma unroll
                for (int tb = 0; tb < 4; ++tb) { const int ta = ta0 + a2; const f32x4 av = acc[a2][tb];
                    if (kind == 0) {
                        const int j = 16 * tb + fr; const float pl = PL[j];
                        f32x4 o;
#pragma unroll
                        for (int r = 0; r < 4; ++r) o[r] = pl * (av[r] + ((16 * ta + 4 * fq + r) == j ? 1.f : 0.f));
                        u32x2 w; w.x = cvt_pk_bf16(o[0], o[1]); w.y = cvt_pk_bf16(o[2], o[3]);
                        *(GAS u32x2*)((bf16_t*)gp + j * 64 + 16 * ta + 4 * fq) = w;
                    } else if (kind == 1) {
                        const f32x4 pl = *(const LAS f32x4*)(PL + 16 * ta + 4 * fq);
                        *(GAS f32x4*)(hp + (16 * tb + fr) * 64 + 16 * ta + 4 * fq) = pl * av;
                    } else if (kind == 2) {
                        const int t = 16 * tb + fr; const u32x2 rr = *(const LAS u32x2*)(L + SL_RT * W_SLOT + t * WRS + (16 * ta + 4 * fq) * 2);
                        u32x2 w; w.x = cvt_pk_bf16(av[0] + bflo(rr.x), av[1] + bfhi(rr.x)); w.y = cvt_pk_bf16(av[2] + bflo(rr.y), av[3] + bfhi(rr.y));
                        *(GAS u32x2*)(qy + t * 64 + 16 * ta + 4 * fq) = w;
                    } else {
                        *(GAS f32x4*)(y0t + (16 * tb + fr) * 64 + 16 * ta + 4 * fq) = av;
                    }
                }
        }
    }
    LDS_BARRIER();
}
DI void scan_w2(const Ctx& F, const RwPar& Q) {
    unsigned char* const wsl = F.ws; const int lane = F.lane, fr = lane & 15, fq = lane >> 4;
    LAS float* yb = (LAS float*)(F.lds + F.wave * 16384);
    const bf16_t* gate = (const bf16_t*)(wsl + WS_GATE); const bf16_t* Eb = (const bf16_t*)(wsl + WS_E); bf16_t* cat = (bf16_t*)(wsl + WS_CAT);
    for (int u = F.gw; u < 96 * NCH; u += F.ngw) {
        const int bh = u % 96, c = u / 96, b = bh / 24, head = bh - b * 24, tokb = b * SEQ + c * CH;
        const bf16_t* qy = (const bf16_t*)(wsl + WS_QY) + (size_t)u * 4096; const float* y0t = (const float*)(wsl + WS_Y0T) + (size_t)u * 4096;
        f32x4 acc[4][4];
#pragma unroll
        for (int tt = 0; tt < 4; ++tt)
#pragma unroll
            for (int it = 0; it < 4; ++it) acc[tt][it] = *(const GAS f32x4*)(y0t + (16 * it + fr) * 64 + 16 * tt + 4 * fq);
        if (c > 0) {
            const bf16_t* sp = (const bf16_t*)gh_ptr(wsl, bh, c - 1, 0) + 4096;
            bf16x8 Bf[4][2];
#pragma unroll
            for (int it = 0; it < 4; ++it)
#pragma unroll
                for (int ks = 0; ks < 2; ++ks) Bf[it][ks] = *(const GAS bf16x8*)(sp + (16 * it + fr) * 64 + 32 * ks + 8 * fq);
#pragma unroll
            for (int tt = 0; tt < 4; ++tt)
#pragma unroll
                for (int ks = 0; ks < 2; ++ks) { const bf16x8 Af = *(const GAS bf16x8*)(qy + (16 * tt + fr) * 64 + 32 * ks + 8 * fq);
#pragma unroll
                    for (int it = 0; it < 4; ++it) acc[tt][it] = __builtin_amdgcn_mfma_f32_16x16x32_bf16(Af, Bf[it][ks], acc[tt][it], 0, 0, 0); }
        }
#pragma unroll
        for (int tt = 0; tt < 4; ++tt)
#pragma unroll
            for (int it = 0; it < 4; ++it)
#pragma unroll
                for (int r = 0; r < 4; ++r) yb[(16 * tt + 4 * fq + r) * 64 + 16 * it + fr] = acc[tt][it][r];
        LDS_WAIT();
#pragma unroll 4
        for (int k = 0; k < 16; ++k) {
            const int slot = k * 64 + lane, t = slot >> 4, li = slot & 15, c4 = head * 64 + 4 * li, tok = tokb + t;
            const f32x4 y = *(const LAS f32x4*)(yb + t * 64 + 4 * li);
            const u32x2 ev = *(const GAS u32x2*)(Eb + (size_t)tok * CMIX + c4), gt = *(const GAS u32x2*)(gate + (size_t)tok * CMIX + c4);
            const float mean = sum16(y.x + y.y + y.z + y.w) * (1.f / 64.f);
            const f32x4 d = y - mean;
            const float var = sum16(d.x * d.x + d.y * d.y + d.z * d.z + d.w * d.w) * (1.f / 64.f);
            const float rstd = rsqrtf(var + GN_EPS);
            const f32x4 g4 = *(const GAS f32x4*)(Q.gng + c4), b4 = *(const GAS f32x4*)(Q.gnb + c4);
            f32x4 o = d * rstd * g4 + b4; o.x += bflo(ev.x); o.y += bfhi(ev.x); o.z += bflo(ev.y); o.w += bfhi(ev.y);
            u32x2 w; w.x = cvt_pk_bf16(o.x * bflo(gt.x), o.y * bfhi(gt.x)); w.y = cvt_pk_bf16(o.z * bflo(gt.y), o.w * bfhi(gt.y));
            *(GAS u32x2*)(cat + (size_t)tok * DM + c4) = w;
        }
        LDS_WAIT();
    }
}
DI void scan_passB(const Ctx& F) {
    unsigned char* const wsl = F.ws; const int lane = F.lane, fr = lane & 15, fq = lane >> 4, ih = F.wave >> 2, q = F.wave & 3, bh = F.bid;
    LAS unsigned char* Sx0 = F.lds;
    bf16x8 ga[7][2]; f32x4 hq[7][2];
#define PB_LOAD(set, cc) do { const GAS bf16_t* _gp = (const GAS bf16_t*)gh_ptr(wsl, bh, (cc), 0) + (16 * q + fr) * 64 + 8 * fq; const GAS float* _hp = (const GAS float*)(gh_ptr(wsl, bh, (cc), 1) + (32 * ih + fr) * 64 + 16 * q + 4 * fq); \
        ga[set][0] = *(const GAS bf16x8*)_gp; ga[set][1] = *(const GAS bf16x8*)(_gp + 32); \
        _Pragma("unroll") for (int _r = 0; _r < 2; ++_r) hq[set][_r] = *(const GAS f32x4*)(_hp + (16 * _r) * 64); } while (0)
    PB_LOAD(0, 0); PB_LOAD(1, 1); PB_LOAD(2, 2); PB_LOAD(3, 3); PB_LOAD(4, 4); PB_LOAD(5, 5);
    for (int c7 = 0; c7 < NCH - 1; c7 += 7) {
#pragma unroll
        for (int u7 = 0; u7 < 7; ++u7) {
            const int c = c7 + u7;
            f32x4 acc[2];
#pragma unroll
            for (int it = 0; it < 2; ++it) acc[it] = hq[u7][it];
            const bf16x8 a0 = ga[u7][0], a1 = ga[u7][1];
            PB_LOAD((u7 + 6) % 7, (c + 6 < NCH - 1) ? c + 6 : NCH - 2);
            if (c > 0) {
#pragma unroll
                for (int it = 0; it < 2; ++it) {
                    acc[it] = __builtin_amdgcn_mfma_f32_16x16x32_bf16(a0, *(const LAS bf16x8*)(Sx0 + (c & 1) * W_SLOT + (32 * ih + 16 * it + fr) * WRS + fq * 16), acc[it], 0, 0, 0);
                    acc[it] = __builtin_amdgcn_mfma_f32_16x16x32_bf16(a1, *(const LAS bf16x8*)(Sx0 + (c & 1) * W_SLOT + (32 * ih + 16 * it + fr) * WRS + 64 + fq * 16), acc[it], 0, 0, 0); }
            }
            GAS bf16_t* op = (GAS bf16_t*)gh_ptr(wsl, bh, c, 0) + 4096 + (32 * ih + fr) * 64 + 16 * q + 4 * fq;
#pragma unroll
            for (int it = 0; it < 2; ++it) { u32x2 w; w.x = cvt_pk_bf16(acc[it].x, acc[it].y); w.y = cvt_pk_bf16(acc[it].z, acc[it].w);
                *(GAS u32x2*)(op + (16 * it) * 64) = w; *(LAS u32x2*)(Sx0 + ((c + 1) & 1) * W_SLOT + (32 * ih + 16 * it + fr) * WRS + (16 * q + 4 * fq) * 2) = w; }
            LDS_BARRIER();
        }
    }
#undef PB_LOAD
}

DI void ln1_router(const Ctx& F, const Params& P, int l, const float* xin) {
    unsigned char* const wsl = F.ws; float* const outl = F.out; (void)outl;
    const float* g = PIN(5) + (size_t)l * DM; const float* bta = PIN(6) + (size_t)l * DM;
    const float* gb = PIN(10) + l * 4; const float* eb = PIN(12) + l * 32;
    const bf16_t* hb = (const bf16_t*)(wsl + WS_HB); bf16_t* xb = (bf16_t*)(wsl + WS_XB); float* xo = outl;
    const bf16_t* wrt = (const bf16_t*)(wsl + WS_WSW + (size_t)l * WSW_STRIDE);
    unsigned* cnt = (unsigned*)(wsl + WS_CTL) + CW_CNT + l * 32 * 64;
    int* ltok = (int*)(wsl + WS_LTOK); float* lgate = (float*)(wsl + WS_LGATE); int* lslot = (int*)(wsl + WS_LSLOT);
    const int lane = F.lane, fr = lane & 15, fq = lane >> 4, wave = F.wave;
    LAS float* lg = (LAS float*)(F.lds + (wave & 3) * 4096);
    LAS float* lgp = (LAS float*)(F.lds + 16384 + (wave & 3) * 4096);
    LAS int* cntl = (LAS int*)(F.lds + 32768); LAS int* basel = cntl + 32;
    if (F.tid < NEXP) cntl[F.tid] = 0;
    __syncthreads();
    for (int blk = F.bid; blk < NTOK / 64; blk += F.G) {
#pragma unroll 1
        for (int pass = 0; pass < 4; ++pass) {
            int lno = lane; asm volatile("" : "+v"(lno));
            const int hr2 = lno >> 5, l32 = lno & 31;
            const size_t ro = (size_t)(blk * 64 + wave * 8 + pass * 2 + hr2) * DM + 8 * l32;
            u32x4 xr[8], hr[8];
#pragma unroll
            for (int i = 0; i < 8; ++i) { xr[i] = *(const GAS u32x4*)(xb + ro + 256 * i); hr[i] = *(const GAS u32x4*)(hb + ro + 256 * i); }
            float s = 0.f, s2 = 0.f;
#pragma unroll
            for (int i = 0; i < 8; ++i) {
#pragma unroll
                for (int e = 0; e < 4; ++e) { const float v0 = ALPHA * bflo(xr[i][e]) + bflo(hr[i][e]), v1 = ALPHA * bfhi(xr[i][e]) + bfhi(hr[i][e]); s += v0 + v1; s2 += v0 * v0 + v1 * v1; } }
            s = sum16(s); s2 = sum16(s2); s += __shfl_xor(s, 16); s2 += __shfl_xor(s2, 16);
            const float mean = s * (1.f / DM), rstd = rsqrtf(fmaxf(s2 * (1.f / DM) - mean * mean, 0.f) + LN_EPS);
#pragma unroll
            for (int i = 0; i < 8; ++i) { const int col = 256 * i + 8 * l32;
                const f32x4 g0 = *(const GAS f32x4*)(g + col), g1 = *(const GAS f32x4*)(g + col + 4), b0 = *(const GAS f32x4*)(bta + col), b1 = *(const GAS f32x4*)(bta + col + 4);
                u32x4 w;
#pragma unroll
                for (int e = 0; e < 4; ++e) { const float v0 = ALPHA * bflo(xr[i][e]) + bflo(hr[i][e]), v1 = ALPHA * bfhi(xr[i][e]) + bfhi(hr[i][e]);
                    const float gg0 = e < 2 ? g0[2 * e] : g1[2 * e - 4], gg1 = e < 2 ? g0[2 * e + 1] : g1[2 * e - 3], bb0 = e < 2 ? b0[2 * e] : b1[2 * e - 4], bb1 = e < 2 ? b0[2 * e + 1] : b1[2 * e - 3];
                    w[e] = cvt_pk_bf16((v0 - mean) * rstd * gg0 + bb0, (v1 - mean) * rstd * gg1 + bb1); }
                *(GAS u32x4*)(xb + ro + 256 * i) = w;
                asm volatile("" ::: "memory"); }
        }
        VM_WAIT();
        __syncthreads();
        __builtin_amdgcn_fence(__ATOMIC_ACQUIRE, "agent");
        VM_WAIT();
        const int row0 = blk * 64 + (wave & 3) * 16, kh = wave >> 2, krot = (F.bid * 5 + wave * 3) & 31;
        f32x4 acc[3];
#pragma unroll
        for (int ct = 0; ct < 3; ++ct) acc[ct] = (f32x4){0.f, 0.f, 0.f, 0.f};
        const bf16_t* arow = xb + (size_t)(row0 + fr) * DM + 8 * fq + kh * 1024;
        LAS unsigned char* wst = F.lds + 36864;
        u32x4 wreg[6];
        { const int st = F.bid & 7;
#pragma unroll
          for (int i = 0; i < 6; ++i) { const int ch = F.tid + NT * i, row = ch >> 4, c16 = ch & 15, rkh = row / 96, rr = row - rkh * 96;
              wreg[i] = *(const GAS u32x4*)(wrt + (size_t)rr * DM + rkh * 1024 + st * 128 + c16 * 8); } }
#pragma unroll 1
        for (int si = 0; si < 8; ++si) {
            const int st = (si + F.bid) & 7;
            LAS unsigned char* wb = wst + (si & 1) * 52224;
#pragma unroll
            for (int i = 0; i < 6; ++i) { const int ch = F.tid + NT * i, row = ch >> 4, c16 = ch & 15; *(LAS u32x4*)(wb + row * 272 + c16 * 16) = wreg[i]; }
            if (si + 1 < 8) { const int stn = (si + 1 + F.bid) & 7;
#pragma unroll
                for (int i = 0; i < 6; ++i) { const int ch = F.tid + NT * i, row = ch >> 4, c16 = ch & 15, rkh = row / 96, rr = row - rkh * 96;
                    wreg[i] = *(const GAS u32x4*)(wrt + (size_t)rr * DM + rkh * 1024 + stn * 128 + c16 * 8); } }
            bf16x8 af[4];
#pragma unroll
            for (int ksl = 0; ksl < 4; ++ksl) af[ksl] = *(const GAS bf16x8*)(arow + st * 128 + ksl * 32);
            LDS_BARRIER();
#pragma unroll
            for (int ksl = 0; ksl < 4; ++ksl)
#pragma unroll
                for (int ct = 0; ct < 3; ++ct) {
                    acc[ct] = __builtin_amdgcn_mfma_f32_16x16x32_bf16(af[ksl], *(const LAS bf16x8*)(wb + (kh * 96 + 16 * ct + fr) * 272 + ksl * 64 + fq * 16), acc[ct], 0, 0, 0);
                    acc[ct] = __builtin_amdgcn_mfma_f32_16x16x32_bf16(af[ksl], *(const LAS bf16x8*)(wb + (kh * 96 + 48 + 16 * ct + fr) * 272 + ksl * 64 + fq * 16), acc[ct], 0, 0, 0);
                }
        }
        if (kh == 1) {
#pragma unroll
            for (int ct = 0; ct < 3; ++ct)
#pragma unroll
                for (int jj = 0; jj < 4; ++jj) lgp[(4 * fq + jj) * 48 + 16 * ct + fr] = acc[ct][jj];
        }
        __syncthreads();
        if (kh == 0) {
#pragma unroll
            for (int ct = 0; ct < 3; ++ct)
#pragma unroll
                for (int jj = 0; jj < 4; ++jj) lg[(4 * fq + jj) * 48 + 16 * ct + fr] = acc[ct][jj] + lgp[(4 * fq + jj) * 48 + 16 * ct + fr];
        }
        LDS_WAIT();
        int se0 = 0, se1 = 0, sr0 = 0, sr1 = 0, stok = 0; float sg0 = 0.f, sg1 = 0.f;
        if (kh == 0 && lane < 16) {
            const LAS float* L = lg + lane * 48; const int tok = row0 + lane;
            float gl[4]; int grp_i = 0; float gmx;
#pragma unroll
            for (int q = 0; q < 4; ++q) gl[q] = L[q] + gb[q];
            gmx = gl[0];
#pragma unroll
            for (int q = 1; q < 4; ++q) if (gl[q] > gmx) { gmx = gl[q]; grp_i = q; }
            float gs = 0.f;
#pragma unroll
            for (int q = 0; q < 4; ++q) gs += __expf(gl[q] - gmx);
            const float pg = 1.f / gs;
            float el[8];
#pragma unroll
            for (int q = 0; q < 8; ++q) el[q] = L[4 + 8 * grp_i + q] + eb[8 * grp_i + q];
            int i0 = 0; float m0 = el[0];
#pragma unroll
            for (int q = 1; q < 8; ++q) if (el[q] > m0) { m0 = el[q]; i0 = q; }
            int i1 = -1; float m1 = -3.0e38f;
#pragma unroll
            for (int q = 0; q < 8; ++q) if (q != i0 && el[q] > m1) { m1 = el[q]; i1 = q; }
            if (i1 < 0) { i1 = (i0 == 0) ? 1 : 0; m1 = m0; }
            const float p1 = __expf(m1 - m0), den = 1.f / (1.f + p1);
            const float g0 = pg * den, g1 = pg * p1 * den;
            se0 = grp_i * 8 + i0; se1 = grp_i * 8 + i1; sg0 = g0; sg1 = g1; stok = tok;
            sr0 = __hip_atomic_fetch_add(cntl + se0, 1, __ATOMIC_RELAXED, __HIP_MEMORY_SCOPE_WORKGROUP);
            sr1 = __hip_atomic_fetch_add(cntl + se1, 1, __ATOMIC_RELAXED, __HIP_MEMORY_SCOPE_WORKGROUP);
        }
        __syncthreads();
        if (wave == 0 && lane < NEXP) { const int n = cntl[lane]; basel[lane] = n ? (int)__hip_atomic_fetch_add(cnt + lane * 64, (unsigned)n, __ATOMIC_RELAXED, __HIP_MEMORY_SCOPE_AGENT) : 0; }
        __syncthreads();
        if (kh == 0 && lane < 16) {
            const int pos0 = basel[se0] + sr0, pos1 = basel[se1] + sr1;
            ltok[se0 * LISTCAP + pos0] = stok; lgate[se0 * LISTCAP + pos0] = sg0; lslot[se0 * LISTCAP + pos0] = 2 * stok;
            ltok[se1 * LISTCAP + pos1] = stok; lgate[se1 * LISTCAP + pos1] = sg1; lslot[se1 * LISTCAP + pos1] = 2 * stok + 1;
        }
        __syncthreads();
        if (F.tid < NEXP) cntl[F.tid] = 0;
        __syncthreads();
    }
}

DI void ln2_phase(const Ctx& F, const Params& P, int l) {
    unsigned char* const wsl = F.ws; float* const outl = F.out;
    const float* g = PIN(7) + (size_t)l * DM; const float* bta = PIN(8) + (size_t)l * DM;
    const bf16_t* ys = (const bf16_t*)(wsl + WS_YS); bf16_t* xb = (bf16_t*)(wsl + WS_XB); float* xo = outl;
#pragma unroll 1
    for (int rp = F.gw; rp < NTOK / 2; rp += F.ngw) {
        int lno = F.lane; asm volatile("" : "+v"(lno));
        const int hr2 = lno >> 5, l32 = lno & 31, row = 2 * rp + hr2;
        const size_t ro = (size_t)row * DM + 8 * l32;
        u32x4 xr[8], y0[8], y1[8];
#pragma unroll
        for (int i = 0; i < 8; ++i) { xr[i] = *(const GAS u32x4*)(xb + ro + 256 * i); y0[i] = *(const GAS u32x4*)(ys + 2 * (size_t)row * DM + 8 * l32 + 256 * i); y1[i] = *(const GAS u32x4*)(ys + (2 * (size_t)row + 1) * DM + 8 * l32 + 256 * i); }
        float s = 0.f, s2 = 0.f;
#pragma unroll
        for (int i = 0; i < 8; ++i) {
#pragma unroll
            for (int e = 0; e < 4; ++e) { const float v0 = ALPHA * bflo(xr[i][e]) + (bflo(y0[i][e]) + bflo(y1[i][e])), v1 = ALPHA * bfhi(xr[i][e]) + (bfhi(y0[i][e]) + bfhi(y1[i][e])); s += v0 + v1; s2 += v0 * v0 + v1 * v1; } }
        s = sum16(s); s2 = sum16(s2); s += __shfl_xor(s, 16); s2 += __shfl_xor(s2, 16);
        const float mean = s * (1.f / DM), rstd = rsqrtf(fmaxf(s2 * (1.f / DM) - mean * mean, 0.f) + LN_EPS);
#pragma unroll
        for (int i = 0; i < 8; ++i) { const int col = 256 * i + 8 * l32;
            const f32x4 g0 = *(const GAS f32x4*)(g + col), g1 = *(const GAS f32x4*)(g + col + 4), b0 = *(const GAS f32x4*)(bta + col), b1 = *(const GAS f32x4*)(bta + col + 4);
            float o[8];
#pragma unroll
            for (int e = 0; e < 4; ++e) { const float v0 = ALPHA * bflo(xr[i][e]) + (bflo(y0[i][e]) + bflo(y1[i][e])), v1 = ALPHA * bfhi(xr[i][e]) + (bfhi(y0[i][e]) + bfhi(y1[i][e]));
                const float gg0 = e < 2 ? g0[2 * e] : g1[2 * e - 4], gg1 = e < 2 ? g0[2 * e + 1] : g1[2 * e - 3], bb0 = e < 2 ? b0[2 * e] : b1[2 * e - 4], bb1 = e < 2 ? b0[2 * e + 1] : b1[2 * e - 3];
                o[2 * e] = (v0 - mean) * rstd * gg0 + bb0; o[2 * e + 1] = (v1 - mean) * rstd * gg1 + bb1; }
            if (l == NLAYER - 1) { *(GAS f32x4*)(xo + (size_t)row * DM + col) = (f32x4){o[0], o[1], o[2], o[3]}; *(GAS f32x4*)(xo + (size_t)row * DM + col + 4) = (f32x4){o[4], o[5], o[6], o[7]}; }
            else { u32x4 w; w.x = cvt_pk_bf16(o[0], o[1]); w.y = cvt_pk_bf16(o[2], o[3]); w.z = cvt_pk_bf16(o[4], o[5]); w.w = cvt_pk_bf16(o[6], o[7]); *(GAS u32x4*)(xb + ro + 256 * i) = w; }
            asm volatile("" ::: "memory"); }
    }
}

DI int moe_table(const Ctx& F, int l) {
    unsigned char* const wsl = F.ws; float* const outl = F.out; (void)outl;
    LAS int* tb = (LAS int*)(F.lds + LDS_CTL_OFF) + 16;
    const unsigned* cnt = (const unsigned*)(wsl + WS_CTL) + CW_CNT + l * 32 * 64;
    __syncthreads();
    if (F.tid == 0) { int acc = 0;
        for (int e = 0; e < NEXP; ++e) { tb[e] = acc; const int n = (int)__hip_atomic_load(cnt + e * 64, __ATOMIC_RELAXED, __HIP_MEMORY_SCOPE_AGENT); acc += (n + 255) >> 8; }
        tb[NEXP] = acc; }
    __syncthreads();
    return tb[NEXP];
}


#ifdef MK_DEBUG
constexpr int CW_DBG = 40960;
DI void dbg_count_bf16(const Ctx& F, const bf16_t* p, size_t n, int k) {
    unsigned bad = 0; const size_t gt = (size_t)F.bid * NT + F.tid, ngt = (size_t)F.G * NT;
    for (size_t i = gt; i < n; i += ngt) { const unsigned b = p[i]; const float v = bf2f(b); if ((b & 0x7f80u) == 0x7f80u || fabsf(v) > 1.0e6f) ++bad; }
    if (bad) atomicAdd((unsigned*)(F.ws + WS_CTL) + CW_DBG + k * 64, bad);
}
DI void dbg_count_f32(const Ctx& F, const float* p, size_t n, int k) {
    unsigned bad = 0; const size_t gt = (size_t)F.bid * NT + F.tid, ngt = (size_t)F.G * NT;
    for (size_t i = gt; i < n; i += ngt) { const float v = p[i]; if (!(fabsf(v) <= 1.0e6f)) ++bad; }
    if (bad) atomicAdd((unsigned*)(F.ws + WS_CTL) + CW_DBG + k * 64, bad);
}
#endif
constexpr int PH_PER_LAYER = 11, N_PHASES = 1 + NLAYER * PH_PER_LAYER;

__global__ void __launch_bounds__(NT, 2) mega_fwd(Params P) {
    extern __shared__ __attribute__((aligned(16))) unsigned char lds_raw[];
    Ctx F0;
    F0.lds = (LAS unsigned char*)lds_raw;
    F0.tid = threadIdx.x; F0.lane = F0.tid & 63; F0.wave = __builtin_amdgcn_readfirstlane(F0.tid >> 6);
    F0.G = gridDim.x; F0.bid = blockIdx.x; F0.gw = F0.bid * NWAVES + F0.wave; F0.ngw = F0.G * NWAVES;
    F0.ws = P.ws; F0.out = P.out;
    for (int u = F0.tid; u < (LDS_BYTES - LDS_CTL_OFF) / 4; u += NT) ((LAS unsigned*)(F0.lds + LDS_CTL_OFF))[u] = 0u;
    __syncthreads();
    XcdBarrier bar; bar.bar = (unsigned*)(F0.ws + WS_CTL) + CW_BAR; bar.x = 0; bar.st = nullptr;
#if !MK_PER_PHASE
    bar = xcd_barrier_post((unsigned*)(F0.ws + WS_CTL) + CW_BAR, (volatile LAS unsigned*)(F0.lds + LDS_CTL_OFF));
#endif
    const int lo = P.ph_lo, hi = P.ph_hi;
#define IN(k) (lo <= (k) && (k) < hi)
#if MK_PER_PHASE
#define SEAM(k) do { } while (0)
#else
#define SEAM(k) do { if ((k) + 1 < hi) { XcdBarrier _b = bar; asm volatile("" : "+s"(_b.bar), "+s"(_b.x)); xcd_barrier(_b); } } while (0)
#endif
#define WSL const Ctx F = relaunder(F0); unsigned char* const ws = F.ws; bf16_t* const xb = (bf16_t*)(ws + WS_XB); bf16_t* const zb = (bf16_t*)(ws + WS_Z); bf16_t* const cat = (bf16_t*)(ws + WS_CAT); (void)xb; (void)zb; (void)cat

    if (IN(0)) { WSL; phase_prologue(F, P); SEAM(0); }

    for (int l = 0; l < NLAYER; ++l) {
        const int kind = l % 3, j = l / 3, pb = 1 + l * PH_PER_LAYER;
        const int zw = (kind == 0) ? ZW_RWKV : ZW_OTH, qcol = (kind == 0) ? 5056 : 4608;
        if (IN(pb + 0)) {
            WSL; const bf16_t* winT = (const bf16_t*)(ws + WS_WIN + (size_t)l * WIN_STRIDE);
            if (kind != 2) dense_gemm(F, xb, DM, winT, DM, NTOK, zw, DM, zb, zw, 0);
            else {
                dense_gemm(F, xb, DM, winT, DM, NTOK, 3072, DM, zb, zw, 0);
                dense_gemm(F, xb, DM, winT + (size_t)4608 * DM, DM, NTOK, 512, DM, zb + 4608, zw, 0);
                dense_gemm(F, winT + (size_t)3072 * DM, DM, xb, DM, CMIX, NTOK, DM, (bf16_t*)(ws + WS_ACT), NTOK, 128);
            }
            if (l == 0) {
                dense_gemm(F, (const bf16_t*)(ws + WS_MEMB), DM, (const bf16_t*)(ws + WS_WK), DM, NBATCH * MEML, 2048, DM, (bf16_t*)(ws + WS_KM), 2048, 128);
                dense_gemm(F, (const bf16_t*)(ws + WS_WV), DM, (const bf16_t*)(ws + WS_MEMB), DM, 2048, NBATCH * MEML, DM, (bf16_t*)(ws + WS_VMT), 1024, 192);
            }
            SEAM(pb + 0);
        }
        if (IN(pb + 1)) {
            WSL;
            if (kind == 0) { for (int rep = 0; rep < REP_PREP; ++rep) rwkv_prep1(F, P, j, zb); for (int rep = 0; rep < REP_MIX * REP_MA; ++rep) memattn_all(F, l, zb, zw, qcol); }
            else if (kind == 1) { for (int rep = 0; rep < REP_MIX; ++rep) conv_mix(F, P, zb); for (int rep = 0; rep < REP_MIX * REP_MA; ++rep) memattn_all(F, l, zb, zw, qcol); for (int rep = 0; rep < REP_CONV; ++rep) expert_convert(F, P, l, F.gw, F.ngw); }
            else { for (int rep = 0; rep < REP_MIX * REP_SB; ++rep) sb_attention(F, zb); for (int rep = 0; rep < REP_MIX * REP_MA; ++rep) memattn_all(F, l, zb, zw, qcol); for (int rep = 0; rep < REP_CONV; ++rep) expert_convert(F, P, l, F.gw, F.ngw); }
            SEAM(pb + 1);
        }
        if (kind == 0) {
            if (IN(pb + 2)) {
                WSL; const bf16_t* act = (const bf16_t*)(ws + WS_ACT); const bf16_t* wa = (const bf16_t*)(ws + WS_LORA + (size_t)j * LORA_STRIDE);
                dense_gemm(F, act, 512, wa, 256, NTOK, 3072, 256, (bf16_t*)(ws + WS_LW), 3072, 0);
                dense_gemm(F, act + 256, 512, wa + (size_t)3072 * 256, 256, NTOK, CMIX, 256, (bf16_t*)(ws + WS_GATE), CMIX, 0);
                SEAM(pb + 2);
            }
            if (IN(pb + 3)) { WSL; const RwPar Q{PIN(17) + (size_t)j * 5056, PIN(18) + j * CMIX, PIN(20) + j * CMIX, PIN(23) + j * CMIX, PIN(24) + j * CMIX, PIN(25) + j * CMIX, PIN(26) + j * CMIX, PIN(27) + j * CMIX};
                for (int rep = 0; rep < REP_SCAN; ++rep) scan_w1(F, Q, zb); SEAM(pb + 3); }
            if (IN(pb + 4)) {
                WSL;
                if (F.bid < 96) scan_passB(F);
                else expert_convert(F, P, l, (F.bid - 96) * NWAVES + F.wave, (F.G - 96) * NWAVES);
                SEAM(pb + 4);
            }
            if (IN(pb + 5)) { WSL; const RwPar Q{PIN(17) + (size_t)j * 5056, PIN(18) + j * CMIX, PIN(20) + j * CMIX, PIN(23) + j * CMIX, PIN(24) + j * CMIX, PIN(25) + j * CMIX, PIN(26) + j * CMIX, PIN(27) + j * CMIX};
                for (int rep = 0; rep < REP_SCAN * REP_W2; ++rep) scan_w2(F, Q); SEAM(pb + 5); }
        }
        if (IN(pb + 6)) { WSL; dense_gemm(F, cat, DM, (const bf16_t*)(ws + WS_WOUT) + (size_t)l * DM * DM, DM, NTOK, DM, DM, (bf16_t*)(ws + WS_HB), DM, 0); SEAM(pb + 6); }
        if (IN(pb + 7)) { WSL; ln1_router(F, P, l, l == 0 ? PIN(0) : (const float*)P.out); SEAM(pb + 7); }
        if (IN(pb + 8)) {
            WSL; const int ntiles = moe_table(F, l);
            pg8::Gemm g{xb, (const bf16_t*)(ws + WS_EXP1), DM, DM, DM};
            pg8::MoeOrder<true> S; S.G = F.G; S.c = F.bid; S.npn = 4; S.total = ntiles * 4; S.tb = (const LAS int*)(F.lds + LDS_CTL_OFF) + 16; S.estride = (size_t)1024 * DM * 2;
            S.ltok = (const int*)(ws + WS_LTOK); S.cnt = (const unsigned*)(ws + WS_CTL) + CW_CNT + l * 32 * 64;
            pg8::EpiSwiGLU E{(bf16_t*)(ws + WS_HE)};
            for (int rep = 0; rep < REP_MOE; ++rep) pg8::gemm_phase<pg8::EpiSwiGLU, pg8::MoeOrder<true>>(F.lds, g, S, E);
            SEAM(pb + 8);
        }
        if (IN(pb + 9)) {
            WSL; const int ntiles = moe_table(F, l);
            pg8::Gemm g{(const bf16_t*)(ws + WS_HE), (const bf16_t*)(ws + WS_EXP2), DEXP, DEXP, DEXP};
            pg8::MoeOrder<false> S; S.G = F.G; S.c = F.bid; S.npn = 8; S.total = ntiles * 8; S.tb = (const LAS int*)(F.lds + LDS_CTL_OFF) + 16; S.estride = (size_t)DM * DEXP * 2;
            S.ltok = (const int*)(ws + WS_LTOK); S.cnt = (const unsigned*)(ws + WS_CTL) + CW_CNT + l * 32 * 64;
            pg8::EpiScatter E{(bf16_t*)(ws + WS_YS), (const int*)(ws + WS_LSLOT), (const float*)(ws + WS_LGATE), S.cnt};
            for (int rep = 0; rep < REP_MOE; ++rep) pg8::gemm_phase<pg8::EpiScatter, pg8::MoeOrder<false>>(F.lds, g, S, E);
            SEAM(pb + 9);
        }
        if (IN(pb + 10)) { WSL; ln2_phase(F, P, l); SEAM(pb + 10); }
    }
#ifdef MK_DEBUG
    {
        WSL;
        xcd_barrier(bar);
        dbg_count_bf16(F, (const bf16_t*)(ws + WS_CAT), (size_t)NTOK * DM, 0);
        dbg_count_bf16(F, (const bf16_t*)(ws + WS_HB), (size_t)NTOK * DM, 1);
        dbg_count_f32(F, (const float*)(ws + WS_LGATE), (size_t)32 * 16384, 2);
        dbg_count_bf16(F, (const bf16_t*)(ws + WS_YS), (size_t)32768 * 2048, 3);
        dbg_count_f32(F, (const float*)F.out, (size_t)NTOK * DM, 4);
        dbg_count_bf16(F, (const bf16_t*)(ws + WS_XB), (size_t)NTOK * DM, 5);
        xcd_barrier(bar);
        int first = 13;
        for (int k = 12; k >= 0; --k) if (__hip_atomic_load((unsigned*)(ws + WS_CTL) + CW_DBG + k * 64, __ATOMIC_RELAXED, __HIP_MEMORY_SCOPE_AGENT) != 0u) first = k;
        const float val = 1000.f * (float)(first + 1);
        for (size_t i = (size_t)F.bid * NT + F.tid; i < (size_t)NTOK * DM; i += (size_t)F.G * NT) F.out[i] = val;
    }
#endif
#undef IN
#undef SEAM
}

extern "C" void kernel_launch(void* const* d_in, const int* in_sizes, int n_in, void* d_out, int out_size, void* d_ws, size_t ws_size, hipStream_t stream) {
    static int grid = 0;
    if (grid == 0) {
        if (n_in != 31 || ws_size < WS_END) { fprintf(stderr, "kernel_launch: expected 31 inputs and >= %zu bytes of workspace, got %d / %zu\n", (size_t)WS_END, n_in, ws_size); grid = -1; return; }
        int dev = 0, cus = 0, per_cu = 0;
        if (hipGetDevice(&dev) != hipSuccess || hipDeviceGetAttribute(&cus, hipDeviceAttributeMultiprocessorCount, dev) != hipSuccess) { grid = -1; return; }
        if (hipFuncSetAttribute((const void*)mega_fwd, hipFuncAttributeMaxDynamicSharedMemorySize, LDS_BYTES) != hipSuccess) { fprintf(stderr, "kernel_launch: hipFuncSetAttribute failed\n"); grid = -1; return; }
        if (hipOccupancyMaxActiveBlocksPerMultiprocessor(&per_cu, (const void*)mega_fwd, NT, LDS_BYTES) != hipSuccess || per_cu < 1)
            fprintf(stderr, "kernel_launch: occupancy query reports %d workgroups per CU\n", per_cu);
        (void)hipGetLastError();
        grid = cus;
    }
    if (grid < 0) return;
    (void)hipMemsetAsync((char*)d_ws + WS_CTL, 0, CTL_BYTES, stream);
    Params p{};
    for (int i = 0; i < 31; ++i) p.in[i] = (const float*)d_in[i];
    p.out = (float*)d_out; p.ws = (unsigned char*)d_ws;
#if MK_PER_PHASE
    for (int ph = 0; ph < N_PHASES; ++ph) {
        if (ph > 0) { const int l = (ph - 1) / PH_PER_LAYER, loc = (ph - 1) % PH_PER_LAYER; if ((l % 3) != 0 && loc >= 2 && loc <= 5) continue; }
        p.ph_lo = ph; p.ph_hi = ph + 1;
        hipLaunchKernelGGL(mega_fwd, dim3(grid), dim3(NT), LDS_BYTES, stream, p);
    }
#else
#ifndef MK_PH_HI
#define MK_PH_HI N_PHASES
#endif
    p.ph_lo = 0; p.ph_hi = MK_PH_HI;
    hipLaunchKernelGGL(mega_fwd, dim3(grid), dim3(NT), LDS_BYTES, stream, p);
#endif
    const hipError_t le = hipPeekAtLastError();
    if (le != hipSuccess) fprintf(stderr, "kernel_launch: launch failed: %s\n", hipGetErrorName(le));
}
```

```cpp
#include <hip/hip_runtime.h>
#include <cstdio>
#include <cstdint>

#ifndef MK_PER_PHASE
#define MK_PER_PHASE 0
#endif
#ifndef MK_PH_HI
#define MK_PH_HI N_PHASES
#endif
#ifndef REP_GEMM
#define REP_GEMM 1
#endif
#ifndef REP_MOE
#define REP_MOE 1
#endif
#ifndef REP_SCAN
#define REP_SCAN 1
#endif
#ifndef REP_PREP
#define REP_PREP 1
#endif
#ifndef REP_MIX
#define REP_MIX 1
#endif
#ifndef REP_CONV
#define REP_CONV 1
#endif
#ifndef REP_SB
#define REP_SB 1
#endif
#ifndef REP_MA
#define REP_MA 1
#endif
#ifndef REP_WX
#define REP_WX 1
#endif
#ifndef REP_WS
#define REP_WS 1
#endif
#ifndef REP_WO
#define REP_WO 1
#endif
#ifndef REP_W2
#define REP_W2 1
#endif

#define LAS __attribute__((address_space(3)))
#define GAS __attribute__((address_space(1)))
#define DI __device__ __forceinline__
typedef unsigned short bf16_t;
typedef short bf16x8 __attribute__((ext_vector_type(8)));
typedef short s16x4 __attribute__((ext_vector_type(4)));
typedef float f32x2 __attribute__((ext_vector_type(2)));
typedef float f32x4 __attribute__((ext_vector_type(4)));
typedef float f32x8 __attribute__((ext_vector_type(8)));
typedef float f32x16 __attribute__((ext_vector_type(16)));
typedef unsigned u32x2 __attribute__((ext_vector_type(2)));
typedef unsigned u32x4 __attribute__((ext_vector_type(4)));

constexpr int NTOK = 16384, DM = 2048, SEQ = 4096, NBATCH = 4, CMIX = 1536, MEMW = 512, MEML = 256, NLAYER = 4;
constexpr int ZW_RWKV = 5632  , ZW_OTH = 5120, RW_IN_COLS = 5568;
constexpr int NEXP = 32, DEXP = 512, LISTCAP = 16384, MAXTILES = 160;
constexpr float LN_EPS = 1e-5f, ALPHA = 1.681792830507429f, GN_EPS = 64e-5f;
constexpr int NT = 512, NWAVES = 8;

constexpr size_t MiB = (size_t)1 << 20;
constexpr size_t WS_CTL = 0, CTL_BYTES = 1 * MiB;
constexpr size_t WS_WIN = 2 * MiB;
constexpr size_t WIN_STRIDE = 22 * MiB;
constexpr size_t WS_WOUT = 90 * MiB;
constexpr size_t WS_WK = 122 * MiB;
constexpr size_t WS_WV = 130 * MiB;
constexpr size_t WS_MEMB = 138 * MiB;
constexpr size_t WS_KM = 142 * MiB;
constexpr size_t WS_VMT = 146 * MiB;
constexpr size_t WS_LORA = 150 * MiB;
constexpr size_t LORA_STRIDE = 3 * MiB;
constexpr size_t WS_WSW = 156 * MiB;
constexpr size_t WSW_STRIDE = 393216;
constexpr size_t WS_EXP1 = 160 * MiB;
constexpr size_t WS_EXP2 = 288 * MiB;
constexpr size_t WS_XB = 352 * MiB;
constexpr size_t WS_Z = 416 * MiB;
constexpr size_t WS_CAT = 592 * MiB;
constexpr size_t WS_HB = 656 * MiB;
constexpr size_t WS_LTOK = 720 * MiB;
constexpr size_t WS_LGATE = 722 * MiB;
constexpr size_t WS_LSLOT = 724 * MiB;
constexpr size_t WS_HE = 728 * MiB;
constexpr size_t WS_YS = 768 * MiB;
constexpr size_t WS_ACT = 896 * MiB;
constexpr size_t WS_LW = 944 * MiB;
constexpr size_t WS_GATE = 1040 * MiB;
constexpr size_t WS_SCAN = 1088 * MiB;
constexpr size_t WS_V = 1568 * MiB;
constexpr size_t WS_Y = 1664 * MiB;
constexpr size_t WS_GH = 1760 * MiB;
constexpr size_t WS_QY = 1088 * MiB;
constexpr size_t WS_Y0T = 1152 * MiB;
constexpr size_t WS_E = 1280 * MiB;
constexpr size_t WS_END = 1952 * MiB;
constexpr int CW_BAR = 4096;
constexpr int CW_CNT = 16384;

constexpr int LDS_BYTES = 147456;
constexpr int LDS_CTL_OFF = 146432;

DI float bf2f(unsigned b) { return __uint_as_float(b << 16); }
typedef float cvt_f32x2 __attribute__((ext_vector_type(2)));
typedef __bf16 cvt_bf16x2 __attribute__((ext_vector_type(2)));
DI unsigned cvt_pk_bf16(float lo, float hi) { const cvt_f32x2 v = {lo, hi}; return __builtin_bit_cast(unsigned, __builtin_convertvector(v, cvt_bf16x2)); }
DI float bflo(unsigned w) { return __uint_as_float(w << 16); }
DI float bfhi(unsigned w) { return __uint_as_float(w & 0xffff0000u); }
DI float wave_sum(float v) {
#pragma unroll
    for (int o = 1; o < 64; o <<= 1) v += __shfl_xor(v, o);
    return v;
}
DI float sum16(float v) {
    v += __builtin_bit_cast(float, __builtin_amdgcn_update_dpp(0, __builtin_bit_cast(int, v), 0x128, 0xf, 0xf, false));
    v += __builtin_bit_cast(float, __builtin_amdgcn_update_dpp(0, __builtin_bit_cast(int, v), 0x124, 0xf, 0xf, false));
    v += __builtin_bit_cast(float, __builtin_amdgcn_update_dpp(0, __builtin_bit_cast(int, v), 0x122, 0xf, 0xf, false));
    v += __builtin_bit_cast(float, __builtin_amdgcn_update_dpp(0, __builtin_bit_cast(int, v), 0x121, 0xf, 0xf, false));
    return v;
}
DI float fma_s(float a, float b, float c) { float d; asm("v_fma_f32 %0, %1, %2, %3" : "=v"(d) : "v"(a), "v"(b), "v"(c)); return d; }
DI float sigmoidf_(float x) { return __builtin_amdgcn_rcpf(1.f + __expf(-x)); }
DI float softplusf_(float x) { return fmaxf(x, 0.f) + __logf(1.f + __expf(-fabsf(x))); }
#define LDS_WAIT() asm volatile("s_waitcnt lgkmcnt(0)" ::: "memory")
#define VM_WAIT() asm volatile("s_waitcnt vmcnt(0)" ::: "memory")
#define LDS_BARRIER() do { asm volatile("s_waitcnt lgkmcnt(0)" ::: "memory"); __builtin_amdgcn_s_barrier(); asm volatile("" ::: "memory"); } while (0)

template <class T> DI T* as_global(T* p) { return p; }
DI const float* kin_ptr(int i) { int off = i * 8; asm volatile("" : "+v"(off)); const char* ka = (const char*)__builtin_amdgcn_kernarg_segment_ptr();
    const unsigned long long p = *(const unsigned long long*)(ka + off);
    const unsigned lo = __builtin_amdgcn_readfirstlane((unsigned)p), hi = __builtin_amdgcn_readfirstlane((unsigned)(p >> 32));
    return as_global((const float*)(((unsigned long long)hi << 32) | lo)); }
#define PIN(i) kin_ptr(i)
DI unsigned char* opq(unsigned char* p) { asm volatile("" : "+s"(p)); return p; }
DI float* opqf(float* p) { asm volatile("" : "+s"(p)); return p; }

#define XB_TMO      128
#define XB_XCNT(j)  (256  + 64 * (j))
#define XB_XSUB(j)  (1280 + 64 * (j))
#define XB_XGEN(j)  (2304 + 64 * (j))
#define XB_TOP      3328
#define XB_TOPGEN   3392
#define XCD_BAR_WORDS 3456
#define XB_SPIN_CAP (1u << 20)

__device__ __forceinline__ unsigned xb_ld(unsigned* p)              { return __hip_atomic_load(p, __ATOMIC_RELAXED, __HIP_MEMORY_SCOPE_AGENT); }
__device__ __forceinline__ unsigned xb_add(unsigned* p, unsigned v) { return __hip_atomic_fetch_add(p, v, __ATOMIC_RELAXED, __HIP_MEMORY_SCOPE_AGENT); }
__device__ __forceinline__ unsigned xb_xcc_id() { return (unsigned)__builtin_amdgcn_s_getreg((3 << 11) | 20) & 0xFu; }
#define XB_SPIN(cond, bar) do { unsigned _sp = 0; while (cond) { __builtin_amdgcn_s_sleep(1); \
    if ((++_sp & 255u) == 0u) { if (xb_ld(&(bar)[XB_TMO])) break; if (_sp > XB_SPIN_CAP) { atomicAdd(&(bar)[XB_TMO], 1u); break; } } } } while (0)

struct XcdBarrier { unsigned* bar; unsigned x; volatile LAS unsigned* st; };

__device__ __forceinline__ XcdBarrier xcd_barrier_post(unsigned* bar, volatile LAS unsigned* st) {
    XcdBarrier b; b.bar = bar; b.x = xb_xcc_id(); b.st = st;
    if (threadIdx.x == 0) (void)xb_add(&bar[XB_XCNT(b.x)], 1u);
    return b;
}
__device__ __forceinline__ void xcd_barrier_complete(unsigned* bar, unsigned x, unsigned& nloc, unsigned& nx) {
    const unsigned G = gridDim.x * gridDim.y * gridDim.z;
    unsigned sum, cnt, mine, sp = 0u;
    for (;;) {
        sum = 0u; cnt = 0u; mine = 0u;
#pragma unroll
        for (unsigned j = 0; j < 16; ++j) { const unsigned c = xb_ld(&bar[XB_XCNT(j)]); sum += c; cnt += (c > 0u) ? 1u : 0u; mine = (j == x) ? c : mine; }
        if (sum == G) break;
        __builtin_amdgcn_s_sleep(1);
        if ((++sp & 255u) == 0u) { if (xb_ld(&bar[XB_TMO])) break; if (sp > XB_SPIN_CAP) { atomicAdd(&bar[XB_TMO], 1u); break; } }
    }
    nloc = mine > 0u ? mine : 1u; nx = cnt > 0u ? cnt : 1u;
}
__device__ __forceinline__ void xcd_barrier(const XcdBarrier& b) {
    asm volatile("s_waitcnt vmcnt(0)" ::: "memory");
    __syncthreads();
    if (threadIdx.x == 0) {
        unsigned* bar = b.bar;
        __builtin_amdgcn_s_waitcnt(0);
        unsigned nloc = b.st[0], nx = b.st[1];
        if (nloc == 0u) { xcd_barrier_complete(bar, b.x, nloc, nx); b.st[0] = nloc; b.st[1] = nx; }
        const unsigned old = xb_add(&bar[XB_XSUB(b.x)], 1u);
        const unsigned gen = old / nloc;
        if (old + 1u == (gen + 1u) * nloc) {
            __builtin_amdgcn_fence(__ATOMIC_RELEASE, "agent");
            asm volatile("s_waitcnt vmcnt(0)" ::: "memory");
            const unsigned og = xb_add(&bar[XB_TOP], 1u);
            const unsigned tg = og / nx;
            if (og + 1u == (tg + 1u) * nx) xb_add(&bar[XB_TOPGEN], 1u);
            else XB_SPIN(xb_ld(&bar[XB_TOPGEN]) == tg, bar);
            __builtin_amdgcn_fence(__ATOMIC_ACQUIRE, "agent");
            xb_add(&bar[XB_XGEN(b.x)], 1u);
            asm volatile("s_waitcnt vmcnt(0)" ::: "memory");
        } else {
            XB_SPIN(xb_ld(&bar[XB_XGEN(b.x)]) == gen, bar);
            __builtin_amdgcn_fence(__ATOMIC_ACQUIRE, "agent");
            asm volatile("s_waitcnt vmcnt(0)" ::: "memory");
        }
    }
    __syncthreads();
}

namespace pg8 {
constexpr int BM = 256, BK = 64, HALF = 128, HTB = HALF * BK * 2, STAGE_BYTES = 8 * HTB, NXCD = 8, WGM = 8;
DI int lds_byte(int r, int c) { const int st = (r >> 4) * 2 + (c >> 5), rr = r & 15, cc = c & 31, ob = rr * 64 + cc * 2; return st * 1024 + (ob ^ (((ob >> 9) & 1) << 5)); }
DI void stage_rc(int b, int& R, int& C) { const int st = b / 1024, sb = b % 1024, swz = sb ^ (((sb >> 9) & 1) << 5); R = (st >> 1) * 16 + swz / 64; C = (st & 1) * 32 + (swz % 64) / 2; }
DI int perm32(int rho) { const int n = rho >> 4, i = rho & 15; return 8 * (i >> 2) + 4 * n + (i & 3); }

struct Unit { int pm, pn, e, rt; };
struct Gemm { const bf16_t* A; const bf16_t* Bt; int lda, ldb, K; };

struct StaticOrder {
    static constexpr bool GATHER = false;
    int nM, nN, nwg, G, c;
    DI void init(int M, int N, int G_, int c_) { nM = M / BM; nN = N / BM; nwg = nM * nN; G = G_; c = c_; }
    DI bool next(int i, Unit& u) const {
        const long L = (long)i * G + c; if (L >= nwg) return false;
        int wgid = (int)L; { const int q = nwg / NXCD, r = nwg % NXCD, xcd = wgid % NXCD, off = wgid / NXCD; wgid = (xcd < r ? xcd * (q + 1) : r * (q + 1) + (xcd - r) * q) + off; }
        const int nig = WGM * nN, gid = wgid / nig, fm = gid * WGM, gsz = (nM - fm) < WGM ? (nM - fm) : WGM;
        u.pm = fm + ((wgid % nig) % gsz); u.pn = (wgid % nig) / gsz; u.e = 0; u.rt = 0; return true;
    }
    DI const char* a_base(const Gemm& g, const Unit& u) const { return (const char*)g.A + (size_t)u.pm * BM * g.lda * 2; }
    DI const char* b_base(const Gemm& g, const Unit& u) const { return (const char*)g.Bt + (size_t)u.pn * BM * g.ldb * 2; }
    DI unsigned gather_voff(const Unit&, int, int, int) const { return 0u; }
};

template <bool GATH> struct MoeOrder {
    static constexpr bool GATHER = GATH;
    int G, c, npn, total; const LAS int* tb; size_t estride; const int* ltok; const unsigned* cnt;
    DI bool next(int i, Unit& u) const {
        if ((G & 7) == 0) {
            const int x = c & 7, r = c >> 3, W = G >> 3, idx = i * W + r;
            const int q = idx / npn, pn = idx - q * npn; int base = 0;
#pragma unroll
            for (int k = 0; k < 4; ++k) { const int e = x + 8 * k, nt = tb[e + 1] - tb[e];
                if (q < base + nt) { u.e = e; u.rt = q - base; u.pm = tb[e] + u.rt; u.pn = pn; return true; }
                base += nt; }
            return false;
        }
        const int L = i * G + c; if (L >= total) return false;
        const int q = L / npn; u.pn = L - q * npn; u.pm = q;
        int e = 0; while (e < NEXP - 1 && tb[e + 1] <= q) ++e;
        u.e = e; u.rt = q - tb[e]; return true;
    }
    DI const char* a_base(const Gemm& g, const Unit& u) const { return (const char*)g.A + (size_t)u.pm * BM * g.lda * 2; }
    DI const char* b_base(const Gemm& g, const Unit& u) const { return (const char*)g.Bt + (size_t)u.e * estride + (size_t)u.pn * BM * g.ldb * 2; }
    DI unsigned gather_voff(const Unit& u, int r, int C, int lda) const {
        const int pos = u.rt * BM + r; const int n = (int)__hip_atomic_load(cnt + u.e * 64, __ATOMIC_RELAXED, __HIP_MEMORY_SCOPE_AGENT);
        const int tok = pos < n ? ltok[u.e * LISTCAP + pos] : 0;
        return (unsigned)(tok * lda + C) * 2u;
    }
};

struct EpiStore {
    bf16_t* O; int ldc;
    DI void operator()(const f32x4 (&acc)[2][2][4][2], const Unit& u, int wr, int wc, int fr, int fq) const {
        const int row0 = u.pm * BM + wr * 64 + fr, col0 = u.pn * BM + wc * 32 + 8 * fq;
#pragma unroll
        for (int ai = 0; ai < 2; ++ai)
#pragma unroll
            for (int m = 0; m < 4; ++m) { bf16_t* rowp = O + (size_t)(row0 + ai * HALF + m * 16) * ldc + col0;
#pragma unroll
                for (int bj = 0; bj < 2; ++bj) { const f32x4 v0 = acc[ai][bj][m][0], v1 = acc[ai][bj][m][1];
                    u32x4 w; w.x = cvt_pk_bf16(v0[0], v0[1]); w.y = cvt_pk_bf16(v0[2], v0[3]); w.z = cvt_pk_bf16(v1[0], v1[1]); w.w = cvt_pk_bf16(v1[2], v1[3]);
                    *(GAS u32x4*)(rowp + bj * HALF) = w; } }
    }
};
struct EpiSwiGLU {
    bf16_t* H;
    DI void operator()(const f32x4 (&acc)[2][2][4][2], const Unit& u, int wr, int wc, int fr, int fq) const {
        const int row0 = u.pm * BM + wr * 64 + fr, col0 = u.pn * HALF + wc * 32 + 8 * fq;
#pragma unroll
        for (int ai = 0; ai < 2; ++ai)
#pragma unroll
            for (int m = 0; m < 4; ++m) { bf16_t* rowp = H + (size_t)(row0 + ai * HALF + m * 16) * DEXP + col0;
                float h[8];
#pragma unroll
                for (int n = 0; n < 2; ++n)
#pragma unroll
                    for (int j = 0; j < 4; ++j) { const float gt = acc[ai][0][m][n][j], up = acc[ai][1][m][n][j]; h[n * 4 + j] = gt * __builtin_amdgcn_rcpf(1.f + __expf(-gt)) * up; }
                u32x4 w; w.x = cvt_pk_bf16(h[0], h[1]); w.y = cvt_pk_bf16(h[2], h[3]); w.z = cvt_pk_bf16(h[4], h[5]); w.w = cvt_pk_bf16(h[6], h[7]);
                *(GAS u32x4*)rowp = w; }
    }
};
struct EpiScatter {
    bf16_t* YS; const int* lslot; const float* lgate; const unsigned* cnt;
    DI void operator()(const f32x4 (&acc)[2][2][4][2], const Unit& u, int wr, int wc, int fr, int fq) const {
        const int n = (int)__hip_atomic_load(cnt + u.e * 64, __ATOMIC_RELAXED, __HIP_MEMORY_SCOPE_AGENT);
        const int col0 = u.pn * BM + wc * 32 + 8 * fq;
#pragma unroll
        for (int ai = 0; ai < 2; ++ai)
#pragma unroll
            for (int m = 0; m < 4; ++m) { const int pos = u.rt * BM + ai * HALF + wr * 64 + m * 16 + fr;
                if (pos < n) { const int slot = lslot[u.e * LISTCAP + pos]; const float gt = lgate[u.e * LISTCAP + pos];
                    bf16_t* rowp = YS + (size_t)slot * DM + col0;
#pragma unroll
                    for (int bj = 0; bj < 2; ++bj) { const f32x4 v0 = acc[ai][bj][m][0] * gt, v1 = acc[ai][bj][m][1] * gt;
                        u32x4 w; w.x = cvt_pk_bf16(v0[0], v0[1]); w.y = cvt_pk_bf16(v0[2], v0[3]); w.z = cvt_pk_bf16(v1[0], v1[1]); w.w = cvt_pk_bf16(v1[2], v1[3]);
                        *(GAS u32x4*)(rowp + bj * HALF) = w; } } }
    }
};

template <class Epi, class Sched>
DI void gemm_phase(LAS unsigned char* lds, const Gemm g, const Sched& S, const Epi& E) {
    int tid = threadIdx.x; asm volatile("" : "+v"(tid));
    const int wid = __builtin_amdgcn_readfirstlane(tid >> 6), lane = tid & 63, wr = wid >> 2, wc = wid & 3, fr = lane & 15, fq = lane >> 4;
    const int K = g.K, nt = K / BK;
    unsigned voffA[2], voffB[2];
#pragma unroll
    for (int i = 0; i < 2; ++i) { int R, C; stage_rc(tid * 16 + i * 8192, R, C); const int Rb = (R & ~31) + perm32(R & 31);
        voffA[i] = (unsigned)(R * g.lda + C) * 2u; voffB[i] = (unsigned)(Rb * g.ldb + C) * 2u; }
    const size_t kstep = (size_t)(BK * 2);
    const size_t hstepA = (size_t)HALF * g.lda * 2, hstepB = (size_t)HALF * g.ldb * 2;
    const unsigned ldsw = (unsigned)wid * 1024u;
    const int aoff = lds_byte(wr * 64 + fr, fq * 8), boff = lds_byte(wc * 32 + fr, fq * 8);
    unsigned gvC[2][2], gvN[2][2];
#define PG8_SA(b, h) (((b) * 2 + (h)) * HTB)
#define PG8_SB(b, h) ((4 + (b) * 2 + (h)) * HTB)
#define PG8_STAGE(bufoff, gbase, voff) do { _Pragma("unroll") for (int _i = 0; _i < 2; ++_i) \
        __builtin_amdgcn_global_load_lds((const unsigned*)((const char*)(gbase) + (voff)[_i]), (LAS unsigned*)(lds + (bufoff) + ldsw + _i * 8192), 16, 0, 0); } while (0)
#define PG8_STAGE_A(bufoff, h, nxtsel, kt) do { \
        if constexpr (Sched::GATHER) { const char* _gb = (const char*)g.A + (size_t)(kt) * kstep; unsigned _vo[2]; _vo[0] = (nxtsel) ? gvN[h][0] : gvC[h][0]; _vo[1] = (nxtsel) ? gvN[h][1] : gvC[h][1]; PG8_STAGE(bufoff, _gb, _vo); } \
        else { const char* _gb = ((nxtsel) ? nA : cA) + (size_t)(h) * hstepA + (size_t)(kt) * kstep; PG8_STAGE(bufoff, _gb, voffA); } } while (0)
#define PG8_GSETUP(dst, u) do { if constexpr (Sched::GATHER) { _Pragma("unroll") for (int _h = 0; _h < 2; ++_h) _Pragma("unroll") for (int _i = 0; _i < 2; ++_i) { int _R, _C; stage_rc(tid * 16 + _i * 8192, _R, _C); \
        dst[_h][_i] = S.gather_voff(u, _h * HALF + _R, _C, g.lda); } asm volatile("s_waitcnt vmcnt(0)" : "+v"(dst[0][0]), "+v"(dst[0][1]), "+v"(dst[1][0]), "+v"(dst[1][1]) :: "memory"); } } while (0)
#define PG8_LDA(dst, b, h) do { _Pragma("unroll") for (int m = 0; m < 4; ++m) _Pragma("unroll") for (int k = 0; k < 2; ++k) dst[m][k] = *(const LAS bf16x8*)(lds + PG8_SA(b, h) + aoff + m * 2048 + k * 1024); } while (0)
#define PG8_LDB(dst, b, h) do { _Pragma("unroll") for (int n = 0; n < 2; ++n) _Pragma("unroll") for (int k = 0; k < 2; ++k) dst[n][k] = *(const LAS bf16x8*)(lds + PG8_SB(b, h) + boff + n * 2048 + k * 1024); } while (0)
#define PG8_MMA(ai, bj, At, Bt) do { __builtin_amdgcn_s_setprio(1); _Pragma("unroll") for (int m = 0; m < 4; ++m) _Pragma("unroll") for (int n = 0; n < 2; ++n) _Pragma("unroll") for (int k = 0; k < 2; ++k) \
        acc[ai][bj][m][n] = __builtin_amdgcn_mfma_f32_16x16x32_bf16(Bt[n][k], At[m][k], acc[ai][bj][m][n], 0, 0, 0); __builtin_amdgcn_s_setprio(0); } while (0)
#define PG8_WAIT_V(n) asm volatile("s_waitcnt vmcnt(" #n ")" ::: "memory")
#define PG8_WAIT_L(n) asm volatile("s_waitcnt lgkmcnt(" #n ")" ::: "memory")
#define PG8_BAR __builtin_amdgcn_s_barrier()
#define PG8_SCHED __builtin_amdgcn_sched_barrier(0)
    Unit cur, nxt; int ui = 0;
    if (!S.next(0, cur)) return;
    f32x4 acc[2][2][4][2];
#pragma unroll
    for (int a = 0; a < 2; ++a)
#pragma unroll
        for (int b = 0; b < 2; ++b)
#pragma unroll
            for (int m = 0; m < 4; ++m)
#pragma unroll
                for (int n = 0; n < 2; ++n) acc[a][b][m][n] = (f32x4){0.f, 0.f, 0.f, 0.f};
    bf16x8 At[4][2], B0[2][2], B1[2][2];
    const char* cA = S.a_base(g, cur); const char* cB = S.b_base(g, cur);
    const char* nA = cA;
    PG8_GSETUP(gvC, cur);
    PG8_STAGE(PG8_SB(0, 0), cB, voffB); PG8_STAGE_A(PG8_SA(0, 0), 0, false, 0); PG8_STAGE(PG8_SB(0, 1), cB + hstepB, voffB); PG8_STAGE_A(PG8_SA(0, 1), 1, false, 0);
    if (wr == 1) PG8_BAR;
    PG8_WAIT_V(4); PG8_BAR;
    PG8_STAGE(PG8_SB(1, 0), cB + kstep, voffB); PG8_STAGE_A(PG8_SA(1, 0), 0, false, 1); PG8_STAGE(PG8_SB(1, 1), cB + hstepB + kstep, voffB);
    PG8_WAIT_V(6); PG8_BAR;
    for (;;) {
        const bool has_next = S.next(ui + 1, nxt);
        nA = has_next ? S.a_base(g, nxt) : cA; const char* nB = has_next ? S.b_base(g, nxt) : cB;
        if constexpr (Sched::GATHER) { if (has_next) { PG8_GSETUP(gvN, nxt); } else {
#pragma unroll
            for (int _h = 0; _h < 2; ++_h) { gvN[_h][0] = gvC[_h][0]; gvN[_h][1] = gvC[_h][1]; } } }
        for (int t = 0; t < nt; t += 2) {
            const bool last = (t == nt - 2);
            const int kt2 = last ? 0 : t + 2;
            const char* b2 = last ? nB : cB + (size_t)(t + 2) * kstep;
            const char* b3 = b2 + kstep;
            PG8_LDB(B0, 0, 0); PG8_SCHED; PG8_LDA(At, 0, 0); PG8_STAGE_A(PG8_SA(1, 1), 1, false, t + 1);
            PG8_WAIT_L(8); PG8_BAR; PG8_WAIT_L(0); PG8_MMA(0, 0, At, B0); PG8_BAR; PG8_SCHED;
            PG8_LDB(B1, 0, 1); PG8_STAGE(PG8_SB(0, 0), b2, voffB);
            PG8_BAR; PG8_WAIT_L(0); PG8_MMA(0, 1, At, B1); PG8_BAR;
            PG8_LDA(At, 0, 1); PG8_STAGE_A(PG8_SA(0, 0), 0, last, kt2);
            PG8_BAR; PG8_WAIT_L(0); PG8_MMA(1, 0, At, B0); PG8_BAR; PG8_SCHED;
            PG8_STAGE(PG8_SB(0, 1), b2 + hstepB, voffB);
            PG8_WAIT_V(6); PG8_BAR; PG8_MMA(1, 1, At, B1); PG8_BAR;
            PG8_LDB(B0, 1, 0); PG8_SCHED; PG8_LDA(At, 1, 0); PG8_STAGE_A(PG8_SA(0, 1), 1, last, kt2);
            PG8_WAIT_L(8); PG8_BAR; PG8_WAIT_L(0); PG8_MMA(0, 0, At, B0); PG8_BAR; PG8_SCHED;
            PG8_LDB(B1, 1, 1); PG8_STAGE(PG8_SB(1, 0), b3, voffB);
            PG8_BAR; PG8_WAIT_L(0); PG8_MMA(0, 1, At, B1); PG8_BAR;
            PG8_LDA(At, 1, 1); PG8_STAGE_A(PG8_SA(1, 0), 0, last, kt2 + 1);
            PG8_BAR; PG8_WAIT_L(0); PG8_MMA(1, 0, At, B0); PG8_BAR; PG8_SCHED;
            PG8_STAGE(PG8_SB(1, 1), b3 + hstepB, voffB);
            PG8_WAIT_V(6); PG8_BAR; PG8_MMA(1, 1, At, B1); PG8_BAR;
        }
        E(acc, cur, wr, wc, fr, fq);
        if (!has_next) break;
#pragma unroll
        for (int a = 0; a < 2; ++a)
#pragma unroll
            for (int b = 0; b < 2; ++b)
#pragma unroll
                for (int m = 0; m < 4; ++m)
#pragma unroll
                    for (int n = 0; n < 2; ++n) acc[a][b][m][n] = (f32x4){0.f, 0.f, 0.f, 0.f};
        cur = nxt; cA = nA; cB = nB; ++ui;
        if constexpr (Sched::GATHER) {
#pragma unroll
            for (int _h = 0; _h < 2; ++_h) { gvC[_h][0] = gvN[_h][0]; gvC[_h][1] = gvN[_h][1]; } }
    }
    PG8_WAIT_V(0);
    if (wr == 0) PG8_BAR;
    PG8_BAR;
#undef PG8_SA
#undef PG8_SB
#undef PG8_STAGE
#undef PG8_STAGE_A
#undef PG8_GSETUP
#undef PG8_LDA
#undef PG8_LDB
#undef PG8_MMA
#undef PG8_WAIT_V
#undef PG8_WAIT_L
#undef PG8_BAR
#undef PG8_SCHED
}
}

struct Params { const float* in[31]; float* out; unsigned char* ws; int ph_lo, ph_hi; };

struct Ctx {
    LAS unsigned char* lds;
    int tid, lane, wave, G, bid, gw, ngw;
    unsigned char* ws; float* out;
};
DI Ctx relaunder(const Ctx& F0) {
    Ctx F = F0;
    asm volatile("" : "+v"(F.tid), "+v"(F.lane));
    asm volatile("" : "+s"(F.wave), "+s"(F.G), "+s"(F.bid), "+s"(F.gw), "+s"(F.ngw));
    asm volatile("" : "+s"(F.ws), "+s"(F.out));
    F.ws = as_global(F.ws); F.out = as_global(F.out);
    return F;
}

DI void dense_gemm(const Ctx& F, const bf16_t* A, int lda, const bf16_t* Bt, int ldb, int M, int N, int K, bf16_t* O, int ldc, int crot) {
    pg8::Gemm g{A, Bt, lda, ldb, K}; pg8::StaticOrder S; S.init(M, N, F.G, (F.bid + crot) % F.G);
    pg8::EpiStore E{O, ldc};
    for (int rep = 0; rep < REP_GEMM; ++rep) pg8::gemm_phase<pg8::EpiStore, pg8::StaticOrder>(F.lds, g, S, E);
}

struct TJob { const float* src; bf16_t* dst; int ldw, dld; };
DI void tr_load(const TJob& j, f32x4 (&r)[16], int lane) {
    const GAS float* p = (const GAS float*)(j.src + (size_t)(lane >> 4) * j.ldw + 4 * (lane & 15));
#pragma unroll
    for (int i = 0; i < 16; ++i) r[i] = *(const GAS f32x4*)(p + (size_t)(4 * i) * j.ldw);
}
DI void tr_store(const TJob& j, const f32x4 (&r)[16], LAS unsigned char* scr, int lane) {
#pragma unroll
    for (int i = 0; i < 16; ++i) { LAS unsigned* w = (LAS unsigned*)(scr + ((lane >> 4) + 4 * i) * 132 + (lane & 15) * 8); w[0] = cvt_pk_bf16(r[i].x, r[i].y); w[1] = cvt_pk_bf16(r[i].z, r[i].w); }
    LDS_WAIT();
    const int kc = lane & 7;
#pragma unroll
    for (int sgrp = 0; sgrp < 8; ++sgrp) { const int n = 8 * sgrp + (lane >> 3); const LAS unsigned short* c = (const LAS unsigned short*)(scr + (8 * kc) * 132 + n * 2);
        u32x4 o; o.x = (unsigned)c[0] | ((unsigned)c[66] << 16); o.y = (unsigned)c[2 * 66] | ((unsigned)c[3 * 66] << 16); o.z = (unsigned)c[4 * 66] | ((unsigned)c[5 * 66] << 16); o.w = (unsigned)c[6 * 66] | ((unsigned)c[7 * 66] << 16);
        *(GAS u32x4*)(j.dst + (size_t)n * j.dld + 8 * kc) = o; }
    LDS_WAIT();
}
template <class Dec> DI void tr_run(const Dec& D, int first, int count, int stride, LAS unsigned char* scr, int lane) {
    f32x4 A[16], B[16]; TJob ja, jb;
    int it = first; if (it >= count) return;
    ja = D(it); tr_load(ja, A, lane);
    for (;;) {
        const int it2 = it + stride; const bool h2 = it2 < count; if (h2) { jb = D(it2); tr_load(jb, B, lane); }
        tr_store(ja, A, scr, lane);
        if (!h2) break;
        const int it3 = it2 + stride; const bool h3 = it3 < count; if (h3) { ja = D(it3); tr_load(ja, A, lane); }
        tr_store(jb, B, scr, lane);
        if (!h3) break;
        it = it3;
    }
}
DI TJob mat_job(const float* W, int K, int N, bf16_t* WT, int item) {
    const int nblk = N / 64, kb = item / nblk, nb = item - kb * nblk;
    TJob j; j.src = W + (size_t)(64 * kb) * N + 64 * nb; j.dst = WT + (size_t)(64 * nb) * K + 64 * kb; j.ldw = N; j.dld = K; return j;
}
DI void row_to_bf16(const float* src, bf16_t* dst, int lane) {
    const GAS f32x4* s = (const GAS f32x4*)src + lane; GAS u32x2* o = (GAS u32x2*)dst + lane;
#pragma unroll
    for (int j = 0; j < 8; ++j) { const f32x4 v = s[64 * j]; u32x2 w; w.x = cvt_pk_bf16(v.x, v.y); w.y = cvt_pk_bf16(v.z, v.w); o[64 * j] = w; }
}

DI void phase_prologue(const Ctx& F, const Params& P) {
    unsigned char* const wsl = F.ws; float* const outl = F.out; (void)outl;
    LAS unsigned char* scr = F.lds + F.wave * 16384;
    unsigned char* ws = wsl;
    constexpr int I_RW = 32 * (RW_IN_COLS / 64), I_OT = 32 * (ZW_OTH / 64), I_WO = 32 * 32, I_KV = 32 * 8;
    constexpr int N_A = 2 * I_RW + 2 * I_OT, N_B = 4 * I_WO, N_C = 8 * I_KV, N_D = NTOK + NBATCH * MEML;
    struct ProDec { unsigned char* ws;
        DI TJob operator()(int it) const { int r = it;
            if (r < N_A) {
                if (r < I_RW) return mat_job(PIN(16), DM, RW_IN_COLS, (bf16_t*)(ws + WS_WIN), r); r -= I_RW;
                if (r < I_OT) return mat_job(PIN(28), DM, ZW_OTH, (bf16_t*)(ws + WS_WIN + WIN_STRIDE), r); r -= I_OT;
                if (r < I_OT) return mat_job(PIN(30), DM, ZW_OTH, (bf16_t*)(ws + WS_WIN + 2 * WIN_STRIDE), r); r -= I_OT;
                return mat_job(PIN(16) + (size_t)DM * RW_IN_COLS, DM, RW_IN_COLS, (bf16_t*)(ws + WS_WIN + 3 * WIN_STRIDE), r);
            }
            r -= N_A;
            if (r < N_B) { const int l = r / I_WO; return mat_job(PIN(2) + (size_t)l * DM * DM, DM, DM, (bf16_t*)(ws + WS_WOUT) + (size_t)l * DM * DM, r - l * I_WO); }
            r -= N_B;
            const int m = r / I_KV, l = m & 3; const bool isv = m >= 4;
            return mat_job(PIN(isv ? 4 : 3) + (size_t)l * DM * MEMW, DM, MEMW, (bf16_t*)(ws + (isv ? WS_WV : WS_WK)) + (size_t)l * MEMW * DM, r - m * I_KV);
        } };
    ProDec PD{ws};
    tr_run(PD, F.gw, N_A + N_B + N_C, F.ngw, scr, F.lane);
    for (int r = F.gw; r < N_D; r += F.ngw) {
        if (r < NTOK) row_to_bf16(PIN(0) + (size_t)r * DM, (bf16_t*)(ws + WS_XB) + (size_t)r * DM, F.lane);
        else row_to_bf16(PIN(1) + (size_t)(r - NTOK) * DM, (bf16_t*)(ws + WS_MEMB) + (size_t)(r - NTOK) * DM, F.lane);
    }
    const int gt = F.bid * NT + F.tid, ngt = F.G * NT;
    for (int idx = gt; idx < 2 * (3072 + 1536) * 256; idx += ngt) {
        const int j = idx / ((3072 + 1536) * 256); int r = idx - j * (3072 + 1536) * 256;
        bf16_t* base = (bf16_t*)(ws + WS_LORA + (size_t)j * LORA_STRIDE);
        const int n = r >> 8, k = r & 255; float v = 0.f;
        if (n < 1536) { if (k < 96) v = PIN(19)[((size_t)j * 96 + k) * CMIX + n]; }
        else if (n < 3072) { if (k >= 96 && k < 192) v = PIN(21)[((size_t)j * 96 + (k - 96)) * CMIX + (n - 1536)]; }
        else v = PIN(22)[((size_t)j * 256 + k) * CMIX + (n - 3072)];
        base[r] = (bf16_t)(cvt_pk_bf16(v, 0.f) & 0xffffu);
    }
    for (int idx = gt; idx < 2 * 64 * DM; idx += ngt) { const int j = idx / (64 * DM), r = idx - j * 64 * DM;
        ((bf16_t*)(ws + WS_WIN + (size_t)(j ? 3 : 0) * WIN_STRIDE))[(size_t)RW_IN_COLS * DM + r] = 0; }
    for (int idx = gt; idx < NLAYER * 48 * DM; idx += ngt) {
        const int l = idx / (48 * DM); int r = idx - l * 48 * DM; const int n = r / DM, k = r - n * DM;
        float v = 0.f;
        if (n < 4) v = PIN(9)[((size_t)l * DM + k) * 4 + n]; else if (n < 36) v = PIN(11)[((size_t)l * DM + k) * 32 + (n - 4)];
        const unsigned hi = cvt_pk_bf16(v, 0.f) & 0xffffu; const float rem = v - bf2f(hi); const unsigned lo = cvt_pk_bf16(rem, 0.f) & 0xffffu;
        bf16_t* base = (bf16_t*)(ws + WS_WSW + (size_t)l * WSW_STRIDE);
        base[r] = (bf16_t)hi; base[48 * DM + r] = (bf16_t)lo;
    }
}

DI void expert_convert(const Ctx& F, const Params& P, int l, int w, int nw) {
    unsigned char* const wsl = F.ws;
    LAS unsigned char* scr = F.lds + F.wave * 16384;
    constexpr int I_GU = NEXP * 32 * 8 * 2, I_DN = NEXP * 8 * 32;
    struct ExpDec { unsigned char* ws; int l;
        DI TJob operator()(int it) const { TJob j;
            if (it < I_GU) {
                const int isup = it / (I_GU / 2); int r = it - isup * (I_GU / 2);
                const int e = r / 256; r -= e * 256; const int kb = r >> 3, nb = r & 7;
                const float* W = PIN(isup ? 14 : 13) + ((size_t)l * NEXP + e) * DM * DEXP;
                const int n0 = 64 * nb, drow = 256 * (n0 >> 7) + (isup ? 128 : 0) + (n0 & 127);
                j.src = W + (size_t)(64 * kb) * DEXP + n0; j.ldw = DEXP; j.dst = (bf16_t*)(ws + WS_EXP1) + ((size_t)e * 1024 + drow) * DM + 64 * kb; j.dld = DM;
            } else {
                int r = it - I_GU; const int e = r / 256; r -= e * 256; const int kb = r >> 5, nb = r & 31;
                const float* W = PIN(15) + ((size_t)l * NEXP + e) * DEXP * DM;
                j.src = W + (size_t)(64 * kb) * DM + 64 * nb; j.ldw = DM; j.dst = (bf16_t*)(ws + WS_EXP2) + ((size_t)e * DM + 64 * nb) * DEXP + 64 * kb; j.dld = DEXP;
            }
            return j; } };
    ExpDec ED{wsl, l};
    tr_run(ED, w, I_GU + I_DN, nw, scr, F.lane);
}

DI void memattn_unit(const Ctx& F, int l, int unit, const bf16_t* z, int zw, int qcol) {
    unsigned char* const wsl = F.ws; float* const outl = F.out; (void)outl;
    const int b = unit >> 6, head = (unit >> 4) & 3, qblk = unit & 15;
    LAS unsigned char* Ks = F.lds; LAS unsigned char* Vs = F.lds + 69632;
    const bf16_t* Km = (const bf16_t*)(wsl + WS_KM); const bf16_t* VmT = (const bf16_t*)(wsl + WS_VMT);
    bf16_t* cat = (bf16_t*)(wsl + WS_CAT);
    __syncthreads();
#pragma unroll
    for (int h = 0; h < 2; ++h) {
        u32x4 kv[4], vv[4];
#pragma unroll
        for (int i = 0; i < 4; ++i) { const int ch = F.tid + NT * (4 * h + i);
            { const int row = ch >> 4, c16 = ch & 15; kv[i] = *(const GAS u32x4*)(Km + (size_t)(b * MEML + row) * 2048 + l * 512 + head * 128 + c16 * 8); }
            { const int d = ch >> 5, c = ch & 31; vv[i] = *(const GAS u32x4*)(VmT + (size_t)(l * 512 + head * 128 + d) * 1024 + b * MEML + c * 8); } }
#pragma unroll
        for (int i = 0; i < 4; ++i) { const int ch = F.tid + NT * (4 * h + i);
            { const int row = ch >> 4, c16 = ch & 15; *(LAS u32x4*)(Ks + row * 272 + c16 * 16) = kv[i]; }
            { const int d = ch >> 5, c = ch & 31; *(LAS u32x4*)(Vs + d * 528 + c * 16) = vv[i]; } }
        asm volatile("" ::: "memory");
    }
    __syncthreads();
    int lane = F.lane; asm volatile("" : "+v"(lane) :: "memory");
    const int fr = lane & 15, fq = lane >> 4;
    for (int itq = 0; itq < 2; ++itq) {
        asm volatile("" : "+v"(lane) :: "memory");
        const int q0 = qblk * 256 + itq * 128 + F.wave * 16, tok0 = b * SEQ + q0;
        bf16x8 Qf[4];
#pragma unroll
        for (int ks = 0; ks < 4; ++ks) Qf[ks] = *(const GAS bf16x8*)(z + (size_t)(tok0 + (lane & 15)) * zw + qcol + head * 128 + ks * 32 + (lane >> 4) * 8);
        f32x4 acc[16];
#pragma unroll
        for (int t = 0; t < 16; ++t) { acc[t] = (f32x4){0.f, 0.f, 0.f, 0.f};
#pragma unroll
            for (int ks = 0; ks < 4; ++ks) { const bf16x8 kf = *(const LAS bf16x8*)(Ks + (16 * t + fr) * 272 + ks * 64 + fq * 16);
                acc[t] = __builtin_amdgcn_mfma_f32_16x16x32_bf16(kf, Qf[ks], acc[t], 0, 0, 0); } }
        const float sc = 0.08838834764831845f;
        float mx = -3.0e38f;
#pragma unroll
        for (int t = 0; t < 16; ++t)
#pragma unroll
            for (int j = 0; j < 4; ++j) { acc[t][j] *= sc; mx = fmaxf(mx, acc[t][j]); }
        mx = fmaxf(mx, __shfl_xor(mx, 16)); mx = fmaxf(mx, __shfl_xor(mx, 32));
        float sum = 0.f;
#pragma unroll
        for (int t = 0; t < 16; ++t)
#pragma unroll
            for (int j = 0; j < 4; ++j) { acc[t][j] = __expf(acc[t][j] - mx); sum += acc[t][j]; }
        sum += __shfl_xor(sum, 16); sum += __shfl_xor(sum, 32);
        const float inv = 1.f / sum;
        f32x4 o[8];
#pragma unroll
        for (int dt = 0; dt < 8; ++dt) o[dt] = (f32x4){0.f, 0.f, 0.f, 0.f};
#pragma unroll
        for (int s = 0; s < 8; ++s) {
            u32x4 pw; pw.x = cvt_pk_bf16(acc[2 * s][0], acc[2 * s][1]); pw.y = cvt_pk_bf16(acc[2 * s][2], acc[2 * s][3]);
            pw.z = cvt_pk_bf16(acc[2 * s + 1][0], acc[2 * s + 1][1]); pw.w = cvt_pk_bf16(acc[2 * s + 1][2], acc[2 * s + 1][3]);
            const bf16x8 pf = __builtin_bit_cast(bf16x8, pw);
#pragma unroll
            for (int dt = 0; dt < 8; ++dt) {
                const u32x2 v0 = *(const LAS u32x2*)(Vs + (16 * dt + fr) * 528 + (32 * s + 4 * fq) * 2);
                const u32x2 v1 = *(const LAS u32x2*)(Vs + (16 * dt + fr) * 528 + (32 * s + 16 + 4 * fq) * 2);
                u32x4 vw; vw.x = v0.x; vw.y = v0.y; vw.z = v1.x; vw.w = v1.y;
                o[dt] = __builtin_amdgcn_mfma_f32_16x16x32_bf16(__builtin_bit_cast(bf16x8, vw), pf, o[dt], 0, 0, 0);
            }
        }
        bf16_t* orow = cat + (size_t)(tok0 + fr) * DM + CMIX + head * 128 + 4 * fq;
#pragma unroll
        for (int dt = 0; dt < 8; ++dt) { u32x2 w; w.x = cvt_pk_bf16(o[dt][0] * inv, o[dt][1] * inv); w.y = cvt_pk_bf16(o[dt][2] * inv, o[dt][3] * inv); *(GAS u32x2*)(orow + 16 * dt) = w; }
    }
}
DI void memattn_all(const Ctx& F, int l, const bf16_t* z, int zw, int qcol) {
    for (int u = F.bid; u < 256; u += F.G) memattn_unit(F, l, u, z, zw, qcol);
    __syncthreads();
}

DI void conv_mix(const Ctx& F, const Params& P, const bf16_t* z) {
    unsigned char* const wsl = F.ws; float* const outl = F.out; (void)outl;
    const float* cw = PIN(29);
    bf16_t* cat = (bf16_t*)(wsl + WS_CAT);
    const int gt = F.bid * NT + F.tid, ngt = F.G * NT;
    for (int idx = gt; idx < NTOK * 192; idx += ngt) {
        const int tok = idx / 192, c8 = idx - tok * 192, c = c8 * 8, t = tok & (SEQ - 1);
        const bf16_t* zr = z + (size_t)tok * ZW_OTH;
        const u32x4 bg = *(const u32x4*)(zr + c);
        float y[8];
#pragma unroll
        for (int j = 0; j < 8; ++j) y[j] = 0.f;
#pragma unroll
        for (int dt = 0; dt < 3; ++dt) {
            if (t - dt >= 0) {
                const u32x4 cg = *(const u32x4*)(zr - (size_t)dt * ZW_OTH + CMIX + c), hh = *(const u32x4*)(zr - (size_t)dt * ZW_OTH + 2 * CMIX + c);
                const f32x4 w0 = *(const f32x4*)(cw + (2 - dt) * CMIX + c), w1 = *(const f32x4*)(cw + (2 - dt) * CMIX + c + 4);
                y[0] += w0.x * bflo(cg.x) * bflo(hh.x); y[1] += w0.y * bfhi(cg.x) * bfhi(hh.x); y[2] += w0.z * bflo(cg.y) * bflo(hh.y); y[3] += w0.w * bfhi(cg.y) * bfhi(hh.y);
                y[4] += w1.x * bflo(cg.z) * bflo(hh.z); y[5] += w1.y * bfhi(cg.z) * bfhi(hh.z); y[6] += w1.z * bflo(cg.w) * bflo(hh.w); y[7] += w1.w * bfhi(cg.w) * bfhi(hh.w);
            }
        }
        u32x4 o; o.x = cvt_pk_bf16(bflo(bg.x) * y[0], bfhi(bg.x) * y[1]); o.y = cvt_pk_bf16(bflo(bg.y) * y[2], bfhi(bg.y) * y[3]);
        o.z = cvt_pk_bf16(bflo(bg.z) * y[4], bfhi(bg.z) * y[5]); o.w = cvt_pk_bf16(bflo(bg.w) * y[6], bfhi(bg.w) * y[7]);
        *(u32x4*)(cat + (size_t)tok * DM + c) = o;
    }
}

DI void sb_attention(const Ctx& F, const bf16_t* z) {
    unsigned char* const wsl = F.ws;
    const bf16_t* VT = (const bf16_t*)(wsl + WS_ACT);
    bf16_t* cat = (bf16_t*)(wsl + WS_CAT);
    LAS unsigned char* Ks = F.lds; LAS unsigned char* Vs = F.lds + 69632;
    const int lane = F.lane, fr = lane & 15, fq = lane >> 4;
    const float sc = 0.08838834764831845f;
    for (int u = F.bid; u < NBATCH * 12 * 32; u += F.G) {
        const int b = u / (12 * 32); int r = u - b * 12 * 32; const int head = r >> 5, qblk = r & 31;
        const int t0 = qblk * 128, kw0 = t0 - 128;
        __syncthreads();
#pragma unroll
        for (int h = 0; h < 2; ++h) {
            u32x4 kv[4], vv[4];
#pragma unroll
            for (int i = 0; i < 4; ++i) { const int ch = F.tid + NT * (4 * h + i);
                { const int row = ch >> 4, c16 = ch & 15, key = kw0 + row, keyc = key < 0 ? 0 : key; kv[i] = *(const GAS u32x4*)(z + (size_t)(b * SEQ + keyc) * ZW_OTH + CMIX + head * 128 + c16 * 8); }
                { const int d = ch >> 5, c = ch & 31, k8 = kw0 + c * 8, k8c = k8 < 0 ? 0 : k8; vv[i] = *(const GAS u32x4*)(VT + (size_t)(head * 128 + d) * NTOK + b * SEQ + k8c); } }
#pragma unroll
            for (int i = 0; i < 4; ++i) { const int ch = F.tid + NT * (4 * h + i);
                { const int row = ch >> 4, c16 = ch & 15; *(LAS u32x4*)(Ks + row * 272 + c16 * 16) = kv[i]; }
                { const int d = ch >> 5, c = ch & 31; *(LAS u32x4*)(Vs + d * 528 + c * 16) = vv[i]; } }
            asm volatile("" ::: "memory");
        }
        __syncthreads();
        int lq = F.lane; asm volatile("" : "+v"(lq) :: "memory");
        const int tq0 = t0 + F.wave * 16, tq = tq0 + fr;
        bf16x8 Qf[4];
#pragma unroll
        for (int ks = 0; ks < 4; ++ks) Qf[ks] = *(const GAS bf16x8*)(z + (size_t)(b * SEQ + tq0 + (lq & 15)) * ZW_OTH + head * 128 + ks * 32 + (lq >> 4) * 8);
        f32x4 o[8];
#pragma unroll
        for (int dt = 0; dt < 8; ++dt) o[dt] = (f32x4){0.f, 0.f, 0.f, 0.f};
        float R = 0.f;
        for (int kt = (tq0 + 14) >> 5; kt >= 0; --kt) {
            const int lk = 32 * kt - kw0;
            bf16x8 Kf[2][4]; u32x2 V0[8], V1[8];
            if (lk >= 0) {
#pragma unroll
                for (int tl = 0; tl < 2; ++tl)
#pragma unroll
                    for (int ks = 0; ks < 4; ++ks) Kf[tl][ks] = *(const LAS bf16x8*)(Ks + (lk + 16 * tl + fr) * 272 + ks * 64 + fq * 16);
#pragma unroll
                for (int dt = 0; dt < 8; ++dt) { V0[dt] = *(const LAS u32x2*)(Vs + (16 * dt + fr) * 528 + (lk + 4 * fq) * 2); V1[dt] = *(const LAS u32x2*)(Vs + (16 * dt + fr) * 528 + (lk + 16 + 4 * fq) * 2); }
            } else {
#pragma unroll
                for (int tl = 0; tl < 2; ++tl)
#pragma unroll
                    for (int ks = 0; ks < 4; ++ks) Kf[tl][ks] = *(const GAS bf16x8*)(z + (size_t)(b * SEQ + 32 * kt + 16 * tl + fr) * ZW_OTH + CMIX + head * 128 + ks * 32 + fq * 8);
#pragma unroll
                for (int dt = 0; dt < 8; ++dt) { const bf16_t* vp = VT + (size_t)(head * 128 + 16 * dt + fr) * NTOK + b * SEQ + 32 * kt + 4 * fq; V0[dt] = *(const GAS u32x2*)vp; V1[dt] = *(const GAS u32x2*)(vp + 16); }
            }
            f32x4 s[2];
#pragma unroll
            for (int tl = 0; tl < 2; ++tl) { s[tl] = (f32x4){0.f, 0.f, 0.f, 0.f};
#pragma unroll
                for (int ks = 0; ks < 4; ++ks) s[tl] = __builtin_amdgcn_mfma_f32_16x16x32_bf16(Kf[tl][ks], Qf[ks], s[tl], 0, 0, 0); }
            float ln[2][4], lsg[2][4], tot[2];
#pragma unroll
            for (int tl = 0; tl < 2; ++tl) { tot[tl] = 0.f;
#pragma unroll
                for (int j = 0; j < 4; ++j) { const float x = s[tl][j] * sc; const int key = 32 * kt + 16 * tl + 4 * fq + j; const bool valid = key < tq;
                    const float sp = softplusf_(x); ln[tl][j] = valid ? -sp : 0.f; lsg[tl][j] = valid ? (x - sp) : -1.0e30f; tot[tl] += ln[tl][j]; } }
            const float a16_0 = __shfl_xor(tot[0], 16), a32_0 = __shfl_xor(tot[0], 32), a48_0 = __shfl_xor(tot[0], 48);
            const float a16_1 = __shfl_xor(tot[1], 16), a32_1 = __shfl_xor(tot[1], 32), a48_1 = __shfl_xor(tot[1], 48);
            float hi0 = 0.f, hi1 = 0.f;
            if ((fq ^ 1) > fq) { hi0 += a16_0; hi1 += a16_1; }
            if ((fq ^ 2) > fq) { hi0 += a32_0; hi1 += a32_1; }
            if ((fq ^ 3) > fq) { hi0 += a48_0; hi1 += a48_1; }
            const float all0 = tot[0] + a16_0 + a32_0 + a48_0, all1 = tot[1] + a16_1 + a32_1 + a48_1;
            const float E0 = R + hi0 + all1, E1 = R + hi1;
            float at[2][4];
#pragma unroll
            for (int tl = 0; tl < 2; ++tl) { float suf = 0.f; const float Eb = tl ? E1 : E0;
#pragma unroll
                for (int j = 3; j >= 0; --j) { at[tl][j] = __expf(lsg[tl][j] + Eb + suf); suf += ln[tl][j]; } }
            R += all0 + all1;
            u32x4 pw; pw.x = cvt_pk_bf16(at[0][0], at[0][1]); pw.y = cvt_pk_bf16(at[0][2], at[0][3]); pw.z = cvt_pk_bf16(at[1][0], at[1][1]); pw.w = cvt_pk_bf16(at[1][2], at[1][3]);
            const bf16x8 pf = __builtin_bit_cast(bf16x8, pw);
#pragma unroll
            for (int dt = 0; dt < 8; ++dt) {
                u32x4 vw; vw.x = V0[dt].x; vw.y = V0[dt].y; vw.z = V1[dt].x; vw.w = V1[dt].y;
                o[dt] = __builtin_amdgcn_mfma_f32_16x16x32_bf16(__builtin_bit_cast(bf16x8, vw), pf, o[dt], 0, 0, 0);
            }
            if (__all(R < -100.f)) break;
        }
        bf16_t* orow = cat + (size_t)(b * SEQ + tq) * DM + head * 128 + 4 * fq;
#pragma unroll
        for (int dt = 0; dt < 8; ++dt) { u32x2 w; w.x = cvt_pk_bf16(o[dt][0], o[dt][1]); w.y = cvt_pk_bf16(o[dt][2], o[dt][3]); *(GAS u32x2*)(orow + 16 * dt) = w; }
    }
    __syncthreads();
}

DI void rwkv_prep1(const Ctx& F, const Params& P, int j, const bf16_t* z) {
    unsigned char* const wsl = F.ws; float* const outl = F.out; (void)outl;
    const float* mu = PIN(17) + (size_t)j * 5056;
    bf16_t* act = (bf16_t*)(wsl + WS_ACT);
    const int gt = F.bid * NT + F.tid, ngt = F.G * NT;
    for (int idx = gt; idx < NTOK * 64; idx += ngt) {
        const int tok = idx >> 6, ci = idx & 63, t = tok & (SEQ - 1);
        u32x4 o = (u32x4){0u, 0u, 0u, 0u};
        if (ci < 24 || ci >= 32) {
            const int sc = ci < 12 ? 4608 + 8 * ci : (ci < 24 ? 4704 + 8 * (ci - 12) : 4800 + 8 * (ci - 32));
            const u32x4 a = *(const u32x4*)(z + (size_t)tok * ZW_RWKV + sc);
            u32x4 p = (u32x4){0u, 0u, 0u, 0u}; if (t > 0) p = *(const u32x4*)(z + (size_t)(tok - 1) * ZW_RWKV + sc);
            const f32x4 m0 = *(const f32x4*)(mu + sc), m1 = *(const f32x4*)(mu + sc + 4);
            float v[8];
            v[0] = bflo(a.x) + (bflo(p.x) - bflo(a.x)) * m0.x; v[1] = bfhi(a.x) + (bfhi(p.x) - bfhi(a.x)) * m0.y;
            v[2] = bflo(a.y) + (bflo(p.y) - bflo(a.y)) * m0.z; v[3] = bfhi(a.y) + (bfhi(p.y) - bfhi(a.y)) * m0.w;
            v[4] = bflo(a.z) + (bflo(p.z) - bflo(a.z)) * m1.x; v[5] = bfhi(a.z) + (bfhi(p.z) - bfhi(a.z)) * m1.y;
            v[6] = bflo(a.w) + (bflo(p.w) - bflo(a.w)) * m1.z; v[7] = bfhi(a.w) + (bfhi(p.w) - bfhi(a.w)) * m1.w;
#pragma unroll
            for (int q = 0; q < 8; ++q) { if (ci < 12) v[q] = tanhf(v[q]); else if (ci >= 32) v[q] = sigmoidf_(v[q]); }
            o.x = cvt_pk_bf16(v[0], v[1]); o.y = cvt_pk_bf16(v[2], v[3]); o.z = cvt_pk_bf16(v[4], v[5]); o.w = cvt_pk_bf16(v[6], v[7]);
        }
        *(u32x4*)(act + (size_t)tok * 512 + ci * 8) = o;
    }
}

constexpr int CH = 64, NCH = SEQ / CH;
DI float* scan_rec(unsigned char* ws, int tok, int head) {
    return (float*)(ws + WS_SCAN) + ((size_t)((tok >> 12) * 24 + head) * SEQ + (tok & (SEQ - 1))) * 320;
}
DI float* gh_ptr(unsigned char* ws, int bh, int c, int which) { return (float*)(ws + WS_GH) + (((size_t)bh * NCH + c) * 2 + which) * 4096; }
struct RwPar { const float *mu, *w0, *a0, *kk, *ka, *rk, *gng, *gnb; };
struct PrepRaw { u32x2 zr, zk, zv, pr, pk, pv, lw, la; };
struct PrepOut { f32x4 dec, ld, bb, kp, r, nk, v; float bon; };
DI void prep_load(PrepRaw& R, const bf16_t* z, const bf16_t* LW, int tok, int c4) {
    tok = tok < NTOK ? tok : NTOK - 1;
    const bool hp = (tok & (SEQ - 1)) != 0;
    const GAS bf16_t* zc = (const GAS bf16_t*)(z + (size_t)tok * ZW_RWKV + c4); const GAS bf16_t* zp = hp ? zc - ZW_RWKV : zc;
    R.zr = *(const GAS u32x2*)zc; R.zk = *(const GAS u32x2*)(zc + CMIX); R.zv = *(const GAS u32x2*)(zc + 2 * CMIX);
    R.pr = *(const GAS u32x2*)zp; R.pk = *(const GAS u32x2*)(zp + CMIX); R.pv = *(const GAS u32x2*)(zp + 2 * CMIX);
    const GAS bf16_t* lp = (const GAS bf16_t*)(LW + (size_t)tok * 3072 + c4); R.lw = *(const GAS u32x2*)lp; R.la = *(const GAS u32x2*)(lp + CMIX);
}
DI f32x4 lerp_u(u32x2 a, u32x2 p, f32x4 m) {
    f32x4 r; r.x = bflo(a.x) + (bflo(p.x) - bflo(a.x)) * m.x; r.y = bfhi(a.x) + (bfhi(p.x) - bfhi(a.x)) * m.y;
    r.z = bflo(a.y) + (bflo(p.y) - bflo(a.y)) * m.z; r.w = bfhi(a.y) + (bfhi(p.y) - bfhi(a.y)) * m.w; return r;
}
struct PrepPar { f32x4 mur, muk, muv, w0, a0, kk, ka, rk; };
DI void par_load(PrepPar& P, const RwPar& Q, int c4) {
    P.mur = *(const GAS f32x4*)(Q.mu + c4); P.muk = *(const GAS f32x4*)(Q.mu + CMIX + c4); P.muv = *(const GAS f32x4*)(Q.mu + 2 * CMIX + c4);
    P.w0 = *(const GAS f32x4*)(Q.w0 + c4); P.a0 = *(const GAS f32x4*)(Q.a0 + c4); P.kk = *(const GAS f32x4*)(Q.kk + c4); P.ka = *(const GAS f32x4*)(Q.ka + c4); P.rk = *(const GAS f32x4*)(Q.rk + c4);
}
template <bool WANT_BON> DI void prep_compute(const PrepRaw& R, const PrepPar& P, bool hp, PrepOut& O) {
    const u32x2 z2 = (u32x2){0u, 0u};
    const f32x4 r = lerp_u(R.zr, hp ? R.pr : z2, P.mur), k = lerp_u(R.zk, hp ? R.pk : z2, P.muk);
    O.v = lerp_u(R.zv, hp ? R.pv : z2, P.muv); O.r = r;
    const f32x4 w0v = P.w0, a0v = P.a0, kkv = P.kk, kav = P.ka;
    f32x4 wr; wr.x = w0v.x + bflo(R.lw.x); wr.y = w0v.y + bfhi(R.lw.x); wr.z = w0v.z + bflo(R.lw.y); wr.w = w0v.w + bfhi(R.lw.y);
    f32x4 ar; ar.x = a0v.x + bflo(R.la.x); ar.y = a0v.y + bfhi(R.la.x); ar.z = a0v.z + bflo(R.la.y); ar.w = a0v.w + bfhi(R.la.y);
    f32x4 a, kk;
#pragma unroll
    for (int q = 0; q < 4; ++q) { const float wl = -softplusf_(-wr[q]) - 0.5f; O.ld[q] = -__expf(wl); O.dec[q] = __expf(O.ld[q]); a[q] = sigmoidf_(ar[q]); kk[q] = k[q] * kkv[q]; O.kp[q] = k[q] * (1.f + (a[q] - 1.f) * kav[q]); }
    const float n2 = sum16(kk.x * kk.x + kk.y * kk.y + kk.z * kk.z + kk.w * kk.w);
    const float inv = __builtin_amdgcn_rsqf(fmaxf(n2, 1e-24f));
#pragma unroll
    for (int q = 0; q < 4; ++q) { const float kn = kk[q] * inv; O.bb[q] = kn * a[q]; O.nk[q] = -kn; }
    if (WANT_BON) { const f32x4 rk = P.rk; O.bon = sum16(r.x * O.kp.x * rk.x + r.y * O.kp.y * rk.y + r.z * O.kp.z * rk.z + r.w * O.kp.w * rk.w); }
}
#define LO2(v) ((f32x2){(v).x, (v).y})
#define HI2(v) ((f32x2){(v).z, (v).w})
constexpr int WRS = 144;
constexpr int W_SLOT = 64 * WRS;
enum { SL_NT = 0, SL_RT, SL_BH, SL_KH, SL_BHT, SL_KHT, SL_VT, SL_MK, SL_NB, SL_NK, SL_W1T, SL_U0T };
constexpr int W_MB = 12 * W_SLOT, W_CL = W_MB + 16384, W_PL = W_CL + 16384;
DI bf16x8 wfrag(LAS unsigned char* L, int slot, int row, int ks, int q) { return *(const LAS bf16x8*)(L + slot * W_SLOT + row * WRS + ks * 64 + q * 16); }
DI void wput(LAS unsigned char* L, int slot, int row, int col, float v) { *(LAS bf16_t*)(L + slot * W_SLOT + row * WRS + col * 2) = (bf16_t)(cvt_pk_bf16(v, 0.f) & 0xffffu); }
DI void tr4x4_rows(f32x4& x) {
    const float f0 = x.x, f1 = x.y, f2 = x.z, f3 = x.w;
    const unsigned u0 = __builtin_bit_cast(unsigned, f0), u1 = __builtin_bit_cast(unsigned, f1), u2 = __builtin_bit_cast(unsigned, f2), u3 = __builtin_bit_cast(unsigned, f3);
    const auto s02 = __builtin_amdgcn_permlane32_swap(u0, u2, false, false); const auto s13 = __builtin_amdgcn_permlane32_swap(u1, u3, false, false);
    const auto t01 = __builtin_amdgcn_permlane16_swap(s02[0], s13[0], false, false); const auto t23 = __builtin_amdgcn_permlane16_swap(s02[1], s13[1], false, false);
    x[0] = __builtin_bit_cast(float, (unsigned)t01[0]); x[1] = __builtin_bit_cast(float, (unsigned)t01[1]); x[2] = __builtin_bit_cast(float, (unsigned)t23[0]); x[3] = __builtin_bit_cast(float, (unsigned)t23[1]);
}
DI void scan_w1(const Ctx& F, const RwPar& Q, const bf16_t* z) {
    unsigned char* const wsl = F.ws; LAS unsigned char* L = F.lds;
    const int wave = F.wave;
    const bf16_t* LW = (const bf16_t*)(wsl + WS_LW);
    LAS float* MB = (LAS float*)(L + W_MB); LAS float* CL = (LAS float*)(L + W_CL); LAS float* PL = (LAS float*)(L + W_PL);
    PrepPar PN;
    PrepRaw RN[2];
    if (F.bid < 96 * NCH) { const int bh = F.bid % 96, c = F.bid / 96, b = bh / 24, head = bh - b * 24, tokb = b * SEQ + c * CH, c4 = head * 64 + 4 * (F.lane & 15);
#pragma unroll
        for (int p = 0; p < 2; ++p) prep_load(RN[p], z, LW, tokb + p * 32 + wave * 4 + (F.lane >> 4), c4);
        par_load(PN, Q, c4); }
    for (int u = F.bid; u < 96 * NCH; u += F.G) {
        int lane = F.lane; asm volatile("" : "+v"(lane));
        const int tq = lane >> 4, li = lane & 15, fr = li, fq = tq;
        const int bh = u % 96, c = u / 96, b = bh / 24, head = bh - b * 24, tokb = b * SEQ + c * CH, c4 = head * 64 + 4 * li;
        LDS_BARRIER();
        PrepOut O[2];
#pragma unroll
        for (int p = 0; p < 2; ++p) {
            const int t = p * 32 + wave * 4 + tq; const PrepRaw R = RN[p];
            prep_compute<true>(R, PN, ((tokb + t) & (SEQ - 1)) != 0, O[p]);
            *(LAS f32x4*)(CL + t * 64 + 4 * li) = O[p].ld;
            u32x2 e; e.x = cvt_pk_bf16(O[p].bon * O[p].v.x, O[p].bon * O[p].v.y); e.y = cvt_pk_bf16(O[p].bon * O[p].v.z, O[p].bon * O[p].v.w);
            *(GAS u32x2*)((bf16_t*)(wsl + WS_E) + (size_t)(tokb + t) * CMIX + c4) = e;
        }
        LDS_BARRIER();
        if (wave == 0) {
            float xs[64];
#pragma unroll
            for (int t = 0; t < 64; ++t) xs[t] = CL[t * 64 + lane];
#pragma unroll
            for (int t = 1; t < 64; ++t) xs[t] += xs[t - 1];
#pragma unroll
            for (int t = 0; t < 64; ++t) CL[t * 64 + lane] = xs[t];
        }
        LDS_BARRIER();
#pragma unroll
        for (int p = 0; p < 2; ++p) {
            const int t = p * 32 + wave * 4 + tq;
            const f32x4 cl = *(const LAS f32x4*)(CL + t * 64 + 4 * li);
            f32x4 clm = (f32x4){0.f, 0.f, 0.f, 0.f}; if (t > 0) clm = *(const LAS f32x4*)(CL + (t - 1) * 64 + 4 * li);
            f32x4 nt, rt, bh4, kh4;
#pragma unroll
            for (int q = 0; q < 4; ++q) { const float P = __expf(cl[q]), Pm = __expf(clm[q]), iP = __expf(-cl[q]);
                nt[q] = O[p].nk[q] * Pm; rt[q] = O[p].r[q] * P; bh4[q] = O[p].bb[q] * iP; kh4[q] = O[p].kp[q] * iP;
                if (t == 63) PL[4 * li + q] = P; }
            u32x2 w;
            w.x = cvt_pk_bf16(nt.x, nt.y); w.y = cvt_pk_bf16(nt.z, nt.w); *(LAS u32x2*)(L + SL_NT * W_SLOT + t * WRS + 8 * li) = w;
            w.x = cvt_pk_bf16(rt.x, rt.y); w.y = cvt_pk_bf16(rt.z, rt.w); *(LAS u32x2*)(L + SL_RT * W_SLOT + t * WRS + 8 * li) = w;
            w.x = cvt_pk_bf16(bh4.x, bh4.y); w.y = cvt_pk_bf16(bh4.z, bh4.w); *(LAS u32x2*)(L + SL_BH * W_SLOT + t * WRS + 8 * li) = w;
            w.x = cvt_pk_bf16(kh4.x, kh4.y); w.y = cvt_pk_bf16(kh4.z, kh4.w); *(LAS u32x2*)(L + SL_KH * W_SLOT + t * WRS + 8 * li) = w;
            { f32x4 vv = O[p].v; tr4x4_rows(bh4); tr4x4_rows(kh4); tr4x4_rows(vv);
              const int off = (4 * li + tq) * WRS + (p * 32 + wave * 4) * 2;
              w.x = cvt_pk_bf16(bh4.x, bh4.y); w.y = cvt_pk_bf16(bh4.z, bh4.w); *(LAS u32x2*)(L + SL_BHT * W_SLOT + off) = w;
              w.x = cvt_pk_bf16(kh4.x, kh4.y); w.y = cvt_pk_bf16(kh4.z, kh4.w); *(LAS u32x2*)(L + SL_KHT * W_SLOT + off) = w;
              w.x = cvt_pk_bf16(vv.x, vv.y); w.y = cvt_pk_bf16(vv.z, vv.w); *(LAS u32x2*)(L + SL_VT * W_SLOT + off) = w; }
        }
        LDS_BARRIER();
        asm volatile("" ::: "memory");
        { const int un = u + F.G; if (un < 96 * NCH) { const int bhn = un % 96, cn = un / 96, bn = bhn / 24, headn = bhn - bn * 24, tokbn = bn * SEQ + cn * CH, c4n = headn * 64 + 4 * li;
#pragma unroll
            for (int p = 0; p < 2; ++p) prep_load(RN[p], z, LW, tokbn + p * 32 + wave * 4 + tq, c4n);
            par_load(PN, Q, c4n); } }
        for (int reps = 0; reps < REP_WS; ++reps) {
            const int mt = wave >> 1, slotA = (mt < 2) ? SL_NT : SL_RT, slotB = (mt & 1) ? SL_KH : SL_BH, slotO = (mt == 1) ? SL_MK : (mt == 2 ? SL_NB : SL_NK), tt0 = (wave & 1) * 2;
            bf16x8 Af[2][2], Bf[4][2];
#pragma unroll
            for (int a2 = 0; a2 < 2; ++a2)
#pragma unroll
                for (int ks = 0; ks < 2; ++ks) Af[a2][ks] = wfrag(L, slotA, 16 * (tt0 + a2) + fr, ks, fq);
#pragma unroll
            for (int ss = 0; ss < 4; ++ss)
#pragma unroll
                for (int ks = 0; ks < 2; ++ks) Bf[ss][ks] = wfrag(L, slotB, 16 * ss + fr, ks, fq);
            float zf = 0.f; asm volatile("" : "+v"(zf));
            const unsigned zu = __builtin_bit_cast(unsigned, zf);
            const int strict = (mt < 2) ? 1 : 0; LAS unsigned char* ob = L + slotO * W_SLOT;
#pragma unroll
            for (int a2 = 0; a2 < 2; ++a2)
#pragma unroll
                for (int ss = 0; ss < 4; ++ss) { const int t = 16 * (tt0 + a2) + fr, s0 = 16 * ss + 4 * fq;
                    if (ss <= tt0 + a2) {
                        f32x4 acc = __builtin_amdgcn_mfma_f32_16x16x32_bf16(Bf[ss][0], Af[a2][0], (f32x4){0.f, 0.f, 0.f, 0.f}, 0, 0, 0);
                        acc = __builtin_amdgcn_mfma_f32_16x16x32_bf16(Bf[ss][1], Af[a2][1], acc, 0, 0, 0);
                        f32x4 o;
#pragma unroll
                        for (int r = 0; r < 4; ++r) o[r] = (s0 + r + strict <= t) ? acc[r] : 0.f;
                        if (mt == 0) *(LAS f32x4*)(MB + t * 64 + s0) = o;
                        else { u32x2 w; w.x = cvt_pk_bf16(o[0], o[1]); w.y = cvt_pk_bf16(o[2], o[3]); *(LAS u32x2*)(ob + t * WRS + s0 * 2) = w; }
                    } else {
                        if (mt == 0) *(LAS f32x4*)(MB + t * 64 + s0) = (f32x4){zf, zf, zf, zf};
                        else *(LAS u32x2*)(ob + t * WRS + s0 * 2) = (u32x2){zu, zu};
                    }
                }
        }
        LDS_BARRIER();
        { const int t = F.tid >> 3, s0 = (F.tid & 7) * 8; const f32x4 a0 = *(const LAS f32x4*)(MB + t * 64 + s0), a1 = *(const LAS f32x4*)(MB + t * 64 + s0 + 4);
          u32x4 w; w.x = cvt_pk_bf16(a0.x, a0.y); w.y = cvt_pk_bf16(a0.z, a0.w); w.z = cvt_pk_bf16(a1.x, a1.y); w.w = cvt_pk_bf16(a1.z, a1.w);
          *(LAS u32x4*)(L + SL_BH * W_SLOT + t * WRS + s0 * 2) = w; }
#pragma unroll
        for (int k2 = 0; k2 < 2; ++k2) {
            const int tile = wave * 2 + k2, tt = tile >> 2, it = tile & 3;
            f32x4 acc = (f32x4){0.f, 0.f, 0.f, 0.f};
#pragma unroll
            for (int ks = 0; ks < 2; ++ks) acc = __builtin_amdgcn_mfma_f32_16x16x32_bf16(wfrag(L, SL_MK, 16 * tt + fr, ks, fq), wfrag(L, SL_VT, 16 * it + fr, ks, fq), acc, 0, 0, 0);
#pragma unroll
            for (int r = 0; r < 4; ++r) CL[(16 * tt + 4 * fq + r) * 64 + 16 * it + fr] = acc[r];
        }
        if (wave >= 4) {
            const int I = wave - 4;
            float d[16], xb[16];
#pragma unroll
            for (int r = 0; r < 16; ++r) d[r] = (r == lane) ? 1.f : 0.f;
            const LAS float* mbv = MB; asm volatile("" : "+v"(mbv));
            const LAS float* mb = mbv + (16 * I) * 64 + 16 * I;
            f32x4 A[8][2], Bm[8][2];
#pragma unroll
            for (int tt = 0; tt < 8; ++tt) { A[tt][0] = *(const LAS f32x4*)(mb + tt * 64); A[tt][1] = *(const LAS f32x4*)(mb + tt * 64 + 4); }
#pragma unroll
            for (int tt = 0; tt < 8; ++tt) { Bm[tt][0] = *(const LAS f32x4*)(mb + (8 + tt) * 64); Bm[tt][1] = *(const LAS f32x4*)(mb + (8 + tt) * 64 + 4); }
#pragma unroll
            for (int sx = 0; sx < 8; ++sx) { xb[sx] = d[sx];
#pragma unroll
                for (int tt = sx + 1; tt < 8; ++tt) d[tt] = fma_s(A[tt][sx >> 2][sx & 3], xb[sx], d[tt]); }
#pragma unroll
            for (int sx = 0; sx < 8; ++sx)
#pragma unroll
                for (int tt = 0; tt < 8; ++tt) d[8 + tt] = fma_s(Bm[tt][sx >> 2][sx & 3], xb[sx], d[8 + tt]);
            asm volatile("" : "+v"(d[8]), "+v"(d[15]) :: "memory");
#pragma unroll
            for (int tt = 0; tt < 8; ++tt) { A[tt][0] = *(const LAS f32x4*)(mb + (8 + tt) * 64 + 8); A[tt][1] = *(const LAS f32x4*)(mb + (8 + tt) * 64 + 12); }
#pragma unroll
            for (int sx = 0; sx < 8; ++sx) { xb[8 + sx] = d[8 + sx];
#pragma unroll
                for (int tt = sx + 1; tt < 8; ++tt) d[8 + tt] = fma_s(A[tt][sx >> 2][sx & 3], xb[8 + sx], d[8 + tt]); }
            if (lane < 16) {
#pragma unroll
                for (int t = 0; t < 16; ++t) *(LAS bf16_t*)(L + SL_KH * W_SLOT + (16 * I + t) * 48 + lane * 2) = (bf16_t)(cvt_pk_bf16(xb[t], 0.f) & 0xffffu);
            }
        }
        LDS_BARRIER();
        asm volatile("" ::: "memory");
        for (int repx = 0; repx < REP_WX; ++repx) {
            const int sys = wave >> 2, ct = wave & 3, slotX = sys == 0 ? SL_W1T : SL_U0T;
            LAS unsigned char* TI = L + SL_KH * W_SLOT;
            f32x4 rhs[4];
            if (sys == 0) {
#pragma unroll
                for (int I = 0; I < 4; ++I)
#pragma unroll
                    for (int r = 0; r < 4; ++r) rhs[I][r] = bf2f(*(const LAS bf16_t*)(L + SL_NT * W_SLOT + (16 * I + 4 * fq + r) * WRS + (16 * ct + fr) * 2));
            } else {
#pragma unroll
                for (int I = 0; I < 4; ++I)
#pragma unroll
                    for (int r = 0; r < 4; ++r) rhs[I][r] = CL[(16 * I + 4 * fq + r) * 64 + 16 * ct + fr];
            }
            u32x2 ta[4], ma[6];
#pragma unroll
            for (int I = 0; I < 4; ++I) ta[I] = *(const LAS u32x2*)(TI + (16 * I + fr) * 48 + 8 * fq);
#pragma unroll
            for (int I = 1; I < 4; ++I)
#pragma unroll
                for (int Ip = 0; Ip < I; ++Ip) ma[I * (I - 1) / 2 + Ip] = *(const LAS u32x2*)(L + SL_BH * W_SLOT + (16 * I + fr) * WRS + (16 * Ip + 4 * fq) * 2);
            u32x2 xk[4];
#pragma unroll
            for (int I = 0; I < 4; ++I) {
                f32x4 acc = rhs[I];
#pragma unroll
                for (int Ip = 0; Ip < I; ++Ip) { const u32x2 m = ma[I * (I - 1) / 2 + Ip];
                    acc = __builtin_amdgcn_mfma_f32_16x16x32_bf16(__builtin_bit_cast(bf16x8, (u32x4){m.x, m.y, 0u, 0u}), __builtin_bit_cast(bf16x8, (u32x4){xk[Ip].x, xk[Ip].y, 0u, 0u}), acc, 0, 0, 0); }
                const unsigned d0 = cvt_pk_bf16(acc[0], acc[1]), d1 = cvt_pk_bf16(acc[2], acc[3]);
                const f32x4 x = __builtin_amdgcn_mfma_f32_16x16x32_bf16(__builtin_bit_cast(bf16x8, (u32x4){ta[I].x, ta[I].y, 0u, 0u}), __builtin_bit_cast(bf16x8, (u32x4){d0, d1, 0u, 0u}), (f32x4){0.f, 0.f, 0.f, 0.f}, 0, 0, 0);
                xk[I].x = cvt_pk_bf16(x[0], x[1]); xk[I].y = cvt_pk_bf16(x[2], x[3]);
                *(LAS u32x2*)(L + slotX * W_SLOT + (16 * ct + fr) * WRS + (16 * I + 4 * fq) * 2) = xk[I];
            }
        }
        LDS_BARRIER();
        for (int repo = 0; repo < REP_WO; ++repo) {
            const int kind = wave >> 1, ta0 = (wave & 1) * 2;
            float* gp = gh_ptr(wsl, bh, c, 0); float* hp = gh_ptr(wsl, bh, c, 1);
            bf16_t* qy = (bf16_t*)(wsl + WS_QY) + (size_t)u * 4096; float* y0t = (float*)(wsl + WS_Y0T) + (size_t)u * 4096;
            const int sA1 = kind == 0 ? SL_W1T : kind == 1 ? SL_BHT : kind == 2 ? SL_W1T : SL_NK, sB1 = kind == 0 ? SL_BHT : kind == 1 ? SL_U0T : kind == 2 ? SL_NB : SL_VT;
            const int sA2 = kind == 1 ? SL_KHT : SL_NB, sB2 = kind == 1 ? SL_VT : SL_U0T; const bool two = (kind & 1) != 0;
            bf16x8 Af[2][2], Bf[4][2];
#pragma unroll
            for (int a2 = 0; a2 < 2; ++a2)
#pragma unroll
                for (int ks = 0; ks < 2; ++ks) Af[a2][ks] = wfrag(L, sA1, 16 * (ta0 + a2) + fr, ks, fq);
#pragma unroll
            for (int tb = 0; tb < 4; ++tb)
#pragma unroll
                for (int ks = 0; ks < 2; ++ks) Bf[tb][ks] = wfrag(L, sB1, 16 * tb + fr, ks, fq);
            f32x4 acc[2][4];
#pragma unroll
            for (int a2 = 0; a2 < 2; ++a2)
#pragma unroll
                for (int tb = 0; tb < 4; ++tb) { acc[a2][tb] = (f32x4){0.f, 0.f, 0.f, 0.f};
#pragma unroll
                    for (int ks = 0; ks < 2; ++ks) acc[a2][tb] = __builtin_amdgcn_mfma_f32_16x16x32_bf16(Af[a2][ks], Bf[tb][ks], acc[a2][tb], 0, 0, 0); }
            if (two) {
#pragma unroll
                for (int a2 = 0; a2 < 2; ++a2)
#pragma unroll
                    for (int ks = 0; ks < 2; ++ks) Af[a2][ks] = wfrag(L, sA2, 16 * (ta0 + a2) + fr, ks, fq);
#pragma unroll
                for (int tb = 0; tb < 4; ++tb)
#pragma unroll
                    for (int ks = 0; ks < 2; ++ks) Bf[tb][ks] = wfrag(L, sB2, 16 * tb + fr, ks, fq);
#pragma unroll
                for (int a2 = 0; a2 < 2; ++a2)
#pragma unroll
                    for (int tb = 0; tb < 4; ++tb)
#pragma unroll
                        for (int ks = 0; ks < 2; ++ks) acc[a2][tb] = __builtin_amdgcn_mfma_f32_16x16x32_bf16(Af[a2][ks], Bf[tb][ks], acc[a2][tb], 0, 0, 0);
            }
#pragma unroll
            for (int a2 = 0; a2 < 2; ++a2)
#pragma unroll
                for (int tb = 0; tb < 4; ++tb) { const int ta = ta0 + a2; const f32x4 av = acc[a2][tb];
                    if (kind == 0) {
                        const int j = 16 * tb + fr; const float pl = PL[j];
                        f32x4 o;
#pragma unroll
                        for (int r = 0; r < 4; ++r) o[r] = pl * (av[r] + ((16 * ta + 4 * fq + r) == j ? 1.f : 0.f));
                        u32x2 w; w.x = cvt_pk_bf16(o[0], o[1]); w.y = cvt_pk_bf16(o[2], o[3]);
                        *(GAS u32x2*)((bf16_t*)gp + j * 64 + 16 * ta + 4 * fq) = w;
                    } else if (kind == 1) {
                        const f32x4 pl = *(const LAS f32x4*)(PL + 16 * ta + 4 * fq);
                        *(GAS f32x4*)(hp + (16 * tb + fr) * 64 + 16 * ta + 4 * fq) = pl * av;
                    } else if (kind == 2) {
                        const int t = 16 * tb + fr; const u32x2 rr = *(const LAS u32x2*)(L + SL_RT * W_SLOT + t * WRS + (16 * ta + 4 * fq) * 2);
                        u32x2 w; w.x = cvt_pk_bf16(av[0] + bflo(rr.x), av[1] + bfhi(rr.x)); w.y = cvt_pk_bf16(av[2] + bflo(rr.y), av[3] + bfhi(rr.y));
                        *(GAS u32x2*)(qy + t * 64 + 16 * ta + 4 * fq) = w;
                    } else {
                        *(GAS f32x4*)(y0t + (16 * tb + fr) * 64 + 16 * ta + 4 * fq) = av;
                    }
                }
        }
    }
    LDS_BARRIER();
}
DI void scan_w2(const Ctx& F, const RwPar& Q) {
    unsigned char* const wsl = F.ws; const int lane = F.lane, fr = lane & 15, fq = lane >> 4;
    LAS float* yb = (LAS float*)(F.lds + F.wave * 16384);
    const bf16_t* gate = (const bf16_t*)(wsl + WS_GATE); const bf16_t* Eb = (const bf16_t*)(wsl + WS_E); bf16_t* cat = (bf16_t*)(wsl + WS_CAT);
    for (int u = F.gw; u < 96 * NCH; u += F.ngw) {
        const int bh = u % 96, c = u / 96, b = bh / 24, head = bh - b * 24, tokb = b * SEQ + c * CH;
        const bf16_t* qy = (const bf16_t*)(wsl + WS_QY) + (size_t)u * 4096; const float* y0t = (const float*)(wsl + WS_Y0T) + (size_t)u * 4096;
        f32x4 acc[4][4];
#pragma unroll
        for (int tt = 0; tt < 4; ++tt)
#pragma unroll
            for (int it = 0; it < 4; ++it) acc[tt][it] = *(const GAS f32x4*)(y0t + (16 * it + fr) * 64 + 16 * tt + 4 * fq);
        if (c > 0) {
            const bf16_t* sp = (const bf16_t*)gh_ptr(wsl, bh, c - 1, 0) + 4096;
            bf16x8 Bf[4][2];
#pragma unroll
            for (int it = 0; it < 4; ++it)
#pragma unroll
                for (int ks = 0; ks < 2; ++ks) Bf[it][ks] = *(const GAS bf16x8*)(sp + (16 * it + fr) * 64 + 32 * ks + 8 * fq);
#pragma unroll
            for (int tt = 0; tt < 4; ++tt)
#pragma unroll
                for (int ks = 0; ks < 2; ++ks) { const bf16x8 Af = *(const GAS bf16x8*)(qy + (16 * tt + fr) * 64 + 32 * ks + 8 * fq);
#pragma unroll
                    for (int it = 0; it < 4; ++it) acc[tt][it] = __builtin_amdgcn_mfma_f32_16x16x32_bf16(Af, Bf[it][ks], acc[tt][it], 0, 0, 0); }
        }
#pragma unroll
        for (int tt = 0; tt < 4; ++tt)
#pragma unroll
            for (int it = 0; it < 4; ++it)
#pragma unroll
                for (int r = 0; r < 4; ++r) yb[(16 * tt + 4 * fq + r) * 64 + 16 * it + fr] = acc[tt][it][r];
        LDS_WAIT();
#pragma unroll 4
        for (int k = 0; k < 16; ++k) {
            const int slot = k * 64 + lane, t = slot >> 4, li = slot & 15, c4 = head * 64 + 4 * li, tok = tokb + t;
            const f32x4 y = *(const LAS f32x4*)(yb + t * 64 + 4 * li);
            const u32x2 ev = *(const GAS u32x2*)(Eb + (size_t)tok * CMIX + c4), gt = *(const GAS u32x2*)(gate + (size_t)tok * CMIX + c4);
            const float mean = sum16(y.x + y.y + y.z + y.w) * (1.f / 64.f);
            const f32x4 d = y - mean;
            const float var = sum16(d.x * d.x + d.y * d.y + d.z * d.z + d.w * d.w) * (1.f / 64.f);
            const float rstd = rsqrtf(var + GN_EPS);
            const f32x4 g4 = *(const GAS f32x4*)(Q.gng + c4), b4 = *(const GAS f32x4*)(Q.gnb + c4);
            f32x4 o = d * rstd * g4 + b4; o.x += bflo(ev.x); o.y += bfhi(ev.x); o.z += bflo(ev.y); o.w += bfhi(ev.y);
            u32x2 w; w.x = cvt_pk_bf16(o.x * bflo(gt.x), o.y * bfhi(gt.x)); w.y = cvt_pk_bf16(o.z * bflo(gt.y), o.w * bfhi(gt.y));
            *(GAS u32x2*)(cat + (size_t)tok * DM + c4) = w;
        }
        LDS_WAIT();
    }
}
DI void scan_passB(const Ctx& F) {
    unsigned char* const wsl = F.ws; const int lane = F.lane, fr = lane & 15, fq = lane >> 4, ih = F.wave >> 2, q = F.wave & 3, bh = F.bid;
    LAS unsigned char* Sx0 = F.lds;
    bf16x8 ga[7][2]; f32x4 hq[7][2];
#define PB_LOAD(set, cc) do { const GAS bf16_t* _gp = (const GAS bf16_t*)gh_ptr(wsl, bh, (cc), 0) + (16 * q + fr) * 64 + 8 * fq; const GAS float* _hp = (const GAS float*)(gh_ptr(wsl, bh, (cc), 1) + (32 * ih + fr) * 64 + 16 * q + 4 * fq); \
        ga[set][0] = *(const GAS bf16x8*)_gp; ga[set][1] = *(const GAS bf16x8*)(_gp + 32); \
        _Pragma("unroll") for (int _r = 0; _r < 2; ++_r) hq[set][_r] = *(const GAS f32x4*)(_hp + (16 * _r) * 64); } while (0)
    PB_LOAD(0, 0); PB_LOAD(1, 1); PB_LOAD(2, 2); PB_LOAD(3, 3); PB_LOAD(4, 4); PB_LOAD(5, 5);
    for (int c7 = 0; c7 < NCH - 1; c7 += 7) {
#pragma unroll
        for (int u7 = 0; u7 < 7; ++u7) {
            const int c = c7 + u7;
            f32x4 acc[2];
#pragma unroll
            for (int it = 0; it < 2; ++it) acc[it] = hq[u7][it];
            const bf16x8 a0 = ga[u7][0], a1 = ga[u7][1];
            PB_LOAD((u7 + 6) % 7, (c + 6 < NCH - 1) ? c + 6 : NCH - 2);
            if (c > 0) {
#pragma unroll
                for (int it = 0; it < 2; ++it) {
                    acc[it] = __builtin_amdgcn_mfma_f32_16x16x32_bf16(a0, *(const LAS bf16x8*)(Sx0 + (c & 1) * W_SLOT + (32 * ih + 16 * it + fr) * WRS + fq * 16), acc[it], 0, 0, 0);
                    acc[it] = __builtin_amdgcn_mfma_f32_16x16x32_bf16(a1, *(const LAS bf16x8*)(Sx0 + (c & 1) * W_SLOT + (32 * ih + 16 * it + fr) * WRS + 64 + fq * 16), acc[it], 0, 0, 0); }
            }
            GAS bf16_t* op = (GAS bf16_t*)gh_ptr(wsl, bh, c, 0) + 4096 + (32 * ih + fr) * 64 + 16 * q + 4 * fq;
#pragma unroll
            for (int it = 0; it < 2; ++it) { u32x2 w; w.x = cvt_pk_bf16(acc[it].x, acc[it].y); w.y = cvt_pk_bf16(acc[it].z, acc[it].w);
                *(GAS u32x2*)(op + (16 * it) * 64) = w; *(LAS u32x2*)(Sx0 + ((c + 1) & 1) * W_SLOT + (32 * ih + 16 * it + fr) * WRS + (16 * q + 4 * fq) * 2) = w; }
            LDS_BARRIER();
        }
    }
#undef PB_LOAD
}

DI void ln1_router(const Ctx& F, const Params& P, int l, const float* xin) {
    unsigned char* const wsl = F.ws; float* const outl = F.out; (void)outl;
    const float* g = PIN(5) + (size_t)l * DM; const float* bta = PIN(6) + (size_t)l * DM;
    const float* gb = PIN(10) + l * 4; const float* eb = PIN(12) + l * 32;
    const bf16_t* hb = (const bf16_t*)(wsl + WS_HB); bf16_t* xb = (bf16_t*)(wsl + WS_XB); float* xo = outl;
    const bf16_t* wrt = (const bf16_t*)(wsl + WS_WSW + (size_t)l * WSW_STRIDE);
    unsigned* cnt = (unsigned*)(wsl + WS_CTL) + CW_CNT + l * 32 * 64;
    int* ltok = (int*)(wsl + WS_LTOK); float* lgate = (float*)(wsl + WS_LGATE); int* lslot = (int*)(wsl + WS_LSLOT);
    const int lane = F.lane, fr = lane & 15, fq = lane >> 4, wave = F.wave;
    LAS float* lg = (LAS float*)(F.lds + (wave & 3) * 4096);
    LAS float* lgp = (LAS float*)(F.lds + 16384 + (wave & 3) * 4096);
    LAS int* cntl = (LAS int*)(F.lds + 32768); LAS int* basel = cntl + 32;
    if (F.tid < NEXP) cntl[F.tid] = 0;
    __syncthreads();
    LAS float* gls = (LAS float*)(F.lds + 36864 + 52224); LAS float* bls = gls + DM;
    for (int blk = F.bid; blk < NTOK / 64; blk += F.G) {
        { const f32x4 gv = *(const GAS f32x4*)(g + 4 * F.tid), bv = *(const GAS f32x4*)(bta + 4 * F.tid); *(LAS f32x4*)(gls + 4 * F.tid) = gv; *(LAS f32x4*)(bls + 4 * F.tid) = bv; }
        __syncthreads();
#pragma unroll 1
        for (int pass = 0; pass < 4; ++pass) {
            int lno = lane; asm volatile("" : "+v"(lno));
            const int hr2 = lno >> 5, l32 = lno & 31;
            const size_t ro = (size_t)(blk * 64 + wave * 8 + pass * 2 + hr2) * DM + 8 * l32;
            u32x4 xr[8], hr[8];
#pragma unroll
            for (int i = 0; i < 8; ++i) { xr[i] = *(const GAS u32x4*)(xb + ro + 256 * i); hr[i] = *(const GAS u32x4*)(hb + ro + 256 * i); }
            float s = 0.f, s2 = 0.f;
#pragma unroll
            for (int i = 0; i < 8; ++i) {
#pragma unroll
                for (int e = 0; e < 4; ++e) { const float v0 = ALPHA * bflo(xr[i][e]) + bflo(hr[i][e]), v1 = ALPHA * bfhi(xr[i][e]) + bfhi(hr[i][e]); s += v0 + v1; s2 += v0 * v0 + v1 * v1; } }
            s = sum16(s); s2 = sum16(s2); s += __shfl_xor(s, 16); s2 += __shfl_xor(s2, 16);
            const float mean = s * (1.f / DM), rstd = rsqrtf(fmaxf(s2 * (1.f / DM) - mean * mean, 0.f) + LN_EPS);
#pragma unroll
            for (int i = 0; i < 8; ++i) { const int col = 256 * i + 8 * l32;
                const f32x4 g0 = *(const LAS f32x4*)(gls + col), g1 = *(const LAS f32x4*)(gls + col + 4), b0 = *(const LAS f32x4*)(bls + col), b1 = *(const LAS f32x4*)(bls + col + 4);
                u32x4 w;
#pragma unroll
                for (int e = 0; e < 4; ++e) { const float v0 = ALPHA * bflo(xr[i][e]) + bflo(hr[i][e]), v1 = ALPHA * bfhi(xr[i][e]) + bfhi(hr[i][e]);
                    const float gg0 = e < 2 ? g0[2 * e] : g1[2 * e - 4], gg1 = e < 2 ? g0[2 * e + 1] : g1[2 * e - 3], bb0 = e < 2 ? b0[2 * e] : b1[2 * e - 4], bb1 = e < 2 ? b0[2 * e + 1] : b1[2 * e - 3];
                    w[e] = cvt_pk_bf16((v0 - mean) * rstd * gg0 + bb0, (v1 - mean) * rstd * gg1 + bb1); }
                *(GAS u32x4*)(xb + ro + 256 * i) = w;
                asm volatile("" ::: "memory"); }
        }
        VM_WAIT();
        __syncthreads();
        __builtin_amdgcn_fence(__ATOMIC_ACQUIRE, "agent");
        VM_WAIT();
        const int row0 = blk * 64 + (wave & 3) * 16, kh = wave >> 2, krot = (F.bid * 5 + wave * 3) & 31;
        f32x4 acc[3];
#pragma unroll
        for (int ct = 0; ct < 3; ++ct) acc[ct] = (f32x4){0.f, 0.f, 0.f, 0.f};
        const bf16_t* arow = xb + (size_t)(row0 + fr) * DM + 8 * fq + kh * 1024;
        LAS unsigned char* wst = F.lds + 36864;
        u32x4 wreg[6];
        { const int st = F.bid & 7;
#pragma unroll
          for (int i = 0; i < 6; ++i) { const int ch = F.tid + NT * i, row = ch >> 4, c16 = ch & 15, rkh = row / 96, rr = row - rkh * 96;
              wreg[i] = *(const GAS u32x4*)(wrt + (size_t)rr * DM + rkh * 1024 + st * 128 + c16 * 8); } }
#pragma unroll 1
        for (int si = 0; si < 8; ++si) {
            const int st = (si + F.bid) & 7;
            LAS unsigned char* wb = wst + (si & 1) * 52224;
#pragma unroll
            for (int i = 0; i < 6; ++i) { const int ch = F.tid + NT * i, row = ch >> 4, c16 = ch & 15; *(LAS u32x4*)(wb + row * 272 + c16 * 16) = wreg[i]; }
            if (si + 1 < 8) { const int stn = (si + 1 + F.bid) & 7;
#pragma unroll
                for (int i = 0; i < 6; ++i) { const int ch = F.tid + NT * i, row = ch >> 4, c16 = ch & 15, rkh = row / 96, rr = row - rkh * 96;
                    wreg[i] = *(const GAS u32x4*)(wrt + (size_t)rr * DM + rkh * 1024 + stn * 128 + c16 * 8); } }
            bf16x8 af[4];
#pragma unroll
            for (int ksl = 0; ksl < 4; ++ksl) af[ksl] = *(const GAS bf16x8*)(arow + st * 128 + ksl * 32);
            LDS_BARRIER();
#pragma unroll
            for (int ksl = 0; ksl < 4; ++ksl)
#pragma unroll
                for (int ct = 0; ct < 3; ++ct) {
                    acc[ct] = __builtin_amdgcn_mfma_f32_16x16x32_bf16(af[ksl], *(const LAS bf16x8*)(wb + (kh * 96 + 16 * ct + fr) * 272 + ksl * 64 + fq * 16), acc[ct], 0, 0, 0);
                    acc[ct] = __builtin_amdgcn_mfma_f32_16x16x32_bf16(af[ksl], *(const LAS bf16x8*)(wb + (kh * 96 + 48 + 16 * ct + fr) * 272 + ksl * 64 + fq * 16), acc[ct], 0, 0, 0);
                }
        }
        if (kh == 1) {
#pragma unroll
            for (int ct = 0; ct < 3; ++ct)
#pragma unroll
                for (int jj = 0; jj < 4; ++jj) lgp[(4 * fq + jj) * 48 + 16 * ct + fr] = acc[ct][jj];
        }
        __syncthreads();
        if (kh == 0) {
#pragma unroll
            for (int ct = 0; ct < 3; ++ct)
#pragma unroll
                for (int jj = 0; jj < 4; ++jj) lg[(4 * fq + jj) * 48 + 16 * ct + fr] = acc[ct][jj] + lgp[(4 * fq + jj) * 48 + 16 * ct + fr];
        }
        LDS_WAIT();
        int se0 = 0, se1 = 0, sr0 = 0, sr1 = 0, stok = 0; float sg0 = 0.f, sg1 = 0.f;
        if (kh == 0 && lane < 16) {
            const LAS float* L = lg + lane * 48; const int tok = row0 + lane;
            float gl[4]; int grp_i = 0; float gmx;
#pragma unroll
            for (int q = 0; q < 4; ++q) gl[q] = L[q] + gb[q];
            gmx = gl[0];
#pragma unroll
            for (int q = 1; q < 4; ++q) if (gl[q] > gmx) { gmx = gl[q]; grp_i = q; }
            float gs = 0.f;
#pragma unroll
            for (int q = 0; q < 4; ++q) gs += __expf(gl[q] - gmx);
            const float pg = 1.f / gs;
            float el[8];
#pragma unroll
            for (int q = 0; q < 8; ++q) el[q] = L[4 + 8 * grp_i + q] + eb[8 * grp_i + q];
            int i0 = 0; float m0 = el[0];
#pragma unroll
            for (int q = 1; q < 8; ++q) if (el[q] > m0) { m0 = el[q]; i0 = q; }
            int i1 = -1; float m1 = -3.0e38f;
#pragma unroll
            for (int q = 0; q < 8; ++q) if (q != i0 && el[q] > m1) { m1 = el[q]; i1 = q; }
            if (i1 < 0) { i1 = (i0 == 0) ? 1 : 0; m1 = m0; }
            const float p1 = __expf(m1 - m0), den = 1.f / (1.f + p1);
            const float g0 = pg * den, g1 = pg * p1 * den;
            se0 = grp_i * 8 + i0; se1 = grp_i * 8 + i1; sg0 = g0; sg1 = g1; stok = tok;
            sr0 = __hip_atomic_fetch_add(cntl + se0, 1, __ATOMIC_RELAXED, __HIP_MEMORY_SCOPE_WORKGROUP);
            sr1 = __hip_atomic_fetch_add(cntl + se1, 1, __ATOMIC_RELAXED, __HIP_MEMORY_SCOPE_WORKGROUP);
        }
        __syncthreads();
        if (wave == 0 && lane < NEXP) { const int n = cntl[lane]; basel[lane] = n ? (int)__hip_atomic_fetch_add(cnt + lane * 64, (unsigned)n, __ATOMIC_RELAXED, __HIP_MEMORY_SCOPE_AGENT) : 0; }
        __syncthreads();
        if (kh == 0 && lane < 16) {
            const int pos0 = basel[se0] + sr0, pos1 = basel[se1] + sr1;
            ltok[se0 * LISTCAP + pos0] = stok; lgate[se0 * LISTCAP + pos0] = sg0; lslot[se0 * LISTCAP + pos0] = 2 * stok;
            ltok[se1 * LISTCAP + pos1] = stok; lgate[se1 * LISTCAP + pos1] = sg1; lslot[se1 * LISTCAP + pos1] = 2 * stok + 1;
        }
        __syncthreads();
        if (F.tid < NEXP) cntl[F.tid] = 0;
        __syncthreads();
    }
}

DI void ln2_phase(const Ctx& F, const Params& P, int l) {
    unsigned char* const wsl = F.ws; float* const outl = F.out;
    const float* g = PIN(7) + (size_t)l * DM; const float* bta = PIN(8) + (size_t)l * DM;
    const bf16_t* ys = (const bf16_t*)(wsl + WS_YS); bf16_t* xb = (bf16_t*)(wsl + WS_XB); float* xo = outl;
    LAS float* gls = (LAS float*)F.lds; LAS float* bls = gls + DM;
    { const f32x4 gv = *(const GAS f32x4*)(g + 4 * F.tid), bv = *(const GAS f32x4*)(bta + 4 * F.tid); *(LAS f32x4*)(gls + 4 * F.tid) = gv; *(LAS f32x4*)(bls + 4 * F.tid) = bv; }
    __syncthreads();
#pragma unroll 1
    for (int rp = F.gw; rp < NTOK / 2; rp += F.ngw) {
        int lno = F.lane; asm volatile("" : "+v"(lno));
        const int hr2 = lno >> 5, l32 = lno & 31, row = 2 * rp + hr2;
        const size_t ro = (size_t)row * DM + 8 * l32;
        u32x4 xr[8], y0[8], y1[8];
#pragma unroll
        for (int i = 0; i < 8; ++i) { xr[i] = *(const GAS u32x4*)(xb + ro + 256 * i); y0[i] = *(const GAS u32x4*)(ys + 2 * (size_t)row * DM + 8 * l32 + 256 * i); y1[i] = *(const GAS u32x4*)(ys + (2 * (size_t)row + 1) * DM + 8 * l32 + 256 * i); }
        float s = 0.f, s2 = 0.f;
#pragma unroll
        for (int i = 0; i < 8; ++i) {
#pragma unroll
            for (int e = 0; e < 4; ++e) { const float v0 = ALPHA * bflo(xr[i][e]) + (bflo(y0[i][e]) + bflo(y1[i][e])), v1 = ALPHA * bfhi(xr[i][e]) + (bfhi(y0[i][e]) + bfhi(y1[i][e])); s += v0 + v1; s2 += v0 * v0 + v1 * v1; } }
        s = sum16(s); s2 = sum16(s2); s += __shfl_xor(s, 16); s2 += __shfl_xor(s2, 16);
        const float mean = s * (1.f / DM), rstd = rsqrtf(fmaxf(s2 * (1.f / DM) - mean * mean, 0.f) + LN_EPS);
#pragma unroll
        for (int i = 0; i < 8; ++i) { const int col = 256 * i + 8 * l32;
            const f32x4 g0 = *(const LAS f32x4*)(gls + col), g1 = *(const LAS f32x4*)(gls + col + 4), b0 = *(const LAS f32x4*)(bls + col), b1 = *(const LAS f32x4*)(bls + col + 4);
            float o[8];
#pragma unroll
            for (int e = 0; e < 4; ++e) { const float v0 = ALPHA * bflo(xr[i][e]) + (bflo(y0[i][e]) + bflo(y1[i][e])), v1 = ALPHA * bfhi(xr[i][e]) + (bfhi(y0[i][e]) + bfhi(y1[i][e]));
                const float gg0 = e < 2 ? g0[2 * e] : g1[2 * e - 4], gg1 = e < 2 ? g0[2 * e + 1] : g1[2 * e - 3], bb0 = e < 2 ? b0[2 * e] : b1[2 * e - 4], bb1 = e < 2 ? b0[2 * e + 1] : b1[2 * e - 3];
                o[2 * e] = (v0 - mean) * rstd * gg0 + bb0; o[2 * e + 1] = (v1 - mean) * rstd * gg1 + bb1; }
            if (l == NLAYER - 1) { *(GAS f32x4*)(xo + (size_t)row * DM + col) = (f32x4){o[0], o[1], o[2], o[3]}; *(GAS f32x4*)(xo + (size_t)row * DM + col + 4) = (f32x4){o[4], o[5], o[6], o[7]}; }
            else { u32x4 w; w.x = cvt_pk_bf16(o[0], o[1]); w.y = cvt_pk_bf16(o[2], o[3]); w.z = cvt_pk_bf16(o[4], o[5]); w.w = cvt_pk_bf16(o[6], o[7]); *(GAS u32x4*)(xb + ro + 256 * i) = w; }
            asm volatile("" ::: "memory"); }
    }
}

DI int moe_table(const Ctx& F, int l) {
    unsigned char* const wsl = F.ws; float* const outl = F.out; (void)outl;
    LAS int* tb = (LAS int*)(F.lds + LDS_CTL_OFF) + 16;
    const unsigned* cnt = (const unsigned*)(wsl + WS_CTL) + CW_CNT + l * 32 * 64;
    __syncthreads();
    if (F.tid == 0) { int acc = 0;
        for (int e = 0; e < NEXP; ++e) { tb[e] = acc; const int n = (int)__hip_atomic_load(cnt + e * 64, __ATOMIC_RELAXED, __HIP_MEMORY_SCOPE_AGENT); acc += (n + 255) >> 8; }
        tb[NEXP] = acc; }
    __syncthreads();
    return tb[NEXP];
}


#ifdef MK_DEBUG
constexpr int CW_DBG = 40960;
DI void dbg_count_bf16(const Ctx& F, const bf16_t* p, size_t n, int k) {
    unsigned bad = 0; const size_t gt = (size_t)F.bid * NT + F.tid, ngt = (size_t)F.G * NT;
    for (size_t i = gt; i < n; i += ngt) { const unsigned b = p[i]; const float v = bf2f(b); if ((b & 0x7f80u) == 0x7f80u || fabsf(v) > 1.0e6f) ++bad; }
    if (bad) atomicAdd((unsigned*)(F.ws + WS_CTL) + CW_DBG + k * 64, bad);
}
DI void dbg_count_f32(const Ctx& F, const float* p, size_t n, int k) {
    unsigned bad = 0; const size_t gt = (size_t)F.bid * NT + F.tid, ngt = (size_t)F.G * NT;
    for (size_t i = gt; i < n; i += ngt) { const float v = p[i]; if (!(fabsf(v) <= 1.0e6f)) ++bad; }
    if (bad) atomicAdd((unsigned*)(F.ws + WS_CTL) + CW_DBG + k * 64, bad);
}
#endif
constexpr int PH_PER_LAYER = 11, N_PHASES = 1 + NLAYER * PH_PER_LAYER;

__global__ void __launch_bounds__(NT, 2) mega_fwd(Params P) {
    extern __shared__ __attribute__((aligned(16))) unsigned char lds_raw[];
    Ctx F0;
    F0.lds = (LAS unsigned char*)lds_raw;
    F0.tid = threadIdx.x; F0.lane = F0.tid & 63; F0.wave = __builtin_amdgcn_readfirstlane(F0.tid >> 6);
    F0.G = gridDim.x; F0.bid = blockIdx.x; F0.gw = F0.bid * NWAVES + F0.wave; F0.ngw = F0.G * NWAVES;
    F0.ws = P.ws; F0.out = P.out;
    for (int u = F0.tid; u < (LDS_BYTES - LDS_CTL_OFF) / 4; u += NT) ((LAS unsigned*)(F0.lds + LDS_CTL_OFF))[u] = 0u;
    __syncthreads();
    XcdBarrier bar; bar.bar = (unsigned*)(F0.ws + WS_CTL) + CW_BAR; bar.x = 0; bar.st = nullptr;
#if !MK_PER_PHASE
    bar = xcd_barrier_post((unsigned*)(F0.ws + WS_CTL) + CW_BAR, (volatile LAS unsigned*)(F0.lds + LDS_CTL_OFF));
#endif
    const int lo = P.ph_lo, hi = P.ph_hi;
#define IN(k) (lo <= (k) && (k) < hi)
#if MK_PER_PHASE
#define SEAM(k) do { } while (0)
#else
#define SEAM(k) do { if ((k) + 1 < hi) { XcdBarrier _b = bar; asm volatile("" : "+s"(_b.bar), "+s"(_b.x)); xcd_barrier(_b); } } while (0)
#endif
#define WSL const Ctx F = relaunder(F0); unsigned char* const ws = F.ws; bf16_t* const xb = (bf16_t*)(ws + WS_XB); bf16_t* const zb = (bf16_t*)(ws + WS_Z); bf16_t* const cat = (bf16_t*)(ws + WS_CAT); (void)xb; (void)zb; (void)cat

    if (IN(0)) { WSL; phase_prologue(F, P); SEAM(0); }

    for (int l = 0; l < NLAYER; ++l) {
        const int kind = l % 3, j = l / 3, pb = 1 + l * PH_PER_LAYER;
        const int zw = (kind == 0) ? ZW_RWKV : ZW_OTH, qcol = (kind == 0) ? 5056 : 4608;
        if (IN(pb + 0)) {
            WSL; const bf16_t* winT = (const bf16_t*)(ws + WS_WIN + (size_t)l * WIN_STRIDE);
            if (kind != 2) dense_gemm(F, xb, DM, winT, DM, NTOK, zw, DM, zb, zw, 0);
            else {
                dense_gemm(F, xb, DM, winT, DM, NTOK, 3072, DM, zb, zw, 0);
                dense_gemm(F, xb, DM, winT + (size_t)4608 * DM, DM, NTOK, 512, DM, zb + 4608, zw, 0);
                dense_gemm(F, winT + (size_t)3072 * DM, DM, xb, DM, CMIX, NTOK, DM, (bf16_t*)(ws + WS_ACT), NTOK, 128);
            }
            if (l == 0) {
                dense_gemm(F, (const bf16_t*)(ws + WS_MEMB), DM, (const bf16_t*)(ws + WS_WK), DM, NBATCH * MEML, 2048, DM, (bf16_t*)(ws + WS_KM), 2048, 128);
                dense_gemm(F, (const bf16_t*)(ws + WS_WV), DM, (const bf16_t*)(ws + WS_MEMB), DM, 2048, NBATCH * MEML, DM, (bf16_t*)(ws + WS_VMT), 1024, 192);
            }
            SEAM(pb + 0);
        }
        if (IN(pb + 1)) {
            WSL;
            if (kind == 0) { for (int rep = 0; rep < REP_PREP; ++rep) rwkv_prep1(F, P, j, zb); for (int rep = 0; rep < REP_MIX * REP_MA; ++rep) memattn_all(F, l, zb, zw, qcol); }
            else if (kind == 1) { for (int rep = 0; rep < REP_MIX; ++rep) conv_mix(F, P, zb); for (int rep = 0; rep < REP_MIX * REP_MA; ++rep) memattn_all(F, l, zb, zw, qcol); for (int rep = 0; rep < REP_CONV; ++rep) expert_convert(F, P, l, F.gw, F.ngw); }
            else { for (int rep = 0; rep < REP_MIX * REP_SB; ++rep) sb_attention(F, zb); for (int rep = 0; rep < REP_MIX * REP_MA; ++rep) memattn_all(F, l, zb, zw, qcol); for (int rep = 0; rep < REP_CONV; ++rep) expert_convert(F, P, l, F.gw, F.ngw); }
            SEAM(pb + 1);
        }
        if (kind == 0) {
            if (IN(pb + 2)) {
                WSL; const bf16_t* act = (const bf16_t*)(ws + WS_ACT); const bf16_t* wa = (const bf16_t*)(ws + WS_LORA + (size_t)j * LORA_STRIDE);
                dense_gemm(F, act, 512, wa, 256, NTOK, 3072, 256, (bf16_t*)(ws + WS_LW), 3072, 0);
                dense_gemm(F, act + 256, 512, wa + (size_t)3072 * 256, 256, NTOK, CMIX, 256, (bf16_t*)(ws + WS_GATE), CMIX, 0);
                SEAM(pb + 2);
            }
            if (IN(pb + 3)) { WSL; const RwPar Q{PIN(17) + (size_t)j * 5056, PIN(18) + j * CMIX, PIN(20) + j * CMIX, PIN(23) + j * CMIX, PIN(24) + j * CMIX, PIN(25) + j * CMIX, PIN(26) + j * CMIX, PIN(27) + j * CMIX};
                for (int rep = 0; rep < REP_SCAN; ++rep) scan_w1(F, Q, zb); SEAM(pb + 3); }
            if (IN(pb + 4)) {
                WSL;
                if (F.bid < 96) scan_passB(F);
                else expert_convert(F, P, l, (F.bid - 96) * NWAVES + F.wave, (F.G - 96) * NWAVES);
                SEAM(pb + 4);
            }
            if (IN(pb + 5)) { WSL; const RwPar Q{PIN(17) + (size_t)j * 5056, PIN(18) + j * CMIX, PIN(20) + j * CMIX, PIN(23) + j * CMIX, PIN(24) + j * CMIX, PIN(25) + j * CMIX, PIN(26) + j * CMIX, PIN(27) + j * CMIX};
                for (int rep = 0; rep < REP_SCAN * REP_W2; ++rep) scan_w2(F, Q); SEAM(pb + 5); }
        }
        if (IN(pb + 6)) { WSL; dense_gemm(F, cat, DM, (const bf16_t*)(ws + WS_WOUT) + (size_t)l * DM * DM, DM, NTOK, DM, DM, (bf16_t*)(ws + WS_HB), DM, 0); SEAM(pb + 6); }
        if (IN(pb + 7)) { WSL; ln1_router(F, P, l, l == 0 ? PIN(0) : (const float*)P.out); SEAM(pb + 7); }
        if (IN(pb + 8)) {
            WSL; const int ntiles = moe_table(F, l);
            pg8::Gemm g{xb, (const bf16_t*)(ws + WS_EXP1), DM, DM, DM};
            pg8::MoeOrder<true> S; S.G = F.G; S.c = F.bid; S.npn = 4; S.total = ntiles * 4; S.tb = (const LAS int*)(F.lds + LDS_CTL_OFF) + 16; S.estride = (size_t)1024 * DM * 2;
            S.ltok = (const int*)(ws + WS_LTOK); S.cnt = (const unsigned*)(ws + WS_CTL) + CW_CNT + l * 32 * 64;
            pg8::EpiSwiGLU E{(bf16_t*)(ws + WS_HE)};
            for (int rep = 0; rep < REP_MOE; ++rep) pg8::gemm_phase<pg8::EpiSwiGLU, pg8::MoeOrder<true>>(F.lds, g, S, E);
            SEAM(pb + 8);
        }
        if (IN(pb + 9)) {
            WSL; const int ntiles = moe_table(F, l);
            pg8::Gemm g{(const bf16_t*)(ws + WS_HE), (const bf16_t*)(ws + WS_EXP2), DEXP, DEXP, DEXP};
            pg8::MoeOrder<false> S; S.G = F.G; S.c = F.bid; S.npn = 8; S.total = ntiles * 8; S.tb = (const LAS int*)(F.lds + LDS_CTL_OFF) + 16; S.estride = (size_t)DM * DEXP * 2;
            S.ltok = (const int*)(ws + WS_LTOK); S.cnt = (const unsigned*)(ws + WS_CTL) + CW_CNT + l * 32 * 64;
            pg8::EpiScatter E{(bf16_t*)(ws + WS_YS), (const int*)(ws + WS_LSLOT), (const float*)(ws + WS_LGATE), S.cnt};
            for (int rep = 0; rep < REP_MOE; ++rep) pg8::gemm_phase<pg8::EpiScatter, pg8::MoeOrder<false>>(F.lds, g, S, E);
            SEAM(pb + 9);
        }
        if (IN(pb + 10)) { WSL; ln2_phase(F, P, l); SEAM(pb + 10); }
    }
#ifdef MK_DEBUG
    {
        WSL;
        xcd_barrier(bar);
        dbg_count_bf16(F, (const bf16_t*)(ws + WS_CAT), (size_t)NTOK * DM, 0);
        dbg_count_bf16(F, (const bf16_t*)(ws + WS_HB), (size_t)NTOK * DM, 1);
        dbg_count_f32(F, (const float*)(ws + WS_LGATE), (size_t)32 * 16384, 2);
        dbg_count_bf16(F, (const bf16_t*)(ws + WS_YS), (size_t)32768 * 2048, 3);
        dbg_count_f32(F, (const float*)F.out, (size_t)NTOK * DM, 4);
        dbg_count_bf16(F, (const bf16_t*)(ws + WS_XB), (size_t)NTOK * DM, 5);
        xcd_barrier(bar);
        int first = 13;
        for (int k = 12; k >= 0; --k) if (__hip_atomic_load((unsigned*)(ws + WS_CTL) + CW_DBG + k * 64, __ATOMIC_RELAXED, __HIP_MEMORY_SCOPE_AGENT) != 0u) first = k;
        const float val = 1000.f * (float)(first + 1);
        for (size_t i = (size_t)F.bid * NT + F.tid; i < (size_t)NTOK * DM; i += (size_t)F.G * NT) F.out[i] = val;
    }
#endif
#undef IN
#undef SEAM
}

extern "C" void kernel_launch(void* const* d_in, const int* in_sizes, int n_in, void* d_out, int out_size, void* d_ws, size_t ws_size, hipStream_t stream) {
    static int grid = 0;
    if (grid == 0) {
        if (n_in != 31 || ws_size < WS_END) { fprintf(stderr, "kernel_launch: expected 31 inputs and >= %zu bytes of workspace, got %d / %zu\n", (size_t)WS_END, n_in, ws_size); grid = -1; return; }
        int dev = 0, cus = 0, per_cu = 0;
        if (hipGetDevice(&dev) != hipSuccess || hipDeviceGetAttribute(&cus, hipDeviceAttributeMultiprocessorCount, dev) != hipSuccess) { grid = -1; return; }
        if (hipFuncSetAttribute((const void*)mega_fwd, hipFuncAttributeMaxDynamicSharedMemorySize, LDS_BYTES) != hipSuccess) { fprintf(stderr, "kernel_launch: hipFuncSetAttribute failed\n"); grid = -1; return; }
        if (hipOccupancyMaxActiveBlocksPerMultiprocessor(&per_cu, (const void*)mega_fwd, NT, LDS_BYTES) != hipSuccess || per_cu < 1)
            fprintf(stderr, "kernel_launch: occupancy query reports %d workgroups per CU\n", per_cu);
        (void)hipGetLastError();
        grid = cus;
    }
    if (grid < 0) return;
    (void)hipMemsetAsync((char*)d_ws + WS_CTL, 0, CTL_BYTES, stream);
    Params p{};
    for (int i = 0; i < 31; ++i) p.in[i] = (const float*)d_in[i];
    p.out = (float*)d_out; p.ws = (unsigned char*)d_ws;
#if MK_PER_PHASE
    for (int ph = 0; ph < N_PHASES; ++ph) {
        if (ph > 0) { const int l = (ph - 1) / PH_PER_LAYER, loc = (ph - 1) % PH_PER_LAYER; if ((l % 3) != 0 && loc >= 2 && loc <= 5) continue; }
        p.ph_lo = ph; p.ph_hi = ph + 1;
        hipLaunchKernelGGL(mega_fwd, dim3(grid), dim3(NT), LDS_BYTES, stream, p);
    }
#else
#ifndef MK_PH_HI
#define MK_PH_HI N_PHASES
#endif
    p.ph_lo = 0; p.ph_hi = MK_PH_HI;
    hipLaunchKernelGGL(mega_fwd, dim3(grid), dim3(NT), LDS_BYTES, stream, p);
#endif
    const hipError_t le = hipPeekAtLastError();
    if (le != hipSuccess) fprintf(stderr, "kernel_launch: launch failed: %s\n", hipGetErrorName(le));
}
```

```cpp
#include <hip/hip_runtime.h>
#include <cstdio>
#include <cstdint>

#ifndef MK_PER_PHASE
#define MK_PER_PHASE 0
#endif
#ifndef MK_PH_HI
#define MK_PH_HI N_PHASES
#endif
#ifndef REP_GEMM
#define REP_GEMM 1
#endif
#ifndef REP_MOE
#define REP_MOE 1
#endif
#ifndef REP_SCAN
#define REP_SCAN 1
#endif
#ifndef REP_PREP
#define REP_PREP 1
#endif
#ifndef REP_MIX
#define REP_MIX 1
#endif
#ifndef REP_CONV
#define REP_CONV 1
#endif
#ifndef REP_SB
#define REP_SB 1
#endif
#ifndef REP_MA
#define REP_MA 1
#endif
#ifndef REP_WX
#define REP_WX 1
#endif
#ifndef REP_WS
#define REP_WS 1
#endif
#ifndef REP_WO
#define REP_WO 1
#endif
#ifndef REP_W2
#define REP_W2 1
#endif

#define LAS __attribute__((address_space(3)))
#define GAS __attribute__((address_space(1)))
#define DI __device__ __forceinline__
typedef unsigned short bf16_t;
typedef short bf16x8 __attribute__((ext_vector_type(8)));
typedef short s16x4 __attribute__((ext_vector_type(4)));
typedef float f32x2 __attribute__((ext_vector_type(2)));
typedef float f32x4 __attribute__((ext_vector_type(4)));
typedef float f32x8 __attribute__((ext_vector_type(8)));
typedef float f32x16 __attribute__((ext_vector_type(16)));
typedef unsigned u32x2 __attribute__((ext_vector_type(2)));
typedef unsigned u32x4 __attribute__((ext_vector_type(4)));

constexpr int NTOK = 16384, DM = 2048, SEQ = 4096, NBATCH = 4, CMIX = 1536, MEMW = 512, MEML = 256, NLAYER = 4;
constexpr int ZW_RWKV = 5632  , ZW_OTH = 5120, RW_IN_COLS = 5568;
constexpr int NEXP = 32, DEXP = 512, LISTCAP = 16384, MAXTILES = 160;
constexpr float LN_EPS = 1e-5f, ALPHA = 1.681792830507429f, GN_EPS = 64e-5f;
constexpr int NT = 512, NWAVES = 8;

constexpr size_t MiB = (size_t)1 << 20;
constexpr size_t WS_CTL = 0, CTL_BYTES = 1 * MiB;
constexpr size_t WS_WIN = 2 * MiB;
constexpr size_t WIN_STRIDE = 22 * MiB;
constexpr size_t WS_WOUT = 90 * MiB;
constexpr size_t WS_WK = 122 * MiB;
constexpr size_t WS_WV = 130 * MiB;
constexpr size_t WS_MEMB = 138 * MiB;
constexpr size_t WS_KM = 142 * MiB;
constexpr size_t WS_VMT = 146 * MiB;
constexpr size_t WS_LORA = 150 * MiB;
constexpr size_t LORA_STRIDE = 3 * MiB;
constexpr size_t WS_WSW = 156 * MiB;
constexpr size_t WSW_STRIDE = 393216;
constexpr size_t WS_EXP1 = 160 * MiB;
constexpr size_t WS_EXP2 = 288 * MiB;
constexpr size_t WS_XB = 352 * MiB;
constexpr size_t WS_Z = 416 * MiB;
constexpr size_t WS_CAT = 592 * MiB;
constexpr size_t WS_HB = 656 * MiB;
constexpr size_t WS_LTOK = 720 * MiB;
constexpr size_t WS_LGATE = 722 * MiB;
constexpr size_t WS_LSLOT = 724 * MiB;
constexpr size_t WS_HE = 728 * MiB;
constexpr size_t WS_YS = 768 * MiB;
constexpr size_t WS_ACT = 896 * MiB;
constexpr size_t WS_LW = 944 * MiB;
constexpr size_t WS_GATE = 1040 * MiB;
constexpr size_t WS_SCAN = 1088 * MiB;
constexpr size_t WS_V = 1568 * MiB;
constexpr size_t WS_Y = 1664 * MiB;
constexpr size_t WS_GH = 1760 * MiB;
constexpr size_t WS_QY = 1088 * MiB;
constexpr size_t WS_Y0T = 1152 * MiB;
constexpr size_t WS_E = 1280 * MiB;
constexpr size_t WS_END = 1952 * MiB;
constexpr int CW_BAR = 4096;
constexpr int CW_CNT = 16384;

constexpr int LDS_BYTES = 147456;
constexpr int LDS_CTL_OFF = 146432;

DI float bf2f(unsigned b) { return __uint_as_float(b << 16); }
typedef float cvt_f32x2 __attribute__((ext_vector_type(2)));
typedef __bf16 cvt_bf16x2 __attribute__((ext_vector_type(2)));
DI unsigned cvt_pk_bf16(float lo, float hi) { const cvt_f32x2 v = {lo, hi}; return __builtin_bit_cast(unsigned, __builtin_convertvector(v, cvt_bf16x2)); }
DI float bflo(unsigned w) { return __uint_as_float(w << 16); }
DI float bfhi(unsigned w) { return __uint_as_float(w & 0xffff0000u); }
DI float wave_sum(float v) {
#pragma unroll
    for (int o = 1; o < 64; o <<= 1) v += __shfl_xor(v, o);
    return v;
}
DI float sum16(float v) {
    v += __builtin_bit_cast(float, __builtin_amdgcn_update_dpp(0, __builtin_bit_cast(int, v), 0x128, 0xf, 0xf, false));
    v += __builtin_bit_cast(float, __builtin_amdgcn_update_dpp(0, __builtin_bit_cast(int, v), 0x124, 0xf, 0xf, false));
    v += __builtin_bit_cast(float, __builtin_amdgcn_update_dpp(0, __builtin_bit_cast(int, v), 0x122, 0xf, 0xf, false));
    v += __builtin_bit_cast(float, __builtin_amdgcn_update_dpp(0, __builtin_bit_cast(int, v), 0x121, 0xf, 0xf, false));
    return v;
}
DI float fma_s(float a, float b, float c) { float d; asm("v_fma_f32 %0, %1, %2, %3" : "=v"(d) : "v"(a), "v"(b), "v"(c)); return d; }
DI float sigmoidf_(float x) { return __builtin_amdgcn_rcpf(1.f + __expf(-x)); }
DI float softplusf_(float x) { return fmaxf(x, 0.f) + __logf(1.f + __expf(-fabsf(x))); }
#define LDS_WAIT() asm volatile("s_waitcnt lgkmcnt(0)" ::: "memory")
#define VM_WAIT() asm volatile("s_waitcnt vmcnt(0)" ::: "memory")
#define LDS_BARRIER() do { asm volatile("s_waitcnt lgkmcnt(0)" ::: "memory"); __builtin_amdgcn_s_barrier(); asm volatile("" ::: "memory"); } while (0)

template <class T> DI T* as_global(T* p) { return p; }
DI const float* kin_ptr(int i) { int off = i * 8; asm volatile("" : "+v"(off)); const char* ka = (const char*)__builtin_amdgcn_kernarg_segment_ptr();
    const unsigned long long p = *(const unsigned long long*)(ka + off);
    const unsigned lo = __builtin_amdgcn_readfirstlane((unsigned)p), hi = __builtin_amdgcn_readfirstlane((unsigned)(p >> 32));
    return as_global((const float*)(((unsigned long long)hi << 32) | lo)); }
#define PIN(i) kin_ptr(i)
DI unsigned char* opq(unsigned char* p) { asm volatile("" : "+s"(p)); return p; }
DI float* opqf(float* p) { asm volatile("" : "+s"(p)); return p; }

#define XB_TMO      128
#define XB_XCNT(j)  (256  + 64 * (j))
#define XB_XSUB(j)  (1280 + 64 * (j))
#define XB_XGEN(j)  (2304 + 64 * (j))
#define XB_TOP      3328
#define XB_TOPGEN   3392
#define XCD_BAR_WORDS 3456
#define XB_SPIN_CAP (1u << 20)

__device__ __forceinline__ unsigned xb_ld(unsigned* p)              { return __hip_atomic_load(p, __ATOMIC_RELAXED, __HIP_MEMORY_SCOPE_AGENT); }
__device__ __forceinline__ unsigned xb_add(unsigned* p, unsigned v) { return __hip_atomic_fetch_add(p, v, __ATOMIC_RELAXED, __HIP_MEMORY_SCOPE_AGENT); }
__device__ __forceinline__ unsigned xb_xcc_id() { return (unsigned)__builtin_amdgcn_s_getreg((3 << 11) | 20) & 0xFu; }
#define XB_SPIN(cond, bar) do { unsigned _sp = 0; while (cond) { __builtin_amdgcn_s_sleep(1); \
    if ((++_sp & 255u) == 0u) { if (xb_ld(&(bar)[XB_TMO])) break; if (_sp > XB_SPIN_CAP) { atomicAdd(&(bar)[XB_TMO], 1u); break; } } } } while (0)

struct XcdBarrier { unsigned* bar; unsigned x; volatile LAS unsigned* st; };

__device__ __forceinline__ XcdBarrier xcd_barrier_post(unsigned* bar, volatile LAS unsigned* st) {
    XcdBarrier b; b.bar = bar; b.x = xb_xcc_id(); b.st = st;
    if (threadIdx.x == 0) (void)xb_add(&bar[XB_XCNT(b.x)], 1u);
    return b;
}
__device__ __forceinline__ void xcd_barrier_complete(unsigned* bar, unsigned x, unsigned& nloc, unsigned& nx) {
    const unsigned G = gridDim.x * gridDim.y * gridDim.z;
    unsigned sum, cnt, mine, sp = 0u;
    for (;;) {
        sum = 0u; cnt = 0u; mine = 0u;
#pragma unroll
        for (unsigned j = 0; j < 16; ++j) { const unsigned c = xb_ld(&bar[XB_XCNT(j)]); sum += c; cnt += (c > 0u) ? 1u : 0u; mine = (j == x) ? c : mine; }
        if (sum == G) break;
        __builtin_amdgcn_s_sleep(1);
        if ((++sp & 255u) == 0u) { if (xb_ld(&bar[XB_TMO])) break; if (sp > XB_SPIN_CAP) { atomicAdd(&bar[XB_TMO], 1u); break; } }
    }
    nloc = mine > 0u ? mine : 1u; nx = cnt > 0u ? cnt : 1u;
}
__device__ __forceinline__ void xcd_barrier(const XcdBarrier& b) {
    asm volatile("s_waitcnt vmcnt(0)" ::: "memory");
    __syncthreads();
    if (threadIdx.x == 0) {
        unsigned* bar = b.bar;
        __builtin_amdgcn_s_waitcnt(0);
        unsigned nloc = b.st[0], nx = b.st[1];
        if (nloc == 0u) { xcd_barrier_complete(bar, b.x, nloc, nx); b.st[0] = nloc; b.st[1] = nx; }
        const unsigned old = xb_add(&bar[XB_XSUB(b.x)], 1u);
        const unsigned gen = old / nloc;
        if (old + 1u == (gen + 1u) * nloc) {
            __builtin_amdgcn_fence(__ATOMIC_RELEASE, "agent");
            asm volatile("s_waitcnt vmcnt(0)" ::: "memory");
            const unsigned og = xb_add(&bar[XB_TOP], 1u);
            const unsigned tg = og / nx;
            if (og + 1u == (tg + 1u) * nx) xb_add(&bar[XB_TOPGEN], 1u);
            else XB_SPIN(xb_ld(&bar[XB_TOPGEN]) == tg, bar);
            __builtin_amdgcn_fence(__ATOMIC_ACQUIRE, "agent");
            xb_add(&bar[XB_XGEN(b.x)], 1u);
            asm volatile("s_waitcnt vmcnt(0)" ::: "memory");
        } else {
            XB_SPIN(xb_ld(&bar[XB_XGEN(b.x)]) == gen, bar);
            __builtin_amdgcn_fence(__ATOMIC_ACQUIRE, "agent");
            asm volatile("s_waitcnt vmcnt(0)" ::: "memory");
        }
    }
    __syncthreads();
}

namespace pg8 {
constexpr int BM = 256, BK = 64, HALF = 128, HTB = HALF * BK * 2, STAGE_BYTES = 8 * HTB, NXCD = 8, WGM = 8;
DI int lds_byte(int r, int c) { const int st = (r >> 4) * 2 + (c >> 5), rr = r & 15, cc = c & 31, ob = rr * 64 + cc * 2; return st * 1024 + (ob ^ (((ob >> 9) & 1) << 5)); }
DI void stage_rc(int b, int& R, int& C) { const int st = b / 1024, sb = b % 1024, swz = sb ^ (((sb >> 9) & 1) << 5); R = (st >> 1) * 16 + swz / 64; C = (st & 1) * 32 + (swz % 64) / 2; }
DI int perm32(int rho) { const int n = rho >> 4, i = rho & 15; return 8 * (i >> 2) + 4 * n + (i & 3); }

struct Unit { int pm, pn, e, rt; };
struct Gemm { const bf16_t* A; const bf16_t* Bt; int lda, ldb, K; };

struct StaticOrder {
    static constexpr bool GATHER = false;
    int nM, nN, nwg, G, c;
    DI void init(int M, int N, int G_, int c_) { nM = M / BM; nN = N / BM; nwg = nM * nN; G = G_; c = c_; }
    DI bool next(int i, Unit& u) const {
        const long L = (long)i * G + c; if (L >= nwg) return false;
        int wgid = (int)L; { const int q = nwg / NXCD, r = nwg % NXCD, xcd = wgid % NXCD, off = wgid / NXCD; wgid = (xcd < r ? xcd * (q + 1) : r * (q + 1) + (xcd - r) * q) + off; }
        const int nig = WGM * nN, gid = wgid / nig, fm = gid * WGM, gsz = (nM - fm) < WGM ? (nM - fm) : WGM;
        u.pm = fm + ((wgid % nig) % gsz); u.pn = (wgid % nig) / gsz; u.e = 0; u.rt = 0; return true;
    }
    DI const char* a_base(const Gemm& g, const Unit& u) const { return (const char*)g.A + (size_t)u.pm * BM * g.lda * 2; }
    DI const char* b_base(const Gemm& g, const Unit& u) const { return (const char*)g.Bt + (size_t)u.pn * BM * g.ldb * 2; }
    DI unsigned gather_voff(const Unit&, int, int, int) const { return 0u; }
};

template <bool GATH> struct MoeOrder {
    static constexpr bool GATHER = GATH;
    int G, c, npn, total; const LAS int* tb; size_t estride; const int* ltok; const unsigned* cnt;
    DI bool next(int i, Unit& u) const {
        if ((G & 7) == 0) {
            const int x = c & 7, r = c >> 3, W = G >> 3, idx = i * W + r;
            const int q = idx / npn, pn = idx - q * npn; int base = 0;
#pragma unroll
            for (int k = 0; k < 4; ++k) { const int e = x + 8 * k, nt = tb[e + 1] - tb[e];
                if (q < base + nt) { u.e = e; u.rt = q - base; u.pm = tb[e] + u.rt; u.pn = pn; return true; }
                base += nt; }
            return false;
        }
        const int L = i * G + c; if (L >= total) return false;
        const int q = L / npn; u.pn = L - q * npn; u.pm = q;
        int e = 0; while (e < NEXP - 1 && tb[e + 1] <= q) ++e;
        u.e = e; u.rt = q - tb[e]; return true;
    }
    DI const char* a_base(const Gemm& g, const Unit& u) const { return (const char*)g.A + (size_t)u.pm * BM * g.lda * 2; }
    DI const char* b_base(const Gemm& g, const Unit& u) const { return (const char*)g.Bt + (size_t)u.e * estride + (size_t)u.pn * BM * g.ldb * 2; }
    DI unsigned gather_voff(const Unit& u, int r, int C, int lda) const {
        const int pos = u.rt * BM + r; const int n = (int)__hip_atomic_load(cnt + u.e * 64, __ATOMIC_RELAXED, __HIP_MEMORY_SCOPE_AGENT);
        const int tok = pos < n ? ltok[u.e * LISTCAP + pos] : 0;
        return (unsigned)(tok * lda + C) * 2u;
    }
};

struct EpiStore {
    bf16_t* O; int ldc;
    DI void operator()(const f32x4 (&acc)[2][2][4][2], const Unit& u, int wr, int wc, int fr, int fq) const {
        const int row0 = u.pm * BM + wr * 64 + fr, col0 = u.pn * BM + wc * 32 + 8 * fq;
#pragma unroll
        for (int ai = 0; ai < 2; ++ai)
#pragma unroll
            for (int m = 0; m < 4; ++m) { bf16_t* rowp = O + (size_t)(row0 + ai * HALF + m * 16) * ldc + col0;
#pragma unroll
                for (int bj = 0; bj < 2; ++bj) { const f32x4 v0 = acc[ai][bj][m][0], v1 = acc[ai][bj][m][1];
                    u32x4 w; w.x = cvt_pk_bf16(v0[0], v0[1]); w.y = cvt_pk_bf16(v0[2], v0[3]); w.z = cvt_pk_bf16(v1[0], v1[1]); w.w = cvt_pk_bf16(v1[2], v1[3]);
                    *(GAS u32x4*)(rowp + bj * HALF) = w; } }
    }
};
struct EpiSwiGLU {
    bf16_t* H;
    DI void operator()(const f32x4 (&acc)[2][2][4][2], const Unit& u, int wr, int wc, int fr, int fq) const {
        const int row0 = u.pm * BM + wr * 64 + fr, col0 = u.pn * HALF + wc * 32 + 8 * fq;
#pragma unroll
        for (int ai = 0; ai < 2; ++ai)
#pragma unroll
            for (int m = 0; m < 4; ++m) { bf16_t* rowp = H + (size_t)(row0 + ai * HALF + m * 16) * DEXP + col0;
                float h[8];
#pragma unroll
                for (int n = 0; n < 2; ++n)
#pragma unroll
                    for (int j = 0; j < 4; ++j) { const float gt = acc[ai][0][m][n][j], up = acc[ai][1][m][n][j]; h[n * 4 + j] = gt * __builtin_amdgcn_rcpf(1.f + __expf(-gt)) * up; }
                u32x4 w; w.x = cvt_pk_bf16(h[0], h[1]); w.y = cvt_pk_bf16(h[2], h[3]); w.z = cvt_pk_bf16(h[4], h[5]); w.w = cvt_pk_bf16(h[6], h[7]);
                *(GAS u32x4*)rowp = w; }
    }
};
struct EpiScatter {
    bf16_t* YS; const int* lslot; const float* lgate; const unsigned* cnt;
    DI void operator()(const f32x4 (&acc)[2][2][4][2], const Unit& u, int wr, int wc, int fr, int fq) const {
        const int n = (int)__hip_atomic_load(cnt + u.e * 64, __ATOMIC_RELAXED, __HIP_MEMORY_SCOPE_AGENT);
        const int col0 = u.pn * BM + wc * 32 + 8 * fq;
#pragma unroll
        for (int ai = 0; ai < 2; ++ai)
#pragma unroll
            for (int m = 0; m < 4; ++m) { const int pos = u.rt * BM + ai * HALF + wr * 64 + m * 16 + fr;
                if (pos < n) { const int slot = lslot[u.e * LISTCAP + pos]; const float gt = lgate[u.e * LISTCAP + pos];
                    bf16_t* rowp = YS + (size_t)slot * DM + col0;
#pragma unroll
                    for (int bj = 0; bj < 2; ++bj) { const f32x4 v0 = acc[ai][bj][m][0] * gt, v1 = acc[ai][bj][m][1] * gt;
                        u32x4 w; w.x = cvt_pk_bf16(v0[0], v0[1]); w.y = cvt_pk_bf16(v0[2], v0[3]); w.z = cvt_pk_bf16(v1[0], v1[1]); w.w = cvt_pk_bf16(v1[2], v1[3]);
                        *(GAS u32x4*)(rowp + bj * HALF) = w; } } }
    }
};

template <class Epi, class Sched>
DI void gemm_phase(LAS unsigned char* lds, const Gemm g, const Sched& S, const Epi& E) {
    int tid = threadIdx.x; asm volatile("" : "+v"(tid));
    const int wid = __builtin_amdgcn_readfirstlane(tid >> 6), lane = tid & 63, wr = wid >> 2, wc = wid & 3, fr = lane & 15, fq = lane >> 4;
    const int K = g.K, nt = K / BK;
    unsigned voffA[2], voffB[2];
#pragma unroll
    for (int i = 0; i < 2; ++i) { int R, C; stage_rc(tid * 16 + i * 8192, R, C); const int Rb = (R & ~31) + perm32(R & 31);
        voffA[i] = (unsigned)(R * g.lda + C) * 2u; voffB[i] = (unsigned)(Rb * g.ldb + C) * 2u; }
    const size_t kstep = (size_t)(BK * 2);
    const size_t hstepA = (size_t)HALF * g.lda * 2, hstepB = (size_t)HALF * g.ldb * 2;
    const unsigned ldsw = (unsigned)wid * 1024u;
    const int aoff = lds_byte(wr * 64 + fr, fq * 8), boff = lds_byte(wc * 32 + fr, fq * 8);
    unsigned gvC[2][2], gvN[2][2];
#define PG8_SA(b, h) (((b) * 2 + (h)) * HTB)
#define PG8_SB(b, h) ((4 + (b) * 2 + (h)) * HTB)
#define PG8_STAGE(bufoff, gbase, voff) do { _Pragma("unroll") for (int _i = 0; _i < 2; ++_i) \
        __builtin_amdgcn_global_load_lds((const unsigned*)((const char*)(gbase) + (voff)[_i]), (LAS unsigned*)(lds + (bufoff) + ldsw + _i * 8192), 16, 0, 0); } while (0)
#define PG8_STAGE_A(bufoff, h, nxtsel, kt) do { \
        if constexpr (Sched::GATHER) { const char* _gb = (const char*)g.A + (size_t)(kt) * kstep; unsigned _vo[2]; _vo[0] = (nxtsel) ? gvN[h][0] : gvC[h][0]; _vo[1] = (nxtsel) ? gvN[h][1] : gvC[h][1]; PG8_STAGE(bufoff, _gb, _vo); } \
        else { const char* _gb = ((nxtsel) ? nA : cA) + (size_t)(h) * hstepA + (size_t)(kt) * kstep; PG8_STAGE(bufoff, _gb, voffA); } } while (0)
#define PG8_GSETUP(dst, u) do { if constexpr (Sched::GATHER) { _Pragma("unroll") for (int _h = 0; _h < 2; ++_h) _Pragma("unroll") for (int _i = 0; _i < 2; ++_i) { int _R, _C; stage_rc(tid * 16 + _i * 8192, _R, _C); \
        dst[_h][_i] = S.gather_voff(u, _h * HALF + _R, _C, g.lda); } asm volatile("s_waitcnt vmcnt(0)" : "+v"(dst[0][0]), "+v"(dst[0][1]), "+v"(dst[1][0]), "+v"(dst[1][1]) :: "memory"); } } while (0)
#define PG8_LDA(dst, b, h) do { _Pragma("unroll") for (int m = 0; m < 4; ++m) _Pragma("unroll") for (int k = 0; k < 2; ++k) dst[m][k] = *(const LAS bf16x8*)(lds + PG8_SA(b, h) + aoff + m * 2048 + k * 1024); } while (0)
#define PG8_LDB(dst, b, h) do { _Pragma("unroll") for (int n = 0; n < 2; ++n) _Pragma("unroll") for (int k = 0; k < 2; ++k) dst[n][k] = *(const LAS bf16x8*)(lds + PG8_SB(b, h) + boff + n * 2048 + k * 1024); } while (0)
#define PG8_MMA(ai, bj, At, Bt) do { __builtin_amdgcn_s_setprio(1); _Pragma("unroll") for (int m = 0; m < 4; ++m) _Pragma("unroll") for (int n = 0; n < 2; ++n) _Pragma("unroll") for (int k = 0; k < 2; ++k) \
        acc[ai][bj][m][n] = __builtin_amdgcn_mfma_f32_16x16x32_bf16(Bt[n][k], At[m][k], acc[ai][bj][m][n], 0, 0, 0); __builtin_amdgcn_s_setprio(0); } while (0)
#define PG8_WAIT_V(n) asm volatile("s_waitcnt vmcnt(" #n ")" ::: "memory")
#define PG8_WAIT_L(n) asm volatile("s_waitcnt lgkmcnt(" #n ")" ::: "memory")
#define PG8_BAR __builtin_amdgcn_s_barrier()
#define PG8_SCHED __builtin_amdgcn_sched_barrier(0)
    Unit cur, nxt; int ui = 0;
    if (!S.next(0, cur)) return;
    f32x4 acc[2][2][4][2];
#pragma unroll
    for (int a = 0; a < 2; ++a)
#pragma unroll
        for (int b = 0; b < 2; ++b)
#pragma unroll
            for (int m = 0; m < 4; ++m)
#pragma unroll
                for (int n = 0; n < 2; ++n) acc[a][b][m][n] = (f32x4){0.f, 0.f, 0.f, 0.f};
    bf16x8 At[4][2], B0[2][2], B1[2][2];
    const char* cA = S.a_base(g, cur); const char* cB = S.b_base(g, cur);
    const char* nA = cA;
    PG8_GSETUP(gvC, cur);
    PG8_STAGE(PG8_SB(0, 0), cB, voffB); PG8_STAGE_A(PG8_SA(0, 0), 0, false, 0); PG8_STAGE(PG8_SB(0, 1), cB + hstepB, voffB); PG8_STAGE_A(PG8_SA(0, 1), 1, false, 0);
    if (wr == 1) PG8_BAR;
    PG8_WAIT_V(4); PG8_BAR;
    PG8_STAGE(PG8_SB(1, 0), cB + kstep, voffB); PG8_STAGE_A(PG8_SA(1, 0), 0, false, 1); PG8_STAGE(PG8_SB(1, 1), cB + hstepB + kstep, voffB);
    PG8_WAIT_V(6); PG8_BAR;
    for (;;) {
        const bool has_next = S.next(ui + 1, nxt);
        nA = has_next ? S.a_base(g, nxt) : cA; const char* nB = has_next ? S.b_base(g, nxt) : cB;
        if constexpr (Sched::GATHER) { if (has_next) { PG8_GSETUP(gvN, nxt); } else {
#pragma unroll
            for (int _h = 0; _h < 2; ++_h) { gvN[_h][0] = gvC[_h][0]; gvN[_h][1] = gvC[_h][1]; } } }
        for (int t = 0; t < nt; t += 2) {
            const bool last = (t == nt - 2);
            const int kt2 = last ? 0 : t + 2;
            const char* b2 = last ? nB : cB + (size_t)(t + 2) * kstep;
            const char* b3 = b2 + kstep;
            PG8_LDB(B0, 0, 0); PG8_SCHED; PG8_LDA(At, 0, 0); PG8_STAGE_A(PG8_SA(1, 1), 1, false, t + 1);
            PG8_WAIT_L(8); PG8_BAR; PG8_WAIT_L(0); PG8_MMA(0, 0, At, B0); PG8_BAR; PG8_SCHED;
            PG8_LDB(B1, 0, 1); PG8_STAGE(PG8_SB(0, 0), b2, voffB);
            PG8_BAR; PG8_WAIT_L(0); PG8_MMA(0, 1, At, B1); PG8_BAR;
            PG8_LDA(At, 0, 1); PG8_STAGE_A(PG8_SA(0, 0), 0, last, kt2);
            PG8_BAR; PG8_WAIT_L(0); PG8_MMA(1, 0, At, B0); PG8_BAR; PG8_SCHED;
            PG8_STAGE(PG8_SB(0, 1), b2 + hstepB, voffB);
            PG8_WAIT_V(6); PG8_BAR; PG8_MMA(1, 1, At, B1); PG8_BAR;
            PG8_LDB(B0, 1, 0); PG8_SCHED; PG8_LDA(At, 1, 0); PG8_STAGE_A(PG8_SA(0, 1), 1, last, kt2);
            PG8_WAIT_L(8); PG8_BAR; PG8_WAIT_L(0); PG8_MMA(0, 0, At, B0); PG8_BAR; PG8_SCHED;
            PG8_LDB(B1, 1, 1); PG8_STAGE(PG8_SB(1, 0), b3, voffB);
            PG8_BAR; PG8_WAIT_L(0); PG8_MMA(0, 1, At, B1); PG8_BAR;
            PG8_LDA(At, 1, 1); PG8_STAGE_A(PG8_SA(1, 0), 0, last, kt2 + 1);
            PG8_BAR; PG8_WAIT_L(0); PG8_MMA(1, 0, At, B0); PG8_BAR; PG8_SCHED;
            PG8_STAGE(PG8_SB(1, 1), b3 + hstepB, voffB);
            PG8_WAIT_V(6); PG8_BAR; PG8_MMA(1, 1, At, B1); PG8_BAR;
        }
        E(acc, cur, wr, wc, fr, fq);
        if (!has_next) break;
#pragma unroll
        for (int a = 0; a < 2; ++a)
#pragma unroll
            for (int b = 0; b < 2; ++b)
#pragma unroll
                for (int m = 0; m < 4; ++m)
#pragma unroll
                    for (int n = 0; n < 2; ++n) acc[a][b][m][n] = (f32x4){0.f, 0.f, 0.f, 0.f};
        cur = nxt; cA = nA; cB = nB; ++ui;
        if constexpr (Sched::GATHER) {
#pragma unroll
            for (int _h = 0; _h < 2; ++_h) { gvC[_h][0] = gvN[_h][0]; gvC[_h][1] = gvN[_h][1]; } }
    }
    PG8_WAIT_V(0);
    if (wr == 0) PG8_BAR;
    PG8_BAR;
#undef PG8_SA
#undef PG8_SB
#undef PG8_STAGE
#undef PG8_STAGE_A
#undef PG8_GSETUP
#undef PG8_LDA
#undef PG8_LDB
#undef PG8_MMA
#undef PG8_WAIT_V
#undef PG8_WAIT_L
#undef PG8_BAR
#undef PG8_SCHED
}
}

struct Params { const float* in[31]; float* out; unsigned char* ws; int ph_lo, ph_hi; };

struct Ctx {
    LAS unsigned char* lds;
    int tid, lane, wave, G, bid, gw, ngw;
    unsigned char* ws; float* out;
};
DI Ctx relaunder(const Ctx& F0) {
    Ctx F = F0;
    asm volatile("" : "+v"(F.tid), "+v"(F.lane));
    asm volatile("" : "+s"(F.wave), "+s"(F.G), "+s"(F.bid), "+s"(F.gw), "+s"(F.ngw));
    asm volatile("" : "+s"(F.ws), "+s"(F.out));
    F.ws = as_global(F.ws); F.out = as_global(F.out);
    return F;
}

DI void dense_gemm(const Ctx& F, const bf16_t* A, int lda, const bf16_t* Bt, int ldb, int M, int N, int K, bf16_t* O, int ldc, int crot) {
    pg8::Gemm g{A, Bt, lda, ldb, K}; pg8::StaticOrder S; S.init(M, N, F.G, (F.bid + crot) % F.G);
    pg8::EpiStore E{O, ldc};
    for (int rep = 0; rep < REP_GEMM; ++rep) pg8::gemm_phase<pg8::EpiStore, pg8::StaticOrder>(F.lds, g, S, E);
}

struct TJob { const float* src; bf16_t* dst; int ldw, dld; };
DI void tr_load(const TJob& j, f32x4 (&r)[16], int lane) {
    const GAS float* p = (const GAS float*)(j.src + (size_t)(lane >> 4) * j.ldw + 4 * (lane & 15));
#pragma unroll
    for (int i = 0; i < 16; ++i) r[i] = *(const GAS f32x4*)(p + (size_t)(4 * i) * j.ldw);
}
DI void tr_store(const TJob& j, const f32x4 (&r)[16], LAS unsigned char* scr, int lane) {
#pragma unroll
    for (int i = 0; i < 16; ++i) { LAS unsigned* w = (LAS unsigned*)(scr + ((lane >> 4) + 4 * i) * 132 + (lane & 15) * 8); w[0] = cvt_pk_bf16(r[i].x, r[i].y); w[1] = cvt_pk_bf16(r[i].z, r[i].w); }
    LDS_WAIT();
    const int kc = lane & 7;
#pragma unroll
    for (int sgrp = 0; sgrp < 8; ++sgrp) { const int n = 8 * sgrp + (lane >> 3); const LAS unsigned short* c = (const LAS unsigned short*)(scr + (8 * kc) * 132 + n * 2);
        u32x4 o; o.x = (unsigned)c[0] | ((unsigned)c[66] << 16); o.y = (unsigned)c[2 * 66] | ((unsigned)c[3 * 66] << 16); o.z = (unsigned)c[4 * 66] | ((unsigned)c[5 * 66] << 16); o.w = (unsigned)c[6 * 66] | ((unsigned)c[7 * 66] << 16);
        *(GAS u32x4*)(j.dst + (size_t)n * j.dld + 8 * kc) = o; }
    LDS_WAIT();
}
template <class Dec> DI void tr_run(const Dec& D, int first, int count, int stride, LAS unsigned char* scr, int lane) {
    f32x4 A[16], B[16]; TJob ja, jb;
    int it = first; if (it >= count) return;
    ja = D(it); tr_load(ja, A, lane);
    for (;;) {
        const int it2 = it + stride; const bool h2 = it2 < count; if (h2) { jb = D(it2); tr_load(jb, B, lane); }
        tr_store(ja, A, scr, lane);
        if (!h2) break;
        const int it3 = it2 + stride; const bool h3 = it3 < count; if (h3) { ja = D(it3); tr_load(ja, A, lane); }
        tr_store(jb, B, scr, lane);
        if (!h3) break;
        it = it3;
    }
}
DI TJob mat_job(const float* W, int K, int N, bf16_t* WT, int item) {
    const int nblk = N / 64, kb = item / nblk, nb = item - kb * nblk;
    TJob j; j.src = W + (size_t)(64 * kb) * N + 64 * nb; j.dst = WT + (size_t)(64 * nb) * K + 64 * kb; j.ldw = N; j.dld = K; return j;
}
DI void row_to_bf16(const float* src, bf16_t* dst, int lane) {
    const GAS f32x4* s = (const GAS f32x4*)src + lane; GAS u32x2* o = (GAS u32x2*)dst + lane;
#pragma unroll
    for (int j = 0; j < 8; ++j) { const f32x4 v = s[64 * j]; u32x2 w; w.x = cvt_pk_bf16(v.x, v.y); w.y = cvt_pk_bf16(v.z, v.w); o[64 * j] = w; }
}

DI void phase_prologue(const Ctx& F, const Params& P) {
    unsigned char* const wsl = F.ws; float* const outl = F.out; (void)outl;
    LAS unsigned char* scr = F.lds + F.wave * 16384;
    unsigned char* ws = wsl;
    constexpr int I_RW = 32 * (RW_IN_COLS / 64), I_OT = 32 * (ZW_OTH / 64), I_WO = 32 * 32, I_KV = 32 * 8;
    constexpr int N_A = 2 * I_RW + 2 * I_OT, N_B = 4 * I_WO, N_C = 8 * I_KV, N_D = NTOK + NBATCH * MEML;
    struct ProDec { unsigned char* ws;
        DI TJob operator()(int it) const { int r = it;
            if (r < N_A) {
                if (r < I_RW) return mat_job(PIN(16), DM, RW_IN_COLS, (bf16_t*)(ws + WS_WIN), r); r -= I_RW;
                if (r < I_OT) return mat_job(PIN(28), DM, ZW_OTH, (bf16_t*)(ws + WS_WIN + WIN_STRIDE), r); r -= I_OT;
                if (r < I_OT) return mat_job(PIN(30), DM, ZW_OTH, (bf16_t*)(ws + WS_WIN + 2 * WIN_STRIDE), r); r -= I_OT;
                return mat_job(PIN(16) + (size_t)DM * RW_IN_COLS, DM, RW_IN_COLS, (bf16_t*)(ws + WS_WIN + 3 * WIN_STRIDE), r);
            }
            r -= N_A;
            if (r < N_B) { const int l = r / I_WO; return mat_job(PIN(2) + (size_t)l * DM * DM, DM, DM, (bf16_t*)(ws + WS_WOUT) + (size_t)l * DM * DM, r - l * I_WO); }
            r -= N_B;
            const int m = r / I_KV, l = m & 3; const bool isv = m >= 4;
            return mat_job(PIN(isv ? 4 : 3) + (size_t)l * DM * MEMW, DM, MEMW, (bf16_t*)(ws + (isv ? WS_WV : WS_WK)) + (size_t)l * MEMW * DM, r - m * I_KV);
        } };
    ProDec PD{ws};
    tr_run(PD, F.gw, N_A + N_B + N_C, F.ngw, scr, F.lane);
    for (int r = F.gw; r < N_D; r += F.ngw) {
        if (r < NTOK) row_to_bf16(PIN(0) + (size_t)r * DM, (bf16_t*)(ws + WS_XB) + (size_t)r * DM, F.lane);
        else row_to_bf16(PIN(1) + (size_t)(r - NTOK) * DM, (bf16_t*)(ws + WS_MEMB) + (size_t)(r - NTOK) * DM, F.lane);
    }
    const int gt = F.bid * NT + F.tid, ngt = F.G * NT;
    for (int idx = gt; idx < 2 * (3072 + 1536) * 256; idx += ngt) {
        const int j = idx / ((3072 + 1536) * 256); int r = idx - j * (3072 + 1536) * 256;
        bf16_t* base = (bf16_t*)(ws + WS_LORA + (size_t)j * LORA_STRIDE);
        const int n = r >> 8, k = r & 255; float v = 0.f;
        if (n < 1536) { if (k < 96) v = PIN(19)[((size_t)j * 96 + k) * CMIX + n]; }
        else if (n < 3072) { if (k >= 96 && k < 192) v = PIN(21)[((size_t)j * 96 + (k - 96)) * CMIX + (n - 1536)]; }
        else v = PIN(22)[((size_t)j * 256 + k) * CMIX + (n - 3072)];
        base[r] = (bf16_t)(cvt_pk_bf16(v, 0.f) & 0xffffu);
    }
    for (int idx = gt; idx < 2 * 64 * DM; idx += ngt) { const int j = idx / (64 * DM), r = idx - j * 64 * DM;
        ((bf16_t*)(ws + WS_WIN + (size_t)(j ? 3 : 0) * WIN_STRIDE))[(size_t)RW_IN_COLS * DM + r] = 0; }
    for (int idx = gt; idx < NLAYER * 48 * DM; idx += ngt) {
        const int l = idx / (48 * DM); int r = idx - l * 48 * DM; const int n = r / DM, k = r - n * DM;
        float v = 0.f;
        if (n < 4) v = PIN(9)[((size_t)l * DM + k) * 4 + n]; else if (n < 36) v = PIN(11)[((size_t)l * DM + k) * 32 + (n - 4)];
        const unsigned hi = cvt_pk_bf16(v, 0.f) & 0xffffu; const float rem = v - bf2f(hi); const unsigned lo = cvt_pk_bf16(rem, 0.f) & 0xffffu;
        bf16_t* base = (bf16_t*)(ws + WS_WSW + (size_t)l * WSW_STRIDE);
        base[r] = (bf16_t)hi; base[48 * DM + r] = (bf16_t)lo;
    }
}

DI void expert_convert(const Ctx& F, const Params& P, int l, int w, int nw) {
    unsigned char* const wsl = F.ws;
    LAS unsigned char* scr = F.lds + F.wave * 16384;
    constexpr int I_GU = NEXP * 32 * 8 * 2, I_DN = NEXP * 8 * 32;
    struct ExpDec { unsigned char* ws; int l;
        DI TJob operator()(int it) const { TJob j;
            if (it < I_GU) {
                const int isup = it / (I_GU / 2); int r = it - isup * (I_GU / 2);
                const int e = r / 256; r -= e * 256; const int kb = r >> 3, nb = r & 7;
                const float* W = PIN(isup ? 14 : 13) + ((size_t)l * NEXP + e) * DM * DEXP;
                const int n0 = 64 * nb, drow = 256 * (n0 >> 7) + (isup ? 128 : 0) + (n0 & 127);
                j.src = W + (size_t)(64 * kb) * DEXP + n0; j.ldw = DEXP; j.dst = (bf16_t*)(ws + WS_EXP1) + ((size_t)e * 1024 + drow) * DM + 64 * kb; j.dld = DM;
            } else {
                int r = it - I_GU; const int e = r / 256; r -= e * 256; const int kb = r >> 5, nb = r & 31;
                const float* W = PIN(15) + ((size_t)l * NEXP + e) * DEXP * DM;
                j.src = W + (size_t)(64 * kb) * DM + 64 * nb; j.ldw = DM; j.dst = (bf16_t*)(ws + WS_EXP2) + ((size_t)e * DM + 64 * nb) * DEXP + 64 * kb; j.dld = DEXP;
            }
            return j; } };
    ExpDec ED{wsl, l};
    tr_run(ED, w, I_GU + I_DN, nw, scr, F.lane);
}

DI void memattn_unit(const Ctx& F, int l, int unit, const bf16_t* z, int zw, int qcol) {
    unsigned char* const wsl = F.ws; float* const outl = F.out; (void)outl;
    const int b = unit >> 6, head = (unit >> 4) & 3, qblk = unit & 15;
    LAS unsigned char* Ks = F.lds; LAS unsigned char* Vs = F.lds + 69632;
    const bf16_t* Km = (const bf16_t*)(wsl + WS_KM); const bf16_t* VmT = (const bf16_t*)(wsl + WS_VMT);
    bf16_t* cat = (bf16_t*)(wsl + WS_CAT);
    __syncthreads();
#pragma unroll
    for (int h = 0; h < 2; ++h) {
        u32x4 kv[4], vv[4];
#pragma unroll
        for (int i = 0; i < 4; ++i) { const int ch = F.tid + NT * (4 * h + i);
            { const int row = ch >> 4, c16 = ch & 15; kv[i] = *(const GAS u32x4*)(Km + (size_t)(b * MEML + row) * 2048 + l * 512 + head * 128 + c16 * 8); }
            { const int d = ch >> 5, c = ch & 31; vv[i] = *(const GAS u32x4*)(VmT + (size_t)(l * 512 + head * 128 + d) * 1024 + b * MEML + c * 8); } }
#pragma unroll
        for (int i = 0; i < 4; ++i) { const int ch = F.tid + NT * (4 * h + i);
            { const int row = ch >> 4, c16 = ch & 15; *(LAS u32x4*)(Ks + row * 272 + c16 * 16) = kv[i]; }
            { const int d = ch >> 5, c = ch & 31; *(LAS u32x4*)(Vs + d * 528 + c * 16) = vv[i]; } }
        asm volatile("" ::: "memory");
    }
    __syncthreads();
    int lane = F.lane; asm volatile("" : "+v"(lane) :: "memory");
    const int fr = lane & 15, fq = lane >> 4;
    for (int itq = 0; itq < 2; ++itq) {
        asm volatile("" : "+v"(lane) :: "memory");
        const int q0 = qblk * 256 + itq * 128 + F.wave * 16, tok0 = b * SEQ + q0;
        bf16x8 Qf[4];
#pragma unroll
        for (int ks = 0; ks < 4; ++ks) Qf[ks] = *(const GAS bf16x8*)(z + (size_t)(tok0 + (lane & 15)) * zw + qcol + head * 128 + ks * 32 + (lane >> 4) * 8);
        f32x4 acc[16];
#pragma unroll
        for (int t = 0; t < 16; ++t) { acc[t] = (f32x4){0.f, 0.f, 0.f, 0.f};
#pragma unroll
            for (int ks = 0; ks < 4; ++ks) { const bf16x8 kf = *(const LAS bf16x8*)(Ks + (16 * t + fr) * 272 + ks * 64 + fq * 16);
                acc[t] = __builtin_amdgcn_mfma_f32_16x16x32_bf16(kf, Qf[ks], acc[t], 0, 0, 0); } }
        const float sc = 0.08838834764831845f;
        float mx = -3.0e38f;
#pragma unroll
        for (int t = 0; t < 16; ++t)
#pragma unroll
            for (int j = 0; j < 4; ++j) { acc[t][j] *= sc; mx = fmaxf(mx, acc[t][j]); }
        mx = fmaxf(mx, __shfl_xor(mx, 16)); mx = fmaxf(mx, __shfl_xor(mx, 32));
        float sum = 0.f;
#pragma unroll
        for (int t = 0; t < 16; ++t)
#pragma unroll
            for (int j = 0; j < 4; ++j) { acc[t][j] = __expf(acc[t][j] - mx); sum += acc[t][j]; }
        sum += __shfl_xor(sum, 16); sum += __shfl_xor(sum, 32);
        const float inv = 1.f / sum;
        f32x4 o[8];
#pragma unroll
        for (int dt = 0; dt < 8; ++dt) o[dt] = (f32x4){0.f, 0.f, 0.f, 0.f};
#pragma unroll
        for (int s = 0; s < 8; ++s) {
            u32x4 pw; pw.x = cvt_pk_bf16(acc[2 * s][0], acc[2 * s][1]); pw.y = cvt_pk_bf16(acc[2 * s][2], acc[2 * s][3]);
            pw.z = cvt_pk_bf16(acc[2 * s + 1][0], acc[2 * s + 1][1]); pw.w = cvt_pk_bf16(acc[2 * s + 1][2], acc[2 * s + 1][3]);
            const bf16x8 pf = __builtin_bit_cast(bf16x8, pw);
#pragma unroll
            for (int dt = 0; dt < 8; ++dt) {
                const u32x2 v0 = *(const LAS u32x2*)(Vs + (16 * dt + fr) * 528 + (32 * s + 4 * fq) * 2);
                const u32x2 v1 = *(const LAS u32x2*)(Vs + (16 * dt + fr) * 528 + (32 * s + 16 + 4 * fq) * 2);
                u32x4 vw; vw.x = v0.x; vw.y = v0.y; vw.z = v1.x; vw.w = v1.y;
                o[dt] = __builtin_amdgcn_mfma_f32_16x16x32_bf16(__builtin_bit_cast(bf16x8, vw), pf, o[dt], 0, 0, 0);
            }
        }
        bf16_t* orow = cat + (size_t)(tok0 + fr) * DM + CMIX + head * 128 + 4 * fq;
#pragma unroll
        for (int dt = 0; dt < 8; ++dt) { u32x2 w; w.x = cvt_pk_bf16(o[dt][0] * inv, o[dt][1] * inv); w.y = cvt_pk_bf16(o[dt][2] * inv, o[dt][3] * inv); *(GAS u32x2*)(orow + 16 * dt) = w; }
    }
}
DI void memattn_all(const Ctx& F, int l, const bf16_t* z, int zw, int qcol) {
    for (int u = F.bid; u < 256; u += F.G) memattn_unit(F, l, u, z, zw, qcol);
    __syncthreads();
}

DI void conv_mix(const Ctx& F, const Params& P, const bf16_t* z) {
    unsigned char* const wsl = F.ws; float* const outl = F.out; (void)outl;
    const float* cw = PIN(29);
    bf16_t* cat = (bf16_t*)(wsl + WS_CAT);
    const int gt = F.bid * NT + F.tid, ngt = F.G * NT;
    for (int idx = gt; idx < NTOK * 192; idx += ngt) {
        const int tok = idx / 192, c8 = idx - tok * 192, c = c8 * 8, t = tok & (SEQ - 1);
        const bf16_t* zr = z + (size_t)tok * ZW_OTH;
        const u32x4 bg = *(const u32x4*)(zr + c);
        float y[8];
#pragma unroll
        for (int j = 0; j < 8; ++j) y[j] = 0.f;
#pragma unroll
        for (int dt = 0; dt < 3; ++dt) {
            if (t - dt >= 0) {
                const u32x4 cg = *(const u32x4*)(zr - (size_t)dt * ZW_OTH + CMIX + c), hh = *(const u32x4*)(zr - (size_t)dt * ZW_OTH + 2 * CMIX + c);
                const f32x4 w0 = *(const f32x4*)(cw + (2 - dt) * CMIX + c), w1 = *(const f32x4*)(cw + (2 - dt) * CMIX + c + 4);
                y[0] += w0.x * bflo(cg.x) * bflo(hh.x); y[1] += w0.y * bfhi(cg.x) * bfhi(hh.x); y[2] += w0.z * bflo(cg.y) * bflo(hh.y); y[3] += w0.w * bfhi(cg.y) * bfhi(hh.y);
                y[4] += w1.x * bflo(cg.z) * bflo(hh.z); y[5] += w1.y * bfhi(cg.z) * bfhi(hh.z); y[6] += w1.z * bflo(cg.w) * bflo(hh.w); y[7] += w1.w * bfhi(cg.w) * bfhi(hh.w);
            }
        }
        u32x4 o; o.x = cvt_pk_bf16(bflo(bg.x) * y[0], bfhi(bg.x) * y[1]); o.y = cvt_pk_bf16(bflo(bg.y) * y[2], bfhi(bg.y) * y[3]);
        o.z = cvt_pk_bf16(bflo(bg.z) * y[4], bfhi(bg.z) * y[5]); o.w = cvt_pk_bf16(bflo(bg.w) * y[6], bfhi(bg.w) * y[7]);
        *(u32x4*)(cat + (size_t)tok * DM + c) = o;
    }
}

DI void sb_attention(const Ctx& F, const bf16_t* z) {
    unsigned char* const wsl = F.ws;
    const bf16_t* VT = (const bf16_t*)(wsl + WS_ACT);
    bf16_t* cat = (bf16_t*)(wsl + WS_CAT);
    LAS unsigned char* Ks = F.lds; LAS unsigned char* Vs = F.lds + 69632;
    const int lane = F.lane, fr = lane & 15, fq = lane >> 4;
    const float sc = 0.08838834764831845f;
    for (int u = F.bid; u < NBATCH * 12 * 32; u += F.G) {
        const int b = u / (12 * 32); int r = u - b * 12 * 32; const int head = r >> 5, qblk = r & 31;
        const int t0 = qblk * 128, kw0 = t0 - 128;
        __syncthreads();
#pragma unroll
        for (int h = 0; h < 2; ++h) {
            u32x4 kv[4], vv[4];
#pragma unroll
            for (int i = 0; i < 4; ++i) { const int ch = F.tid + NT * (4 * h + i);
                { const int row = ch >> 4, c16 = ch & 15, key = kw0 + row, keyc = key < 0 ? 0 : key; kv[i] = *(const GAS u32x4*)(z + (size_t)(b * SEQ + keyc) * ZW_OTH + CMIX + head * 128 + c16 * 8); }
                { const int d = ch >> 5, c = ch & 31, k8 = kw0 + c * 8, k8c = k8 < 0 ? 0 : k8; vv[i] = *(const GAS u32x4*)(VT + (size_t)(head * 128 + d) * NTOK + b * SEQ + k8c); } }
#pragma unroll
            for (int i = 0; i < 4; ++i) { const int ch = F.tid + NT * (4 * h + i);
                { const int row = ch >> 4, c16 = ch & 15; *(LAS u32x4*)(Ks + row * 272 + c16 * 16) = kv[i]; }
                { const int d = ch >> 5, c = ch & 31; *(LAS u32x4*)(Vs + d * 528 + c * 16) = vv[i]; } }
            asm volatile("" ::: "memory");
        }
        __syncthreads();
        int lq = F.lane; asm volatile("" : "+v"(lq) :: "memory");
        const int tq0 = t0 + F.wave * 16, tq = tq0 + fr;
        bf16x8 Qf[4];
#pragma unroll
        for (int ks = 0; ks < 4; ++ks) Qf[ks] = *(const GAS bf16x8*)(z + (size_t)(b * SEQ + tq0 + (lq & 15)) * ZW_OTH + head * 128 + ks * 32 + (lq >> 4) * 8);
        f32x4 o[8];
#pragma unroll
        for (int dt = 0; dt < 8; ++dt) o[dt] = (f32x4){0.f, 0.f, 0.f, 0.f};
        float R = 0.f;
        for (int kt = (tq0 + 14) >> 5; kt >= 0; --kt) {
            const int lk = 32 * kt - kw0;
            bf16x8 Kf[2][4]; u32x2 V0[8], V1[8];
            if (lk >= 0) {
#pragma unroll
                for (int tl = 0; tl < 2; ++tl)
#pragma unroll
                    for (int ks = 0; ks < 4; ++ks) Kf[tl][ks] = *(const LAS bf16x8*)(Ks + (lk + 16 * tl + fr) * 272 + ks * 64 + fq * 16);
#pragma unroll
                for (int dt = 0; dt < 8; ++dt) { V0[dt] = *(const LAS u32x2*)(Vs + (16 * dt + fr) * 528 + (lk + 4 * fq) * 2); V1[dt] = *(const LAS u32x2*)(Vs + (16 * dt + fr) * 528 + (lk + 16 + 4 * fq) * 2); }
            } else {
#pragma unroll
                for (int tl = 0; tl < 2; ++tl)
#pragma unroll
                    for (int ks = 0; ks < 4; ++ks) Kf[tl][ks] = *(const GAS bf16x8*)(z + (size_t)(b * SEQ + 32 * kt + 16 * tl + fr) * ZW_OTH + CMIX + head * 128 + ks * 32 + fq * 8);
#pragma unroll
                for (int dt = 0; dt < 8; ++dt) { const bf16_t* vp = VT + (size_t)(head * 128 + 16 * dt + fr) * NTOK + b * SEQ + 32 * kt + 4 * fq; V0[dt] = *(const GAS u32x2*)vp; V1[dt] = *(const GAS u32x2*)(vp + 16); }
            }
            f32x4 s[2];
#pragma unroll
            for (int tl = 0; tl < 2; ++tl) { s[tl] = (f32x4){0.f, 0.f, 0.f, 0.f};
#pragma unroll
                for (int ks = 0; ks < 4; ++ks) s[tl] = __builtin_amdgcn_mfma_f32_16x16x32_bf16(Kf[tl][ks], Qf[ks], s[tl], 0, 0, 0); }
            float ln[2][4], lsg[2][4], tot[2];
#pragma unroll
            for (int tl = 0; tl < 2; ++tl) { tot[tl] = 0.f;
#pragma unroll
                for (int j = 0; j < 4; ++j) { const float x = s[tl][j] * sc; const int key = 32 * kt + 16 * tl + 4 * fq + j; const bool valid = key < tq;
                    const float sp = softplusf_(x); ln[tl][j] = valid ? -sp : 0.f; lsg[tl][j] = valid ? (x - sp) : -1.0e30f; tot[tl] += ln[tl][j]; } }
            const float a16_0 = __shfl_xor(tot[0], 16), a32_0 = __shfl_xor(tot[0], 32), a48_0 = __shfl_xor(tot[0], 48);
            const float a16_1 = __shfl_xor(tot[1], 16), a32_1 = __shfl_xor(tot[1], 32), a48_1 = __shfl_xor(tot[1], 48);
            float hi0 = 0.f, hi1 = 0.f;
            if ((fq ^ 1) > fq) { hi0 += a16_0; hi1 += a16_1; }
            if ((fq ^ 2) > fq) { hi0 += a32_0; hi1 += a32_1; }
            if ((fq ^ 3) > fq) { hi0 += a48_0; hi1 += a48_1; }
            const float all0 = tot[0] + a16_0 + a32_0 + a48_0, all1 = tot[1] + a16_1 + a32_1 + a48_1;
            const float E0 = R + hi0 + all1, E1 = R + hi1;
            float at[2][4];
#pragma unroll
            for (int tl = 0; tl < 2; ++tl) { float suf = 0.f; const float Eb = tl ? E1 : E0;
#pragma unroll
                for (int j = 3; j >= 0; --j) { at[tl][j] = __expf(lsg[tl][j] + Eb + suf); suf += ln[tl][j]; } }
            R += all0 + all1;
            u32x4 pw; pw.x = cvt_pk_bf16(at[0][0], at[0][1]); pw.y = cvt_pk_bf16(at[0][2], at[0][3]); pw.z = cvt_pk_bf16(at[1][0], at[1][1]); pw.w = cvt_pk_bf16(at[1][2], at[1][3]);
            const bf16x8 pf = __builtin_bit_cast(bf16x8, pw);
#pragma unroll
            for (int dt = 0; dt < 8; ++dt) {
                u32x4 vw; vw.x = V0[dt].x; vw.y = V0[dt].y; vw.z = V1[dt].x; vw.w = V1[dt].y;
                o[dt] = __builtin_amdgcn_mfma_f32_16x16x32_bf16(__builtin_bit_cast(bf16x8, vw), pf, o[dt], 0, 0, 0);
            }
            if (__all(R < -100.f)) break;
        }
        bf16_t* orow = cat + (size_t)(b * SEQ + tq) * DM + head * 128 + 4 * fq;
#pragma unroll
        for (int dt = 0; dt < 8; ++dt) { u32x2 w; w.x = cvt_pk_bf16(o[dt][0], o[dt][1]); w.y = cvt_pk_bf16(o[dt][2], o[dt][3]); *(GAS u32x2*)(orow + 16 * dt) = w; }
    }
    __syncthreads();
}

DI void rwkv_prep1(const Ctx& F, const Params& P, int j, const bf16_t* z) {
    unsigned char* const wsl = F.ws; float* const outl = F.out; (void)outl;
    const float* mu = PIN(17) + (size_t)j * 5056;
    bf16_t* act = (bf16_t*)(wsl + WS_ACT);
    const int gt = F.bid * NT + F.tid, ngt = F.G * NT;
    for (int idx = gt; idx < NTOK * 64; idx += ngt) {
        const int tok = idx >> 6, ci = idx & 63, t = tok & (SEQ - 1);
        u32x4 o = (u32x4){0u, 0u, 0u, 0u};
        if (ci < 24 || ci >= 32) {
            const int sc = ci < 12 ? 4608 + 8 * ci : (ci < 24 ? 4704 + 8 * (ci - 12) : 4800 + 8 * (ci - 32));
            const u32x4 a = *(const u32x4*)(z + (size_t)tok * ZW_RWKV + sc);
            u32x4 p = (u32x4){0u, 0u, 0u, 0u}; if (t > 0) p = *(const u32x4*)(z + (size_t)(tok - 1) * ZW_RWKV + sc);
            const f32x4 m0 = *(const f32x4*)(mu + sc), m1 = *(const f32x4*)(mu + sc + 4);
            float v[8];
            v[0] = bflo(a.x) + (bflo(p.x) - bflo(a.x)) * m0.x; v[1] = bfhi(a.x) + (bfhi(p.x) - bfhi(a.x)) * m0.y;
            v[2] = bflo(a.y) + (bflo(p.y) - bflo(a.y)) * m0.z; v[3] = bfhi(a.y) + (bfhi(p.y) - bfhi(a.y)) * m0.w;
            v[4] = bflo(a.z) + (bflo(p.z) - bflo(a.z)) * m1.x; v[5] = bfhi(a.z) + (bfhi(p.z) - bfhi(a.z)) * m1.y;
            v[6] = bflo(a.w) + (bflo(p.w) - bflo(a.w)) * m1.z; v[7] = bfhi(a.w) + (bfhi(p.w) - bfhi(a.w)) * m1.w;
#pragma unroll
            for (int q = 0; q < 8; ++q) { if (ci < 12) v[q] = tanhf(v[q]); else if (ci >= 32) v[q] = sigmoidf_(v[q]); }
            o.x = cvt_pk_bf16(v[0], v[1]); o.y = cvt_pk_bf16(v[2], v[3]); o.z = cvt_pk_bf16(v[4], v[5]); o.w = cvt_pk_bf16(v[6], v[7]);
        }
        *(u32x4*)(act + (size_t)tok * 512 + ci * 8) = o;
    }
}

constexpr int CH = 64, NCH = SEQ / CH;
DI float* scan_rec(unsigned char* ws, int tok, int head) {
    return (float*)(ws + WS_SCAN) + ((size_t)((tok >> 12) * 24 + head) * SEQ + (tok & (SEQ - 1))) * 320;
}
DI float* gh_ptr(unsigned char* ws, int bh, int c, int which) { return (float*)(ws + WS_GH) + (((size_t)bh * NCH + c) * 2 + which) * 4096; }
struct RwPar { const float *mu, *w0, *a0, *kk, *ka, *rk, *gng, *gnb; };
struct PrepRaw { u32x2 zr, zk, zv, pr, pk, pv, lw, la; };
struct PrepOut { f32x4 dec, ld, bb, kp, r, nk, v; float bon; };
DI void prep_load(PrepRaw& R, const bf16_t* z, const bf16_t* LW, int tok, int c4) {
    tok = tok < NTOK ? tok : NTOK - 1;
    const bool hp = (tok & (SEQ - 1)) != 0;
    const GAS bf16_t* zc = (const GAS bf16_t*)(z + (size_t)tok * ZW_RWKV + c4); const GAS bf16_t* zp = hp ? zc - ZW_RWKV : zc;
    R.zr = *(const GAS u32x2*)zc; R.zk = *(const GAS u32x2*)(zc + CMIX); R.zv = *(const GAS u32x2*)(zc + 2 * CMIX);
    R.pr = *(const GAS u32x2*)zp; R.pk = *(const GAS u32x2*)(zp + CMIX); R.pv = *(const GAS u32x2*)(zp + 2 * CMIX);
    const GAS bf16_t* lp = (const GAS bf16_t*)(LW + (size_t)tok * 3072 + c4); R.lw = *(const GAS u32x2*)lp; R.la = *(const GAS u32x2*)(lp + CMIX);
}
DI f32x4 lerp_u(u32x2 a, u32x2 p, f32x4 m) {
    f32x4 r; r.x = bflo(a.x) + (bflo(p.x) - bflo(a.x)) * m.x; r.y = bfhi(a.x) + (bfhi(p.x) - bfhi(a.x)) * m.y;
    r.z = bflo(a.y) + (bflo(p.y) - bflo(a.y)) * m.z; r.w = bfhi(a.y) + (bfhi(p.y) - bfhi(a.y)) * m.w; return r;
}
struct PrepPar { f32x4 mur, muk, muv, w0, a0, kk, ka, rk; };
DI void par_load(PrepPar& P, const RwPar& Q, int c4) {
    P.mur = *(const GAS f32x4*)(Q.mu + c4); P.muk = *(const GAS f32x4*)(Q.mu + CMIX + c4); P.muv = *(const GAS f32x4*)(Q.mu + 2 * CMIX + c4);
    P.w0 = *(const GAS f32x4*)(Q.w0 + c4); P.a0 = *(const GAS f32x4*)(Q.a0 + c4); P.kk = *(const GAS f32x4*)(Q.kk + c4); P.ka = *(const GAS f32x4*)(Q.ka + c4); P.rk = *(const GAS f32x4*)(Q.rk + c4);
}
template <bool WANT_BON> DI void prep_compute(const PrepRaw& R, const PrepPar& P, bool hp, PrepOut& O) {
    const u32x2 z2 = (u32x2){0u, 0u};
    const f32x4 r = lerp_u(R.zr, hp ? R.pr : z2, P.mur), k = lerp_u(R.zk, hp ? R.pk : z2, P.muk);
    O.v = lerp_u(R.zv, hp ? R.pv : z2, P.muv); O.r = r;
    const f32x4 w0v = P.w0, a0v = P.a0, kkv = P.kk, kav = P.ka;
    f32x4 wr; wr.x = w0v.x + bflo(R.lw.x); wr.y = w0v.y + bfhi(R.lw.x); wr.z = w0v.z + bflo(R.lw.y); wr.w = w0v.w + bfhi(R.lw.y);
    f32x4 ar; ar.x = a0v.x + bflo(R.la.x); ar.y = a0v.y + bfhi(R.la.x); ar.z = a0v.z + bflo(R.la.y); ar.w = a0v.w + bfhi(R.la.y);
    f32x4 a, kk;
#pragma unroll
    for (int q = 0; q < 4; ++q) { const float wl = -softplusf_(-wr[q]) - 0.5f; O.ld[q] = -__expf(wl); O.dec[q] = __expf(O.ld[q]); a[q] = sigmoidf_(ar[q]); kk[q] = k[q] * kkv[q]; O.kp[q] = k[q] * (1.f + (a[q] - 1.f) * kav[q]); }
    const float n2 = sum16(kk.x * kk.x + kk.y * kk.y + kk.z * kk.z + kk.w * kk.w);
    const float inv = __builtin_amdgcn_rsqf(fmaxf(n2, 1e-24f));
#pragma unroll
    for (int q = 0; q < 4; ++q) { const float kn = kk[q] * inv; O.bb[q] = kn * a[q]; O.nk[q] = -kn; }
    if (WANT_BON) { const f32x4 rk = P.rk; O.bon = sum16(r.x * O.kp.x * rk.x + r.y * O.kp.y * rk.y + r.z * O.kp.z * rk.z + r.w * O.kp.w * rk.w); }
}
#define LO2(v) ((f32x2){(v).x, (v).y})
#define HI2(v) ((f32x2){(v).z, (v).w})
constexpr int WRS = 144;
constexpr int W_SLOT = 64 * WRS;
enum { SL_NT = 0, SL_RT, SL_BH, SL_KH, SL_BHT, SL_KHT, SL_VT, SL_MK, SL_NB, SL_NK, SL_W1T, SL_U0T };
constexpr int W_MB = 12 * W_SLOT, W_CL = W_MB + 16384, W_PL = W_CL + 16384;
DI bf16x8 wfrag(LAS unsigned char* L, int slot, int row, int ks, int q) { return *(const LAS bf16x8*)(L + slot * W_SLOT + row * WRS + ks * 64 + q * 16); }
DI void wput(LAS unsigned char* L, int slot, int row, int col, float v) { *(LAS bf16_t*)(L + slot * W_SLOT + row * WRS + col * 2) = (bf16_t)(cvt_pk_bf16(v, 0.f) & 0xffffu); }
DI void tr4x4_rows(f32x4& x) {
    const float f0 = x.x, f1 = x.y, f2 = x.z, f3 = x.w;
    const unsigned u0 = __builtin_bit_cast(unsigned, f0), u1 = __builtin_bit_cast(unsigned, f1), u2 = __builtin_bit_cast(unsigned, f2), u3 = __builtin_bit_cast(unsigned, f3);
    const auto s02 = __builtin_amdgcn_permlane32_swap(u0, u2, false, false); const auto s13 = __builtin_amdgcn_permlane32_swap(u1, u3, false, false);
    const auto t01 = __builtin_amdgcn_permlane16_swap(s02[0], s13[0], false, false); const auto t23 = __builtin_amdgcn_permlane16_swap(s02[1], s13[1], false, false);
    x[0] = __builtin_bit_cast(float, (unsigned)t01[0]); x[1] = __builtin_bit_cast(float, (unsigned)t01[1]); x[2] = __builtin_bit_cast(float, (unsigned)t23[0]); x[3] = __builtin_bit_cast(float, (unsigned)t23[1]);
}
DI void scan_w1(const Ctx& F, const RwPar& Q, const bf16_t* z) {
    unsigned char* const wsl = F.ws; LAS unsigned char* L = F.lds;
    const int wave = F.wave;
    const bf16_t* LW = (const bf16_t*)(wsl + WS_LW);
    LAS float* MB = (LAS float*)(L + W_MB); LAS float* CL = (LAS float*)(L + W_CL); LAS float* PL = (LAS float*)(L + W_PL);
    PrepPar PN;
    PrepRaw RN[2];
    if (F.bid < 96 * NCH) { const int bh = F.bid % 96, c = F.bid / 96, b = bh / 24, head = bh - b * 24, tokb = b * SEQ + c * CH, c4 = head * 64 + 4 * (F.lane & 15);
#pragma unroll
        for (int p = 0; p < 2; ++p) prep_load(RN[p], z, LW, tokb + p * 32 + wave * 4 + (F.lane >> 4), c4);
        par_load(PN, Q, c4); }
    for (int u = F.bid; u < 96 * NCH; u += F.G) {
        int lane = F.lane; asm volatile("" : "+v"(lane));
        const int tq = lane >> 4, li = lane & 15, fr = li, fq = tq;
        const int bh = u % 96, c = u / 96, b = bh / 24, head = bh - b * 24, tokb = b * SEQ + c * CH, c4 = head * 64 + 4 * li;
        LDS_BARRIER();
        PrepOut O[2];
#pragma unroll
        for (int p = 0; p < 2; ++p) {
            const int t = p * 32 + wave * 4 + tq; const PrepRaw R = RN[p];
            prep_compute<true>(R, PN, ((tokb + t) & (SEQ - 1)) != 0, O[p]);
            *(LAS f32x4*)(CL + t * 64 + 4 * li) = O[p].ld;
            u32x2 e; e.x = cvt_pk_bf16(O[p].bon * O[p].v.x, O[p].bon * O[p].v.y); e.y = cvt_pk_bf16(O[p].bon * O[p].v.z, O[p].bon * O[p].v.w);
            *(GAS u32x2*)((bf16_t*)(wsl + WS_E) + (size_t)(tokb + t) * CMIX + c4) = e;
        }
        LDS_BARRIER();
        if (wave == 0) {
            float xs[64];
#pragma unroll
            for (int t = 0; t < 64; ++t) xs[t] = CL[t * 64 + lane];
#pragma unroll
            for (int t = 1; t < 64; ++t) xs[t] += xs[t - 1];
#pragma unroll
            for (int t = 0; t < 64; ++t) CL[t * 64 + lane] = xs[t];
        }
        LDS_BARRIER();
#pragma unroll
        for (int p = 0; p < 2; ++p) {
            const int t = p * 32 + wave * 4 + tq;
            const f32x4 cl = *(const LAS f32x4*)(CL + t * 64 + 4 * li);
            f32x4 clm = (f32x4){0.f, 0.f, 0.f, 0.f}; if (t > 0) clm = *(const LAS f32x4*)(CL + (t - 1) * 64 + 4 * li);
            f32x4 nt, rt, bh4, kh4;
#pragma unroll
            for (int q = 0; q < 4; ++q) { const float P = __expf(cl[q]), Pm = __expf(clm[q]), iP = __expf(-cl[q]);
                nt[q] = O[p].nk[q] * Pm; rt[q] = O[p].r[q] * P; bh4[q] = O[p].bb[q] * iP; kh4[q] = O[p].kp[q] * iP;
                if (t == 63) PL[4 * li + q] = P; }
            u32x2 w;
            w.x = cvt_pk_bf16(nt.x, nt.y); w.y = cvt_pk_bf16(nt.z, nt.w); *(LAS u32x2*)(L + SL_NT * W_SLOT + t * WRS + 8 * li) = w;
            w.x = cvt_pk_bf16(rt.x, rt.y); w.y = cvt_pk_bf16(rt.z, rt.w); *(LAS u32x2*)(L + SL_RT * W_SLOT + t * WRS + 8 * li) = w;
            w.x = cvt_pk_bf16(bh4.x, bh4.y); w.y = cvt_pk_bf16(bh4.z, bh4.w); *(LAS u32x2*)(L + SL_BH * W_SLOT + t * WRS + 8 * li) = w;
            w.x = cvt_pk_bf16(kh4.x, kh4.y); w.y = cvt_pk_bf16(kh4.z, kh4.w); *(LAS u32x2*)(L + SL_KH * W_SLOT + t * WRS + 8 * li) = w;
            { f32x4 vv = O[p].v; tr4x4_rows(bh4); tr4x4_rows(kh4); tr4x4_rows(vv);
              const int off = (4 * li + tq) * WRS + (p * 32 + wave * 4) * 2;
              w.x = cvt_pk_bf16(bh4.x, bh4.y); w.y = cvt_pk_bf16(bh4.z, bh4.w); *(LAS u32x2*)(L + SL_BHT * W_SLOT + off) = w;
              w.x = cvt_pk_bf16(kh4.x, kh4.y); w.y = cvt_pk_bf16(kh4.z, kh4.w); *(LAS u32x2*)(L + SL_KHT * W_SLOT + off) = w;
              w.x = cvt_pk_bf16(vv.x, vv.y); w.y = cvt_pk_bf16(vv.z, vv.w); *(LAS u32x2*)(L + SL_VT * W_SLOT + off) = w; }
        }
        LDS_BARRIER();
        asm volatile("" ::: "memory");
        { const int un = u + F.G; if (un < 96 * NCH) { const int bhn = un % 96, cn = un / 96, bn = bhn / 24, headn = bhn - bn * 24, tokbn = bn * SEQ + cn * CH, c4n = headn * 64 + 4 * li;
#pragma unroll
            for (int p = 0; p < 2; ++p) prep_load(RN[p], z, LW, tokbn + p * 32 + wave * 4 + tq, c4n);
            par_load(PN, Q, c4n); } }
        for (int reps = 0; reps < REP_WS; ++reps) {
            const int mt = wave >> 1, slotA = (mt < 2) ? SL_NT : SL_RT, slotB = (mt & 1) ? SL_KH : SL_BH, slotO = (mt == 1) ? SL_MK : (mt == 2 ? SL_NB : SL_NK), tt0 = (wave & 1) * 2;
            bf16x8 Af[2][2], Bf[4][2];
#pragma unroll
            for (int a2 = 0; a2 < 2; ++a2)
#pragma unroll
                for (int ks = 0; ks < 2; ++ks) Af[a2][ks] = wfrag(L, slotA, 16 * (tt0 + a2) + fr, ks, fq);
#pragma unroll
            for (int ss = 0; ss < 4; ++ss)
#pragma unroll
                for (int ks = 0; ks < 2; ++ks) Bf[ss][ks] = wfrag(L, slotB, 16 * ss + fr, ks, fq);
            float zf = 0.f; asm volatile("" : "+v"(zf));
            const unsigned zu = __builtin_bit_cast(unsigned, zf);
            const int strict = (mt < 2) ? 1 : 0; LAS unsigned char* ob = L + slotO * W_SLOT;
#pragma unroll
            for (int a2 = 0; a2 < 2; ++a2)
#pragma unroll
                for (int ss = 0; ss < 4; ++ss) { const int t = 16 * (tt0 + a2) + fr, s0 = 16 * ss + 4 * fq;
                    if (ss <= tt0 + a2) {
                        f32x4 acc = __builtin_amdgcn_mfma_f32_16x16x32_bf16(Bf[ss][0], Af[a2][0], (f32x4){0.f, 0.f, 0.f, 0.f}, 0, 0, 0);
                        acc = __builtin_amdgcn_mfma_f32_16x16x32_bf16(Bf[ss][1], Af[a2][1], acc, 0, 0, 0);
                        f32x4 o;
#pragma unroll
                        for (int r = 0; r < 4; ++r) o[r] = (s0 + r + strict <= t) ? acc[r] : 0.f;
                        if (mt == 0) *(LAS f32x4*)(MB + t * 64 + s0) = o;
                        else { u32x2 w; w.x = cvt_pk_bf16(o[0], o[1]); w.y = cvt_pk_bf16(o[2], o[3]); *(LAS u32x2*)(ob + t * WRS + s0 * 2) = w; }
                    } else {
                        if (mt == 0) *(LAS f32x4*)(MB + t * 64 + s0) = (f32x4){zf, zf, zf, zf};
                        else *(LAS u32x2*)(ob + t * WRS + s0 * 2) = (u32x2){zu, zu};
                    }
                }
        }
        LDS_BARRIER();
        { const int t = F.tid >> 3, s0 = (F.tid & 7) * 8; const f32x4 a0 = *(const LAS f32x4*)(MB + t * 64 + s0), a1 = *(const LAS f32x4*)(MB + t * 64 + s0 + 4);
          u32x4 w; w.x = cvt_pk_bf16(a0.x, a0.y); w.y = cvt_pk_bf16(a0.z, a0.w); w.z = cvt_pk_bf16(a1.x, a1.y); w.w = cvt_pk_bf16(a1.z, a1.w);
          *(LAS u32x4*)(L + SL_BH * W_SLOT + t * WRS + s0 * 2) = w; }
#pragma unroll
        for (int k2 = 0; k2 < 2; ++k2) {
            const int tile = wave * 2 + k2, tt = tile >> 2, it = tile & 3;
            f32x4 acc = (f32x4){0.f, 0.f, 0.f, 0.f};
#pragma unroll
            for (int ks = 0; ks < 2; ++ks) acc = __builtin_amdgcn_mfma_f32_16x16x32_bf16(wfrag(L, SL_MK, 16 * tt + fr, ks, fq), wfrag(L, SL_VT, 16 * it + fr, ks, fq), acc, 0, 0, 0);
#pragma unroll
            for (int r = 0; r < 4; ++r) CL[(16 * tt + 4 * fq + r) * 64 + 16 * it + fr] = acc[r];
        }
        if (wave >= 4) {
            const int I = wave - 4;
            float d[16], xb[16];
#pragma unroll
            for (int r = 0; r < 16; ++r) d[r] = (r == lane) ? 1.f : 0.f;
            const LAS float* mbv = MB; asm volatile("" : "+v"(mbv));
            const LAS float* mb = mbv + (16 * I) * 64 + 16 * I;
            f32x4 A[8][2], Bm[8][2];
#pragma unroll
            for (int tt = 0; tt < 8; ++tt) { A[tt][0] = *(const LAS f32x4*)(mb + tt * 64); A[tt][1] = *(const LAS f32x4*)(mb + tt * 64 + 4); }
#pragma unroll
            for (int tt = 0; tt < 8; ++tt) { Bm[tt][0] = *(const LAS f32x4*)(mb + (8 + tt) * 64); Bm[tt][1] = *(const LAS f32x4*)(mb + (8 + tt) * 64 + 4); }
#pragma unroll
            for (int sx = 0; sx < 8; ++sx) { xb[sx] = d[sx];
#pragma unroll
                for (int tt = sx + 1; tt < 8; ++tt) d[tt] = fma_s(A[tt][sx >> 2][sx & 3], xb[sx], d[tt]); }
#pragma unroll
            for (int sx = 0; sx < 8; ++sx)
#pragma unroll
                for (int tt = 0; tt < 8; ++tt) d[8 + tt] = fma_s(Bm[tt][sx >> 2][sx & 3], xb[sx], d[8 + tt]);
            asm volatile("" : "+v"(d[8]), "+v"(d[15]) :: "memory");
#pragma unroll
            for (int tt = 0; tt < 8; ++tt) { A[tt][0] = *(const LAS f32x4*)(mb + (8 + tt) * 64 + 8); A[tt][1] = *(const LAS f32x4*)(mb + (8 + tt) * 64 + 12); }
#pragma unroll
            for (int sx = 0; sx < 8; ++sx) { xb[8 + sx] = d[8 + sx];
#pragma unroll
                for (int tt = sx + 1; tt < 8; ++tt) d[8 + tt] = fma_s(A[tt][sx >> 2][sx & 3], xb[8 + sx], d[8 + tt]); }
            if (lane < 16) {
#pragma unroll
                for (int t = 0; t < 16; ++t) *(LAS bf16_t*)(L + SL_KH * W_SLOT + (16 * I + t) * 48 + lane * 2) = (bf16_t)(cvt_pk_bf16(xb[t], 0.f) & 0xffffu);
            }
        }
        LDS_BARRIER();
        asm volatile("" ::: "memory");
        for (int repx = 0; repx < REP_WX; ++repx) {
            const int sys = wave >> 2, ct = wave & 3, slotX = sys == 0 ? SL_W1T : SL_U0T;
            LAS unsigned char* TI = L + SL_KH * W_SLOT;
            f32x4 rhs[4];
            if (sys == 0) {
#pragma unroll
                for (int I = 0; I < 4; ++I)
#pragma unroll
                    for (int r = 0; r < 4; ++r) rhs[I][r] = bf2f(*(const LAS bf16_t*)(L + SL_NT * W_SLOT + (16 * I + 4 * fq + r) * WRS + (16 * ct + fr) * 2));
            } else {
#pragma unroll
                for (int I = 0; I < 4; ++I)
#pragma unroll
                    for (int r = 0; r < 4; ++r) rhs[I][r] = CL[(16 * I + 4 * fq + r) * 64 + 16 * ct + fr];
            }
            u32x2 ta[4], ma[6];
#pragma unroll
            for (int I = 0; I < 4; ++I) ta[I] = *(const LAS u32x2*)(TI + (16 * I + fr) * 48 + 8 * fq);
#pragma unroll
            for (int I = 1; I < 4; ++I)
#pragma unroll
                for (int Ip = 0; Ip < I; ++Ip) ma[I * (I - 1) / 2 + Ip] = *(const LAS u32x2*)(L + SL_BH * W_SLOT + (16 * I + fr) * WRS + (16 * Ip + 4 * fq) * 2);
            u32x2 xk[4];
#pragma unroll
            for (int I = 0; I < 4; ++I) {
                f32x4 acc = rhs[I];
#pragma unroll
                for (int Ip = 0; Ip < I; ++Ip) { const u32x2 m = ma[I * (I - 1) / 2 + Ip];
                    acc = __builtin_amdgcn_mfma_f32_16x16x32_bf16(__builtin_bit_cast(bf16x8, (u32x4){m.x, m.y, 0u, 0u}), __builtin_bit_cast(bf16x8, (u32x4){xk[Ip].x, xk[Ip].y, 0u, 0u}), acc, 0, 0, 0); }
                const unsigned d0 = cvt_pk_bf16(acc[0], acc[1]), d1 = cvt_pk_bf16(acc[2], acc[3]);
                const f32x4 x = __builtin_amdgcn_mfma_f32_16x16x32_bf16(__builtin_bit_cast(bf16x8, (u32x4){ta[I].x, ta[I].y, 0u, 0u}), __builtin_bit_cast(bf16x8, (u32x4){d0, d1, 0u, 0u}), (f32x4){0.f, 0.f, 0.f, 0.f}, 0, 0, 0);
                xk[I].x = cvt_pk_bf16(x[0], x[1]); xk[I].y = cvt_pk_bf16(x[2], x[3]);
                *(LAS u32x2*)(L + slotX * W_SLOT + (16 * ct + fr) * WRS + (16 * I + 4 * fq) * 2) = xk[I];
            }
        }
        LDS_BARRIER();
        for (int repo = 0; repo < REP_WO; ++repo) {
            const int kind = wave >> 1, ta0 = (wave & 1) * 2;
            float* gp = gh_ptr(wsl, bh, c, 0); float* hp = gh_ptr(wsl, bh, c, 1);
            bf16_t* qy = (bf16_t*)(wsl + WS_QY) + (size_t)u * 4096; float* y0t = (float*)(wsl + WS_Y0T) + (size_t)u * 4096;
            const int sA1 = kind == 0 ? SL_W1T : kind == 1 ? SL_BHT : kind == 2 ? SL_W1T : SL_NK, sB1 = kind == 0 ? SL_BHT : kind == 1 ? SL_U0T : kind == 2 ? SL_NB : SL_VT;
            const int sA2 = kind == 1 ? SL_KHT : SL_NB, sB2 = kind == 1 ? SL_VT : SL_U0T; const bool two = (kind & 1) != 0;
            bf16x8 Af[2][2], Bf[4][2];
#pragma unroll
            for (int a2 = 0; a2 < 2; ++a2)
#pragma unroll
                for (int ks = 0; ks < 2; ++ks) Af[a2][ks] = wfrag(L, sA1, 16 * (ta0 + a2) + fr, ks, fq);
#pragma unroll
            for (int tb = 0; tb < 4; ++tb)
#pragma unroll
                for (int ks = 0; ks < 2; ++ks) Bf[tb][ks] = wfrag(L, sB1, 16 * tb + fr, ks, fq);
            f32x4 acc[2][4];
#pragma unroll
            for (int a2 = 0; a2 < 2; ++a2)
#pragma unroll
                for (int tb = 0; tb < 4; ++tb) { acc[a2][tb] = (f32x4){0.f, 0.f, 0.f, 0.f};
#pragma unroll
                    for (int ks = 0; ks < 2; ++ks) acc[a2][tb] = __builtin_amdgcn_mfma_f32_16x16x32_bf16(Af[a2][ks], Bf[tb][ks], acc[a2][tb], 0, 0, 0); }
            if (two) {
#pragma unroll
                for (int a2 = 0; a2 < 2; ++a2)
#pragma unroll
                    for (int ks = 0; ks < 2; ++ks) Af[a2][ks] = wfrag(L, sA2, 16 * (ta0 + a2) + fr, ks, fq);
#pragma unroll
                for (int tb = 0; tb < 4; ++tb)
#pragma unroll
                    for (int ks = 0; ks < 2; ++ks) Bf[tb][ks] = wfrag(L, sB2, 16 * tb + fr, ks, fq);
#pragma unroll
                for (int a2 = 0; a2 < 2; ++a2)
#pragma unroll
                    for (int tb = 0; tb < 4; ++tb)
#pragma unroll
                        for (int ks = 0; ks < 2; ++ks) acc[a2][tb] = __builtin_amdgcn_mfma_f32_16x16x32_bf16(Af[a2][ks], Bf[tb][ks], acc[a2][tb], 0, 0, 0);
            }
#pragma unroll
            for (int a2 = 0; a2 < 2; ++a2)
#pragma unroll
                for (int tb = 0; tb < 4; ++tb) { const int ta = ta0 + a2; const f32x4 av = acc[a2][tb];
                    if (kind == 0) {
                        const int j = 16 * tb + fr; const float pl = PL[j];
                        f32x4 o;
#pragma unroll
                        for (int r = 0; r < 4; ++r) o[r] = pl * (av[r] + ((16 * ta + 4 * fq + r) == j ? 1.f : 0.f));
                        u32x2 w; w.x = cvt_pk_bf16(o[0], o[1]); w.y = cvt_pk_bf16(o[2], o[3]);
                        *(GAS u32x2*)((bf16_t*)gp + j * 64 + 16 * ta + 4 * fq) = w;
                    } else if (kind == 1) {
                        const f32x4 pl = *(const LAS f32x4*)(PL + 16 * ta + 4 * fq);
                        *(GAS f32x4*)(hp + (16 * tb + fr) * 64 + 16 * ta + 4 * fq) = pl * av;
                    } else if (kind == 2) {
                        const int t = 16 * tb + fr; const u32x2 rr = *(const LAS u32x2*)(L + SL_RT * W_SLOT + t * WRS + (16 * ta + 4 * fq) * 2);
                        u32x2 w; w.x = cvt_pk_bf16(av[0] + bflo(rr.x), av[1] + bfhi(rr.x)); w.y = cvt_pk_bf16(av[2] + bflo(rr.y), av[3] + bfhi(rr.y));
                        *(GAS u32x2*)(qy + t * 64 + 16 * ta + 4 * fq) = w;
                    } else {
                        *(GAS f32x4*)(y0t + (16 * tb + fr) * 64 + 16 * ta + 4 * fq) = av;
                    }
                }
        }
    }
    LDS_BARRIER();
}
DI void scan_w2(const Ctx& F, const RwPar& Q) {
    unsigned char* const wsl = F.ws; const int lane = F.lane, fr = lane & 15, fq = lane >> 4;
    LAS float* yb = (LAS float*)(F.lds + F.wave * 16384);
    const bf16_t* gate = (const bf16_t*)(wsl + WS_GATE); const bf16_t* Eb = (const bf16_t*)(wsl + WS_E); bf16_t* cat = (bf16_t*)(wsl + WS_CAT);
    for (int u = F.gw; u < 96 * NCH; u += F.ngw) {
        const int bh = u % 96, c = u / 96, b = bh / 24, head = bh - b * 24, tokb = b * SEQ + c * CH;
        const bf16_t* qy = (const bf16_t*)(wsl + WS_QY) + (size_t)u * 4096; const float* y0t = (const float*)(wsl + WS_Y0T) + (size_t)u * 4096;
        f32x4 acc[4][4];
#pragma unroll
        for (int tt = 0; tt < 4; ++tt)
#pragma unroll
            for (int it = 0; it < 4; ++it) acc[tt][it] = *(const GAS f32x4*)(y0t + (16 * it + fr) * 64 + 16 * tt + 4 * fq);
        if (c > 0) {
            const bf16_t* sp = (const bf16_t*)gh_ptr(wsl, bh, c - 1, 0) + 4096;
            bf16x8 Bf[4][2];
#pragma unroll
            for (int it = 0; it < 4; ++it)
#pragma unroll
                for (int ks = 0; ks < 2; ++ks) Bf[it][ks] = *(const GAS bf16x8*)(sp + (16 * it + fr) * 64 + 32 * ks + 8 * fq);
#pragma unroll
            for (int tt = 0; tt < 4; ++tt)
#pragma unroll
                for (int ks = 0; ks < 2; ++ks) { const bf16x8 Af = *(const GAS bf16x8*)(qy + (16 * tt + fr) * 64 + 32 * ks + 8 * fq);
#pragma unroll
                    for (int it = 0; it < 4; ++it) acc[tt][it] = __builtin_amdgcn_mfma_f32_16x16x32_bf16(Af, Bf[it][ks], acc[tt][it], 0, 0, 0); }
        }
#pragma unroll
        for (int tt = 0; tt < 4; ++tt)
#pragma unroll
            for (int it = 0; it < 4; ++it)
#pragma unroll
                for (int r = 0; r < 4; ++r) yb[(16 * tt + 4 * fq + r) * 64 + 16 * it + fr] = acc[tt][it][r];
        const int c4 = head * 64 + 4 * (lane & 15);
        const f32x4 g4 = *(const GAS f32x4*)(Q.gng + c4), b4 = *(const GAS f32x4*)(Q.gnb + c4);
        u32x2 evs[16], gts[16];
#pragma unroll
        for (int k = 0; k < 16; ++k) { const int tok = tokb + 4 * k + (lane >> 4); evs[k] = *(const GAS u32x2*)(Eb + (size_t)tok * CMIX + c4); gts[k] = *(const GAS u32x2*)(gate + (size_t)tok * CMIX + c4); }
        LDS_WAIT();
#pragma unroll
        for (int k = 0; k < 16; ++k) {
            const int slot = k * 64 + lane, t = slot >> 4, li = slot & 15, tok = tokb + t;
            const f32x4 y = *(const LAS f32x4*)(yb + t * 64 + 4 * li);
            const u32x2 ev = evs[k], gt = gts[k];
            const float mean = sum16(y.x + y.y + y.z + y.w) * (1.f / 64.f);
            const f32x4 d = y - mean;
            const float var = sum16(d.x * d.x + d.y * d.y + d.z * d.z + d.w * d.w) * (1.f / 64.f);
            const float rstd = rsqrtf(var + GN_EPS);
            f32x4 o = d * rstd * g4 + b4; o.x += bflo(ev.x); o.y += bfhi(ev.x); o.z += bflo(ev.y); o.w += bfhi(ev.y);
            u32x2 w; w.x = cvt_pk_bf16(o.x * bflo(gt.x), o.y * bfhi(gt.x)); w.y = cvt_pk_bf16(o.z * bflo(gt.y), o.w * bfhi(gt.y));
            *(GAS u32x2*)(cat + (size_t)tok * DM + c4) = w;
        }
        LDS_WAIT();
    }
}
DI void scan_passB(const Ctx& F) {
    unsigned char* const wsl = F.ws; const int lane = F.lane, fr = lane & 15, fq = lane >> 4, ih = F.wave >> 2, q = F.wave & 3, bh = F.bid;
    LAS unsigned char* Sx0 = F.lds;
    bf16x8 ga[7][2]; f32x4 hq[7][2];
#define PB_LOAD(set, cc) do { const GAS bf16_t* _gp = (const GAS bf16_t*)gh_ptr(wsl, bh, (cc), 0) + (16 * q + fr) * 64 + 8 * fq; const GAS float* _hp = (const GAS float*)(gh_ptr(wsl, bh, (cc), 1) + (32 * ih + fr) * 64 + 16 * q + 4 * fq); \
        ga[set][0] = *(const GAS bf16x8*)_gp; ga[set][1] = *(const GAS bf16x8*)(_gp + 32); \
        _Pragma("unroll") for (int _r = 0; _r < 2; ++_r) hq[set][_r] = *(const GAS f32x4*)(_hp + (16 * _r) * 64); } while (0)
    PB_LOAD(0, 0); PB_LOAD(1, 1); PB_LOAD(2, 2); PB_LOAD(3, 3); PB_LOAD(4, 4); PB_LOAD(5, 5);
    for (int c7 = 0; c7 < NCH - 1; c7 += 7) {
#pragma unroll
        for (int u7 = 0; u7 < 7; ++u7) {
            const int c = c7 + u7;
            f32x4 acc[2];
#pragma unroll
            for (int it = 0; it < 2; ++it) acc[it] = hq[u7][it];
            const bf16x8 a0 = ga[u7][0], a1 = ga[u7][1];
            PB_LOAD((u7 + 6) % 7, (c + 6 < NCH - 1) ? c + 6 : NCH - 2);
            if (c > 0) {
#pragma unroll
                for (int it = 0; it < 2; ++it) {
                    acc[it] = __builtin_amdgcn_mfma_f32_16x16x32_bf16(a0, *(const LAS bf16x8*)(Sx0 + (c & 1) * W_SLOT + (32 * ih + 16 * it + fr) * WRS + fq * 16), acc[it], 0, 0, 0);
                    acc[it] = __builtin_amdgcn_mfma_f32_16x16x32_bf16(a1, *(const LAS bf16x8*)(Sx0 + (c & 1) * W_SLOT + (32 * ih + 16 * it + fr) * WRS + 64 + fq * 16), acc[it], 0, 0, 0); }
            }
            GAS bf16_t* op = (GAS bf16_t*)gh_ptr(wsl, bh, c, 0) + 4096 + (32 * ih + fr) * 64 + 16 * q + 4 * fq;
#pragma unroll
            for (int it = 0; it < 2; ++it) { u32x2 w; w.x = cvt_pk_bf16(acc[it].x, acc[it].y); w.y = cvt_pk_bf16(acc[it].z, acc[it].w);
                *(GAS u32x2*)(op + (16 * it) * 64) = w; *(LAS u32x2*)(Sx0 + ((c + 1) & 1) * W_SLOT + (32 * ih + 16 * it + fr) * WRS + (16 * q + 4 * fq) * 2) = w; }
            LDS_BARRIER();
        }
    }
#undef PB_LOAD
}

DI void ln1_router(const Ctx& F, const Params& P, int l, const float* xin) {
    unsigned char* const wsl = F.ws; float* const outl = F.out; (void)outl;
    const float* g = PIN(5) + (size_t)l * DM; const float* bta = PIN(6) + (size_t)l * DM;
    const float* gb = PIN(10) + l * 4; const float* eb = PIN(12) + l * 32;
    const bf16_t* hb = (const bf16_t*)(wsl + WS_HB); bf16_t* xb = (bf16_t*)(wsl + WS_XB); float* xo = outl;
    const bf16_t* wrt = (const bf16_t*)(wsl + WS_WSW + (size_t)l * WSW_STRIDE);
    unsigned* cnt = (unsigned*)(wsl + WS_CTL) + CW_CNT + l * 32 * 64;
    int* ltok = (int*)(wsl + WS_LTOK); float* lgate = (float*)(wsl + WS_LGATE); int* lslot = (int*)(wsl + WS_LSLOT);
    const int lane = F.lane, fr = lane & 15, fq = lane >> 4, wave = F.wave;
    LAS float* lg = (LAS float*)(F.lds + (wave & 3) * 4096);
    LAS float* lgp = (LAS float*)(F.lds + 16384 + (wave & 3) * 4096);
    LAS int* cntl = (LAS int*)(F.lds + 32768); LAS int* basel = cntl + 32;
    if (F.tid < NEXP) cntl[F.tid] = 0;
    __syncthreads();
    LAS float* gls = (LAS float*)(F.lds + 36864 + 52224); LAS float* bls = gls + DM;
    for (int blk = F.bid; blk < NTOK / 64; blk += F.G) {
        { const f32x4 gv = *(const GAS f32x4*)(g + 4 * F.tid), bv = *(const GAS f32x4*)(bta + 4 * F.tid); *(LAS f32x4*)(gls + 4 * F.tid) = gv; *(LAS f32x4*)(bls + 4 * F.tid) = bv; }
        __syncthreads();
#pragma unroll 1
        for (int pass = 0; pass < 4; ++pass) {
            int lno = lane; asm volatile("" : "+v"(lno));
            const int hr2 = lno >> 5, l32 = lno & 31;
            const size_t ro = (size_t)(blk * 64 + wave * 8 + pass * 2 + hr2) * DM + 8 * l32;
            u32x4 xr[8], hr[8];
#pragma unroll
            for (int i = 0; i < 8; ++i) { xr[i] = *(const GAS u32x4*)(xb + ro + 256 * i); hr[i] = *(const GAS u32x4*)(hb + ro + 256 * i); }
            float s = 0.f, s2 = 0.f;
#pragma unroll
            for (int i = 0; i < 8; ++i) {
#pragma unroll
                for (int e = 0; e < 4; ++e) { const float v0 = ALPHA * bflo(xr[i][e]) + bflo(hr[i][e]), v1 = ALPHA * bfhi(xr[i][e]) + bfhi(hr[i][e]); s += v0 + v1; s2 += v0 * v0 + v1 * v1; } }
            s = sum16(s); s2 = sum16(s2); s += __shfl_xor(s, 16); s2 += __shfl_xor(s2, 16);
            const float mean = s * (1.f / DM), rstd = rsqrtf(fmaxf(s2 * (1.f / DM) - mean * mean, 0.f) + LN_EPS);
#pragma unroll
            for (int i = 0; i < 8; ++i) { const int col = 256 * i + 8 * l32;
                const f32x4 g0 = *(const LAS f32x4*)(gls + col), g1 = *(const LAS f32x4*)(gls + col + 4), b0 = *(const LAS f32x4*)(bls + col), b1 = *(const LAS f32x4*)(bls + col + 4);
                u32x4 w;
#pragma unroll
                for (int e = 0; e < 4; ++e) { const float v0 = ALPHA * bflo(xr[i][e]) + bflo(hr[i][e]), v1 = ALPHA * bfhi(xr[i][e]) + bfhi(hr[i][e]);
                    const float gg0 = e < 2 ? g0[2 * e] : g1[2 * e - 4], gg1 = e < 2 ? g0[2 * e + 1] : g1[2 * e - 3], bb0 = e < 2 ? b0[2 * e] : b1[2 * e - 4], bb1 = e < 2 ? b0[2 * e + 1] : b1[2 * e - 3];
                    w[e] = cvt_pk_bf16((v0 - mean) * rstd * gg0 + bb0, (v1 - mean) * rstd * gg1 + bb1); }
                *(GAS u32x4*)(xb + ro + 256 * i) = w;
                asm volatile("" ::: "memory"); }
        }
        VM_WAIT();
        __syncthreads();
        __builtin_amdgcn_fence(__ATOMIC_ACQUIRE, "agent");
        VM_WAIT();
        const int row0 = blk * 64 + (wave & 3) * 16, kh = wave >> 2, krot = (F.bid * 5 + wave * 3) & 31;
        f32x4 acc[3];
#pragma unroll
        for (int ct = 0; ct < 3; ++ct) acc[ct] = (f32x4){0.f, 0.f, 0.f, 0.f};
        const bf16_t* arow = xb + (size_t)(row0 + fr) * DM + 8 * fq + kh * 1024;
        LAS unsigned char* wst = F.lds + 36864;
        u32x4 wreg[6];
        { const int st = F.bid & 7;
#pragma unroll
          for (int i = 0; i < 6; ++i) { const int ch = F.tid + NT * i, row = ch >> 4, c16 = ch & 15, rkh = row / 96, rr = row - rkh * 96;
              wreg[i] = *(const GAS u32x4*)(wrt + (size_t)rr * DM + rkh * 1024 + st * 128 + c16 * 8); } }
#pragma unroll 1
        for (int si = 0; si < 8; ++si) {
            const int st = (si + F.bid) & 7;
            LAS unsigned char* wb = wst + (si & 1) * 52224;
#pragma unroll
            for (int i = 0; i < 6; ++i) { const int ch = F.tid + NT * i, row = ch >> 4, c16 = ch & 15; *(LAS u32x4*)(wb + row * 272 + c16 * 16) = wreg[i]; }
            if (si + 1 < 8) { const int stn = (si + 1 + F.bid) & 7;
#pragma unroll
                for (int i = 0; i < 6; ++i) { const int ch = F.tid + NT * i, row = ch >> 4, c16 = ch & 15, rkh = row / 96, rr = row - rkh * 96;
                    wreg[i] = *(const GAS u32x4*)(wrt + (size_t)rr * DM + rkh * 1024 + stn * 128 + c16 * 8); } }
            bf16x8 af[4];
#pragma unroll
            for (int ksl = 0; ksl < 4; ++ksl) af[ksl] = *(const GAS bf16x8*)(arow + st * 128 + ksl * 32);
            LDS_BARRIER();
#pragma unroll
            for (int ksl = 0; ksl < 4; ++ksl)
#pragma unroll
                for (int ct = 0; ct < 3; ++ct) {
                    acc[ct] = __builtin_amdgcn_mfma_f32_16x16x32_bf16(af[ksl], *(const LAS bf16x8*)(wb + (kh * 96 + 16 * ct + fr) * 272 + ksl * 64 + fq * 16), acc[ct], 0, 0, 0);
                    acc[ct] = __builtin_amdgcn_mfma_f32_16x16x32_bf16(af[ksl], *(const LAS bf16x8*)(wb + (kh * 96 + 48 + 16 * ct + fr) * 272 + ksl * 64 + fq * 16), acc[ct], 0, 0, 0);
                }
        }
        if (kh == 1) {
#pragma unroll
            for (int ct = 0; ct < 3; ++ct)
#pragma unroll
                for (int jj = 0; jj < 4; ++jj) lgp[(4 * fq + jj) * 48 + 16 * ct + fr] = acc[ct][jj];
        }
        __syncthreads();
        if (kh == 0) {
#pragma unroll
            for (int ct = 0; ct < 3; ++ct)
#pragma unroll
                for (int jj = 0; jj < 4; ++jj) lg[(4 * fq + jj) * 48 + 16 * ct + fr] = acc[ct][jj] + lgp[(4 * fq + jj) * 48 + 16 * ct + fr];
        }
        LDS_WAIT();
        int se0 = 0, se1 = 0, sr0 = 0, sr1 = 0, stok = 0; float sg0 = 0.f, sg1 = 0.f;
        if (kh == 0 && lane < 16) {
            const LAS float* L = lg + lane * 48; const int tok = row0 + lane;
            float gl[4]; int grp_i = 0; float gmx;
#pragma unroll
            for (int q = 0; q < 4; ++q) gl[q] = L[q] + gb[q];
            gmx = gl[0];
#pragma unroll
            for (int q = 1; q < 4; ++q) if (gl[q] > gmx) { gmx = gl[q]; grp_i = q; }
            float gs = 0.f;
#pragma unroll
            for (int q = 0; q < 4; ++q) gs += __expf(gl[q] - gmx);
            const float pg = 1.f / gs;
            float el[8];
#pragma unroll
            for (int q = 0; q < 8; ++q) el[q] = L[4 + 8 * grp_i + q] + eb[8 * grp_i + q];
            int i0 = 0; float m0 = el[0];
#pragma unroll
            for (int q = 1; q < 8; ++q) if (el[q] > m0) { m0 = el[q]; i0 = q; }
            int i1 = -1; float m1 = -3.0e38f;
#pragma unroll
            for (int q = 0; q < 8; ++q) if (q != i0 && el[q] > m1) { m1 = el[q]; i1 = q; }
            if (i1 < 0) { i1 = (i0 == 0) ? 1 : 0; m1 = m0; }
            const float p1 = __expf(m1 - m0), den = 1.f / (1.f + p1);
            const float g0 = pg * den, g1 = pg * p1 * den;
            se0 = grp_i * 8 + i0; se1 = grp_i * 8 + i1; sg0 = g0; sg1 = g1; stok = tok;
            sr0 = __hip_atomic_fetch_add(cntl + se0, 1, __ATOMIC_RELAXED, __HIP_MEMORY_SCOPE_WORKGROUP);
            sr1 = __hip_atomic_fetch_add(cntl + se1, 1, __ATOMIC_RELAXED, __HIP_MEMORY_SCOPE_WORKGROUP);
        }
        __syncthreads();
        if (wave == 0 && lane < NEXP) { const int n = cntl[lane]; basel[lane] = n ? (int)__hip_atomic_fetch_add(cnt + lane * 64, (unsigned)n, __ATOMIC_RELAXED, __HIP_MEMORY_SCOPE_AGENT) : 0; }
        __syncthreads();
        if (kh == 0 && lane < 16) {
            const int pos0 = basel[se0] + sr0, pos1 = basel[se1] + sr1;
            ltok[se0 * LISTCAP + pos0] = stok; lgate[se0 * LISTCAP + pos0] = sg0; lslot[se0 * LISTCAP + pos0] = 2 * stok;
            ltok[se1 * LISTCAP + pos1] = stok; lgate[se1 * LISTCAP + pos1] = sg1; lslot[se1 * LISTCAP + pos1] = 2 * stok + 1;
        }
        __syncthreads();
        if (F.tid < NEXP) cntl[F.tid] = 0;
        __syncthreads();
    }
}

DI void ln2_phase(const Ctx& F, const Params& P, int l) {
    unsigned char* const wsl = F.ws; float* const outl = F.out;
    const float* g = PIN(7) + (size_t)l * DM; const float* bta = PIN(8) + (size_t)l * DM;
    const bf16_t* ys = (const bf16_t*)(wsl + WS_YS); bf16_t* xb = (bf16_t*)(wsl + WS_XB); float* xo = outl;
    LAS float* gls = (LAS float*)F.lds; LAS float* bls = gls + DM;
    { const f32x4 gv = *(const GAS f32x4*)(g + 4 * F.tid), bv = *(const GAS f32x4*)(bta + 4 * F.tid); *(LAS f32x4*)(gls + 4 * F.tid) = gv; *(LAS f32x4*)(bls + 4 * F.tid) = bv; }
    __syncthreads();
#pragma unroll 1
    for (int rp = F.gw; rp < NTOK / 2; rp += F.ngw) {
        int lno = F.lane; asm volatile("" : "+v"(lno));
        const int hr2 = lno >> 5, l32 = lno & 31, row = 2 * rp + hr2;
        const size_t ro = (size_t)row * DM + 8 * l32;
        u32x4 xr[8], y0[8], y1[8];
#pragma unroll
        for (int i = 0; i < 8; ++i) { xr[i] = *(const GAS u32x4*)(xb + ro + 256 * i); y0[i] = *(const GAS u32x4*)(ys + 2 * (size_t)row * DM + 8 * l32 + 256 * i); y1[i] = *(const GAS u32x4*)(ys + (2 * (size_t)row + 1) * DM + 8 * l32 + 256 * i); }
        float s = 0.f, s2 = 0.f;
#pragma unroll
        for (int i = 0; i < 8; ++i) {
#pragma unroll
            for (int e = 0; e < 4; ++e) { const float v0 = ALPHA * bflo(xr[i][e]) + (bflo(y0[i][e]) + bflo(y1[i][e])), v1 = ALPHA * bfhi(xr[i][e]) + (bfhi(y0[i][e]) + bfhi(y1[i][e])); s += v0 + v1; s2 += v0 * v0 + v1 * v1; } }
        s = sum16(s); s2 = sum16(s2); s += __shfl_xor(s, 16); s2 += __shfl_xor(s2, 16);
        const float mean = s * (1.f / DM), rstd = rsqrtf(fmaxf(s2 * (1.f / DM) - mean * mean, 0.f) + LN_EPS);
#pragma unroll
        for (int i = 0; i < 8; ++i) { const int col = 256 * i + 8 * l32;
            const f32x4 g0 = *(const LAS f32x4*)(gls + col), g1 = *(const LAS f32x4*)(gls + col + 4), b0 = *(const LAS f32x4*)(bls + col), b1 = *(const LAS f32x4*)(bls + col + 4);
            float o[8];
#pragma unroll
            for (int e = 0; e < 4; ++e) { const float v0 = ALPHA * bflo(xr[i][e]) + (bflo(y0[i][e]) + bflo(y1[i][e])), v1 = ALPHA * bfhi(xr[i][e]) + (bfhi(y0[i][e]) + bfhi(y1[i][e]));
                const float gg0 = e < 2 ? g0[2 * e] : g1[2 * e - 4], gg1 = e < 2 ? g0[2 * e + 1] : g1[2 * e - 3], bb0 = e < 2 ? b0[2 * e] : b1[2 * e - 4], bb1 = e < 2 ? b0[2 * e + 1] : b1[2 * e - 3];
                o[2 * e] = (v0 - mean) * rstd * gg0 + bb0; o[2 * e + 1] = (v1 - mean) * rstd * gg1 + bb1; }
            if (l == NLAYER - 1) { *(GAS f32x4*)(xo + (size_t)row * DM + col) = (f32x4){o[0], o[1], o[2], o[3]}; *(GAS f32x4*)(xo + (size_t)row * DM + col + 4) = (f32x4){o[4], o[5], o[6], o[7]}; }
            else { u32x4 w; w.x = cvt_pk_bf16(o[0], o[1]); w.y = cvt_pk_bf16(o[2], o[3]); w.z = cvt_pk_bf16(o[4], o[5]); w.w = cvt_pk_bf16(o[6], o[7]); *(GAS u32x4*)(xb + ro + 256 * i) = w; }
            asm volatile("" ::: "memory"); }
    }
}

DI int moe_table(const Ctx& F, int l) {
    unsigned char* const wsl = F.ws; float* const outl = F.out; (void)outl;
    LAS int* tb = (LAS int*)(F.lds + LDS_CTL_OFF) + 16;
    const unsigned* cnt = (const unsigned*)(wsl + WS_CTL) + CW_CNT + l * 32 * 64;
    __syncthreads();
    if (F.tid == 0) { int acc = 0;
        for (int e = 0; e < NEXP; ++e) { tb[e] = acc; const int n = (int)__hip_atomic_load(cnt + e * 64, __ATOMIC_RELAXED, __HIP_MEMORY_SCOPE_AGENT); acc += (n + 255) >> 8; }
        tb[NEXP] = acc; }
    __syncthreads();
    return tb[NEXP];
}


#ifdef MK_DEBUG
constexpr int CW_DBG = 40960;
DI void dbg_count_bf16(const Ctx& F, const bf16_t* p, size_t n, int k) {
    unsigned bad = 0; const size_t gt = (size_t)F.bid * NT + F.tid, ngt = (size_t)F.G * NT;
    for (size_t i = gt; i < n; i += ngt) { const unsigned b = p[i]; const float v = bf2f(b); if ((b & 0x7f80u) == 0x7f80u || fabsf(v) > 1.0e6f) ++bad; }
    if (bad) atomicAdd((unsigned*)(F.ws + WS_CTL) + CW_DBG + k * 64, bad);
}
DI void dbg_count_f32(const Ctx& F, const float* p, size_t n, int k) {
    unsigned bad = 0; const size_t gt = (size_t)F.bid * NT + F.tid, ngt = (size_t)F.G * NT;
    for (size_t i = gt; i < n; i += ngt) { const float v = p[i]; if (!(fabsf(v) <= 1.0e6f)) ++bad; }
    if (bad) atomicAdd((unsigned*)(F.ws + WS_CTL) + CW_DBG + k * 64, bad);
}
#endif
constexpr int PH_PER_LAYER = 11, N_PHASES = 1 + NLAYER * PH_PER_LAYER;

__global__ void __launch_bounds__(NT, 2) mega_fwd(Params P) {
    extern __shared__ __attribute__((aligned(16))) unsigned char lds_raw[];
    Ctx F0;
    F0.lds = (LAS unsigned char*)lds_raw;
    F0.tid = threadIdx.x; F0.lane = F0.tid & 63; F0.wave = __builtin_amdgcn_readfirstlane(F0.tid >> 6);
    F0.G = gridDim.x; F0.bid = blockIdx.x; F0.gw = F0.bid * NWAVES + F0.wave; F0.ngw = F0.G * NWAVES;
    F0.ws = P.ws; F0.out = P.out;
    for (int u = F0.tid; u < (LDS_BYTES - LDS_CTL_OFF) / 4; u += NT) ((LAS unsigned*)(F0.lds + LDS_CTL_OFF))[u] = 0u;
    __syncthreads();
    XcdBarrier bar; bar.bar = (unsigned*)(F0.ws + WS_CTL) + CW_BAR; bar.x = 0; bar.st = nullptr;
#if !MK_PER_PHASE
    bar = xcd_barrier_post((unsigned*)(F0.ws + WS_CTL) + CW_BAR, (volatile LAS unsigned*)(F0.lds + LDS_CTL_OFF));
#endif
    const int lo = P.ph_lo, hi = P.ph_hi;
#define IN(k) (lo <= (k) && (k) < hi)
#if MK_PER_PHASE
#define SEAM(k) do { } while (0)
#else
#define SEAM(k) do { if ((k) + 1 < hi) { XcdBarrier _b = bar; asm volatile("" : "+s"(_b.bar), "+s"(_b.x)); xcd_barrier(_b); } } while (0)
#endif
#define WSL const Ctx F = relaunder(F0); unsigned char* const ws = F.ws; bf16_t* const xb = (bf16_t*)(ws + WS_XB); bf16_t* const zb = (bf16_t*)(ws + WS_Z); bf16_t* const cat = (bf16_t*)(ws + WS_CAT); (void)xb; (void)zb; (void)cat

    if (IN(0)) { WSL; phase_prologue(F, P); SEAM(0); }

    for (int l = 0; l < NLAYER; ++l) {
        const int kind = l % 3, j = l / 3, pb = 1 + l * PH_PER_LAYER;
        const int zw = (kind == 0) ? ZW_RWKV : ZW_OTH, qcol = (kind == 0) ? 5056 : 4608;
        if (IN(pb + 0)) {
            WSL; const bf16_t* winT = (const bf16_t*)(ws + WS_WIN + (size_t)l * WIN_STRIDE);
            if (kind != 2) dense_gemm(F, xb, DM, winT, DM, NTOK, zw, DM, zb, zw, 0);
            else {
                dense_gemm(F, xb, DM, winT, DM, NTOK, 3072, DM, zb, zw, 0);
                dense_gemm(F, xb, DM, winT + (size_t)4608 * DM, DM, NTOK, 512, DM, zb + 4608, zw, 0);
                dense_gemm(F, winT + (size_t)3072 * DM, DM, xb, DM, CMIX, NTOK, DM, (bf16_t*)(ws + WS_ACT), NTOK, 128);
            }
            if (l == 0) {
                dense_gemm(F, (const bf16_t*)(ws + WS_MEMB), DM, (const bf16_t*)(ws + WS_WK), DM, NBATCH * MEML, 2048, DM, (bf16_t*)(ws + WS_KM), 2048, 128);
                dense_gemm(F, (const bf16_t*)(ws + WS_WV), DM, (const bf16_t*)(ws + WS_MEMB), DM, 2048, NBATCH * MEML, DM, (bf16_t*)(ws + WS_VMT), 1024, 192);
            }
            SEAM(pb + 0);
        }
        if (IN(pb + 1)) {
            WSL;
            if (kind == 0) { for (int rep = 0; rep < REP_PREP; ++rep) rwkv_prep1(F, P, j, zb); for (int rep = 0; rep < REP_MIX * REP_MA; ++rep) memattn_all(F, l, zb, zw, qcol); }
            else if (kind == 1) { for (int rep = 0; rep < REP_MIX; ++rep) conv_mix(F, P, zb); for (int rep = 0; rep < REP_MIX * REP_MA; ++rep) memattn_all(F, l, zb, zw, qcol); for (int rep = 0; rep < REP_CONV; ++rep) expert_convert(F, P, l, F.gw, F.ngw); }
            else { for (int rep = 0; rep < REP_MIX * REP_SB; ++rep) sb_attention(F, zb); for (int rep = 0; rep < REP_MIX * REP_MA; ++rep) memattn_all(F, l, zb, zw, qcol); for (int rep = 0; rep < REP_CONV; ++rep) expert_convert(F, P, l, F.gw, F.ngw); }
            SEAM(pb + 1);
        }
        if (kind == 0) {
            if (IN(pb + 2)) {
                WSL; const bf16_t* act = (const bf16_t*)(ws + WS_ACT); const bf16_t* wa = (const bf16_t*)(ws + WS_LORA + (size_t)j * LORA_STRIDE);
                dense_gemm(F, act, 512, wa, 256, NTOK, 3072, 256, (bf16_t*)(ws + WS_LW), 3072, 0);
                dense_gemm(F, act + 256, 512, wa + (size_t)3072 * 256, 256, NTOK, CMIX, 256, (bf16_t*)(ws + WS_GATE), CMIX, 0);
                SEAM(pb + 2);
            }
            if (IN(pb + 3)) { WSL; const RwPar Q{PIN(17) + (size_t)j * 5056, PIN(18) + j * CMIX, PIN(20) + j * CMIX, PIN(23) + j * CMIX, PIN(24) + j * CMIX, PIN(25) + j * CMIX, PIN(26) + j * CMIX, PIN(27) + j * CMIX};
                for (int rep = 0; rep < REP_SCAN; ++rep) scan_w1(F, Q, zb); SEAM(pb + 3); }
            if (IN(pb + 4)) {
                WSL;
                if (F.bid < 96) scan_passB(F);
                else expert_convert(F, P, l, (F.bid - 96) * NWAVES + F.wave, (F.G - 96) * NWAVES);
                SEAM(pb + 4);
            }
            if (IN(pb + 5)) { WSL; const RwPar Q{PIN(17) + (size_t)j * 5056, PIN(18) + j * CMIX, PIN(20) + j * CMIX, PIN(23) + j * CMIX, PIN(24) + j * CMIX, PIN(25) + j * CMIX, PIN(26) + j * CMIX, PIN(27) + j * CMIX};
                for (int rep = 0; rep < REP_SCAN * REP_W2; ++rep) scan_w2(F, Q); SEAM(pb + 5); }
        }
        if (IN(pb + 6)) { WSL; dense_gemm(F, cat, DM, (const bf16_t*)(ws + WS_WOUT) + (size_t)l * DM * DM, DM, NTOK, DM, DM, (bf16_t*)(ws + WS_HB), DM, 0); SEAM(pb + 6); }
        if (IN(pb + 7)) { WSL; ln1_router(F, P, l, l == 0 ? PIN(0) : (const float*)P.out); SEAM(pb + 7); }
        if (IN(pb + 8)) {
            WSL; const int ntiles = moe_table(F, l);
            pg8::Gemm g{xb, (const bf16_t*)(ws + WS_EXP1), DM, DM, DM};
            pg8::MoeOrder<true> S; S.G = F.G; S.c = F.bid; S.npn = 4; S.total = ntiles * 4; S.tb = (const LAS int*)(F.lds + LDS_CTL_OFF) + 16; S.estride = (size_t)1024 * DM * 2;
            S.ltok = (const int*)(ws + WS_LTOK); S.cnt = (const unsigned*)(ws + WS_CTL) + CW_CNT + l * 32 * 64;
            pg8::EpiSwiGLU E{(bf16_t*)(ws + WS_HE)};
            for (int rep = 0; rep < REP_MOE; ++rep) pg8::gemm_phase<pg8::EpiSwiGLU, pg8::MoeOrder<true>>(F.lds, g, S, E);
            SEAM(pb + 8);
        }
        if (IN(pb + 9)) {
            WSL; const int ntiles = moe_table(F, l);
            pg8::Gemm g{(const bf16_t*)(ws + WS_HE), (const bf16_t*)(ws + WS_EXP2), DEXP, DEXP, DEXP};
            pg8::MoeOrder<false> S; S.G = F.G; S.c = F.bid; S.npn = 8; S.total = ntiles * 8; S.tb = (const LAS int*)(F.lds + LDS_CTL_OFF) + 16; S.estride = (size_t)DM * DEXP * 2;
            S.ltok = (const int*)(ws + WS_LTOK); S.cnt = (const unsigned*)(ws + WS_CTL) + CW_CNT + l * 32 * 64;
            pg8::EpiScatter E{(bf16_t*)(ws + WS_YS), (const int*)(ws + WS_LSLOT), (const float*)(ws + WS_LGATE), S.cnt};
            for (int rep = 0; rep < REP_MOE; ++rep) pg8::gemm_phase<pg8::EpiScatter, pg8::MoeOrder<false>>(F.lds, g, S, E);
            SEAM(pb + 9);
        }
        if (IN(pb + 10)) { WSL; ln2_phase(F, P, l); SEAM(pb + 10); }
    }
#ifdef MK_DEBUG
    {
        WSL;
        xcd_barrier(bar);
        dbg_count_bf16(F, (const bf16_t*)(ws + WS_CAT), (size_t)NTOK * DM, 0);
        dbg_count_bf16(F, (const bf16_t*)(ws + WS_HB), (size_t)NTOK * DM, 1);
        dbg_count_f32(F, (const float*)(ws + WS_LGATE), (size_t)32 * 16384, 2);
        dbg_count_bf16(F, (const bf16_t*)(ws + WS_YS), (size_t)32768 * 2048, 3);
        dbg_count_f32(F, (const float*)F.out, (size_t)NTOK * DM, 4);
        dbg_count_bf16(F, (const bf16_t*)(ws + WS_XB), (size_t)NTOK * DM, 5);
        xcd_barrier(bar);
        int first = 13;
        for (int k = 12; k >= 0; --k) if (__hip_atomic_load((unsigned*)(ws + WS_CTL) + CW_DBG + k * 64, __ATOMIC_RELAXED, __HIP_MEMORY_SCOPE_AGENT) != 0u) first = k;
        const float val = 1000.f * (float)(first + 1);
        for (size_t i = (size_t)F.bid * NT + F.tid; i < (size_t)NTOK * DM; i += (size_t)F.G * NT) F.out[i] = val;
    }
#endif
#undef IN
#undef SEAM
}

extern "C" void kernel_launch(void* const* d_in, const int* in_sizes, int n_in, void* d_out, int out_size, void* d_ws, size_t ws_size, hipStream_t stream) {
    static int grid = 0;
    if (grid == 0) {
        if (n_in != 31 || ws_size < WS_END) { fprintf(stderr, "kernel_launch: expected 31 inputs and >= %zu bytes of workspace, got %d / %zu\n", (size_t)WS_END, n_in, ws_size); grid = -1; return; }
        int dev = 0, cus = 0, per_cu = 0;
        if (hipGetDevice(&dev) != hipSuccess || hipDeviceGetAttribute(&cus, hipDeviceAttributeMultiprocessorCount, dev) != hipSuccess) { grid = -1; return; }
        if (hipFuncSetAttribute((const void*)mega_fwd, hipFuncAttributeMaxDynamicSharedMemorySize, LDS_BYTES) != hipSuccess) { fprintf(stderr, "kernel_launch: hipFuncSetAttribute failed\n"); grid = -1; return; }
        if (hipOccupancyMaxActiveBlocksPerMultiprocessor(&per_cu, (const void*)mega_fwd, NT, LDS_BYTES) != hipSuccess || per_cu < 1)
            fprintf(stderr, "kernel_launch: occupancy query reports %d workgroups per CU\n", per_cu);
        (void)hipGetLastError();
        grid = cus;
    }
    if (grid < 0) return;
    (void)hipMemsetAsync((char*)d_ws + WS_CTL, 0, CTL_BYTES, stream);
    Params p{};
    for (int i = 0; i < 31; ++i) p.in[i] = (const float*)d_in[i];
    p.out = (float*)d_out; p.ws = (unsigned char*)d_ws;
#if MK_PER_PHASE
    for (int ph = 0; ph < N_PHASES; ++ph) {
        if (ph > 0) { const int l = (ph - 1) / PH_PER_LAYER, loc = (ph - 1) % PH_PER_LAYER; if ((l % 3) != 0 && loc >= 2 && loc <= 5) continue; }
        p.ph_lo = ph; p.ph_hi = ph + 1;
        hipLaunchKernelGGL(mega_fwd, dim3(grid), dim3(NT), LDS_BYTES, stream, p);
    }
#else
#ifndef MK_PH_HI
#define MK_PH_HI N_PHASES
#endif
    p.ph_lo = 0; p.ph_hi = MK_PH_HI;
    hipLaunchKernelGGL(mega_fwd, dim3(grid), dim3(NT), LDS_BYTES, stream, p);
#endif
    const hipError_t le = hipPeekAtLastError();
    if (le != hipSuccess) fprintf(stderr, "kernel_launch: launch failed: %s\n", hipGetErrorName(le));
}
```

```cpp
#include <hip/hip_runtime.h>
#include <cstdio>
#include <cstdint>

#ifndef MK_PER_PHASE
#define MK_PER_PHASE 0
#endif
#ifndef MK_PH_HI
#define MK_PH_HI N_PHASES
#endif
#ifndef REP_GEMM
#define REP_GEMM 1
#endif
#ifndef REP_MOE
#define REP_MOE 1
#endif
#ifndef REP_SCAN
#define REP_SCAN 1
#endif
#ifndef REP_PREP
#define REP_PREP 1
#endif
#ifndef REP_MIX
#define REP_MIX 1
#endif
#ifndef REP_CONV
#define REP_CONV 1
#endif
#ifndef REP_SB
#define REP_SB 1
#endif
#ifndef REP_MA
#define REP_MA 1
#endif
#ifndef REP_WX
#define REP_WX 1
#endif
#ifndef REP_WS
#define REP_WS 1
#endif
#ifndef REP_WO
#define REP_WO 1
#endif
#ifndef REP_W2
#define REP_W2 1
#endif

#define LAS __attribute__((address_space(3)))
#define GAS __attribute__((address_space(1)))
#define DI __device__ __forceinline__
typedef unsigned short bf16_t;
typedef short bf16x8 __attribute__((ext_vector_type(8)));
typedef short s16x4 __attribute__((ext_vector_type(4)));
typedef float f32x2 __attribute__((ext_vector_type(2)));
typedef float f32x4 __attribute__((ext_vector_type(4)));
typedef float f32x8 __attribute__((ext_vector_type(8)));
typedef float f32x16 __attribute__((ext_vector_type(16)));
typedef unsigned u32x2 __attribute__((ext_vector_type(2)));
typedef unsigned u32x4 __attribute__((ext_vector_type(4)));

constexpr int NTOK = 16384, DM = 2048, SEQ = 4096, NBATCH = 4, CMIX = 1536, MEMW = 512, MEML = 256, NLAYER = 4;
constexpr int ZW_RWKV = 5632  , ZW_OTH = 5120, RW_IN_COLS = 5568;
constexpr int NEXP = 32, DEXP = 512, LISTCAP = 16384, MAXTILES = 160;
constexpr float LN_EPS = 1e-5f, ALPHA = 1.681792830507429f, GN_EPS = 64e-5f;
constexpr int NT = 512, NWAVES = 8;

constexpr size_t MiB = (size_t)1 << 20;
constexpr size_t WS_CTL = 0, CTL_BYTES = 1 * MiB;
constexpr size_t WS_WIN = 2 * MiB;
constexpr size_t WIN_STRIDE = 22 * MiB;
constexpr size_t WS_WOUT = 90 * MiB;
constexpr size_t WS_WK = 122 * MiB;
constexpr size_t WS_WV = 130 * MiB;
constexpr size_t WS_MEMB = 138 * MiB;
constexpr size_t WS_KM = 142 * MiB;
constexpr size_t WS_VMT = 146 * MiB;
constexpr size_t WS_LORA = 150 * MiB;
constexpr size_t LORA_STRIDE = 3 * MiB;
constexpr size_t WS_WSW = 156 * MiB;
constexpr size_t WSW_STRIDE = 393216;
constexpr size_t WS_EXP1 = 160 * MiB;
constexpr size_t WS_EXP2 = 288 * MiB;
constexpr size_t WS_XB = 352 * MiB;
constexpr size_t WS_Z = 416 * MiB;
constexpr size_t WS_CAT = 592 * MiB;
constexpr size_t WS_HB = 656 * MiB;
constexpr size_t WS_LTOK = 720 * MiB;
constexpr size_t WS_LGATE = 722 * MiB;
constexpr size_t WS_LSLOT = 724 * MiB;
constexpr size_t WS_HE = 728 * MiB;
constexpr size_t WS_YS = 768 * MiB;
constexpr size_t WS_ACT = 896 * MiB;
constexpr size_t WS_LW = 944 * MiB;
constexpr size_t WS_GATE = 1040 * MiB;
constexpr size_t WS_SCAN = 1088 * MiB;
constexpr size_t WS_V = 1568 * MiB;
constexpr size_t WS_Y = 1664 * MiB;
constexpr size_t WS_GH = 1760 * MiB;
constexpr size_t WS_QY = 1088 * MiB;
constexpr size_t WS_Y0T = 1152 * MiB;
constexpr size_t WS_E = 1280 * MiB;
constexpr size_t WS_END = 1952 * MiB;
constexpr int CW_BAR = 4096;
constexpr int CW_CNT = 16384;

constexpr int LDS_BYTES = 147456;
constexpr int LDS_CTL_OFF = 146432;

DI float bf2f(unsigned b) { return __uint_as_float(b << 16); }
typedef float cvt_f32x2 __attribute__((ext_vector_type(2)));
typedef __bf16 cvt_bf16x2 __attribute__((ext_vector_type(2)));
DI unsigned cvt_pk_bf16(float lo, float hi) { const cvt_f32x2 v = {lo, hi}; return __builtin_bit_cast(unsigned, __builtin_convertvector(v, cvt_bf16x2)); }
DI float bflo(unsigned w) { return __uint_as_float(w << 16); }
DI float bfhi(unsigned w) { return __uint_as_float(w & 0xffff0000u); }
DI float wave_sum(float v) {
#pragma unroll
    for (int o = 1; o < 64; o <<= 1) v += __shfl_xor(v, o);
    return v;
}
DI float sum16(float v) {
    v += __builtin_bit_cast(float, __builtin_amdgcn_update_dpp(0, __builtin_bit_cast(int, v), 0x128, 0xf, 0xf, false));
    v += __builtin_bit_cast(float, __builtin_amdgcn_update_dpp(0, __builtin_bit_cast(int, v), 0x124, 0xf, 0xf, false));
    v += __builtin_bit_cast(float, __builtin_amdgcn_update_dpp(0, __builtin_bit_cast(int, v), 0x122, 0xf, 0xf, false));
    v += __builtin_bit_cast(float, __builtin_amdgcn_update_dpp(0, __builtin_bit_cast(int, v), 0x121, 0xf, 0xf, false));
    return v;
}
DI float fma_s(float a, float b, float c) { float d; asm("v_fma_f32 %0, %1, %2, %3" : "=v"(d) : "v"(a), "v"(b), "v"(c)); return d; }
DI float sigmoidf_(float x) { return __builtin_amdgcn_rcpf(1.f + __expf(-x)); }
DI float softplusf_(float x) { return fmaxf(x, 0.f) + __logf(1.f + __expf(-fabsf(x))); }
#define LDS_WAIT() asm volatile("s_waitcnt lgkmcnt(0)" ::: "memory")
#define VM_WAIT() asm volatile("s_waitcnt vmcnt(0)" ::: "memory")
#define LDS_BARRIER() do { asm volatile("s_waitcnt lgkmcnt(0)" ::: "memory"); __builtin_amdgcn_s_barrier(); asm volatile("" ::: "memory"); } while (0)

template <class T> DI T* as_global(T* p) { return p; }
DI const float* kin_ptr(int i) { int off = i * 8; asm volatile("" : "+v"(off)); const char* ka = (const char*)__builtin_amdgcn_kernarg_segment_ptr();
    const unsigned long long p = *(const unsigned long long*)(ka + off);
    const unsigned lo = __builtin_amdgcn_readfirstlane((unsigned)p), hi = __builtin_amdgcn_readfirstlane((unsigned)(p >> 32));
    return as_global((const float*)(((unsigned long long)hi << 32) | lo)); }
#define PIN(i) kin_ptr(i)
DI unsigned char* opq(unsigned char* p) { asm volatile("" : "+s"(p)); return p; }
DI float* opqf(float* p) { asm volatile("" : "+s"(p)); return p; }

#define XB_TMO      128
#define XB_XCNT(j)  (256  + 64 * (j))
#define XB_XSUB(j)  (1280 + 64 * (j))
#define XB_XGEN(j)  (2304 + 64 * (j))
#define XB_TOP      3328
#define XB_TOPGEN   3392
#define XCD_BAR_WORDS 3456
#define XB_SPIN_CAP (1u << 20)

__device__ __forceinline__ unsigned xb_ld(unsigned* p)              { return __hip_atomic_load(p, __ATOMIC_RELAXED, __HIP_MEMORY_SCOPE_AGENT); }
__device__ __forceinline__ unsigned xb_add(unsigned* p, unsigned v) { return __hip_atomic_fetch_add(p, v, __ATOMIC_RELAXED, __HIP_MEMORY_SCOPE_AGENT); }
__device__ __forceinline__ unsigned xb_xcc_id() { return (unsigned)__builtin_amdgcn_s_getreg((3 << 11) | 20) & 0xFu; }
#define XB_SPIN(cond, bar) do { unsigned _sp = 0; while (cond) { __builtin_amdgcn_s_sleep(1); \
    if ((++_sp & 255u) == 0u) { if (xb_ld(&(bar)[XB_TMO])) break; if (_sp > XB_SPIN_CAP) { atomicAdd(&(bar)[XB_TMO], 1u); break; } } } } while (0)

struct XcdBarrier { unsigned* bar; unsigned x; volatile LAS unsigned* st; };

__device__ __forceinline__ XcdBarrier xcd_barrier_post(unsigned* bar, volatile LAS unsigned* st) {
    XcdBarrier b; b.bar = bar; b.x = xb_xcc_id(); b.st = st;
    if (threadIdx.x == 0) (void)xb_add(&bar[XB_XCNT(b.x)], 1u);
    return b;
}
__device__ __forceinline__ void xcd_barrier_complete(unsigned* bar, unsigned x, unsigned& nloc, unsigned& nx) {
    const unsigned G = gridDim.x * gridDim.y * gridDim.z;
    unsigned sum, cnt, mine, sp = 0u;
    for (;;) {
        sum = 0u; cnt = 0u; mine = 0u;
#pragma unroll
        for (unsigned j = 0; j < 16; ++j) { const unsigned c = xb_ld(&bar[XB_XCNT(j)]); sum += c; cnt += (c > 0u) ? 1u : 0u; mine = (j == x) ? c : mine; }
        if (sum == G) break;
        __builtin_amdgcn_s_sleep(1);
        if ((++sp & 255u) == 0u) { if (xb_ld(&bar[XB_TMO])) break; if (sp > XB_SPIN_CAP) { atomicAdd(&bar[XB_TMO], 1u); break; } }
    }
    nloc = mine > 0u ? mine : 1u; nx = cnt > 0u ? cnt : 1u;
}
__device__ __forceinline__ void xcd_barrier(const XcdBarrier& b) {
    asm volatile("s_waitcnt vmcnt(0)" ::: "memory");
    __syncthreads();
    if (threadIdx.x == 0) {
        unsigned* bar = b.bar;
        __builtin_amdgcn_s_waitcnt(0);
        unsigned nloc = b.st[0], nx = b.st[1];
        if (nloc == 0u) { xcd_barrier_complete(bar, b.x, nloc, nx); b.st[0] = nloc; b.st[1] = nx; }
        const unsigned old = xb_add(&bar[XB_XSUB(b.x)], 1u);
        const unsigned gen = old / nloc;
        if (old + 1u == (gen + 1u) * nloc) {
            __builtin_amdgcn_fence(__ATOMIC_RELEASE, "agent");
            asm volatile("s_waitcnt vmcnt(0)" ::: "memory");
            const unsigned og = xb_add(&bar[XB_TOP], 1u);
            const unsigned tg = og / nx;
            if (og + 1u == (tg + 1u) * nx) xb_add(&bar[XB_TOPGEN], 1u);
            else XB_SPIN(xb_ld(&bar[XB_TOPGEN]) == tg, bar);
            __builtin_amdgcn_fence(__ATOMIC_ACQUIRE, "agent");
            xb_add(&bar[XB_XGEN(b.x)], 1u);
            asm volatile("s_waitcnt vmcnt(0)" ::: "memory");
        } else {
            XB_SPIN(xb_ld(&bar[XB_XGEN(b.x)]) == gen, bar);
            __builtin_amdgcn_fence(__ATOMIC_ACQUIRE, "agent");
            asm volatile("s_waitcnt vmcnt(0)" ::: "memory");
        }
    }
    __syncthreads();
}

namespace pg8 {
constexpr int BM = 256, BK = 64, HALF = 128, HTB = HALF * BK * 2, STAGE_BYTES = 8 * HTB, NXCD = 8, WGM = 8;
DI int lds_byte(int r, int c) { const int st = (r >> 4) * 2 + (c >> 5), rr = r & 15, cc = c & 31, ob = rr * 64 + cc * 2; return st * 1024 + (ob ^ (((ob >> 9) & 1) << 5)); }
DI void stage_rc(int b, int& R, int& C) { const int st = b / 1024, sb = b % 1024, swz = sb ^ (((sb >> 9) & 1) << 5); R = (st >> 1) * 16 + swz / 64; C = (st & 1) * 32 + (swz % 64) / 2; }
DI int perm32(int rho) { const int n = rho >> 4, i = rho & 15; return 8 * (i >> 2) + 4 * n + (i & 3); }

struct Unit { int pm, pn, e, rt; };
struct Gemm { const bf16_t* A; const bf16_t* Bt; int lda, ldb, K; };

struct StaticOrder {
    static constexpr bool GATHER = false;
    int nM, nN, nwg, G, c;
    DI void init(int M, int N, int G_, int c_) { nM = M / BM; nN = N / BM; nwg = nM * nN; G = G_; c = c_; }
    DI bool next(int i, Unit& u) const {
        const long L = (long)i * G + c; if (L >= nwg) return false;
        int wgid = (int)L; { const int q = nwg / NXCD, r = nwg % NXCD, xcd = wgid % NXCD, off = wgid / NXCD; wgid = (xcd < r ? xcd * (q + 1) : r * (q + 1) + (xcd - r) * q) + off; }
        const int nig = WGM * nN, gid = wgid / nig, fm = gid * WGM, gsz = (nM - fm) < WGM ? (nM - fm) : WGM;
        u.pm = fm + ((wgid % nig) % gsz); u.pn = (wgid % nig) / gsz; u.e = 0; u.rt = 0; return true;
    }
    DI const char* a_base(const Gemm& g, const Unit& u) const { return (const char*)g.A + (size_t)u.pm * BM * g.lda * 2; }
    DI const char* b_base(const Gemm& g, const Unit& u) const { return (const char*)g.Bt + (size_t)u.pn * BM * g.ldb * 2; }
    DI unsigned gather_voff(const Unit&, int, int, int) const { return 0u; }
};

template <bool GATH> struct MoeOrder {
    static constexpr bool GATHER = GATH;
    int G, c, npn, total; const LAS int* tb; size_t estride; const int* ltok; const unsigned* cnt;
    DI bool next(int i, Unit& u) const {
        if ((G & 7) == 0) {
            const int x = c & 7, r = c >> 3, W = G >> 3, idx = i * W + r;
            const int q = idx / npn, pn = idx - q * npn; int base = 0;
#pragma unroll
            for (int k = 0; k < 4; ++k) { const int e = x + 8 * k, nt = tb[e + 1] - tb[e];
                if (q < base + nt) { u.e = e; u.rt = q - base; u.pm = tb[e] + u.rt; u.pn = pn; return true; }
                base += nt; }
            return false;
        }
        const int L = i * G + c; if (L >= total) return false;
        const int q = L / npn; u.pn = L - q * npn; u.pm = q;
        int e = 0; while (e < NEXP - 1 && tb[e + 1] <= q) ++e;
        u.e = e; u.rt = q - tb[e]; return true;
    }
    DI const char* a_base(const Gemm& g, const Unit& u) const { return (const char*)g.A + (size_t)u.pm * BM * g.lda * 2; }
    DI const char* b_base(const Gemm& g, const Unit& u) const { return (const char*)g.Bt + (size_t)u.e * estride + (size_t)u.pn * BM * g.ldb * 2; }
    DI unsigned gather_voff(const Unit& u, int r, int C, int lda) const {
        const int pos = u.rt * BM + r; const int n = (int)__hip_atomic_load(cnt + u.e * 64, __ATOMIC_RELAXED, __HIP_MEMORY_SCOPE_AGENT);
        const int tok = pos < n ? ltok[u.e * LISTCAP + pos] : 0;
        return (unsigned)(tok * lda + C) * 2u;
    }
};

struct EpiStore {
    bf16_t* O; int ldc;
    DI void operator()(const f32x4 (&acc)[2][2][4][2], const Unit& u, int wr, int wc, int fr, int fq) const {
        const int row0 = u.pm * BM + wr * 64 + fr, col0 = u.pn * BM + wc * 32 + 8 * fq;
#pragma unroll
        for (int ai = 0; ai < 2; ++ai)
#pragma unroll
            for (int m = 0; m < 4; ++m) { bf16_t* rowp = O + (size_t)(row0 + ai * HALF + m * 16) * ldc + col0;
#pragma unroll
                for (int bj = 0; bj < 2; ++bj) { const f32x4 v0 = acc[ai][bj][m][0], v1 = acc[ai][bj][m][1];
                    u32x4 w; w.x = cvt_pk_bf16(v0[0], v0[1]); w.y = cvt_pk_bf16(v0[2], v0[3]); w.z = cvt_pk_bf16(v1[0], v1[1]); w.w = cvt_pk_bf16(v1[2], v1[3]);
                    *(GAS u32x4*)(rowp + bj * HALF) = w; } }
    }
};
struct EpiSwiGLU {
    bf16_t* H;
    DI void operator()(const f32x4 (&acc)[2][2][4][2], const Unit& u, int wr, int wc, int fr, int fq) const {
        const int row0 = u.pm * BM + wr * 64 + fr, col0 = u.pn * HALF + wc * 32 + 8 * fq;
#pragma unroll
        for (int ai = 0; ai < 2; ++ai)
#pragma unroll
            for (int m = 0; m < 4; ++m) { bf16_t* rowp = H + (size_t)(row0 + ai * HALF + m * 16) * DEXP + col0;
                float h[8];
#pragma unroll
                for (int n = 0; n < 2; ++n)
#pragma unroll
                    for (int j = 0; j < 4; ++j) { const float gt = acc[ai][0][m][n][j], up = acc[ai][1][m][n][j]; h[n * 4 + j] = gt * __builtin_amdgcn_rcpf(1.f + __expf(-gt)) * up; }
                u32x4 w; w.x = cvt_pk_bf16(h[0], h[1]); w.y = cvt_pk_bf16(h[2], h[3]); w.z = cvt_pk_bf16(h[4], h[5]); w.w = cvt_pk_bf16(h[6], h[7]);
                *(GAS u32x4*)rowp = w; }
    }
};
struct EpiScatter {
    bf16_t* YS; const int* lslot; const float* lgate; const unsigned* cnt;
    DI void operator()(const f32x4 (&acc)[2][2][4][2], const Unit& u, int wr, int wc, int fr, int fq) const {
        const int n = (int)__hip_atomic_load(cnt + u.e * 64, __ATOMIC_RELAXED, __HIP_MEMORY_SCOPE_AGENT);
        const int col0 = u.pn * BM + wc * 32 + 8 * fq;
#pragma unroll
        for (int ai = 0; ai < 2; ++ai)
#pragma unroll
            for (int m = 0; m < 4; ++m) { const int pos = u.rt * BM + ai * HALF + wr * 64 + m * 16 + fr;
                if (pos < n) { const int slot = lslot[u.e * LISTCAP + pos]; const float gt = lgate[u.e * LISTCAP + pos];
                    bf16_t* rowp = YS + (size_t)slot * DM + col0;
#pragma unroll
                    for (int bj = 0; bj < 2; ++bj) { const f32x4 v0 = acc[ai][bj][m][0] * gt, v1 = acc[ai][bj][m][1] * gt;
                        u32x4 w; w.x = cvt_pk_bf16(v0[0], v0[1]); w.y = cvt_pk_bf16(v0[2], v0[3]); w.z = cvt_pk_bf16(v1[0], v1[1]); w.w = cvt_pk_bf16(v1[2], v1[3]);
                        *(GAS u32x4*)(rowp + bj * HALF) = w; } } }
    }
};

template <class Epi, class Sched>
DI void gemm_phase(LAS unsigned char* lds, const Gemm g, const Sched& S, const Epi& E) {
    int tid = threadIdx.x; asm volatile("" : "+v"(tid));
    const int wid = __builtin_amdgcn_readfirstlane(tid >> 6), lane = tid & 63, wr = wid >> 2, wc = wid & 3, fr = lane & 15, fq = lane >> 4;
    const int K = g.K, nt = K / BK;
    unsigned voffA[2], voffB[2];
#pragma unroll
    for (int i = 0; i < 2; ++i) { int R, C; stage_rc(tid * 16 + i * 8192, R, C); const int Rb = (R & ~31) + perm32(R & 31);
        voffA[i] = (unsigned)(R * g.lda + C) * 2u; voffB[i] = (unsigned)(Rb * g.ldb + C) * 2u; }
    const size_t kstep = (size_t)(BK * 2);
    const size_t hstepA = (size_t)HALF * g.lda * 2, hstepB = (size_t)HALF * g.ldb * 2;
    const unsigned ldsw = (unsigned)wid * 1024u;
    const int aoff = lds_byte(wr * 64 + fr, fq * 8), boff = lds_byte(wc * 32 + fr, fq * 8);
    unsigned gvC[2][2], gvN[2][2];
#define PG8_SA(b, h) (((b) * 2 + (h)) * HTB)
#define PG8_SB(b, h) ((4 + (b) * 2 + (h)) * HTB)
#define PG8_STAGE(bufoff, gbase, voff) do { _Pragma("unroll") for (int _i = 0; _i < 2; ++_i) \
        __builtin_amdgcn_global_load_lds((const unsigned*)((const char*)(gbase) + (voff)[_i]), (LAS unsigned*)(lds + (bufoff) + ldsw + _i * 8192), 16, 0, 0); } while (0)
#define PG8_STAGE_A(bufoff, h, nxtsel, kt) do { \
        if constexpr (Sched::GATHER) { const char* _gb = (const char*)g.A + (size_t)(kt) * kstep; unsigned _vo[2]; _vo[0] = (nxtsel) ? gvN[h][0] : gvC[h][0]; _vo[1] = (nxtsel) ? gvN[h][1] : gvC[h][1]; PG8_STAGE(bufoff, _gb, _vo); } \
        else { const char* _gb = ((nxtsel) ? nA : cA) + (size_t)(h) * hstepA + (size_t)(kt) * kstep; PG8_STAGE(bufoff, _gb, voffA); } } while (0)
#define PG8_GSETUP(dst, u) do { if constexpr (Sched::GATHER) { _Pragma("unroll") for (int _h = 0; _h < 2; ++_h) _Pragma("unroll") for (int _i = 0; _i < 2; ++_i) { int _R, _C; stage_rc(tid * 16 + _i * 8192, _R, _C); \
        dst[_h][_i] = S.gather_voff(u, _h * HALF + _R, _C, g.lda); } asm volatile("s_waitcnt vmcnt(0)" : "+v"(dst[0][0]), "+v"(dst[0][1]), "+v"(dst[1][0]), "+v"(dst[1][1]) :: "memory"); } } while (0)
#define PG8_LDA(dst, b, h) do { _Pragma("unroll") for (int m = 0; m < 4; ++m) _Pragma("unroll") for (int k = 0; k < 2; ++k) dst[m][k] = *(const LAS bf16x8*)(lds + PG8_SA(b, h) + aoff + m * 2048 + k * 1024); } while (0)
#define PG8_LDB(dst, b, h) do { _Pragma("unroll") for (int n = 0; n < 2; ++n) _Pragma("unroll") for (int k = 0; k < 2; ++k) dst[n][k] = *(const LAS bf16x8*)(lds + PG8_SB(b, h) + boff + n * 2048 + k * 1024); } while (0)
#define PG8_MMA(ai, bj, At, Bt) do { __builtin_amdgcn_s_setprio(1); _Pragma("unroll") for (int m = 0; m < 4; ++m) _Pragma("unroll") for (int n = 0; n < 2; ++n) _Pragma("unroll") for (int k = 0; k < 2; ++k) \
        acc[ai][bj][m][n] = __builtin_amdgcn_mfma_f32_16x16x32_bf16(Bt[n][k], At[m][k], acc[ai][bj][m][n], 0, 0, 0); __builtin_amdgcn_s_setprio(0); } while (0)
#define PG8_WAIT_V(n) asm volatile("s_waitcnt vmcnt(" #n ")" ::: "memory")
#define PG8_WAIT_L(n) asm volatile("s_waitcnt lgkmcnt(" #n ")" ::: "memory")
#define PG8_BAR __builtin_amdgcn_s_barrier()
#define PG8_SCHED __builtin_amdgcn_sched_barrier(0)
    Unit cur, nxt; int ui = 0;
    if (!S.next(0, cur)) return;
    f32x4 acc[2][2][4][2];
#pragma unroll
    for (int a = 0; a < 2; ++a)
#pragma unroll
        for (int b = 0; b < 2; ++b)
#pragma unroll
            for (int m = 0; m < 4; ++m)
#pragma unroll
                for (int n = 0; n < 2; ++n) acc[a][b][m][n] = (f32x4){0.f, 0.f, 0.f, 0.f};
    bf16x8 At[4][2], B0[2][2], B1[2][2];
    const char* cA = S.a_base(g, cur); const char* cB = S.b_base(g, cur);
    const char* nA = cA;
    PG8_GSETUP(gvC, cur);
    PG8_STAGE(PG8_SB(0, 0), cB, voffB); PG8_STAGE_A(PG8_SA(0, 0), 0, false, 0); PG8_STAGE(PG8_SB(0, 1), cB + hstepB, voffB); PG8_STAGE_A(PG8_SA(0, 1), 1, false, 0);
    if (wr == 1) PG8_BAR;
    PG8_WAIT_V(4); PG8_BAR;
    PG8_STAGE(PG8_SB(1, 0), cB + kstep, voffB); PG8_STAGE_A(PG8_SA(1, 0), 0, false, 1); PG8_STAGE(PG8_SB(1, 1), cB + hstepB + kstep, voffB);
    PG8_WAIT_V(6); PG8_BAR;
    for (;;) {
        const bool has_next = S.next(ui + 1, nxt);
        nA = has_next ? S.a_base(g, nxt) : cA; const char* nB = has_next ? S.b_base(g, nxt) : cB;
        if constexpr (Sched::GATHER) { if (has_next) { PG8_GSETUP(gvN, nxt); } else {
#pragma unroll
            for (int _h = 0; _h < 2; ++_h) { gvN[_h][0] = gvC[_h][0]; gvN[_h][1] = gvC[_h][1]; } } }
        for (int t = 0; t < nt; t += 2) {
            const bool last = (t == nt - 2);
            const int kt2 = last ? 0 : t + 2;
            const char* b2 = last ? nB : cB + (size_t)(t + 2) * kstep;
            const char* b3 = b2 + kstep;
            PG8_LDB(B0, 0, 0); PG8_SCHED; PG8_LDA(At, 0, 0); PG8_STAGE_A(PG8_SA(1, 1), 1, false, t + 1);
            PG8_WAIT_L(8); PG8_BAR; PG8_WAIT_L(0); PG8_MMA(0, 0, At, B0); PG8_BAR; PG8_SCHED;
            PG8_LDB(B1, 0, 1); PG8_STAGE(PG8_SB(0, 0), b2, voffB);
            PG8_BAR; PG8_WAIT_L(0); PG8_MMA(0, 1, At, B1); PG8_BAR;
            PG8_LDA(At, 0, 1); PG8_STAGE_A(PG8_SA(0, 0), 0, last, kt2);
            PG8_BAR; PG8_WAIT_L(0); PG8_MMA(1, 0, At, B0); PG8_BAR; PG8_SCHED;
            PG8_STAGE(PG8_SB(0, 1), b2 + hstepB, voffB);
            PG8_WAIT_V(6); PG8_BAR; PG8_MMA(1, 1, At, B1); PG8_BAR;
            PG8_LDB(B0, 1, 0); PG8_SCHED; PG8_LDA(At, 1, 0); PG8_STAGE_A(PG8_SA(0, 1), 1, last, kt2);
            PG8_WAIT_L(8); PG8_BAR; PG8_WAIT_L(0); PG8_MMA(0, 0, At, B0); PG8_BAR; PG8_SCHED;
            PG8_LDB(B1, 1, 1); PG8_STAGE(PG8_SB(1, 0), b3, voffB);
            PG8_BAR; PG8_WAIT_L(0); PG8_MMA(0, 1, At, B1); PG8_BAR;
            PG8_LDA(At, 1, 1); PG8_STAGE_A(PG8_SA(1, 0), 0, last, kt2 + 1);
            PG8_BAR; PG8_WAIT_L(0); PG8_MMA(1, 0, At, B0); PG8_BAR; PG8_SCHED;
            PG8_STAGE(PG8_SB(1, 1), b3 + hstepB, voffB);
            PG8_WAIT_V(6); PG8_BAR; PG8_MMA(1, 1, At, B1); PG8_BAR;
        }
        E(acc, cur, wr, wc, fr, fq);
        if (!has_next) break;
#pragma unroll
        for (int a = 0; a < 2; ++a)
#pragma unroll
            for (int b = 0; b < 2; ++b)
#pragma unroll
                for (int m = 0; m < 4; ++m)
#pragma unroll
                    for (int n = 0; n < 2; ++n) acc[a][b][m][n] = (f32x4){0.f, 0.f, 0.f, 0.f};
        cur = nxt; cA = nA; cB = nB; ++ui;
        if constexpr (Sched::GATHER) {
#pragma unroll
            for (int _h = 0; _h < 2; ++_h) { gvC[_h][0] = gvN[_h][0]; gvC[_h][1] = gvN[_h][1]; } }
    }
    PG8_WAIT_V(0);
    if (wr == 0) PG8_BAR;
    PG8_BAR;
#undef PG8_SA
#undef PG8_SB
#undef PG8_STAGE
#undef PG8_STAGE_A
#undef PG8_GSETUP
#undef PG8_LDA
#undef PG8_LDB
#undef PG8_MMA
#undef PG8_WAIT_V
#undef PG8_WAIT_L
#undef PG8_BAR
#undef PG8_SCHED
}
}

struct Params { const float* in[31]; float* out; unsigned char* ws; int ph_lo, ph_hi; };

struct Ctx {
    LAS unsigned char* lds;
    int tid, lane, wave, G, bid, gw, ngw;
    unsigned char* ws; float* out;
};
DI Ctx relaunder(const Ctx& F0) {
    Ctx F = F0;
    asm volatile("" : "+v"(F.tid), "+v"(F.lane));
    asm volatile("" : "+s"(F.wave), "+s"(F.G), "+s"(F.bid), "+s"(F.gw), "+s"(F.ngw));
    asm volatile("" : "+s"(F.ws), "+s"(F.out));
    F.ws = as_global(F.ws); F.out = as_global(F.out);
    return F;
}

DI void dense_gemm(const Ctx& F, const bf16_t* A, int lda, const bf16_t* Bt, int ldb, int M, int N, int K, bf16_t* O, int ldc, int crot) {
    pg8::Gemm g{A, Bt, lda, ldb, K}; pg8::StaticOrder S; S.init(M, N, F.G, (F.bid + crot) % F.G);
    pg8::EpiStore E{O, ldc};
    for (int rep = 0; rep < REP_GEMM; ++rep) pg8::gemm_phase<pg8::EpiStore, pg8::StaticOrder>(F.lds, g, S, E);
}

struct TJob { const float* src; bf16_t* dst; int ldw, dld; };
DI void tr_load(const TJob& j, f32x4 (&r)[16], int lane) {
    const GAS float* p = (const GAS float*)(j.src + (size_t)(lane >> 4) * j.ldw + 4 * (lane & 15));
#pragma unroll
    for (int i = 0; i < 16; ++i) r[i] = *(const GAS f32x4*)(p + (size_t)(4 * i) * j.ldw);
}
DI void tr_store(const TJob& j, const f32x4 (&r)[16], LAS unsigned char* scr, int lane) {
#pragma unroll
    for (int i = 0; i < 16; ++i) { LAS unsigned* w = (LAS unsigned*)(scr + ((lane >> 4) + 4 * i) * 132 + (lane & 15) * 8); w[0] = cvt_pk_bf16(r[i].x, r[i].y); w[1] = cvt_pk_bf16(r[i].z, r[i].w); }
    LDS_WAIT();
    const int kc = lane & 7;
#pragma unroll
    for (int sgrp = 0; sgrp < 8; ++sgrp) { const int n = 8 * sgrp + (lane >> 3); const LAS unsigned short* c = (const LAS unsigned short*)(scr + (8 * kc) * 132 + n * 2);
        u32x4 o; o.x = (unsigned)c[0] | ((unsigned)c[66] << 16); o.y = (unsigned)c[2 * 66] | ((unsigned)c[3 * 66] << 16); o.z = (unsigned)c[4 * 66] | ((unsigned)c[5 * 66] << 16); o.w = (unsigned)c[6 * 66] | ((unsigned)c[7 * 66] << 16);
        *(GAS u32x4*)(j.dst + (size_t)n * j.dld + 8 * kc) = o; }
    LDS_WAIT();
}
template <class Dec> DI void tr_run(const Dec& D, int first, int count, int stride, LAS unsigned char* scr, int lane) {
    f32x4 A[16], B[16]; TJob ja, jb;
    int it = first; if (it >= count) return;
    ja = D(it); tr_load(ja, A, lane);
    for (;;) {
        const int it2 = it + stride; const bool h2 = it2 < count; if (h2) { jb = D(it2); tr_load(jb, B, lane); }
        tr_store(ja, A, scr, lane);
        if (!h2) break;
        const int it3 = it2 + stride; const bool h3 = it3 < count; if (h3) { ja = D(it3); tr_load(ja, A, lane); }
        tr_store(jb, B, scr, lane);
        if (!h3) break;
        it = it3;
    }
}
DI TJob mat_job(const float* W, int K, int N, bf16_t* WT, int item) {
    const int nblk = N / 64, kb = item / nblk, nb = item - kb * nblk;
    TJob j; j.src = W + (size_t)(64 * kb) * N + 64 * nb; j.dst = WT + (size_t)(64 * nb) * K + 64 * kb; j.ldw = N; j.dld = K; return j;
}
DI void row_to_bf16(const float* src, bf16_t* dst, int lane) {
    const GAS f32x4* s = (const GAS f32x4*)src + lane; GAS u32x2* o = (GAS u32x2*)dst + lane;
#pragma unroll
    for (int j = 0; j < 8; ++j) { const f32x4 v = s[64 * j]; u32x2 w; w.x = cvt_pk_bf16(v.x, v.y); w.y = cvt_pk_bf16(v.z, v.w); o[64 * j] = w; }
}

DI void phase_prologue(const Ctx& F, const Params& P) {
    unsigned char* const wsl = F.ws; float* const outl = F.out; (void)outl;
    LAS unsigned char* scr = F.lds + F.wave * 16384;
    unsigned char* ws = wsl;
    constexpr int I_RW = 32 * (RW_IN_COLS / 64), I_OT = 32 * (ZW_OTH / 64), I_WO = 32 * 32, I_KV = 32 * 8;
    constexpr int N_A = 2 * I_RW + 2 * I_OT, N_B = 4 * I_WO, N_C = 8 * I_KV, N_D = NTOK + NBATCH * MEML;
    struct ProDec { unsigned char* ws;
        DI TJob operator()(int it) const { int r = it;
            if (r < N_A) {
                if (r < I_RW) return mat_job(PIN(16), DM, RW_IN_COLS, (bf16_t*)(ws + WS_WIN), r); r -= I_RW;
                if (r < I_OT) return mat_job(PIN(28), DM, ZW_OTH, (bf16_t*)(ws + WS_WIN + WIN_STRIDE), r); r -= I_OT;
                if (r < I_OT) return mat_job(PIN(30), DM, ZW_OTH, (bf16_t*)(ws + WS_WIN + 2 * WIN_STRIDE), r); r -= I_OT;
                return mat_job(PIN(16) + (size_t)DM * RW_IN_COLS, DM, RW_IN_COLS, (bf16_t*)(ws + WS_WIN + 3 * WIN_STRIDE), r);
            }
            r -= N_A;
            if (r < N_B) { const int l = r / I_WO; return mat_job(PIN(2) + (size_t)l * DM * DM, DM, DM, (bf16_t*)(ws + WS_WOUT) + (size_t)l * DM * DM, r - l * I_WO); }
            r -= N_B;
            const int m = r / I_KV, l = m & 3; const bool isv = m >= 4;
            return mat_job(PIN(isv ? 4 : 3) + (size_t)l * DM * MEMW, DM, MEMW, (bf16_t*)(ws + (isv ? WS_WV : WS_WK)) + (size_t)l * MEMW * DM, r - m * I_KV);
        } };
    ProDec PD{ws};
    tr_run(PD, F.gw, N_A + N_B + N_C, F.ngw, scr, F.lane);
    for (int r = F.gw; r < N_D; r += F.ngw) {
        if (r < NTOK) row_to_bf16(PIN(0) + (size_t)r * DM, (bf16_t*)(ws + WS_XB) + (size_t)r * DM, F.lane);
        else row_to_bf16(PIN(1) + (size_t)(r - NTOK) * DM, (bf16_t*)(ws + WS_MEMB) + (size_t)(r - NTOK) * DM, F.lane);
    }
    const int gt = F.bid * NT + F.tid, ngt = F.G * NT;
    for (int idx = gt; idx < 2 * (3072 + 1536) * 256; idx += ngt) {
        const int j = idx / ((3072 + 1536) * 256); int r = idx - j * (3072 + 1536) * 256;
        bf16_t* base = (bf16_t*)(ws + WS_LORA + (size_t)j * LORA_STRIDE);
        const int n = r >> 8, k = r & 255; float v = 0.f;
        if (n < 1536) { if (k < 96) v = PIN(19)[((size_t)j * 96 + k) * CMIX + n]; }
        else if (n < 3072) { if (k >= 96 && k < 192) v = PIN(21)[((size_t)j * 96 + (k - 96)) * CMIX + (n - 1536)]; }
        else v = PIN(22)[((size_t)j * 256 + k) * CMIX + (n - 3072)];
        base[r] = (bf16_t)(cvt_pk_bf16(v, 0.f) & 0xffffu);
    }
    for (int idx = gt; idx < 2 * 64 * DM; idx += ngt) { const int j = idx / (64 * DM), r = idx - j * 64 * DM;
        ((bf16_t*)(ws + WS_WIN + (size_t)(j ? 3 : 0) * WIN_STRIDE))[(size_t)RW_IN_COLS * DM + r] = 0; }
    for (int idx = gt; idx < NLAYER * 48 * DM; idx += ngt) {
        const int l = idx / (48 * DM); int r = idx - l * 48 * DM; const int n = r / DM, k = r - n * DM;
        float v = 0.f;
        if (n < 4) v = PIN(9)[((size_t)l * DM + k) * 4 + n]; else if (n < 36) v = PIN(11)[((size_t)l * DM + k) * 32 + (n - 4)];
        const unsigned hi = cvt_pk_bf16(v, 0.f) & 0xffffu; const float rem = v - bf2f(hi); const unsigned lo = cvt_pk_bf16(rem, 0.f) & 0xffffu;
        bf16_t* base = (bf16_t*)(ws + WS_WSW + (size_t)l * WSW_STRIDE);
        base[r] = (bf16_t)hi; base[48 * DM + r] = (bf16_t)lo;
    }
}

DI void expert_convert(const Ctx& F, const Params& P, int l, int w, int nw) {
    unsigned char* const wsl = F.ws;
    LAS unsigned char* scr = F.lds + F.wave * 16384;
    constexpr int I_GU = NEXP * 32 * 8 * 2, I_DN = NEXP * 8 * 32;
    struct ExpDec { unsigned char* ws; int l;
        DI TJob operator()(int it) const { TJob j;
            if (it < I_GU) {
                const int isup = it / (I_GU / 2); int r = it - isup * (I_GU / 2);
                const int e = r / 256; r -= e * 256; const int kb = r >> 3, nb = r & 7;
                const float* W = PIN(isup ? 14 : 13) + ((size_t)l * NEXP + e) * DM * DEXP;
                const int n0 = 64 * nb, drow = 256 * (n0 >> 7) + (isup ? 128 : 0) + (n0 & 127);
                j.src = W + (size_t)(64 * kb) * DEXP + n0; j.ldw = DEXP; j.dst = (bf16_t*)(ws + WS_EXP1) + ((size_t)e * 1024 + drow) * DM + 64 * kb; j.dld = DM;
            } else {
                int r = it - I_GU; const int e = r / 256; r -= e * 256; const int kb = r >> 5, nb = r & 31;
                const float* W = PIN(15) + ((size_t)l * NEXP + e) * DEXP * DM;
                j.src = W + (size_t)(64 * kb) * DM + 64 * nb; j.ldw = DM; j.dst = (bf16_t*)(ws + WS_EXP2) + ((size_t)e * DM + 64 * nb) * DEXP + 64 * kb; j.dld = DEXP;
            }
            return j; } };
    ExpDec ED{wsl, l};
    tr_run(ED, w, I_GU + I_DN, nw, scr, F.lane);
}

DI void memattn_unit(const Ctx& F, int l, int unit, const bf16_t* z, int zw, int qcol) {
    unsigned char* const wsl = F.ws; float* const outl = F.out; (void)outl;
    const int b = unit >> 6, head = (unit >> 4) & 3, qblk = unit & 15;
    LAS unsigned char* Ks = F.lds; LAS unsigned char* Vs = F.lds + 69632;
    const bf16_t* Km = (const bf16_t*)(wsl + WS_KM); const bf16_t* VmT = (const bf16_t*)(wsl + WS_VMT);
    bf16_t* cat = (bf16_t*)(wsl + WS_CAT);
    __syncthreads();
#pragma unroll
    for (int h = 0; h < 2; ++h) {
        u32x4 kv[4], vv[4];
#pragma unroll
        for (int i = 0; i < 4; ++i) { const int ch = F.tid + NT * (4 * h + i);
            { const int row = ch >> 4, c16 = ch & 15; kv[i] = *(const GAS u32x4*)(Km + (size_t)(b * MEML + row) * 2048 + l * 512 + head * 128 + c16 * 8); }
            { const int d = ch >> 5, c = ch & 31; vv[i] = *(const GAS u32x4*)(VmT + (size_t)(l * 512 + head * 128 + d) * 1024 + b * MEML + c * 8); } }
#pragma unroll
        for (int i = 0; i < 4; ++i) { const int ch = F.tid + NT * (4 * h + i);
            { const int row = ch >> 4, c16 = ch & 15; *(LAS u32x4*)(Ks + row * 272 + c16 * 16) = kv[i]; }
            { const int d = ch >> 5, c = ch & 31; *(LAS u32x4*)(Vs + d * 528 + c * 16) = vv[i]; } }
        asm volatile("" ::: "memory");
    }
    __syncthreads();
    int lane = F.lane; asm volatile("" : "+v"(lane) :: "memory");
    const int fr = lane & 15, fq = lane >> 4;
    for (int itq = 0; itq < 2; ++itq) {
        asm volatile("" : "+v"(lane) :: "memory");
        const int q0 = qblk * 256 + itq * 128 + F.wave * 16, tok0 = b * SEQ + q0;
        bf16x8 Qf[4];
#pragma unroll
        for (int ks = 0; ks < 4; ++ks) Qf[ks] = *(const GAS bf16x8*)(z + (size_t)(tok0 + (lane & 15)) * zw + qcol + head * 128 + ks * 32 + (lane >> 4) * 8);
        f32x4 acc[16];
#pragma unroll
        for (int t = 0; t < 16; ++t) { acc[t] = (f32x4){0.f, 0.f, 0.f, 0.f};
#pragma unroll
            for (int ks = 0; ks < 4; ++ks) { const bf16x8 kf = *(const LAS bf16x8*)(Ks + (16 * t + fr) * 272 + ks * 64 + fq * 16);
                acc[t] = __builtin_amdgcn_mfma_f32_16x16x32_bf16(kf, Qf[ks], acc[t], 0, 0, 0); } }
        const float sc = 0.08838834764831845f;
        float mx = -3.0e38f;
#pragma unroll
        for (int t = 0; t < 16; ++t)
#pragma unroll
            for (int j = 0; j < 4; ++j) { acc[t][j] *= sc; mx = fmaxf(mx, acc[t][j]); }
        mx = fmaxf(mx, __shfl_xor(mx, 16)); mx = fmaxf(mx, __shfl_xor(mx, 32));
        float sum = 0.f;
#pragma unroll
        for (int t = 0; t < 16; ++t)
#pragma unroll
            for (int j = 0; j < 4; ++j) { acc[t][j] = __expf(acc[t][j] - mx); sum += acc[t][j]; }
        sum += __shfl_xor(sum, 16); sum += __shfl_xor(sum, 32);
        const float inv = 1.f / sum;
        f32x4 o[8];
#pragma unroll
        for (int dt = 0; dt < 8; ++dt) o[dt] = (f32x4){0.f, 0.f, 0.f, 0.f};
#pragma unroll
        for (int s = 0; s < 8; ++s) {
            u32x4 pw; pw.x = cvt_pk_bf16(acc[2 * s][0], acc[2 * s][1]); pw.y = cvt_pk_bf16(acc[2 * s][2], acc[2 * s][3]);
            pw.z = cvt_pk_bf16(acc[2 * s + 1][0], acc[2 * s + 1][1]); pw.w = cvt_pk_bf16(acc[2 * s + 1][2], acc[2 * s + 1][3]);
            const bf16x8 pf = __builtin_bit_cast(bf16x8, pw);
#pragma unroll
            for (int dt = 0; dt < 8; ++dt) {
                const u32x2 v0 = *(const LAS u32x2*)(Vs + (16 * dt + fr) * 528 + (32 * s + 4 * fq) * 2);
                const u32x2 v1 = *(const LAS u32x2*)(Vs + (16 * dt + fr) * 528 + (32 * s + 16 + 4 * fq) * 2);
                u32x4 vw; vw.x = v0.x; vw.y = v0.y; vw.z = v1.x; vw.w = v1.y;
                o[dt] = __builtin_amdgcn_mfma_f32_16x16x32_bf16(__builtin_bit_cast(bf16x8, vw), pf, o[dt], 0, 0, 0);
            }
        }
        bf16_t* orow = cat + (size_t)(tok0 + fr) * DM + CMIX + head * 128 + 4 * fq;
#pragma unroll
        for (int dt = 0; dt < 8; ++dt) { u32x2 w; w.x = cvt_pk_bf16(o[dt][0] * inv, o[dt][1] * inv); w.y = cvt_pk_bf16(o[dt][2] * inv, o[dt][3] * inv); *(GAS u32x2*)(orow + 16 * dt) = w; }
    }
}
DI void memattn_all(const Ctx& F, int l, const bf16_t* z, int zw, int qcol) {
    for (int u = F.bid; u < 256; u += F.G) memattn_unit(F, l, u, z, zw, qcol);
    __syncthreads();
}

DI void conv_mix(const Ctx& F, const Params& P, const bf16_t* z) {
    unsigned char* const wsl = F.ws; float* const outl = F.out; (void)outl;
    const float* cw = PIN(29);
    bf16_t* cat = (bf16_t*)(wsl + WS_CAT);
    const int gt = F.bid * NT + F.tid, ngt = F.G * NT;
    for (int idx = gt; idx < NTOK * 192; idx += ngt) {
        const int tok = idx / 192, c8 = idx - tok * 192, c = c8 * 8, t = tok & (SEQ - 1);
        const bf16_t* zr = z + (size_t)tok * ZW_OTH;
        const u32x4 bg = *(const GAS u32x4*)(zr + c);
        u32x4 cg[3], hh[3]; f32x4 w0[3], w1[3];
#pragma unroll
        for (int dt = 0; dt < 3; ++dt) { const bf16_t* zp = (t - dt >= 0) ? zr - (size_t)dt * ZW_OTH : zr;
            cg[dt] = *(const GAS u32x4*)(zp + CMIX + c); hh[dt] = *(const GAS u32x4*)(zp + 2 * CMIX + c);
            w0[dt] = *(const GAS f32x4*)(cw + (2 - dt) * CMIX + c); w1[dt] = *(const GAS f32x4*)(cw + (2 - dt) * CMIX + c + 4); }
        float y[8];
#pragma unroll
        for (int j = 0; j < 8; ++j) y[j] = 0.f;
#pragma unroll
        for (int dt = 0; dt < 3; ++dt) {
            const float m = (t - dt >= 0) ? 1.f : 0.f;
            y[0] += m * (w0[dt].x * bflo(cg[dt].x) * bflo(hh[dt].x)); y[1] += m * (w0[dt].y * bfhi(cg[dt].x) * bfhi(hh[dt].x)); y[2] += m * (w0[dt].z * bflo(cg[dt].y) * bflo(hh[dt].y)); y[3] += m * (w0[dt].w * bfhi(cg[dt].y) * bfhi(hh[dt].y));
            y[4] += m * (w1[dt].x * bflo(cg[dt].z) * bflo(hh[dt].z)); y[5] += m * (w1[dt].y * bfhi(cg[dt].z) * bfhi(hh[dt].z)); y[6] += m * (w1[dt].z * bflo(cg[dt].w) * bflo(hh[dt].w)); y[7] += m * (w1[dt].w * bfhi(cg[dt].w) * bfhi(hh[dt].w));
        }
        u32x4 o; o.x = cvt_pk_bf16(bflo(bg.x) * y[0], bfhi(bg.x) * y[1]); o.y = cvt_pk_bf16(bflo(bg.y) * y[2], bfhi(bg.y) * y[3]);
        o.z = cvt_pk_bf16(bflo(bg.z) * y[4], bfhi(bg.z) * y[5]); o.w = cvt_pk_bf16(bflo(bg.w) * y[6], bfhi(bg.w) * y[7]);
        *(GAS u32x4*)(cat + (size_t)tok * DM + c) = o;
    }
}

DI void sb_attention(const Ctx& F, const bf16_t* z) {
    unsigned char* const wsl = F.ws;
    const bf16_t* VT = (const bf16_t*)(wsl + WS_ACT);
    bf16_t* cat = (bf16_t*)(wsl + WS_CAT);
    LAS unsigned char* Ks = F.lds; LAS unsigned char* Vs = F.lds + 69632;
    const int lane = F.lane, fr = lane & 15, fq = lane >> 4;
    const float sc = 0.08838834764831845f;
    for (int u = F.bid; u < NBATCH * 12 * 32; u += F.G) {
        const int b = u / (12 * 32); int r = u - b * 12 * 32; const int head = r >> 5, qblk = r & 31;
        const int t0 = qblk * 128, kw0 = t0 - 128;
        __syncthreads();
#pragma unroll
        for (int h = 0; h < 2; ++h) {
            u32x4 kv[4], vv[4];
#pragma unroll
            for (int i = 0; i < 4; ++i) { const int ch = F.tid + NT * (4 * h + i);
                { const int row = ch >> 4, c16 = ch & 15, key = kw0 + row, keyc = key < 0 ? 0 : key; kv[i] = *(const GAS u32x4*)(z + (size_t)(b * SEQ + keyc) * ZW_OTH + CMIX + head * 128 + c16 * 8); }
                { const int d = ch >> 5, c = ch & 31, k8 = kw0 + c * 8, k8c = k8 < 0 ? 0 : k8; vv[i] = *(const GAS u32x4*)(VT + (size_t)(head * 128 + d) * NTOK + b * SEQ + k8c); } }
#pragma unroll
            for (int i = 0; i < 4; ++i) { const int ch = F.tid + NT * (4 * h + i);
                { const int row = ch >> 4, c16 = ch & 15; *(LAS u32x4*)(Ks + row * 272 + c16 * 16) = kv[i]; }
                { const int d = ch >> 5, c = ch & 31; *(LAS u32x4*)(Vs + d * 528 + c * 16) = vv[i]; } }
            asm volatile("" ::: "memory");
        }
        __syncthreads();
        int lq = F.lane; asm volatile("" : "+v"(lq) :: "memory");
        const int tq0 = t0 + F.wave * 16, tq = tq0 + fr;
        bf16x8 Qf[4];
#pragma unroll
        for (int ks = 0; ks < 4; ++ks) Qf[ks] = *(const GAS bf16x8*)(z + (size_t)(b * SEQ + tq0 + (lq & 15)) * ZW_OTH + head * 128 + ks * 32 + (lq >> 4) * 8);
        f32x4 o[8];
#pragma unroll
        for (int dt = 0; dt < 8; ++dt) o[dt] = (f32x4){0.f, 0.f, 0.f, 0.f};
        float R = 0.f;
        for (int kt = (tq0 + 14) >> 5; kt >= 0; --kt) {
            const int lk = 32 * kt - kw0;
            bf16x8 Kf[2][4]; u32x2 V0[8], V1[8];
            if (lk >= 0) {
#pragma unroll
                for (int tl = 0; tl < 2; ++tl)
#pragma unroll
                    for (int ks = 0; ks < 4; ++ks) Kf[tl][ks] = *(const LAS bf16x8*)(Ks + (lk + 16 * tl + fr) * 272 + ks * 64 + fq * 16);
#pragma unroll
                for (int dt = 0; dt < 8; ++dt) { V0[dt] = *(const LAS u32x2*)(Vs + (16 * dt + fr) * 528 + (lk + 4 * fq) * 2); V1[dt] = *(const LAS u32x2*)(Vs + (16 * dt + fr) * 528 + (lk + 16 + 4 * fq) * 2); }
            } else {
#pragma unroll
                for (int tl = 0; tl < 2; ++tl)
#pragma unroll
                    for (int ks = 0; ks < 4; ++ks) Kf[tl][ks] = *(const GAS bf16x8*)(z + (size_t)(b * SEQ + 32 * kt + 16 * tl + fr) * ZW_OTH + CMIX + head * 128 + ks * 32 + fq * 8);
#pragma unroll
                for (int dt = 0; dt < 8; ++dt) { const bf16_t* vp = VT + (size_t)(head * 128 + 16 * dt + fr) * NTOK + b * SEQ + 32 * kt + 4 * fq; V0[dt] = *(const GAS u32x2*)vp; V1[dt] = *(const GAS u32x2*)(vp + 16); }
            }
            f32x4 s[2];
#pragma unroll
            for (int tl = 0; tl < 2; ++tl) { s[tl] = (f32x4){0.f, 0.f, 0.f, 0.f};
#pragma unroll
                for (int ks = 0; ks < 4; ++ks) s[tl] = __builtin_amdgcn_mfma_f32_16x16x32_bf16(Kf[tl][ks], Qf[ks], s[tl], 0, 0, 0); }
            float ln[2][4], lsg[2][4], tot[2];
#pragma unroll
            for (int tl = 0; tl < 2; ++tl) { tot[tl] = 0.f;
#pragma unroll
                for (int j = 0; j < 4; ++j) { const float x = s[tl][j] * sc; const int key = 32 * kt + 16 * tl + 4 * fq + j; const bool valid = key < tq;
                    const float sp = softplusf_(x); ln[tl][j] = valid ? -sp : 0.f; lsg[tl][j] = valid ? (x - sp) : -1.0e30f; tot[tl] += ln[tl][j]; } }
            const float a16_0 = __shfl_xor(tot[0], 16), a32_0 = __shfl_xor(tot[0], 32), a48_0 = __shfl_xor(tot[0], 48);
            const float a16_1 = __shfl_xor(tot[1], 16), a32_1 = __shfl_xor(tot[1], 32), a48_1 = __shfl_xor(tot[1], 48);
            float hi0 = 0.f, hi1 = 0.f;
            if ((fq ^ 1) > fq) { hi0 += a16_0; hi1 += a16_1; }
            if ((fq ^ 2) > fq) { hi0 += a32_0; hi1 += a32_1; }
            if ((fq ^ 3) > fq) { hi0 += a48_0; hi1 += a48_1; }
            const float all0 = tot[0] + a16_0 + a32_0 + a48_0, all1 = tot[1] + a16_1 + a32_1 + a48_1;
            const float E0 = R + hi0 + all1, E1 = R + hi1;
            float at[2][4];
#pragma unroll
            for (int tl = 0; tl < 2; ++tl) { float suf = 0.f; const float Eb = tl ? E1 : E0;
#pragma unroll
                for (int j = 3; j >= 0; --j) { at[tl][j] = __expf(lsg[tl][j] + Eb + suf); suf += ln[tl][j]; } }
            R += all0 + all1;
            u32x4 pw; pw.x = cvt_pk_bf16(at[0][0], at[0][1]); pw.y = cvt_pk_bf16(at[0][2], at[0][3]); pw.z = cvt_pk_bf16(at[1][0], at[1][1]); pw.w = cvt_pk_bf16(at[1][2], at[1][3]);
            const bf16x8 pf = __builtin_bit_cast(bf16x8, pw);
#pragma unroll
            for (int dt = 0; dt < 8; ++dt) {
                u32x4 vw; vw.x = V0[dt].x; vw.y = V0[dt].y; vw.z = V1[dt].x; vw.w = V1[dt].y;
                o[dt] = __builtin_amdgcn_mfma_f32_16x16x32_bf16(__builtin_bit_cast(bf16x8, vw), pf, o[dt], 0, 0, 0);
            }
            if (__all(R < -100.f)) break;
        }
        bf16_t* orow = cat + (size_t)(b * SEQ + tq) * DM + head * 128 + 4 * fq;
#pragma unroll
        for (int dt = 0; dt < 8; ++dt) { u32x2 w; w.x = cvt_pk_bf16(o[dt][0], o[dt][1]); w.y = cvt_pk_bf16(o[dt][2], o[dt][3]); *(GAS u32x2*)(orow + 16 * dt) = w; }
    }
    __syncthreads();
}

DI void rwkv_prep1(const Ctx& F, const Params& P, int j, const bf16_t* z) {
    unsigned char* const wsl = F.ws; float* const outl = F.out; (void)outl;
    const float* mu = PIN(17) + (size_t)j * 5056;
    bf16_t* act = (bf16_t*)(wsl + WS_ACT);
    const int gt = F.bid * NT + F.tid, ngt = F.G * NT;
    for (int idx = gt; idx < NTOK * 64; idx += ngt) {
        const int tok = idx >> 6, ci = idx & 63, t = tok & (SEQ - 1);
        u32x4 o = (u32x4){0u, 0u, 0u, 0u};
        if (ci < 24 || ci >= 32) {
            const int sc = ci < 12 ? 4608 + 8 * ci : (ci < 24 ? 4704 + 8 * (ci - 12) : 4800 + 8 * (ci - 32));
            const u32x4 a = *(const GAS u32x4*)(z + (size_t)tok * ZW_RWKV + sc);
            u32x4 p = *(const GAS u32x4*)(z + (size_t)(t > 0 ? tok - 1 : tok) * ZW_RWKV + sc);
            const f32x4 m0 = *(const GAS f32x4*)(mu + sc), m1 = *(const GAS f32x4*)(mu + sc + 4);
            if (t == 0) p = (u32x4){0u, 0u, 0u, 0u};
            float v[8];
            v[0] = bflo(a.x) + (bflo(p.x) - bflo(a.x)) * m0.x; v[1] = bfhi(a.x) + (bfhi(p.x) - bfhi(a.x)) * m0.y;
            v[2] = bflo(a.y) + (bflo(p.y) - bflo(a.y)) * m0.z; v[3] = bfhi(a.y) + (bfhi(p.y) - bfhi(a.y)) * m0.w;
            v[4] = bflo(a.z) + (bflo(p.z) - bflo(a.z)) * m1.x; v[5] = bfhi(a.z) + (bfhi(p.z) - bfhi(a.z)) * m1.y;
            v[6] = bflo(a.w) + (bflo(p.w) - bflo(a.w)) * m1.z; v[7] = bfhi(a.w) + (bfhi(p.w) - bfhi(a.w)) * m1.w;
#pragma unroll
            for (int q = 0; q < 8; ++q) { if (ci < 12) v[q] = tanhf(v[q]); else if (ci >= 32) v[q] = sigmoidf_(v[q]); }
            o.x = cvt_pk_bf16(v[0], v[1]); o.y = cvt_pk_bf16(v[2], v[3]); o.z = cvt_pk_bf16(v[4], v[5]); o.w = cvt_pk_bf16(v[6], v[7]);
        }
        *(GAS u32x4*)(act + (size_t)tok * 512 + ci * 8) = o;
    }
}

constexpr int CH = 64, NCH = SEQ / CH;
DI float* scan_rec(unsigned char* ws, int tok, int head) {
    return (float*)(ws + WS_SCAN) + ((size_t)((tok >> 12) * 24 + head) * SEQ + (tok & (SEQ - 1))) * 320;
}
DI float* gh_ptr(unsigned char* ws, int bh, int c, int which) { return (float*)(ws + WS_GH) + (((size_t)bh * NCH + c) * 2 + which) * 4096; }
struct RwPar { const float *mu, *w0, *a0, *kk, *ka, *rk, *gng, *gnb; };
struct PrepRaw { u32x2 zr, zk, zv, pr, pk, pv, lw, la; };
struct PrepOut { f32x4 dec, ld, bb, kp, r, nk, v; float bon; };
DI void prep_load(PrepRaw& R, const bf16_t* z, const bf16_t* LW, int tok, int c4) {
    tok = tok < NTOK ? tok : NTOK - 1;
    const bool hp = (tok & (SEQ - 1)) != 0;
    const GAS bf16_t* zc = (const GAS bf16_t*)(z + (size_t)tok * ZW_RWKV + c4); const GAS bf16_t* zp = hp ? zc - ZW_RWKV : zc;
    R.zr = *(const GAS u32x2*)zc; R.zk = *(const GAS u32x2*)(zc + CMIX); R.zv = *(const GAS u32x2*)(zc + 2 * CMIX);
    R.pr = *(const GAS u32x2*)zp; R.pk = *(const GAS u32x2*)(zp + CMIX); R.pv = *(const GAS u32x2*)(zp + 2 * CMIX);
    const GAS bf16_t* lp = (const GAS bf16_t*)(LW + (size_t)tok * 3072 + c4); R.lw = *(const GAS u32x2*)lp; R.la = *(const GAS u32x2*)(lp + CMIX);
}
DI f32x4 lerp_u(u32x2 a, u32x2 p, f32x4 m) {
    f32x4 r; r.x = bflo(a.x) + (bflo(p.x) - bflo(a.x)) * m.x; r.y = bfhi(a.x) + (bfhi(p.x) - bfhi(a.x)) * m.y;
    r.z = bflo(a.y) + (bflo(p.y) - bflo(a.y)) * m.z; r.w = bfhi(a.y) + (bfhi(p.y) - bfhi(a.y)) * m.w; return r;
}
struct PrepPar { f32x4 mur, muk, muv, w0, a0, kk, ka, rk; };
DI void par_load(PrepPar& P, const RwPar& Q, int c4) {
    P.mur = *(const GAS f32x4*)(Q.mu + c4); P.muk = *(const GAS f32x4*)(Q.mu + CMIX + c4); P.muv = *(const GAS f32x4*)(Q.mu + 2 * CMIX + c4);
    P.w0 = *(const GAS f32x4*)(Q.w0 + c4); P.a0 = *(const GAS f32x4*)(Q.a0 + c4); P.kk = *(const GAS f32x4*)(Q.kk + c4); P.ka = *(const GAS f32x4*)(Q.ka + c4); P.rk = *(const GAS f32x4*)(Q.rk + c4);
}
template <bool WANT_BON> DI void prep_compute(const PrepRaw& R, const PrepPar& P, bool hp, PrepOut& O) {
    const u32x2 z2 = (u32x2){0u, 0u};
    const f32x4 r = lerp_u(R.zr, hp ? R.pr : z2, P.mur), k = lerp_u(R.zk, hp ? R.pk : z2, P.muk);
    O.v = lerp_u(R.zv, hp ? R.pv : z2, P.muv); O.r = r;
    const f32x4 w0v = P.w0, a0v = P.a0, kkv = P.kk, kav = P.ka;
    f32x4 wr; wr.x = w0v.x + bflo(R.lw.x); wr.y = w0v.y + bfhi(R.lw.x); wr.z = w0v.z + bflo(R.lw.y); wr.w = w0v.w + bfhi(R.lw.y);
    f32x4 ar; ar.x = a0v.x + bflo(R.la.x); ar.y = a0v.y + bfhi(R.la.x); ar.z = a0v.z + bflo(R.la.y); ar.w = a0v.w + bfhi(R.la.y);
    f32x4 a, kk;
#pragma unroll
    for (int q = 0; q < 4; ++q) { const float wl = -softplusf_(-wr[q]) - 0.5f; O.ld[q] = -__expf(wl); O.dec[q] = __expf(O.ld[q]); a[q] = sigmoidf_(ar[q]); kk[q] = k[q] * kkv[q]; O.kp[q] = k[q] * (1.f + (a[q] - 1.f) * kav[q]); }
    const float n2 = sum16(kk.x * kk.x + kk.y * kk.y + kk.z * kk.z + kk.w * kk.w);
    const float inv = __builtin_amdgcn_rsqf(fmaxf(n2, 1e-24f));
#pragma unroll
    for (int q = 0; q < 4; ++q) { const float kn = kk[q] * inv; O.bb[q] = kn * a[q]; O.nk[q] = -kn; }
    if (WANT_BON) { const f32x4 rk = P.rk; O.bon = sum16(r.x * O.kp.x * rk.x + r.y * O.kp.y * rk.y + r.z * O.kp.z * rk.z + r.w * O.kp.w * rk.w); }
}
#define LO2(v) ((f32x2){(v).x, (v).y})
#define HI2(v) ((f32x2){(v).z, (v).w})
constexpr int WRS = 144;
constexpr int W_SLOT = 64 * WRS;
enum { SL_NT = 0, SL_RT, SL_BH, SL_KH, SL_BHT, SL_KHT, SL_VT, SL_MK, SL_NB, SL_NK, SL_W1T, SL_U0T };
constexpr int W_MB = 12 * W_SLOT, W_CL = W_MB + 16384, W_PL = W_CL + 16384;
DI bf16x8 wfrag(LAS unsigned char* L, int slot, int row, int ks, int q) { return *(const LAS bf16x8*)(L + slot * W_SLOT + row * WRS + ks * 64 + q * 16); }
DI void wput(LAS unsigned char* L, int slot, int row, int col, float v) { *(LAS bf16_t*)(L + slot * W_SLOT + row * WRS + col * 2) = (bf16_t)(cvt_pk_bf16(v, 0.f) & 0xffffu); }
DI void tr4x4_rows(f32x4& x) {
    const float f0 = x.x, f1 = x.y, f2 = x.z, f3 = x.w;
    const unsigned u0 = __builtin_bit_cast(unsigned, f0), u1 = __builtin_bit_cast(unsigned, f1), u2 = __builtin_bit_cast(unsigned, f2), u3 = __builtin_bit_cast(unsigned, f3);
    const auto s02 = __builtin_amdgcn_permlane32_swap(u0, u2, false, false); const auto s13 = __builtin_amdgcn_permlane32_swap(u1, u3, false, false);
    const auto t01 = __builtin_amdgcn_permlane16_swap(s02[0], s13[0], false, false); const auto t23 = __builtin_amdgcn_permlane16_swap(s02[1], s13[1], false, false);
    x[0] = __builtin_bit_cast(float, (unsigned)t01[0]); x[1] = __builtin_bit_cast(float, (unsigned)t01[1]); x[2] = __builtin_bit_cast(float, (unsigned)t23[0]); x[3] = __builtin_bit_cast(float, (unsigned)t23[1]);
}
DI void scan_w1(const Ctx& F, const RwPar& Q, const bf16_t* z) {
    unsigned char* const wsl = F.ws; LAS unsigned char* L = F.lds;
    const int wave = F.wave;
    const bf16_t* LW = (const bf16_t*)(wsl + WS_LW);
    LAS float* MB = (LAS float*)(L + W_MB); LAS float* CL = (LAS float*)(L + W_CL); LAS float* PL = (LAS float*)(L + W_PL);
    PrepPar PN;
    PrepRaw RN[2];
    if (F.bid < 96 * NCH) { const int bh = F.bid % 96, c = F.bid / 96, b = bh / 24, head = bh - b * 24, tokb = b * SEQ + c * CH, c4 = head * 64 + 4 * (F.lane & 15);
#pragma unroll
        for (int p = 0; p < 2; ++p) prep_load(RN[p], z, LW, tokb + p * 32 + wave * 4 + (F.lane >> 4), c4);
        par_load(PN, Q, c4); }
    for (int u = F.bid; u < 96 * NCH; u += F.G) {
        int lane = F.lane; asm volatile("" : "+v"(lane));
        const int tq = lane >> 4, li = lane & 15, fr = li, fq = tq;
        const int bh = u % 96, c = u / 96, b = bh / 24, head = bh - b * 24, tokb = b * SEQ + c * CH, c4 = head * 64 + 4 * li;
        LDS_BARRIER();
        PrepOut O[2];
#pragma unroll
        for (int p = 0; p < 2; ++p) {
            const int t = p * 32 + wave * 4 + tq; const PrepRaw R = RN[p];
            prep_compute<true>(R, PN, ((tokb + t) & (SEQ - 1)) != 0, O[p]);
            *(LAS f32x4*)(CL + t * 64 + 4 * li) = O[p].ld;
            u32x2 e; e.x = cvt_pk_bf16(O[p].bon * O[p].v.x, O[p].bon * O[p].v.y); e.y = cvt_pk_bf16(O[p].bon * O[p].v.z, O[p].bon * O[p].v.w);
            *(GAS u32x2*)((bf16_t*)(wsl + WS_E) + (size_t)(tokb + t) * CMIX + c4) = e;
        }
        LDS_BARRIER();
        if (wave == 0) {
            float xs[64];
#pragma unroll
            for (int t = 0; t < 64; ++t) xs[t] = CL[t * 64 + lane];
#pragma unroll
            for (int t = 1; t < 64; ++t) xs[t] += xs[t - 1];
#pragma unroll
            for (int t = 0; t < 64; ++t) CL[t * 64 + lane] = xs[t];
        }
        LDS_BARRIER();
#pragma unroll
        for (int p = 0; p < 2; ++p) {
            const int t = p * 32 + wave * 4 + tq;
            const f32x4 cl = *(const LAS f32x4*)(CL + t * 64 + 4 * li);
            f32x4 clm = (f32x4){0.f, 0.f, 0.f, 0.f}; if (t > 0) clm = *(const LAS f32x4*)(CL + (t - 1) * 64 + 4 * li);
            f32x4 nt, rt, bh4, kh4;
#pragma unroll
            for (int q = 0; q < 4; ++q) { const float P = __expf(cl[q]), Pm = __expf(clm[q]), iP = __expf(-cl[q]);
                nt[q] = O[p].nk[q] * Pm; rt[q] = O[p].r[q] * P; bh4[q] = O[p].bb[q] * iP; kh4[q] = O[p].kp[q] * iP;
                if (t == 63) PL[4 * li + q] = P; }
            u32x2 w;
            w.x = cvt_pk_bf16(nt.x, nt.y); w.y = cvt_pk_bf16(nt.z, nt.w); *(LAS u32x2*)(L + SL_NT * W_SLOT + t * WRS + 8 * li) = w;
            w.x = cvt_pk_bf16(rt.x, rt.y); w.y = cvt_pk_bf16(rt.z, rt.w); *(LAS u32x2*)(L + SL_RT * W_SLOT + t * WRS + 8 * li) = w;
            w.x = cvt_pk_bf16(bh4.x, bh4.y); w.y = cvt_pk_bf16(bh4.z, bh4.w); *(LAS u32x2*)(L + SL_BH * W_SLOT + t * WRS + 8 * li) = w;
            w.x = cvt_pk_bf16(kh4.x, kh4.y); w.y = cvt_pk_bf16(kh4.z, kh4.w); *(LAS u32x2*)(L + SL_KH * W_SLOT + t * WRS + 8 * li) = w;
            { f32x4 vv = O[p].v; tr4x4_rows(bh4); tr4x4_rows(kh4); tr4x4_rows(vv);
              const int off = (4 * li + tq) * WRS + (p * 32 + wave * 4) * 2;
              w.x = cvt_pk_bf16(bh4.x, bh4.y); w.y = cvt_pk_bf16(bh4.z, bh4.w); *(LAS u32x2*)(L + SL_BHT * W_SLOT + off) = w;
              w.x = cvt_pk_bf16(kh4.x, kh4.y); w.y = cvt_pk_bf16(kh4.z, kh4.w); *(LAS u32x2*)(L + SL_KHT * W_SLOT + off) = w;
              w.x = cvt_pk_bf16(vv.x, vv.y); w.y = cvt_pk_bf16(vv.z, vv.w); *(LAS u32x2*)(L + SL_VT * W_SLOT + off) = w; }
        }
        LDS_BARRIER();
        asm volatile("" ::: "memory");
        { const int un = u + F.G; if (un < 96 * NCH) { const int bhn = un % 96, cn = un / 96, bn = bhn / 24, headn = bhn - bn * 24, tokbn = bn * SEQ + cn * CH, c4n = headn * 64 + 4 * li;
#pragma unroll
            for (int p = 0; p < 2; ++p) prep_load(RN[p], z, LW, tokbn + p * 32 + wave * 4 + tq, c4n);
            par_load(PN, Q, c4n); } }
        for (int reps = 0; reps < REP_WS; ++reps) {
            const int mt = wave >> 1, slotA = (mt < 2) ? SL_NT : SL_RT, slotB = (mt & 1) ? SL_KH : SL_BH, slotO = (mt == 1) ? SL_MK : (mt == 2 ? SL_NB : SL_NK), tt0 = (wave & 1) * 2;
            bf16x8 Af[2][2], Bf[4][2];
#pragma unroll
            for (int a2 = 0; a2 < 2; ++a2)
#pragma unroll
                for (int ks = 0; ks < 2; ++ks) Af[a2][ks] = wfrag(L, slotA, 16 * (tt0 + a2) + fr, ks, fq);
#pragma unroll
            for (int ss = 0; ss < 4; ++ss)
#pragma unroll
                for (int ks = 0; ks < 2; ++ks) Bf[ss][ks] = wfrag(L, slotB, 16 * ss + fr, ks, fq);
            float zf = 0.f; asm volatile("" : "+v"(zf));
            const unsigned zu = __builtin_bit_cast(unsigned, zf);
            const int strict = (mt < 2) ? 1 : 0; LAS unsigned char* ob = L + slotO * W_SLOT;
#pragma unroll
            for (int a2 = 0; a2 < 2; ++a2)
#pragma unroll
                for (int ss = 0; ss < 4; ++ss) { const int t = 16 * (tt0 + a2) + fr, s0 = 16 * ss + 4 * fq;
                    if (ss <= tt0 + a2) {
                        f32x4 acc = __builtin_amdgcn_mfma_f32_16x16x32_bf16(Bf[ss][0], Af[a2][0], (f32x4){0.f, 0.f, 0.f, 0.f}, 0, 0, 0);
                        acc = __builtin_amdgcn_mfma_f32_16x16x32_bf16(Bf[ss][1], Af[a2][1], acc, 0, 0, 0);
                        f32x4 o;
#pragma unroll
                        for (int r = 0; r < 4; ++r) o[r] = (s0 + r + strict <= t) ? acc[r] : 0.f;
                        if (mt == 0) *(LAS f32x4*)(MB + t * 64 + s0) = o;
                        else { u32x2 w; w.x = cvt_pk_bf16(o[0], o[1]); w.y = cvt_pk_bf16(o[2], o[3]); *(LAS u32x2*)(ob + t * WRS + s0 * 2) = w; }
                    } else {
                        if (mt == 0) *(LAS f32x4*)(MB + t * 64 + s0) = (f32x4){zf, zf, zf, zf};
                        else *(LAS u32x2*)(ob + t * WRS + s0 * 2) = (u32x2){zu, zu};
                    }
                }
        }
        LDS_BARRIER();
        { const int t = F.tid >> 3, s0 = (F.tid & 7) * 8; const f32x4 a0 = *(const LAS f32x4*)(MB + t * 64 + s0), a1 = *(const LAS f32x4*)(MB + t * 64 + s0 + 4);
          u32x4 w; w.x = cvt_pk_bf16(a0.x, a0.y); w.y = cvt_pk_bf16(a0.z, a0.w); w.z = cvt_pk_bf16(a1.x, a1.y); w.w = cvt_pk_bf16(a1.z, a1.w);
          *(LAS u32x4*)(L + SL_BH * W_SLOT + t * WRS + s0 * 2) = w; }
#pragma unroll
        for (int k2 = 0; k2 < 2; ++k2) {
            const int tile = wave * 2 + k2, tt = tile >> 2, it = tile & 3;
            f32x4 acc = (f32x4){0.f, 0.f, 0.f, 0.f};
#pragma unroll
            for (int ks = 0; ks < 2; ++ks) acc = __builtin_amdgcn_mfma_f32_16x16x32_bf16(wfrag(L, SL_MK, 16 * tt + fr, ks, fq), wfrag(L, SL_VT, 16 * it + fr, ks, fq), acc, 0, 0, 0);
#pragma unroll
            for (int r = 0; r < 4; ++r) CL[(16 * tt + 4 * fq + r) * 64 + 16 * it + fr] = acc[r];
        }
        if (wave >= 4) {
            const int I = wave - 4;
            float d[16], xb[16];
#pragma unroll
            for (int r = 0; r < 16; ++r) d[r] = (r == lane) ? 1.f : 0.f;
            const LAS float* mbv = MB; asm volatile("" : "+v"(mbv));
            const LAS float* mb = mbv + (16 * I) * 64 + 16 * I;
            f32x4 A[8][2], Bm[8][2];
#pragma unroll
            for (int tt = 0; tt < 8; ++tt) { A[tt][0] = *(const LAS f32x4*)(mb + tt * 64); A[tt][1] = *(const LAS f32x4*)(mb + tt * 64 + 4); }
#pragma unroll
            for (int tt = 0; tt < 8; ++tt) { Bm[tt][0] = *(const LAS f32x4*)(mb + (8 + tt) * 64); Bm[tt][1] = *(const LAS f32x4*)(mb + (8 + tt) * 64 + 4); }
#pragma unroll
            for (int sx = 0; sx < 8; ++sx) { xb[sx] = d[sx];
#pragma unroll
                for (int tt = sx + 1; tt < 8; ++tt) d[tt] = fma_s(A[tt][sx >> 2][sx & 3], xb[sx], d[tt]); }
#pragma unroll
            for (int sx = 0; sx < 8; ++sx)
#pragma unroll
                for (int tt = 0; tt < 8; ++tt) d[8 + tt] = fma_s(Bm[tt][sx >> 2][sx & 3], xb[sx], d[8 + tt]);
            asm volatile("" : "+v"(d[8]), "+v"(d[15]) :: "memory");
#pragma unroll
            for (int tt = 0; tt < 8; ++tt) { A[tt][0] = *(const LAS f32x4*)(mb + (8 + tt) * 64 + 8); A[tt][1] = *(const LAS f32x4*)(mb + (8 + tt) * 64 + 12); }
#pragma unroll
            for (int sx = 0; sx < 8; ++sx) { xb[8 + sx] = d[8 + sx];
#pragma unroll
                for (int tt = sx + 1; tt < 8; ++tt) d[8 + tt] = fma_s(A[tt][sx >> 2][sx & 3], xb[8 + sx], d[8 + tt]); }
            if (lane < 16) {
#pragma unroll
                for (int t = 0; t < 16; ++t) *(LAS bf16_t*)(L + SL_KH * W_SLOT + (16 * I + t) * 48 + lane * 2) = (bf16_t)(cvt_pk_bf16(xb[t], 0.f) & 0xffffu);
            }
        }
        LDS_BARRIER();
        asm volatile("" ::: "memory");
        for (int repx = 0; repx < REP_WX; ++repx) {
            const int sys = wave >> 2, ct = wave & 3, slotX = sys == 0 ? SL_W1T : SL_U0T;
            LAS unsigned char* TI = L + SL_KH * W_SLOT;
            f32x4 rhs[4];
            if (sys == 0) {
#pragma unroll
                for (int I = 0; I < 4; ++I)
#pragma unroll
                    for (int r = 0; r < 4; ++r) rhs[I][r] = bf2f(*(const LAS bf16_t*)(L + SL_NT * W_SLOT + (16 * I + 4 * fq + r) * WRS + (16 * ct + fr) * 2));
            } else {
#pragma unroll
                for (int I = 0; I < 4; ++I)
#pragma unroll
                    for (int r = 0; r < 4; ++r) rhs[I][r] = CL[(16 * I + 4 * fq + r) * 64 + 16 * ct + fr];
            }
            u32x2 ta[4], ma[6];
#pragma unroll
            for (int I = 0; I < 4; ++I) ta[I] = *(const LAS u32x2*)(TI + (16 * I + fr) * 48 + 8 * fq);
#pragma unroll
            for (int I = 1; I < 4; ++I)
#pragma unroll
                for (int Ip = 0; Ip < I; ++Ip) ma[I * (I - 1) / 2 + Ip] = *(const LAS u32x2*)(L + SL_BH * W_SLOT + (16 * I + fr) * WRS + (16 * Ip + 4 * fq) * 2);
            u32x2 xk[4];
#pragma unroll
            for (int I = 0; I < 4; ++I) {
                f32x4 acc = rhs[I];
#pragma unroll
                for (int Ip = 0; Ip < I; ++Ip) { const u32x2 m = ma[I * (I - 1) / 2 + Ip];
                    acc = __builtin_amdgcn_mfma_f32_16x16x32_bf16(__builtin_bit_cast(bf16x8, (u32x4){m.x, m.y, 0u, 0u}), __builtin_bit_cast(bf16x8, (u32x4){xk[Ip].x, xk[Ip].y, 0u, 0u}), acc, 0, 0, 0); }
                const unsigned d0 = cvt_pk_bf16(acc[0], acc[1]), d1 = cvt_pk_bf16(acc[2], acc[3]);
                const f32x4 x = __builtin_amdgcn_mfma_f32_16x16x32_bf16(__builtin_bit_cast(bf16x8, (u32x4){ta[I].x, ta[I].y, 0u, 0u}), __builtin_bit_cast(bf16x8, (u32x4){d0, d1, 0u, 0u}), (f32x4){0.f, 0.f, 0.f, 0.f}, 0, 0, 0);
                xk[I].x = cvt_pk_bf16(x[0], x[1]); xk[I].y = cvt_pk_bf16(x[2], x[3]);
                *(LAS u32x2*)(L + slotX * W_SLOT + (16 * ct + fr) * WRS + (16 * I + 4 * fq) * 2) = xk[I];
            }
        }
        LDS_BARRIER();
        for (int repo = 0; repo < REP_WO; ++repo) {
            const int kind = wave >> 1, ta0 = (wave & 1) * 2;
            float* gp = gh_ptr(wsl, bh, c, 0); float* hp = gh_ptr(wsl, bh, c, 1);
            bf16_t* qy = (bf16_t*)(wsl + WS_QY) + (size_t)u * 4096; float* y0t = (float*)(wsl + WS_Y0T) + (size_t)u * 4096;
            const int sA1 = kind == 0 ? SL_W1T : kind == 1 ? SL_BHT : kind == 2 ? SL_W1T : SL_NK, sB1 = kind == 0 ? SL_BHT : kind == 1 ? SL_U0T : kind == 2 ? SL_NB : SL_VT;
            const int sA2 = kind == 1 ? SL_KHT : SL_NB, sB2 = kind == 1 ? SL_VT : SL_U0T; const bool two = (kind & 1) != 0;
            bf16x8 Af[2][2], Bf[4][2];
#pragma unroll
            for (int a2 = 0; a2 < 2; ++a2)
#pragma unroll
                for (int ks = 0; ks < 2; ++ks) Af[a2][ks] = wfrag(L, sA1, 16 * (ta0 + a2) + fr, ks, fq);
#pragma unroll
            for (int tb = 0; tb < 4; ++tb)
#pragma unroll
                for (int ks = 0; ks < 2; ++ks) Bf[tb][ks] = wfrag(L, sB1, 16 * tb + fr, ks, fq);
            f32x4 acc[2][4];
#pragma unroll
            for (int a2 = 0; a2 < 2; ++a2)
#pragma unroll
                for (int tb = 0; tb < 4; ++tb) { acc[a2][tb] = (f32x4){0.f, 0.f, 0.f, 0.f};
#pragma unroll
                    for (int ks = 0; ks < 2; ++ks) acc[a2][tb] = __builtin_amdgcn_mfma_f32_16x16x32_bf16(Af[a2][ks], Bf[tb][ks], acc[a2][tb], 0, 0, 0); }
            if (two) {
#pragma unroll
                for (int a2 = 0; a2 < 2; ++a2)
#pragma unroll
                    for (int ks = 0; ks < 2; ++ks) Af[a2][ks] = wfrag(L, sA2, 16 * (ta0 + a2) + fr, ks, fq);
#pragma unroll
                for (int tb = 0; tb < 4; ++tb)
#pragma unroll
                    for (int ks = 0; ks < 2; ++ks) Bf[tb][ks] = wfrag(L, sB2, 16 * tb + fr, ks, fq);
#pragma unroll
                for (int a2 = 0; a2 < 2; ++a2)
#pragma unroll
                    for (int tb = 0; tb < 4; ++tb)
#pragma unroll
                        for (int ks = 0; ks < 2; ++ks) acc[a2][tb] = __builtin_amdgcn_mfma_f32_16x16x32_bf16(Af[a2][ks], Bf[tb][ks], acc[a2][tb], 0, 0, 0);
            }
#pragma unroll
            for (int a2 = 0; a2 < 2; ++a2)
#pragma unroll
                for (int tb = 0; tb < 4; ++tb) { const int ta = ta0 + a2; const f32x4 av = acc[a2][tb];
                    if (kind == 0) {
                        const int j = 16 * tb + fr; const float pl = PL[j];
                        f32x4 o;
#pragma unroll
                        for (int r = 0; r < 4; ++r) o[r] = pl * (av[r] + ((16 * ta + 4 * fq + r) == j ? 1.f : 0.f));
                        u32x2 w; w.x = cvt_pk_bf16(o[0], o[1]); w.y = cvt_pk_bf16(o[2], o[3]);
                        *(GAS u32x2*)((bf16_t*)gp + j * 64 + 16 * ta + 4 * fq) = w;
                    } else if (kind == 1) {
                        const f32x4 pl = *(const LAS f32x4*)(PL + 16 * ta + 4 * fq);
                        *(GAS f32x4*)(hp + (16 * tb + fr) * 64 + 16 * ta + 4 * fq) = pl * av;
                    } else if (kind == 2) {
                        const int t = 16 * tb + fr; const u32x2 rr = *(const LAS u32x2*)(L + SL_RT * W_SLOT + t * WRS + (16 * ta + 4 * fq) * 2);
                        u32x2 w; w.x = cvt_pk_bf16(av[0] + bflo(rr.x), av[1] + bfhi(rr.x)); w.y = cvt_pk_bf16(av[2] + bflo(rr.y), av[3] + bfhi(rr.y));
                        *(GAS u32x2*)(qy + t * 64 + 16 * ta + 4 * fq) = w;
                    } else {
                        u32x2 w; w.x = cvt_pk_bf16(av[0], av[1]); w.y = cvt_pk_bf16(av[2], av[3]); *(GAS u32x2*)((bf16_t*)y0t + (16 * tb + fr) * 64 + 16 * ta + 4 * fq) = w;
                    }
                }
        }
    }
    LDS_BARRIER();
}
DI void scan_w2(const Ctx& F, const RwPar& Q) {
    unsigned char* const wsl = F.ws; const int lane = F.lane, fr = lane & 15, fq = lane >> 4;
    LAS float* yb = (LAS float*)(F.lds + F.wave * 16384);
    const bf16_t* gate = (const bf16_t*)(wsl + WS_GATE); const bf16_t* Eb = (const bf16_t*)(wsl + WS_E); bf16_t* cat = (bf16_t*)(wsl + WS_CAT);
    for (int u = F.gw; u < 96 * NCH; u += F.ngw) {
        const int bh = u % 96, c = u / 96, b = bh / 24, head = bh - b * 24, tokb = b * SEQ + c * CH;
        const bf16_t* qy = (const bf16_t*)(wsl + WS_QY) + (size_t)u * 4096; const float* y0t = (const float*)(wsl + WS_Y0T) + (size_t)u * 4096;
        f32x4 acc[4][4];
#pragma unroll
        for (int tt = 0; tt < 4; ++tt)
#pragma unroll
            for (int it = 0; it < 4; ++it) { const u32x2 yv = *(const GAS u32x2*)((const bf16_t*)y0t + (16 * it + fr) * 64 + 16 * tt + 4 * fq); acc[tt][it] = (f32x4){bflo(yv.x), bfhi(yv.x), bflo(yv.y), bfhi(yv.y)}; }
        if (c > 0) {
            const bf16_t* sp = (const bf16_t*)gh_ptr(wsl, bh, c - 1, 0) + 4096;
            bf16x8 Bf[4][2];
#pragma unroll
            for (int it = 0; it < 4; ++it)
#pragma unroll
                for (int ks = 0; ks < 2; ++ks) Bf[it][ks] = *(const GAS bf16x8*)(sp + (16 * it + fr) * 64 + 32 * ks + 8 * fq);
#pragma unroll
            for (int tt = 0; tt < 4; ++tt)
#pragma unroll
                for (int ks = 0; ks < 2; ++ks) { const bf16x8 Af = *(const GAS bf16x8*)(qy + (16 * tt + fr) * 64 + 32 * ks + 8 * fq);
#pragma unroll
                    for (int it = 0; it < 4; ++it) acc[tt][it] = __builtin_amdgcn_mfma_f32_16x16x32_bf16(Af, Bf[it][ks], acc[tt][it], 0, 0, 0); }
        }
#pragma unroll
        for (int tt = 0; tt < 4; ++tt)
#pragma unroll
            for (int it = 0; it < 4; ++it)
#pragma unroll
                for (int r = 0; r < 4; ++r) yb[(16 * tt + 4 * fq + r) * 64 + 16 * it + fr] = acc[tt][it][r];
        const int c4 = head * 64 + 4 * (lane & 15);
        const f32x4 g4 = *(const GAS f32x4*)(Q.gng + c4), b4 = *(const GAS f32x4*)(Q.gnb + c4);
        u32x2 evs[16], gts[16];
#pragma unroll
        for (int k = 0; k < 16; ++k) { const int tok = tokb + 4 * k + (lane >> 4); evs[k] = *(const GAS u32x2*)(Eb + (size_t)tok * CMIX + c4); gts[k] = *(const GAS u32x2*)(gate + (size_t)tok * CMIX + c4); }
        LDS_WAIT();
#pragma unroll
        for (int k = 0; k < 16; ++k) {
            const int slot = k * 64 + lane, t = slot >> 4, li = slot & 15, tok = tokb + t;
            const f32x4 y = *(const LAS f32x4*)(yb + t * 64 + 4 * li);
            const u32x2 ev = evs[k], gt = gts[k];
            const float mean = sum16(y.x + y.y + y.z + y.w) * (1.f / 64.f);
            const f32x4 d = y - mean;
            const float var = sum16(d.x * d.x + d.y * d.y + d.z * d.z + d.w * d.w) * (1.f / 64.f);
            const float rstd = rsqrtf(var + GN_EPS);
            f32x4 o = d * rstd * g4 + b4; o.x += bflo(ev.x); o.y += bfhi(ev.x); o.z += bflo(ev.y); o.w += bfhi(ev.y);
            u32x2 w; w.x = cvt_pk_bf16(o.x * bflo(gt.x), o.y * bfhi(gt.x)); w.y = cvt_pk_bf16(o.z * bflo(gt.y), o.w * bfhi(gt.y));
            *(GAS u32x2*)(cat + (size_t)tok * DM + c4) = w;
        }
        LDS_WAIT();
    }
}
DI void scan_passB(const Ctx& F) {
    unsigned char* const wsl = F.ws; const int lane = F.lane, fr = lane & 15, fq = lane >> 4, ih = F.wave >> 2, q = F.wave & 3, bh = F.bid;
    LAS unsigned char* Sx0 = F.lds;
    bf16x8 ga[7][2]; f32x4 hq[7][2];
#define PB_LOAD(set, cc) do { const GAS bf16_t* _gp = (const GAS bf16_t*)gh_ptr(wsl, bh, (cc), 0) + (16 * q + fr) * 64 + 8 * fq; const GAS float* _hp = (const GAS float*)(gh_ptr(wsl, bh, (cc), 1) + (32 * ih + fr) * 64 + 16 * q + 4 * fq); \
        ga[set][0] = *(const GAS bf16x8*)_gp; ga[set][1] = *(const GAS bf16x8*)(_gp + 32); \
        _Pragma("unroll") for (int _r = 0; _r < 2; ++_r) hq[set][_r] = *(const GAS f32x4*)(_hp + (16 * _r) * 64); } while (0)
    PB_LOAD(0, 0); PB_LOAD(1, 1); PB_LOAD(2, 2); PB_LOAD(3, 3); PB_LOAD(4, 4); PB_LOAD(5, 5);
    for (int c7 = 0; c7 < NCH - 1; c7 += 7) {
#pragma unroll
        for (int u7 = 0; u7 < 7; ++u7) {
            const int c = c7 + u7;
            f32x4 acc[2];
#pragma unroll
            for (int it = 0; it < 2; ++it) acc[it] = hq[u7][it];
            const bf16x8 a0 = ga[u7][0], a1 = ga[u7][1];
            PB_LOAD((u7 + 6) % 7, (c + 6 < NCH - 1) ? c + 6 : NCH - 2);
            if (c > 0) {
#pragma unroll
                for (int it = 0; it < 2; ++it) {
                    acc[it] = __builtin_amdgcn_mfma_f32_16x16x32_bf16(a0, *(const LAS bf16x8*)(Sx0 + (c & 1) * W_SLOT + (32 * ih + 16 * it + fr) * WRS + fq * 16), acc[it], 0, 0, 0);
                    acc[it] = __builtin_amdgcn_mfma_f32_16x16x32_bf16(a1, *(const LAS bf16x8*)(Sx0 + (c & 1) * W_SLOT + (32 * ih + 16 * it + fr) * WRS + 64 + fq * 16), acc[it], 0, 0, 0); }
            }
            GAS bf16_t* op = (GAS bf16_t*)gh_ptr(wsl, bh, c, 0) + 4096 + (32 * ih + fr) * 64 + 16 * q + 4 * fq;
#pragma unroll
            for (int it = 0; it < 2; ++it) { u32x2 w; w.x = cvt_pk_bf16(acc[it].x, acc[it].y); w.y = cvt_pk_bf16(acc[it].z, acc[it].w);
                *(GAS u32x2*)(op + (16 * it) * 64) = w; *(LAS u32x2*)(Sx0 + ((c + 1) & 1) * W_SLOT + (32 * ih + 16 * it + fr) * WRS + (16 * q + 4 * fq) * 2) = w; }
            LDS_BARRIER();
        }
    }
#undef PB_LOAD
}

DI void ln1_router(const Ctx& F, const Params& P, int l, const float* xin) {
    unsigned char* const wsl = F.ws; float* const outl = F.out; (void)outl;
    const float* g = PIN(5) + (size_t)l * DM; const float* bta = PIN(6) + (size_t)l * DM;
    const float* gb = PIN(10) + l * 4; const float* eb = PIN(12) + l * 32;
    const bf16_t* hb = (const bf16_t*)(wsl + WS_HB); bf16_t* xb = (bf16_t*)(wsl + WS_XB); float* xo = outl;
    const bf16_t* wrt = (const bf16_t*)(wsl + WS_WSW + (size_t)l * WSW_STRIDE);
    unsigned* cnt = (unsigned*)(wsl + WS_CTL) + CW_CNT + l * 32 * 64;
    int* ltok = (int*)(wsl + WS_LTOK); float* lgate = (float*)(wsl + WS_LGATE); int* lslot = (int*)(wsl + WS_LSLOT);
    const int lane = F.lane, fr = lane & 15, fq = lane >> 4, wave = F.wave;
    LAS float* lg = (LAS float*)(F.lds + (wave & 3) * 4096);
    LAS float* lgp = (LAS float*)(F.lds + 16384 + (wave & 3) * 4096);
    LAS int* cntl = (LAS int*)(F.lds + 32768); LAS int* basel = cntl + 32;
    if (F.tid < NEXP) cntl[F.tid] = 0;
    __syncthreads();
    LAS float* gls = (LAS float*)(F.lds + 36864 + 52224); LAS float* bls = gls + DM;
    for (int blk = F.bid; blk < NTOK / 64; blk += F.G) {
        { const f32x4 gv = *(const GAS f32x4*)(g + 4 * F.tid), bv = *(const GAS f32x4*)(bta + 4 * F.tid); *(LAS f32x4*)(gls + 4 * F.tid) = gv; *(LAS f32x4*)(bls + 4 * F.tid) = bv; }
        __syncthreads();
#pragma unroll 1
        for (int pass = 0; pass < 4; ++pass) {
            int lno = lane; asm volatile("" : "+v"(lno));
            const int hr2 = lno >> 5, l32 = lno & 31;
            const size_t ro = (size_t)(blk * 64 + wave * 8 + pass * 2 + hr2) * DM + 8 * l32;
            u32x4 xr[8], hr[8];
#pragma unroll
            for (int i = 0; i < 8; ++i) { xr[i] = *(const GAS u32x4*)(xb + ro + 256 * i); hr[i] = *(const GAS u32x4*)(hb + ro + 256 * i); }
            float s = 0.f, s2 = 0.f;
#pragma unroll
            for (int i = 0; i < 8; ++i) {
#pragma unroll
                for (int e = 0; e < 4; ++e) { const float v0 = ALPHA * bflo(xr[i][e]) + bflo(hr[i][e]), v1 = ALPHA * bfhi(xr[i][e]) + bfhi(hr[i][e]); s += v0 + v1; s2 += v0 * v0 + v1 * v1; } }
            s = sum16(s); s2 = sum16(s2); s += __shfl_xor(s, 16); s2 += __shfl_xor(s2, 16);
            const float mean = s * (1.f / DM), rstd = rsqrtf(fmaxf(s2 * (1.f / DM) - mean * mean, 0.f) + LN_EPS);
#pragma unroll
            for (int i = 0; i < 8; ++i) { const int col = 256 * i + 8 * l32;
                const f32x4 g0 = *(const LAS f32x4*)(gls + col), g1 = *(const LAS f32x4*)(gls + col + 4), b0 = *(const LAS f32x4*)(bls + col), b1 = *(const LAS f32x4*)(bls + col + 4);
                u32x4 w;
#pragma unroll
                for (int e = 0; e < 4; ++e) { const float v0 = ALPHA * bflo(xr[i][e]) + bflo(hr[i][e]), v1 = ALPHA * bfhi(xr[i][e]) + bfhi(hr[i][e]);
                    const float gg0 = e < 2 ? g0[2 * e] : g1[2 * e - 4], gg1 = e < 2 ? g0[2 * e + 1] : g1[2 * e - 3], bb0 = e < 2 ? b0[2 * e] : b1[2 * e - 4], bb1 = e < 2 ? b0[2 * e + 1] : b1[2 * e - 3];
                    w[e] = cvt_pk_bf16((v0 - mean) * rstd * gg0 + bb0, (v1 - mean) * rstd * gg1 + bb1); }
                *(GAS u32x4*)(xb + ro + 256 * i) = w;
                asm volatile("" ::: "memory"); }
        }
        VM_WAIT();
        __syncthreads();
        __builtin_amdgcn_fence(__ATOMIC_ACQUIRE, "agent");
        VM_WAIT();
        const int row0 = blk * 64 + (wave & 3) * 16, kh = wave >> 2, krot = (F.bid * 5 + wave * 3) & 31;
        f32x4 acc[3];
#pragma unroll
        for (int ct = 0; ct < 3; ++ct) acc[ct] = (f32x4){0.f, 0.f, 0.f, 0.f};
        const bf16_t* arow = xb + (size_t)(row0 + fr) * DM + 8 * fq + kh * 1024;
        LAS unsigned char* wst = F.lds + 36864;
        u32x4 wreg[6];
        { const int st = F.bid & 7;
#pragma unroll
          for (int i = 0; i < 6; ++i) { const int ch = F.tid + NT * i, row = ch >> 4, c16 = ch & 15, rkh = row / 96, rr = row - rkh * 96;
              wreg[i] = *(const GAS u32x4*)(wrt + (size_t)rr * DM + rkh * 1024 + st * 128 + c16 * 8); } }
#pragma unroll 1
        for (int si = 0; si < 8; ++si) {
            const int st = (si + F.bid) & 7;
            LAS unsigned char* wb = wst + (si & 1) * 52224;
#pragma unroll
            for (int i = 0; i < 6; ++i) { const int ch = F.tid + NT * i, row = ch >> 4, c16 = ch & 15; *(LAS u32x4*)(wb + row * 272 + c16 * 16) = wreg[i]; }
            if (si + 1 < 8) { const int stn = (si + 1 + F.bid) & 7;
#pragma unroll
                for (int i = 0; i < 6; ++i) { const int ch = F.tid + NT * i, row = ch >> 4, c16 = ch & 15, rkh = row / 96, rr = row - rkh * 96;
                    wreg[i] = *(const GAS u32x4*)(wrt + (size_t)rr * DM + rkh * 1024 + stn * 128 + c16 * 8); } }
            bf16x8 af[4];
#pragma unroll
            for (int ksl = 0; ksl < 4; ++ksl) af[ksl] = *(const GAS bf16x8*)(arow + st * 128 + ksl * 32);
            LDS_BARRIER();
#pragma unroll
            for (int ksl = 0; ksl < 4; ++ksl)
#pragma unroll
                for (int ct = 0; ct < 3; ++ct) {
                    acc[ct] = __builtin_amdgcn_mfma_f32_16x16x32_bf16(af[ksl], *(const LAS bf16x8*)(wb + (kh * 96 + 16 * ct + fr) * 272 + ksl * 64 + fq * 16), acc[ct], 0, 0, 0);
                    acc[ct] = __builtin_amdgcn_mfma_f32_16x16x32_bf16(af[ksl], *(const LAS bf16x8*)(wb + (kh * 96 + 48 + 16 * ct + fr) * 272 + ksl * 64 + fq * 16), acc[ct], 0, 0, 0);
                }
        }
        if (kh == 1) {
#pragma unroll
            for (int ct = 0; ct < 3; ++ct)
#pragma unroll
                for (int jj = 0; jj < 4; ++jj) lgp[(4 * fq + jj) * 48 + 16 * ct + fr] = acc[ct][jj];
        }
        __syncthreads();
        if (kh == 0) {
#pragma unroll
            for (int ct = 0; ct < 3; ++ct)
#pragma unroll
                for (int jj = 0; jj < 4; ++jj) lg[(4 * fq + jj) * 48 + 16 * ct + fr] = acc[ct][jj] + lgp[(4 * fq + jj) * 48 + 16 * ct + fr];
        }
        LDS_WAIT();
        int se0 = 0, se1 = 0, sr0 = 0, sr1 = 0, stok = 0; float sg0 = 0.f, sg1 = 0.f;
        if (kh == 0 && lane < 16) {
            const LAS float* L = lg + lane * 48; const int tok = row0 + lane;
            float gl[4]; int grp_i = 0; float gmx;
#pragma unroll
            for (int q = 0; q < 4; ++q) gl[q] = L[q] + gb[q];
            gmx = gl[0];
#pragma unroll
            for (int q = 1; q < 4; ++q) if (gl[q] > gmx) { gmx = gl[q]; grp_i = q; }
            float gs = 0.f;
#pragma unroll
            for (int q = 0; q < 4; ++q) gs += __expf(gl[q] - gmx);
            const float pg = 1.f / gs;
            float el[8];
#pragma unroll
            for (int q = 0; q < 8; ++q) el[q] = L[4 + 8 * grp_i + q] + eb[8 * grp_i + q];
            int i0 = 0; float m0 = el[0];
#pragma unroll
            for (int q = 1; q < 8; ++q) if (el[q] > m0) { m0 = el[q]; i0 = q; }
            int i1 = -1; float m1 = -3.0e38f;
#pragma unroll
            for (int q = 0; q < 8; ++q) if (q != i0 && el[q] > m1) { m1 = el[q]; i1 = q; }
            if (i1 < 0) { i1 = (i0 == 0) ? 1 : 0; m1 = m0; }
            const float p1 = __expf(m1 - m0), den = 1.f / (1.f + p1);
            const float g0 = pg * den, g1 = pg * p1 * den;
            se0 = grp_i * 8 + i0; se1 = grp_i * 8 + i1; sg0 = g0; sg1 = g1; stok = tok;
            sr0 = __hip_atomic_fetch_add(cntl + se0, 1, __ATOMIC_RELAXED, __HIP_MEMORY_SCOPE_WORKGROUP);
            sr1 = __hip_atomic_fetch_add(cntl + se1, 1, __ATOMIC_RELAXED, __HIP_MEMORY_SCOPE_WORKGROUP);
        }
        __syncthreads();
        if (wave == 0 && lane < NEXP) { const int n = cntl[lane]; basel[lane] = n ? (int)__hip_atomic_fetch_add(cnt + lane * 64, (unsigned)n, __ATOMIC_RELAXED, __HIP_MEMORY_SCOPE_AGENT) : 0; }
        __syncthreads();
        if (kh == 0 && lane < 16) {
            const int pos0 = basel[se0] + sr0, pos1 = basel[se1] + sr1;
            ltok[se0 * LISTCAP + pos0] = stok; lgate[se0 * LISTCAP + pos0] = sg0; lslot[se0 * LISTCAP + pos0] = 2 * stok;
            ltok[se1 * LISTCAP + pos1] = stok; lgate[se1 * LISTCAP + pos1] = sg1; lslot[se1 * LISTCAP + pos1] = 2 * stok + 1;
        }
        __syncthreads();
        if (F.tid < NEXP) cntl[F.tid] = 0;
        __syncthreads();
    }
}

DI void ln2_phase(const Ctx& F, const Params& P, int l) {
    unsigned char* const wsl = F.ws; float* const outl = F.out;
    const float* g = PIN(7) + (size_t)l * DM; const float* bta = PIN(8) + (size_t)l * DM;
    const bf16_t* ys = (const bf16_t*)(wsl + WS_YS); bf16_t* xb = (bf16_t*)(wsl + WS_XB); float* xo = outl;
    LAS float* gls = (LAS float*)F.lds; LAS float* bls = gls + DM;
    { const f32x4 gv = *(const GAS f32x4*)(g + 4 * F.tid), bv = *(const GAS f32x4*)(bta + 4 * F.tid); *(LAS f32x4*)(gls + 4 * F.tid) = gv; *(LAS f32x4*)(bls + 4 * F.tid) = bv; }
    __syncthreads();
#pragma unroll 1
    for (int rp = F.gw; rp < NTOK / 2; rp += F.ngw) {
        int lno = F.lane; asm volatile("" : "+v"(lno));
        const int hr2 = lno >> 5, l32 = lno & 31, row = 2 * rp + hr2;
        const size_t ro = (size_t)row * DM + 8 * l32;
        u32x4 xr[8], y0[8], y1[8];
#pragma unroll
        for (int i = 0; i < 8; ++i) { xr[i] = *(const GAS u32x4*)(xb + ro + 256 * i); y0[i] = *(const GAS u32x4*)(ys + 2 * (size_t)row * DM + 8 * l32 + 256 * i); y1[i] = *(const GAS u32x4*)(ys + (2 * (size_t)row + 1) * DM + 8 * l32 + 256 * i); }
        float s = 0.f, s2 = 0.f;
#pragma unroll
        for (int i = 0; i < 8; ++i) {
#pragma unroll
            for (int e = 0; e < 4; ++e) { const float v0 = ALPHA * bflo(xr[i][e]) + (bflo(y0[i][e]) + bflo(y1[i][e])), v1 = ALPHA * bfhi(xr[i][e]) + (bfhi(y0[i][e]) + bfhi(y1[i][e])); s += v0 + v1; s2 += v0 * v0 + v1 * v1; } }
        s = sum16(s); s2 = sum16(s2); s += __shfl_xor(s, 16); s2 += __shfl_xor(s2, 16);
        const float mean = s * (1.f / DM), rstd = rsqrtf(fmaxf(s2 * (1.f / DM) - mean * mean, 0.f) + LN_EPS);
#pragma unroll
        for (int i = 0; i < 8; ++i) { const int col = 256 * i + 8 * l32;
            const f32x4 g0 = *(const LAS f32x4*)(gls + col), g1 = *(const LAS f32x4*)(gls + col + 4), b0 = *(const LAS f32x4*)(bls + col), b1 = *(const LAS f32x4*)(bls + col + 4);
            float o[8];
#pragma unroll
            for (int e = 0; e < 4; ++e) { const float v0 = ALPHA * bflo(xr[i][e]) + (bflo(y0[i][e]) + bflo(y1[i][e])), v1 = ALPHA * bfhi(xr[i][e]) + (bfhi(y0[i][e]) + bfhi(y1[i][e]));
                const float gg0 = e < 2 ? g0[2 * e] : g1[2 * e - 4], gg1 = e < 2 ? g0[2 * e + 1] : g1[2 * e - 3], bb0 = e < 2 ? b0[2 * e] : b1[2 * e - 4], bb1 = e < 2 ? b0[2 * e + 1] : b1[2 * e - 3];
                o[2 * e] = (v0 - mean) * rstd * gg0 + bb0; o[2 * e + 1] = (v1 - mean) * rstd * gg1 + bb1; }
            if (l == NLAYER - 1) { *(GAS f32x4*)(xo + (size_t)row * DM + col) = (f32x4){o[0], o[1], o[2], o[3]}; *(GAS f32x4*)(xo + (size_t)row * DM + col + 4) = (f32x4){o[4], o[5], o[6], o[7]}; }
            else { u32x4 w; w.x = cvt_pk_bf16(o[0], o[1]); w.y = cvt_pk_bf16(o[2], o[3]); w.z = cvt_pk_bf16(o[4], o[5]); w.w = cvt_pk_bf16(o[6], o[7]); *(GAS u32x4*)(xb + ro + 256 * i) = w; }
            asm volatile("" ::: "memory"); }
    }
}

DI int moe_table(const Ctx& F, int l) {
    unsigned char* const wsl = F.ws; float* const outl = F.out; (void)outl;
    LAS int* tb = (LAS int*)(F.lds + LDS_CTL_OFF) + 16;
    const unsigned* cnt = (const unsigned*)(wsl + WS_CTL) + CW_CNT + l * 32 * 64;
    __syncthreads();
    if (F.tid == 0) { int acc = 0;
        for (int e = 0; e < NEXP; ++e) { tb[e] = acc; const int n = (int)__hip_atomic_load(cnt + e * 64, __ATOMIC_RELAXED, __HIP_MEMORY_SCOPE_AGENT); acc += (n + 255) >> 8; }
        tb[NEXP] = acc; }
    __syncthreads();
    return tb[NEXP];
}


#ifdef MK_DEBUG
constexpr int CW_DBG = 40960;
DI void dbg_count_bf16(const Ctx& F, const bf16_t* p, size_t n, int k) {
    unsigned bad = 0; const size_t gt = (size_t)F.bid * NT + F.tid, ngt = (size_t)F.G * NT;
    for (size_t i = gt; i < n; i += ngt) { const unsigned b = p[i]; const float v = bf2f(b); if ((b & 0x7f80u) == 0x7f80u || fabsf(v) > 1.0e6f) ++bad; }
    if (bad) atomicAdd((unsigned*)(F.ws + WS_CTL) + CW_DBG + k * 64, bad);
}
DI void dbg_count_f32(const Ctx& F, const float* p, size_t n, int k) {
    unsigned bad = 0; const size_t gt = (size_t)F.bid * NT + F.tid, ngt = (size_t)F.G * NT;
    for (size_t i = gt; i < n; i += ngt) { const float v = p[i]; if (!(fabsf(v) <= 1.0e6f)) ++bad; }
    if (bad) atomicAdd((unsigned*)(F.ws + WS_CTL) + CW_DBG + k * 64, bad);
}
#endif
constexpr int PH_PER_LAYER = 11, N_PHASES = 1 + NLAYER * PH_PER_LAYER;

__global__ void __launch_bounds__(NT, 2) mega_fwd(Params P) {
    extern __shared__ __attribute__((aligned(16))) unsigned char lds_raw[];
    Ctx F0;
    F0.lds = (LAS unsigned char*)lds_raw;
    F0.tid = threadIdx.x; F0.lane = F0.tid & 63; F0.wave = __builtin_amdgcn_readfirstlane(F0.tid >> 6);
    F0.G = gridDim.x; F0.bid = blockIdx.x; F0.gw = F0.bid * NWAVES + F0.wave; F0.ngw = F0.G * NWAVES;
    F0.ws = P.ws; F0.out = P.out;
    for (int u = F0.tid; u < (LDS_BYTES - LDS_CTL_OFF) / 4; u += NT) ((LAS unsigned*)(F0.lds + LDS_CTL_OFF))[u] = 0u;
    __syncthreads();
    XcdBarrier bar; bar.bar = (unsigned*)(F0.ws + WS_CTL) + CW_BAR; bar.x = 0; bar.st = nullptr;
#if !MK_PER_PHASE
    bar = xcd_barrier_post((unsigned*)(F0.ws + WS_CTL) + CW_BAR, (volatile LAS unsigned*)(F0.lds + LDS_CTL_OFF));
#endif
    const int lo = P.ph_lo, hi = P.ph_hi;
#define IN(k) (lo <= (k) && (k) < hi)
#if MK_PER_PHASE
#define SEAM(k) do { } while (0)
#else
#define SEAM(k) do { if ((k) + 1 < hi) { XcdBarrier _b = bar; asm volatile("" : "+s"(_b.bar), "+s"(_b.x)); xcd_barrier(_b); } } while (0)
#endif
#define WSL const Ctx F = relaunder(F0); unsigned char* const ws = F.ws; bf16_t* const xb = (bf16_t*)(ws + WS_XB); bf16_t* const zb = (bf16_t*)(ws + WS_Z); bf16_t* const cat = (bf16_t*)(ws + WS_CAT); (void)xb; (void)zb; (void)cat

    if (IN(0)) { WSL; phase_prologue(F, P); SEAM(0); }

    for (int l = 0; l < NLAYER; ++l) {
        const int kind = l % 3, j = l / 3, pb = 1 + l * PH_PER_LAYER;
        const int zw = (kind == 0) ? ZW_RWKV : ZW_OTH, qcol = (kind == 0) ? 5056 : 4608;
        if (IN(pb + 0)) {
            WSL; const bf16_t* winT = (const bf16_t*)(ws + WS_WIN + (size_t)l * WIN_STRIDE);
            if (kind != 2) dense_gemm(F, xb, DM, winT, DM, NTOK, zw, DM, zb, zw, 0);
            else {
                dense_gemm(F, xb, DM, winT, DM, NTOK, 3072, DM, zb, zw, 0);
                dense_gemm(F, xb, DM, winT + (size_t)4608 * DM, DM, NTOK, 512, DM, zb + 4608, zw, 0);
                dense_gemm(F, winT + (size_t)3072 * DM, DM, xb, DM, CMIX, NTOK, DM, (bf16_t*)(ws + WS_ACT), NTOK, 128);
            }
            if (l == 0) {
                dense_gemm(F, (const bf16_t*)(ws + WS_MEMB), DM, (const bf16_t*)(ws + WS_WK), DM, NBATCH * MEML, 2048, DM, (bf16_t*)(ws + WS_KM), 2048, 128);
                dense_gemm(F, (const bf16_t*)(ws + WS_WV), DM, (const bf16_t*)(ws + WS_MEMB), DM, 2048, NBATCH * MEML, DM, (bf16_t*)(ws + WS_VMT), 1024, 192);
            }
            SEAM(pb + 0);
        }
        if (IN(pb + 1)) {
            WSL;
            if (kind == 0) { for (int rep = 0; rep < REP_PREP; ++rep) rwkv_prep1(F, P, j, zb); for (int rep = 0; rep < REP_MIX * REP_MA; ++rep) memattn_all(F, l, zb, zw, qcol); }
            else if (kind == 1) { for (int rep = 0; rep < REP_MIX; ++rep) conv_mix(F, P, zb); for (int rep = 0; rep < REP_MIX * REP_MA; ++rep) memattn_all(F, l, zb, zw, qcol); for (int rep = 0; rep < REP_CONV; ++rep) expert_convert(F, P, l, F.gw, F.ngw); }
            else { for (int rep = 0; rep < REP_MIX * REP_SB; ++rep) sb_attention(F, zb); for (int rep = 0; rep < REP_MIX * REP_MA; ++rep) memattn_all(F, l, zb, zw, qcol); for (int rep = 0; rep < REP_CONV; ++rep) expert_convert(F, P, l, F.gw, F.ngw); }
            SEAM(pb + 1);
        }
        if (kind == 0) {
            if (IN(pb + 2)) {
                WSL; const bf16_t* act = (const bf16_t*)(ws + WS_ACT); const bf16_t* wa = (const bf16_t*)(ws + WS_LORA + (size_t)j * LORA_STRIDE);
                dense_gemm(F, act, 512, wa, 256, NTOK, 3072, 256, (bf16_t*)(ws + WS_LW), 3072, 0);
                dense_gemm(F, act + 256, 512, wa + (size_t)3072 * 256, 256, NTOK, CMIX, 256, (bf16_t*)(ws + WS_GATE), CMIX, 0);
                SEAM(pb + 2);
            }
            if (IN(pb + 3)) { WSL; const RwPar Q{PIN(17) + (size_t)j * 5056, PIN(18) + j * CMIX, PIN(20) + j * CMIX, PIN(23) + j * CMIX, PIN(24) + j * CMIX, PIN(25) + j * CMIX, PIN(26) + j * CMIX, PIN(27) + j * CMIX};
                for (int rep = 0; rep < REP_SCAN; ++rep) scan_w1(F, Q, zb); SEAM(pb + 3); }
            if (IN(pb + 4)) {
                WSL;
                if (F.bid < 96) scan_passB(F);
                else expert_convert(F, P, l, (F.bid - 96) * NWAVES + F.wave, (F.G - 96) * NWAVES);
                SEAM(pb + 4);
            }
            if (IN(pb + 5)) { WSL; const RwPar Q{PIN(17) + (size_t)j * 5056, PIN(18) + j * CMIX, PIN(20) + j * CMIX, PIN(23) + j * CMIX, PIN(24) + j * CMIX, PIN(25) + j * CMIX, PIN(26) + j * CMIX, PIN(27) + j * CMIX};
                for (int rep = 0; rep < REP_SCAN * REP_W2; ++rep) scan_w2(F, Q); SEAM(pb + 5); }
        }
        if (IN(pb + 6)) { WSL; dense_gemm(F, cat, DM, (const bf16_t*)(ws + WS_WOUT) + (size_t)l * DM * DM, DM, NTOK, DM, DM, (bf16_t*)(ws + WS_HB), DM, 0); SEAM(pb + 6); }
        if (IN(pb + 7)) { WSL; ln1_router(F, P, l, l == 0 ? PIN(0) : (const float*)P.out); SEAM(pb + 7); }
        if (IN(pb + 8)) {
            WSL; const int ntiles = moe_table(F, l);
            pg8::Gemm g{xb, (const bf16_t*)(ws + WS_EXP1), DM, DM, DM};
            pg8::MoeOrder<true> S; S.G = F.G; S.c = F.bid; S.npn = 4; S.total = ntiles * 4; S.tb = (const LAS int*)(F.lds + LDS_CTL_OFF) + 16; S.estride = (size_t)1024 * DM * 2;
            S.ltok = (const int*)(ws + WS_LTOK); S.cnt = (const unsigned*)(ws + WS_CTL) + CW_CNT + l * 32 * 64;
            pg8::EpiSwiGLU E{(bf16_t*)(ws + WS_HE)};
            for (int rep = 0; rep < REP_MOE; ++rep) pg8::gemm_phase<pg8::EpiSwiGLU, pg8::MoeOrder<true>>(F.lds, g, S, E);
            SEAM(pb + 8);
        }
        if (IN(pb + 9)) {
            WSL; const int ntiles = moe_table(F, l);
            pg8::Gemm g{(const bf16_t*)(ws + WS_HE), (const bf16_t*)(ws + WS_EXP2), DEXP, DEXP, DEXP};
            pg8::MoeOrder<false> S; S.G = F.G; S.c = F.bid; S.npn = 8; S.total = ntiles * 8; S.tb = (const LAS int*)(F.lds + LDS_CTL_OFF) + 16; S.estride = (size_t)DM * DEXP * 2;
            S.ltok = (const int*)(ws + WS_LTOK); S.cnt = (const unsigned*)(ws + WS_CTL) + CW_CNT + l * 32 * 64;
            pg8::EpiScatter E{(bf16_t*)(ws + WS_YS), (const int*)(ws + WS_LSLOT), (const float*)(ws + WS_LGATE), S.cnt};
            for (int rep = 0; rep < REP_MOE; ++rep) pg8::gemm_phase<pg8::EpiScatter, pg8::MoeOrder<false>>(F.lds, g, S, E);
            SEAM(pb + 9);
        }
        if (IN(pb + 10)) { WSL; ln2_phase(F, P, l); SEAM(pb + 10); }
    }
#ifdef MK_DEBUG
    {
        WSL;
        xcd_barrier(bar);
        dbg_count_bf16(F, (const bf16_t*)(ws + WS_CAT), (size_t)NTOK * DM, 0);
        dbg_count_bf16(F, (const bf16_t*)(ws + WS_HB), (size_t)NTOK * DM, 1);
        dbg_count_f32(F, (const float*)(ws + WS_LGATE), (size_t)32 * 16384, 2);
        dbg_count_bf16(F, (const bf16_t*)(ws + WS_YS), (size_t)32768 * 2048, 3);
        dbg_count_f32(F, (const float*)F.out, (size_t)NTOK * DM, 4);
        dbg_count_bf16(F, (const bf16_t*)(ws + WS_XB), (size_t)NTOK * DM, 5);
        xcd_barrier(bar);
        int first = 13;
        for (int k = 12; k >= 0; --k) if (__hip_atomic_load((unsigned*)(ws + WS_CTL) + CW_DBG + k * 64, __ATOMIC_RELAXED, __HIP_MEMORY_SCOPE_AGENT) != 0u) first = k;
        const float val = 1000.f * (float)(first + 1);
        for (size_t i = (size_t)F.bid * NT + F.tid; i < (size_t)NTOK * DM; i += (size_t)F.G * NT) F.out[i] = val;
    }
#endif
#undef IN
#undef SEAM
}

extern "C" void kernel_launch(void* const* d_in, const int* in_sizes, int n_in, void* d_out, int out_size, void* d_ws, size_t ws_size, hipStream_t stream) {
    static int grid = 0;
    if (grid == 0) {
        if (n_in != 31 || ws_size < WS_END) { fprintf(stderr, "kernel_launch: expected 31 inputs and >= %zu bytes of workspace, got %d / %zu\n", (size_t)WS_END, n_in, ws_size); grid = -1; return; }
        int dev = 0, cus = 0, per_cu = 0;
        if (hipGetDevice(&dev) != hipSuccess || hipDeviceGetAttribute(&cus, hipDeviceAttributeMultiprocessorCount, dev) != hipSuccess) { grid = -1; return; }
        if (hipFuncSetAttribute((const void*)mega_fwd, hipFuncAttributeMaxDynamicSharedMemorySize, LDS_BYTES) != hipSuccess) { fprintf(stderr, "kernel_launch: hipFuncSetAttribute failed\n"); grid = -1; return; }
        if (hipOccupancyMaxActiveBlocksPerMultiprocessor(&per_cu, (const void*)mega_fwd, NT, LDS_BYTES) != hipSuccess || per_cu < 1)
            fprintf(stderr, "kernel_launch: occupancy query reports %d workgroups per CU\n", per_cu);
        (void)hipGetLastError();
        grid = cus;
    }
    if (grid < 0) return;
    (void)hipMemsetAsync((char*)d_ws + WS_CTL, 0, CTL_BYTES, stream);
    Params p{};
    for (int i = 0; i < 31; ++i) p.in[i] = (const float*)d_in[i];
    p.out = (float*)d_out; p.ws = (unsigned char*)d_ws;
#if MK_PER_PHASE
    for (int ph = 0; ph < N_PHASES; ++ph) {
        if (ph > 0) { const int l = (ph - 1) / PH_PER_LAYER, loc = (ph - 1) % PH_PER_LAYER; if ((l % 3) != 0 && loc >= 2 && loc <= 5) continue; }
        p.ph_lo = ph; p.ph_hi = ph + 1;
        hipLaunchKernelGGL(mega_fwd, dim3(grid), dim3(NT), LDS_BYTES, stream, p);
    }
#else
#ifndef MK_PH_HI
#define MK_PH_HI N_PHASES
#endif
    p.ph_lo = 0; p.ph_hi = MK_PH_HI;
    hipLaunchKernelGGL(mega_fwd, dim3(grid), dim3(NT), LDS_BYTES, stream, p);
#endif
    const hipError_t le = hipPeekAtLastError();
    if (le != hipSuccess) fprintf(stderr, "kernel_launch: launch failed: %s\n", hipGetErrorName(le));
}
```

```cpp
#include <hip/hip_runtime.h>
#include <cstdio>
#include <cstdint>

#ifndef MK_PER_PHASE
#define MK_PER_PHASE 0
#endif
#ifndef MK_PH_HI
#define MK_PH_HI N_PHASES
#endif
#ifndef REP_GEMM
#define REP_GEMM 1
#endif
#ifndef REP_MOE
#define REP_MOE 1
#endif
#ifndef REP_SCAN
#define REP_SCAN 1
#endif
#ifndef REP_PREP
#define REP_PREP 1
#endif
#ifndef REP_MIX
#define REP_MIX 1
#endif
#ifndef REP_CONV
#define REP_CONV 1
#endif
#ifndef REP_SB
#define REP_SB 1
#endif
#ifndef REP_MA
#define REP_MA 1
#endif
#ifndef REP_WX
#define REP_WX 1
#endif
#ifndef REP_WS
#define REP_WS 1
#endif
#ifndef REP_WO
#define REP_WO 1
#endif
#ifndef REP_W2
#define REP_W2 1
#endif

#define LAS __attribute__((address_space(3)))
#define GAS __attribute__((address_space(1)))
#define DI __device__ __forceinline__
typedef unsigned short bf16_t;
typedef short bf16x8 __attribute__((ext_vector_type(8)));
typedef short s16x4 __attribute__((ext_vector_type(4)));
typedef float f32x2 __attribute__((ext_vector_type(2)));
typedef float f32x4 __attribute__((ext_vector_type(4)));
typedef float f32x8 __attribute__((ext_vector_type(8)));
typedef float f32x16 __attribute__((ext_vector_type(16)));
typedef unsigned u32x2 __attribute__((ext_vector_type(2)));
typedef unsigned u32x4 __attribute__((ext_vector_type(4)));

constexpr int NTOK = 16384, DM = 2048, SEQ = 4096, NBATCH = 4, CMIX = 1536, MEMW = 512, MEML = 256, NLAYER = 4;
constexpr int ZW_RWKV = 5632  , ZW_OTH = 5120, RW_IN_COLS = 5568;
constexpr int NEXP = 32, DEXP = 512, LISTCAP = 16384, MAXTILES = 160;
constexpr float LN_EPS = 1e-5f, ALPHA = 1.681792830507429f, GN_EPS = 64e-5f;
constexpr int NT = 512, NWAVES = 8;

constexpr size_t MiB = (size_t)1 << 20;
constexpr size_t WS_CTL = 0, CTL_BYTES = 1 * MiB;
constexpr size_t WS_WIN = 2 * MiB;
constexpr size_t WIN_STRIDE = 22 * MiB;
constexpr size_t WS_WOUT = 90 * MiB;
constexpr size_t WS_WK = 122 * MiB;
constexpr size_t WS_WV = 130 * MiB;
constexpr size_t WS_MEMB = 138 * MiB;
constexpr size_t WS_KM = 142 * MiB;
constexpr size_t WS_VMT = 146 * MiB;
constexpr size_t WS_LORA = 150 * MiB;
constexpr size_t LORA_STRIDE = 3 * MiB;
constexpr size_t WS_WSW = 156 * MiB;
constexpr size_t WSW_STRIDE = 393216;
constexpr size_t WS_EXP1 = 160 * MiB;
constexpr size_t WS_EXP2 = 288 * MiB;
constexpr size_t WS_XB = 352 * MiB;
constexpr size_t WS_Z = 416 * MiB;
constexpr size_t WS_CAT = 592 * MiB;
constexpr size_t WS_HB = 656 * MiB;
constexpr size_t WS_LTOK = 720 * MiB;
constexpr size_t WS_LGATE = 722 * MiB;
constexpr size_t WS_LSLOT = 724 * MiB;
constexpr size_t WS_HE = 728 * MiB;
constexpr size_t WS_YS = 768 * MiB;
constexpr size_t WS_ACT = 896 * MiB;
constexpr size_t WS_LW = 944 * MiB;
constexpr size_t WS_GATE = 1040 * MiB;
constexpr size_t WS_SCAN = 1088 * MiB;
constexpr size_t WS_V = 1568 * MiB;
constexpr size_t WS_Y = 1664 * MiB;
constexpr size_t WS_GH = 1760 * MiB;
constexpr size_t WS_QY = 1088 * MiB;
constexpr size_t WS_Y0T = 1152 * MiB;
constexpr size_t WS_E = 1280 * MiB;
constexpr size_t WS_END = 1952 * MiB;
constexpr int CW_BAR = 4096;
constexpr int CW_CNT = 16384;

constexpr int LDS_BYTES = 147456;
constexpr int LDS_CTL_OFF = 146432;

DI float bf2f(unsigned b) { return __uint_as_float(b << 16); }
typedef float cvt_f32x2 __attribute__((ext_vector_type(2)));
typedef __bf16 cvt_bf16x2 __attribute__((ext_vector_type(2)));
DI unsigned cvt_pk_bf16(float lo, float hi) { const cvt_f32x2 v = {lo, hi}; return __builtin_bit_cast(unsigned, __builtin_convertvector(v, cvt_bf16x2)); }
DI float bflo(unsigned w) { return __uint_as_float(w << 16); }
DI float bfhi(unsigned w) { return __uint_as_float(w & 0xffff0000u); }
DI float wave_sum(float v) {
#pragma unroll
    for (int o = 1; o < 64; o <<= 1) v += __shfl_xor(v, o);
    return v;
}
DI float sum16(float v) {
    v += __builtin_bit_cast(float, __builtin_amdgcn_update_dpp(0, __builtin_bit_cast(int, v), 0x128, 0xf, 0xf, false));
    v += __builtin_bit_cast(float, __builtin_amdgcn_update_dpp(0, __builtin_bit_cast(int, v), 0x124, 0xf, 0xf, false));
    v += __builtin_bit_cast(float, __builtin_amdgcn_update_dpp(0, __builtin_bit_cast(int, v), 0x122, 0xf, 0xf, false));
    v += __builtin_bit_cast(float, __builtin_amdgcn_update_dpp(0, __builtin_bit_cast(int, v), 0x121, 0xf, 0xf, false));
    return v;
}
DI float fma_s(float a, float b, float c) { float d; asm("v_fma_f32 %0, %1, %2, %3" : "=v"(d) : "v"(a), "v"(b), "v"(c)); return d; }
DI float sigmoidf_(float x) { return __builtin_amdgcn_rcpf(1.f + __expf(-x)); }
DI float softplusf_(float x) { return fmaxf(x, 0.f) + __logf(1.f + __expf(-fabsf(x))); }
#define LDS_WAIT() asm volatile("s_waitcnt lgkmcnt(0)" ::: "memory")
#define VM_WAIT() asm volatile("s_waitcnt vmcnt(0)" ::: "memory")
#define LDS_BARRIER() do { asm volatile("s_waitcnt lgkmcnt(0)" ::: "memory"); __builtin_amdgcn_s_barrier(); asm volatile("" ::: "memory"); } while (0)

template <class T> DI T* as_global(T* p) { return p; }
DI const float* kin_ptr(int i) { int off = i * 8; asm volatile("" : "+v"(off)); const char* ka = (const char*)__builtin_amdgcn_kernarg_segment_ptr();
    const unsigned long long p = *(const unsigned long long*)(ka + off);
    const unsigned lo = __builtin_amdgcn_readfirstlane((unsigned)p), hi = __builtin_amdgcn_readfirstlane((unsigned)(p >> 32));
    return as_global((const float*)(((unsigned long long)hi << 32) | lo)); }
#define PIN(i) kin_ptr(i)
DI unsigned char* opq(unsigned char* p) { asm volatile("" : "+s"(p)); return p; }
DI float* opqf(float* p) { asm volatile("" : "+s"(p)); return p; }

#define XB_TMO      128
#define XB_XCNT(j)  (256  + 64 * (j))
#define XB_XSUB(j)  (1280 + 64 * (j))
#define XB_XGEN(j)  (2304 + 64 * (j))
#define XB_TOP      3328
#define XB_TOPGEN   3392
#define XCD_BAR_WORDS 3456
#define XB_SPIN_CAP (1u << 20)

__device__ __forceinline__ unsigned xb_ld(unsigned* p)              { return __hip_atomic_load(p, __ATOMIC_RELAXED, __HIP_MEMORY_SCOPE_AGENT); }
__device__ __forceinline__ unsigned xb_add(unsigned* p, unsigned v) { return __hip_atomic_fetch_add(p, v, __ATOMIC_RELAXED, __HIP_MEMORY_SCOPE_AGENT); }
__device__ __forceinline__ unsigned xb_xcc_id() { return (unsigned)__builtin_amdgcn_s_getreg((3 << 11) | 20) & 0xFu; }
#define XB_SPIN(cond, bar) do { unsigned _sp = 0; while (cond) { __builtin_amdgcn_s_sleep(1); \
    if ((++_sp & 255u) == 0u) { if (xb_ld(&(bar)[XB_TMO])) break; if (_sp > XB_SPIN_CAP) { atomicAdd(&(bar)[XB_TMO], 1u); break; } } } } while (0)

struct XcdBarrier { unsigned* bar; unsigned x; volatile LAS unsigned* st; };

__device__ __forceinline__ XcdBarrier xcd_barrier_post(unsigned* bar, volatile LAS unsigned* st) {
    XcdBarrier b; b.bar = bar; b.x = xb_xcc_id(); b.st = st;
    if (threadIdx.x == 0) (void)xb_add(&bar[XB_XCNT(b.x)], 1u);
    return b;
}
__device__ __forceinline__ void xcd_barrier_complete(unsigned* bar, unsigned x, unsigned& nloc, unsigned& nx) {
    const unsigned G = gridDim.x * gridDim.y * gridDim.z;
    unsigned sum, cnt, mine, sp = 0u;
    for (;;) {
        sum = 0u; cnt = 0u; mine = 0u;
#pragma unroll
        for (unsigned j = 0; j < 16; ++j) { const unsigned c = xb_ld(&bar[XB_XCNT(j)]); sum += c; cnt += (c > 0u) ? 1u : 0u; mine = (j == x) ? c : mine; }
        if (sum == G) break;
        __builtin_amdgcn_s_sleep(1);
        if ((++sp & 255u) == 0u) { if (xb_ld(&bar[XB_TMO])) break; if (sp > XB_SPIN_CAP) { atomicAdd(&bar[XB_TMO], 1u); break; } }
    }
    nloc = mine > 0u ? mine : 1u; nx = cnt > 0u ? cnt : 1u;
}
__device__ __forceinline__ void xcd_barrier(const XcdBarrier& b) {
    asm volatile("s_waitcnt vmcnt(0)" ::: "memory");
    __syncthreads();
    if (threadIdx.x == 0) {
        unsigned* bar = b.bar;
        __builtin_amdgcn_s_waitcnt(0);
        unsigned nloc = b.st[0], nx = b.st[1];
        if (nloc == 0u) { xcd_barrier_complete(bar, b.x, nloc, nx); b.st[0] = nloc; b.st[1] = nx; }
        const unsigned old = xb_add(&bar[XB_XSUB(b.x)], 1u);
        const unsigned gen = old / nloc;
        if (old + 1u == (gen + 1u) * nloc) {
            __builtin_amdgcn_fence(__ATOMIC_RELEASE, "agent");
            asm volatile("s_waitcnt vmcnt(0)" ::: "memory");
            const unsigned og = xb_add(&bar[XB_TOP], 1u);
            const unsigned tg = og / nx;
            if (og + 1u == (tg + 1u) * nx) xb_add(&bar[XB_TOPGEN], 1u);
            else XB_SPIN(xb_ld(&bar[XB_TOPGEN]) == tg, bar);
            __builtin_amdgcn_fence(__ATOMIC_ACQUIRE, "agent");
            xb_add(&bar[XB_XGEN(b.x)], 1u);
            asm volatile("s_waitcnt vmcnt(0)" ::: "memory");
        } else {
            XB_SPIN(xb_ld(&bar[XB_XGEN(b.x)]) == gen, bar);
            __builtin_amdgcn_fence(__ATOMIC_ACQUIRE, "agent");
            asm volatile("s_waitcnt vmcnt(0)" ::: "memory");
        }
    }
    __syncthreads();
}

namespace pg8 {
constexpr int BM = 256, BK = 64, HALF = 128, HTB = HALF * BK * 2, STAGE_BYTES = 8 * HTB, NXCD = 8, WGM = 8;
DI int lds_byte(int r, int c) { const int st = (r >> 4) * 2 + (c >> 5), rr = r & 15, cc = c & 31, ob = rr * 64 + cc * 2; return st * 1024 + (ob ^ (((ob >> 9) & 1) << 5)); }
DI void stage_rc(int b, int& R, int& C) { const int st = b / 1024, sb = b % 1024, swz = sb ^ (((sb >> 9) & 1) << 5); R = (st >> 1) * 16 + swz / 64; C = (st & 1) * 32 + (swz % 64) / 2; }
DI int perm32(int rho) { const int n = rho >> 4, i = rho & 15; return 8 * (i >> 2) + 4 * n + (i & 3); }

struct Unit { int pm, pn, e, rt; };
struct Gemm { const bf16_t* A; const bf16_t* Bt; int lda, ldb, K; };

struct StaticOrder {
    static constexpr bool GATHER = false;
    int nM, nN, nwg, G, c;
    DI void init(int M, int N, int G_, int c_) { nM = M / BM; nN = N / BM; nwg = nM * nN; G = G_; c = c_; }
    DI bool next(int i, Unit& u) const {
        const long L = (long)i * G + c; if (L >= nwg) return false;
        int wgid = (int)L; { const int q = nwg / NXCD, r = nwg % NXCD, xcd = wgid % NXCD, off = wgid / NXCD; wgid = (xcd < r ? xcd * (q + 1) : r * (q + 1) + (xcd - r) * q) + off; }
        const int nig = WGM * nN, gid = wgid / nig, fm = gid * WGM, gsz = (nM - fm) < WGM ? (nM - fm) : WGM;
        u.pm = fm + ((wgid % nig) % gsz); u.pn = (wgid % nig) / gsz; u.e = 0; u.rt = 0; return true;
    }
    DI const char* a_base(const Gemm& g, const Unit& u) const { return (const char*)g.A + (size_t)u.pm * BM * g.lda * 2; }
    DI const char* b_base(const Gemm& g, const Unit& u) const { return (const char*)g.Bt + (size_t)u.pn * BM * g.ldb * 2; }
    DI unsigned gather_voff(const Unit&, int, int, int) const { return 0u; }
};

template <bool GATH> struct MoeOrder {
    static constexpr bool GATHER = GATH;
    int G, c, npn, total; const LAS int* tb; size_t estride; const int* ltok; const unsigned* cnt;
    DI bool next(int i, Unit& u) const {
        if ((G & 7) == 0) {
            const int x = c & 7, r = c >> 3, W = G >> 3, idx = i * W + r;
            const int q = idx / npn, pn = idx - q * npn; int base = 0;
#pragma unroll
            for (int k = 0; k < 4; ++k) { const int e = x + 8 * k, nt = tb[e + 1] - tb[e];
                if (q < base + nt) { u.e = e; u.rt = q - base; u.pm = tb[e] + u.rt; u.pn = pn; return true; }
                base += nt; }
            return false;
        }
        const int L = i * G + c; if (L >= total) return false;
        const int q = L / npn; u.pn = L - q * npn; u.pm = q;
        int e = 0; while (e < NEXP - 1 && tb[e + 1] <= q) ++e;
        u.e = e; u.rt = q - tb[e]; return true;
    }
    DI const char* a_base(const Gemm& g, const Unit& u) const { return (const char*)g.A + (size_t)u.pm * BM * g.lda * 2; }
    DI const char* b_base(const Gemm& g, const Unit& u) const { return (const char*)g.Bt + (size_t)u.e * estride + (size_t)u.pn * BM * g.ldb * 2; }
    DI unsigned gather_voff(const Unit& u, int r, int C, int lda) const {
        const int pos = u.rt * BM + r; const int n = (int)__hip_atomic_load(cnt + u.e * 64, __ATOMIC_RELAXED, __HIP_MEMORY_SCOPE_AGENT);
        const int tok = pos < n ? ltok[u.e * LISTCAP + pos] : 0;
        return (unsigned)(tok * lda + C) * 2u;
    }
};

struct EpiStore {
    bf16_t* O; int ldc;
    DI void operator()(const f32x4 (&acc)[2][2][4][2], const Unit& u, int wr, int wc, int fr, int fq) const {
        const int row0 = u.pm * BM + wr * 64 + fr, col0 = u.pn * BM + wc * 32 + 8 * fq;
#pragma unroll
        for (int ai = 0; ai < 2; ++ai)
#pragma unroll
            for (int m = 0; m < 4; ++m) { bf16_t* rowp = O + (size_t)(row0 + ai * HALF + m * 16) * ldc + col0;
#pragma unroll
                for (int bj = 0; bj < 2; ++bj) { const f32x4 v0 = acc[ai][bj][m][0], v1 = acc[ai][bj][m][1];
                    u32x4 w; w.x = cvt_pk_bf16(v0[0], v0[1]); w.y = cvt_pk_bf16(v0[2], v0[3]); w.z = cvt_pk_bf16(v1[0], v1[1]); w.w = cvt_pk_bf16(v1[2], v1[3]);
                    *(GAS u32x4*)(rowp + bj * HALF) = w; } }
    }
};
struct EpiSwiGLU {
    bf16_t* H;
    DI void operator()(const f32x4 (&acc)[2][2][4][2], const Unit& u, int wr, int wc, int fr, int fq) const {
        const int row0 = u.pm * BM + wr * 64 + fr, col0 = u.pn * HALF + wc * 32 + 8 * fq;
#pragma unroll
        for (int ai = 0; ai < 2; ++ai)
#pragma unroll
            for (int m = 0; m < 4; ++m) { bf16_t* rowp = H + (size_t)(row0 + ai * HALF + m * 16) * DEXP + col0;
                float h[8];
#pragma unroll
                for (int n = 0; n < 2; ++n)
#pragma unroll
                    for (int j = 0; j < 4; ++j) { const float gt = acc[ai][0][m][n][j], up = acc[ai][1][m][n][j]; h[n * 4 + j] = gt * __builtin_amdgcn_rcpf(1.f + __expf(-gt)) * up; }
                u32x4 w; w.x = cvt_pk_bf16(h[0], h[1]); w.y = cvt_pk_bf16(h[2], h[3]); w.z = cvt_pk_bf16(h[4], h[5]); w.w = cvt_pk_bf16(h[6], h[7]);
                *(GAS u32x4*)rowp = w; }
    }
};
struct EpiScatter {
    bf16_t* YS; const int* lslot; const float* lgate; const unsigned* cnt;
    DI void operator()(const f32x4 (&acc)[2][2][4][2], const Unit& u, int wr, int wc, int fr, int fq) const {
        const int n = (int)__hip_atomic_load(cnt + u.e * 64, __ATOMIC_RELAXED, __HIP_MEMORY_SCOPE_AGENT);
        const int col0 = u.pn * BM + wc * 32 + 8 * fq;
        int slots[2][4]; float gts[2][4];
#pragma unroll
        for (int ai = 0; ai < 2; ++ai)
#pragma unroll
            for (int m = 0; m < 4; ++m) { int pos = u.rt * BM + ai * HALF + wr * 64 + m * 16 + fr; pos = pos < LISTCAP ? pos : LISTCAP - 1;
                slots[ai][m] = *(const GAS int*)(lslot + u.e * LISTCAP + pos); gts[ai][m] = *(const GAS float*)(lgate + u.e * LISTCAP + pos); }
#pragma unroll
        for (int ai = 0; ai < 2; ++ai)
#pragma unroll
            for (int m = 0; m < 4; ++m) { const int pos = u.rt * BM + ai * HALF + wr * 64 + m * 16 + fr;
                if (pos < n) { const int slot = slots[ai][m]; const float gt = gts[ai][m];
                    bf16_t* rowp = YS + (size_t)slot * DM + col0;
#pragma unroll
                    for (int bj = 0; bj < 2; ++bj) { const f32x4 v0 = acc[ai][bj][m][0] * gt, v1 = acc[ai][bj][m][1] * gt;
                        u32x4 w; w.x = cvt_pk_bf16(v0[0], v0[1]); w.y = cvt_pk_bf16(v0[2], v0[3]); w.z = cvt_pk_bf16(v1[0], v1[1]); w.w = cvt_pk_bf16(v1[2], v1[3]);
                        *(GAS u32x4*)(rowp + bj * HALF) = w; } } }
    }
};

template <class Epi, class Sched>
DI void gemm_phase(LAS unsigned char* lds, const Gemm g, const Sched& S, const Epi& E) {
    int tid = threadIdx.x; asm volatile("" : "+v"(tid));
    const int wid = __builtin_amdgcn_readfirstlane(tid >> 6), lane = tid & 63, wr = wid >> 2, wc = wid & 3, fr = lane & 15, fq = lane >> 4;
    const int K = g.K, nt = K / BK;
    unsigned voffA[2], voffB[2];
#pragma unroll
    for (int i = 0; i < 2; ++i) { int R, C; stage_rc(tid * 16 + i * 8192, R, C); const int Rb = (R & ~31) + perm32(R & 31);
        voffA[i] = (unsigned)(R * g.lda + C) * 2u; voffB[i] = (unsigned)(Rb * g.ldb + C) * 2u; }
    const size_t kstep = (size_t)(BK * 2);
    const size_t hstepA = (size_t)HALF * g.lda * 2, hstepB = (size_t)HALF * g.ldb * 2;
    const unsigned ldsw = (unsigned)wid * 1024u;
    const int aoff = lds_byte(wr * 64 + fr, fq * 8), boff = lds_byte(wc * 32 + fr, fq * 8);
    unsigned gvC[2][2], gvN[2][2];
#define PG8_SA(b, h) (((b) * 2 + (h)) * HTB)
#define PG8_SB(b, h) ((4 + (b) * 2 + (h)) * HTB)
#define PG8_STAGE(bufoff, gbase, voff) do { _Pragma("unroll") for (int _i = 0; _i < 2; ++_i) \
        __builtin_amdgcn_global_load_lds((const unsigned*)((const char*)(gbase) + (voff)[_i]), (LAS unsigned*)(lds + (bufoff) + ldsw + _i * 8192), 16, 0, 0); } while (0)
#define PG8_STAGE_A(bufoff, h, nxtsel, kt) do { \
        if constexpr (Sched::GATHER) { const char* _gb = (const char*)g.A + (size_t)(kt) * kstep; unsigned _vo[2]; _vo[0] = (nxtsel) ? gvN[h][0] : gvC[h][0]; _vo[1] = (nxtsel) ? gvN[h][1] : gvC[h][1]; PG8_STAGE(bufoff, _gb, _vo); } \
        else { const char* _gb = ((nxtsel) ? nA : cA) + (size_t)(h) * hstepA + (size_t)(kt) * kstep; PG8_STAGE(bufoff, _gb, voffA); } } while (0)
#define PG8_GSETUP(dst, u) do { if constexpr (Sched::GATHER) { _Pragma("unroll") for (int _h = 0; _h < 2; ++_h) _Pragma("unroll") for (int _i = 0; _i < 2; ++_i) { int _R, _C; stage_rc(tid * 16 + _i * 8192, _R, _C); \
        dst[_h][_i] = S.gather_voff(u, _h * HALF + _R, _C, g.lda); } asm volatile("s_waitcnt vmcnt(0)" : "+v"(dst[0][0]), "+v"(dst[0][1]), "+v"(dst[1][0]), "+v"(dst[1][1]) :: "memory"); } } while (0)
#define PG8_LDA(dst, b, h) do { _Pragma("unroll") for (int m = 0; m < 4; ++m) _Pragma("unroll") for (int k = 0; k < 2; ++k) dst[m][k] = *(const LAS bf16x8*)(lds + PG8_SA(b, h) + aoff + m * 2048 + k * 1024); } while (0)
#define PG8_LDB(dst, b, h) do { _Pragma("unroll") for (int n = 0; n < 2; ++n) _Pragma("unroll") for (int k = 0; k < 2; ++k) dst[n][k] = *(const LAS bf16x8*)(lds + PG8_SB(b, h) + boff + n * 2048 + k * 1024); } while (0)
#define PG8_MMA(ai, bj, At, Bt) do { __builtin_amdgcn_s_setprio(1); _Pragma("unroll") for (int m = 0; m < 4; ++m) _Pragma("unroll") for (int n = 0; n < 2; ++n) _Pragma("unroll") for (int k = 0; k < 2; ++k) \
        acc[ai][bj][m][n] = __builtin_amdgcn_mfma_f32_16x16x32_bf16(Bt[n][k], At[m][k], acc[ai][bj][m][n], 0, 0, 0); __builtin_amdgcn_s_setprio(0); } while (0)
#define PG8_WAIT_V(n) asm volatile("s_waitcnt vmcnt(" #n ")" ::: "memory")
#define PG8_WAIT_L(n) asm volatile("s_waitcnt lgkmcnt(" #n ")" ::: "memory")
#define PG8_BAR __builtin_amdgcn_s_barrier()
#define PG8_SCHED __builtin_amdgcn_sched_barrier(0)
    Unit cur, nxt; int ui = 0;
    if (!S.next(0, cur)) return;
    f32x4 acc[2][2][4][2];
#pragma unroll
    for (int a = 0; a < 2; ++a)
#pragma unroll
        for (int b = 0; b < 2; ++b)
#pragma unroll
            for (int m = 0; m < 4; ++m)
#pragma unroll
                for (int n = 0; n < 2; ++n) acc[a][b][m][n] = (f32x4){0.f, 0.f, 0.f, 0.f};
    bf16x8 At[4][2], B0[2][2], B1[2][2];
    const char* cA = S.a_base(g, cur); const char* cB = S.b_base(g, cur);
    const char* nA = cA;
    PG8_GSETUP(gvC, cur);
    PG8_STAGE(PG8_SB(0, 0), cB, voffB); PG8_STAGE_A(PG8_SA(0, 0), 0, false, 0); PG8_STAGE(PG8_SB(0, 1), cB + hstepB, voffB); PG8_STAGE_A(PG8_SA(0, 1), 1, false, 0);
    if (wr == 1) PG8_BAR;
    PG8_WAIT_V(4); PG8_BAR;
    PG8_STAGE(PG8_SB(1, 0), cB + kstep, voffB); PG8_STAGE_A(PG8_SA(1, 0), 0, false, 1); PG8_STAGE(PG8_SB(1, 1), cB + hstepB + kstep, voffB);
    PG8_WAIT_V(6); PG8_BAR;
    for (;;) {
        const bool has_next = S.next(ui + 1, nxt);
        nA = has_next ? S.a_base(g, nxt) : cA; const char* nB = has_next ? S.b_base(g, nxt) : cB;
        if constexpr (Sched::GATHER) { if (has_next) { PG8_GSETUP(gvN, nxt); } else {
#pragma unroll
            for (int _h = 0; _h < 2; ++_h) { gvN[_h][0] = gvC[_h][0]; gvN[_h][1] = gvC[_h][1]; } } }
        for (int t = 0; t < nt; t += 2) {
            const bool last = (t == nt - 2);
            const int kt2 = last ? 0 : t + 2;
            const char* b2 = last ? nB : cB + (size_t)(t + 2) * kstep;
            const char* b3 = b2 + kstep;
            PG8_LDB(B0, 0, 0); PG8_SCHED; PG8_LDA(At, 0, 0); PG8_STAGE_A(PG8_SA(1, 1), 1, false, t + 1);
            PG8_WAIT_L(8); PG8_BAR; PG8_WAIT_L(0); PG8_MMA(0, 0, At, B0); PG8_BAR; PG8_SCHED;
            PG8_LDB(B1, 0, 1); PG8_STAGE(PG8_SB(0, 0), b2, voffB);
            PG8_BAR; PG8_WAIT_L(0); PG8_MMA(0, 1, At, B1); PG8_BAR;
            PG8_LDA(At, 0, 1); PG8_STAGE_A(PG8_SA(0, 0), 0, last, kt2);
            PG8_BAR; PG8_WAIT_L(0); PG8_MMA(1, 0, At, B0); PG8_BAR; PG8_SCHED;
            PG8_STAGE(PG8_SB(0, 1), b2 + hstepB, voffB);
            PG8_WAIT_V(6); PG8_BAR; PG8_MMA(1, 1, At, B1); PG8_BAR;
            PG8_LDB(B0, 1, 0); PG8_SCHED; PG8_LDA(At, 1, 0); PG8_STAGE_A(PG8_SA(0, 1), 1, last, kt2);
            PG8_WAIT_L(8); PG8_BAR; PG8_WAIT_L(0); PG8_MMA(0, 0, At, B0); PG8_BAR; PG8_SCHED;
            PG8_LDB(B1, 1, 1); PG8_STAGE(PG8_SB(1, 0), b3, voffB);
            PG8_BAR; PG8_WAIT_L(0); PG8_MMA(0, 1, At, B1); PG8_BAR;
            PG8_LDA(At, 1, 1); PG8_STAGE_A(PG8_SA(1, 0), 0, last, kt2 + 1);
            PG8_BAR; PG8_WAIT_L(0); PG8_MMA(1, 0, At, B0); PG8_BAR; PG8_SCHED;
            PG8_STAGE(PG8_SB(1, 1), b3 + hstepB, voffB);
            PG8_WAIT_V(6); PG8_BAR; PG8_MMA(1, 1, At, B1); PG8_BAR;
        }
        E(acc, cur, wr, wc, fr, fq);
        if (!has_next) break;
#pragma unroll
        for (int a = 0; a < 2; ++a)
#pragma unroll
            for (int b = 0; b < 2; ++b)
#pragma unroll
                for (int m = 0; m < 4; ++m)
#pragma unroll
                    for (int n = 0; n < 2; ++n) acc[a][b][m][n] = (f32x4){0.f, 0.f, 0.f, 0.f};
        cur = nxt; cA = nA; cB = nB; ++ui;
        if constexpr (Sched::GATHER) {
#pragma unroll
            for (int _h = 0; _h < 2; ++_h) { gvC[_h][0] = gvN[_h][0]; gvC[_h][1] = gvN[_h][1]; } }
    }
    PG8_WAIT_V(0);
    if (wr == 0) PG8_BAR;
    PG8_BAR;
#undef PG8_SA
#undef PG8_SB
#undef PG8_STAGE
#undef PG8_STAGE_A
#undef PG8_GSETUP
#undef PG8_LDA
#undef PG8_LDB
#undef PG8_MMA
#undef PG8_WAIT_V
#undef PG8_WAIT_L
#undef PG8_BAR
#undef PG8_SCHED
}
}

struct Params { const float* in[31]; float* out; unsigned char* ws; int ph_lo, ph_hi; };

struct Ctx {
    LAS unsigned char* lds;
    int tid, lane, wave, G, bid, gw, ngw;
    unsigned char* ws; float* out;
};
DI Ctx relaunder(const Ctx& F0) {
    Ctx F = F0;
    asm volatile("" : "+v"(F.tid), "+v"(F.lane));
    asm volatile("" : "+s"(F.wave), "+s"(F.G), "+s"(F.bid), "+s"(F.gw), "+s"(F.ngw));
    asm volatile("" : "+s"(F.ws), "+s"(F.out));
    F.ws = as_global(F.ws); F.out = as_global(F.out);
    return F;
}

DI void dense_gemm(const Ctx& F, const bf16_t* A, int lda, const bf16_t* Bt, int ldb, int M, int N, int K, bf16_t* O, int ldc, int crot) {
    pg8::Gemm g{A, Bt, lda, ldb, K}; pg8::StaticOrder S; S.init(M, N, F.G, (F.bid + crot) % F.G);
    pg8::EpiStore E{O, ldc};
    for (int rep = 0; rep < REP_GEMM; ++rep) pg8::gemm_phase<pg8::EpiStore, pg8::StaticOrder>(F.lds, g, S, E);
}

struct TJob { const float* src; bf16_t* dst; int ldw, dld; };
DI void tr_load(const TJob& j, f32x4 (&r)[16], int lane) {
    const GAS float* p = (const GAS float*)(j.src + (size_t)(lane >> 4) * j.ldw + 4 * (lane & 15));
#pragma unroll
    for (int i = 0; i < 16; ++i) r[i] = *(const GAS f32x4*)(p + (size_t)(4 * i) * j.ldw);
}
DI void tr_store(const TJob& j, const f32x4 (&r)[16], LAS unsigned char* scr, int lane) {
#pragma unroll
    for (int i = 0; i < 16; ++i) { LAS unsigned* w = (LAS unsigned*)(scr + ((lane >> 4) + 4 * i) * 132 + (lane & 15) * 8); w[0] = cvt_pk_bf16(r[i].x, r[i].y); w[1] = cvt_pk_bf16(r[i].z, r[i].w); }
    LDS_WAIT();
    const int kc = lane & 7;
#pragma unroll
    for (int sgrp = 0; sgrp < 8; ++sgrp) { const int n = 8 * sgrp + (lane >> 3); const LAS unsigned short* c = (const LAS unsigned short*)(scr + (8 * kc) * 132 + n * 2);
        u32x4 o; o.x = (unsigned)c[0] | ((unsigned)c[66] << 16); o.y = (unsigned)c[2 * 66] | ((unsigned)c[3 * 66] << 16); o.z = (unsigned)c[4 * 66] | ((unsigned)c[5 * 66] << 16); o.w = (unsigned)c[6 * 66] | ((unsigned)c[7 * 66] << 16);
        *(GAS u32x4*)(j.dst + (size_t)n * j.dld + 8 * kc) = o; }
    LDS_WAIT();
}
template <class Dec> DI void tr_run(const Dec& D, int first, int count, int stride, LAS unsigned char* scr, int lane) {
    f32x4 A[16], B[16]; TJob ja, jb;
    int it = first; if (it >= count) return;
    ja = D(it); tr_load(ja, A, lane);
    for (;;) {
        const int it2 = it + stride; const bool h2 = it2 < count; if (h2) { jb = D(it2); tr_load(jb, B, lane); }
        tr_store(ja, A, scr, lane);
        if (!h2) break;
        const int it3 = it2 + stride; const bool h3 = it3 < count; if (h3) { ja = D(it3); tr_load(ja, A, lane); }
        tr_store(jb, B, scr, lane);
        if (!h3) break;
        it = it3;
    }
}
DI TJob mat_job(const float* W, int K, int N, bf16_t* WT, int item) {
    const int nblk = N / 64, kb = item / nblk, nb = item - kb * nblk;
    TJob j; j.src = W + (size_t)(64 * kb) * N + 64 * nb; j.dst = WT + (size_t)(64 * nb) * K + 64 * kb; j.ldw = N; j.dld = K; return j;
}
DI void row_to_bf16(const float* src, bf16_t* dst, int lane) {
    const GAS f32x4* s = (const GAS f32x4*)src + lane; GAS u32x2* o = (GAS u32x2*)dst + lane;
#pragma unroll
    for (int j = 0; j < 8; ++j) { const f32x4 v = s[64 * j]; u32x2 w; w.x = cvt_pk_bf16(v.x, v.y); w.y = cvt_pk_bf16(v.z, v.w); o[64 * j] = w; }
}

DI void phase_prologue(const Ctx& F, const Params& P) {
    unsigned char* const wsl = F.ws; float* const outl = F.out; (void)outl;
    LAS unsigned char* scr = F.lds + F.wave * 16384;
    unsigned char* ws = wsl;
    constexpr int I_RW = 32 * (RW_IN_COLS / 64), I_OT = 32 * (ZW_OTH / 64), I_WO = 32 * 32, I_KV = 32 * 8;
    constexpr int N_A = 2 * I_RW + 2 * I_OT, N_B = 4 * I_WO, N_C = 8 * I_KV, N_D = NTOK + NBATCH * MEML;
    struct ProDec { unsigned char* ws;
        DI TJob operator()(int it) const { int r = it;
            if (r < N_A) {
                if (r < I_RW) return mat_job(PIN(16), DM, RW_IN_COLS, (bf16_t*)(ws + WS_WIN), r); r -= I_RW;
                if (r < I_OT) return mat_job(PIN(28), DM, ZW_OTH, (bf16_t*)(ws + WS_WIN + WIN_STRIDE), r); r -= I_OT;
                if (r < I_OT) return mat_job(PIN(30), DM, ZW_OTH, (bf16_t*)(ws + WS_WIN + 2 * WIN_STRIDE), r); r -= I_OT;
                return mat_job(PIN(16) + (size_t)DM * RW_IN_COLS, DM, RW_IN_COLS, (bf16_t*)(ws + WS_WIN + 3 * WIN_STRIDE), r);
            }
            r -= N_A;
            if (r < N_B) { const int l = r / I_WO; return mat_job(PIN(2) + (size_t)l * DM * DM, DM, DM, (bf16_t*)(ws + WS_WOUT) + (size_t)l * DM * DM, r - l * I_WO); }
            r -= N_B;
            const int m = r / I_KV, l = m & 3; const bool isv = m >= 4;
            return mat_job(PIN(isv ? 4 : 3) + (size_t)l * DM * MEMW, DM, MEMW, (bf16_t*)(ws + (isv ? WS_WV : WS_WK)) + (size_t)l * MEMW * DM, r - m * I_KV);
        } };
    ProDec PD{ws};
    tr_run(PD, F.gw, N_A + N_B + N_C, F.ngw, scr, F.lane);
    for (int r = F.gw; r < N_D; r += F.ngw) {
        if (r < NTOK) row_to_bf16(PIN(0) + (size_t)r * DM, (bf16_t*)(ws + WS_XB) + (size_t)r * DM, F.lane);
        else row_to_bf16(PIN(1) + (size_t)(r - NTOK) * DM, (bf16_t*)(ws + WS_MEMB) + (size_t)(r - NTOK) * DM, F.lane);
    }
    const int gt = F.bid * NT + F.tid, ngt = F.G * NT;
    for (int idx = gt; idx < 2 * (3072 + 1536) * 256; idx += ngt) {
        const int j = idx / ((3072 + 1536) * 256); int r = idx - j * (3072 + 1536) * 256;
        bf16_t* base = (bf16_t*)(ws + WS_LORA + (size_t)j * LORA_STRIDE);
        const int n = r >> 8, k = r & 255; float v = 0.f;
        if (n < 1536) { if (k < 96) v = PIN(19)[((size_t)j * 96 + k) * CMIX + n]; }
        else if (n < 3072) { if (k >= 96 && k < 192) v = PIN(21)[((size_t)j * 96 + (k - 96)) * CMIX + (n - 1536)]; }
        else v = PIN(22)[((size_t)j * 256 + k) * CMIX + (n - 3072)];
        base[r] = (bf16_t)(cvt_pk_bf16(v, 0.f) & 0xffffu);
    }
    for (int idx = gt; idx < 2 * 64 * DM; idx += ngt) { const int j = idx / (64 * DM), r = idx - j * 64 * DM;
        ((bf16_t*)(ws + WS_WIN + (size_t)(j ? 3 : 0) * WIN_STRIDE))[(size_t)RW_IN_COLS * DM + r] = 0; }
    for (int idx = gt; idx < NLAYER * 48 * DM; idx += ngt) {
        const int l = idx / (48 * DM); int r = idx - l * 48 * DM; const int n = r / DM, k = r - n * DM;
        float v = 0.f;
        if (n < 4) v = PIN(9)[((size_t)l * DM + k) * 4 + n]; else if (n < 36) v = PIN(11)[((size_t)l * DM + k) * 32 + (n - 4)];
        const unsigned hi = cvt_pk_bf16(v, 0.f) & 0xffffu; const float rem = v - bf2f(hi); const unsigned lo = cvt_pk_bf16(rem, 0.f) & 0xffffu;
        bf16_t* base = (bf16_t*)(ws + WS_WSW + (size_t)l * WSW_STRIDE);
        base[r] = (bf16_t)hi; base[48 * DM + r] = (bf16_t)lo;
    }
}

DI void expert_convert(const Ctx& F, const Params& P, int l, int w, int nw) {
    unsigned char* const wsl = F.ws;
    LAS unsigned char* scr = F.lds + F.wave * 16384;
    constexpr int I_GU = NEXP * 32 * 8 * 2, I_DN = NEXP * 8 * 32;
    struct ExpDec { unsigned char* ws; int l;
        DI TJob operator()(int it) const { TJob j;
            if (it < I_GU) {
                const int isup = it / (I_GU / 2); int r = it - isup * (I_GU / 2);
                const int e = r / 256; r -= e * 256; const int kb = r >> 3, nb = r & 7;
                const float* W = PIN(isup ? 14 : 13) + ((size_t)l * NEXP + e) * DM * DEXP;
                const int n0 = 64 * nb, drow = 256 * (n0 >> 7) + (isup ? 128 : 0) + (n0 & 127);
                j.src = W + (size_t)(64 * kb) * DEXP + n0; j.ldw = DEXP; j.dst = (bf16_t*)(ws + WS_EXP1) + ((size_t)e * 1024 + drow) * DM + 64 * kb; j.dld = DM;
            } else {
                int r = it - I_GU; const int e = r / 256; r -= e * 256; const int kb = r >> 5, nb = r & 31;
                const float* W = PIN(15) + ((size_t)l * NEXP + e) * DEXP * DM;
                j.src = W + (size_t)(64 * kb) * DM + 64 * nb; j.ldw = DM; j.dst = (bf16_t*)(ws + WS_EXP2) + ((size_t)e * DM + 64 * nb) * DEXP + 64 * kb; j.dld = DEXP;
            }
            return j; } };
    ExpDec ED{wsl, l};
    tr_run(ED, w, I_GU + I_DN, nw, scr, F.lane);
}

DI void memattn_unit(const Ctx& F, int l, int unit, const bf16_t* z, int zw, int qcol) {
    unsigned char* const wsl = F.ws; float* const outl = F.out; (void)outl;
    const int b = unit >> 6, head = (unit >> 4) & 3, qblk = unit & 15;
    LAS unsigned char* Ks = F.lds; LAS unsigned char* Vs = F.lds + 69632;
    const bf16_t* Km = (const bf16_t*)(wsl + WS_KM); const bf16_t* VmT = (const bf16_t*)(wsl + WS_VMT);
    bf16_t* cat = (bf16_t*)(wsl + WS_CAT);
    __syncthreads();
#pragma unroll
    for (int h = 0; h < 2; ++h) {
        u32x4 kv[4], vv[4];
#pragma unroll
        for (int i = 0; i < 4; ++i) { const int ch = F.tid + NT * (4 * h + i);
            { const int row = ch >> 4, c16 = ch & 15; kv[i] = *(const GAS u32x4*)(Km + (size_t)(b * MEML + row) * 2048 + l * 512 + head * 128 + c16 * 8); }
            { const int d = ch >> 5, c = ch & 31; vv[i] = *(const GAS u32x4*)(VmT + (size_t)(l * 512 + head * 128 + d) * 1024 + b * MEML + c * 8); } }
#pragma unroll
        for (int i = 0; i < 4; ++i) { const int ch = F.tid + NT * (4 * h + i);
            { const int row = ch >> 4, c16 = ch & 15; *(LAS u32x4*)(Ks + row * 272 + c16 * 16) = kv[i]; }
            { const int d = ch >> 5, c = ch & 31; *(LAS u32x4*)(Vs + d * 528 + c * 16) = vv[i]; } }
        asm volatile("" ::: "memory");
    }
    __syncthreads();
    int lane = F.lane; asm volatile("" : "+v"(lane) :: "memory");
    const int fr = lane & 15, fq = lane >> 4;
    for (int itq = 0; itq < 2; ++itq) {
        asm volatile("" : "+v"(lane) :: "memory");
        const int q0 = qblk * 256 + itq * 128 + F.wave * 16, tok0 = b * SEQ + q0;
        bf16x8 Qf[4];
#pragma unroll
        for (int ks = 0; ks < 4; ++ks) Qf[ks] = *(const GAS bf16x8*)(z + (size_t)(tok0 + (lane & 15)) * zw + qcol + head * 128 + ks * 32 + (lane >> 4) * 8);
        f32x4 acc[16];
#pragma unroll
        for (int t = 0; t < 16; ++t) { acc[t] = (f32x4){0.f, 0.f, 0.f, 0.f};
#pragma unroll
            for (int ks = 0; ks < 4; ++ks) { const bf16x8 kf = *(const LAS bf16x8*)(Ks + (16 * t + fr) * 272 + ks * 64 + fq * 16);
                acc[t] = __builtin_amdgcn_mfma_f32_16x16x32_bf16(kf, Qf[ks], acc[t], 0, 0, 0); } }
        const float sc = 0.08838834764831845f;
        float mx = -3.0e38f;
#pragma unroll
        for (int t = 0; t < 16; ++t)
#pragma unroll
            for (int j = 0; j < 4; ++j) { acc[t][j] *= sc; mx = fmaxf(mx, acc[t][j]); }
        mx = fmaxf(mx, __shfl_xor(mx, 16)); mx = fmaxf(mx, __shfl_xor(mx, 32));
        float sum = 0.f;
#pragma unroll
        for (int t = 0; t < 16; ++t)
#pragma unroll
            for (int j = 0; j < 4; ++j) { acc[t][j] = __expf(acc[t][j] - mx); sum += acc[t][j]; }
        sum += __shfl_xor(sum, 16); sum += __shfl_xor(sum, 32);
        const float inv = 1.f / sum;
        f32x4 o[8];
#pragma unroll
        for (int dt = 0; dt < 8; ++dt) o[dt] = (f32x4){0.f, 0.f, 0.f, 0.f};
#pragma unroll
        for (int s = 0; s < 8; ++s) {
            u32x4 pw; pw.x = cvt_pk_bf16(acc[2 * s][0], acc[2 * s][1]); pw.y = cvt_pk_bf16(acc[2 * s][2], acc[2 * s][3]);
            pw.z = cvt_pk_bf16(acc[2 * s + 1][0], acc[2 * s + 1][1]); pw.w = cvt_pk_bf16(acc[2 * s + 1][2], acc[2 * s + 1][3]);
            const bf16x8 pf = __builtin_bit_cast(bf16x8, pw);
#pragma unroll
            for (int dt = 0; dt < 8; ++dt) {
                const u32x2 v0 = *(const LAS u32x2*)(Vs + (16 * dt + fr) * 528 + (32 * s + 4 * fq) * 2);
                const u32x2 v1 = *(const LAS u32x2*)(Vs + (16 * dt + fr) * 528 + (32 * s + 16 + 4 * fq) * 2);
                u32x4 vw; vw.x = v0.x; vw.y = v0.y; vw.z = v1.x; vw.w = v1.y;
                o[dt] = __builtin_amdgcn_mfma_f32_16x16x32_bf16(__builtin_bit_cast(bf16x8, vw), pf, o[dt], 0, 0, 0);
            }
        }
        bf16_t* orow = cat + (size_t)(tok0 + fr) * DM + CMIX + head * 128 + 4 * fq;
#pragma unroll
        for (int dt = 0; dt < 8; ++dt) { u32x2 w; w.x = cvt_pk_bf16(o[dt][0] * inv, o[dt][1] * inv); w.y = cvt_pk_bf16(o[dt][2] * inv, o[dt][3] * inv); *(GAS u32x2*)(orow + 16 * dt) = w; }
    }
}
DI void memattn_all(const Ctx& F, int l, const bf16_t* z, int zw, int qcol) {
    for (int u = F.bid; u < 256; u += F.G) memattn_unit(F, l, u, z, zw, qcol);
    __syncthreads();
}

DI void conv_mix(const Ctx& F, const Params& P, const bf16_t* z) {
    unsigned char* const wsl = F.ws; float* const outl = F.out; (void)outl;
    const float* cw = PIN(29);
    bf16_t* cat = (bf16_t*)(wsl + WS_CAT);
    const int gt = F.bid * NT + F.tid, ngt = F.G * NT;
    for (int idx = gt; idx < NTOK * 192; idx += ngt) {
        const int tok = idx / 192, c8 = idx - tok * 192, c = c8 * 8, t = tok & (SEQ - 1);
        const bf16_t* zr = z + (size_t)tok * ZW_OTH;
        const u32x4 bg = *(const GAS u32x4*)(zr + c);
        u32x4 cg[3], hh[3]; f32x4 w0[3], w1[3];
#pragma unroll
        for (int dt = 0; dt < 3; ++dt) { const bf16_t* zp = (t - dt >= 0) ? zr - (size_t)dt * ZW_OTH : zr;
            cg[dt] = *(const GAS u32x4*)(zp + CMIX + c); hh[dt] = *(const GAS u32x4*)(zp + 2 * CMIX + c);
            w0[dt] = *(const GAS f32x4*)(cw + (2 - dt) * CMIX + c); w1[dt] = *(const GAS f32x4*)(cw + (2 - dt) * CMIX + c + 4); }
        float y[8];
#pragma unroll
        for (int j = 0; j < 8; ++j) y[j] = 0.f;
#pragma unroll
        for (int dt = 0; dt < 3; ++dt) {
            const float m = (t - dt >= 0) ? 1.f : 0.f;
            y[0] += m * (w0[dt].x * bflo(cg[dt].x) * bflo(hh[dt].x)); y[1] += m * (w0[dt].y * bfhi(cg[dt].x) * bfhi(hh[dt].x)); y[2] += m * (w0[dt].z * bflo(cg[dt].y) * bflo(hh[dt].y)); y[3] += m * (w0[dt].w * bfhi(cg[dt].y) * bfhi(hh[dt].y));
            y[4] += m * (w1[dt].x * bflo(cg[dt].z) * bflo(hh[dt].z)); y[5] += m * (w1[dt].y * bfhi(cg[dt].z) * bfhi(hh[dt].z)); y[6] += m * (w1[dt].z * bflo(cg[dt].w) * bflo(hh[dt].w)); y[7] += m * (w1[dt].w * bfhi(cg[dt].w) * bfhi(hh[dt].w));
        }
        u32x4 o; o.x = cvt_pk_bf16(bflo(bg.x) * y[0], bfhi(bg.x) * y[1]); o.y = cvt_pk_bf16(bflo(bg.y) * y[2], bfhi(bg.y) * y[3]);
        o.z = cvt_pk_bf16(bflo(bg.z) * y[4], bfhi(bg.z) * y[5]); o.w = cvt_pk_bf16(bflo(bg.w) * y[6], bfhi(bg.w) * y[7]);
        *(GAS u32x4*)(cat + (size_t)tok * DM + c) = o;
    }
}

DI void sb_attention(const Ctx& F, const bf16_t* z) {
    unsigned char* const wsl = F.ws;
    const bf16_t* VT = (const bf16_t*)(wsl + WS_ACT);
    bf16_t* cat = (bf16_t*)(wsl + WS_CAT);
    LAS unsigned char* Ks = F.lds; LAS unsigned char* Vs = F.lds + 69632;
    const int lane = F.lane, fr = lane & 15, fq = lane >> 4;
    const float sc = 0.08838834764831845f;
    for (int u = F.bid; u < NBATCH * 12 * 32; u += F.G) {
        const int b = u / (12 * 32); int r = u - b * 12 * 32; const int head = r >> 5, qblk = r & 31;
        const int t0 = qblk * 128, kw0 = t0 - 128;
        __syncthreads();
#pragma unroll
        for (int h = 0; h < 2; ++h) {
            u32x4 kv[4], vv[4];
#pragma unroll
            for (int i = 0; i < 4; ++i) { const int ch = F.tid + NT * (4 * h + i);
                { const int row = ch >> 4, c16 = ch & 15, key = kw0 + row, keyc = key < 0 ? 0 : key; kv[i] = *(const GAS u32x4*)(z + (size_t)(b * SEQ + keyc) * ZW_OTH + CMIX + head * 128 + c16 * 8); }
                { const int d = ch >> 5, c = ch & 31, k8 = kw0 + c * 8, k8c = k8 < 0 ? 0 : k8; vv[i] = *(const GAS u32x4*)(VT + (size_t)(head * 128 + d) * NTOK + b * SEQ + k8c); } }
#pragma unroll
            for (int i = 0; i < 4; ++i) { const int ch = F.tid + NT * (4 * h + i);
                { const int row = ch >> 4, c16 = ch & 15; *(LAS u32x4*)(Ks + row * 272 + c16 * 16) = kv[i]; }
                { const int d = ch >> 5, c = ch & 31; *(LAS u32x4*)(Vs + d * 528 + c * 16) = vv[i]; } }
            asm volatile("" ::: "memory");
        }
        __syncthreads();
        int lq = F.lane; asm volatile("" : "+v"(lq) :: "memory");
        const int tq0 = t0 + F.wave * 16, tq = tq0 + fr;
        bf16x8 Qf[4];
#pragma unroll
        for (int ks = 0; ks < 4; ++ks) Qf[ks] = *(const GAS bf16x8*)(z + (size_t)(b * SEQ + tq0 + (lq & 15)) * ZW_OTH + head * 128 + ks * 32 + (lq >> 4) * 8);
        f32x4 o[8];
#pragma unroll
        for (int dt = 0; dt < 8; ++dt) o[dt] = (f32x4){0.f, 0.f, 0.f, 0.f};
        float R = 0.f;
        for (int kt = (tq0 + 14) >> 5; kt >= 0; --kt) {
            const int lk = 32 * kt - kw0;
            bf16x8 Kf[2][4]; u32x2 V0[8], V1[8];
            if (lk >= 0) {
#pragma unroll
                for (int tl = 0; tl < 2; ++tl)
#pragma unroll
                    for (int ks = 0; ks < 4; ++ks) Kf[tl][ks] = *(const LAS bf16x8*)(Ks + (lk + 16 * tl + fr) * 272 + ks * 64 + fq * 16);
#pragma unroll
                for (int dt = 0; dt < 8; ++dt) { V0[dt] = *(const LAS u32x2*)(Vs + (16 * dt + fr) * 528 + (lk + 4 * fq) * 2); V1[dt] = *(const LAS u32x2*)(Vs + (16 * dt + fr) * 528 + (lk + 16 + 4 * fq) * 2); }
            } else {
#pragma unroll
                for (int tl = 0; tl < 2; ++tl)
#pragma unroll
                    for (int ks = 0; ks < 4; ++ks) Kf[tl][ks] = *(const GAS bf16x8*)(z + (size_t)(b * SEQ + 32 * kt + 16 * tl + fr) * ZW_OTH + CMIX + head * 128 + ks * 32 + fq * 8);
#pragma unroll
                for (int dt = 0; dt < 8; ++dt) { const bf16_t* vp = VT + (size_t)(head * 128 + 16 * dt + fr) * NTOK + b * SEQ + 32 * kt + 4 * fq; V0[dt] = *(const GAS u32x2*)vp; V1[dt] = *(const GAS u32x2*)(vp + 16); }
            }
            f32x4 s[2];
#pragma unroll
            for (int tl = 0; tl < 2; ++tl) { s[tl] = (f32x4){0.f, 0.f, 0.f, 0.f};
#pragma unroll
                for (int ks = 0; ks < 4; ++ks) s[tl] = __builtin_amdgcn_mfma_f32_16x16x32_bf16(Kf[tl][ks], Qf[ks], s[tl], 0, 0, 0); }
            float ln[2][4], lsg[2][4], tot[2];
#pragma unroll
            for (int tl = 0; tl < 2; ++tl) { tot[tl] = 0.f;
#pragma unroll
                for (int j = 0; j < 4; ++j) { const float x = s[tl][j] * sc; const int key = 32 * kt + 16 * tl + 4 * fq + j; const bool valid = key < tq;
                    const float sp = softplusf_(x); ln[tl][j] = valid ? -sp : 0.f; lsg[tl][j] = valid ? (x - sp) : -1.0e30f; tot[tl] += ln[tl][j]; } }
            const float a16_0 = __shfl_xor(tot[0], 16), a32_0 = __shfl_xor(tot[0], 32), a48_0 = __shfl_xor(tot[0], 48);
            const float a16_1 = __shfl_xor(tot[1], 16), a32_1 = __shfl_xor(tot[1], 32), a48_1 = __shfl_xor(tot[1], 48);
            float hi0 = 0.f, hi1 = 0.f;
            if ((fq ^ 1) > fq) { hi0 += a16_0; hi1 += a16_1; }
            if ((fq ^ 2) > fq) { hi0 += a32_0; hi1 += a32_1; }
            if ((fq ^ 3) > fq) { hi0 += a48_0; hi1 += a48_1; }
            const float all0 = tot[0] + a16_0 + a32_0 + a48_0, all1 = tot[1] + a16_1 + a32_1 + a48_1;
            const float E0 = R + hi0 + all1, E1 = R + hi1;
            float at[2][4];
#pragma unroll
            for (int tl = 0; tl < 2; ++tl) { float suf = 0.f; const float Eb = tl ? E1 : E0;
#pragma unroll
                for (int j = 3; j >= 0; --j) { at[tl][j] = __expf(lsg[tl][j] + Eb + suf); suf += ln[tl][j]; } }
            R += all0 + all1;
            u32x4 pw; pw.x = cvt_pk_bf16(at[0][0], at[0][1]); pw.y = cvt_pk_bf16(at[0][2], at[0][3]); pw.z = cvt_pk_bf16(at[1][0], at[1][1]); pw.w = cvt_pk_bf16(at[1][2], at[1][3]);
            const bf16x8 pf = __builtin_bit_cast(bf16x8, pw);
#pragma unroll
            for (int dt = 0; dt < 8; ++dt) {
                u32x4 vw; vw.x = V0[dt].x; vw.y = V0[dt].y; vw.z = V1[dt].x; vw.w = V1[dt].y;
                o[dt] = __builtin_amdgcn_mfma_f32_16x16x32_bf16(__builtin_bit_cast(bf16x8, vw), pf, o[dt], 0, 0, 0);
            }
            if (__all(R < -100.f)) break;
        }
        bf16_t* orow = cat + (size_t)(b * SEQ + tq) * DM + head * 128 + 4 * fq;
#pragma unroll
        for (int dt = 0; dt < 8; ++dt) { u32x2 w; w.x = cvt_pk_bf16(o[dt][0], o[dt][1]); w.y = cvt_pk_bf16(o[dt][2], o[dt][3]); *(GAS u32x2*)(orow + 16 * dt) = w; }
    }
    __syncthreads();
}

DI void rwkv_prep1(const Ctx& F, const Params& P, int j, const bf16_t* z) {
    unsigned char* const wsl = F.ws; float* const outl = F.out; (void)outl;
    const float* mu = PIN(17) + (size_t)j * 5056;
    bf16_t* act = (bf16_t*)(wsl + WS_ACT);
    const int gt = F.bid * NT + F.tid, ngt = F.G * NT;
    for (int idx = gt; idx < NTOK * 64; idx += ngt) {
        const int tok = idx >> 6, ci = idx & 63, t = tok & (SEQ - 1);
        u32x4 o = (u32x4){0u, 0u, 0u, 0u};
        if (ci < 24 || ci >= 32) {
            const int sc = ci < 12 ? 4608 + 8 * ci : (ci < 24 ? 4704 + 8 * (ci - 12) : 4800 + 8 * (ci - 32));
            const u32x4 a = *(const GAS u32x4*)(z + (size_t)tok * ZW_RWKV + sc);
            u32x4 p = *(const GAS u32x4*)(z + (size_t)(t > 0 ? tok - 1 : tok) * ZW_RWKV + sc);
            const f32x4 m0 = *(const GAS f32x4*)(mu + sc), m1 = *(const GAS f32x4*)(mu + sc + 4);
            if (t == 0) p = (u32x4){0u, 0u, 0u, 0u};
            float v[8];
            v[0] = bflo(a.x) + (bflo(p.x) - bflo(a.x)) * m0.x; v[1] = bfhi(a.x) + (bfhi(p.x) - bfhi(a.x)) * m0.y;
            v[2] = bflo(a.y) + (bflo(p.y) - bflo(a.y)) * m0.z; v[3] = bfhi(a.y) + (bfhi(p.y) - bfhi(a.y)) * m0.w;
            v[4] = bflo(a.z) + (bflo(p.z) - bflo(a.z)) * m1.x; v[5] = bfhi(a.z) + (bfhi(p.z) - bfhi(a.z)) * m1.y;
            v[6] = bflo(a.w) + (bflo(p.w) - bflo(a.w)) * m1.z; v[7] = bfhi(a.w) + (bfhi(p.w) - bfhi(a.w)) * m1.w;
#pragma unroll
            for (int q = 0; q < 8; ++q) { if (ci < 12) v[q] = tanhf(v[q]); else if (ci >= 32) v[q] = sigmoidf_(v[q]); }
            o.x = cvt_pk_bf16(v[0], v[1]); o.y = cvt_pk_bf16(v[2], v[3]); o.z = cvt_pk_bf16(v[4], v[5]); o.w = cvt_pk_bf16(v[6], v[7]);
        }
        *(GAS u32x4*)(act + (size_t)tok * 512 + ci * 8) = o;
    }
}

constexpr int CH = 64, NCH = SEQ / CH;
DI float* scan_rec(unsigned char* ws, int tok, int head) {
    return (float*)(ws + WS_SCAN) + ((size_t)((tok >> 12) * 24 + head) * SEQ + (tok & (SEQ - 1))) * 320;
}
DI float* gh_ptr(unsigned char* ws, int bh, int c, int which) { return (float*)(ws + WS_GH) + (((size_t)bh * NCH + c) * 2 + which) * 4096; }
struct RwPar { const float *mu, *w0, *a0, *kk, *ka, *rk, *gng, *gnb; };
struct PrepRaw { u32x2 zr, zk, zv, pr, pk, pv, lw, la; };
struct PrepOut { f32x4 dec, ld, bb, kp, r, nk, v; float bon; };
DI void prep_load(PrepRaw& R, const bf16_t* z, const bf16_t* LW, int tok, int c4) {
    tok = tok < NTOK ? tok : NTOK - 1;
    const bool hp = (tok & (SEQ - 1)) != 0;
    const GAS bf16_t* zc = (const GAS bf16_t*)(z + (size_t)tok * ZW_RWKV + c4); const GAS bf16_t* zp = hp ? zc - ZW_RWKV : zc;
    R.zr = *(const GAS u32x2*)zc; R.zk = *(const GAS u32x2*)(zc + CMIX); R.zv = *(const GAS u32x2*)(zc + 2 * CMIX);
    R.pr = *(const GAS u32x2*)zp; R.pk = *(const GAS u32x2*)(zp + CMIX); R.pv = *(const GAS u32x2*)(zp + 2 * CMIX);
    const GAS bf16_t* lp = (const GAS bf16_t*)(LW + (size_t)tok * 3072 + c4); R.lw = *(const GAS u32x2*)lp; R.la = *(const GAS u32x2*)(lp + CMIX);
}
DI f32x4 lerp_u(u32x2 a, u32x2 p, f32x4 m) {
    f32x4 r; r.x = bflo(a.x) + (bflo(p.x) - bflo(a.x)) * m.x; r.y = bfhi(a.x) + (bfhi(p.x) - bfhi(a.x)) * m.y;
    r.z = bflo(a.y) + (bflo(p.y) - bflo(a.y)) * m.z; r.w = bfhi(a.y) + (bfhi(p.y) - bfhi(a.y)) * m.w; return r;
}
struct PrepPar { f32x4 mur, muk, muv, w0, a0, kk, ka, rk; };
DI void par_load(PrepPar& P, const RwPar& Q, int c4) {
    P.mur = *(const GAS f32x4*)(Q.mu + c4); P.muk = *(const GAS f32x4*)(Q.mu + CMIX + c4); P.muv = *(const GAS f32x4*)(Q.mu + 2 * CMIX + c4);
    P.w0 = *(const GAS f32x4*)(Q.w0 + c4); P.a0 = *(const GAS f32x4*)(Q.a0 + c4); P.kk = *(const GAS f32x4*)(Q.kk + c4); P.ka = *(const GAS f32x4*)(Q.ka + c4); P.rk = *(const GAS f32x4*)(Q.rk + c4);
}
template <bool WANT_BON> DI void prep_compute(const PrepRaw& R, const PrepPar& P, bool hp, PrepOut& O) {
    const u32x2 z2 = (u32x2){0u, 0u};
    const f32x4 r = lerp_u(R.zr, hp ? R.pr : z2, P.mur), k = lerp_u(R.zk, hp ? R.pk : z2, P.muk);
    O.v = lerp_u(R.zv, hp ? R.pv : z2, P.muv); O.r = r;
    const f32x4 w0v = P.w0, a0v = P.a0, kkv = P.kk, kav = P.ka;
    f32x4 wr; wr.x = w0v.x + bflo(R.lw.x); wr.y = w0v.y + bfhi(R.lw.x); wr.z = w0v.z + bflo(R.lw.y); wr.w = w0v.w + bfhi(R.lw.y);
    f32x4 ar; ar.x = a0v.x + bflo(R.la.x); ar.y = a0v.y + bfhi(R.la.x); ar.z = a0v.z + bflo(R.la.y); ar.w = a0v.w + bfhi(R.la.y);
    f32x4 a, kk;
#pragma unroll
    for (int q = 0; q < 4; ++q) { const float wl = -softplusf_(-wr[q]) - 0.5f; O.ld[q] = -__expf(wl); O.dec[q] = __expf(O.ld[q]); a[q] = sigmoidf_(ar[q]); kk[q] = k[q] * kkv[q]; O.kp[q] = k[q] * (1.f + (a[q] - 1.f) * kav[q]); }
    const float n2 = sum16(kk.x * kk.x + kk.y * kk.y + kk.z * kk.z + kk.w * kk.w);
    const float inv = __builtin_amdgcn_rsqf(fmaxf(n2, 1e-24f));
#pragma unroll
    for (int q = 0; q < 4; ++q) { const float kn = kk[q] * inv; O.bb[q] = kn * a[q]; O.nk[q] = -kn; }
    if (WANT_BON) { const f32x4 rk = P.rk; O.bon = sum16(r.x * O.kp.x * rk.x + r.y * O.kp.y * rk.y + r.z * O.kp.z * rk.z + r.w * O.kp.w * rk.w); }
}
#define LO2(v) ((f32x2){(v).x, (v).y})
#define HI2(v) ((f32x2){(v).z, (v).w})
constexpr int WRS = 144;
constexpr int W_SLOT = 64 * WRS;
enum { SL_NT = 0, SL_RT, SL_BH, SL_KH, SL_BHT, SL_KHT, SL_VT, SL_MK, SL_NB, SL_NK, SL_W1T, SL_U0T };
constexpr int W_MB = 12 * W_SLOT, W_CL = W_MB + 16384, W_PL = W_CL + 16384;
DI bf16x8 wfrag(LAS unsigned char* L, int slot, int row, int ks, int q) { return *(const LAS bf16x8*)(L + slot * W_SLOT + row * WRS + ks * 64 + q * 16); }
DI void wput(LAS unsigned char* L, int slot, int row, int col, float v) { *(LAS bf16_t*)(L + slot * W_SLOT + row * WRS + col * 2) = (bf16_t)(cvt_pk_bf16(v, 0.f) & 0xffffu); }
DI void tr4x4_rows(f32x4& x) {
    const float f0 = x.x, f1 = x.y, f2 = x.z, f3 = x.w;
    const unsigned u0 = __builtin_bit_cast(unsigned, f0), u1 = __builtin_bit_cast(unsigned, f1), u2 = __builtin_bit_cast(unsigned, f2), u3 = __builtin_bit_cast(unsigned, f3);
    const auto s02 = __builtin_amdgcn_permlane32_swap(u0, u2, false, false); const auto s13 = __builtin_amdgcn_permlane32_swap(u1, u3, false, false);
    const auto t01 = __builtin_amdgcn_permlane16_swap(s02[0], s13[0], false, false); const auto t23 = __builtin_amdgcn_permlane16_swap(s02[1], s13[1], false, false);
    x[0] = __builtin_bit_cast(float, (unsigned)t01[0]); x[1] = __builtin_bit_cast(float, (unsigned)t01[1]); x[2] = __builtin_bit_cast(float, (unsigned)t23[0]); x[3] = __builtin_bit_cast(float, (unsigned)t23[1]);
}
DI void scan_w1(const Ctx& F, const RwPar& Q, const bf16_t* z) {
    unsigned char* const wsl = F.ws; LAS unsigned char* L = F.lds;
    const int wave = F.wave;
    const bf16_t* LW = (const bf16_t*)(wsl + WS_LW);
    LAS float* MB = (LAS float*)(L + W_MB); LAS float* CL = (LAS float*)(L + W_CL); LAS float* PL = (LAS float*)(L + W_PL);
    PrepPar PN;
    PrepRaw RN[2];
    if (F.bid < 96 * NCH) { const int bh = F.bid % 96, c = F.bid / 96, b = bh / 24, head = bh - b * 24, tokb = b * SEQ + c * CH, c4 = head * 64 + 4 * (F.lane & 15);
#pragma unroll
        for (int p = 0; p < 2; ++p) prep_load(RN[p], z, LW, tokb + p * 32 + wave * 4 + (F.lane >> 4), c4);
        par_load(PN, Q, c4); }
    for (int u = F.bid; u < 96 * NCH; u += F.G) {
        int lane = F.lane; asm volatile("" : "+v"(lane));
        const int tq = lane >> 4, li = lane & 15, fr = li, fq = tq;
        const int bh = u % 96, c = u / 96, b = bh / 24, head = bh - b * 24, tokb = b * SEQ + c * CH, c4 = head * 64 + 4 * li;
        LDS_BARRIER();
        PrepOut O[2];
#pragma unroll
        for (int p = 0; p < 2; ++p) {
            const int t = p * 32 + wave * 4 + tq; const PrepRaw R = RN[p];
            prep_compute<true>(R, PN, ((tokb + t) & (SEQ - 1)) != 0, O[p]);
            *(LAS f32x4*)(CL + t * 64 + 4 * li) = O[p].ld;
            u32x2 e; e.x = cvt_pk_bf16(O[p].bon * O[p].v.x, O[p].bon * O[p].v.y); e.y = cvt_pk_bf16(O[p].bon * O[p].v.z, O[p].bon * O[p].v.w);
            *(GAS u32x2*)((bf16_t*)(wsl + WS_E) + (size_t)(tokb + t) * CMIX + c4) = e;
        }
        LDS_BARRIER();
        if (wave == 0) {
            float xs[64];
#pragma unroll
            for (int t = 0; t < 64; ++t) xs[t] = CL[t * 64 + lane];
#pragma unroll
            for (int t = 1; t < 64; ++t) xs[t] += xs[t - 1];
#pragma unroll
            for (int t = 0; t < 64; ++t) CL[t * 64 + lane] = xs[t];
        }
        LDS_BARRIER();
#pragma unroll
        for (int p = 0; p < 2; ++p) {
            const int t = p * 32 + wave * 4 + tq;
            const f32x4 cl = *(const LAS f32x4*)(CL + t * 64 + 4 * li);
            f32x4 clm = (f32x4){0.f, 0.f, 0.f, 0.f}; if (t > 0) clm = *(const LAS f32x4*)(CL + (t - 1) * 64 + 4 * li);
            f32x4 nt, rt, bh4, kh4;
#pragma unroll
            for (int q = 0; q < 4; ++q) { const float P = __expf(cl[q]), Pm = __expf(clm[q]), iP = __expf(-cl[q]);
                nt[q] = O[p].nk[q] * Pm; rt[q] = O[p].r[q] * P; bh4[q] = O[p].bb[q] * iP; kh4[q] = O[p].kp[q] * iP;
                if (t == 63) PL[4 * li + q] = P; }
            u32x2 w;
            w.x = cvt_pk_bf16(nt.x, nt.y); w.y = cvt_pk_bf16(nt.z, nt.w); *(LAS u32x2*)(L + SL_NT * W_SLOT + t * WRS + 8 * li) = w;
            w.x = cvt_pk_bf16(rt.x, rt.y); w.y = cvt_pk_bf16(rt.z, rt.w); *(LAS u32x2*)(L + SL_RT * W_SLOT + t * WRS + 8 * li) = w;
            w.x = cvt_pk_bf16(bh4.x, bh4.y); w.y = cvt_pk_bf16(bh4.z, bh4.w); *(LAS u32x2*)(L + SL_BH * W_SLOT + t * WRS + 8 * li) = w;
            w.x = cvt_pk_bf16(kh4.x, kh4.y); w.y = cvt_pk_bf16(kh4.z, kh4.w); *(LAS u32x2*)(L + SL_KH * W_SLOT + t * WRS + 8 * li) = w;
            { f32x4 vv = O[p].v; tr4x4_rows(bh4); tr4x4_rows(kh4); tr4x4_rows(vv);
              const int off = (4 * li + tq) * WRS + (p * 32 + wave * 4) * 2;
              w.x = cvt_pk_bf16(bh4.x, bh4.y); w.y = cvt_pk_bf16(bh4.z, bh4.w); *(LAS u32x2*)(L + SL_BHT * W_SLOT + off) = w;
              w.x = cvt_pk_bf16(kh4.x, kh4.y); w.y = cvt_pk_bf16(kh4.z, kh4.w); *(LAS u32x2*)(L + SL_KHT * W_SLOT + off) = w;
              w.x = cvt_pk_bf16(vv.x, vv.y); w.y = cvt_pk_bf16(vv.z, vv.w); *(LAS u32x2*)(L + SL_VT * W_SLOT + off) = w; }
        }
        LDS_BARRIER();
        asm volatile("" ::: "memory");
        { const int un = u + F.G; if (un < 96 * NCH) { const int bhn = un % 96, cn = un / 96, bn = bhn / 24, headn = bhn - bn * 24, tokbn = bn * SEQ + cn * CH, c4n = headn * 64 + 4 * li;
#pragma unroll
            for (int p = 0; p < 2; ++p) prep_load(RN[p], z, LW, tokbn + p * 32 + wave * 4 + tq, c4n);
            par_load(PN, Q, c4n); } }
        for (int reps = 0; reps < REP_WS; ++reps) {
            const int mt = wave >> 1, slotA = (mt < 2) ? SL_NT : SL_RT, slotB = (mt & 1) ? SL_KH : SL_BH, slotO = (mt == 1) ? SL_MK : (mt == 2 ? SL_NB : SL_NK), tt0 = (wave & 1) * 2;
            bf16x8 Af[2][2], Bf[4][2];
#pragma unroll
            for (int a2 = 0; a2 < 2; ++a2)
#pragma unroll
                for (int ks = 0; ks < 2; ++ks) Af[a2][ks] = wfrag(L, slotA, 16 * (tt0 + a2) + fr, ks, fq);
#pragma unroll
            for (int ss = 0; ss < 4; ++ss)
#pragma unroll
                for (int ks = 0; ks < 2; ++ks) Bf[ss][ks] = wfrag(L, slotB, 16 * ss + fr, ks, fq);
            float zf = 0.f; asm volatile("" : "+v"(zf));
            const unsigned zu = __builtin_bit_cast(unsigned, zf);
            const int strict = (mt < 2) ? 1 : 0; LAS unsigned char* ob = L + slotO * W_SLOT;
#pragma unroll
            for (int a2 = 0; a2 < 2; ++a2)
#pragma unroll
                for (int ss = 0; ss < 4; ++ss) { const int t = 16 * (tt0 + a2) + fr, s0 = 16 * ss + 4 * fq;
                    if (ss <= tt0 + a2) {
                        f32x4 acc = __builtin_amdgcn_mfma_f32_16x16x32_bf16(Bf[ss][0], Af[a2][0], (f32x4){0.f, 0.f, 0.f, 0.f}, 0, 0, 0);
                        acc = __builtin_amdgcn_mfma_f32_16x16x32_bf16(Bf[ss][1], Af[a2][1], acc, 0, 0, 0);
                        f32x4 o;
#pragma unroll
                        for (int r = 0; r < 4; ++r) o[r] = (s0 + r + strict <= t) ? acc[r] : 0.f;
                        if (mt == 0) *(LAS f32x4*)(MB + t * 64 + s0) = o;
                        else { u32x2 w; w.x = cvt_pk_bf16(o[0], o[1]); w.y = cvt_pk_bf16(o[2], o[3]); *(LAS u32x2*)(ob + t * WRS + s0 * 2) = w; }
                    } else {
                        if (mt == 0) *(LAS f32x4*)(MB + t * 64 + s0) = (f32x4){zf, zf, zf, zf};
                        else *(LAS u32x2*)(ob + t * WRS + s0 * 2) = (u32x2){zu, zu};
                    }
                }
        }
        LDS_BARRIER();
        { const int t = F.tid >> 3, s0 = (F.tid & 7) * 8; const f32x4 a0 = *(const LAS f32x4*)(MB + t * 64 + s0), a1 = *(const LAS f32x4*)(MB + t * 64 + s0 + 4);
          u32x4 w; w.x = cvt_pk_bf16(a0.x, a0.y); w.y = cvt_pk_bf16(a0.z, a0.w); w.z = cvt_pk_bf16(a1.x, a1.y); w.w = cvt_pk_bf16(a1.z, a1.w);
          *(LAS u32x4*)(L + SL_BH * W_SLOT + t * WRS + s0 * 2) = w; }
#pragma unroll
        for (int k2 = 0; k2 < 2; ++k2) {
            const int tile = wave * 2 + k2, tt = tile >> 2, it = tile & 3;
            f32x4 acc = (f32x4){0.f, 0.f, 0.f, 0.f};
#pragma unroll
            for (int ks = 0; ks < 2; ++ks) acc = __builtin_amdgcn_mfma_f32_16x16x32_bf16(wfrag(L, SL_MK, 16 * tt + fr, ks, fq), wfrag(L, SL_VT, 16 * it + fr, ks, fq), acc, 0, 0, 0);
#pragma unroll
            for (int r = 0; r < 4; ++r) CL[(16 * tt + 4 * fq + r) * 64 + 16 * it + fr] = acc[r];
        }
        if (wave >= 4) {
            const int I = wave - 4;
            float d[16], xb[16];
#pragma unroll
            for (int r = 0; r < 16; ++r) d[r] = (r == lane) ? 1.f : 0.f;
            const LAS float* mbv = MB; asm volatile("" : "+v"(mbv));
            const LAS float* mb = mbv + (16 * I) * 64 + 16 * I;
            f32x4 A[8][2], Bm[8][2];
#pragma unroll
            for (int tt = 0; tt < 8; ++tt) { A[tt][0] = *(const LAS f32x4*)(mb + tt * 64); A[tt][1] = *(const LAS f32x4*)(mb + tt * 64 + 4); }
#pragma unroll
            for (int tt = 0; tt < 8; ++tt) { Bm[tt][0] = *(const LAS f32x4*)(mb + (8 + tt) * 64); Bm[tt][1] = *(const LAS f32x4*)(mb + (8 + tt) * 64 + 4); }
#pragma unroll
            for (int sx = 0; sx < 8; ++sx) { xb[sx] = d[sx];
#pragma unroll
                for (int tt = sx + 1; tt < 8; ++tt) d[tt] = fma_s(A[tt][sx >> 2][sx & 3], xb[sx], d[tt]); }
#pragma unroll
            for (int sx = 0; sx < 8; ++sx)
#pragma unroll
                for (int tt = 0; tt < 8; ++tt) d[8 + tt] = fma_s(Bm[tt][sx >> 2][sx & 3], xb[sx], d[8 + tt]);
            asm volatile("" : "+v"(d[8]), "+v"(d[15]) :: "memory");
#pragma unroll
            for (int tt = 0; tt < 8; ++tt) { A[tt][0] = *(const LAS f32x4*)(mb + (8 + tt) * 64 + 8); A[tt][1] = *(const LAS f32x4*)(mb + (8 + tt) * 64 + 12); }
#pragma unroll
            for (int sx = 0; sx < 8; ++sx) { xb[8 + sx] = d[8 + sx];
#pragma unroll
                for (int tt = sx + 1; tt < 8; ++tt) d[8 + tt] = fma_s(A[tt][sx >> 2][sx & 3], xb[8 + sx], d[8 + tt]); }
            if (lane < 16) {
#pragma unroll
                for (int t = 0; t < 16; ++t) *(LAS bf16_t*)(L + SL_KH * W_SLOT + (16 * I + t) * 48 + lane * 2) = (bf16_t)(cvt_pk_bf16(xb[t], 0.f) & 0xffffu);
            }
        }
        LDS_BARRIER();
        asm volatile("" ::: "memory");
        for (int repx = 0; repx < REP_WX; ++repx) {
            const int sys = wave >> 2, ct = wave & 3, slotX = sys == 0 ? SL_W1T : SL_U0T;
            LAS unsigned char* TI = L + SL_KH * W_SLOT;
            f32x4 rhs[4];
            if (sys == 0) {
#pragma unroll
                for (int I = 0; I < 4; ++I)
#pragma unroll
                    for (int r = 0; r < 4; ++r) rhs[I][r] = bf2f(*(const LAS bf16_t*)(L + SL_NT * W_SLOT + (16 * I + 4 * fq + r) * WRS + (16 * ct + fr) * 2));
            } else {
#pragma unroll
                for (int I = 0; I < 4; ++I)
#pragma unroll
                    for (int r = 0; r < 4; ++r) rhs[I][r] = CL[(16 * I + 4 * fq + r) * 64 + 16 * ct + fr];
            }
            u32x2 ta[4], ma[6];
#pragma unroll
            for (int I = 0; I < 4; ++I) ta[I] = *(const LAS u32x2*)(TI + (16 * I + fr) * 48 + 8 * fq);
#pragma unroll
            for (int I = 1; I < 4; ++I)
#pragma unroll
                for (int Ip = 0; Ip < I; ++Ip) ma[I * (I - 1) / 2 + Ip] = *(const LAS u32x2*)(L + SL_BH * W_SLOT + (16 * I + fr) * WRS + (16 * Ip + 4 * fq) * 2);
            u32x2 xk[4];
#pragma unroll
            for (int I = 0; I < 4; ++I) {
                f32x4 acc = rhs[I];
#pragma unroll
                for (int Ip = 0; Ip < I; ++Ip) { const u32x2 m = ma[I * (I - 1) / 2 + Ip];
                    acc = __builtin_amdgcn_mfma_f32_16x16x32_bf16(__builtin_bit_cast(bf16x8, (u32x4){m.x, m.y, 0u, 0u}), __builtin_bit_cast(bf16x8, (u32x4){xk[Ip].x, xk[Ip].y, 0u, 0u}), acc, 0, 0, 0); }
                const unsigned d0 = cvt_pk_bf16(acc[0], acc[1]), d1 = cvt_pk_bf16(acc[2], acc[3]);
                const f32x4 x = __builtin_amdgcn_mfma_f32_16x16x32_bf16(__builtin_bit_cast(bf16x8, (u32x4){ta[I].x, ta[I].y, 0u, 0u}), __builtin_bit_cast(bf16x8, (u32x4){d0, d1, 0u, 0u}), (f32x4){0.f, 0.f, 0.f, 0.f}, 0, 0, 0);
                xk[I].x = cvt_pk_bf16(x[0], x[1]); xk[I].y = cvt_pk_bf16(x[2], x[3]);
                *(LAS u32x2*)(L + slotX * W_SLOT + (16 * ct + fr) * WRS + (16 * I + 4 * fq) * 2) = xk[I];
            }
        }
        LDS_BARRIER();
        for (int repo = 0; repo < REP_WO; ++repo) {
            const int kind = wave >> 1, ta0 = (wave & 1) * 2;
            float* gp = gh_ptr(wsl, bh, c, 0); float* hp = gh_ptr(wsl, bh, c, 1);
            bf16_t* qy = (bf16_t*)(wsl + WS_QY) + (size_t)u * 4096; float* y0t = (float*)(wsl + WS_Y0T) + (size_t)u * 4096;
            const int sA1 = kind == 0 ? SL_W1T : kind == 1 ? SL_BHT : kind == 2 ? SL_W1T : SL_NK, sB1 = kind == 0 ? SL_BHT : kind == 1 ? SL_U0T : kind == 2 ? SL_NB : SL_VT;
            const int sA2 = kind == 1 ? SL_KHT : SL_NB, sB2 = kind == 1 ? SL_VT : SL_U0T; const bool two = (kind & 1) != 0;
            bf16x8 Af[2][2], Bf[4][2];
#pragma unroll
            for (int a2 = 0; a2 < 2; ++a2)
#pragma unroll
                for (int ks = 0; ks < 2; ++ks) Af[a2][ks] = wfrag(L, sA1, 16 * (ta0 + a2) + fr, ks, fq);
#pragma unroll
            for (int tb = 0; tb < 4; ++tb)
#pragma unroll
                for (int ks = 0; ks < 2; ++ks) Bf[tb][ks] = wfrag(L, sB1, 16 * tb + fr, ks, fq);
            f32x4 acc[2][4];
#pragma unroll
            for (int a2 = 0; a2 < 2; ++a2)
#pragma unroll
                for (int tb = 0; tb < 4; ++tb) { acc[a2][tb] = (f32x4){0.f, 0.f, 0.f, 0.f};
#pragma unroll
                    for (int ks = 0; ks < 2; ++ks) acc[a2][tb] = __builtin_amdgcn_mfma_f32_16x16x32_bf16(Af[a2][ks], Bf[tb][ks], acc[a2][tb], 0, 0, 0); }
            if (two) {
#pragma unroll
                for (int a2 = 0; a2 < 2; ++a2)
#pragma unroll
                    for (int ks = 0; ks < 2; ++ks) Af[a2][ks] = wfrag(L, sA2, 16 * (ta0 + a2) + fr, ks, fq);
#pragma unroll
                for (int tb = 0; tb < 4; ++tb)
#pragma unroll
                    for (int ks = 0; ks < 2; ++ks) Bf[tb][ks] = wfrag(L, sB2, 16 * tb + fr, ks, fq);
#pragma unroll
                for (int a2 = 0; a2 < 2; ++a2)
#pragma unroll
                    for (int tb = 0; tb < 4; ++tb)
#pragma unroll
                        for (int ks = 0; ks < 2; ++ks) acc[a2][tb] = __builtin_amdgcn_mfma_f32_16x16x32_bf16(Af[a2][ks], Bf[tb][ks], acc[a2][tb], 0, 0, 0);
            }
#pragma unroll
            for (int a2 = 0; a2 < 2; ++a2)
#pragma unroll
                for (int tb = 0; tb < 4; ++tb) { const int ta = ta0 + a2; const f32x4 av = acc[a2][tb];
                    if (kind == 0) {
                        const int j = 16 * tb + fr; const float pl = PL[j];
                        f32x4 o;
#pragma unroll
                        for (int r = 0; r < 4; ++r) o[r] = pl * (av[r] + ((16 * ta + 4 * fq + r) == j ? 1.f : 0.f));
                        u32x2 w; w.x = cvt_pk_bf16(o[0], o[1]); w.y = cvt_pk_bf16(o[2], o[3]);
                        *(GAS u32x2*)((bf16_t*)gp + j * 64 + 16 * ta + 4 * fq) = w;
                    } else if (kind == 1) {
                        const f32x4 pl = *(const LAS f32x4*)(PL + 16 * ta + 4 * fq);
                        *(GAS f32x4*)(hp + (16 * tb + fr) * 64 + 16 * ta + 4 * fq) = pl * av;
                    } else if (kind == 2) {
                        const int t = 16 * tb + fr; const u32x2 rr = *(const LAS u32x2*)(L + SL_RT * W_SLOT + t * WRS + (16 * ta + 4 * fq) * 2);
                        u32x2 w; w.x = cvt_pk_bf16(av[0] + bflo(rr.x), av[1] + bfhi(rr.x)); w.y = cvt_pk_bf16(av[2] + bflo(rr.y), av[3] + bfhi(rr.y));
                        *(GAS u32x2*)(qy + t * 64 + 16 * ta + 4 * fq) = w;
                    } else {
                        u32x2 w; w.x = cvt_pk_bf16(av[0], av[1]); w.y = cvt_pk_bf16(av[2], av[3]); *(GAS u32x2*)((bf16_t*)y0t + (16 * tb + fr) * 64 + 16 * ta + 4 * fq) = w;
                    }
                }
        }
    }
    LDS_BARRIER();
}
DI void scan_w2(const Ctx& F, const RwPar& Q) {
    unsigned char* const wsl = F.ws; const int lane = F.lane, fr = lane & 15, fq = lane >> 4;
    LAS float* yb = (LAS float*)(F.lds + F.wave * 16384);
    const bf16_t* gate = (const bf16_t*)(wsl + WS_GATE); const bf16_t* Eb = (const bf16_t*)(wsl + WS_E); bf16_t* cat = (bf16_t*)(wsl + WS_CAT);
    for (int u = F.gw; u < 96 * NCH; u += F.ngw) {
        const int bh = u % 96, c = u / 96, b = bh / 24, head = bh - b * 24, tokb = b * SEQ + c * CH;
        const bf16_t* qy = (const bf16_t*)(wsl + WS_QY) + (size_t)u * 4096; const float* y0t = (const float*)(wsl + WS_Y0T) + (size_t)u * 4096;
        f32x4 acc[4][4];
#pragma unroll
        for (int tt = 0; tt < 4; ++tt)
#pragma unroll
            for (int it = 0; it < 4; ++it) { const u32x2 yv = *(const GAS u32x2*)((const bf16_t*)y0t + (16 * it + fr) * 64 + 16 * tt + 4 * fq); acc[tt][it] = (f32x4){bflo(yv.x), bfhi(yv.x), bflo(yv.y), bfhi(yv.y)}; }
        if (c > 0) {
            const bf16_t* sp = (const bf16_t*)gh_ptr(wsl, bh, c - 1, 0) + 4096;
            bf16x8 Bf[4][2];
#pragma unroll
            for (int it = 0; it < 4; ++it)
#pragma unroll
                for (int ks = 0; ks < 2; ++ks) Bf[it][ks] = *(const GAS bf16x8*)(sp + (16 * it + fr) * 64 + 32 * ks + 8 * fq);
#pragma unroll
            for (int tt = 0; tt < 4; ++tt)
#pragma unroll
                for (int ks = 0; ks < 2; ++ks) { const bf16x8 Af = *(const GAS bf16x8*)(qy + (16 * tt + fr) * 64 + 32 * ks + 8 * fq);
#pragma unroll
                    for (int it = 0; it < 4; ++it) acc[tt][it] = __builtin_amdgcn_mfma_f32_16x16x32_bf16(Af, Bf[it][ks], acc[tt][it], 0, 0, 0); }
        }
#pragma unroll
        for (int tt = 0; tt < 4; ++tt)
#pragma unroll
            for (int it = 0; it < 4; ++it)
#pragma unroll
                for (int r = 0; r < 4; ++r) yb[(16 * tt + 4 * fq + r) * 64 + 16 * it + fr] = acc[tt][it][r];
        const int c4 = head * 64 + 4 * (lane & 15);
        const f32x4 g4 = *(const GAS f32x4*)(Q.gng + c4), b4 = *(const GAS f32x4*)(Q.gnb + c4);
        u32x2 evs[16], gts[16];
#pragma unroll
        for (int k = 0; k < 16; ++k) { const int tok = tokb + 4 * k + (lane >> 4); evs[k] = *(const GAS u32x2*)(Eb + (size_t)tok * CMIX + c4); gts[k] = *(const GAS u32x2*)(gate + (size_t)tok * CMIX + c4); }
        LDS_WAIT();
#pragma unroll
        for (int k = 0; k < 16; ++k) {
            const int slot = k * 64 + lane, t = slot >> 4, li = slot & 15, tok = tokb + t;
            const f32x4 y = *(const LAS f32x4*)(yb + t * 64 + 4 * li);
            const u32x2 ev = evs[k], gt = gts[k];
            const float mean = sum16(y.x + y.y + y.z + y.w) * (1.f / 64.f);
            const f32x4 d = y - mean;
            const float var = sum16(d.x * d.x + d.y * d.y + d.z * d.z + d.w * d.w) * (1.f / 64.f);
            const float rstd = rsqrtf(var + GN_EPS);
            f32x4 o = d * rstd * g4 + b4; o.x += bflo(ev.x); o.y += bfhi(ev.x); o.z += bflo(ev.y); o.w += bfhi(ev.y);
            u32x2 w; w.x = cvt_pk_bf16(o.x * bflo(gt.x), o.y * bfhi(gt.x)); w.y = cvt_pk_bf16(o.z * bflo(gt.y), o.w * bfhi(gt.y));
            *(GAS u32x2*)(cat + (size_t)tok * DM + c4) = w;
        }
        LDS_WAIT();
    }
}
DI void scan_passB(const Ctx& F) {
    unsigned char* const wsl = F.ws; const int lane = F.lane, fr = lane & 15, fq = lane >> 4, ih = F.wave >> 2, q = F.wave & 3, bh = F.bid;
    LAS unsigned char* Sx0 = F.lds;
    bf16x8 ga[7][2]; f32x4 hq[7][2];
#define PB_LOAD(set, cc) do { const GAS bf16_t* _gp = (const GAS bf16_t*)gh_ptr(wsl, bh, (cc), 0) + (16 * q + fr) * 64 + 8 * fq; const GAS float* _hp = (const GAS float*)(gh_ptr(wsl, bh, (cc), 1) + (32 * ih + fr) * 64 + 16 * q + 4 * fq); \
        ga[set][0] = *(const GAS bf16x8*)_gp; ga[set][1] = *(const GAS bf16x8*)(_gp + 32); \
        _Pragma("unroll") for (int _r = 0; _r < 2; ++_r) hq[set][_r] = *(const GAS f32x4*)(_hp + (16 * _r) * 64); } while (0)
    PB_LOAD(0, 0); PB_LOAD(1, 1); PB_LOAD(2, 2); PB_LOAD(3, 3); PB_LOAD(4, 4); PB_LOAD(5, 5);
    for (int c7 = 0; c7 < NCH - 1; c7 += 7) {
#pragma unroll
        for (int u7 = 0; u7 < 7; ++u7) {
            const int c = c7 + u7;
            f32x4 acc[2];
#pragma unroll
            for (int it = 0; it < 2; ++it) acc[it] = hq[u7][it];
            const bf16x8 a0 = ga[u7][0], a1 = ga[u7][1];
            PB_LOAD((u7 + 6) % 7, (c + 6 < NCH - 1) ? c + 6 : NCH - 2);
            if (c > 0) {
#pragma unroll
                for (int it = 0; it < 2; ++it) {
                    acc[it] = __builtin_amdgcn_mfma_f32_16x16x32_bf16(a0, *(const LAS bf16x8*)(Sx0 + (c & 1) * W_SLOT + (32 * ih + 16 * it + fr) * WRS + fq * 16), acc[it], 0, 0, 0);
                    acc[it] = __builtin_amdgcn_mfma_f32_16x16x32_bf16(a1, *(const LAS bf16x8*)(Sx0 + (c & 1) * W_SLOT + (32 * ih + 16 * it + fr) * WRS + 64 + fq * 16), acc[it], 0, 0, 0); }
            }
            GAS bf16_t* op = (GAS bf16_t*)gh_ptr(wsl, bh, c, 0) + 4096 + (32 * ih + fr) * 64 + 16 * q + 4 * fq;
#pragma unroll
            for (int it = 0; it < 2; ++it) { u32x2 w; w.x = cvt_pk_bf16(acc[it].x, acc[it].y); w.y = cvt_pk_bf16(acc[it].z, acc[it].w);
                *(GAS u32x2*)(op + (16 * it) * 64) = w; *(LAS u32x2*)(Sx0 + ((c + 1) & 1) * W_SLOT + (32 * ih + 16 * it + fr) * WRS + (16 * q + 4 * fq) * 2) = w; }
            LDS_BARRIER();
        }
    }
#undef PB_LOAD
}

DI void ln1_router(const Ctx& F, const Params& P, int l, const float* xin) {
    unsigned char* const wsl = F.ws; float* const outl = F.out; (void)outl;
    const float* g = PIN(5) + (size_t)l * DM; const float* bta = PIN(6) + (size_t)l * DM;
    const float* gb = PIN(10) + l * 4; const float* eb = PIN(12) + l * 32;
    const bf16_t* hb = (const bf16_t*)(wsl + WS_HB); bf16_t* xb = (bf16_t*)(wsl + WS_XB); float* xo = outl;
    const bf16_t* wrt = (const bf16_t*)(wsl + WS_WSW + (size_t)l * WSW_STRIDE);
    unsigned* cnt = (unsigned*)(wsl + WS_CTL) + CW_CNT + l * 32 * 64;
    int* ltok = (int*)(wsl + WS_LTOK); float* lgate = (float*)(wsl + WS_LGATE); int* lslot = (int*)(wsl + WS_LSLOT);
    const int lane = F.lane, fr = lane & 15, fq = lane >> 4, wave = F.wave;
    LAS float* lg = (LAS float*)(F.lds + (wave & 3) * 4096);
    LAS float* lgp = (LAS float*)(F.lds + 16384 + (wave & 3) * 4096);
    LAS int* cntl = (LAS int*)(F.lds + 32768); LAS int* basel = cntl + 32;
    if (F.tid < NEXP) cntl[F.tid] = 0;
    __syncthreads();
    LAS float* gls = (LAS float*)(F.lds + 36864 + 52224); LAS float* bls = gls + DM;
    for (int blk = F.bid; blk < NTOK / 64; blk += F.G) {
        { const f32x4 gv = *(const GAS f32x4*)(g + 4 * F.tid), bv = *(const GAS f32x4*)(bta + 4 * F.tid); *(LAS f32x4*)(gls + 4 * F.tid) = gv; *(LAS f32x4*)(bls + 4 * F.tid) = bv; }
        __syncthreads();
#pragma unroll 1
        for (int pass = 0; pass < 4; ++pass) {
            int lno = lane; asm volatile("" : "+v"(lno));
            const int hr2 = lno >> 5, l32 = lno & 31;
            const size_t ro = (size_t)(blk * 64 + wave * 8 + pass * 2 + hr2) * DM + 8 * l32;
            u32x4 xr[8], hr[8];
#pragma unroll
            for (int i = 0; i < 8; ++i) { xr[i] = *(const GAS u32x4*)(xb + ro + 256 * i); hr[i] = *(const GAS u32x4*)(hb + ro + 256 * i); }
            float s = 0.f, s2 = 0.f;
#pragma unroll
            for (int i = 0; i < 8; ++i) {
#pragma unroll
                for (int e = 0; e < 4; ++e) { const float v0 = ALPHA * bflo(xr[i][e]) + bflo(hr[i][e]), v1 = ALPHA * bfhi(xr[i][e]) + bfhi(hr[i][e]); s += v0 + v1; s2 += v0 * v0 + v1 * v1; } }
            s = sum16(s); s2 = sum16(s2); s += __shfl_xor(s, 16); s2 += __shfl_xor(s2, 16);
            const float mean = s * (1.f / DM), rstd = rsqrtf(fmaxf(s2 * (1.f / DM) - mean * mean, 0.f) + LN_EPS);
#pragma unroll
            for (int i = 0; i < 8; ++i) { const int col = 256 * i + 8 * l32;
                const f32x4 g0 = *(const LAS f32x4*)(gls + col), g1 = *(const LAS f32x4*)(gls + col + 4), b0 = *(const LAS f32x4*)(bls + col), b1 = *(const LAS f32x4*)(bls + col + 4);
                u32x4 w;
#pragma unroll
                for (int e = 0; e < 4; ++e) { const float v0 = ALPHA * bflo(xr[i][e]) + bflo(hr[i][e]), v1 = ALPHA * bfhi(xr[i][e]) + bfhi(hr[i][e]);
                    const float gg0 = e < 2 ? g0[2 * e] : g1[2 * e - 4], gg1 = e < 2 ? g0[2 * e + 1] : g1[2 * e - 3], bb0 = e < 2 ? b0[2 * e] : b1[2 * e - 4], bb1 = e < 2 ? b0[2 * e + 1] : b1[2 * e - 3];
                    w[e] = cvt_pk_bf16((v0 - mean) * rstd * gg0 + bb0, (v1 - mean) * rstd * gg1 + bb1); }
                *(GAS u32x4*)(xb + ro + 256 * i) = w;
                asm volatile("" ::: "memory"); }
        }
        VM_WAIT();
        __syncthreads();
        __builtin_amdgcn_fence(__ATOMIC_ACQUIRE, "agent");
        VM_WAIT();
        const int row0 = blk * 64 + (wave & 3) * 16, kh = wave >> 2, krot = (F.bid * 5 + wave * 3) & 31;
        f32x4 acc[3];
#pragma unroll
        for (int ct = 0; ct < 3; ++ct) acc[ct] = (f32x4){0.f, 0.f, 0.f, 0.f};
        const bf16_t* arow = xb + (size_t)(row0 + fr) * DM + 8 * fq + kh * 1024;
        LAS unsigned char* wst = F.lds + 36864;
        u32x4 wreg[6];
        { const int st = F.bid & 7;
#pragma unroll
          for (int i = 0; i < 6; ++i) { const int ch = F.tid + NT * i, row = ch >> 4, c16 = ch & 15, rkh = row / 96, rr = row - rkh * 96;
              wreg[i] = *(const GAS u32x4*)(wrt + (size_t)rr * DM + rkh * 1024 + st * 128 + c16 * 8); } }
#pragma unroll 1
        for (int si = 0; si < 8; ++si) {
            const int st = (si + F.bid) & 7;
            LAS unsigned char* wb = wst + (si & 1) * 52224;
#pragma unroll
            for (int i = 0; i < 6; ++i) { const int ch = F.tid + NT * i, row = ch >> 4, c16 = ch & 15; *(LAS u32x4*)(wb + row * 272 + c16 * 16) = wreg[i]; }
            if (si + 1 < 8) { const int stn = (si + 1 + F.bid) & 7;
#pragma unroll
                for (int i = 0; i < 6; ++i) { const int ch = F.tid + NT * i, row = ch >> 4, c16 = ch & 15, rkh = row / 96, rr = row - rkh * 96;
                    wreg[i] = *(const GAS u32x4*)(wrt + (size_t)rr * DM + rkh * 1024 + stn * 128 + c16 * 8); } }
            bf16x8 af[4];
#pragma unroll
            for (int ksl = 0; ksl < 4; ++ksl) af[ksl] = *(const GAS bf16x8*)(arow + st * 128 + ksl * 32);
            LDS_BARRIER();
#pragma unroll
            for (int ksl = 0; ksl < 4; ++ksl)
#pragma unroll
                for (int ct = 0; ct < 3; ++ct) {
                    acc[ct] = __builtin_amdgcn_mfma_f32_16x16x32_bf16(af[ksl], *(const LAS bf16x8*)(wb + (kh * 96 + 16 * ct + fr) * 272 + ksl * 64 + fq * 16), acc[ct], 0, 0, 0);
                    acc[ct] = __builtin_amdgcn_mfma_f32_16x16x32_bf16(af[ksl], *(const LAS bf16x8*)(wb + (kh * 96 + 48 + 16 * ct + fr) * 272 + ksl * 64 + fq * 16), acc[ct], 0, 0, 0);
                }
        }
        if (kh == 1) {
#pragma unroll
            for (int ct = 0; ct < 3; ++ct)
#pragma unroll
                for (int jj = 0; jj < 4; ++jj) lgp[(4 * fq + jj) * 48 + 16 * ct + fr] = acc[ct][jj];
        }
        __syncthreads();
        if (kh == 0) {
#pragma unroll
            for (int ct = 0; ct < 3; ++ct)
#pragma unroll
                for (int jj = 0; jj < 4; ++jj) lg[(4 * fq + jj) * 48 + 16 * ct + fr] = acc[ct][jj] + lgp[(4 * fq + jj) * 48 + 16 * ct + fr];
        }
        LDS_WAIT();
        int se0 = 0, se1 = 0, sr0 = 0, sr1 = 0, stok = 0; float sg0 = 0.f, sg1 = 0.f;
        if (kh == 0 && lane < 16) {
            const LAS float* L = lg + lane * 48; const int tok = row0 + lane;
            float gl[4]; int grp_i = 0; float gmx;
#pragma unroll
            for (int q = 0; q < 4; ++q) gl[q] = L[q] + gb[q];
            gmx = gl[0];
#pragma unroll
            for (int q = 1; q < 4; ++q) if (gl[q] > gmx) { gmx = gl[q]; grp_i = q; }
            float gs = 0.f;
#pragma unroll
            for (int q = 0; q < 4; ++q) gs += __expf(gl[q] - gmx);
            const float pg = 1.f / gs;
            float el[8];
#pragma unroll
            for (int q = 0; q < 8; ++q) el[q] = L[4 + 8 * grp_i + q] + eb[8 * grp_i + q];
            int i0 = 0; float m0 = el[0];
#pragma unroll
            for (int q = 1; q < 8; ++q) if (el[q] > m0) { m0 = el[q]; i0 = q; }
            int i1 = -1; float m1 = -3.0e38f;
#pragma unroll
            for (int q = 0; q < 8; ++q) if (q != i0 && el[q] > m1) { m1 = el[q]; i1 = q; }
            if (i1 < 0) { i1 = (i0 == 0) ? 1 : 0; m1 = m0; }
            const float p1 = __expf(m1 - m0), den = 1.f / (1.f + p1);
            const float g0 = pg * den, g1 = pg * p1 * den;
            se0 = grp_i * 8 + i0; se1 = grp_i * 8 + i1; sg0 = g0; sg1 = g1; stok = tok;
            sr0 = __hip_atomic_fetch_add(cntl + se0, 1, __ATOMIC_RELAXED, __HIP_MEMORY_SCOPE_WORKGROUP);
            sr1 = __hip_atomic_fetch_add(cntl + se1, 1, __ATOMIC_RELAXED, __HIP_MEMORY_SCOPE_WORKGROUP);
        }
        __syncthreads();
        if (wave == 0 && lane < NEXP) { const int n = cntl[lane]; basel[lane] = n ? (int)__hip_atomic_fetch_add(cnt + lane * 64, (unsigned)n, __ATOMIC_RELAXED, __HIP_MEMORY_SCOPE_AGENT) : 0; }
        __syncthreads();
        if (kh == 0 && lane < 16) {
            const int pos0 = basel[se0] + sr0, pos1 = basel[se1] + sr1;
            ltok[se0 * LISTCAP + pos0] = stok; lgate[se0 * LISTCAP + pos0] = sg0; lslot[se0 * LISTCAP + pos0] = 2 * stok;
            ltok[se1 * LISTCAP + pos1] = stok; lgate[se1 * LISTCAP + pos1] = sg1; lslot[se1 * LISTCAP + pos1] = 2 * stok + 1;
        }
        __syncthreads();
        if (F.tid < NEXP) cntl[F.tid] = 0;
        __syncthreads();
    }
}

DI void ln2_phase(const Ctx& F, const Params& P, int l) {
    unsigned char* const wsl = F.ws; float* const outl = F.out;
    const float* g = PIN(7) + (size_t)l * DM; const float* bta = PIN(8) + (size_t)l * DM;
    const bf16_t* ys = (const bf16_t*)(wsl + WS_YS); bf16_t* xb = (bf16_t*)(wsl + WS_XB); float* xo = outl;
    LAS float* gls = (LAS float*)F.lds; LAS float* bls = gls + DM;
    { const f32x4 gv = *(const GAS f32x4*)(g + 4 * F.tid), bv = *(const GAS f32x4*)(bta + 4 * F.tid); *(LAS f32x4*)(gls + 4 * F.tid) = gv; *(LAS f32x4*)(bls + 4 * F.tid) = bv; }
    __syncthreads();
#pragma unroll 1
    for (int rp = F.gw; rp < NTOK / 2; rp += F.ngw) {
        int lno = F.lane; asm volatile("" : "+v"(lno));
        const int hr2 = lno >> 5, l32 = lno & 31, row = 2 * rp + hr2;
        const size_t ro = (size_t)row * DM + 8 * l32;
        u32x4 xr[8], y0[8], y1[8];
#pragma unroll
        for (int i = 0; i < 8; ++i) { xr[i] = *(const GAS u32x4*)(xb + ro + 256 * i); y0[i] = *(const GAS u32x4*)(ys + 2 * (size_t)row * DM + 8 * l32 + 256 * i); y1[i] = *(const GAS u32x4*)(ys + (2 * (size_t)row + 1) * DM + 8 * l32 + 256 * i); }
        float s = 0.f, s2 = 0.f;
#pragma unroll
        for (int i = 0; i < 8; ++i) {
#pragma unroll
            for (int e = 0; e < 4; ++e) { const float v0 = ALPHA * bflo(xr[i][e]) + (bflo(y0[i][e]) + bflo(y1[i][e])), v1 = ALPHA * bfhi(xr[i][e]) + (bfhi(y0[i][e]) + bfhi(y1[i][e])); s += v0 + v1; s2 += v0 * v0 + v1 * v1; } }
        s = sum16(s); s2 = sum16(s2); s += __shfl_xor(s, 16); s2 += __shfl_xor(s2, 16);
        const float mean = s * (1.f / DM), rstd = rsqrtf(fmaxf(s2 * (1.f / DM) - mean * mean, 0.f) + LN_EPS);
#pragma unroll
        for (int i = 0; i < 8; ++i) { const int col = 256 * i + 8 * l32;
            const f32x4 g0 = *(const LAS f32x4*)(gls + col), g1 = *(const LAS f32x4*)(gls + col + 4), b0 = *(const LAS f32x4*)(bls + col), b1 = *(const LAS f32x4*)(bls + col + 4);
            float o[8];
#pragma unroll
            for (int e = 0; e < 4; ++e) { const float v0 = ALPHA * bflo(xr[i][e]) + (bflo(y0[i][e]) + bflo(y1[i][e])), v1 = ALPHA * bfhi(xr[i][e]) + (bfhi(y0[i][e]) + bfhi(y1[i][e]));
                const float gg0 = e < 2 ? g0[2 * e] : g1[2 * e - 4], gg1 = e < 2 ? g0[2 * e + 1] : g1[2 * e - 3], bb0 = e < 2 ? b0[2 * e] : b1[2 * e - 4], bb1 = e < 2 ? b0[2 * e + 1] : b1[2 * e - 3];
                o[2 * e] = (v0 - mean) * rstd * gg0 + bb0; o[2 * e + 1] = (v1 - mean) * rstd * gg1 + bb1; }
            if (l == NLAYER - 1) { *(GAS f32x4*)(xo + (size_t)row * DM + col) = (f32x4){o[0], o[1], o[2], o[3]}; *(GAS f32x4*)(xo + (size_t)row * DM + col + 4) = (f32x4){o[4], o[5], o[6], o[7]}; }
            else { u32x4 w; w.x = cvt_pk_bf16(o[0], o[1]); w.y = cvt_pk_bf16(o[2], o[3]); w.z = cvt_pk_bf16(o[4], o[5]); w.w = cvt_pk_bf16(o[6], o[7]); *(GAS u32x4*)(xb + ro + 256 * i) = w; }
            asm volatile("" ::: "memory"); }
    }
}

DI int moe_table(const Ctx& F, int l) {
    unsigned char* const wsl = F.ws; float* const outl = F.out; (void)outl;
    LAS int* tb = (LAS int*)(F.lds + LDS_CTL_OFF) + 16;
    const unsigned* cnt = (const unsigned*)(wsl + WS_CTL) + CW_CNT + l * 32 * 64;
    __syncthreads();
    if (F.tid == 0) { int acc = 0;
        for (int e = 0; e < NEXP; ++e) { tb[e] = acc; const int n = (int)__hip_atomic_load(cnt + e * 64, __ATOMIC_RELAXED, __HIP_MEMORY_SCOPE_AGENT); acc += (n + 255) >> 8; }
        tb[NEXP] = acc; }
    __syncthreads();
    return tb[NEXP];
}


#ifdef MK_DEBUG
constexpr int CW_DBG = 40960;
DI void dbg_count_bf16(const Ctx& F, const bf16_t* p, size_t n, int k) {
    unsigned bad = 0; const size_t gt = (size_t)F.bid * NT + F.tid, ngt = (size_t)F.G * NT;
    for (size_t i = gt; i < n; i += ngt) { const unsigned b = p[i]; const float v = bf2f(b); if ((b & 0x7f80u) == 0x7f80u || fabsf(v) > 1.0e6f) ++bad; }
    if (bad) atomicAdd((unsigned*)(F.ws + WS_CTL) + CW_DBG + k * 64, bad);
}
DI void dbg_count_f32(const Ctx& F, const float* p, size_t n, int k) {
    unsigned bad = 0; const size_t gt = (size_t)F.bid * NT + F.tid, ngt = (size_t)F.G * NT;
    for (size_t i = gt; i < n; i += ngt) { const float v = p[i]; if (!(fabsf(v) <= 1.0e6f)) ++bad; }
    if (bad) atomicAdd((unsigned*)(F.ws + WS_CTL) + CW_DBG + k * 64, bad);
}
#endif
constexpr int PH_PER_LAYER = 11, N_PHASES = 1 + NLAYER * PH_PER_LAYER;

__global__ void __launch_bounds__(NT, 2) mega_fwd(Params P) {
    extern __shared__ __attribute__((aligned(16))) unsigned char lds_raw[];
    Ctx F0;
    F0.lds = (LAS unsigned char*)lds_raw;
    F0.tid = threadIdx.x; F0.lane = F0.tid & 63; F0.wave = __builtin_amdgcn_readfirstlane(F0.tid >> 6);
    F0.G = gridDim.x; F0.bid = blockIdx.x; F0.gw = F0.bid * NWAVES + F0.wave; F0.ngw = F0.G * NWAVES;
    F0.ws = P.ws; F0.out = P.out;
    for (int u = F0.tid; u < (LDS_BYTES - LDS_CTL_OFF) / 4; u += NT) ((LAS unsigned*)(F0.lds + LDS_CTL_OFF))[u] = 0u;
    __syncthreads();
    XcdBarrier bar; bar.bar = (unsigned*)(F0.ws + WS_CTL) + CW_BAR; bar.x = 0; bar.st = nullptr;
#if !MK_PER_PHASE
    bar = xcd_barrier_post((unsigned*)(F0.ws + WS_CTL) + CW_BAR, (volatile LAS unsigned*)(F0.lds + LDS_CTL_OFF));
#endif
    const int lo = P.ph_lo, hi = P.ph_hi;
#define IN(k) (lo <= (k) && (k) < hi)
#if MK_PER_PHASE
#define SEAM(k) do { } while (0)
#else
#define SEAM(k) do { if ((k) + 1 < hi) { XcdBarrier _b = bar; asm volatile("" : "+s"(_b.bar), "+s"(_b.x)); xcd_barrier(_b); } } while (0)
#endif
#define WSL const Ctx F = relaunder(F0); unsigned char* const ws = F.ws; bf16_t* const xb = (bf16_t*)(ws + WS_XB); bf16_t* const zb = (bf16_t*)(ws + WS_Z); bf16_t* const cat = (bf16_t*)(ws + WS_CAT); (void)xb; (void)zb; (void)cat

    if (IN(0)) { WSL; phase_prologue(F, P); SEAM(0); }

    for (int l = 0; l < NLAYER; ++l) {
        const int kind = l % 3, j = l / 3, pb = 1 + l * PH_PER_LAYER;
        const int zw = (kind == 0) ? ZW_RWKV : ZW_OTH, qcol = (kind == 0) ? 5056 : 4608;
        if (IN(pb + 0)) {
            WSL; const bf16_t* winT = (const bf16_t*)(ws + WS_WIN + (size_t)l * WIN_STRIDE);
            if (kind != 2) dense_gemm(F, xb, DM, winT, DM, NTOK, zw, DM, zb, zw, 0);
            else {
                dense_gemm(F, xb, DM, winT, DM, NTOK, 3072, DM, zb, zw, 0);
                dense_gemm(F, xb, DM, winT + (size_t)4608 * DM, DM, NTOK, 512, DM, zb + 4608, zw, 0);
                dense_gemm(F, winT + (size_t)3072 * DM, DM, xb, DM, CMIX, NTOK, DM, (bf16_t*)(ws + WS_ACT), NTOK, 128);
            }
            if (l == 0) {
                dense_gemm(F, (const bf16_t*)(ws + WS_MEMB), DM, (const bf16_t*)(ws + WS_WK), DM, NBATCH * MEML, 2048, DM, (bf16_t*)(ws + WS_KM), 2048, 128);
                dense_gemm(F, (const bf16_t*)(ws + WS_WV), DM, (const bf16_t*)(ws + WS_MEMB), DM, 2048, NBATCH * MEML, DM, (bf16_t*)(ws + WS_VMT), 1024, 192);
            }
            SEAM(pb + 0);
        }
        if (IN(pb + 1)) {
            WSL;
            if (kind == 0) { for (int rep = 0; rep < REP_PREP; ++rep) rwkv_prep1(F, P, j, zb); for (int rep = 0; rep < REP_MIX * REP_MA; ++rep) memattn_all(F, l, zb, zw, qcol); }
            else if (kind == 1) { for (int rep = 0; rep < REP_MIX; ++rep) conv_mix(F, P, zb); for (int rep = 0; rep < REP_MIX * REP_MA; ++rep) memattn_all(F, l, zb, zw, qcol); for (int rep = 0; rep < REP_CONV; ++rep) expert_convert(F, P, l, F.gw, F.ngw); }
            else { for (int rep = 0; rep < REP_MIX * REP_SB; ++rep) sb_attention(F, zb); for (int rep = 0; rep < REP_MIX * REP_MA; ++rep) memattn_all(F, l, zb, zw, qcol); for (int rep = 0; rep < REP_CONV; ++rep) expert_convert(F, P, l, F.gw, F.ngw); }
            SEAM(pb + 1);
        }
        if (kind == 0) {
            if (IN(pb + 2)) {
                WSL; const bf16_t* act = (const bf16_t*)(ws + WS_ACT); const bf16_t* wa = (const bf16_t*)(ws + WS_LORA + (size_t)j * LORA_STRIDE);
                dense_gemm(F, act, 512, wa, 256, NTOK, 3072, 256, (bf16_t*)(ws + WS_LW), 3072, 0);
                dense_gemm(F, act + 256, 512, wa + (size_t)3072 * 256, 256, NTOK, CMIX, 256, (bf16_t*)(ws + WS_GATE), CMIX, 0);
                SEAM(pb + 2);
            }
            if (IN(pb + 3)) { WSL; const RwPar Q{PIN(17) + (size_t)j * 5056, PIN(18) + j * CMIX, PIN(20) + j * CMIX, PIN(23) + j * CMIX, PIN(24) + j * CMIX, PIN(25) + j * CMIX, PIN(26) + j * CMIX, PIN(27) + j * CMIX};
                for (int rep = 0; rep < REP_SCAN; ++rep) scan_w1(F, Q, zb); SEAM(pb + 3); }
            if (IN(pb + 4)) {
                WSL;
                if (F.bid < 96) scan_passB(F);
                else expert_convert(F, P, l, (F.bid - 96) * NWAVES + F.wave, (F.G - 96) * NWAVES);
                SEAM(pb + 4);
            }
            if (IN(pb + 5)) { WSL; const RwPar Q{PIN(17) + (size_t)j * 5056, PIN(18) + j * CMIX, PIN(20) + j * CMIX, PIN(23) + j * CMIX, PIN(24) + j * CMIX, PIN(25) + j * CMIX, PIN(26) + j * CMIX, PIN(27) + j * CMIX};
                for (int rep = 0; rep < REP_SCAN * REP_W2; ++rep) scan_w2(F, Q); SEAM(pb + 5); }
        }
        if (IN(pb + 6)) { WSL; dense_gemm(F, cat, DM, (const bf16_t*)(ws + WS_WOUT) + (size_t)l * DM * DM, DM, NTOK, DM, DM, (bf16_t*)(ws + WS_HB), DM, 0); SEAM(pb + 6); }
        if (IN(pb + 7)) { WSL; ln1_router(F, P, l, l == 0 ? PIN(0) : (const float*)P.out); SEAM(pb + 7); }
        if (IN(pb + 8)) {
            WSL; const int ntiles = moe_table(F, l);
            pg8::Gemm g{xb, (const bf16_t*)(ws + WS_EXP1), DM, DM, DM};
            pg8::MoeOrder<true> S; S.G = F.G; S.c = F.bid; S.npn = 4; S.total = ntiles * 4; S.tb = (const LAS int*)(F.lds + LDS_CTL_OFF) + 16; S.estride = (size_t)1024 * DM * 2;
            S.ltok = (const int*)(ws + WS_LTOK); S.cnt = (const unsigned*)(ws + WS_CTL) + CW_CNT + l * 32 * 64;
            pg8::EpiSwiGLU E{(bf16_t*)(ws + WS_HE)};
            for (int rep = 0; rep < REP_MOE; ++rep) pg8::gemm_phase<pg8::EpiSwiGLU, pg8::MoeOrder<true>>(F.lds, g, S, E);
            SEAM(pb + 8);
        }
        if (IN(pb + 9)) {
            WSL; const int ntiles = moe_table(F, l);
            pg8::Gemm g{(const bf16_t*)(ws + WS_HE), (const bf16_t*)(ws + WS_EXP2), DEXP, DEXP, DEXP};
            pg8::MoeOrder<false> S; S.G = F.G; S.c = F.bid; S.npn = 8; S.total = ntiles * 8; S.tb = (const LAS int*)(F.lds + LDS_CTL_OFF) + 16; S.estride = (size_t)DM * DEXP * 2;
            S.ltok = (const int*)(ws + WS_LTOK); S.cnt = (const unsigned*)(ws + WS_CTL) + CW_CNT + l * 32 * 64;
            pg8::EpiScatter E{(bf16_t*)(ws + WS_YS), (const int*)(ws + WS_LSLOT), (const float*)(ws + WS_LGATE), S.cnt};
            for (int rep = 0; rep < REP_MOE; ++rep) pg8::gemm_phase<pg8::EpiScatter, pg8::MoeOrder<false>>(F.lds, g, S, E);
            SEAM(pb + 9);
        }
        if (IN(pb + 10)) { WSL; ln2_phase(F, P, l); SEAM(pb + 10); }
    }
#ifdef MK_DEBUG
    {
        WSL;
        xcd_barrier(bar);
        dbg_count_bf16(F, (const bf16_t*)(ws + WS_CAT), (size_t)NTOK * DM, 0);
        dbg_count_bf16(F, (const bf16_t*)(ws + WS_HB), (size_t)NTOK * DM, 1);
        dbg_count_f32(F, (const float*)(ws + WS_LGATE), (size_t)32 * 16384, 2);
        dbg_count_bf16(F, (const bf16_t*)(ws + WS_YS), (size_t)32768 * 2048, 3);
        dbg_count_f32(F, (const float*)F.out, (size_t)NTOK * DM, 4);
        dbg_count_bf16(F, (const bf16_t*)(ws + WS_XB), (size_t)NTOK * DM, 5);
        xcd_barrier(bar);
        int first = 13;
        for (int k = 12; k >= 0; --k) if (__hip_atomic_load((unsigned*)(ws + WS_CTL) + CW_DBG + k * 64, __ATOMIC_RELAXED, __HIP_MEMORY_SCOPE_AGENT) != 0u) first = k;
        const float val = 1000.f * (float)(first + 1);
        for (size_t i = (size_t)F.bid * NT + F.tid; i < (size_t)NTOK * DM; i += (size_t)F.G * NT) F.out[i] = val;
    }
#endif
#undef IN
#undef SEAM
}

extern "C" void kernel_launch(void* const* d_in, const int* in_sizes, int n_in, void* d_out, int out_size, void* d_ws, size_t ws_size, hipStream_t stream) {
    static int grid = 0;
    if (grid == 0) {
        if (n_in != 31 || ws_size < WS_END) { fprintf(stderr, "kernel_launch: expected 31 inputs and >= %zu bytes of workspace, got %d / %zu\n", (size_t)WS_END, n_in, ws_size); grid = -1; return; }
        int dev = 0, cus = 0, per_cu = 0;
        if (hipGetDevice(&dev) != hipSuccess || hipDeviceGetAttribute(&cus, hipDeviceAttributeMultiprocessorCount, dev) != hipSuccess) { grid = -1; return; }
        if (hipFuncSetAttribute((const void*)mega_fwd, hipFuncAttributeMaxDynamicSharedMemorySize, LDS_BYTES) != hipSuccess) { fprintf(stderr, "kernel_launch: hipFuncSetAttribute failed\n"); grid = -1; return; }
        if (hipOccupancyMaxActiveBlocksPerMultiprocessor(&per_cu, (const void*)mega_fwd, NT, LDS_BYTES) != hipSuccess || per_cu < 1)
            fprintf(stderr, "kernel_launch: occupancy query reports %d workgroups per CU\n", per_cu);
        (void)hipGetLastError();
        grid = cus;
    }
    if (grid < 0) return;
    (void)hipMemsetAsync((char*)d_ws + WS_CTL, 0, CTL_BYTES, stream);
    Params p{};
    for (int i = 0; i < 31; ++i) p.in[i] = (const float*)d_in[i];
    p.out = (float*)d_out; p.ws = (unsigned char*)d_ws;
#if MK_PER_PHASE
    for (int ph = 0; ph < N_PHASES; ++ph) {
        if (ph > 0) { const int l = (ph - 1) / PH_PER_LAYER, loc = (ph - 1) % PH_PER_LAYER; if ((l % 3) != 0 && loc >= 2 && loc <= 5) continue; }
        p.ph_lo = ph; p.ph_hi = ph + 1;
        hipLaunchKernelGGL(mega_fwd, dim3(grid), dim3(NT), LDS_BYTES, stream, p);
    }
#else
#ifndef MK_PH_HI
#define MK_PH_HI N_PHASES
#endif
    p.ph_lo = 0; p.ph_hi = MK_PH_HI;
    hipLaunchKernelGGL(mega_fwd, dim3(grid), dim3(NT), LDS_BYTES, stream, p);
#endif
    const hipError_t le = hipPeekAtLastError();
    if (le != hipSuccess) fprintf(stderr, "kernel_launch: launch failed: %s\n", hipGetErrorName(le));
}
```

```cpp
#include <hip/hip_runtime.h>
#include <cstdio>
#include <cstdint>

#ifndef MK_PER_PHASE
#define MK_PER_PHASE 0
#endif
#ifndef MK_PH_HI
#define MK_PH_HI N_PHASES
#endif
#ifndef REP_GEMM
#define REP_GEMM 1
#endif
#ifndef REP_MOE
#define REP_MOE 1
#endif
#ifndef REP_SCAN
#define REP_SCAN 1
#endif
#ifndef REP_PREP
#define REP_PREP 1
#endif
#ifndef REP_MIX
#define REP_MIX 1
#endif
#ifndef REP_CONV
#define REP_CONV 1
#endif
#ifndef REP_SB
#define REP_SB 1
#endif
#ifndef REP_MA
#define REP_MA 1
#endif
#ifndef REP_WX
#define REP_WX 1
#endif
#ifndef REP_WS
#define REP_WS 1
#endif
#ifndef REP_WO
#define REP_WO 1
#endif
#ifndef REP_W2
#define REP_W2 1
#endif

#define LAS __attribute__((address_space(3)))
#define GAS __attribute__((address_space(1)))
#define DI __device__ __forceinline__
typedef unsigned short bf16_t;
typedef short bf16x8 __attribute__((ext_vector_type(8)));
typedef short s16x4 __attribute__((ext_vector_type(4)));
typedef float f32x2 __attribute__((ext_vector_type(2)));
typedef float f32x4 __attribute__((ext_vector_type(4)));
typedef float f32x8 __attribute__((ext_vector_type(8)));
typedef float f32x16 __attribute__((ext_vector_type(16)));
typedef unsigned u32x2 __attribute__((ext_vector_type(2)));
typedef unsigned u32x4 __attribute__((ext_vector_type(4)));

constexpr int NTOK = 16384, DM = 2048, SEQ = 4096, NBATCH = 4, CMIX = 1536, MEMW = 512, MEML = 256, NLAYER = 4;
constexpr int ZW_RWKV = 5632  , ZW_OTH = 5120, RW_IN_COLS = 5568;
constexpr int NEXP = 32, DEXP = 512, LISTCAP = 16384, MAXTILES = 160;
constexpr float LN_EPS = 1e-5f, ALPHA = 1.681792830507429f, GN_EPS = 64e-5f;
constexpr int NT = 512, NWAVES = 8;

constexpr size_t MiB = (size_t)1 << 20;
constexpr size_t WS_CTL = 0, CTL_BYTES = 1 * MiB;
constexpr size_t WS_WIN = 2 * MiB;
constexpr size_t WIN_STRIDE = 22 * MiB;
constexpr size_t WS_WOUT = 90 * MiB;
constexpr size_t WS_WK = 122 * MiB;
constexpr size_t WS_WV = 130 * MiB;
constexpr size_t WS_MEMB = 138 * MiB;
constexpr size_t WS_KM = 142 * MiB;
constexpr size_t WS_VMT = 146 * MiB;
constexpr size_t WS_LORA = 150 * MiB;
constexpr size_t LORA_STRIDE = 3 * MiB;
constexpr size_t WS_WSW = 156 * MiB;
constexpr size_t WSW_STRIDE = 393216;
constexpr size_t WS_EXP1 = 160 * MiB;
constexpr size_t WS_EXP2 = 288 * MiB;
constexpr size_t WS_XB = 352 * MiB;
constexpr size_t WS_Z = 416 * MiB;
constexpr size_t WS_CAT = 592 * MiB;
constexpr size_t WS_HB = 656 * MiB;
constexpr size_t WS_LTOK = 720 * MiB;
constexpr size_t WS_LGATE = 722 * MiB;
constexpr size_t WS_LSLOT = 724 * MiB;
constexpr size_t WS_HE = 728 * MiB;
constexpr size_t WS_YS = 768 * MiB;
constexpr size_t WS_ACT = 896 * MiB;
constexpr size_t WS_LW = 944 * MiB;
constexpr size_t WS_GATE = 1040 * MiB;
constexpr size_t WS_SCAN = 1088 * MiB;
constexpr size_t WS_V = 1568 * MiB;
constexpr size_t WS_Y = 1664 * MiB;
constexpr size_t WS_GH = 1760 * MiB;
constexpr size_t WS_QY = 1088 * MiB;
constexpr size_t WS_Y0T = 1152 * MiB;
constexpr size_t WS_E = 1280 * MiB;
constexpr size_t WS_END = 1952 * MiB;
constexpr int CW_BAR = 4096;
constexpr int CW_CNT = 16384;

constexpr int LDS_BYTES = 147456;
constexpr int LDS_CTL_OFF = 146432;

DI float bf2f(unsigned b) { return __uint_as_float(b << 16); }
typedef float cvt_f32x2 __attribute__((ext_vector_type(2)));
typedef __bf16 cvt_bf16x2 __attribute__((ext_vector_type(2)));
DI unsigned cvt_pk_bf16(float lo, float hi) { const cvt_f32x2 v = {lo, hi}; return __builtin_bit_cast(unsigned, __builtin_convertvector(v, cvt_bf16x2)); }
DI float bflo(unsigned w) { return __uint_as_float(w << 16); }
DI float bfhi(unsigned w) { return __uint_as_float(w & 0xffff0000u); }
DI float wave_sum(float v) {
#pragma unroll
    for (int o = 1; o < 64; o <<= 1) v += __shfl_xor(v, o);
    return v;
}
DI float sum16(float v) {
    v += __builtin_bit_cast(float, __builtin_amdgcn_update_dpp(0, __builtin_bit_cast(int, v), 0x128, 0xf, 0xf, false));
    v += __builtin_bit_cast(float, __builtin_amdgcn_update_dpp(0, __builtin_bit_cast(int, v), 0x124, 0xf, 0xf, false));
    v += __builtin_bit_cast(float, __builtin_amdgcn_update_dpp(0, __builtin_bit_cast(int, v), 0x122, 0xf, 0xf, false));
    v += __builtin_bit_cast(float, __builtin_amdgcn_update_dpp(0, __builtin_bit_cast(int, v), 0x121, 0xf, 0xf, false));
    return v;
}
DI float fma_s(float a, float b, float c) { float d; asm("v_fma_f32 %0, %1, %2, %3" : "=v"(d) : "v"(a), "v"(b), "v"(c)); return d; }
DI float sigmoidf_(float x) { return __builtin_amdgcn_rcpf(1.f + __expf(-x)); }
DI float softplusf_(float x) { return fmaxf(x, 0.f) + __logf(1.f + __expf(-fabsf(x))); }
#define LDS_WAIT() asm volatile("s_waitcnt lgkmcnt(0)" ::: "memory")
#define VM_WAIT() asm volatile("s_waitcnt vmcnt(0)" ::: "memory")
#define LDS_BARRIER() do { asm volatile("s_waitcnt lgkmcnt(0)" ::: "memory"); __builtin_amdgcn_s_barrier(); asm volatile("" ::: "memory"); } while (0)

template <class T> DI T* as_global(T* p) { return p; }
DI const float* kin_ptr(int i) { int off = i * 8; asm volatile("" : "+v"(off)); const char* ka = (const char*)__builtin_amdgcn_kernarg_segment_ptr();
    const unsigned long long p = *(const unsigned long long*)(ka + off);
    const unsigned lo = __builtin_amdgcn_readfirstlane((unsigned)p), hi = __builtin_amdgcn_readfirstlane((unsigned)(p >> 32));
    return as_global((const float*)(((unsigned long long)hi << 32) | lo)); }
#define PIN(i) kin_ptr(i)
DI unsigned char* opq(unsigned char* p) { asm volatile("" : "+s"(p)); return p; }
DI float* opqf(float* p) { asm volatile("" : "+s"(p)); return p; }

#define XB_TMO      128
#define XB_XCNT(j)  (256  + 64 * (j))
#define XB_XSUB(j)  (1280 + 64 * (j))
#define XB_XGEN(j)  (2304 + 64 * (j))
#define XB_TOP      3328
#define XB_TOPGEN   3392
#define XCD_BAR_WORDS 3456
#define XB_SPIN_CAP (1u << 20)

__device__ __forceinline__ unsigned xb_ld(unsigned* p)              { return __hip_atomic_load(p, __ATOMIC_RELAXED, __HIP_MEMORY_SCOPE_AGENT); }
__device__ __forceinline__ unsigned xb_add(unsigned* p, unsigned v) { return __hip_atomic_fetch_add(p, v, __ATOMIC_RELAXED, __HIP_MEMORY_SCOPE_AGENT); }
__device__ __forceinline__ unsigned xb_xcc_id() { return (unsigned)__builtin_amdgcn_s_getreg((3 << 11) | 20) & 0xFu; }
#define XB_SPIN(cond, bar) do { unsigned _sp = 0; while (cond) { __builtin_amdgcn_s_sleep(1); \
    if ((++_sp & 255u) == 0u) { if (xb_ld(&(bar)[XB_TMO])) break; if (_sp > XB_SPIN_CAP) { atomicAdd(&(bar)[XB_TMO], 1u); break; } } } } while (0)

struct XcdBarrier { unsigned* bar; unsigned x; volatile LAS unsigned* st; };

__device__ __forceinline__ XcdBarrier xcd_barrier_post(unsigned* bar, volatile LAS unsigned* st) {
    XcdBarrier b; b.bar = bar; b.x = xb_xcc_id(); b.st = st;
    if (threadIdx.x == 0) (void)xb_add(&bar[XB_XCNT(b.x)], 1u);
    return b;
}
__device__ __forceinline__ void xcd_barrier_complete(unsigned* bar, unsigned x, unsigned& nloc, unsigned& nx) {
    const unsigned G = gridDim.x * gridDim.y * gridDim.z;
    unsigned sum, cnt, mine, sp = 0u;
    for (;;) {
        sum = 0u; cnt = 0u; mine = 0u;
#pragma unroll
        for (unsigned j = 0; j < 16; ++j) { const unsigned c = xb_ld(&bar[XB_XCNT(j)]); sum += c; cnt += (c > 0u) ? 1u : 0u; mine = (j == x) ? c : mine; }
        if (sum == G) break;
        __builtin_amdgcn_s_sleep(1);
        if ((++sp & 255u) == 0u) { if (xb_ld(&bar[XB_TMO])) break; if (sp > XB_SPIN_CAP) { atomicAdd(&bar[XB_TMO], 1u); break; } }
    }
    nloc = mine > 0u ? mine : 1u; nx = cnt > 0u ? cnt : 1u;
}
__device__ __forceinline__ void xcd_barrier(const XcdBarrier& b) {
    asm volatile("s_waitcnt vmcnt(0)" ::: "memory");
    __syncthreads();
    if (threadIdx.x == 0) {
        unsigned* bar = b.bar;
        __builtin_amdgcn_s_waitcnt(0);
        unsigned nloc = b.st[0], nx = b.st[1];
        if (nloc == 0u) { xcd_barrier_complete(bar, b.x, nloc, nx); b.st[0] = nloc; b.st[1] = nx; }
        const unsigned old = xb_add(&bar[XB_XSUB(b.x)], 1u);
        const unsigned gen = old / nloc;
        if (old + 1u == (gen + 1u) * nloc) {
            __builtin_amdgcn_fence(__ATOMIC_RELEASE, "agent");
            asm volatile("s_waitcnt vmcnt(0)" ::: "memory");
            const unsigned og = xb_add(&bar[XB_TOP], 1u);
            const unsigned tg = og / nx;
            if (og + 1u == (tg + 1u) * nx) xb_add(&bar[XB_TOPGEN], 1u);
            else XB_SPIN(xb_ld(&bar[XB_TOPGEN]) == tg, bar);
            __builtin_amdgcn_fence(__ATOMIC_ACQUIRE, "agent");
            xb_add(&bar[XB_XGEN(b.x)], 1u);
            asm volatile("s_waitcnt vmcnt(0)" ::: "memory");
        } else {
            XB_SPIN(xb_ld(&bar[XB_XGEN(b.x)]) == gen, bar);
            __builtin_amdgcn_fence(__ATOMIC_ACQUIRE, "agent");
            asm volatile("s_waitcnt vmcnt(0)" ::: "memory");
        }
    }
    __syncthreads();
}

namespace pg8 {
constexpr int BM = 256, BK = 64, HALF = 128, HTB = HALF * BK * 2, STAGE_BYTES = 8 * HTB, NXCD = 8, WGM = 8;
DI int lds_byte(int r, int c) { const int st = (r >> 4) * 2 + (c >> 5), rr = r & 15, cc = c & 31, ob = rr * 64 + cc * 2; return st * 1024 + (ob ^ (((ob >> 9) & 1) << 5)); }
DI void stage_rc(int b, int& R, int& C) { const int st = b / 1024, sb = b % 1024, swz = sb ^ (((sb >> 9) & 1) << 5); R = (st >> 1) * 16 + swz / 64; C = (st & 1) * 32 + (swz % 64) / 2; }
DI int perm32(int rho) { const int n = rho >> 4, i = rho & 15; return 8 * (i >> 2) + 4 * n + (i & 3); }

struct Unit { int pm, pn, e, rt; };
struct Gemm { const bf16_t* A; const bf16_t* Bt; int lda, ldb, K; };

struct StaticOrder {
    static constexpr bool GATHER = false;
    int nM, nN, nwg, G, c;
    DI void init(int M, int N, int G_, int c_) { nM = M / BM; nN = N / BM; nwg = nM * nN; G = G_; c = c_; }
    DI bool next(int i, Unit& u) const {
        const long L = (long)i * G + c; if (L >= nwg) return false;
        int wgid = (int)L; { const int q = nwg / NXCD, r = nwg % NXCD, xcd = wgid % NXCD, off = wgid / NXCD; wgid = (xcd < r ? xcd * (q + 1) : r * (q + 1) + (xcd - r) * q) + off; }
        const int nig = WGM * nN, gid = wgid / nig, fm = gid * WGM, gsz = (nM - fm) < WGM ? (nM - fm) : WGM;
        u.pm = fm + ((wgid % nig) % gsz); u.pn = (wgid % nig) / gsz; u.e = 0; u.rt = 0; return true;
    }
    DI const char* a_base(const Gemm& g, const Unit& u) const { return (const char*)g.A + (size_t)u.pm * BM * g.lda * 2; }
    DI const char* b_base(const Gemm& g, const Unit& u) const { return (const char*)g.Bt + (size_t)u.pn * BM * g.ldb * 2; }
    DI unsigned gather_voff(const Unit&, int, int, int) const { return 0u; }
};

template <bool GATH> struct MoeOrder {
    static constexpr bool GATHER = GATH;
    int G, c, npn, total; const LAS int* tb; size_t estride; const int* ltok; const unsigned* cnt;
    DI bool next(int i, Unit& u) const {
        if ((G & 7) == 0) {
            const int x = c & 7, r = c >> 3, W = G >> 3, idx = i * W + r;
            const int q = idx / npn, pn = idx - q * npn; int base = 0;
#pragma unroll
            for (int k = 0; k < 4; ++k) { const int e = x + 8 * k, nt = tb[e + 1] - tb[e];
                if (q < base + nt) { u.e = e; u.rt = q - base; u.pm = tb[e] + u.rt; u.pn = pn; return true; }
                base += nt; }
            return false;
        }
        const int L = i * G + c; if (L >= total) return false;
        const int q = L / npn; u.pn = L - q * npn; u.pm = q;
        int e = 0; while (e < NEXP - 1 && tb[e + 1] <= q) ++e;
        u.e = e; u.rt = q - tb[e]; return true;
    }
    DI const char* a_base(const Gemm& g, const Unit& u) const { return (const char*)g.A + (size_t)u.pm * BM * g.lda * 2; }
    DI const char* b_base(const Gemm& g, const Unit& u) const { return (const char*)g.Bt + (size_t)u.e * estride + (size_t)u.pn * BM * g.ldb * 2; }
    DI unsigned gather_voff(const Unit& u, int r, int C, int lda) const {
        const int pos = u.rt * BM + r; const int n = (int)__hip_atomic_load(cnt + u.e * 64, __ATOMIC_RELAXED, __HIP_MEMORY_SCOPE_AGENT);
        const int tok = pos < n ? ltok[u.e * LISTCAP + pos] : 0;
        return (unsigned)(tok * lda + C) * 2u;
    }
};

struct EpiStore {
    bf16_t* O; int ldc;
    DI void operator()(const f32x4 (&acc)[2][2][4][2], const Unit& u, int wr, int wc, int fr, int fq) const {
        const int row0 = u.pm * BM + wr * 64 + fr, col0 = u.pn * BM + wc * 32 + 8 * fq;
#pragma unroll
        for (int ai = 0; ai < 2; ++ai)
#pragma unroll
            for (int m = 0; m < 4; ++m) { bf16_t* rowp = O + (size_t)(row0 + ai * HALF + m * 16) * ldc + col0;
#pragma unroll
                for (int bj = 0; bj < 2; ++bj) { const f32x4 v0 = acc[ai][bj][m][0], v1 = acc[ai][bj][m][1];
                    u32x4 w; w.x = cvt_pk_bf16(v0[0], v0[1]); w.y = cvt_pk_bf16(v0[2], v0[3]); w.z = cvt_pk_bf16(v1[0], v1[1]); w.w = cvt_pk_bf16(v1[2], v1[3]);
                    *(GAS u32x4*)(rowp + bj * HALF) = w; } }
    }
};
struct EpiSwiGLU {
    bf16_t* H;
    DI void operator()(const f32x4 (&acc)[2][2][4][2], const Unit& u, int wr, int wc, int fr, int fq) const {
        const int row0 = u.pm * BM + wr * 64 + fr, col0 = u.pn * HALF + wc * 32 + 8 * fq;
#pragma unroll
        for (int ai = 0; ai < 2; ++ai)
#pragma unroll
            for (int m = 0; m < 4; ++m) { bf16_t* rowp = H + (size_t)(row0 + ai * HALF + m * 16) * DEXP + col0;
                float h[8];
#pragma unroll
                for (int n = 0; n < 2; ++n)
#pragma unroll
                    for (int j = 0; j < 4; ++j) { const float gt = acc[ai][0][m][n][j], up = acc[ai][1][m][n][j]; h[n * 4 + j] = gt * __builtin_amdgcn_rcpf(1.f + __expf(-gt)) * up; }
                u32x4 w; w.x = cvt_pk_bf16(h[0], h[1]); w.y = cvt_pk_bf16(h[2], h[3]); w.z = cvt_pk_bf16(h[4], h[5]); w.w = cvt_pk_bf16(h[6], h[7]);
                *(GAS u32x4*)rowp = w; }
    }
};
struct EpiScatter {
    bf16_t* YS; const int* lslot; const float* lgate; const unsigned* cnt;
    DI void operator()(const f32x4 (&acc)[2][2][4][2], const Unit& u, int wr, int wc, int fr, int fq) const {
        const int n = (int)__hip_atomic_load(cnt + u.e * 64, __ATOMIC_RELAXED, __HIP_MEMORY_SCOPE_AGENT);
        const int col0 = u.pn * BM + wc * 32 + 8 * fq;
        int slots[2][4]; float gts[2][4];
#pragma unroll
        for (int ai = 0; ai < 2; ++ai)
#pragma unroll
            for (int m = 0; m < 4; ++m) { int pos = u.rt * BM + ai * HALF + wr * 64 + m * 16 + fr; pos = pos < LISTCAP ? pos : LISTCAP - 1;
                slots[ai][m] = *(const GAS int*)(lslot + u.e * LISTCAP + pos); gts[ai][m] = *(const GAS float*)(lgate + u.e * LISTCAP + pos); }
#pragma unroll
        for (int ai = 0; ai < 2; ++ai)
#pragma unroll
            for (int m = 0; m < 4; ++m) { const int pos = u.rt * BM + ai * HALF + wr * 64 + m * 16 + fr;
                if (pos < n) { const int slot = slots[ai][m]; const float gt = gts[ai][m];
                    bf16_t* rowp = YS + (size_t)slot * DM + col0;
#pragma unroll
                    for (int bj = 0; bj < 2; ++bj) { const f32x4 v0 = acc[ai][bj][m][0] * gt, v1 = acc[ai][bj][m][1] * gt;
                        u32x4 w; w.x = cvt_pk_bf16(v0[0], v0[1]); w.y = cvt_pk_bf16(v0[2], v0[3]); w.z = cvt_pk_bf16(v1[0], v1[1]); w.w = cvt_pk_bf16(v1[2], v1[3]);
                        *(GAS u32x4*)(rowp + bj * HALF) = w; } } }
    }
};

template <class Epi, class Sched>
DI void gemm_phase(LAS unsigned char* lds, const Gemm g, const Sched& S, const Epi& E) {
    int tid = threadIdx.x; asm volatile("" : "+v"(tid));
    const int wid = __builtin_amdgcn_readfirstlane(tid >> 6), lane = tid & 63, wr = wid >> 2, wc = wid & 3, fr = lane & 15, fq = lane >> 4;
    const int K = g.K, nt = K / BK;
    unsigned voffA[2], voffB[2];
#pragma unroll
    for (int i = 0; i < 2; ++i) { int R, C; stage_rc(tid * 16 + i * 8192, R, C); const int Rb = (R & ~31) + perm32(R & 31);
        voffA[i] = (unsigned)(R * g.lda + C) * 2u; voffB[i] = (unsigned)(Rb * g.ldb + C) * 2u; }
    const size_t kstep = (size_t)(BK * 2);
    const size_t hstepA = (size_t)HALF * g.lda * 2, hstepB = (size_t)HALF * g.ldb * 2;
    const unsigned ldsw = (unsigned)wid * 1024u;
    const int aoff = lds_byte(wr * 64 + fr, fq * 8), boff = lds_byte(wc * 32 + fr, fq * 8);
    unsigned gvC[2][2], gvN[2][2];
#define PG8_SA(b, h) (((b) * 2 + (h)) * HTB)
#define PG8_SB(b, h) ((4 + (b) * 2 + (h)) * HTB)
#define PG8_STAGE(bufoff, gbase, voff) do { _Pragma("unroll") for (int _i = 0; _i < 2; ++_i) \
        __builtin_amdgcn_global_load_lds((const unsigned*)((const char*)(gbase) + (voff)[_i]), (LAS unsigned*)(lds + (bufoff) + ldsw + _i * 8192), 16, 0, 0); } while (0)
#define PG8_STAGE_A(bufoff, h, nxtsel, kt) do { \
        if constexpr (Sched::GATHER) { const char* _gb = (const char*)g.A + (size_t)(kt) * kstep; unsigned _vo[2]; _vo[0] = (nxtsel) ? gvN[h][0] : gvC[h][0]; _vo[1] = (nxtsel) ? gvN[h][1] : gvC[h][1]; PG8_STAGE(bufoff, _gb, _vo); } \
        else { const char* _gb = ((nxtsel) ? nA : cA) + (size_t)(h) * hstepA + (size_t)(kt) * kstep; PG8_STAGE(bufoff, _gb, voffA); } } while (0)
#define PG8_GSETUP(dst, u) do { if constexpr (Sched::GATHER) { _Pragma("unroll") for (int _h = 0; _h < 2; ++_h) _Pragma("unroll") for (int _i = 0; _i < 2; ++_i) { int _R, _C; stage_rc(tid * 16 + _i * 8192, _R, _C); \
        dst[_h][_i] = S.gather_voff(u, _h * HALF + _R, _C, g.lda); } asm volatile("s_waitcnt vmcnt(0)" : "+v"(dst[0][0]), "+v"(dst[0][1]), "+v"(dst[1][0]), "+v"(dst[1][1]) :: "memory"); } } while (0)
#define PG8_LDA(dst, b, h) do { _Pragma("unroll") for (int m = 0; m < 4; ++m) _Pragma("unroll") for (int k = 0; k < 2; ++k) dst[m][k] = *(const LAS bf16x8*)(lds + PG8_SA(b, h) + aoff + m * 2048 + k * 1024); } while (0)
#define PG8_LDB(dst, b, h) do { _Pragma("unroll") for (int n = 0; n < 2; ++n) _Pragma("unroll") for (int k = 0; k < 2; ++k) dst[n][k] = *(const LAS bf16x8*)(lds + PG8_SB(b, h) + boff + n * 2048 + k * 1024); } while (0)
#define PG8_MMA(ai, bj, At, Bt) do { __builtin_amdgcn_s_setprio(1); _Pragma("unroll") for (int m = 0; m < 4; ++m) _Pragma("unroll") for (int n = 0; n < 2; ++n) _Pragma("unroll") for (int k = 0; k < 2; ++k) \
        acc[ai][bj][m][n] = __builtin_amdgcn_mfma_f32_16x16x32_bf16(Bt[n][k], At[m][k], acc[ai][bj][m][n], 0, 0, 0); __builtin_amdgcn_s_setprio(0); } while (0)
#define PG8_WAIT_V(n) asm volatile("s_waitcnt vmcnt(" #n ")" ::: "memory")
#define PG8_WAIT_L(n) asm volatile("s_waitcnt lgkmcnt(" #n ")" ::: "memory")
#define PG8_BAR __builtin_amdgcn_s_barrier()
#define PG8_SCHED __builtin_amdgcn_sched_barrier(0)
    Unit cur, nxt; int ui = 0;
    if (!S.next(0, cur)) return;
    f32x4 acc[2][2][4][2];
#pragma unroll
    for (int a = 0; a < 2; ++a)
#pragma unroll
        for (int b = 0; b < 2; ++b)
#pragma unroll
            for (int m = 0; m < 4; ++m)
#pragma unroll
                for (int n = 0; n < 2; ++n) acc[a][b][m][n] = (f32x4){0.f, 0.f, 0.f, 0.f};
    bf16x8 At[4][2], B0[2][2], B1[2][2];
    const char* cA = S.a_base(g, cur); const char* cB = S.b_base(g, cur);
    const char* nA = cA;
    PG8_GSETUP(gvC, cur);
    PG8_STAGE(PG8_SB(0, 0), cB, voffB); PG8_STAGE_A(PG8_SA(0, 0), 0, false, 0); PG8_STAGE(PG8_SB(0, 1), cB + hstepB, voffB); PG8_STAGE_A(PG8_SA(0, 1), 1, false, 0);
    if (wr == 1) PG8_BAR;
    PG8_WAIT_V(4); PG8_BAR;
    PG8_STAGE(PG8_SB(1, 0), cB + kstep, voffB); PG8_STAGE_A(PG8_SA(1, 0), 0, false, 1); PG8_STAGE(PG8_SB(1, 1), cB + hstepB + kstep, voffB);
    PG8_WAIT_V(6); PG8_BAR;
    for (;;) {
        const bool has_next = S.next(ui + 1, nxt);
        nA = has_next ? S.a_base(g, nxt) : cA; const char* nB = has_next ? S.b_base(g, nxt) : cB;
        if constexpr (Sched::GATHER) { if (has_next) { PG8_GSETUP(gvN, nxt); } else {
#pragma unroll
            for (int _h = 0; _h < 2; ++_h) { gvN[_h][0] = gvC[_h][0]; gvN[_h][1] = gvC[_h][1]; } } }
        for (int t = 0; t < nt; t += 2) {
            const bool last = (t == nt - 2);
            const int kt2 = last ? 0 : t + 2;
            const char* b2 = last ? nB : cB + (size_t)(t + 2) * kstep;
            const char* b3 = b2 + kstep;
            PG8_LDB(B0, 0, 0); PG8_SCHED; PG8_LDA(At, 0, 0); PG8_STAGE_A(PG8_SA(1, 1), 1, false, t + 1);
            PG8_WAIT_L(8); PG8_BAR; PG8_WAIT_L(0); PG8_MMA(0, 0, At, B0); PG8_BAR; PG8_SCHED;
            PG8_LDB(B1, 0, 1); PG8_STAGE(PG8_SB(0, 0), b2, voffB);
            PG8_BAR; PG8_WAIT_L(0); PG8_MMA(0, 1, At, B1); PG8_BAR;
            PG8_LDA(At, 0, 1); PG8_STAGE_A(PG8_SA(0, 0), 0, last, kt2);
            PG8_BAR; PG8_WAIT_L(0); PG8_MMA(1, 0, At, B0); PG8_BAR; PG8_SCHED;
            PG8_STAGE(PG8_SB(0, 1), b2 + hstepB, voffB);
            PG8_WAIT_V(6); PG8_BAR; PG8_MMA(1, 1, At, B1); PG8_BAR;
            PG8_LDB(B0, 1, 0); PG8_SCHED; PG8_LDA(At, 1, 0); PG8_STAGE_A(PG8_SA(0, 1), 1, last, kt2);
            PG8_WAIT_L(8); PG8_BAR; PG8_WAIT_L(0); PG8_MMA(0, 0, At, B0); PG8_BAR; PG8_SCHED;
            PG8_LDB(B1, 1, 1); PG8_STAGE(PG8_SB(1, 0), b3, voffB);
            PG8_BAR; PG8_WAIT_L(0); PG8_MMA(0, 1, At, B1); PG8_BAR;
            PG8_LDA(At, 1, 1); PG8_STAGE_A(PG8_SA(1, 0), 0, last, kt2 + 1);
            PG8_BAR; PG8_WAIT_L(0); PG8_MMA(1, 0, At, B0); PG8_BAR; PG8_SCHED;
            PG8_STAGE(PG8_SB(1, 1), b3 + hstepB, voffB);
            PG8_WAIT_V(6); PG8_BAR; PG8_MMA(1, 1, At, B1); PG8_BAR;
        }
        E(acc, cur, wr, wc, fr, fq);
        if (!has_next) break;
#pragma unroll
        for (int a = 0; a < 2; ++a)
#pragma unroll
            for (int b = 0; b < 2; ++b)
#pragma unroll
                for (int m = 0; m < 4; ++m)
#pragma unroll
                    for (int n = 0; n < 2; ++n) acc[a][b][m][n] = (f32x4){0.f, 0.f, 0.f, 0.f};
        cur = nxt; cA = nA; cB = nB; ++ui;
        if constexpr (Sched::GATHER) {
#pragma unroll
            for (int _h = 0; _h < 2; ++_h) { gvC[_h][0] = gvN[_h][0]; gvC[_h][1] = gvN[_h][1]; } }
    }
    PG8_WAIT_V(0);
    if (wr == 0) PG8_BAR;
    PG8_BAR;
#undef PG8_SA
#undef PG8_SB
#undef PG8_STAGE
#undef PG8_STAGE_A
#undef PG8_GSETUP
#undef PG8_LDA
#undef PG8_LDB
#undef PG8_MMA
#undef PG8_WAIT_V
#undef PG8_WAIT_L
#undef PG8_BAR
#undef PG8_SCHED
}
}

struct Params { const float* in[31]; float* out; unsigned char* ws; int ph_lo, ph_hi; };

struct Ctx {
    LAS unsigned char* lds;
    int tid, lane, wave, G, bid, gw, ngw;
    unsigned char* ws; float* out;
};
DI Ctx relaunder(const Ctx& F0) {
    Ctx F = F0;
    asm volatile("" : "+v"(F.tid), "+v"(F.lane));
    asm volatile("" : "+s"(F.wave), "+s"(F.G), "+s"(F.bid), "+s"(F.gw), "+s"(F.ngw));
    asm volatile("" : "+s"(F.ws), "+s"(F.out));
    F.ws = as_global(F.ws); F.out = as_global(F.out);
    return F;
}

DI void dense_gemm(const Ctx& F, const bf16_t* A, int lda, const bf16_t* Bt, int ldb, int M, int N, int K, bf16_t* O, int ldc, int crot) {
    pg8::Gemm g{A, Bt, lda, ldb, K}; pg8::StaticOrder S; S.init(M, N, F.G, (F.bid + crot) % F.G);
    pg8::EpiStore E{O, ldc};
    for (int rep = 0; rep < REP_GEMM; ++rep) pg8::gemm_phase<pg8::EpiStore, pg8::StaticOrder>(F.lds, g, S, E);
}

struct TJob { const float* src; bf16_t* dst; int ldw, dld; };
DI void tr_load(const TJob& j, f32x4 (&r)[16], int lane) {
    const GAS float* p = (const GAS float*)(j.src + (size_t)(lane >> 4) * j.ldw + 4 * (lane & 15));
#pragma unroll
    for (int i = 0; i < 16; ++i) r[i] = *(const GAS f32x4*)(p + (size_t)(4 * i) * j.ldw);
}
DI void tr_store(const TJob& j, const f32x4 (&r)[16], LAS unsigned char* scr, int lane) {
#pragma unroll
    for (int i = 0; i < 16; ++i) { LAS unsigned* w = (LAS unsigned*)(scr + ((lane >> 4) + 4 * i) * 132 + (lane & 15) * 8); w[0] = cvt_pk_bf16(r[i].x, r[i].y); w[1] = cvt_pk_bf16(r[i].z, r[i].w); }
    LDS_WAIT();
    const int kc = lane & 7;
#pragma unroll
    for (int sgrp = 0; sgrp < 8; ++sgrp) { const int n = 8 * sgrp + (lane >> 3); const LAS unsigned short* c = (const LAS unsigned short*)(scr + (8 * kc) * 132 + n * 2);
        u32x4 o; o.x = (unsigned)c[0] | ((unsigned)c[66] << 16); o.y = (unsigned)c[2 * 66] | ((unsigned)c[3 * 66] << 16); o.z = (unsigned)c[4 * 66] | ((unsigned)c[5 * 66] << 16); o.w = (unsigned)c[6 * 66] | ((unsigned)c[7 * 66] << 16);
        *(GAS u32x4*)(j.dst + (size_t)n * j.dld + 8 * kc) = o; }
    LDS_WAIT();
}
template <class Dec> DI void tr_run(const Dec& D, int first, int count, int stride, LAS unsigned char* scr, int lane) {
    f32x4 A[16], B[16]; TJob ja, jb;
    int it = first; if (it >= count) return;
    ja = D(it); tr_load(ja, A, lane);
    for (;;) {
        const int it2 = it + stride; const bool h2 = it2 < count; if (h2) { jb = D(it2); tr_load(jb, B, lane); }
        tr_store(ja, A, scr, lane);
        if (!h2) break;
        const int it3 = it2 + stride; const bool h3 = it3 < count; if (h3) { ja = D(it3); tr_load(ja, A, lane); }
        tr_store(jb, B, scr, lane);
        if (!h3) break;
        it = it3;
    }
}
DI TJob mat_job(const float* W, int K, int N, bf16_t* WT, int item) {
    const int nblk = N / 64, kb = item / nblk, nb = item - kb * nblk;
    TJob j; j.src = W + (size_t)(64 * kb) * N + 64 * nb; j.dst = WT + (size_t)(64 * nb) * K + 64 * kb; j.ldw = N; j.dld = K; return j;
}
DI void row_to_bf16(const float* src, bf16_t* dst, int lane) {
    const GAS f32x4* s = (const GAS f32x4*)src + lane; GAS u32x2* o = (GAS u32x2*)dst + lane;
#pragma unroll
    for (int j = 0; j < 8; ++j) { const f32x4 v = s[64 * j]; u32x2 w; w.x = cvt_pk_bf16(v.x, v.y); w.y = cvt_pk_bf16(v.z, v.w); o[64 * j] = w; }
}

DI void phase_prologue(const Ctx& F, const Params& P) {
    unsigned char* const wsl = F.ws; float* const outl = F.out; (void)outl;
    LAS unsigned char* scr = F.lds + F.wave * 16384;
    unsigned char* ws = wsl;
    constexpr int I_RW = 32 * (RW_IN_COLS / 64), I_OT = 32 * (ZW_OTH / 64), I_WO = 32 * 32, I_KV = 32 * 8;
    constexpr int N_A = 2 * I_RW + 2 * I_OT, N_B = 4 * I_WO, N_C = 8 * I_KV, N_D = NTOK + NBATCH * MEML;
    struct ProDec { unsigned char* ws;
        DI TJob operator()(int it) const { int r = it;
            if (r < N_A) {
                if (r < I_RW) return mat_job(PIN(16), DM, RW_IN_COLS, (bf16_t*)(ws + WS_WIN), r); r -= I_RW;
                if (r < I_OT) return mat_job(PIN(28), DM, ZW_OTH, (bf16_t*)(ws + WS_WIN + WIN_STRIDE), r); r -= I_OT;
                if (r < I_OT) return mat_job(PIN(30), DM, ZW_OTH, (bf16_t*)(ws + WS_WIN + 2 * WIN_STRIDE), r); r -= I_OT;
                return mat_job(PIN(16) + (size_t)DM * RW_IN_COLS, DM, RW_IN_COLS, (bf16_t*)(ws + WS_WIN + 3 * WIN_STRIDE), r);
            }
            r -= N_A;
            if (r < N_B) { const int l = r / I_WO; return mat_job(PIN(2) + (size_t)l * DM * DM, DM, DM, (bf16_t*)(ws + WS_WOUT) + (size_t)l * DM * DM, r - l * I_WO); }
            r -= N_B;
            const int m = r / I_KV, l = m & 3; const bool isv = m >= 4;
            return mat_job(PIN(isv ? 4 : 3) + (size_t)l * DM * MEMW, DM, MEMW, (bf16_t*)(ws + (isv ? WS_WV : WS_WK)) + (size_t)l * MEMW * DM, r - m * I_KV);
        } };
    ProDec PD{ws};
    tr_run(PD, F.gw, N_A + N_B + N_C, F.ngw, scr, F.lane);
    for (int r = F.gw; r < N_D; r += F.ngw) {
        if (r < NTOK) row_to_bf16(PIN(0) + (size_t)r * DM, (bf16_t*)(ws + WS_XB) + (size_t)r * DM, F.lane);
        else row_to_bf16(PIN(1) + (size_t)(r - NTOK) * DM, (bf16_t*)(ws + WS_MEMB) + (size_t)(r - NTOK) * DM, F.lane);
    }
    const int gt = F.bid * NT + F.tid, ngt = F.G * NT;
    for (int idx = gt; idx < 2 * (3072 + 1536) * 256; idx += ngt) {
        const int j = idx / ((3072 + 1536) * 256); int r = idx - j * (3072 + 1536) * 256;
        bf16_t* base = (bf16_t*)(ws + WS_LORA + (size_t)j * LORA_STRIDE);
        const int n = r >> 8, k = r & 255; float v = 0.f;
        if (n < 1536) { if (k < 96) v = PIN(19)[((size_t)j * 96 + k) * CMIX + n]; }
        else if (n < 3072) { if (k >= 96 && k < 192) v = PIN(21)[((size_t)j * 96 + (k - 96)) * CMIX + (n - 1536)]; }
        else v = PIN(22)[((size_t)j * 256 + k) * CMIX + (n - 3072)];
        base[r] = (bf16_t)(cvt_pk_bf16(v, 0.f) & 0xffffu);
    }
    for (int idx = gt; idx < 2 * 64 * DM; idx += ngt) { const int j = idx / (64 * DM), r = idx - j * 64 * DM;
        ((bf16_t*)(ws + WS_WIN + (size_t)(j ? 3 : 0) * WIN_STRIDE))[(size_t)RW_IN_COLS * DM + r] = 0; }
    for (int idx = gt; idx < NLAYER * 48 * DM; idx += ngt) {
        const int l = idx / (48 * DM); int r = idx - l * 48 * DM; const int n = r / DM, k = r - n * DM;
        float v = 0.f;
        if (n < 4) v = PIN(9)[((size_t)l * DM + k) * 4 + n]; else if (n < 36) v = PIN(11)[((size_t)l * DM + k) * 32 + (n - 4)];
        const unsigned hi = cvt_pk_bf16(v, 0.f) & 0xffffu; const float rem = v - bf2f(hi); const unsigned lo = cvt_pk_bf16(rem, 0.f) & 0xffffu;
        bf16_t* base = (bf16_t*)(ws + WS_WSW + (size_t)l * WSW_STRIDE);
        base[r] = (bf16_t)hi; base[48 * DM + r] = (bf16_t)lo;
    }
}

DI void expert_convert(const Ctx& F, const Params& P, int l, int w, int nw) {
    unsigned char* const wsl = F.ws;
    LAS unsigned char* scr = F.lds + F.wave * 16384;
    constexpr int I_GU = NEXP * 32 * 8 * 2, I_DN = NEXP * 8 * 32;
    struct ExpDec { unsigned char* ws; int l;
        DI TJob operator()(int it) const { TJob j;
            if (it < I_GU) {
                const int isup = it / (I_GU / 2); int r = it - isup * (I_GU / 2);
                const int e = r / 256; r -= e * 256; const int kb = r >> 3, nb = r & 7;
                const float* W = PIN(isup ? 14 : 13) + ((size_t)l * NEXP + e) * DM * DEXP;
                const int n0 = 64 * nb, drow = 256 * (n0 >> 7) + (isup ? 128 : 0) + (n0 & 127);
                j.src = W + (size_t)(64 * kb) * DEXP + n0; j.ldw = DEXP; j.dst = (bf16_t*)(ws + WS_EXP1) + ((size_t)e * 1024 + drow) * DM + 64 * kb; j.dld = DM;
            } else {
                int r = it - I_GU; const int e = r / 256; r -= e * 256; const int kb = r >> 5, nb = r & 31;
                const float* W = PIN(15) + ((size_t)l * NEXP + e) * DEXP * DM;
                j.src = W + (size_t)(64 * kb) * DM + 64 * nb; j.ldw = DM; j.dst = (bf16_t*)(ws + WS_EXP2) + ((size_t)e * DM + 64 * nb) * DEXP + 64 * kb; j.dld = DEXP;
            }
            return j; } };
    ExpDec ED{wsl, l};
    tr_run(ED, w, I_GU + I_DN, nw, scr, F.lane);
}

DI void memattn_unit(const Ctx& F, int l, int unit, const bf16_t* z, int zw, int qcol) {
    unsigned char* const wsl = F.ws; float* const outl = F.out; (void)outl;
    const int b = unit >> 6, head = (unit >> 4) & 3, qblk = unit & 15;
    LAS unsigned char* Ks = F.lds; LAS unsigned char* Vs = F.lds + 69632;
    const bf16_t* Km = (const bf16_t*)(wsl + WS_KM); const bf16_t* VmT = (const bf16_t*)(wsl + WS_VMT);
    bf16_t* cat = (bf16_t*)(wsl + WS_CAT);
    __syncthreads();
#pragma unroll
    for (int h = 0; h < 2; ++h) {
        u32x4 kv[4], vv[4];
#pragma unroll
        for (int i = 0; i < 4; ++i) { const int ch = F.tid + NT * (4 * h + i);
            { const int row = ch >> 4, c16 = ch & 15; kv[i] = *(const GAS u32x4*)(Km + (size_t)(b * MEML + row) * 2048 + l * 512 + head * 128 + c16 * 8); }
            { const int d = ch >> 5, c = ch & 31; vv[i] = *(const GAS u32x4*)(VmT + (size_t)(l * 512 + head * 128 + d) * 1024 + b * MEML + c * 8); } }
#pragma unroll
        for (int i = 0; i < 4; ++i) { const int ch = F.tid + NT * (4 * h + i);
            { const int row = ch >> 4, c16 = ch & 15; *(LAS u32x4*)(Ks + row * 272 + c16 * 16) = kv[i]; }
            { const int d = ch >> 5, c = ch & 31; *(LAS u32x4*)(Vs + d * 528 + c * 16) = vv[i]; } }
        asm volatile("" ::: "memory");
    }
    __syncthreads();
    int lane = F.lane; asm volatile("" : "+v"(lane) :: "memory");
    const int fr = lane & 15, fq = lane >> 4;
    for (int itq = 0; itq < 2; ++itq) {
        asm volatile("" : "+v"(lane) :: "memory");
        const int q0 = qblk * 256 + itq * 128 + F.wave * 16, tok0 = b * SEQ + q0;
        bf16x8 Qf[4];
#pragma unroll
        for (int ks = 0; ks < 4; ++ks) Qf[ks] = *(const GAS bf16x8*)(z + (size_t)(tok0 + (lane & 15)) * zw + qcol + head * 128 + ks * 32 + (lane >> 4) * 8);
        f32x4 acc[16];
#pragma unroll
        for (int t = 0; t < 16; ++t) { acc[t] = (f32x4){0.f, 0.f, 0.f, 0.f};
#pragma unroll
            for (int ks = 0; ks < 4; ++ks) { const bf16x8 kf = *(const LAS bf16x8*)(Ks + (16 * t + fr) * 272 + ks * 64 + fq * 16);
                acc[t] = __builtin_amdgcn_mfma_f32_16x16x32_bf16(kf, Qf[ks], acc[t], 0, 0, 0); } }
        const float sc = 0.08838834764831845f;
        float mx = -3.0e38f;
#pragma unroll
        for (int t = 0; t < 16; ++t)
#pragma unroll
            for (int j = 0; j < 4; ++j) { acc[t][j] *= sc; mx = fmaxf(mx, acc[t][j]); }
        mx = fmaxf(mx, __shfl_xor(mx, 16)); mx = fmaxf(mx, __shfl_xor(mx, 32));
        float sum = 0.f;
#pragma unroll
        for (int t = 0; t < 16; ++t)
#pragma unroll
            for (int j = 0; j < 4; ++j) { acc[t][j] = __expf(acc[t][j] - mx); sum += acc[t][j]; }
        sum += __shfl_xor(sum, 16); sum += __shfl_xor(sum, 32);
        const float inv = 1.f / sum;
        f32x4 o[8];
#pragma unroll
        for (int dt = 0; dt < 8; ++dt) o[dt] = (f32x4){0.f, 0.f, 0.f, 0.f};
#pragma unroll
        for (int s = 0; s < 8; ++s) {
            u32x4 pw; pw.x = cvt_pk_bf16(acc[2 * s][0], acc[2 * s][1]); pw.y = cvt_pk_bf16(acc[2 * s][2], acc[2 * s][3]);
            pw.z = cvt_pk_bf16(acc[2 * s + 1][0], acc[2 * s + 1][1]); pw.w = cvt_pk_bf16(acc[2 * s + 1][2], acc[2 * s + 1][3]);
            const bf16x8 pf = __builtin_bit_cast(bf16x8, pw);
#pragma unroll
            for (int dt = 0; dt < 8; ++dt) {
                const u32x2 v0 = *(const LAS u32x2*)(Vs + (16 * dt + fr) * 528 + (32 * s + 4 * fq) * 2);
                const u32x2 v1 = *(const LAS u32x2*)(Vs + (16 * dt + fr) * 528 + (32 * s + 16 + 4 * fq) * 2);
                u32x4 vw; vw.x = v0.x; vw.y = v0.y; vw.z = v1.x; vw.w = v1.y;
                o[dt] = __builtin_amdgcn_mfma_f32_16x16x32_bf16(__builtin_bit_cast(bf16x8, vw), pf, o[dt], 0, 0, 0);
            }
        }
        bf16_t* orow = cat + (size_t)(tok0 + fr) * DM + CMIX + head * 128 + 4 * fq;
#pragma unroll
        for (int dt = 0; dt < 8; ++dt) { u32x2 w; w.x = cvt_pk_bf16(o[dt][0] * inv, o[dt][1] * inv); w.y = cvt_pk_bf16(o[dt][2] * inv, o[dt][3] * inv); *(GAS u32x2*)(orow + 16 * dt) = w; }
    }
}
DI void memattn_all(const Ctx& F, int l, const bf16_t* z, int zw, int qcol) {
    for (int u = F.bid; u < 256; u += F.G) memattn_unit(F, l, u, z, zw, qcol);
    __syncthreads();
}

DI void conv_mix(const Ctx& F, const Params& P, const bf16_t* z) {
    unsigned char* const wsl = F.ws; float* const outl = F.out; (void)outl;
    const float* cw = PIN(29);
    bf16_t* cat = (bf16_t*)(wsl + WS_CAT);
    const int gt = F.bid * NT + F.tid, ngt = F.G * NT;
    for (int idx = gt; idx < NTOK * 192; idx += ngt) {
        const int tok = idx / 192, c8 = idx - tok * 192, c = c8 * 8, t = tok & (SEQ - 1);
        const bf16_t* zr = z + (size_t)tok * ZW_OTH;
        const u32x4 bg = *(const GAS u32x4*)(zr + c);
        u32x4 cg[3], hh[3]; f32x4 w0[3], w1[3];
#pragma unroll
        for (int dt = 0; dt < 3; ++dt) { const bf16_t* zp = (t - dt >= 0) ? zr - (size_t)dt * ZW_OTH : zr;
            cg[dt] = *(const GAS u32x4*)(zp + CMIX + c); hh[dt] = *(const GAS u32x4*)(zp + 2 * CMIX + c);
            w0[dt] = *(const GAS f32x4*)(cw + (2 - dt) * CMIX + c); w1[dt] = *(const GAS f32x4*)(cw + (2 - dt) * CMIX + c + 4); }
        float y[8];
#pragma unroll
        for (int j = 0; j < 8; ++j) y[j] = 0.f;
#pragma unroll
        for (int dt = 0; dt < 3; ++dt) {
            const float m = (t - dt >= 0) ? 1.f : 0.f;
            y[0] += m * (w0[dt].x * bflo(cg[dt].x) * bflo(hh[dt].x)); y[1] += m * (w0[dt].y * bfhi(cg[dt].x) * bfhi(hh[dt].x)); y[2] += m * (w0[dt].z * bflo(cg[dt].y) * bflo(hh[dt].y)); y[3] += m * (w0[dt].w * bfhi(cg[dt].y) * bfhi(hh[dt].y));
            y[4] += m * (w1[dt].x * bflo(cg[dt].z) * bflo(hh[dt].z)); y[5] += m * (w1[dt].y * bfhi(cg[dt].z) * bfhi(hh[dt].z)); y[6] += m * (w1[dt].z * bflo(cg[dt].w) * bflo(hh[dt].w)); y[7] += m * (w1[dt].w * bfhi(cg[dt].w) * bfhi(hh[dt].w));
        }
        u32x4 o; o.x = cvt_pk_bf16(bflo(bg.x) * y[0], bfhi(bg.x) * y[1]); o.y = cvt_pk_bf16(bflo(bg.y) * y[2], bfhi(bg.y) * y[3]);
        o.z = cvt_pk_bf16(bflo(bg.z) * y[4], bfhi(bg.z) * y[5]); o.w = cvt_pk_bf16(bflo(bg.w) * y[6], bfhi(bg.w) * y[7]);
        *(GAS u32x4*)(cat + (size_t)tok * DM + c) = o;
    }
}

DI void sb_attention(const Ctx& F, const bf16_t* z) {
    unsigned char* const wsl = F.ws;
    const bf16_t* VT = (const bf16_t*)(wsl + WS_ACT);
    bf16_t* cat = (bf16_t*)(wsl + WS_CAT);
    LAS unsigned char* Ks = F.lds; LAS unsigned char* Vs = F.lds + 69632;
    const int lane = F.lane, fr = lane & 15, fq = lane >> 4;
    const float sc = 0.08838834764831845f;
    for (int u = F.bid; u < NBATCH * 12 * 32; u += F.G) {
        const int b = u / (12 * 32); int r = u - b * 12 * 32; const int head = r >> 5, qblk = r & 31;
        const int t0 = qblk * 128, kw0 = t0 - 128;
        __syncthreads();
#pragma unroll
        for (int h = 0; h < 2; ++h) {
            u32x4 kv[4], vv[4];
#pragma unroll
            for (int i = 0; i < 4; ++i) { const int ch = F.tid + NT * (4 * h + i);
                { const int row = ch >> 4, c16 = ch & 15, key = kw0 + row, keyc = key < 0 ? 0 : key; kv[i] = *(const GAS u32x4*)(z + (size_t)(b * SEQ + keyc) * ZW_OTH + CMIX + head * 128 + c16 * 8); }
                { const int d = ch >> 5, c = ch & 31, k8 = kw0 + c * 8, k8c = k8 < 0 ? 0 : k8; vv[i] = *(const GAS u32x4*)(VT + (size_t)(head * 128 + d) * NTOK + b * SEQ + k8c); } }
#pragma unroll
            for (int i = 0; i < 4; ++i) { const int ch = F.tid + NT * (4 * h + i);
                { const int row = ch >> 4, c16 = ch & 15; *(LAS u32x4*)(Ks + row * 272 + c16 * 16) = kv[i]; }
                { const int d = ch >> 5, c = ch & 31; *(LAS u32x4*)(Vs + d * 528 + c * 16) = vv[i]; } }
            asm volatile("" ::: "memory");
        }
        __syncthreads();
        int lq = F.lane; asm volatile("" : "+v"(lq) :: "memory");
        const int tq0 = t0 + F.wave * 16, tq = tq0 + fr;
        bf16x8 Qf[4];
#pragma unroll
        for (int ks = 0; ks < 4; ++ks) Qf[ks] = *(const GAS bf16x8*)(z + (size_t)(b * SEQ + tq0 + (lq & 15)) * ZW_OTH + head * 128 + ks * 32 + (lq >> 4) * 8);
        f32x4 o[8];
#pragma unroll
        for (int dt = 0; dt < 8; ++dt) o[dt] = (f32x4){0.f, 0.f, 0.f, 0.f};
        float R = 0.f;
        for (int kt = (tq0 + 14) >> 5; kt >= 0; --kt) {
            const int lk = 32 * kt - kw0;
            bf16x8 Kf[2][4]; u32x2 V0[8], V1[8];
            if (lk >= 0) {
#pragma unroll
                for (int tl = 0; tl < 2; ++tl)
#pragma unroll
                    for (int ks = 0; ks < 4; ++ks) Kf[tl][ks] = *(const LAS bf16x8*)(Ks + (lk + 16 * tl + fr) * 272 + ks * 64 + fq * 16);
#pragma unroll
                for (int dt = 0; dt < 8; ++dt) { V0[dt] = *(const LAS u32x2*)(Vs + (16 * dt + fr) * 528 + (lk + 4 * fq) * 2); V1[dt] = *(const LAS u32x2*)(Vs + (16 * dt + fr) * 528 + (lk + 16 + 4 * fq) * 2); }
            } else {
#pragma unroll
                for (int tl = 0; tl < 2; ++tl)
#pragma unroll
                    for (int ks = 0; ks < 4; ++ks) Kf[tl][ks] = *(const GAS bf16x8*)(z + (size_t)(b * SEQ + 32 * kt + 16 * tl + fr) * ZW_OTH + CMIX + head * 128 + ks * 32 + fq * 8);
#pragma unroll
                for (int dt = 0; dt < 8; ++dt) { const bf16_t* vp = VT + (size_t)(head * 128 + 16 * dt + fr) * NTOK + b * SEQ + 32 * kt + 4 * fq; V0[dt] = *(const GAS u32x2*)vp; V1[dt] = *(const GAS u32x2*)(vp + 16); }
            }
            f32x4 s[2];
#pragma unroll
            for (int tl = 0; tl < 2; ++tl) { s[tl] = (f32x4){0.f, 0.f, 0.f, 0.f};
#pragma unroll
                for (int ks = 0; ks < 4; ++ks) s[tl] = __builtin_amdgcn_mfma_f32_16x16x32_bf16(Kf[tl][ks], Qf[ks], s[tl], 0, 0, 0); }
            float ln[2][4], lsg[2][4], tot[2];
#pragma unroll
            for (int tl = 0; tl < 2; ++tl) { tot[tl] = 0.f;
#pragma unroll
                for (int j = 0; j < 4; ++j) { const float x = s[tl][j] * sc; const int key = 32 * kt + 16 * tl + 4 * fq + j; const bool valid = key < tq;
                    const float sp = softplusf_(x); ln[tl][j] = valid ? -sp : 0.f; lsg[tl][j] = valid ? (x - sp) : -1.0e30f; tot[tl] += ln[tl][j]; } }
            const float a16_0 = __shfl_xor(tot[0], 16), a32_0 = __shfl_xor(tot[0], 32), a48_0 = __shfl_xor(tot[0], 48);
            const float a16_1 = __shfl_xor(tot[1], 16), a32_1 = __shfl_xor(tot[1], 32), a48_1 = __shfl_xor(tot[1], 48);
            float hi0 = 0.f, hi1 = 0.f;
            if ((fq ^ 1) > fq) { hi0 += a16_0; hi1 += a16_1; }
            if ((fq ^ 2) > fq) { hi0 += a32_0; hi1 += a32_1; }
            if ((fq ^ 3) > fq) { hi0 += a48_0; hi1 += a48_1; }
            const float all0 = tot[0] + a16_0 + a32_0 + a48_0, all1 = tot[1] + a16_1 + a32_1 + a48_1;
            const float E0 = R + hi0 + all1, E1 = R + hi1;
            float at[2][4];
#pragma unroll
            for (int tl = 0; tl < 2; ++tl) { float suf = 0.f; const float Eb = tl ? E1 : E0;
#pragma unroll
                for (int j = 3; j >= 0; --j) { at[tl][j] = __expf(lsg[tl][j] + Eb + suf); suf += ln[tl][j]; } }
            R += all0 + all1;
            u32x4 pw; pw.x = cvt_pk_bf16(at[0][0], at[0][1]); pw.y = cvt_pk_bf16(at[0][2], at[0][3]); pw.z = cvt_pk_bf16(at[1][0], at[1][1]); pw.w = cvt_pk_bf16(at[1][2], at[1][3]);
            const bf16x8 pf = __builtin_bit_cast(bf16x8, pw);
#pragma unroll
            for (int dt = 0; dt < 8; ++dt) {
                u32x4 vw; vw.x = V0[dt].x; vw.y = V0[dt].y; vw.z = V1[dt].x; vw.w = V1[dt].y;
                o[dt] = __builtin_amdgcn_mfma_f32_16x16x32_bf16(__builtin_bit_cast(bf16x8, vw), pf, o[dt], 0, 0, 0);
            }
            if (__all(R < -100.f)) break;
        }
        bf16_t* orow = cat + (size_t)(b * SEQ + tq) * DM + head * 128 + 4 * fq;
#pragma unroll
        for (int dt = 0; dt < 8; ++dt) { u32x2 w; w.x = cvt_pk_bf16(o[dt][0], o[dt][1]); w.y = cvt_pk_bf16(o[dt][2], o[dt][3]); *(GAS u32x2*)(orow + 16 * dt) = w; }
    }
    __syncthreads();
}

DI void rwkv_prep1(const Ctx& F, const Params& P, int j, const bf16_t* z) {
    unsigned char* const wsl = F.ws; float* const outl = F.out; (void)outl;
    const float* mu = PIN(17) + (size_t)j * 5056;
    bf16_t* act = (bf16_t*)(wsl + WS_ACT);
    const int gt = F.bid * NT + F.tid, ngt = F.G * NT;
    for (int idx = gt; idx < NTOK * 64; idx += ngt) {
        const int tok = idx >> 6, ci = idx & 63, t = tok & (SEQ - 1);
        u32x4 o = (u32x4){0u, 0u, 0u, 0u};
        if (ci < 24 || ci >= 32) {
            const int sc = ci < 12 ? 4608 + 8 * ci : (ci < 24 ? 4704 + 8 * (ci - 12) : 4800 + 8 * (ci - 32));
            const u32x4 a = *(const GAS u32x4*)(z + (size_t)tok * ZW_RWKV + sc);
            u32x4 p = *(const GAS u32x4*)(z + (size_t)(t > 0 ? tok - 1 : tok) * ZW_RWKV + sc);
            const f32x4 m0 = *(const GAS f32x4*)(mu + sc), m1 = *(const GAS f32x4*)(mu + sc + 4);
            if (t == 0) p = (u32x4){0u, 0u, 0u, 0u};
            float v[8];
            v[0] = bflo(a.x) + (bflo(p.x) - bflo(a.x)) * m0.x; v[1] = bfhi(a.x) + (bfhi(p.x) - bfhi(a.x)) * m0.y;
            v[2] = bflo(a.y) + (bflo(p.y) - bflo(a.y)) * m0.z; v[3] = bfhi(a.y) + (bfhi(p.y) - bfhi(a.y)) * m0.w;
            v[4] = bflo(a.z) + (bflo(p.z) - bflo(a.z)) * m1.x; v[5] = bfhi(a.z) + (bfhi(p.z) - bfhi(a.z)) * m1.y;
            v[6] = bflo(a.w) + (bflo(p.w) - bflo(a.w)) * m1.z; v[7] = bfhi(a.w) + (bfhi(p.w) - bfhi(a.w)) * m1.w;
#pragma unroll
            for (int q = 0; q < 8; ++q) { if (ci < 12) v[q] = tanhf(v[q]); else if (ci >= 32) v[q] = sigmoidf_(v[q]); }
            o.x = cvt_pk_bf16(v[0], v[1]); o.y = cvt_pk_bf16(v[2], v[3]); o.z = cvt_pk_bf16(v[4], v[5]); o.w = cvt_pk_bf16(v[6], v[7]);
        }
        *(GAS u32x4*)(act + (size_t)tok * 512 + ci * 8) = o;
    }
}

constexpr int CH = 64, NCH = SEQ / CH;
DI float* scan_rec(unsigned char* ws, int tok, int head) {
    return (float*)(ws + WS_SCAN) + ((size_t)((tok >> 12) * 24 + head) * SEQ + (tok & (SEQ - 1))) * 320;
}
DI float* gh_ptr(unsigned char* ws, int bh, int c, int which) { return (float*)(ws + WS_GH) + (((size_t)bh * NCH + c) * 2 + which) * 4096; }
struct RwPar { const float *mu, *w0, *a0, *kk, *ka, *rk, *gng, *gnb; };
struct PrepRaw { u32x2 zr, zk, zv, pr, pk, pv, lw, la; };
struct PrepOut { f32x4 dec, ld, bb, kp, r, nk, v; float bon; };
DI void prep_load(PrepRaw& R, const bf16_t* z, const bf16_t* LW, int tok, int c4) {
    tok = tok < NTOK ? tok : NTOK - 1;
    const bool hp = (tok & (SEQ - 1)) != 0;
    const GAS bf16_t* zc = (const GAS bf16_t*)(z + (size_t)tok * ZW_RWKV + c4); const GAS bf16_t* zp = hp ? zc - ZW_RWKV : zc;
    R.zr = *(const GAS u32x2*)zc; R.zk = *(const GAS u32x2*)(zc + CMIX); R.zv = *(const GAS u32x2*)(zc + 2 * CMIX);
    R.pr = *(const GAS u32x2*)zp; R.pk = *(const GAS u32x2*)(zp + CMIX); R.pv = *(const GAS u32x2*)(zp + 2 * CMIX);
    const GAS bf16_t* lp = (const GAS bf16_t*)(LW + (size_t)tok * 3072 + c4); R.lw = *(const GAS u32x2*)lp; R.la = *(const GAS u32x2*)(lp + CMIX);
}
DI f32x4 lerp_u(u32x2 a, u32x2 p, f32x4 m) {
    f32x4 r; r.x = bflo(a.x) + (bflo(p.x) - bflo(a.x)) * m.x; r.y = bfhi(a.x) + (bfhi(p.x) - bfhi(a.x)) * m.y;
    r.z = bflo(a.y) + (bflo(p.y) - bflo(a.y)) * m.z; r.w = bfhi(a.y) + (bfhi(p.y) - bfhi(a.y)) * m.w; return r;
}
struct PrepPar { f32x4 mur, muk, muv, w0, a0, kk, ka, rk; };
DI void par_load(PrepPar& P, const RwPar& Q, int c4) {
    P.mur = *(const GAS f32x4*)(Q.mu + c4); P.muk = *(const GAS f32x4*)(Q.mu + CMIX + c4); P.muv = *(const GAS f32x4*)(Q.mu + 2 * CMIX + c4);
    P.w0 = *(const GAS f32x4*)(Q.w0 + c4); P.a0 = *(const GAS f32x4*)(Q.a0 + c4); P.kk = *(const GAS f32x4*)(Q.kk + c4); P.ka = *(const GAS f32x4*)(Q.ka + c4); P.rk = *(const GAS f32x4*)(Q.rk + c4);
}
template <bool WANT_BON> DI void prep_compute(const PrepRaw& R, const PrepPar& P, bool hp, PrepOut& O) {
    const u32x2 z2 = (u32x2){0u, 0u};
    const f32x4 r = lerp_u(R.zr, hp ? R.pr : z2, P.mur), k = lerp_u(R.zk, hp ? R.pk : z2, P.muk);
    O.v = lerp_u(R.zv, hp ? R.pv : z2, P.muv); O.r = r;
    const f32x4 w0v = P.w0, a0v = P.a0, kkv = P.kk, kav = P.ka;
    f32x4 wr; wr.x = w0v.x + bflo(R.lw.x); wr.y = w0v.y + bfhi(R.lw.x); wr.z = w0v.z + bflo(R.lw.y); wr.w = w0v.w + bfhi(R.lw.y);
    f32x4 ar; ar.x = a0v.x + bflo(R.la.x); ar.y = a0v.y + bfhi(R.la.x); ar.z = a0v.z + bflo(R.la.y); ar.w = a0v.w + bfhi(R.la.y);
    f32x4 a, kk;
#pragma unroll
    for (int q = 0; q < 4; ++q) { const float wl = -softplusf_(-wr[q]) - 0.5f; O.ld[q] = -__expf(wl); O.dec[q] = __expf(O.ld[q]); a[q] = sigmoidf_(ar[q]); kk[q] = k[q] * kkv[q]; O.kp[q] = k[q] * (1.f + (a[q] - 1.f) * kav[q]); }
    const float n2 = sum16(kk.x * kk.x + kk.y * kk.y + kk.z * kk.z + kk.w * kk.w);
    const float inv = __builtin_amdgcn_rsqf(fmaxf(n2, 1e-24f));
#pragma unroll
    for (int q = 0; q < 4; ++q) { const float kn = kk[q] * inv; O.bb[q] = kn * a[q]; O.nk[q] = -kn; }
    if (WANT_BON) { const f32x4 rk = P.rk; O.bon = sum16(r.x * O.kp.x * rk.x + r.y * O.kp.y * rk.y + r.z * O.kp.z * rk.z + r.w * O.kp.w * rk.w); }
}
#define LO2(v) ((f32x2){(v).x, (v).y})
#define HI2(v) ((f32x2){(v).z, (v).w})
constexpr int WRS = 144;
constexpr int W_SLOT = 64 * WRS;
enum { SL_NT = 0, SL_RT, SL_BH, SL_KH, SL_BHT, SL_KHT, SL_VT, SL_MK, SL_NB, SL_NK, SL_W1T, SL_U0T };
constexpr int W_MB = 12 * W_SLOT, W_CL = W_MB + 16384, W_PL = W_CL + 16384;
DI bf16x8 wfrag(LAS unsigned char* L, int slot, int row, int ks, int q) { return *(const LAS bf16x8*)(L + slot * W_SLOT + row * WRS + ks * 64 + q * 16); }
DI void wput(LAS unsigned char* L, int slot, int row, int col, float v) { *(LAS bf16_t*)(L + slot * W_SLOT + row * WRS + col * 2) = (bf16_t)(cvt_pk_bf16(v, 0.f) & 0xffffu); }
DI void tr4x4_rows(f32x4& x) {
    const float f0 = x.x, f1 = x.y, f2 = x.z, f3 = x.w;
    const unsigned u0 = __builtin_bit_cast(unsigned, f0), u1 = __builtin_bit_cast(unsigned, f1), u2 = __builtin_bit_cast(unsigned, f2), u3 = __builtin_bit_cast(unsigned, f3);
    const auto s02 = __builtin_amdgcn_permlane32_swap(u0, u2, false, false); const auto s13 = __builtin_amdgcn_permlane32_swap(u1, u3, false, false);
    const auto t01 = __builtin_amdgcn_permlane16_swap(s02[0], s13[0], false, false); const auto t23 = __builtin_amdgcn_permlane16_swap(s02[1], s13[1], false, false);
    x[0] = __builtin_bit_cast(float, (unsigned)t01[0]); x[1] = __builtin_bit_cast(float, (unsigned)t01[1]); x[2] = __builtin_bit_cast(float, (unsigned)t23[0]); x[3] = __builtin_bit_cast(float, (unsigned)t23[1]);
}
DI void scan_w1(const Ctx& F, const RwPar& Q, const bf16_t* z) {
    unsigned char* const wsl = F.ws; LAS unsigned char* L = F.lds;
    const int wave = F.wave;
    const bf16_t* LW = (const bf16_t*)(wsl + WS_LW);
    LAS float* MB = (LAS float*)(L + W_MB); LAS float* CL = (LAS float*)(L + W_CL); LAS float* PL = (LAS float*)(L + W_PL);
    PrepPar PN;
    PrepRaw RN[2];
    if (F.bid < 96 * NCH) { const int bh = F.bid % 96, c = F.bid / 96, b = bh / 24, head = bh - b * 24, tokb = b * SEQ + c * CH, c4 = head * 64 + 4 * (F.lane & 15);
#pragma unroll
        for (int p = 0; p < 2; ++p) prep_load(RN[p], z, LW, tokb + p * 32 + wave * 4 + (F.lane >> 4), c4);
        par_load(PN, Q, c4); }
    for (int u = F.bid; u < 96 * NCH; u += F.G) {
        int lane = F.lane; asm volatile("" : "+v"(lane));
        const int tq = lane >> 4, li = lane & 15, fr = li, fq = tq;
        const int bh = u % 96, c = u / 96, b = bh / 24, head = bh - b * 24, tokb = b * SEQ + c * CH, c4 = head * 64 + 4 * li;
        LDS_BARRIER();
        PrepOut O[2];
#pragma unroll
        for (int p = 0; p < 2; ++p) {
            const int t = p * 32 + wave * 4 + tq; const PrepRaw R = RN[p];
            prep_compute<true>(R, PN, ((tokb + t) & (SEQ - 1)) != 0, O[p]);
            *(LAS f32x4*)(CL + t * 64 + 4 * li) = O[p].ld;
            u32x2 e; e.x = cvt_pk_bf16(O[p].bon * O[p].v.x, O[p].bon * O[p].v.y); e.y = cvt_pk_bf16(O[p].bon * O[p].v.z, O[p].bon * O[p].v.w);
            *(GAS u32x2*)((bf16_t*)(wsl + WS_E) + (size_t)(tokb + t) * CMIX + c4) = e;
        }
        LDS_BARRIER();
        if (wave == 0) {
            float xs[64];
#pragma unroll
            for (int t = 0; t < 64; ++t) xs[t] = CL[t * 64 + lane];
#pragma unroll
            for (int t = 1; t < 64; ++t) xs[t] += xs[t - 1];
#pragma unroll
            for (int t = 0; t < 64; ++t) CL[t * 64 + lane] = xs[t];
        }
        LDS_BARRIER();
#pragma unroll
        for (int p = 0; p < 2; ++p) {
            const int t = p * 32 + wave * 4 + tq;
            const f32x4 cl = *(const LAS f32x4*)(CL + t * 64 + 4 * li);
            f32x4 clm = (f32x4){0.f, 0.f, 0.f, 0.f}; if (t > 0) clm = *(const LAS f32x4*)(CL + (t - 1) * 64 + 4 * li);
            f32x4 nt, rt, bh4, kh4;
#pragma unroll
            for (int q = 0; q < 4; ++q) { const float P = __expf(cl[q]), Pm = __expf(clm[q]), iP = __expf(-cl[q]);
                nt[q] = O[p].nk[q] * Pm; rt[q] = O[p].r[q] * P; bh4[q] = O[p].bb[q] * iP; kh4[q] = O[p].kp[q] * iP;
                if (t == 63) PL[4 * li + q] = P; }
            u32x2 w;
            w.x = cvt_pk_bf16(nt.x, nt.y); w.y = cvt_pk_bf16(nt.z, nt.w); *(LAS u32x2*)(L + SL_NT * W_SLOT + t * WRS + 8 * li) = w;
            w.x = cvt_pk_bf16(rt.x, rt.y); w.y = cvt_pk_bf16(rt.z, rt.w); *(LAS u32x2*)(L + SL_RT * W_SLOT + t * WRS + 8 * li) = w;
            w.x = cvt_pk_bf16(bh4.x, bh4.y); w.y = cvt_pk_bf16(bh4.z, bh4.w); *(LAS u32x2*)(L + SL_BH * W_SLOT + t * WRS + 8 * li) = w;
            w.x = cvt_pk_bf16(kh4.x, kh4.y); w.y = cvt_pk_bf16(kh4.z, kh4.w); *(LAS u32x2*)(L + SL_KH * W_SLOT + t * WRS + 8 * li) = w;
            { f32x4 vv = O[p].v; tr4x4_rows(bh4); tr4x4_rows(kh4); tr4x4_rows(vv);
              const int off = (4 * li + tq) * WRS + (p * 32 + wave * 4) * 2;
              w.x = cvt_pk_bf16(bh4.x, bh4.y); w.y = cvt_pk_bf16(bh4.z, bh4.w); *(LAS u32x2*)(L + SL_BHT * W_SLOT + off) = w;
              w.x = cvt_pk_bf16(kh4.x, kh4.y); w.y = cvt_pk_bf16(kh4.z, kh4.w); *(LAS u32x2*)(L + SL_KHT * W_SLOT + off) = w;
              w.x = cvt_pk_bf16(vv.x, vv.y); w.y = cvt_pk_bf16(vv.z, vv.w); *(LAS u32x2*)(L + SL_VT * W_SLOT + off) = w; }
        }
        LDS_BARRIER();
        asm volatile("" ::: "memory");
        { const int un = u + F.G; if (un < 96 * NCH) { const int bhn = un % 96, cn = un / 96, bn = bhn / 24, headn = bhn - bn * 24, tokbn = bn * SEQ + cn * CH, c4n = headn * 64 + 4 * li;
#pragma unroll
            for (int p = 0; p < 2; ++p) prep_load(RN[p], z, LW, tokbn + p * 32 + wave * 4 + tq, c4n);
            par_load(PN, Q, c4n); } }
        for (int reps = 0; reps < REP_WS; ++reps) {
            const int mt = wave >> 1, slotA = (mt < 2) ? SL_NT : SL_RT, slotB = (mt & 1) ? SL_KH : SL_BH, slotO = (mt == 1) ? SL_MK : (mt == 2 ? SL_NB : SL_NK), tt0 = (wave & 1) * 2;
            bf16x8 Af[2][2], Bf[4][2];
#pragma unroll
            for (int a2 = 0; a2 < 2; ++a2)
#pragma unroll
                for (int ks = 0; ks < 2; ++ks) Af[a2][ks] = wfrag(L, slotA, 16 * (tt0 + a2) + fr, ks, fq);
#pragma unroll
            for (int ss = 0; ss < 4; ++ss)
#pragma unroll
                for (int ks = 0; ks < 2; ++ks) Bf[ss][ks] = wfrag(L, slotB, 16 * ss + fr, ks, fq);
            float zf = 0.f; asm volatile("" : "+v"(zf));
            const unsigned zu = __builtin_bit_cast(unsigned, zf);
            const int strict = (mt < 2) ? 1 : 0; LAS unsigned char* ob = L + slotO * W_SLOT;
#pragma unroll
            for (int a2 = 0; a2 < 2; ++a2)
#pragma unroll
                for (int ss = 0; ss < 4; ++ss) { const int t = 16 * (tt0 + a2) + fr, s0 = 16 * ss + 4 * fq;
                    if (ss <= tt0 + a2) {
                        f32x4 acc = __builtin_amdgcn_mfma_f32_16x16x32_bf16(Bf[ss][0], Af[a2][0], (f32x4){0.f, 0.f, 0.f, 0.f}, 0, 0, 0);
                        acc = __builtin_amdgcn_mfma_f32_16x16x32_bf16(Bf[ss][1], Af[a2][1], acc, 0, 0, 0);
                        f32x4 o;
#pragma unroll
                        for (int r = 0; r < 4; ++r) o[r] = (s0 + r + strict <= t) ? acc[r] : 0.f;
                        if (mt == 0) *(LAS f32x4*)(MB + t * 64 + s0) = o;
                        else { u32x2 w; w.x = cvt_pk_bf16(o[0], o[1]); w.y = cvt_pk_bf16(o[2], o[3]); *(LAS u32x2*)(ob + t * WRS + s0 * 2) = w; }
                    } else {
                        if (mt == 0) *(LAS f32x4*)(MB + t * 64 + s0) = (f32x4){zf, zf, zf, zf};
                        else *(LAS u32x2*)(ob + t * WRS + s0 * 2) = (u32x2){zu, zu};
                    }
                }
        }
        LDS_BARRIER();
        { const int t = F.tid >> 3, s0 = (F.tid & 7) * 8; const f32x4 a0 = *(const LAS f32x4*)(MB + t * 64 + s0), a1 = *(const LAS f32x4*)(MB + t * 64 + s0 + 4);
          u32x4 w; w.x = cvt_pk_bf16(a0.x, a0.y); w.y = cvt_pk_bf16(a0.z, a0.w); w.z = cvt_pk_bf16(a1.x, a1.y); w.w = cvt_pk_bf16(a1.z, a1.w);
          *(LAS u32x4*)(L + SL_BH * W_SLOT + t * WRS + s0 * 2) = w; }
#pragma unroll
        for (int k2 = 0; k2 < 2; ++k2) {
            const int tile = wave * 2 + k2, tt = tile >> 2, it = tile & 3;
            f32x4 acc = (f32x4){0.f, 0.f, 0.f, 0.f};
#pragma unroll
            for (int ks = 0; ks < 2; ++ks) acc = __builtin_amdgcn_mfma_f32_16x16x32_bf16(wfrag(L, SL_MK, 16 * tt + fr, ks, fq), wfrag(L, SL_VT, 16 * it + fr, ks, fq), acc, 0, 0, 0);
#pragma unroll
            for (int r = 0; r < 4; ++r) CL[(16 * tt + 4 * fq + r) * 64 + 16 * it + fr] = acc[r];
        }
        if (wave >= 4) {
            const int I = wave - 4;
            float d[16], xb[16];
#pragma unroll
            for (int r = 0; r < 16; ++r) d[r] = (r == lane) ? 1.f : 0.f;
            const LAS float* mbv = MB; asm volatile("" : "+v"(mbv));
            const LAS float* mb = mbv + (16 * I) * 64 + 16 * I;
            f32x4 A[8][2], Bm[8][2];
#pragma unroll
            for (int tt = 0; tt < 8; ++tt) { A[tt][0] = *(const LAS f32x4*)(mb + tt * 64); A[tt][1] = *(const LAS f32x4*)(mb + tt * 64 + 4); }
#pragma unroll
            for (int tt = 0; tt < 8; ++tt) { Bm[tt][0] = *(const LAS f32x4*)(mb + (8 + tt) * 64); Bm[tt][1] = *(const LAS f32x4*)(mb + (8 + tt) * 64 + 4); }
#pragma unroll
            for (int sx = 0; sx < 8; ++sx) { xb[sx] = d[sx];
#pragma unroll
                for (int tt = sx + 1; tt < 8; ++tt) d[tt] = fma_s(A[tt][sx >> 2][sx & 3], xb[sx], d[tt]); }
#pragma unroll
            for (int sx = 0; sx < 8; ++sx)
#pragma unroll
                for (int tt = 0; tt < 8; ++tt) d[8 + tt] = fma_s(Bm[tt][sx >> 2][sx & 3], xb[sx], d[8 + tt]);
            asm volatile("" : "+v"(d[8]), "+v"(d[15]) :: "memory");
#pragma unroll
            for (int tt = 0; tt < 8; ++tt) { A[tt][0] = *(const LAS f32x4*)(mb + (8 + tt) * 64 + 8); A[tt][1] = *(const LAS f32x4*)(mb + (8 + tt) * 64 + 12); }
#pragma unroll
            for (int sx = 0; sx < 8; ++sx) { xb[8 + sx] = d[8 + sx];
#pragma unroll
                for (int tt = sx + 1; tt < 8; ++tt) d[8 + tt] = fma_s(A[tt][sx >> 2][sx & 3], xb[8 + sx], d[8 + tt]); }
            if (lane < 16) {
#pragma unroll
                for (int t = 0; t < 16; ++t) *(LAS bf16_t*)(L + SL_KH * W_SLOT + (16 * I + t) * 48 + lane * 2) = (bf16_t)(cvt_pk_bf16(xb[t], 0.f) & 0xffffu);
            }
        }
        LDS_BARRIER();
        asm volatile("" ::: "memory");
        for (int repx = 0; repx < REP_WX; ++repx) {
            const int sys = wave >> 2, ct = wave & 3, slotX = sys == 0 ? SL_W1T : SL_U0T;
            LAS unsigned char* TI = L + SL_KH * W_SLOT;
            f32x4 rhs[4];
            if (sys == 0) {
#pragma unroll
                for (int I = 0; I < 4; ++I)
#pragma unroll
                    for (int r = 0; r < 4; ++r) rhs[I][r] = bf2f(*(const LAS bf16_t*)(L + SL_NT * W_SLOT + (16 * I + 4 * fq + r) * WRS + (16 * ct + fr) * 2));
            } else {
#pragma unroll
                for (int I = 0; I < 4; ++I)
#pragma unroll
                    for (int r = 0; r < 4; ++r) rhs[I][r] = CL[(16 * I + 4 * fq + r) * 64 + 16 * ct + fr];
            }
            u32x2 ta[4], ma[6];
#pragma unroll
            for (int I = 0; I < 4; ++I) ta[I] = *(const LAS u32x2*)(TI + (16 * I + fr) * 48 + 8 * fq);
#pragma unroll
            for (int I = 1; I < 4; ++I)
#pragma unroll
                for (int Ip = 0; Ip < I; ++Ip) ma[I * (I - 1) / 2 + Ip] = *(const LAS u32x2*)(L + SL_BH * W_SLOT + (16 * I + fr) * WRS + (16 * Ip + 4 * fq) * 2);
            u32x2 xk[4];
#pragma unroll
            for (int I = 0; I < 4; ++I) {
                f32x4 acc = rhs[I];
#pragma unroll
                for (int Ip = 0; Ip < I; ++Ip) { const u32x2 m = ma[I * (I - 1) / 2 + Ip];
                    acc = __builtin_amdgcn_mfma_f32_16x16x32_bf16(__builtin_bit_cast(bf16x8, (u32x4){m.x, m.y, 0u, 0u}), __builtin_bit_cast(bf16x8, (u32x4){xk[Ip].x, xk[Ip].y, 0u, 0u}), acc, 0, 0, 0); }
                const unsigned d0 = cvt_pk_bf16(acc[0], acc[1]), d1 = cvt_pk_bf16(acc[2], acc[3]);
                const f32x4 x = __builtin_amdgcn_mfma_f32_16x16x32_bf16(__builtin_bit_cast(bf16x8, (u32x4){ta[I].x, ta[I].y, 0u, 0u}), __builtin_bit_cast(bf16x8, (u32x4){d0, d1, 0u, 0u}), (f32x4){0.f, 0.f, 0.f, 0.f}, 0, 0, 0);
                xk[I].x = cvt_pk_bf16(x[0], x[1]); xk[I].y = cvt_pk_bf16(x[2], x[3]);
                *(LAS u32x2*)(L + slotX * W_SLOT + (16 * ct + fr) * WRS + (16 * I + 4 * fq) * 2) = xk[I];
            }
        }
        LDS_BARRIER();
        for (int repo = 0; repo < REP_WO; ++repo) {
            const int kind = wave >> 1, ta0 = (wave & 1) * 2;
            float* gp = gh_ptr(wsl, bh, c, 0); float* hp = gh_ptr(wsl, bh, c, 1);
            bf16_t* qy = (bf16_t*)(wsl + WS_QY) + (size_t)u * 4096; float* y0t = (float*)(wsl + WS_Y0T) + (size_t)u * 4096;
            const int sA1 = kind == 0 ? SL_W1T : kind == 1 ? SL_BHT : kind == 2 ? SL_W1T : SL_NK, sB1 = kind == 0 ? SL_BHT : kind == 1 ? SL_U0T : kind == 2 ? SL_NB : SL_VT;
            const int sA2 = kind == 1 ? SL_KHT : SL_NB, sB2 = kind == 1 ? SL_VT : SL_U0T; const bool two = (kind & 1) != 0;
            bf16x8 Af[2][2], Bf[4][2];
#pragma unroll
            for (int a2 = 0; a2 < 2; ++a2)
#pragma unroll
                for (int ks = 0; ks < 2; ++ks) Af[a2][ks] = wfrag(L, sA1, 16 * (ta0 + a2) + fr, ks, fq);
#pragma unroll
            for (int tb = 0; tb < 4; ++tb)
#pragma unroll
                for (int ks = 0; ks < 2; ++ks) Bf[tb][ks] = wfrag(L, sB1, 16 * tb + fr, ks, fq);
            f32x4 acc[2][4];
#pragma unroll
            for (int a2 = 0; a2 < 2; ++a2)
#pragma unroll
                for (int tb = 0; tb < 4; ++tb) { acc[a2][tb] = (f32x4){0.f, 0.f, 0.f, 0.f};
#pragma unroll
                    for (int ks = 0; ks < 2; ++ks) acc[a2][tb] = __builtin_amdgcn_mfma_f32_16x16x32_bf16(Af[a2][ks], Bf[tb][ks], acc[a2][tb], 0, 0, 0); }
            if (two) {
#pragma unroll
                for (int a2 = 0; a2 < 2; ++a2)
#pragma unroll
                    for (int ks = 0; ks < 2; ++ks) Af[a2][ks] = wfrag(L, sA2, 16 * (ta0 + a2) + fr, ks, fq);
#pragma unroll
                for (int tb = 0; tb < 4; ++tb)
#pragma unroll
                    for (int ks = 0; ks < 2; ++ks) Bf[tb][ks] = wfrag(L, sB2, 16 * tb + fr, ks, fq);
#pragma unroll
                for (int a2 = 0; a2 < 2; ++a2)
#pragma unroll
                    for (int tb = 0; tb < 4; ++tb)
#pragma unroll
                        for (int ks = 0; ks < 2; ++ks) acc[a2][tb] = __builtin_amdgcn_mfma_f32_16x16x32_bf16(Af[a2][ks], Bf[tb][ks], acc[a2][tb], 0, 0, 0);
            }
#pragma unroll
            for (int a2 = 0; a2 < 2; ++a2)
#pragma unroll
                for (int tb = 0; tb < 4; ++tb) { const int ta = ta0 + a2; const f32x4 av = acc[a2][tb];
                    if (kind == 0) {
                        const int j = 16 * tb + fr; const float pl = PL[j];
                        f32x4 o;
#pragma unroll
                        for (int r = 0; r < 4; ++r) o[r] = pl * (av[r] + ((16 * ta + 4 * fq + r) == j ? 1.f : 0.f));
                        u32x2 w; w.x = cvt_pk_bf16(o[0], o[1]); w.y = cvt_pk_bf16(o[2], o[3]);
                        *(GAS u32x2*)((bf16_t*)gp + j * 64 + 16 * ta + 4 * fq) = w;
                    } else if (kind == 1) {
                        const f32x4 pl = *(const LAS f32x4*)(PL + 16 * ta + 4 * fq);
                        *(GAS f32x4*)(hp + (16 * tb + fr) * 64 + 16 * ta + 4 * fq) = pl * av;
                    } else if (kind == 2) {
                        const int t = 16 * tb + fr; const u32x2 rr = *(const LAS u32x2*)(L + SL_RT * W_SLOT + t * WRS + (16 * ta + 4 * fq) * 2);
                        u32x2 w; w.x = cvt_pk_bf16(av[0] + bflo(rr.x), av[1] + bfhi(rr.x)); w.y = cvt_pk_bf16(av[2] + bflo(rr.y), av[3] + bfhi(rr.y));
                        *(GAS u32x2*)(qy + t * 64 + 16 * ta + 4 * fq) = w;
                    } else {
                        u32x2 w; w.x = cvt_pk_bf16(av[0], av[1]); w.y = cvt_pk_bf16(av[2], av[3]); *(GAS u32x2*)((bf16_t*)y0t + (16 * tb + fr) * 64 + 16 * ta + 4 * fq) = w;
                    }
                }
        }
    }
    LDS_BARRIER();
}
DI void scan_w2(const Ctx& F, const RwPar& Q) {
    unsigned char* const wsl = F.ws; const int lane = F.lane, fr = lane & 15, fq = lane >> 4;
    LAS float* yb = (LAS float*)(F.lds + F.wave * 16384);
    const bf16_t* gate = (const bf16_t*)(wsl + WS_GATE); const bf16_t* Eb = (const bf16_t*)(wsl + WS_E); bf16_t* cat = (bf16_t*)(wsl + WS_CAT);
    for (int u = F.gw; u < 96 * NCH; u += F.ngw) {
        const int bh = u % 96, c = u / 96, b = bh / 24, head = bh - b * 24, tokb = b * SEQ + c * CH;
        const bf16_t* qy = (const bf16_t*)(wsl + WS_QY) + (size_t)u * 4096; const float* y0t = (const float*)(wsl + WS_Y0T) + (size_t)u * 4096;
        f32x4 acc[4][4];
#pragma unroll
        for (int tt = 0; tt < 4; ++tt)
#pragma unroll
            for (int it = 0; it < 4; ++it) { const u32x2 yv = *(const GAS u32x2*)((const bf16_t*)y0t + (16 * it + fr) * 64 + 16 * tt + 4 * fq); acc[tt][it] = (f32x4){bflo(yv.x), bfhi(yv.x), bflo(yv.y), bfhi(yv.y)}; }
        if (c > 0) {
            const bf16_t* sp = (const bf16_t*)gh_ptr(wsl, bh, c - 1, 0) + 4096;
            bf16x8 Bf[4][2];
#pragma unroll
            for (int it = 0; it < 4; ++it)
#pragma unroll
                for (int ks = 0; ks < 2; ++ks) Bf[it][ks] = *(const GAS bf16x8*)(sp + (16 * it + fr) * 64 + 32 * ks + 8 * fq);
#pragma unroll
            for (int tt = 0; tt < 4; ++tt)
#pragma unroll
                for (int ks = 0; ks < 2; ++ks) { const bf16x8 Af = *(const GAS bf16x8*)(qy + (16 * tt + fr) * 64 + 32 * ks + 8 * fq);
#pragma unroll
                    for (int it = 0; it < 4; ++it) acc[tt][it] = __builtin_amdgcn_mfma_f32_16x16x32_bf16(Af, Bf[it][ks], acc[tt][it], 0, 0, 0); }
        }
#pragma unroll
        for (int tt = 0; tt < 4; ++tt)
#pragma unroll
            for (int it = 0; it < 4; ++it)
#pragma unroll
                for (int r = 0; r < 4; ++r) yb[(16 * tt + 4 * fq + r) * 64 + 16 * it + fr] = acc[tt][it][r];
        const int c4 = head * 64 + 4 * (lane & 15);
        const f32x4 g4 = *(const GAS f32x4*)(Q.gng + c4), b4 = *(const GAS f32x4*)(Q.gnb + c4);
        u32x2 evs[16], gts[16];
#pragma unroll
        for (int k = 0; k < 16; ++k) { const int tok = tokb + 4 * k + (lane >> 4); evs[k] = *(const GAS u32x2*)(Eb + (size_t)tok * CMIX + c4); gts[k] = *(const GAS u32x2*)(gate + (size_t)tok * CMIX + c4); }
        LDS_WAIT();
#pragma unroll
        for (int k = 0; k < 16; ++k) {
            const int slot = k * 64 + lane, t = slot >> 4, li = slot & 15, tok = tokb + t;
            const f32x4 y = *(const LAS f32x4*)(yb + t * 64 + 4 * li);
            const u32x2 ev = evs[k], gt = gts[k];
            const float mean = sum16(y.x + y.y + y.z + y.w) * (1.f / 64.f);
            const f32x4 d = y - mean;
            const float var = sum16(d.x * d.x + d.y * d.y + d.z * d.z + d.w * d.w) * (1.f / 64.f);
            const float rstd = rsqrtf(var + GN_EPS);
            f32x4 o = d * rstd * g4 + b4; o.x += bflo(ev.x); o.y += bfhi(ev.x); o.z += bflo(ev.y); o.w += bfhi(ev.y);
            u32x2 w; w.x = cvt_pk_bf16(o.x * bflo(gt.x), o.y * bfhi(gt.x)); w.y = cvt_pk_bf16(o.z * bflo(gt.y), o.w * bfhi(gt.y));
            *(GAS u32x2*)(cat + (size_t)tok * DM + c4) = w;
        }
        LDS_WAIT();
    }
}
DI void scan_passB(const Ctx& F) {
    unsigned char* const wsl = F.ws; const int lane = F.lane, fr = lane & 15, fq = lane >> 4, ih = F.wave >> 2, q = F.wave & 3, bh = F.bid;
    LAS unsigned char* Sx0 = F.lds;
    bf16x8 ga[7][2]; f32x4 hq[7][2];
#define PB_LOAD(set, cc) do { const GAS bf16_t* _gp = (const GAS bf16_t*)gh_ptr(wsl, bh, (cc), 0) + (16 * q + fr) * 64 + 8 * fq; const GAS float* _hp = (const GAS float*)(gh_ptr(wsl, bh, (cc), 1) + (32 * ih + fr) * 64 + 16 * q + 4 * fq); \
        ga[set][0] = *(const GAS bf16x8*)_gp; ga[set][1] = *(const GAS bf16x8*)(_gp + 32); \
        _Pragma("unroll") for (int _r = 0; _r < 2; ++_r) hq[set][_r] = *(const GAS f32x4*)(_hp + (16 * _r) * 64); } while (0)
    PB_LOAD(0, 0); PB_LOAD(1, 1); PB_LOAD(2, 2); PB_LOAD(3, 3); PB_LOAD(4, 4); PB_LOAD(5, 5);
    for (int c7 = 0; c7 < NCH - 1; c7 += 7) {
#pragma unroll
        for (int u7 = 0; u7 < 7; ++u7) {
            const int c = c7 + u7;
            f32x4 acc[2];
#pragma unroll
            for (int it = 0; it < 2; ++it) acc[it] = hq[u7][it];
            const bf16x8 a0 = ga[u7][0], a1 = ga[u7][1];
            PB_LOAD((u7 + 6) % 7, (c + 6 < NCH - 1) ? c + 6 : NCH - 2);
            if (c > 0) {
#pragma unroll
                for (int it = 0; it < 2; ++it) {
                    acc[it] = __builtin_amdgcn_mfma_f32_16x16x32_bf16(a0, *(const LAS bf16x8*)(Sx0 + (c & 1) * W_SLOT + (32 * ih + 16 * it + fr) * WRS + fq * 16), acc[it], 0, 0, 0);
                    acc[it] = __builtin_amdgcn_mfma_f32_16x16x32_bf16(a1, *(const LAS bf16x8*)(Sx0 + (c & 1) * W_SLOT + (32 * ih + 16 * it + fr) * WRS + 64 + fq * 16), acc[it], 0, 0, 0); }
            }
            GAS bf16_t* op = (GAS bf16_t*)gh_ptr(wsl, bh, c, 0) + 4096 + (32 * ih + fr) * 64 + 16 * q + 4 * fq;
#pragma unroll
            for (int it = 0; it < 2; ++it) { u32x2 w; w.x = cvt_pk_bf16(acc[it].x, acc[it].y); w.y = cvt_pk_bf16(acc[it].z, acc[it].w);
                *(GAS u32x2*)(op + (16 * it) * 64) = w; *(LAS u32x2*)(Sx0 + ((c + 1) & 1) * W_SLOT + (32 * ih + 16 * it + fr) * WRS + (16 * q + 4 * fq) * 2) = w; }
            LDS_BARRIER();
        }
    }
#undef PB_LOAD
}

DI void ln1_router(const Ctx& F, const Params& P, int l, const float* xin) {
    unsigned char* const wsl = F.ws; float* const outl = F.out; (void)outl;
    const float* g = PIN(5) + (size_t)l * DM; const float* bta = PIN(6) + (size_t)l * DM;
    const float* gb = PIN(10) + l * 4; const float* eb = PIN(12) + l * 32;
    const bf16_t* hb = (const bf16_t*)(wsl + WS_HB); bf16_t* xb = (bf16_t*)(wsl + WS_XB); float* xo = outl;
    const bf16_t* wrt = (const bf16_t*)(wsl + WS_WSW + (size_t)l * WSW_STRIDE);
    unsigned* cnt = (unsigned*)(wsl + WS_CTL) + CW_CNT + l * 32 * 64;
    int* ltok = (int*)(wsl + WS_LTOK); float* lgate = (float*)(wsl + WS_LGATE); int* lslot = (int*)(wsl + WS_LSLOT);
    const int lane = F.lane, fr = lane & 15, fq = lane >> 4, wave = F.wave;
    LAS float* lg = (LAS float*)(F.lds + (wave & 3) * 4096);
    LAS float* lgp = (LAS float*)(F.lds + 16384 + (wave & 3) * 4096);
    LAS int* cntl = (LAS int*)(F.lds + 32768); LAS int* basel = cntl + 32;
    if (F.tid < NEXP) cntl[F.tid] = 0;
    __syncthreads();
    LAS float* gls = (LAS float*)(F.lds + 36864 + 52224); LAS float* bls = gls + DM;
    for (int blk = F.bid; blk < NTOK / 64; blk += F.G) {
        { const f32x4 gv = *(const GAS f32x4*)(g + 4 * F.tid), bv = *(const GAS f32x4*)(bta + 4 * F.tid); *(LAS f32x4*)(gls + 4 * F.tid) = gv; *(LAS f32x4*)(bls + 4 * F.tid) = bv; }
        __syncthreads();
#pragma unroll 1
        for (int pass = 0; pass < 4; ++pass) {
            int lno = lane; asm volatile("" : "+v"(lno));
            const int hr2 = lno >> 5, l32 = lno & 31;
            const size_t ro = (size_t)(blk * 64 + wave * 8 + pass * 2 + hr2) * DM + 8 * l32;
            u32x4 xr[8], hr[8];
#pragma unroll
            for (int i = 0; i < 8; ++i) { xr[i] = *(const GAS u32x4*)(xb + ro + 256 * i); hr[i] = *(const GAS u32x4*)(hb + ro + 256 * i); }
            float s = 0.f, s2 = 0.f;
#pragma unroll
            for (int i = 0; i < 8; ++i) {
#pragma unroll
                for (int e = 0; e < 4; ++e) { const float v0 = ALPHA * bflo(xr[i][e]) + bflo(hr[i][e]), v1 = ALPHA * bfhi(xr[i][e]) + bfhi(hr[i][e]); s += v0 + v1; s2 += v0 * v0 + v1 * v1; } }
            s = sum16(s); s2 = sum16(s2); s += __shfl_xor(s, 16); s2 += __shfl_xor(s2, 16);
            const float mean = s * (1.f / DM), rstd = rsqrtf(fmaxf(s2 * (1.f / DM) - mean * mean, 0.f) + LN_EPS);
#pragma unroll
            for (int i = 0; i < 8; ++i) { const int col = 256 * i + 8 * l32;
                const f32x4 g0 = *(const LAS f32x4*)(gls + col), g1 = *(const LAS f32x4*)(gls + col + 4), b0 = *(const LAS f32x4*)(bls + col), b1 = *(const LAS f32x4*)(bls + col + 4);
                u32x4 w;
#pragma unroll
                for (int e = 0; e < 4; ++e) { const float v0 = ALPHA * bflo(xr[i][e]) + bflo(hr[i][e]), v1 = ALPHA * bfhi(xr[i][e]) + bfhi(hr[i][e]);
                    const float gg0 = e < 2 ? g0[2 * e] : g1[2 * e - 4], gg1 = e < 2 ? g0[2 * e + 1] : g1[2 * e - 3], bb0 = e < 2 ? b0[2 * e] : b1[2 * e - 4], bb1 = e < 2 ? b0[2 * e + 1] : b1[2 * e - 3];
                    w[e] = cvt_pk_bf16((v0 - mean) * rstd * gg0 + bb0, (v1 - mean) * rstd * gg1 + bb1); }
                *(GAS u32x4*)(xb + ro + 256 * i) = w;
                asm volatile("" ::: "memory"); }
        }
        VM_WAIT();
        __syncthreads();
        __builtin_amdgcn_fence(__ATOMIC_ACQUIRE, "agent");
        VM_WAIT();
        const int row0 = blk * 64 + (wave & 3) * 16, kh = wave >> 2, krot = (F.bid * 5 + wave * 3) & 31;
        f32x4 acc[3];
#pragma unroll
        for (int ct = 0; ct < 3; ++ct) acc[ct] = (f32x4){0.f, 0.f, 0.f, 0.f};
        const bf16_t* arow = xb + (size_t)(row0 + fr) * DM + 8 * fq + kh * 1024;
        LAS unsigned char* wst = F.lds + 36864;
        u32x4 wreg[6];
        { const int st = F.bid & 7;
#pragma unroll
          for (int i = 0; i < 6; ++i) { const int ch = F.tid + NT * i, row = ch >> 4, c16 = ch & 15, rkh = row / 96, rr = row - rkh * 96;
              wreg[i] = *(const GAS u32x4*)(wrt + (size_t)rr * DM + rkh * 1024 + st * 128 + c16 * 8); } }
#pragma unroll 1
        for (int si = 0; si < 8; ++si) {
            const int st = (si + F.bid) & 7;
            LAS unsigned char* wb = wst + (si & 1) * 52224;
#pragma unroll
            for (int i = 0; i < 6; ++i) { const int ch = F.tid + NT * i, row = ch >> 4, c16 = ch & 15; *(LAS u32x4*)(wb + row * 272 + c16 * 16) = wreg[i]; }
            if (si + 1 < 8) { const int stn = (si + 1 + F.bid) & 7;
#pragma unroll
                for (int i = 0; i < 6; ++i) { const int ch = F.tid + NT * i, row = ch >> 4, c16 = ch & 15, rkh = row / 96, rr = row - rkh * 96;
                    wreg[i] = *(const GAS u32x4*)(wrt + (size_t)rr * DM + rkh * 1024 + stn * 128 + c16 * 8); } }
            bf16x8 af[4];
#pragma unroll
            for (int ksl = 0; ksl < 4; ++ksl) af[ksl] = *(const GAS bf16x8*)(arow + st * 128 + ksl * 32);
            LDS_BARRIER();
#pragma unroll
            for (int ksl = 0; ksl < 4; ++ksl)
#pragma unroll
                for (int ct = 0; ct < 3; ++ct) {
                    acc[ct] = __builtin_amdgcn_mfma_f32_16x16x32_bf16(af[ksl], *(const LAS bf16x8*)(wb + (kh * 96 + 16 * ct + fr) * 272 + ksl * 64 + fq * 16), acc[ct], 0, 0, 0);
                    acc[ct] = __builtin_amdgcn_mfma_f32_16x16x32_bf16(af[ksl], *(const LAS bf16x8*)(wb + (kh * 96 + 48 + 16 * ct + fr) * 272 + ksl * 64 + fq * 16), acc[ct], 0, 0, 0);
                }
        }
        if (kh == 1) {
#pragma unroll
            for (int ct = 0; ct < 3; ++ct)
#pragma unroll
                for (int jj = 0; jj < 4; ++jj) lgp[(4 * fq + jj) * 48 + 16 * ct + fr] = acc[ct][jj];
        }
        __syncthreads();
        if (kh == 0) {
#pragma unroll
            for (int ct = 0; ct < 3; ++ct)
#pragma unroll
                for (int jj = 0; jj < 4; ++jj) lg[(4 * fq + jj) * 48 + 16 * ct + fr] = acc[ct][jj] + lgp[(4 * fq + jj) * 48 + 16 * ct + fr];
        }
        LDS_WAIT();
        int se0 = 0, se1 = 0, sr0 = 0, sr1 = 0, stok = 0; float sg0 = 0.f, sg1 = 0.f;
        if (kh == 0 && lane < 16) {
            const LAS float* L = lg + lane * 48; const int tok = row0 + lane;
            float gl[4]; int grp_i = 0; float gmx;
#pragma unroll
            for (int q = 0; q < 4; ++q) gl[q] = L[q] + gb[q];
            gmx = gl[0];
#pragma unroll
            for (int q = 1; q < 4; ++q) if (gl[q] > gmx) { gmx = gl[q]; grp_i = q; }
            float gs = 0.f;
#pragma unroll
            for (int q = 0; q < 4; ++q) gs += __expf(gl[q] - gmx);
            const float pg = 1.f / gs;
            float el[8];
#pragma unroll
            for (int q = 0; q < 8; ++q) el[q] = L[4 + 8 * grp_i + q] + eb[8 * grp_i + q];
            int i0 = 0; float m0 = el[0];
#pragma unroll
            for (int q = 1; q < 8; ++q) if (el[q] > m0) { m0 = el[q]; i0 = q; }
            int i1 = -1; float m1 = -3.0e38f;
#pragma unroll
            for (int q = 0; q < 8; ++q) if (q != i0 && el[q] > m1) { m1 = el[q]; i1 = q; }
            if (i1 < 0) { i1 = (i0 == 0) ? 1 : 0; m1 = m0; }
            const float p1 = __expf(m1 - m0), den = 1.f / (1.f + p1);
            const float g0 = pg * den, g1 = pg * p1 * den;
            se0 = grp_i * 8 + i0; se1 = grp_i * 8 + i1; sg0 = g0; sg1 = g1; stok = tok;
            sr0 = __hip_atomic_fetch_add(cntl + se0, 1, __ATOMIC_RELAXED, __HIP_MEMORY_SCOPE_WORKGROUP);
            sr1 = __hip_atomic_fetch_add(cntl + se1, 1, __ATOMIC_RELAXED, __HIP_MEMORY_SCOPE_WORKGROUP);
        }
        __syncthreads();
        if (wave == 0 && lane < NEXP) { const int n = cntl[lane]; basel[lane] = n ? (int)__hip_atomic_fetch_add(cnt + lane * 64, (unsigned)n, __ATOMIC_RELAXED, __HIP_MEMORY_SCOPE_AGENT) : 0; }
        __syncthreads();
        if (kh == 0 && lane < 16) {
            const int pos0 = basel[se0] + sr0, pos1 = basel[se1] + sr1;
            ltok[se0 * LISTCAP + pos0] = stok; lgate[se0 * LISTCAP + pos0] = sg0; lslot[se0 * LISTCAP + pos0] = 2 * stok;
            ltok[se1 * LISTCAP + pos1] = stok; lgate[se1 * LISTCAP + pos1] = sg1; lslot[se1 * LISTCAP + pos1] = 2 * stok + 1;
        }
        __syncthreads();
        if (F.tid < NEXP) cntl[F.tid] = 0;
        __syncthreads();
    }
}

DI void ln2_phase(const Ctx& F, const Params& P, int l) {
    unsigned char* const wsl = F.ws; float* const outl = F.out;
    const float* g = PIN(7) + (size_t)l * DM; const float* bta = PIN(8) + (size_t)l * DM;
    const bf16_t* ys = (const bf16_t*)(wsl + WS_YS); bf16_t* xb = (bf16_t*)(wsl + WS_XB); float* xo = outl;
    LAS float* gls = (LAS float*)F.lds; LAS float* bls = gls + DM;
    { const f32x4 gv = *(const GAS f32x4*)(g + 4 * F.tid), bv = *(const GAS f32x4*)(bta + 4 * F.tid); *(LAS f32x4*)(gls + 4 * F.tid) = gv; *(LAS f32x4*)(bls + 4 * F.tid) = bv; }
    __syncthreads();
#pragma unroll 1
    for (int rp = F.gw; rp < NTOK / 2; rp += F.ngw) {
        int lno = F.lane; asm volatile("" : "+v"(lno));
        const int hr2 = lno >> 5, l32 = lno & 31, row = 2 * rp + hr2;
        const size_t ro = (size_t)row * DM + 8 * l32;
        u32x4 xr[8], y0[8], y1[8];
#pragma unroll
        for (int i = 0; i < 8; ++i) { xr[i] = *(const GAS u32x4*)(xb + ro + 256 * i); y0[i] = *(const GAS u32x4*)(ys + 2 * (size_t)row * DM + 8 * l32 + 256 * i); y1[i] = *(const GAS u32x4*)(ys + (2 * (size_t)row + 1) * DM + 8 * l32 + 256 * i); }
        float s = 0.f, s2 = 0.f;
#pragma unroll
        for (int i = 0; i < 8; ++i) {
#pragma unroll
            for (int e = 0; e < 4; ++e) { const float v0 = ALPHA * bflo(xr[i][e]) + (bflo(y0[i][e]) + bflo(y1[i][e])), v1 = ALPHA * bfhi(xr[i][e]) + (bfhi(y0[i][e]) + bfhi(y1[i][e])); s += v0 + v1; s2 += v0 * v0 + v1 * v1; } }
        s = sum16(s); s2 = sum16(s2); s += __shfl_xor(s, 16); s2 += __shfl_xor(s2, 16);
        const float mean = s * (1.f / DM), rstd = rsqrtf(fmaxf(s2 * (1.f / DM) - mean * mean, 0.f) + LN_EPS);
#pragma unroll
        for (int i = 0; i < 8; ++i) { const int col = 256 * i + 8 * l32;
            const f32x4 g0 = *(const LAS f32x4*)(gls + col), g1 = *(const LAS f32x4*)(gls + col + 4), b0 = *(const LAS f32x4*)(bls + col), b1 = *(const LAS f32x4*)(bls + col + 4);
            float o[8];
#pragma unroll
            for (int e = 0; e < 4; ++e) { const float v0 = ALPHA * bflo(xr[i][e]) + (bflo(y0[i][e]) + bflo(y1[i][e])), v1 = ALPHA * bfhi(xr[i][e]) + (bfhi(y0[i][e]) + bfhi(y1[i][e]));
                const float gg0 = e < 2 ? g0[2 * e] : g1[2 * e - 4], gg1 = e < 2 ? g0[2 * e + 1] : g1[2 * e - 3], bb0 = e < 2 ? b0[2 * e] : b1[2 * e - 4], bb1 = e < 2 ? b0[2 * e + 1] : b1[2 * e - 3];
                o[2 * e] = (v0 - mean) * rstd * gg0 + bb0; o[2 * e + 1] = (v1 - mean) * rstd * gg1 + bb1; }
            if (l == NLAYER - 1) { *(GAS f32x4*)(xo + (size_t)row * DM + col) = (f32x4){o[0], o[1], o[2], o[3]}; *(GAS f32x4*)(xo + (size_t)row * DM + col + 4) = (f32x4){o[4], o[5], o[6], o[7]}; }
            else { u32x4 w; w.x = cvt_pk_bf16(o[0], o[1]); w.y = cvt_pk_bf16(o[2], o[3]); w.z = cvt_pk_bf16(o[4], o[5]); w.w = cvt_pk_bf16(o[6], o[7]); *(GAS u32x4*)(xb + ro + 256 * i) = w; }
            asm volatile("" ::: "memory"); }
    }
}

DI int moe_table(const Ctx& F, int l) {
    unsigned char* const wsl = F.ws; float* const outl = F.out; (void)outl;
    LAS int* tb = (LAS int*)(F.lds + LDS_CTL_OFF) + 16;
    const unsigned* cnt = (const unsigned*)(wsl + WS_CTL) + CW_CNT + l * 32 * 64;
    __syncthreads();
    if (F.wave == 0) {
        const int e = F.lane; int nt = 0;
        if (e < NEXP) { const int n = (int)__hip_atomic_load(cnt + e * 64, __ATOMIC_RELAXED, __HIP_MEMORY_SCOPE_AGENT); nt = (n + 255) >> 8; }
        int incl = nt;
#pragma unroll
        for (int d = 1; d < 32; d <<= 1) { const int v = __shfl_up(incl, d); if (e >= d) incl += v; }
        if (e < NEXP) tb[e] = incl - nt;
        if (e == NEXP - 1) tb[NEXP] = incl;
    }
    __syncthreads();
    return tb[NEXP];
}


#ifdef MK_DEBUG
constexpr int CW_DBG = 40960;
DI void dbg_count_bf16(const Ctx& F, const bf16_t* p, size_t n, int k) {
    unsigned bad = 0; const size_t gt = (size_t)F.bid * NT + F.tid, ngt = (size_t)F.G * NT;
    for (size_t i = gt; i < n; i += ngt) { const unsigned b = p[i]; const float v = bf2f(b); if ((b & 0x7f80u) == 0x7f80u || fabsf(v) > 1.0e6f) ++bad; }
    if (bad) atomicAdd((unsigned*)(F.ws + WS_CTL) + CW_DBG + k * 64, bad);
}
DI void dbg_count_f32(const Ctx& F, const float* p, size_t n, int k) {
    unsigned bad = 0; const size_t gt = (size_t)F.bid * NT + F.tid, ngt = (size_t)F.G * NT;
    for (size_t i = gt; i < n; i += ngt) { const float v = p[i]; if (!(fabsf(v) <= 1.0e6f)) ++bad; }
    if (bad) atomicAdd((unsigned*)(F.ws + WS_CTL) + CW_DBG + k * 64, bad);
}
#endif
constexpr int PH_PER_LAYER = 11, N_PHASES = 1 + NLAYER * PH_PER_LAYER;

__global__ void __launch_bounds__(NT, 2) mega_fwd(Params P) {
    extern __shared__ __attribute__((aligned(16))) unsigned char lds_raw[];
    Ctx F0;
    F0.lds = (LAS unsigned char*)lds_raw;
    F0.tid = threadIdx.x; F0.lane = F0.tid & 63; F0.wave = __builtin_amdgcn_readfirstlane(F0.tid >> 6);
    F0.G = gridDim.x; F0.bid = blockIdx.x; F0.gw = F0.bid * NWAVES + F0.wave; F0.ngw = F0.G * NWAVES;
    F0.ws = P.ws; F0.out = P.out;
    for (int u = F0.tid; u < (LDS_BYTES - LDS_CTL_OFF) / 4; u += NT) ((LAS unsigned*)(F0.lds + LDS_CTL_OFF))[u] = 0u;
    __syncthreads();
    XcdBarrier bar; bar.bar = (unsigned*)(F0.ws + WS_CTL) + CW_BAR; bar.x = 0; bar.st = nullptr;
#if !MK_PER_PHASE
    bar = xcd_barrier_post((unsigned*)(F0.ws + WS_CTL) + CW_BAR, (volatile LAS unsigned*)(F0.lds + LDS_CTL_OFF));
#endif
    const int lo = P.ph_lo, hi = P.ph_hi;
#define IN(k) (lo <= (k) && (k) < hi)
#if MK_PER_PHASE
#define SEAM(k) do { } while (0)
#else
#define SEAM(k) do { if ((k) + 1 < hi) { XcdBarrier _b = bar; asm volatile("" : "+s"(_b.bar), "+s"(_b.x)); xcd_barrier(_b); } } while (0)
#endif
#define WSL const Ctx F = relaunder(F0); unsigned char* const ws = F.ws; bf16_t* const xb = (bf16_t*)(ws + WS_XB); bf16_t* const zb = (bf16_t*)(ws + WS_Z); bf16_t* const cat = (bf16_t*)(ws + WS_CAT); (void)xb; (void)zb; (void)cat

    if (IN(0)) { WSL; phase_prologue(F, P); SEAM(0); }

    for (int l = 0; l < NLAYER; ++l) {
        const int kind = l % 3, j = l / 3, pb = 1 + l * PH_PER_LAYER;
        const int zw = (kind == 0) ? ZW_RWKV : ZW_OTH, qcol = (kind == 0) ? 5056 : 4608;
        if (IN(pb + 0)) {
            WSL; const bf16_t* winT = (const bf16_t*)(ws + WS_WIN + (size_t)l * WIN_STRIDE);
            if (kind != 2) dense_gemm(F, xb, DM, winT, DM, NTOK, zw, DM, zb, zw, 0);
            else {
                dense_gemm(F, xb, DM, winT, DM, NTOK, 3072, DM, zb, zw, 0);
                dense_gemm(F, xb, DM, winT + (size_t)4608 * DM, DM, NTOK, 512, DM, zb + 4608, zw, 0);
                dense_gemm(F, winT + (size_t)3072 * DM, DM, xb, DM, CMIX, NTOK, DM, (bf16_t*)(ws + WS_ACT), NTOK, 128);
            }
            if (l == 0) {
                dense_gemm(F, (const bf16_t*)(ws + WS_MEMB), DM, (const bf16_t*)(ws + WS_WK), DM, NBATCH * MEML, 2048, DM, (bf16_t*)(ws + WS_KM), 2048, 128);
                dense_gemm(F, (const bf16_t*)(ws + WS_WV), DM, (const bf16_t*)(ws + WS_MEMB), DM, 2048, NBATCH * MEML, DM, (bf16_t*)(ws + WS_VMT), 1024, 192);
            }
            SEAM(pb + 0);
        }
        if (IN(pb + 1)) {
            WSL;
            if (kind == 0) { for (int rep = 0; rep < REP_PREP; ++rep) rwkv_prep1(F, P, j, zb); for (int rep = 0; rep < REP_MIX * REP_MA; ++rep) memattn_all(F, l, zb, zw, qcol); }
            else if (kind == 1) { for (int rep = 0; rep < REP_MIX; ++rep) conv_mix(F, P, zb); for (int rep = 0; rep < REP_MIX * REP_MA; ++rep) memattn_all(F, l, zb, zw, qcol); for (int rep = 0; rep < REP_CONV; ++rep) expert_convert(F, P, l, F.gw, F.ngw); }
            else { for (int rep = 0; rep < REP_MIX * REP_SB; ++rep) sb_attention(F, zb); for (int rep = 0; rep < REP_MIX * REP_MA; ++rep) memattn_all(F, l, zb, zw, qcol); for (int rep = 0; rep < REP_CONV; ++rep) expert_convert(F, P, l, F.gw, F.ngw); }
            SEAM(pb + 1);
        }
        if (kind == 0) {
            if (IN(pb + 2)) {
                WSL; const bf16_t* act = (const bf16_t*)(ws + WS_ACT); const bf16_t* wa = (const bf16_t*)(ws + WS_LORA + (size_t)j * LORA_STRIDE);
                dense_gemm(F, act, 512, wa, 256, NTOK, 3072, 256, (bf16_t*)(ws + WS_LW), 3072, 0);
                dense_gemm(F, act + 256, 512, wa + (size_t)3072 * 256, 256, NTOK, CMIX, 256, (bf16_t*)(ws + WS_GATE), CMIX, 0);
                SEAM(pb + 2);
            }
            if (IN(pb + 3)) { WSL; const RwPar Q{PIN(17) + (size_t)j * 5056, PIN(18) + j * CMIX, PIN(20) + j * CMIX, PIN(23) + j * CMIX, PIN(24) + j * CMIX, PIN(25) + j * CMIX, PIN(26) + j * CMIX, PIN(27) + j * CMIX};
                for (int rep = 0; rep < REP_SCAN; ++rep) scan_w1(F, Q, zb); SEAM(pb + 3); }
            if (IN(pb + 4)) {
                WSL;
                if (F.bid < 96) scan_passB(F);
                else expert_convert(F, P, l, (F.bid - 96) * NWAVES + F.wave, (F.G - 96) * NWAVES);
                SEAM(pb + 4);
            }
            if (IN(pb + 5)) { WSL; const RwPar Q{PIN(17) + (size_t)j * 5056, PIN(18) + j * CMIX, PIN(20) + j * CMIX, PIN(23) + j * CMIX, PIN(24) + j * CMIX, PIN(25) + j * CMIX, PIN(26) + j * CMIX, PIN(27) + j * CMIX};
                for (int rep = 0; rep < REP_SCAN * REP_W2; ++rep) scan_w2(F, Q); SEAM(pb + 5); }
        }
        if (IN(pb + 6)) { WSL; dense_gemm(F, cat, DM, (const bf16_t*)(ws + WS_WOUT) + (size_t)l * DM * DM, DM, NTOK, DM, DM, (bf16_t*)(ws + WS_HB), DM, 0); SEAM(pb + 6); }
        if (IN(pb + 7)) { WSL; ln1_router(F, P, l, l == 0 ? PIN(0) : (const float*)P.out); SEAM(pb + 7); }
        if (IN(pb + 8)) {
            WSL; const int ntiles = moe_table(F, l);
            pg8::Gemm g{xb, (const bf16_t*)(ws + WS_EXP1), DM, DM, DM};
            pg8::MoeOrder<true> S; S.G = F.G; S.c = F.bid; S.npn = 4; S.total = ntiles * 4; S.tb = (const LAS int*)(F.lds + LDS_CTL_OFF) + 16; S.estride = (size_t)1024 * DM * 2;
            S.ltok = (const int*)(ws + WS_LTOK); S.cnt = (const unsigned*)(ws + WS_CTL) + CW_CNT + l * 32 * 64;
            pg8::EpiSwiGLU E{(bf16_t*)(ws + WS_HE)};
            for (int rep = 0; rep < REP_MOE; ++rep) pg8::gemm_phase<pg8::EpiSwiGLU, pg8::MoeOrder<true>>(F.lds, g, S, E);
            SEAM(pb + 8);
        }
        if (IN(pb + 9)) {
            WSL; const int ntiles = moe_table(F, l);
            pg8::Gemm g{(const bf16_t*)(ws + WS_HE), (const bf16_t*)(ws + WS_EXP2), DEXP, DEXP, DEXP};
            pg8::MoeOrder<false> S; S.G = F.G; S.c = F.bid; S.npn = 8; S.total = ntiles * 8; S.tb = (const LAS int*)(F.lds + LDS_CTL_OFF) + 16; S.estride = (size_t)DM * DEXP * 2;
            S.ltok = (const int*)(ws + WS_LTOK); S.cnt = (const unsigned*)(ws + WS_CTL) + CW_CNT + l * 32 * 64;
            pg8::EpiScatter E{(bf16_t*)(ws + WS_YS), (const int*)(ws + WS_LSLOT), (const float*)(ws + WS_LGATE), S.cnt};
            for (int rep = 0; rep < REP_MOE; ++rep) pg8::gemm_phase<pg8::EpiScatter, pg8::MoeOrder<false>>(F.lds, g, S, E);
            SEAM(pb + 9);
        }
        if (IN(pb + 10)) { WSL; ln2_phase(F, P, l); SEAM(pb + 10); }
    }
#ifdef MK_DEBUG
    {
        WSL;
        xcd_barrier(bar);
        dbg_count_bf16(F, (const bf16_t*)(ws + WS_CAT), (size_t)NTOK * DM, 0);
        dbg_count_bf16(F, (const bf16_t*)(ws + WS_HB), (size_t)NTOK * DM, 1);
        dbg_count_f32(F, (const float*)(ws + WS_LGATE), (size_t)32 * 16384, 2);
        dbg_count_bf16(F, (const bf16_t*)(ws + WS_YS), (size_t)32768 * 2048, 3);
        dbg_count_f32(F, (const float*)F.out, (size_t)NTOK * DM, 4);
        dbg_count_bf16(F, (const bf16_t*)(ws + WS_XB), (size_t)NTOK * DM, 5);
        xcd_barrier(bar);
        int first = 13;
        for (int k = 12; k >= 0; --k) if (__hip_atomic_load((unsigned*)(ws + WS_CTL) + CW_DBG + k * 64, __ATOMIC_RELAXED, __HIP_MEMORY_SCOPE_AGENT) != 0u) first = k;
        const float val = 1000.f * (float)(first + 1);
        for (size_t i = (size_t)F.bid * NT + F.tid; i < (size_t)NTOK * DM; i += (size_t)F.G * NT) F.out[i] = val;
    }
#endif
#undef IN
#undef SEAM
}

extern "C" void kernel_launch(void* const* d_in, const int* in_sizes, int n_in, void* d_out, int out_size, void* d_ws, size_t ws_size, hipStream_t stream) {
    static int grid = 0;
    if (grid == 0) {
        if (n_in != 31 || ws_size < WS_END) { fprintf(stderr, "kernel_launch: expected 31 inputs and >= %zu bytes of workspace, got %d / %zu\n", (size_t)WS_END, n_in, ws_size); grid = -1; return; }
        int dev = 0, cus = 0, per_cu = 0;
        if (hipGetDevice(&dev) != hipSuccess || hipDeviceGetAttribute(&cus, hipDeviceAttributeMultiprocessorCount, dev) != hipSuccess) { grid = -1; return; }
        if (hipFuncSetAttribute((const void*)mega_fwd, hipFuncAttributeMaxDynamicSharedMemorySize, LDS_BYTES) != hipSuccess) { fprintf(stderr, "kernel_launch: hipFuncSetAttribute failed\n"); grid = -1; return; }
        if (hipOccupancyMaxActiveBlocksPerMultiprocessor(&per_cu, (const void*)mega_fwd, NT, LDS_BYTES) != hipSuccess || per_cu < 1)
            fprintf(stderr, "kernel_launch: occupancy query reports %d workgroups per CU\n", per_cu);
        (void)hipGetLastError();
        grid = cus;
    }
    if (grid < 0) return;
    (void)hipMemsetAsync((char*)d_ws + WS_CTL, 0, CTL_BYTES, stream);
    Params p{};
    for (int i = 0; i < 31; ++i) p.in[i] = (const float*)d_in[i];
    p.out = (float*)d_out; p.ws = (unsigned char*)d_ws;
#if MK_PER_PHASE
    for (int ph = 0; ph < N_PHASES; ++ph) {
        if (ph > 0) { const int l = (ph - 1) / PH_PER_LAYER, loc = (ph - 1) % PH_PER_LAYER; if ((l % 3) != 0 && loc >= 2 && loc <= 5) continue; }
        p.ph_lo = ph; p.ph_hi = ph + 1;
        hipLaunchKernelGGL(mega_fwd, dim3(grid), dim3(NT), LDS_BYTES, stream, p);
    }
#else
#ifndef MK_PH_HI
#define MK_PH_HI N_PHASES
#endif
    p.ph_lo = 0; p.ph_hi = MK_PH_HI;
    hipLaunchKernelGGL(mega_fwd, dim3(grid), dim3(NT), LDS_BYTES, stream, p);
#endif
    const hipError_t le = hipPeekAtLastError();
    if (le != hipSuccess) fprintf(stderr, "kernel_launch: launch failed: %s\n", hipGetErrorName(le));
}
```

```cpp
#include <hip/hip_runtime.h>
#include <cstdio>
#include <cstdint>

#ifndef MK_PER_PHASE
#define MK_PER_PHASE 0
#endif
#ifndef MK_PH_HI
#define MK_PH_HI N_PHASES
#endif
#ifndef REP_GEMM
#define REP_GEMM 1
#endif
#ifndef REP_MOE
#define REP_MOE 1
#endif
#ifndef REP_SCAN
#define REP_SCAN 1
#endif
#ifndef REP_PREP
#define REP_PREP 1
#endif
#ifndef REP_MIX
#define REP_MIX 1
#endif
#ifndef REP_CONV
#define REP_CONV 1
#endif
#ifndef REP_SB
#define REP_SB 1
#endif
#ifndef REP_MA
#define REP_MA 1
#endif
#ifndef REP_WX
#define REP_WX 1
#endif
#ifndef REP_WS
#define REP_WS 1
#endif
#ifndef REP_WO
#define REP_WO 1
#endif
#ifndef REP_W2
#define REP_W2 1
#endif

#define LAS __attribute__((address_space(3)))
#define GAS __attribute__((address_space(1)))
#define DI __device__ __forceinline__
typedef unsigned short bf16_t;
typedef short bf16x8 __attribute__((ext_vector_type(8)));
typedef short s16x4 __attribute__((ext_vector_type(4)));
typedef float f32x2 __attribute__((ext_vector_type(2)));
typedef float f32x4 __attribute__((ext_vector_type(4)));
typedef float f32x8 __attribute__((ext_vector_type(8)));
typedef float f32x16 __attribute__((ext_vector_type(16)));
typedef unsigned u32x2 __attribute__((ext_vector_type(2)));
typedef unsigned u32x4 __attribute__((ext_vector_type(4)));

constexpr int NTOK = 16384, DM = 2048, SEQ = 4096, NBATCH = 4, CMIX = 1536, MEMW = 512, MEML = 256, NLAYER = 4;
constexpr int ZW_RWKV = 5632  , ZW_OTH = 5120, RW_IN_COLS = 5568;
constexpr int NEXP = 32, DEXP = 512, LISTCAP = 16384, MAXTILES = 160;
constexpr float LN_EPS = 1e-5f, ALPHA = 1.681792830507429f, GN_EPS = 64e-5f;
constexpr int NT = 512, NWAVES = 8;

constexpr size_t MiB = (size_t)1 << 20;
constexpr size_t WS_CTL = 0, CTL_BYTES = 1 * MiB;
constexpr size_t WS_WIN = 2 * MiB;
constexpr size_t WIN_STRIDE = 22 * MiB;
constexpr size_t WS_WOUT = 90 * MiB;
constexpr size_t WS_WK = 122 * MiB;
constexpr size_t WS_WV = 130 * MiB;
constexpr size_t WS_MEMB = 138 * MiB;
constexpr size_t WS_KM = 142 * MiB;
constexpr size_t WS_VMT = 146 * MiB;
constexpr size_t WS_LORA = 150 * MiB;
constexpr size_t LORA_STRIDE = 3 * MiB;
constexpr size_t WS_WSW = 156 * MiB;
constexpr size_t WSW_STRIDE = 393216;
constexpr size_t WS_EXP1 = 160 * MiB;
constexpr size_t WS_EXP2 = 288 * MiB;
constexpr size_t WS_XB = 352 * MiB;
constexpr size_t WS_Z = 416 * MiB;
constexpr size_t WS_CAT = 592 * MiB;
constexpr size_t WS_HB = 656 * MiB;
constexpr size_t WS_LTOK = 720 * MiB;
constexpr size_t WS_LGATE = 722 * MiB;
constexpr size_t WS_LSLOT = 724 * MiB;
constexpr size_t WS_HE = 728 * MiB;
constexpr size_t WS_YS = 768 * MiB;
constexpr size_t WS_ACT = 896 * MiB;
constexpr size_t WS_LW = 944 * MiB;
constexpr size_t WS_GATE = 1040 * MiB;
constexpr size_t WS_SCAN = 1088 * MiB;
constexpr size_t WS_V = 1568 * MiB;
constexpr size_t WS_Y = 1664 * MiB;
constexpr size_t WS_GH = 1760 * MiB;
constexpr size_t WS_QY = 1088 * MiB;
constexpr size_t WS_Y0T = 1152 * MiB;
constexpr size_t WS_E = 1280 * MiB;
constexpr size_t WS_END = 1952 * MiB;
constexpr int CW_BAR = 4096;
constexpr int CW_CNT = 16384;

constexpr int LDS_BYTES = 147456;
constexpr int LDS_CTL_OFF = 146432;

DI float bf2f(unsigned b) { return __uint_as_float(b << 16); }
typedef float cvt_f32x2 __attribute__((ext_vector_type(2)));
typedef __bf16 cvt_bf16x2 __attribute__((ext_vector_type(2)));
DI unsigned cvt_pk_bf16(float lo, float hi) { const cvt_f32x2 v = {lo, hi}; return __builtin_bit_cast(unsigned, __builtin_convertvector(v, cvt_bf16x2)); }
DI float bflo(unsigned w) { return __uint_as_float(w << 16); }
DI float bfhi(unsigned w) { return __uint_as_float(w & 0xffff0000u); }
DI float wave_sum(float v) {
#pragma unroll
    for (int o = 1; o < 64; o <<= 1) v += __shfl_xor(v, o);
    return v;
}
DI float sum16(float v) {
    v += __builtin_bit_cast(float, __builtin_amdgcn_update_dpp(0, __builtin_bit_cast(int, v), 0x128, 0xf, 0xf, false));
    v += __builtin_bit_cast(float, __builtin_amdgcn_update_dpp(0, __builtin_bit_cast(int, v), 0x124, 0xf, 0xf, false));
    v += __builtin_bit_cast(float, __builtin_amdgcn_update_dpp(0, __builtin_bit_cast(int, v), 0x122, 0xf, 0xf, false));
    v += __builtin_bit_cast(float, __builtin_amdgcn_update_dpp(0, __builtin_bit_cast(int, v), 0x121, 0xf, 0xf, false));
    return v;
}
DI float fma_s(float a, float b, float c) { float d; asm("v_fma_f32 %0, %1, %2, %3" : "=v"(d) : "v"(a), "v"(b), "v"(c)); return d; }
DI float sigmoidf_(float x) { return __builtin_amdgcn_rcpf(1.f + __expf(-x)); }
DI float softplusf_(float x) { return fmaxf(x, 0.f) + __logf(1.f + __expf(-fabsf(x))); }
#define LDS_WAIT() asm volatile("s_waitcnt lgkmcnt(0)" ::: "memory")
#define VM_WAIT() asm volatile("s_waitcnt vmcnt(0)" ::: "memory")
#define LDS_BARRIER() do { asm volatile("s_waitcnt lgkmcnt(0)" ::: "memory"); __builtin_amdgcn_s_barrier(); asm volatile("" ::: "memory"); } while (0)

template <class T> DI T* as_global(T* p) { return p; }
constexpr int LDS_KARG_OFF = LDS_CTL_OFF + 512;
DI const float* kin_ptr(int i) { extern __shared__ __attribute__((aligned(16))) unsigned char lds_raw[]; int off = LDS_KARG_OFF + i * 8; asm volatile("" : "+v"(off));
    const unsigned long long p = *(const LAS unsigned long long*)((LAS unsigned char*)lds_raw + off);
    const unsigned lo = __builtin_amdgcn_readfirstlane((unsigned)p), hi = __builtin_amdgcn_readfirstlane((unsigned)(p >> 32));
    return as_global((const float*)(((unsigned long long)hi << 32) | lo)); }
#define PIN(i) kin_ptr(i)
DI unsigned char* opq(unsigned char* p) { asm volatile("" : "+s"(p)); return p; }
DI float* opqf(float* p) { asm volatile("" : "+s"(p)); return p; }

#define XB_TMO      128
#define XB_XCNT(j)  (256  + 64 * (j))
#define XB_XSUB(j)  (1280 + 64 * (j))
#define XB_XGEN(j)  (2304 + 64 * (j))
#define XB_TOP      3328
#define XB_TOPGEN   3392
#define XCD_BAR_WORDS 3456
#define XB_SPIN_CAP (1u << 20)

__device__ __forceinline__ unsigned xb_ld(unsigned* p)              { return __hip_atomic_load(p, __ATOMIC_RELAXED, __HIP_MEMORY_SCOPE_AGENT); }
__device__ __forceinline__ unsigned xb_add(unsigned* p, unsigned v) { return __hip_atomic_fetch_add(p, v, __ATOMIC_RELAXED, __HIP_MEMORY_SCOPE_AGENT); }
__device__ __forceinline__ unsigned xb_xcc_id() { return (unsigned)__builtin_amdgcn_s_getreg((3 << 11) | 20) & 0xFu; }
#define XB_SPIN(cond, bar) do { unsigned _sp = 0; while (cond) { __builtin_amdgcn_s_sleep(1); \
    if ((++_sp & 255u) == 0u) { if (xb_ld(&(bar)[XB_TMO])) break; if (_sp > XB_SPIN_CAP) { atomicAdd(&(bar)[XB_TMO], 1u); break; } } } } while (0)

struct XcdBarrier { unsigned* bar; unsigned x; volatile LAS unsigned* st; };

__device__ __forceinline__ XcdBarrier xcd_barrier_post(unsigned* bar, volatile LAS unsigned* st) {
    XcdBarrier b; b.bar = bar; b.x = xb_xcc_id(); b.st = st;
    if (threadIdx.x == 0) (void)xb_add(&bar[XB_XCNT(b.x)], 1u);
    return b;
}
__device__ __forceinline__ void xcd_barrier_complete(unsigned* bar, unsigned x, unsigned& nloc, unsigned& nx) {
    const unsigned G = gridDim.x * gridDim.y * gridDim.z;
    unsigned sum, cnt, mine, sp = 0u;
    for (;;) {
        sum = 0u; cnt = 0u; mine = 0u;
#pragma unroll
        for (unsigned j = 0; j < 16; ++j) { const unsigned c = xb_ld(&bar[XB_XCNT(j)]); sum += c; cnt += (c > 0u) ? 1u : 0u; mine = (j == x) ? c : mine; }
        if (sum == G) break;
        __builtin_amdgcn_s_sleep(1);
        if ((++sp & 255u) == 0u) { if (xb_ld(&bar[XB_TMO])) break; if (sp > XB_SPIN_CAP) { atomicAdd(&bar[XB_TMO], 1u); break; } }
    }
    nloc = mine > 0u ? mine : 1u; nx = cnt > 0u ? cnt : 1u;
}
__device__ __forceinline__ void xcd_barrier(const XcdBarrier& b) {
    asm volatile("s_waitcnt vmcnt(0)" ::: "memory");
    __syncthreads();
    if (threadIdx.x == 0) {
        unsigned* bar = b.bar;
        __builtin_amdgcn_s_waitcnt(0);
        unsigned nloc = b.st[0], nx = b.st[1];
        if (nloc == 0u) { xcd_barrier_complete(bar, b.x, nloc, nx); b.st[0] = nloc; b.st[1] = nx; }
        const unsigned old = xb_add(&bar[XB_XSUB(b.x)], 1u);
        const unsigned gen = old / nloc;
        if (old + 1u == (gen + 1u) * nloc) {
            __builtin_amdgcn_fence(__ATOMIC_RELEASE, "agent");
            asm volatile("s_waitcnt vmcnt(0)" ::: "memory");
            const unsigned og = xb_add(&bar[XB_TOP], 1u);
            const unsigned tg = og / nx;
            if (og + 1u == (tg + 1u) * nx) xb_add(&bar[XB_TOPGEN], 1u);
            else XB_SPIN(xb_ld(&bar[XB_TOPGEN]) == tg, bar);
            __builtin_amdgcn_fence(__ATOMIC_ACQUIRE, "agent");
            xb_add(&bar[XB_XGEN(b.x)], 1u);
            asm volatile("s_waitcnt vmcnt(0)" ::: "memory");
        } else {
            XB_SPIN(xb_ld(&bar[XB_XGEN(b.x)]) == gen, bar);
            __builtin_amdgcn_fence(__ATOMIC_ACQUIRE, "agent");
            asm volatile("s_waitcnt vmcnt(0)" ::: "memory");
        }
    }
    __syncthreads();
}

namespace pg8 {
constexpr int BM = 256, BK = 64, HALF = 128, HTB = HALF * BK * 2, STAGE_BYTES = 8 * HTB, NXCD = 8, WGM = 8;
DI int lds_byte(int r, int c) { const int st = (r >> 4) * 2 + (c >> 5), rr = r & 15, cc = c & 31, ob = rr * 64 + cc * 2; return st * 1024 + (ob ^ (((ob >> 9) & 1) << 5)); }
DI void stage_rc(int b, int& R, int& C) { const int st = b / 1024, sb = b % 1024, swz = sb ^ (((sb >> 9) & 1) << 5); R = (st >> 1) * 16 + swz / 64; C = (st & 1) * 32 + (swz % 64) / 2; }
DI int perm32(int rho) { const int n = rho >> 4, i = rho & 15; return 8 * (i >> 2) + 4 * n + (i & 3); }

struct Unit { int pm, pn, e, rt; };
struct Gemm { const bf16_t* A; const bf16_t* Bt; int lda, ldb, K; };

struct StaticOrder {
    static constexpr bool GATHER = false;
    int nM, nN, nwg, G, c;
    DI void init(int M, int N, int G_, int c_) { nM = M / BM; nN = N / BM; nwg = nM * nN; G = G_; c = c_; }
    DI bool next(int i, Unit& u) const {
        const long L = (long)i * G + c; if (L >= nwg) return false;
        int wgid = (int)L; { const int q = nwg / NXCD, r = nwg % NXCD, xcd = wgid % NXCD, off = wgid / NXCD; wgid = (xcd < r ? xcd * (q + 1) : r * (q + 1) + (xcd - r) * q) + off; }
        const int nig = WGM * nN, gid = wgid / nig, fm = gid * WGM, gsz = (nM - fm) < WGM ? (nM - fm) : WGM;
        u.pm = fm + ((wgid % nig) % gsz); u.pn = (wgid % nig) / gsz; u.e = 0; u.rt = 0; return true;
    }
    DI const char* a_base(const Gemm& g, const Unit& u) const { return (const char*)g.A + (size_t)u.pm * BM * g.lda * 2; }
    DI const char* b_base(const Gemm& g, const Unit& u) const { return (const char*)g.Bt + (size_t)u.pn * BM * g.ldb * 2; }
    DI unsigned gather_voff(const Unit&, int, int, int) const { return 0u; }
};

template <bool GATH> struct MoeOrder {
    static constexpr bool GATHER = GATH;
    int G, c, npn, total; const LAS int* tb; size_t estride; const int* ltok; const unsigned* cnt;
    DI bool next(int i, Unit& u) const {
        if ((G & 7) == 0) {
            const int x = c & 7, r = c >> 3, W = G >> 3, idx = i * W + r;
            const int q = idx / npn, pn = idx - q * npn; int base = 0;
#pragma unroll
            for (int k = 0; k < 4; ++k) { const int e = x + 8 * k, nt = tb[e + 1] - tb[e];
                if (q < base + nt) { u.e = e; u.rt = q - base; u.pm = tb[e] + u.rt; u.pn = pn; return true; }
                base += nt; }
            return false;
        }
        const int L = i * G + c; if (L >= total) return false;
        const int q = L / npn; u.pn = L - q * npn; u.pm = q;
        int e = 0; while (e < NEXP - 1 && tb[e + 1] <= q) ++e;
        u.e = e; u.rt = q - tb[e]; return true;
    }
    DI const char* a_base(const Gemm& g, const Unit& u) const { return (const char*)g.A + (size_t)u.pm * BM * g.lda * 2; }
    DI const char* b_base(const Gemm& g, const Unit& u) const { return (const char*)g.Bt + (size_t)u.e * estride + (size_t)u.pn * BM * g.ldb * 2; }
    DI unsigned gather_voff(const Unit& u, int r, int C, int lda) const {
        const int pos = u.rt * BM + r; const int n = (int)__hip_atomic_load(cnt + u.e * 64, __ATOMIC_RELAXED, __HIP_MEMORY_SCOPE_AGENT);
        const int tokl = *(const GAS int*)(ltok + u.e * LISTCAP + pos);
        const int tok = pos < n ? tokl : 0;
        return (unsigned)(tok * lda + C) * 2u;
    }
};

struct EpiStore {
    bf16_t* O; int ldc;
    DI void operator()(const f32x4 (&acc)[2][2][4][2], const Unit& u, int wr, int wc, int fr, int fq) const {
        const int row0 = u.pm * BM + wr * 64 + fr, col0 = u.pn * BM + wc * 32 + 8 * fq;
#pragma unroll
        for (int ai = 0; ai < 2; ++ai)
#pragma unroll
            for (int m = 0; m < 4; ++m) { bf16_t* rowp = O + (size_t)(row0 + ai * HALF + m * 16) * ldc + col0;
#pragma unroll
                for (int bj = 0; bj < 2; ++bj) { const f32x4 v0 = acc[ai][bj][m][0], v1 = acc[ai][bj][m][1];
                    u32x4 w; w.x = cvt_pk_bf16(v0[0], v0[1]); w.y = cvt_pk_bf16(v0[2], v0[3]); w.z = cvt_pk_bf16(v1[0], v1[1]); w.w = cvt_pk_bf16(v1[2], v1[3]);
                    *(GAS u32x4*)(rowp + bj * HALF) = w; } }
    }
};
struct EpiSwiGLU {
    bf16_t* H;
    DI void operator()(const f32x4 (&acc)[2][2][4][2], const Unit& u, int wr, int wc, int fr, int fq) const {
        const int row0 = u.pm * BM + wr * 64 + fr, col0 = u.pn * HALF + wc * 32 + 8 * fq;
#pragma unroll
        for (int ai = 0; ai < 2; ++ai)
#pragma unroll
            for (int m = 0; m < 4; ++m) { bf16_t* rowp = H + (size_t)(row0 + ai * HALF + m * 16) * DEXP + col0;
                float h[8];
#pragma unroll
                for (int n = 0; n < 2; ++n)
#pragma unroll
                    for (int j = 0; j < 4; ++j) { const float gt = acc[ai][0][m][n][j], up = acc[ai][1][m][n][j]; h[n * 4 + j] = gt * __builtin_amdgcn_rcpf(1.f + __expf(-gt)) * up; }
                u32x4 w; w.x = cvt_pk_bf16(h[0], h[1]); w.y = cvt_pk_bf16(h[2], h[3]); w.z = cvt_pk_bf16(h[4], h[5]); w.w = cvt_pk_bf16(h[6], h[7]);
                *(GAS u32x4*)rowp = w; }
    }
};
struct EpiScatter {
    bf16_t* YS; const int* lslot; const float* lgate; const unsigned* cnt;
    DI void operator()(const f32x4 (&acc)[2][2][4][2], const Unit& u, int wr, int wc, int fr, int fq) const {
        const int n = (int)__hip_atomic_load(cnt + u.e * 64, __ATOMIC_RELAXED, __HIP_MEMORY_SCOPE_AGENT);
        const int col0 = u.pn * BM + wc * 32 + 8 * fq;
        int slots[2][4]; float gts[2][4];
#pragma unroll
        for (int ai = 0; ai < 2; ++ai)
#pragma unroll
            for (int m = 0; m < 4; ++m) { int pos = u.rt * BM + ai * HALF + wr * 64 + m * 16 + fr; pos = pos < LISTCAP ? pos : LISTCAP - 1;
                slots[ai][m] = *(const GAS int*)(lslot + u.e * LISTCAP + pos); gts[ai][m] = *(const GAS float*)(lgate + u.e * LISTCAP + pos); }
#pragma unroll
        for (int ai = 0; ai < 2; ++ai)
#pragma unroll
            for (int m = 0; m < 4; ++m) { const int pos = u.rt * BM + ai * HALF + wr * 64 + m * 16 + fr;
                if (pos < n) { const int slot = slots[ai][m]; const float gt = gts[ai][m];
                    bf16_t* rowp = YS + (size_t)slot * DM + col0;
#pragma unroll
                    for (int bj = 0; bj < 2; ++bj) { const f32x4 v0 = acc[ai][bj][m][0] * gt, v1 = acc[ai][bj][m][1] * gt;
                        u32x4 w; w.x = cvt_pk_bf16(v0[0], v0[1]); w.y = cvt_pk_bf16(v0[2], v0[3]); w.z = cvt_pk_bf16(v1[0], v1[1]); w.w = cvt_pk_bf16(v1[2], v1[3]);
                        *(GAS u32x4*)(rowp + bj * HALF) = w; } } }
    }
};

template <class Epi, class Sched>
DI void gemm_phase(LAS unsigned char* lds, const Gemm g, const Sched& S, const Epi& E) {
    int tid = threadIdx.x; asm volatile("" : "+v"(tid));
    const int wid = __builtin_amdgcn_readfirstlane(tid >> 6), lane = tid & 63, wr = wid >> 2, wc = wid & 3, fr = lane & 15, fq = lane >> 4;
    const int K = g.K, nt = K / BK;
    unsigned voffA[2], voffB[2];
#pragma unroll
    for (int i = 0; i < 2; ++i) { int R, C; stage_rc(tid * 16 + i * 8192, R, C); const int Rb = (R & ~31) + perm32(R & 31);
        voffA[i] = (unsigned)(R * g.lda + C) * 2u; voffB[i] = (unsigned)(Rb * g.ldb + C) * 2u; }
    const size_t kstep = (size_t)(BK * 2);
    const size_t hstepA = (size_t)HALF * g.lda * 2, hstepB = (size_t)HALF * g.ldb * 2;
    const unsigned ldsw = (unsigned)wid * 1024u;
    const int aoff = lds_byte(wr * 64 + fr, fq * 8), boff = lds_byte(wc * 32 + fr, fq * 8);
    unsigned gvC[2][2], gvN[2][2];
#define PG8_SA(b, h) (((b) * 2 + (h)) * HTB)
#define PG8_SB(b, h) ((4 + (b) * 2 + (h)) * HTB)
#define PG8_STAGE(bufoff, gbase, voff) do { _Pragma("unroll") for (int _i = 0; _i < 2; ++_i) \
        __builtin_amdgcn_global_load_lds((const unsigned*)((const char*)(gbase) + (voff)[_i]), (LAS unsigned*)(lds + (bufoff) + ldsw + _i * 8192), 16, 0, 0); } while (0)
#define PG8_STAGE_A(bufoff, h, nxtsel, kt) do { \
        if constexpr (Sched::GATHER) { const char* _gb = (const char*)g.A + (size_t)(kt) * kstep; unsigned _vo[2]; _vo[0] = (nxtsel) ? gvN[h][0] : gvC[h][0]; _vo[1] = (nxtsel) ? gvN[h][1] : gvC[h][1]; PG8_STAGE(bufoff, _gb, _vo); } \
        else { const char* _gb = ((nxtsel) ? nA : cA) + (size_t)(h) * hstepA + (size_t)(kt) * kstep; PG8_STAGE(bufoff, _gb, voffA); } } while (0)
#define PG8_GSETUP(dst, u) do { if constexpr (Sched::GATHER) { _Pragma("unroll") for (int _h = 0; _h < 2; ++_h) _Pragma("unroll") for (int _i = 0; _i < 2; ++_i) { int _R, _C; stage_rc(tid * 16 + _i * 8192, _R, _C); \
        dst[_h][_i] = S.gather_voff(u, _h * HALF + _R, _C, g.lda); } asm volatile("s_waitcnt vmcnt(0)" : "+v"(dst[0][0]), "+v"(dst[0][1]), "+v"(dst[1][0]), "+v"(dst[1][1]) :: "memory"); } } while (0)
#define PG8_LDA(dst, b, h) do { _Pragma("unroll") for (int m = 0; m < 4; ++m) _Pragma("unroll") for (int k = 0; k < 2; ++k) dst[m][k] = *(const LAS bf16x8*)(lds + PG8_SA(b, h) + aoff + m * 2048 + k * 1024); } while (0)
#define PG8_LDB(dst, b, h) do { _Pragma("unroll") for (int n = 0; n < 2; ++n) _Pragma("unroll") for (int k = 0; k < 2; ++k) dst[n][k] = *(const LAS bf16x8*)(lds + PG8_SB(b, h) + boff + n * 2048 + k * 1024); } while (0)
#define PG8_MMA(ai, bj, At, Bt) do { __builtin_amdgcn_s_setprio(1); _Pragma("unroll") for (int m = 0; m < 4; ++m) _Pragma("unroll") for (int n = 0; n < 2; ++n) _Pragma("unroll") for (int k = 0; k < 2; ++k) \
        acc[ai][bj][m][n] = __builtin_amdgcn_mfma_f32_16x16x32_bf16(Bt[n][k], At[m][k], acc[ai][bj][m][n], 0, 0, 0); __builtin_amdgcn_s_setprio(0); } while (0)
#define PG8_WAIT_V(n) asm volatile("s_waitcnt vmcnt(" #n ")" ::: "memory")
#define PG8_WAIT_L(n) asm volatile("s_waitcnt lgkmcnt(" #n ")" ::: "memory")
#define PG8_BAR __builtin_amdgcn_s_barrier()
#define PG8_SCHED __builtin_amdgcn_sched_barrier(0)
    Unit cur, nxt; int ui = 0;
    if (!S.next(0, cur)) return;
    f32x4 acc[2][2][4][2];
#pragma unroll
    for (int a = 0; a < 2; ++a)
#pragma unroll
        for (int b = 0; b < 2; ++b)
#pragma unroll
            for (int m = 0; m < 4; ++m)
#pragma unroll
                for (int n = 0; n < 2; ++n) acc[a][b][m][n] = (f32x4){0.f, 0.f, 0.f, 0.f};
    bf16x8 At[4][2], B0[2][2], B1[2][2];
    const char* cA = S.a_base(g, cur); const char* cB = S.b_base(g, cur);
    const char* nA = cA;
    PG8_GSETUP(gvC, cur);
    PG8_STAGE(PG8_SB(0, 0), cB, voffB); PG8_STAGE_A(PG8_SA(0, 0), 0, false, 0); PG8_STAGE(PG8_SB(0, 1), cB + hstepB, voffB); PG8_STAGE_A(PG8_SA(0, 1), 1, false, 0);
    if (wr == 1) PG8_BAR;
    PG8_WAIT_V(4); PG8_BAR;
    PG8_STAGE(PG8_SB(1, 0), cB + kstep, voffB); PG8_STAGE_A(PG8_SA(1, 0), 0, false, 1); PG8_STAGE(PG8_SB(1, 1), cB + hstepB + kstep, voffB);
    PG8_WAIT_V(6); PG8_BAR;
    for (;;) {
        const bool has_next = S.next(ui + 1, nxt);
        nA = has_next ? S.a_base(g, nxt) : cA; const char* nB = has_next ? S.b_base(g, nxt) : cB;
        if constexpr (Sched::GATHER) { if (has_next) { PG8_GSETUP(gvN, nxt); } else {
#pragma unroll
            for (int _h = 0; _h < 2; ++_h) { gvN[_h][0] = gvC[_h][0]; gvN[_h][1] = gvC[_h][1]; } } }
        for (int t = 0; t < nt; t += 2) {
            const bool last = (t == nt - 2);
            const int kt2 = last ? 0 : t + 2;
            const char* b2 = last ? nB : cB + (size_t)(t + 2) * kstep;
            const char* b3 = b2 + kstep;
            PG8_LDB(B0, 0, 0); PG8_SCHED; PG8_LDA(At, 0, 0); PG8_STAGE_A(PG8_SA(1, 1), 1, false, t + 1);
            PG8_WAIT_L(8); PG8_BAR; PG8_WAIT_L(0); PG8_MMA(0, 0, At, B0); PG8_BAR; PG8_SCHED;
            PG8_LDB(B1, 0, 1); PG8_STAGE(PG8_SB(0, 0), b2, voffB);
            PG8_BAR; PG8_WAIT_L(0); PG8_MMA(0, 1, At, B1); PG8_BAR;
            PG8_LDA(At, 0, 1); PG8_STAGE_A(PG8_SA(0, 0), 0, last, kt2);
            PG8_BAR; PG8_WAIT_L(0); PG8_MMA(1, 0, At, B0); PG8_BAR; PG8_SCHED;
            PG8_STAGE(PG8_SB(0, 1), b2 + hstepB, voffB);
            PG8_WAIT_V(6); PG8_BAR; PG8_MMA(1, 1, At, B1); PG8_BAR;
            PG8_LDB(B0, 1, 0); PG8_SCHED; PG8_LDA(At, 1, 0); PG8_STAGE_A(PG8_SA(0, 1), 1, last, kt2);
            PG8_WAIT_L(8); PG8_BAR; PG8_WAIT_L(0); PG8_MMA(0, 0, At, B0); PG8_BAR; PG8_SCHED;
            PG8_LDB(B1, 1, 1); PG8_STAGE(PG8_SB(1, 0), b3, voffB);
            PG8_BAR; PG8_WAIT_L(0); PG8_MMA(0, 1, At, B1); PG8_BAR;
            PG8_LDA(At, 1, 1); PG8_STAGE_A(PG8_SA(1, 0), 0, last, kt2 + 1);
            PG8_BAR; PG8_WAIT_L(0); PG8_MMA(1, 0, At, B0); PG8_BAR; PG8_SCHED;
            PG8_STAGE(PG8_SB(1, 1), b3 + hstepB, voffB);
            PG8_WAIT_V(6); PG8_BAR; PG8_MMA(1, 1, At, B1); PG8_BAR;
        }
        E(acc, cur, wr, wc, fr, fq);
        if (!has_next) break;
#pragma unroll
        for (int a = 0; a < 2; ++a)
#pragma unroll
            for (int b = 0; b < 2; ++b)
#pragma unroll
                for (int m = 0; m < 4; ++m)
#pragma unroll
                    for (int n = 0; n < 2; ++n) acc[a][b][m][n] = (f32x4){0.f, 0.f, 0.f, 0.f};
        cur = nxt; cA = nA; cB = nB; ++ui;
        if constexpr (Sched::GATHER) {
#pragma unroll
            for (int _h = 0; _h < 2; ++_h) { gvC[_h][0] = gvN[_h][0]; gvC[_h][1] = gvN[_h][1]; } }
    }
    PG8_WAIT_V(0);
    if (wr == 0) PG8_BAR;
    PG8_BAR;
#undef PG8_SA
#undef PG8_SB
#undef PG8_STAGE
#undef PG8_STAGE_A
#undef PG8_GSETUP
#undef PG8_LDA
#undef PG8_LDB
#undef PG8_MMA
#undef PG8_WAIT_V
#undef PG8_WAIT_L
#undef PG8_BAR
#undef PG8_SCHED
}
}

struct Params { const float* in[31]; float* out; unsigned char* ws; int ph_lo, ph_hi; };

struct Ctx {
    LAS unsigned char* lds;
    int tid, lane, wave, G, bid, gw, ngw;
    unsigned char* ws; float* out;
};
DI Ctx relaunder(const Ctx& F0) {
    Ctx F = F0;
    asm volatile("" : "+v"(F.tid), "+v"(F.lane));
    asm volatile("" : "+s"(F.wave), "+s"(F.G), "+s"(F.bid), "+s"(F.gw), "+s"(F.ngw));
    asm volatile("" : "+s"(F.ws), "+s"(F.out));
    F.ws = as_global(F.ws); F.out = as_global(F.out);
    return F;
}

DI void dense_gemm(const Ctx& F, const bf16_t* A, int lda, const bf16_t* Bt, int ldb, int M, int N, int K, bf16_t* O, int ldc, int crot) {
    pg8::Gemm g{A, Bt, lda, ldb, K}; pg8::StaticOrder S; S.init(M, N, F.G, (F.bid + crot) % F.G);
    pg8::EpiStore E{O, ldc};
    for (int rep = 0; rep < REP_GEMM; ++rep) pg8::gemm_phase<pg8::EpiStore, pg8::StaticOrder>(F.lds, g, S, E);
}

struct TJob { const float* src; bf16_t* dst; int ldw, dld; };
DI void tr_load(const TJob& j, f32x4 (&r)[16], int lane) {
    const GAS float* p = (const GAS float*)(j.src + (size_t)(lane >> 4) * j.ldw + 4 * (lane & 15));
#pragma unroll
    for (int i = 0; i < 16; ++i) r[i] = *(const GAS f32x4*)(p + (size_t)(4 * i) * j.ldw);
}
DI void tr_store(const TJob& j, const f32x4 (&r)[16], LAS unsigned char* scr, int lane) {
#pragma unroll
    for (int i = 0; i < 16; ++i) { LAS unsigned* w = (LAS unsigned*)(scr + ((lane >> 4) + 4 * i) * 132 + (lane & 15) * 8); w[0] = cvt_pk_bf16(r[i].x, r[i].y); w[1] = cvt_pk_bf16(r[i].z, r[i].w); }
    LDS_WAIT();
    const int kc = lane & 7;
#pragma unroll
    for (int sgrp = 0; sgrp < 8; ++sgrp) { const int n = 8 * sgrp + (lane >> 3); const LAS unsigned short* c = (const LAS unsigned short*)(scr + (8 * kc) * 132 + n * 2);
        u32x4 o; o.x = (unsigned)c[0] | ((unsigned)c[66] << 16); o.y = (unsigned)c[2 * 66] | ((unsigned)c[3 * 66] << 16); o.z = (unsigned)c[4 * 66] | ((unsigned)c[5 * 66] << 16); o.w = (unsigned)c[6 * 66] | ((unsigned)c[7 * 66] << 16);
        *(GAS u32x4*)(j.dst + (size_t)n * j.dld + 8 * kc) = o; }
    LDS_WAIT();
}
template <class Dec> DI void tr_run(const Dec& D, int first, int count, int stride, LAS unsigned char* scr, int lane) {
    f32x4 A[16], B[16]; TJob ja, jb;
    int it = first; if (it >= count) return;
    ja = D(it); tr_load(ja, A, lane);
    for (;;) {
        const int it2 = it + stride; const bool h2 = it2 < count; if (h2) { jb = D(it2); tr_load(jb, B, lane); }
        tr_store(ja, A, scr, lane);
        if (!h2) break;
        const int it3 = it2 + stride; const bool h3 = it3 < count; if (h3) { ja = D(it3); tr_load(ja, A, lane); }
        tr_store(jb, B, scr, lane);
        if (!h3) break;
        it = it3;
    }
}
DI TJob mat_job(const float* W, int K, int N, bf16_t* WT, int item) {
    const int nblk = N / 64, kb = item / nblk, nb = item - kb * nblk;
    TJob j; j.src = W + (size_t)(64 * kb) * N + 64 * nb; j.dst = WT + (size_t)(64 * nb) * K + 64 * kb; j.ldw = N; j.dld = K; return j;
}
DI void row_to_bf16(const float* src, bf16_t* dst, int lane) {
    const GAS f32x4* s = (const GAS f32x4*)src + lane; GAS u32x2* o = (GAS u32x2*)dst + lane;
#pragma unroll
    for (int j = 0; j < 8; ++j) { const f32x4 v = s[64 * j]; u32x2 w; w.x = cvt_pk_bf16(v.x, v.y); w.y = cvt_pk_bf16(v.z, v.w); o[64 * j] = w; }
}

DI void phase_prologue(const Ctx& F, const Params& P) {
    unsigned char* const wsl = F.ws; float* const outl = F.out; (void)outl;
    LAS unsigned char* scr = F.lds + F.wave * 16384;
    unsigned char* ws = wsl;
    constexpr int I_RW = 32 * (RW_IN_COLS / 64), I_OT = 32 * (ZW_OTH / 64), I_WO = 32 * 32, I_KV = 32 * 8;
    constexpr int N_A = 2 * I_RW + 2 * I_OT, N_B = 4 * I_WO, N_C = 8 * I_KV, N_D = NTOK + NBATCH * MEML;
    struct ProDec { unsigned char* ws;
        DI TJob operator()(int it) const { int r = it;
            if (r < N_A) {
                if (r < I_RW) return mat_job(PIN(16), DM, RW_IN_COLS, (bf16_t*)(ws + WS_WIN), r); r -= I_RW;
                if (r < I_OT) return mat_job(PIN(28), DM, ZW_OTH, (bf16_t*)(ws + WS_WIN + WIN_STRIDE), r); r -= I_OT;
                if (r < I_OT) return mat_job(PIN(30), DM, ZW_OTH, (bf16_t*)(ws + WS_WIN + 2 * WIN_STRIDE), r); r -= I_OT;
                return mat_job(PIN(16) + (size_t)DM * RW_IN_COLS, DM, RW_IN_COLS, (bf16_t*)(ws + WS_WIN + 3 * WIN_STRIDE), r);
            }
            r -= N_A;
            if (r < N_B) { const int l = r / I_WO; return mat_job(PIN(2) + (size_t)l * DM * DM, DM, DM, (bf16_t*)(ws + WS_WOUT) + (size_t)l * DM * DM, r - l * I_WO); }
            r -= N_B;
            const int m = r / I_KV, l = m & 3; const bool isv = m >= 4;
            return mat_job(PIN(isv ? 4 : 3) + (size_t)l * DM * MEMW, DM, MEMW, (bf16_t*)(ws + (isv ? WS_WV : WS_WK)) + (size_t)l * MEMW * DM, r - m * I_KV);
        } };
    ProDec PD{ws};
    tr_run(PD, F.gw, N_A + N_B + N_C, F.ngw, scr, F.lane);
    for (int r = F.gw; r < N_D; r += F.ngw) {
        if (r < NTOK) row_to_bf16(PIN(0) + (size_t)r * DM, (bf16_t*)(ws + WS_XB) + (size_t)r * DM, F.lane);
        else row_to_bf16(PIN(1) + (size_t)(r - NTOK) * DM, (bf16_t*)(ws + WS_MEMB) + (size_t)(r - NTOK) * DM, F.lane);
    }
    const int gt = F.bid * NT + F.tid, ngt = F.G * NT;
    for (int idx = gt; idx < 2 * (3072 + 1536) * 256; idx += ngt) {
        const int j = idx / ((3072 + 1536) * 256); int r = idx - j * (3072 + 1536) * 256;
        bf16_t* base = (bf16_t*)(ws + WS_LORA + (size_t)j * LORA_STRIDE);
        const int n = r >> 8, k = r & 255; float v = 0.f;
        if (n < 1536) { if (k < 96) v = PIN(19)[((size_t)j * 96 + k) * CMIX + n]; }
        else if (n < 3072) { if (k >= 96 && k < 192) v = PIN(21)[((size_t)j * 96 + (k - 96)) * CMIX + (n - 1536)]; }
        else v = PIN(22)[((size_t)j * 256 + k) * CMIX + (n - 3072)];
        base[r] = (bf16_t)(cvt_pk_bf16(v, 0.f) & 0xffffu);
    }
    for (int idx = gt; idx < 2 * 64 * DM; idx += ngt) { const int j = idx / (64 * DM), r = idx - j * 64 * DM;
        ((bf16_t*)(ws + WS_WIN + (size_t)(j ? 3 : 0) * WIN_STRIDE))[(size_t)RW_IN_COLS * DM + r] = 0; }
    for (int idx = gt; idx < NLAYER * 48 * DM; idx += ngt) {
        const int l = idx / (48 * DM); int r = idx - l * 48 * DM; const int n = r / DM, k = r - n * DM;
        float v = 0.f;
        if (n < 4) v = PIN(9)[((size_t)l * DM + k) * 4 + n]; else if (n < 36) v = PIN(11)[((size_t)l * DM + k) * 32 + (n - 4)];
        const unsigned hi = cvt_pk_bf16(v, 0.f) & 0xffffu; const float rem = v - bf2f(hi); const unsigned lo = cvt_pk_bf16(rem, 0.f) & 0xffffu;
        bf16_t* base = (bf16_t*)(ws + WS_WSW + (size_t)l * WSW_STRIDE);
        base[r] = (bf16_t)hi; base[48 * DM + r] = (bf16_t)lo;
    }
}

constexpr int EXP_ITEMS = 24576, EXP_EARLY0 = 3584, EXP_EARLY3 = 7168;
DI void expert_convert(const Ctx& F, const Params& P, int l, int w, int nw, int it0, int it1) {
    unsigned char* const wsl = F.ws;
    LAS unsigned char* scr = F.lds + F.wave * 16384;
    constexpr int I_GU = NEXP * 32 * 8 * 2, I_DN = NEXP * 8 * 32;
    struct ExpDec { unsigned char* ws; int l, base;
        DI TJob operator()(int it) const { TJob j; it += base;
            if (it < I_GU) {
                const int isup = it / (I_GU / 2); int r = it - isup * (I_GU / 2);
                const int e = r / 256; r -= e * 256; const int kb = r >> 3, nb = r & 7;
                const float* W = PIN(isup ? 14 : 13) + ((size_t)l * NEXP + e) * DM * DEXP;
                const int n0 = 64 * nb, drow = 256 * (n0 >> 7) + (isup ? 128 : 0) + (n0 & 127);
                j.src = W + (size_t)(64 * kb) * DEXP + n0; j.ldw = DEXP; j.dst = (bf16_t*)(ws + WS_EXP1) + ((size_t)e * 1024 + drow) * DM + 64 * kb; j.dld = DM;
            } else {
                int r = it - I_GU; const int e = r / 256; r -= e * 256; const int kb = r >> 5, nb = r & 31;
                const float* W = PIN(15) + ((size_t)l * NEXP + e) * DEXP * DM;
                j.src = W + (size_t)(64 * kb) * DM + 64 * nb; j.ldw = DM; j.dst = (bf16_t*)(ws + WS_EXP2) + ((size_t)e * DM + 64 * nb) * DEXP + 64 * kb; j.dld = DEXP;
            }
            return j; } };
    ExpDec ED{wsl, l, it0};
    tr_run(ED, w, it1 - it0, nw, scr, F.lane);
}

DI void memattn_unit(const Ctx& F, int l, int unit, const bf16_t* z, int zw, int qcol) {
    unsigned char* const wsl = F.ws; float* const outl = F.out; (void)outl;
    const int b = unit >> 6, head = (unit >> 4) & 3, qblk = unit & 15;
    LAS unsigned char* Ks = F.lds; LAS unsigned char* Vs = F.lds + 69632;
    const bf16_t* Km = (const bf16_t*)(wsl + WS_KM); const bf16_t* VmT = (const bf16_t*)(wsl + WS_VMT);
    bf16_t* cat = (bf16_t*)(wsl + WS_CAT);
    __syncthreads();
#pragma unroll
    for (int h = 0; h < 2; ++h) {
        u32x4 kv[4], vv[4];
#pragma unroll
        for (int i = 0; i < 4; ++i) { const int ch = F.tid + NT * (4 * h + i);
            { const int row = ch >> 4, c16 = ch & 15; kv[i] = *(const GAS u32x4*)(Km + (size_t)(b * MEML + row) * 2048 + l * 512 + head * 128 + c16 * 8); }
            { const int d = ch >> 5, c = ch & 31; vv[i] = *(const GAS u32x4*)(VmT + (size_t)(l * 512 + head * 128 + d) * 1024 + b * MEML + c * 8); } }
#pragma unroll
        for (int i = 0; i < 4; ++i) { const int ch = F.tid + NT * (4 * h + i);
            { const int row = ch >> 4, c16 = ch & 15; *(LAS u32x4*)(Ks + row * 272 + c16 * 16) = kv[i]; }
            { const int d = ch >> 5, c = ch & 31; *(LAS u32x4*)(Vs + d * 528 + c * 16) = vv[i]; } }
        asm volatile("" ::: "memory");
    }
    __syncthreads();
    int lane = F.lane; asm volatile("" : "+v"(lane) :: "memory");
    const int fr = lane & 15, fq = lane >> 4;
    for (int itq = 0; itq < 2; ++itq) {
        asm volatile("" : "+v"(lane) :: "memory");
        const int q0 = qblk * 256 + itq * 128 + F.wave * 16, tok0 = b * SEQ + q0;
        bf16x8 Qf[4];
#pragma unroll
        for (int ks = 0; ks < 4; ++ks) Qf[ks] = *(const GAS bf16x8*)(z + (size_t)(tok0 + (lane & 15)) * zw + qcol + head * 128 + ks * 32 + (lane >> 4) * 8);
        f32x4 acc[16];
#pragma unroll
        for (int t = 0; t < 16; ++t) { acc[t] = (f32x4){0.f, 0.f, 0.f, 0.f};
#pragma unroll
            for (int ks = 0; ks < 4; ++ks) { const bf16x8 kf = *(const LAS bf16x8*)(Ks + (16 * t + fr) * 272 + ks * 64 + fq * 16);
                acc[t] = __builtin_amdgcn_mfma_f32_16x16x32_bf16(kf, Qf[ks], acc[t], 0, 0, 0); } }
        const float sc = 0.08838834764831845f;
        float mx = -3.0e38f;
#pragma unroll
        for (int t = 0; t < 16; ++t)
#pragma unroll
            for (int j = 0; j < 4; ++j) { acc[t][j] *= sc; mx = fmaxf(mx, acc[t][j]); }
        mx = fmaxf(mx, __shfl_xor(mx, 16)); mx = fmaxf(mx, __shfl_xor(mx, 32));
        float sum = 0.f;
#pragma unroll
        for (int t = 0; t < 16; ++t)
#pragma unroll
            for (int j = 0; j < 4; ++j) { acc[t][j] = __expf(acc[t][j] - mx); sum += acc[t][j]; }
        sum += __shfl_xor(sum, 16); sum += __shfl_xor(sum, 32);
        const float inv = 1.f / sum;
        f32x4 o[8];
#pragma unroll
        for (int dt = 0; dt < 8; ++dt) o[dt] = (f32x4){0.f, 0.f, 0.f, 0.f};
#pragma unroll
        for (int s = 0; s < 8; ++s) {
            u32x4 pw; pw.x = cvt_pk_bf16(acc[2 * s][0], acc[2 * s][1]); pw.y = cvt_pk_bf16(acc[2 * s][2], acc[2 * s][3]);
            pw.z = cvt_pk_bf16(acc[2 * s + 1][0], acc[2 * s + 1][1]); pw.w = cvt_pk_bf16(acc[2 * s + 1][2], acc[2 * s + 1][3]);
            const bf16x8 pf = __builtin_bit_cast(bf16x8, pw);
#pragma unroll
            for (int dt = 0; dt < 8; ++dt) {
                const u32x2 v0 = *(const LAS u32x2*)(Vs + (16 * dt + fr) * 528 + (32 * s + 4 * fq) * 2);
                const u32x2 v1 = *(const LAS u32x2*)(Vs + (16 * dt + fr) * 528 + (32 * s + 16 + 4 * fq) * 2);
                u32x4 vw; vw.x = v0.x; vw.y = v0.y; vw.z = v1.x; vw.w = v1.y;
                o[dt] = __builtin_amdgcn_mfma_f32_16x16x32_bf16(__builtin_bit_cast(bf16x8, vw), pf, o[dt], 0, 0, 0);
            }
        }
        bf16_t* orow = cat + (size_t)(tok0 + fr) * DM + CMIX + head * 128 + 4 * fq;
#pragma unroll
        for (int dt = 0; dt < 8; ++dt) { u32x2 w; w.x = cvt_pk_bf16(o[dt][0] * inv, o[dt][1] * inv); w.y = cvt_pk_bf16(o[dt][2] * inv, o[dt][3] * inv); *(GAS u32x2*)(orow + 16 * dt) = w; }
    }
}
DI void memattn_all(const Ctx& F, int l, const bf16_t* z, int zw, int qcol) {
    for (int u = F.bid; u < 256; u += F.G) memattn_unit(F, l, u, z, zw, qcol);
    __syncthreads();
}

DI void conv_mix(const Ctx& F, const Params& P, const bf16_t* z) {
    unsigned char* const wsl = F.ws; float* const outl = F.out; (void)outl;
    const float* cw = PIN(29);
    bf16_t* cat = (bf16_t*)(wsl + WS_CAT);
    const int gt = F.bid * NT + F.tid, ngt = F.G * NT;
    for (int idx = gt; idx < NTOK * 192; idx += ngt) {
        const int tok = idx / 192, c8 = idx - tok * 192, c = c8 * 8, t = tok & (SEQ - 1);
        const bf16_t* zr = z + (size_t)tok * ZW_OTH;
        const u32x4 bg = *(const GAS u32x4*)(zr + c);
        u32x4 cg[3], hh[3]; f32x4 w0[3], w1[3];
#pragma unroll
        for (int dt = 0; dt < 3; ++dt) { const bf16_t* zp = (t - dt >= 0) ? zr - (size_t)dt * ZW_OTH : zr;
            cg[dt] = *(const GAS u32x4*)(zp + CMIX + c); hh[dt] = *(const GAS u32x4*)(zp + 2 * CMIX + c);
            w0[dt] = *(const GAS f32x4*)(cw + (2 - dt) * CMIX + c); w1[dt] = *(const GAS f32x4*)(cw + (2 - dt) * CMIX + c + 4); }
        float y[8];
#pragma unroll
        for (int j = 0; j < 8; ++j) y[j] = 0.f;
#pragma unroll
        for (int dt = 0; dt < 3; ++dt) {
            const float m = (t - dt >= 0) ? 1.f : 0.f;
            y[0] += m * (w0[dt].x * bflo(cg[dt].x) * bflo(hh[dt].x)); y[1] += m * (w0[dt].y * bfhi(cg[dt].x) * bfhi(hh[dt].x)); y[2] += m * (w0[dt].z * bflo(cg[dt].y) * bflo(hh[dt].y)); y[3] += m * (w0[dt].w * bfhi(cg[dt].y) * bfhi(hh[dt].y));
            y[4] += m * (w1[dt].x * bflo(cg[dt].z) * bflo(hh[dt].z)); y[5] += m * (w1[dt].y * bfhi(cg[dt].z) * bfhi(hh[dt].z)); y[6] += m * (w1[dt].z * bflo(cg[dt].w) * bflo(hh[dt].w)); y[7] += m * (w1[dt].w * bfhi(cg[dt].w) * bfhi(hh[dt].w));
        }
        u32x4 o; o.x = cvt_pk_bf16(bflo(bg.x) * y[0], bfhi(bg.x) * y[1]); o.y = cvt_pk_bf16(bflo(bg.y) * y[2], bfhi(bg.y) * y[3]);
        o.z = cvt_pk_bf16(bflo(bg.z) * y[4], bfhi(bg.z) * y[5]); o.w = cvt_pk_bf16(bflo(bg.w) * y[6], bfhi(bg.w) * y[7]);
        *(GAS u32x4*)(cat + (size_t)tok * DM + c) = o;
    }
}

DI void sb_attention(const Ctx& F, const bf16_t* z) {
    unsigned char* const wsl = F.ws;
    const bf16_t* VT = (const bf16_t*)(wsl + WS_ACT);
    bf16_t* cat = (bf16_t*)(wsl + WS_CAT);
    LAS unsigned char* Ks = F.lds; LAS unsigned char* Vs = F.lds + 69632;
    const int lane = F.lane, fr = lane & 15, fq = lane >> 4;
    const float sc = 0.08838834764831845f;
    for (int u = F.bid; u < NBATCH * 12 * 32; u += F.G) {
        const int b = u / (12 * 32); int r = u - b * 12 * 32; const int head = r >> 5, qblk = r & 31;
        const int t0 = qblk * 128, kw0 = t0 - 128;
        __syncthreads();
#pragma unroll
        for (int h = 0; h < 2; ++h) {
            u32x4 kv[4], vv[4];
#pragma unroll
            for (int i = 0; i < 4; ++i) { const int ch = F.tid + NT * (4 * h + i);
                { const int row = ch >> 4, c16 = ch & 15, key = kw0 + row, keyc = key < 0 ? 0 : key; kv[i] = *(const GAS u32x4*)(z + (size_t)(b * SEQ + keyc) * ZW_OTH + CMIX + head * 128 + c16 * 8); }
                { const int d = ch >> 5, c = ch & 31, k8 = kw0 + c * 8, k8c = k8 < 0 ? 0 : k8; vv[i] = *(const GAS u32x4*)(VT + (size_t)(head * 128 + d) * NTOK + b * SEQ + k8c); } }
#pragma unroll
            for (int i = 0; i < 4; ++i) { const int ch = F.tid + NT * (4 * h + i);
                { const int row = ch >> 4, c16 = ch & 15; *(LAS u32x4*)(Ks + row * 272 + c16 * 16) = kv[i]; }
                { const int d = ch >> 5, c = ch & 31; *(LAS u32x4*)(Vs + d * 528 + c * 16) = vv[i]; } }
            asm volatile("" ::: "memory");
        }
        __syncthreads();
        int lq = F.lane; asm volatile("" : "+v"(lq) :: "memory");
        const int tq0 = t0 + F.wave * 16, tq = tq0 + fr;
        bf16x8 Qf[4];
#pragma unroll
        for (int ks = 0; ks < 4; ++ks) Qf[ks] = *(const GAS bf16x8*)(z + (size_t)(b * SEQ + tq0 + (lq & 15)) * ZW_OTH + head * 128 + ks * 32 + (lq >> 4) * 8);
        f32x4 o[8];
#pragma unroll
        for (int dt = 0; dt < 8; ++dt) o[dt] = (f32x4){0.f, 0.f, 0.f, 0.f};
        float R = 0.f;
        for (int kt = (tq0 + 14) >> 5; kt >= 0; --kt) {
            const int lk = 32 * kt - kw0;
            bf16x8 Kf[2][4]; u32x2 V0[8], V1[8];
            if (lk >= 0) {
#pragma unroll
                for (int tl = 0; tl < 2; ++tl)
#pragma unroll
                    for (int ks = 0; ks < 4; ++ks) Kf[tl][ks] = *(const LAS bf16x8*)(Ks + (lk + 16 * tl + fr) * 272 + ks * 64 + fq * 16);
#pragma unroll
                for (int dt = 0; dt < 8; ++dt) { V0[dt] = *(const LAS u32x2*)(Vs + (16 * dt + fr) * 528 + (lk + 4 * fq) * 2); V1[dt] = *(const LAS u32x2*)(Vs + (16 * dt + fr) * 528 + (lk + 16 + 4 * fq) * 2); }
            } else {
#pragma unroll
                for (int tl = 0; tl < 2; ++tl)
#pragma unroll
                    for (int ks = 0; ks < 4; ++ks) Kf[tl][ks] = *(const GAS bf16x8*)(z + (size_t)(b * SEQ + 32 * kt + 16 * tl + fr) * ZW_OTH + CMIX + head * 128 + ks * 32 + fq * 8);
#pragma unroll
                for (int dt = 0; dt < 8; ++dt) { const bf16_t* vp = VT + (size_t)(head * 128 + 16 * dt + fr) * NTOK + b * SEQ + 32 * kt + 4 * fq; V0[dt] = *(const GAS u32x2*)vp; V1[dt] = *(const GAS u32x2*)(vp + 16); }
            }
            f32x4 s[2];
#pragma unroll
            for (int tl = 0; tl < 2; ++tl) { s[tl] = (f32x4){0.f, 0.f, 0.f, 0.f};
#pragma unroll
                for (int ks = 0; ks < 4; ++ks) s[tl] = __builtin_amdgcn_mfma_f32_16x16x32_bf16(Kf[tl][ks], Qf[ks], s[tl], 0, 0, 0); }
            float ln[2][4], lsg[2][4], tot[2];
#pragma unroll
            for (int tl = 0; tl < 2; ++tl) { tot[tl] = 0.f;
#pragma unroll
                for (int j = 0; j < 4; ++j) { const float x = s[tl][j] * sc; const int key = 32 * kt + 16 * tl + 4 * fq + j; const bool valid = key < tq;
                    const float sp = softplusf_(x); ln[tl][j] = valid ? -sp : 0.f; lsg[tl][j] = valid ? (x - sp) : -1.0e30f; tot[tl] += ln[tl][j]; } }
            const float a16_0 = __shfl_xor(tot[0], 16), a32_0 = __shfl_xor(tot[0], 32), a48_0 = __shfl_xor(tot[0], 48);
            const float a16_1 = __shfl_xor(tot[1], 16), a32_1 = __shfl_xor(tot[1], 32), a48_1 = __shfl_xor(tot[1], 48);
            float hi0 = 0.f, hi1 = 0.f;
            if ((fq ^ 1) > fq) { hi0 += a16_0; hi1 += a16_1; }
            if ((fq ^ 2) > fq) { hi0 += a32_0; hi1 += a32_1; }
            if ((fq ^ 3) > fq) { hi0 += a48_0; hi1 += a48_1; }
            const float all0 = tot[0] + a16_0 + a32_0 + a48_0, all1 = tot[1] + a16_1 + a32_1 + a48_1;
            const float E0 = R + hi0 + all1, E1 = R + hi1;
            float at[2][4];
#pragma unroll
            for (int tl = 0; tl < 2; ++tl) { float suf = 0.f; const float Eb = tl ? E1 : E0;
#pragma unroll
                for (int j = 3; j >= 0; --j) { at[tl][j] = __expf(lsg[tl][j] + Eb + suf); suf += ln[tl][j]; } }
            R += all0 + all1;
            u32x4 pw; pw.x = cvt_pk_bf16(at[0][0], at[0][1]); pw.y = cvt_pk_bf16(at[0][2], at[0][3]); pw.z = cvt_pk_bf16(at[1][0], at[1][1]); pw.w = cvt_pk_bf16(at[1][2], at[1][3]);
            const bf16x8 pf = __builtin_bit_cast(bf16x8, pw);
#pragma unroll
            for (int dt = 0; dt < 8; ++dt) {
                u32x4 vw; vw.x = V0[dt].x; vw.y = V0[dt].y; vw.z = V1[dt].x; vw.w = V1[dt].y;
                o[dt] = __builtin_amdgcn_mfma_f32_16x16x32_bf16(__builtin_bit_cast(bf16x8, vw), pf, o[dt], 0, 0, 0);
            }
            if (__all(R < -100.f)) break;
        }
        bf16_t* orow = cat + (size_t)(b * SEQ + tq) * DM + head * 128 + 4 * fq;
#pragma unroll
        for (int dt = 0; dt < 8; ++dt) { u32x2 w; w.x = cvt_pk_bf16(o[dt][0], o[dt][1]); w.y = cvt_pk_bf16(o[dt][2], o[dt][3]); *(GAS u32x2*)(orow + 16 * dt) = w; }
    }
    __syncthreads();
}

DI void rwkv_prep1(const Ctx& F, const Params& P, int j, const bf16_t* z) {
    unsigned char* const wsl = F.ws; float* const outl = F.out; (void)outl;
    const float* mu = PIN(17) + (size_t)j * 5056;
    bf16_t* act = (bf16_t*)(wsl + WS_ACT);
    const int gt = F.bid * NT + F.tid, ngt = F.G * NT;
    for (int idx = gt; idx < NTOK * 64; idx += ngt) {
        const int tok = idx >> 6, ci = idx & 63, t = tok & (SEQ - 1);
        u32x4 o = (u32x4){0u, 0u, 0u, 0u};
        if (ci < 24 || ci >= 32) {
            const int sc = ci < 12 ? 4608 + 8 * ci : (ci < 24 ? 4704 + 8 * (ci - 12) : 4800 + 8 * (ci - 32));
            const u32x4 a = *(const GAS u32x4*)(z + (size_t)tok * ZW_RWKV + sc);
            u32x4 p = *(const GAS u32x4*)(z + (size_t)(t > 0 ? tok - 1 : tok) * ZW_RWKV + sc);
            const f32x4 m0 = *(const GAS f32x4*)(mu + sc), m1 = *(const GAS f32x4*)(mu + sc + 4);
            if (t == 0) p = (u32x4){0u, 0u, 0u, 0u};
            float v[8];
            v[0] = bflo(a.x) + (bflo(p.x) - bflo(a.x)) * m0.x; v[1] = bfhi(a.x) + (bfhi(p.x) - bfhi(a.x)) * m0.y;
            v[2] = bflo(a.y) + (bflo(p.y) - bflo(a.y)) * m0.z; v[3] = bfhi(a.y) + (bfhi(p.y) - bfhi(a.y)) * m0.w;
            v[4] = bflo(a.z) + (bflo(p.z) - bflo(a.z)) * m1.x; v[5] = bfhi(a.z) + (bfhi(p.z) - bfhi(a.z)) * m1.y;
            v[6] = bflo(a.w) + (bflo(p.w) - bflo(a.w)) * m1.z; v[7] = bfhi(a.w) + (bfhi(p.w) - bfhi(a.w)) * m1.w;
#pragma unroll
            for (int q = 0; q < 8; ++q) { if (ci < 12) v[q] = tanhf(v[q]); else if (ci >= 32) v[q] = sigmoidf_(v[q]); }
            o.x = cvt_pk_bf16(v[0], v[1]); o.y = cvt_pk_bf16(v[2], v[3]); o.z = cvt_pk_bf16(v[4], v[5]); o.w = cvt_pk_bf16(v[6], v[7]);
        }
        *(GAS u32x4*)(act + (size_t)tok * 512 + ci * 8) = o;
    }
}

constexpr int CH = 64, NCH = SEQ / CH;
DI float* scan_rec(unsigned char* ws, int tok, int head) {
    return (float*)(ws + WS_SCAN) + ((size_t)((tok >> 12) * 24 + head) * SEQ + (tok & (SEQ - 1))) * 320;
}
DI float* gh_ptr(unsigned char* ws, int bh, int c, int which) { return (float*)(ws + WS_GH) + (((size_t)bh * NCH + c) * 2 + which) * 4096; }
struct RwPar { const float *mu, *w0, *a0, *kk, *ka, *rk, *gng, *gnb; };
struct PrepRaw { u32x2 zr, zk, zv, pr, pk, pv, lw, la; };
struct PrepOut { f32x4 dec, ld, bb, kp, r, nk, v; float bon; };
DI void prep_load(PrepRaw& R, const bf16_t* z, const bf16_t* LW, int tok, int c4) {
    tok = tok < NTOK ? tok : NTOK - 1;
    const bool hp = (tok & (SEQ - 1)) != 0;
    const GAS bf16_t* zc = (const GAS bf16_t*)(z + (size_t)tok * ZW_RWKV + c4); const GAS bf16_t* zp = hp ? zc - ZW_RWKV : zc;
    R.zr = *(const GAS u32x2*)zc; R.zk = *(const GAS u32x2*)(zc + CMIX); R.zv = *(const GAS u32x2*)(zc + 2 * CMIX);
    R.pr = *(const GAS u32x2*)zp; R.pk = *(const GAS u32x2*)(zp + CMIX); R.pv = *(const GAS u32x2*)(zp + 2 * CMIX);
    const GAS bf16_t* lp = (const GAS bf16_t*)(LW + (size_t)tok * 3072 + c4); R.lw = *(const GAS u32x2*)lp; R.la = *(const GAS u32x2*)(lp + CMIX);
}
DI f32x4 lerp_u(u32x2 a, u32x2 p, f32x4 m) {
    f32x4 r; r.x = bflo(a.x) + (bflo(p.x) - bflo(a.x)) * m.x; r.y = bfhi(a.x) + (bfhi(p.x) - bfhi(a.x)) * m.y;
    r.z = bflo(a.y) + (bflo(p.y) - bflo(a.y)) * m.z; r.w = bfhi(a.y) + (bfhi(p.y) - bfhi(a.y)) * m.w; return r;
}
struct PrepPar { f32x4 mur, muk, muv, w0, a0, kk, ka, rk; };
DI void par_load(PrepPar& P, const RwPar& Q, int c4) {
    P.mur = *(const GAS f32x4*)(Q.mu + c4); P.muk = *(const GAS f32x4*)(Q.mu + CMIX + c4); P.muv = *(const GAS f32x4*)(Q.mu + 2 * CMIX + c4);
    P.w0 = *(const GAS f32x4*)(Q.w0 + c4); P.a0 = *(const GAS f32x4*)(Q.a0 + c4); P.kk = *(const GAS f32x4*)(Q.kk + c4); P.ka = *(const GAS f32x4*)(Q.ka + c4); P.rk = *(const GAS f32x4*)(Q.rk + c4);
}
template <bool WANT_BON> DI void prep_compute(const PrepRaw& R, const PrepPar& P, bool hp, PrepOut& O) {
    const u32x2 z2 = (u32x2){0u, 0u};
    const f32x4 r = lerp_u(R.zr, hp ? R.pr : z2, P.mur), k = lerp_u(R.zk, hp ? R.pk : z2, P.muk);
    O.v = lerp_u(R.zv, hp ? R.pv : z2, P.muv); O.r = r;
    const f32x4 w0v = P.w0, a0v = P.a0, kkv = P.kk, kav = P.ka;
    f32x4 wr; wr.x = w0v.x + bflo(R.lw.x); wr.y = w0v.y + bfhi(R.lw.x); wr.z = w0v.z + bflo(R.lw.y); wr.w = w0v.w + bfhi(R.lw.y);
    f32x4 ar; ar.x = a0v.x + bflo(R.la.x); ar.y = a0v.y + bfhi(R.la.x); ar.z = a0v.z + bflo(R.la.y); ar.w = a0v.w + bfhi(R.la.y);
    f32x4 a, kk;
#pragma unroll
    for (int q = 0; q < 4; ++q) { const float wl = -softplusf_(-wr[q]) - 0.5f; O.ld[q] = -__expf(wl); O.dec[q] = __expf(O.ld[q]); a[q] = sigmoidf_(ar[q]); kk[q] = k[q] * kkv[q]; O.kp[q] = k[q] * (1.f + (a[q] - 1.f) * kav[q]); }
    const float n2 = sum16(kk.x * kk.x + kk.y * kk.y + kk.z * kk.z + kk.w * kk.w);
    const float inv = __builtin_amdgcn_rsqf(fmaxf(n2, 1e-24f));
#pragma unroll
    for (int q = 0; q < 4; ++q) { const float kn = kk[q] * inv; O.bb[q] = kn * a[q]; O.nk[q] = -kn; }
    if (WANT_BON) { const f32x4 rk = P.rk; O.bon = sum16(r.x * O.kp.x * rk.x + r.y * O.kp.y * rk.y + r.z * O.kp.z * rk.z + r.w * O.kp.w * rk.w); }
}
#define LO2(v) ((f32x2){(v).x, (v).y})
#define HI2(v) ((f32x2){(v).z, (v).w})
constexpr int WRS = 144;
constexpr int W_SLOT = 64 * WRS;
enum { SL_NT = 0, SL_RT, SL_BH, SL_KH, SL_BHT, SL_KHT, SL_VT, SL_MK, SL_NB, SL_NK, SL_W1T, SL_U0T };
constexpr int W_MB = 12 * W_SLOT, W_CL = W_MB + 16384, W_PL = W_CL + 16384;
DI bf16x8 wfrag(LAS unsigned char* L, int slot, int row, int ks, int q) { return *(const LAS bf16x8*)(L + slot * W_SLOT + row * WRS + ks * 64 + q * 16); }
DI void wput(LAS unsigned char* L, int slot, int row, int col, float v) { *(LAS bf16_t*)(L + slot * W_SLOT + row * WRS + col * 2) = (bf16_t)(cvt_pk_bf16(v, 0.f) & 0xffffu); }
DI void tr4x4_rows(f32x4& x) {
    const float f0 = x.x, f1 = x.y, f2 = x.z, f3 = x.w;
    const unsigned u0 = __builtin_bit_cast(unsigned, f0), u1 = __builtin_bit_cast(unsigned, f1), u2 = __builtin_bit_cast(unsigned, f2), u3 = __builtin_bit_cast(unsigned, f3);
    const auto s02 = __builtin_amdgcn_permlane32_swap(u0, u2, false, false); const auto s13 = __builtin_amdgcn_permlane32_swap(u1, u3, false, false);
    const auto t01 = __builtin_amdgcn_permlane16_swap(s02[0], s13[0], false, false); const auto t23 = __builtin_amdgcn_permlane16_swap(s02[1], s13[1], false, false);
    x[0] = __builtin_bit_cast(float, (unsigned)t01[0]); x[1] = __builtin_bit_cast(float, (unsigned)t01[1]); x[2] = __builtin_bit_cast(float, (unsigned)t23[0]); x[3] = __builtin_bit_cast(float, (unsigned)t23[1]);
}
DI void scan_w1(const Ctx& F, const RwPar& Q, const bf16_t* z) {
    unsigned char* const wsl = F.ws; LAS unsigned char* L = F.lds;
    const int wave = F.wave;
    const bf16_t* LW = (const bf16_t*)(wsl + WS_LW);
    LAS float* MB = (LAS float*)(L + W_MB); LAS float* CL = (LAS float*)(L + W_CL); LAS float* PL = (LAS float*)(L + W_PL);
    PrepPar PN;
    PrepRaw RN[2];
    if (F.bid < 96 * NCH) { const int bh = F.bid % 96, c = F.bid / 96, b = bh / 24, head = bh - b * 24, tokb = b * SEQ + c * CH, c4 = head * 64 + 4 * (F.lane & 15);
#pragma unroll
        for (int p = 0; p < 2; ++p) prep_load(RN[p], z, LW, tokb + p * 32 + wave * 4 + (F.lane >> 4), c4);
        par_load(PN, Q, c4); }
    for (int u = F.bid; u < 96 * NCH; u += F.G) {
        int lane = F.lane; asm volatile("" : "+v"(lane));
        const int tq = lane >> 4, li = lane & 15, fr = li, fq = tq;
        const int bh = u % 96, c = u / 96, b = bh / 24, head = bh - b * 24, tokb = b * SEQ + c * CH, c4 = head * 64 + 4 * li;
        LDS_BARRIER();
        PrepOut O[2];
#pragma unroll
        for (int p = 0; p < 2; ++p) {
            const int t = p * 32 + wave * 4 + tq; const PrepRaw R = RN[p];
            prep_compute<true>(R, PN, ((tokb + t) & (SEQ - 1)) != 0, O[p]);
            *(LAS f32x4*)(CL + t * 64 + 4 * li) = O[p].ld;
            u32x2 e; e.x = cvt_pk_bf16(O[p].bon * O[p].v.x, O[p].bon * O[p].v.y); e.y = cvt_pk_bf16(O[p].bon * O[p].v.z, O[p].bon * O[p].v.w);
            *(GAS u32x2*)((bf16_t*)(wsl + WS_E) + (size_t)(tokb + t) * CMIX + c4) = e;
        }
        LDS_BARRIER();
        if (wave == 0) {
            float xs[64];
#pragma unroll
            for (int t = 0; t < 64; ++t) xs[t] = CL[t * 64 + lane];
#pragma unroll
            for (int t = 1; t < 64; ++t) xs[t] += xs[t - 1];
#pragma unroll
            for (int t = 0; t < 64; ++t) CL[t * 64 + lane] = xs[t];
        }
        LDS_BARRIER();
#pragma unroll
        for (int p = 0; p < 2; ++p) {
            const int t = p * 32 + wave * 4 + tq;
            const f32x4 cl = *(const LAS f32x4*)(CL + t * 64 + 4 * li);
            f32x4 clm = (f32x4){0.f, 0.f, 0.f, 0.f}; if (t > 0) clm = *(const LAS f32x4*)(CL + (t - 1) * 64 + 4 * li);
            f32x4 nt, rt, bh4, kh4;
#pragma unroll
            for (int q = 0; q < 4; ++q) { const float P = __expf(cl[q]), Pm = __expf(clm[q]), iP = __expf(-cl[q]);
                nt[q] = O[p].nk[q] * Pm; rt[q] = O[p].r[q] * P; bh4[q] = O[p].bb[q] * iP; kh4[q] = O[p].kp[q] * iP;
                if (t == 63) PL[4 * li + q] = P; }
            u32x2 w;
            w.x = cvt_pk_bf16(nt.x, nt.y); w.y = cvt_pk_bf16(nt.z, nt.w); *(LAS u32x2*)(L + SL_NT * W_SLOT + t * WRS + 8 * li) = w;
            w.x = cvt_pk_bf16(rt.x, rt.y); w.y = cvt_pk_bf16(rt.z, rt.w); *(LAS u32x2*)(L + SL_RT * W_SLOT + t * WRS + 8 * li) = w;
            w.x = cvt_pk_bf16(bh4.x, bh4.y); w.y = cvt_pk_bf16(bh4.z, bh4.w); *(LAS u32x2*)(L + SL_BH * W_SLOT + t * WRS + 8 * li) = w;
            w.x = cvt_pk_bf16(kh4.x, kh4.y); w.y = cvt_pk_bf16(kh4.z, kh4.w); *(LAS u32x2*)(L + SL_KH * W_SLOT + t * WRS + 8 * li) = w;
            { f32x4 vv = O[p].v; tr4x4_rows(bh4); tr4x4_rows(kh4); tr4x4_rows(vv);
              const int off = (4 * li + tq) * WRS + (p * 32 + wave * 4) * 2;
              w.x = cvt_pk_bf16(bh4.x, bh4.y); w.y = cvt_pk_bf16(bh4.z, bh4.w); *(LAS u32x2*)(L + SL_BHT * W_SLOT + off) = w;
              w.x = cvt_pk_bf16(kh4.x, kh4.y); w.y = cvt_pk_bf16(kh4.z, kh4.w); *(LAS u32x2*)(L + SL_KHT * W_SLOT + off) = w;
              w.x = cvt_pk_bf16(vv.x, vv.y); w.y = cvt_pk_bf16(vv.z, vv.w); *(LAS u32x2*)(L + SL_VT * W_SLOT + off) = w; }
        }
        LDS_BARRIER();
        asm volatile("" ::: "memory");
        { const int un = u + F.G; if (un < 96 * NCH) { const int bhn = un % 96, cn = un / 96, bn = bhn / 24, headn = bhn - bn * 24, tokbn = bn * SEQ + cn * CH, c4n = headn * 64 + 4 * li;
#pragma unroll
            for (int p = 0; p < 2; ++p) prep_load(RN[p], z, LW, tokbn + p * 32 + wave * 4 + tq, c4n);
            par_load(PN, Q, c4n); } }
        for (int reps = 0; reps < REP_WS; ++reps) {
            const int mt = wave >> 1, slotA = (mt < 2) ? SL_NT : SL_RT, slotB = (mt & 1) ? SL_KH : SL_BH, slotO = (mt == 1) ? SL_MK : (mt == 2 ? SL_NB : SL_NK), tt0 = (wave & 1) * 2;
            bf16x8 Af[2][2], Bf[4][2];
#pragma unroll
            for (int a2 = 0; a2 < 2; ++a2)
#pragma unroll
                for (int ks = 0; ks < 2; ++ks) Af[a2][ks] = wfrag(L, slotA, 16 * (tt0 + a2) + fr, ks, fq);
#pragma unroll
            for (int ss = 0; ss < 4; ++ss)
#pragma unroll
                for (int ks = 0; ks < 2; ++ks) Bf[ss][ks] = wfrag(L, slotB, 16 * ss + fr, ks, fq);
            float zf = 0.f; asm volatile("" : "+v"(zf));
            const unsigned zu = __builtin_bit_cast(unsigned, zf);
            const int strict = (mt < 2) ? 1 : 0; LAS unsigned char* ob = L + slotO * W_SLOT;
#pragma unroll
            for (int a2 = 0; a2 < 2; ++a2)
#pragma unroll
                for (int ss = 0; ss < 4; ++ss) { const int t = 16 * (tt0 + a2) + fr, s0 = 16 * ss + 4 * fq;
                    if (ss <= tt0 + a2) {
                        f32x4 acc = __builtin_amdgcn_mfma_f32_16x16x32_bf16(Bf[ss][0], Af[a2][0], (f32x4){0.f, 0.f, 0.f, 0.f}, 0, 0, 0);
                        acc = __builtin_amdgcn_mfma_f32_16x16x32_bf16(Bf[ss][1], Af[a2][1], acc, 0, 0, 0);
                        f32x4 o;
#pragma unroll
                        for (int r = 0; r < 4; ++r) o[r] = (s0 + r + strict <= t) ? acc[r] : 0.f;
                        if (mt == 0) *(LAS f32x4*)(MB + t * 64 + s0) = o;
                        else { u32x2 w; w.x = cvt_pk_bf16(o[0], o[1]); w.y = cvt_pk_bf16(o[2], o[3]); *(LAS u32x2*)(ob + t * WRS + s0 * 2) = w; }
                    } else {
                        if (mt == 0) *(LAS f32x4*)(MB + t * 64 + s0) = (f32x4){zf, zf, zf, zf};
                        else *(LAS u32x2*)(ob + t * WRS + s0 * 2) = (u32x2){zu, zu};
                    }
                }
        }
        LDS_BARRIER();
        { const int t = F.tid >> 3, s0 = (F.tid & 7) * 8; const f32x4 a0 = *(const LAS f32x4*)(MB + t * 64 + s0), a1 = *(const LAS f32x4*)(MB + t * 64 + s0 + 4);
          u32x4 w; w.x = cvt_pk_bf16(a0.x, a0.y); w.y = cvt_pk_bf16(a0.z, a0.w); w.z = cvt_pk_bf16(a1.x, a1.y); w.w = cvt_pk_bf16(a1.z, a1.w);
          *(LAS u32x4*)(L + SL_BH * W_SLOT + t * WRS + s0 * 2) = w; }
#pragma unroll
        for (int k2 = 0; k2 < 2; ++k2) {
            const int tile = wave * 2 + k2, tt = tile >> 2, it = tile & 3;
            f32x4 acc = (f32x4){0.f, 0.f, 0.f, 0.f};
#pragma unroll
            for (int ks = 0; ks < 2; ++ks) acc = __builtin_amdgcn_mfma_f32_16x16x32_bf16(wfrag(L, SL_MK, 16 * tt + fr, ks, fq), wfrag(L, SL_VT, 16 * it + fr, ks, fq), acc, 0, 0, 0);
#pragma unroll
            for (int r = 0; r < 4; ++r) CL[(16 * tt + 4 * fq + r) * 64 + 16 * it + fr] = acc[r];
        }
        if (wave >= 4) {
            const int I = wave - 4;
            float d[16], xb[16];
#pragma unroll
            for (int r = 0; r < 16; ++r) d[r] = (r == lane) ? 1.f : 0.f;
            const LAS float* mbv = MB; asm volatile("" : "+v"(mbv));
            const LAS float* mb = mbv + (16 * I) * 64 + 16 * I;
            f32x4 A[8][2], Bm[8][2];
#pragma unroll
            for (int tt = 0; tt < 8; ++tt) { A[tt][0] = *(const LAS f32x4*)(mb + tt * 64); A[tt][1] = *(const LAS f32x4*)(mb + tt * 64 + 4); }
#pragma unroll
            for (int tt = 0; tt < 8; ++tt) { Bm[tt][0] = *(const LAS f32x4*)(mb + (8 + tt) * 64); Bm[tt][1] = *(const LAS f32x4*)(mb + (8 + tt) * 64 + 4); }
#pragma unroll
            for (int sx = 0; sx < 8; ++sx) { xb[sx] = d[sx];
#pragma unroll
                for (int tt = sx + 1; tt < 8; ++tt) d[tt] = fma_s(A[tt][sx >> 2][sx & 3], xb[sx], d[tt]); }
#pragma unroll
            for (int sx = 0; sx < 8; ++sx)
#pragma unroll
                for (int tt = 0; tt < 8; ++tt) d[8 + tt] = fma_s(Bm[tt][sx >> 2][sx & 3], xb[sx], d[8 + tt]);
            asm volatile("" : "+v"(d[8]), "+v"(d[15]) :: "memory");
#pragma unroll
            for (int tt = 0; tt < 8; ++tt) { A[tt][0] = *(const LAS f32x4*)(mb + (8 + tt) * 64 + 8); A[tt][1] = *(const LAS f32x4*)(mb + (8 + tt) * 64 + 12); }
#pragma unroll
            for (int sx = 0; sx < 8; ++sx) { xb[8 + sx] = d[8 + sx];
#pragma unroll
                for (int tt = sx + 1; tt < 8; ++tt) d[8 + tt] = fma_s(A[tt][sx >> 2][sx & 3], xb[8 + sx], d[8 + tt]); }
            if (lane < 16) {
#pragma unroll
                for (int t = 0; t < 16; ++t) *(LAS bf16_t*)(L + SL_KH * W_SLOT + (16 * I + t) * 48 + lane * 2) = (bf16_t)(cvt_pk_bf16(xb[t], 0.f) & 0xffffu);
            }
        }
        LDS_BARRIER();
        asm volatile("" ::: "memory");
        for (int repx = 0; repx < REP_WX; ++repx) {
            const int sys = wave >> 2, ct = wave & 3, slotX = sys == 0 ? SL_W1T : SL_U0T;
            LAS unsigned char* TI = L + SL_KH * W_SLOT;
            f32x4 rhs[4];
            if (sys == 0) {
#pragma unroll
                for (int I = 0; I < 4; ++I)
#pragma unroll
                    for (int r = 0; r < 4; ++r) rhs[I][r] = bf2f(*(const LAS bf16_t*)(L + SL_NT * W_SLOT + (16 * I + 4 * fq + r) * WRS + (16 * ct + fr) * 2));
            } else {
#pragma unroll
                for (int I = 0; I < 4; ++I)
#pragma unroll
                    for (int r = 0; r < 4; ++r) rhs[I][r] = CL[(16 * I + 4 * fq + r) * 64 + 16 * ct + fr];
            }
            u32x2 ta[4], ma[6];
#pragma unroll
            for (int I = 0; I < 4; ++I) ta[I] = *(const LAS u32x2*)(TI + (16 * I + fr) * 48 + 8 * fq);
#pragma unroll
            for (int I = 1; I < 4; ++I)
#pragma unroll
                for (int Ip = 0; Ip < I; ++Ip) ma[I * (I - 1) / 2 + Ip] = *(const LAS u32x2*)(L + SL_BH * W_SLOT + (16 * I + fr) * WRS + (16 * Ip + 4 * fq) * 2);
            u32x2 xk[4];
#pragma unroll
            for (int I = 0; I < 4; ++I) {
                f32x4 acc = rhs[I];
#pragma unroll
                for (int Ip = 0; Ip < I; ++Ip) { const u32x2 m = ma[I * (I - 1) / 2 + Ip];
                    acc = __builtin_amdgcn_mfma_f32_16x16x32_bf16(__builtin_bit_cast(bf16x8, (u32x4){m.x, m.y, 0u, 0u}), __builtin_bit_cast(bf16x8, (u32x4){xk[Ip].x, xk[Ip].y, 0u, 0u}), acc, 0, 0, 0); }
                const unsigned d0 = cvt_pk_bf16(acc[0], acc[1]), d1 = cvt_pk_bf16(acc[2], acc[3]);
                const f32x4 x = __builtin_amdgcn_mfma_f32_16x16x32_bf16(__builtin_bit_cast(bf16x8, (u32x4){ta[I].x, ta[I].y, 0u, 0u}), __builtin_bit_cast(bf16x8, (u32x4){d0, d1, 0u, 0u}), (f32x4){0.f, 0.f, 0.f, 0.f}, 0, 0, 0);
                xk[I].x = cvt_pk_bf16(x[0], x[1]); xk[I].y = cvt_pk_bf16(x[2], x[3]);
                *(LAS u32x2*)(L + slotX * W_SLOT + (16 * ct + fr) * WRS + (16 * I + 4 * fq) * 2) = xk[I];
            }
        }
        LDS_BARRIER();
        for (int repo = 0; repo < REP_WO; ++repo) {
            const int kind = wave >> 1, ta0 = (wave & 1) * 2;
            float* gp = gh_ptr(wsl, bh, c, 0); float* hp = gh_ptr(wsl, bh, c, 1);
            bf16_t* qy = (bf16_t*)(wsl + WS_QY) + (size_t)u * 4096; float* y0t = (float*)(wsl + WS_Y0T) + (size_t)u * 4096;
            const int sA1 = kind == 0 ? SL_W1T : kind == 1 ? SL_BHT : kind == 2 ? SL_W1T : SL_NK, sB1 = kind == 0 ? SL_BHT : kind == 1 ? SL_U0T : kind == 2 ? SL_NB : SL_VT;
            const int sA2 = kind == 1 ? SL_KHT : SL_NB, sB2 = kind == 1 ? SL_VT : SL_U0T; const bool two = (kind & 1) != 0;
            bf16x8 Af[2][2], Bf[4][2];
#pragma unroll
            for (int a2 = 0; a2 < 2; ++a2)
#pragma unroll
                for (int ks = 0; ks < 2; ++ks) Af[a2][ks] = wfrag(L, sA1, 16 * (ta0 + a2) + fr, ks, fq);
#pragma unroll
            for (int tb = 0; tb < 4; ++tb)
#pragma unroll
                for (int ks = 0; ks < 2; ++ks) Bf[tb][ks] = wfrag(L, sB1, 16 * tb + fr, ks, fq);
            f32x4 acc[2][4];
#pragma unroll
            for (int a2 = 0; a2 < 2; ++a2)
#pragma unroll
                for (int tb = 0; tb < 4; ++tb) { acc[a2][tb] = (f32x4){0.f, 0.f, 0.f, 0.f};
#pragma unroll
                    for (int ks = 0; ks < 2; ++ks) acc[a2][tb] = __builtin_amdgcn_mfma_f32_16x16x32_bf16(Af[a2][ks], Bf[tb][ks], acc[a2][tb], 0, 0, 0); }
            if (two) {
#pragma unroll
                for (int a2 = 0; a2 < 2; ++a2)
#pragma unroll
                    for (int ks = 0; ks < 2; ++ks) Af[a2][ks] = wfrag(L, sA2, 16 * (ta0 + a2) + fr, ks, fq);
#pragma unroll
                for (int tb = 0; tb < 4; ++tb)
#pragma unroll
                    for (int ks = 0; ks < 2; ++ks) Bf[tb][ks] = wfrag(L, sB2, 16 * tb + fr, ks, fq);
#pragma unroll
                for (int a2 = 0; a2 < 2; ++a2)
#pragma unroll
                    for (int tb = 0; tb < 4; ++tb)
#pragma unroll
                        for (int ks = 0; ks < 2; ++ks) acc[a2][tb] = __builtin_amdgcn_mfma_f32_16x16x32_bf16(Af[a2][ks], Bf[tb][ks], acc[a2][tb], 0, 0, 0);
            }
#pragma unroll
            for (int a2 = 0; a2 < 2; ++a2)
#pragma unroll
                for (int tb = 0; tb < 4; ++tb) { const int ta = ta0 + a2; const f32x4 av = acc[a2][tb];
                    if (kind == 0) {
                        const int j = 16 * tb + fr; const float pl = PL[j];
                        f32x4 o;
#pragma unroll
                        for (int r = 0; r < 4; ++r) o[r] = pl * (av[r] + ((16 * ta + 4 * fq + r) == j ? 1.f : 0.f));
                        u32x2 w; w.x = cvt_pk_bf16(o[0], o[1]); w.y = cvt_pk_bf16(o[2], o[3]);
                        *(GAS u32x2*)((bf16_t*)gp + j * 64 + 16 * ta + 4 * fq) = w;
                    } else if (kind == 1) {
                        const f32x4 pl = *(const LAS f32x4*)(PL + 16 * ta + 4 * fq);
                        const f32x4 hv = pl * av; u32x2 w; w.x = cvt_pk_bf16(hv[0], hv[1]); w.y = cvt_pk_bf16(hv[2], hv[3]); *(GAS u32x2*)((bf16_t*)hp + (16 * tb + fr) * 64 + 16 * ta + 4 * fq) = w;
                    } else if (kind == 2) {
                        const int t = 16 * tb + fr; const u32x2 rr = *(const LAS u32x2*)(L + SL_RT * W_SLOT + t * WRS + (16 * ta + 4 * fq) * 2);
                        u32x2 w; w.x = cvt_pk_bf16(av[0] + bflo(rr.x), av[1] + bfhi(rr.x)); w.y = cvt_pk_bf16(av[2] + bflo(rr.y), av[3] + bfhi(rr.y));
                        *(GAS u32x2*)(qy + t * 64 + 16 * ta + 4 * fq) = w;
                    } else {
                        u32x2 w; w.x = cvt_pk_bf16(av[0], av[1]); w.y = cvt_pk_bf16(av[2], av[3]); *(GAS u32x2*)((bf16_t*)y0t + (16 * tb + fr) * 64 + 16 * ta + 4 * fq) = w;
                    }
                }
        }
    }
    LDS_BARRIER();
}
DI void scan_w2(const Ctx& F, const RwPar& Q) {
    unsigned char* const wsl = F.ws; const int lane = F.lane, fr = lane & 15, fq = lane >> 4;
    LAS float* yb = (LAS float*)(F.lds + F.wave * 16384);
    const bf16_t* gate = (const bf16_t*)(wsl + WS_GATE); const bf16_t* Eb = (const bf16_t*)(wsl + WS_E); bf16_t* cat = (bf16_t*)(wsl + WS_CAT);
    for (int u = F.gw; u < 96 * NCH; u += F.ngw) {
        const int bh = u % 96, c = u / 96, b = bh / 24, head = bh - b * 24, tokb = b * SEQ + c * CH;
        const bf16_t* qy = (const bf16_t*)(wsl + WS_QY) + (size_t)u * 4096; const float* y0t = (const float*)(wsl + WS_Y0T) + (size_t)u * 4096;
        u32x2 yv[4][4];
#pragma unroll
        for (int tt = 0; tt < 4; ++tt)
#pragma unroll
            for (int it = 0; it < 4; ++it) yv[tt][it] = *(const GAS u32x2*)((const bf16_t*)y0t + (16 * it + fr) * 64 + 16 * tt + 4 * fq);
        const bf16_t* sp = (const bf16_t*)gh_ptr(wsl, bh, c > 0 ? c - 1 : 0, 0) + 4096;
        bf16x8 Bf[4][2], Af[4][2];
#pragma unroll
        for (int it = 0; it < 4; ++it)
#pragma unroll
            for (int ks = 0; ks < 2; ++ks) Bf[it][ks] = *(const GAS bf16x8*)(sp + (16 * it + fr) * 64 + 32 * ks + 8 * fq);
#pragma unroll
        for (int tt = 0; tt < 4; ++tt)
#pragma unroll
            for (int ks = 0; ks < 2; ++ks) Af[tt][ks] = *(const GAS bf16x8*)(qy + (16 * tt + fr) * 64 + 32 * ks + 8 * fq);
        f32x4 acc[4][4];
#pragma unroll
        for (int tt = 0; tt < 4; ++tt)
#pragma unroll
            for (int it = 0; it < 4; ++it) acc[tt][it] = (f32x4){bflo(yv[tt][it].x), bfhi(yv[tt][it].x), bflo(yv[tt][it].y), bfhi(yv[tt][it].y)};
        if (c > 0) {
#pragma unroll
            for (int tt = 0; tt < 4; ++tt)
#pragma unroll
                for (int ks = 0; ks < 2; ++ks)
#pragma unroll
                    for (int it = 0; it < 4; ++it) acc[tt][it] = __builtin_amdgcn_mfma_f32_16x16x32_bf16(Af[tt][ks], Bf[it][ks], acc[tt][it], 0, 0, 0);
        }
#pragma unroll
        for (int tt = 0; tt < 4; ++tt)
#pragma unroll
            for (int it = 0; it < 4; ++it)
#pragma unroll
                for (int r = 0; r < 4; ++r) yb[(16 * tt + 4 * fq + r) * 64 + 16 * it + fr] = acc[tt][it][r];
        const int c4 = head * 64 + 4 * (lane & 15);
        const f32x4 g4 = *(const GAS f32x4*)(Q.gng + c4), b4 = *(const GAS f32x4*)(Q.gnb + c4);
        u32x2 evs[16], gts[16];
#pragma unroll
        for (int k = 0; k < 16; ++k) { const int tok = tokb + 4 * k + (lane >> 4); evs[k] = *(const GAS u32x2*)(Eb + (size_t)tok * CMIX + c4); gts[k] = *(const GAS u32x2*)(gate + (size_t)tok * CMIX + c4); }
        LDS_WAIT();
#pragma unroll
        for (int k = 0; k < 16; ++k) {
            const int slot = k * 64 + lane, t = slot >> 4, li = slot & 15, tok = tokb + t;
            const f32x4 y = *(const LAS f32x4*)(yb + t * 64 + 4 * li);
            const u32x2 ev = evs[k], gt = gts[k];
            const float mean = sum16(y.x + y.y + y.z + y.w) * (1.f / 64.f);
            const f32x4 d = y - mean;
            const float var = sum16(d.x * d.x + d.y * d.y + d.z * d.z + d.w * d.w) * (1.f / 64.f);
            const float rstd = rsqrtf(var + GN_EPS);
            f32x4 o = d * rstd * g4 + b4; o.x += bflo(ev.x); o.y += bfhi(ev.x); o.z += bflo(ev.y); o.w += bfhi(ev.y);
            u32x2 w; w.x = cvt_pk_bf16(o.x * bflo(gt.x), o.y * bfhi(gt.x)); w.y = cvt_pk_bf16(o.z * bflo(gt.y), o.w * bfhi(gt.y));
            *(GAS u32x2*)(cat + (size_t)tok * DM + c4) = w;
        }
        LDS_WAIT();
    }
}
DI void scan_passB(const Ctx& F) {
    unsigned char* const wsl = F.ws; const int lane = F.lane, fr = lane & 15, fq = lane >> 4, ih = F.wave >> 2, q = F.wave & 3, bh = F.bid;
    LAS unsigned char* Sx0 = F.lds;
    bf16x8 ga[9][2]; u32x2 hq[9][2];
#define PB_LOAD(set, cc) do { const GAS bf16_t* _gp = (const GAS bf16_t*)gh_ptr(wsl, bh, (cc), 0) + (16 * q + fr) * 64 + 8 * fq; const GAS bf16_t* _hp = (const GAS bf16_t*)gh_ptr(wsl, bh, (cc), 1) + (32 * ih + fr) * 64 + 16 * q + 4 * fq; \
        ga[set][0] = *(const GAS bf16x8*)_gp; ga[set][1] = *(const GAS bf16x8*)(_gp + 32); \
        _Pragma("unroll") for (int _r = 0; _r < 2; ++_r) hq[set][_r] = *(const GAS u32x2*)(_hp + (16 * _r) * 64); } while (0)
    PB_LOAD(0, 0); PB_LOAD(1, 1); PB_LOAD(2, 2); PB_LOAD(3, 3); PB_LOAD(4, 4); PB_LOAD(5, 5); PB_LOAD(6, 6); PB_LOAD(7, 7);
    for (int c7 = 0; c7 < NCH - 1; c7 += 9) {
#pragma unroll
        for (int u7 = 0; u7 < 9; ++u7) {
            const int c = c7 + u7;
            f32x4 acc[2];
#pragma unroll
            for (int it = 0; it < 2; ++it) acc[it] = (f32x4){bflo(hq[u7][it].x), bfhi(hq[u7][it].x), bflo(hq[u7][it].y), bfhi(hq[u7][it].y)};
            const bf16x8 a0 = ga[u7][0], a1 = ga[u7][1];
            PB_LOAD((u7 + 8) % 9, (c + 8 < NCH - 1) ? c + 8 : NCH - 2);
            if (c > 0) {
#pragma unroll
                for (int it = 0; it < 2; ++it) {
                    acc[it] = __builtin_amdgcn_mfma_f32_16x16x32_bf16(a0, *(const LAS bf16x8*)(Sx0 + (c & 1) * W_SLOT + (32 * ih + 16 * it + fr) * WRS + fq * 16), acc[it], 0, 0, 0);
                    acc[it] = __builtin_amdgcn_mfma_f32_16x16x32_bf16(a1, *(const LAS bf16x8*)(Sx0 + (c & 1) * W_SLOT + (32 * ih + 16 * it + fr) * WRS + 64 + fq * 16), acc[it], 0, 0, 0); }
            }
            GAS bf16_t* op = (GAS bf16_t*)gh_ptr(wsl, bh, c, 0) + 4096 + (32 * ih + fr) * 64 + 16 * q + 4 * fq;
#pragma unroll
            for (int it = 0; it < 2; ++it) { u32x2 w; w.x = cvt_pk_bf16(acc[it].x, acc[it].y); w.y = cvt_pk_bf16(acc[it].z, acc[it].w);
                *(GAS u32x2*)(op + (16 * it) * 64) = w; *(LAS u32x2*)(Sx0 + ((c + 1) & 1) * W_SLOT + (32 * ih + 16 * it + fr) * WRS + (16 * q + 4 * fq) * 2) = w; }
            LDS_BARRIER();
        }
    }
#undef PB_LOAD
}

DI void ln1_router(const Ctx& F, const Params& P, int l, const float* xin) {
    unsigned char* const wsl = F.ws; float* const outl = F.out; (void)outl;
    const float* g = PIN(5) + (size_t)l * DM; const float* bta = PIN(6) + (size_t)l * DM;
    const float* gb = PIN(10) + l * 4; const float* eb = PIN(12) + l * 32;
    const bf16_t* hb = (const bf16_t*)(wsl + WS_HB); bf16_t* xb = (bf16_t*)(wsl + WS_XB); float* xo = outl;
    const bf16_t* wrt = (const bf16_t*)(wsl + WS_WSW + (size_t)l * WSW_STRIDE);
    unsigned* cnt = (unsigned*)(wsl + WS_CTL) + CW_CNT + l * 32 * 64;
    int* ltok = (int*)(wsl + WS_LTOK); float* lgate = (float*)(wsl + WS_LGATE); int* lslot = (int*)(wsl + WS_LSLOT);
    const int lane = F.lane, fr = lane & 15, fq = lane >> 4, wave = F.wave;
    LAS float* lg = (LAS float*)(F.lds + (wave & 3) * 4096);
    LAS float* lgp = (LAS float*)(F.lds + 16384 + (wave & 3) * 4096);
    LAS int* cntl = (LAS int*)(F.lds + 32768); LAS int* basel = cntl + 32;
    if (F.tid < NEXP) cntl[F.tid] = 0;
    __syncthreads();
    LAS float* gls = (LAS float*)(F.lds + 36864 + 52224); LAS float* bls = gls + DM;
    for (int blk = F.bid; blk < NTOK / 64; blk += F.G) {
        { const f32x4 gv = *(const GAS f32x4*)(g + 4 * F.tid), bv = *(const GAS f32x4*)(bta + 4 * F.tid); *(LAS f32x4*)(gls + 4 * F.tid) = gv; *(LAS f32x4*)(bls + 4 * F.tid) = bv; }
        __syncthreads();
#pragma unroll 1
        for (int pass = 0; pass < 4; ++pass) {
            int lno = lane; asm volatile("" : "+v"(lno));
            const int hr2 = lno >> 5, l32 = lno & 31;
            const size_t ro = (size_t)(blk * 64 + wave * 8 + pass * 2 + hr2) * DM + 8 * l32;
            u32x4 xr[8], hr[8];
#pragma unroll
            for (int i = 0; i < 8; ++i) { xr[i] = *(const GAS u32x4*)(xb + ro + 256 * i); hr[i] = *(const GAS u32x4*)(hb + ro + 256 * i); }
            float s = 0.f, s2 = 0.f;
#pragma unroll
            for (int i = 0; i < 8; ++i) {
#pragma unroll
                for (int e = 0; e < 4; ++e) { const float v0 = ALPHA * bflo(xr[i][e]) + bflo(hr[i][e]), v1 = ALPHA * bfhi(xr[i][e]) + bfhi(hr[i][e]); s += v0 + v1; s2 += v0 * v0 + v1 * v1; } }
            s = sum16(s); s2 = sum16(s2); s += __shfl_xor(s, 16); s2 += __shfl_xor(s2, 16);
            const float mean = s * (1.f / DM), rstd = rsqrtf(fmaxf(s2 * (1.f / DM) - mean * mean, 0.f) + LN_EPS);
#pragma unroll
            for (int i = 0; i < 8; ++i) { const int col = 256 * i + 8 * l32;
                const f32x4 g0 = *(const LAS f32x4*)(gls + col), g1 = *(const LAS f32x4*)(gls + col + 4), b0 = *(const LAS f32x4*)(bls + col), b1 = *(const LAS f32x4*)(bls + col + 4);
                u32x4 w;
#pragma unroll
                for (int e = 0; e < 4; ++e) { const float v0 = ALPHA * bflo(xr[i][e]) + bflo(hr[i][e]), v1 = ALPHA * bfhi(xr[i][e]) + bfhi(hr[i][e]);
                    const float gg0 = e < 2 ? g0[2 * e] : g1[2 * e - 4], gg1 = e < 2 ? g0[2 * e + 1] : g1[2 * e - 3], bb0 = e < 2 ? b0[2 * e] : b1[2 * e - 4], bb1 = e < 2 ? b0[2 * e + 1] : b1[2 * e - 3];
                    w[e] = cvt_pk_bf16((v0 - mean) * rstd * gg0 + bb0, (v1 - mean) * rstd * gg1 + bb1); }
                *(GAS u32x4*)(xb + ro + 256 * i) = w;
                asm volatile("" ::: "memory"); }
        }
        VM_WAIT();
        __syncthreads();
        __builtin_amdgcn_fence(__ATOMIC_ACQUIRE, "agent");
        VM_WAIT();
        const int row0 = blk * 64 + (wave & 3) * 16, kh = wave >> 2, krot = (F.bid * 5 + wave * 3) & 31;
        f32x4 acc[3];
#pragma unroll
        for (int ct = 0; ct < 3; ++ct) acc[ct] = (f32x4){0.f, 0.f, 0.f, 0.f};
        const bf16_t* arow = xb + (size_t)(row0 + fr) * DM + 8 * fq + kh * 1024;
        LAS unsigned char* wst = F.lds + 36864;
        u32x4 wreg[6];
        { const int st = F.bid & 7;
#pragma unroll
          for (int i = 0; i < 6; ++i) { const int ch = F.tid + NT * i, row = ch >> 4, c16 = ch & 15, rkh = row / 96, rr = row - rkh * 96;
              wreg[i] = *(const GAS u32x4*)(wrt + (size_t)rr * DM + rkh * 1024 + st * 128 + c16 * 8); } }
        bf16x8 af[4];
#pragma unroll
        for (int ksl = 0; ksl < 4; ++ksl) af[ksl] = *(const GAS bf16x8*)(arow + (F.bid & 7) * 128 + ksl * 32);
#pragma unroll 1
        for (int si = 0; si < 8; ++si) {
            LAS unsigned char* wb = wst + (si & 1) * 52224;
#pragma unroll
            for (int i = 0; i < 6; ++i) { const int ch = F.tid + NT * i, row = ch >> 4, c16 = ch & 15; *(LAS u32x4*)(wb + row * 272 + c16 * 16) = wreg[i]; }
            if (si + 1 < 8) { const int stn = (si + 1 + F.bid) & 7;
#pragma unroll
                for (int i = 0; i < 6; ++i) { const int ch = F.tid + NT * i, row = ch >> 4, c16 = ch & 15, rkh = row / 96, rr = row - rkh * 96;
                    wreg[i] = *(const GAS u32x4*)(wrt + (size_t)rr * DM + rkh * 1024 + stn * 128 + c16 * 8); } }
            bf16x8 afn[4];
            { const int stn = (si + 1 + F.bid) & 7;
#pragma unroll
              for (int ksl = 0; ksl < 4; ++ksl) afn[ksl] = *(const GAS bf16x8*)(arow + stn * 128 + ksl * 32); }
            LDS_BARRIER();
#pragma unroll
            for (int ksl = 0; ksl < 4; ++ksl)
#pragma unroll
                for (int ct = 0; ct < 3; ++ct) {
                    acc[ct] = __builtin_amdgcn_mfma_f32_16x16x32_bf16(af[ksl], *(const LAS bf16x8*)(wb + (kh * 96 + 16 * ct + fr) * 272 + ksl * 64 + fq * 16), acc[ct], 0, 0, 0);
                    acc[ct] = __builtin_amdgcn_mfma_f32_16x16x32_bf16(af[ksl], *(const LAS bf16x8*)(wb + (kh * 96 + 48 + 16 * ct + fr) * 272 + ksl * 64 + fq * 16), acc[ct], 0, 0, 0);
                }
#pragma unroll
            for (int ksl = 0; ksl < 4; ++ksl) af[ksl] = afn[ksl];
        }
        if (kh == 1) {
#pragma unroll
            for (int ct = 0; ct < 3; ++ct)
#pragma unroll
                for (int jj = 0; jj < 4; ++jj) lgp[(4 * fq + jj) * 48 + 16 * ct + fr] = acc[ct][jj];
        }
        __syncthreads();
        if (kh == 0) {
#pragma unroll
            for (int ct = 0; ct < 3; ++ct)
#pragma unroll
                for (int jj = 0; jj < 4; ++jj) lg[(4 * fq + jj) * 48 + 16 * ct + fr] = acc[ct][jj] + lgp[(4 * fq + jj) * 48 + 16 * ct + fr];
        }
        LDS_WAIT();
        int se0 = 0, se1 = 0, sr0 = 0, sr1 = 0, stok = 0; float sg0 = 0.f, sg1 = 0.f;
        if (kh == 0 && lane < 16) {
            const LAS float* L = lg + lane * 48; const int tok = row0 + lane;
            float gl[4]; int grp_i = 0; float gmx;
#pragma unroll
            for (int q = 0; q < 4; ++q) gl[q] = L[q] + gb[q];
            gmx = gl[0];
#pragma unroll
            for (int q = 1; q < 4; ++q) if (gl[q] > gmx) { gmx = gl[q]; grp_i = q; }
            float gs = 0.f;
#pragma unroll
            for (int q = 0; q < 4; ++q) gs += __expf(gl[q] - gmx);
            const float pg = 1.f / gs;
            float el[8];
#pragma unroll
            for (int q = 0; q < 8; ++q) el[q] = L[4 + 8 * grp_i + q] + eb[8 * grp_i + q];
            int i0 = 0; float m0 = el[0];
#pragma unroll
            for (int q = 1; q < 8; ++q) if (el[q] > m0) { m0 = el[q]; i0 = q; }
            int i1 = -1; float m1 = -3.0e38f;
#pragma unroll
            for (int q = 0; q < 8; ++q) if (q != i0 && el[q] > m1) { m1 = el[q]; i1 = q; }
            if (i1 < 0) { i1 = (i0 == 0) ? 1 : 0; m1 = m0; }
            const float p1 = __expf(m1 - m0), den = 1.f / (1.f + p1);
            const float g0 = pg * den, g1 = pg * p1 * den;
            se0 = grp_i * 8 + i0; se1 = grp_i * 8 + i1; sg0 = g0; sg1 = g1; stok = tok;
            sr0 = __hip_atomic_fetch_add(cntl + se0, 1, __ATOMIC_RELAXED, __HIP_MEMORY_SCOPE_WORKGROUP);
            sr1 = __hip_atomic_fetch_add(cntl + se1, 1, __ATOMIC_RELAXED, __HIP_MEMORY_SCOPE_WORKGROUP);
        }
        __syncthreads();
        if (wave == 0 && lane < NEXP) { const int n = cntl[lane]; basel[lane] = n ? (int)__hip_atomic_fetch_add(cnt + lane * 64, (unsigned)n, __ATOMIC_RELAXED, __HIP_MEMORY_SCOPE_AGENT) : 0; }
        __syncthreads();
        if (kh == 0 && lane < 16) {
            const int pos0 = basel[se0] + sr0, pos1 = basel[se1] + sr1;
            ltok[se0 * LISTCAP + pos0] = stok; lgate[se0 * LISTCAP + pos0] = sg0; lslot[se0 * LISTCAP + pos0] = 2 * stok;
            ltok[se1 * LISTCAP + pos1] = stok; lgate[se1 * LISTCAP + pos1] = sg1; lslot[se1 * LISTCAP + pos1] = 2 * stok + 1;
        }
        __syncthreads();
        if (F.tid < NEXP) cntl[F.tid] = 0;
        __syncthreads();
    }
}

DI void ln2_phase(const Ctx& F, const Params& P, int l) {
    unsigned char* const wsl = F.ws; float* const outl = F.out;
    const float* g = PIN(7) + (size_t)l * DM; const float* bta = PIN(8) + (size_t)l * DM;
    const bf16_t* ys = (const bf16_t*)(wsl + WS_YS); bf16_t* xb = (bf16_t*)(wsl + WS_XB); float* xo = outl;
    LAS float* gls = (LAS float*)F.lds; LAS float* bls = gls + DM;
    { const f32x4 gv = *(const GAS f32x4*)(g + 4 * F.tid), bv = *(const GAS f32x4*)(bta + 4 * F.tid); *(LAS f32x4*)(gls + 4 * F.tid) = gv; *(LAS f32x4*)(bls + 4 * F.tid) = bv; }
    __syncthreads();
#pragma unroll 1
    for (int rp = F.gw; rp < NTOK / 2; rp += F.ngw) {
        int lno = F.lane; asm volatile("" : "+v"(lno));
        const int hr2 = lno >> 5, l32 = lno & 31, row = 2 * rp + hr2;
        const size_t ro = (size_t)row * DM + 8 * l32;
        u32x4 xr[8], y0[8], y1[8];
#pragma unroll
        for (int i = 0; i < 8; ++i) { xr[i] = *(const GAS u32x4*)(xb + ro + 256 * i); y0[i] = *(const GAS u32x4*)(ys + 2 * (size_t)row * DM + 8 * l32 + 256 * i); y1[i] = *(const GAS u32x4*)(ys + (2 * (size_t)row + 1) * DM + 8 * l32 + 256 * i); }
        float s = 0.f, s2 = 0.f;
#pragma unroll
        for (int i = 0; i < 8; ++i) {
#pragma unroll
            for (int e = 0; e < 4; ++e) { const float v0 = ALPHA * bflo(xr[i][e]) + (bflo(y0[i][e]) + bflo(y1[i][e])), v1 = ALPHA * bfhi(xr[i][e]) + (bfhi(y0[i][e]) + bfhi(y1[i][e])); s += v0 + v1; s2 += v0 * v0 + v1 * v1; } }
        s = sum16(s); s2 = sum16(s2); s += __shfl_xor(s, 16); s2 += __shfl_xor(s2, 16);
        const float mean = s * (1.f / DM), rstd = rsqrtf(fmaxf(s2 * (1.f / DM) - mean * mean, 0.f) + LN_EPS);
#pragma unroll
        for (int i = 0; i < 8; ++i) { const int col = 256 * i + 8 * l32;
            const f32x4 g0 = *(const LAS f32x4*)(gls + col), g1 = *(const LAS f32x4*)(gls + col + 4), b0 = *(const LAS f32x4*)(bls + col), b1 = *(const LAS f32x4*)(bls + col + 4);
            float o[8];
#pragma unroll
            for (int e = 0; e < 4; ++e) { const float v0 = ALPHA * bflo(xr[i][e]) + (bflo(y0[i][e]) + bflo(y1[i][e])), v1 = ALPHA * bfhi(xr[i][e]) + (bfhi(y0[i][e]) + bfhi(y1[i][e]));
                const float gg0 = e < 2 ? g0[2 * e] : g1[2 * e - 4], gg1 = e < 2 ? g0[2 * e + 1] : g1[2 * e - 3], bb0 = e < 2 ? b0[2 * e] : b1[2 * e - 4], bb1 = e < 2 ? b0[2 * e + 1] : b1[2 * e - 3];
                o[2 * e] = (v0 - mean) * rstd * gg0 + bb0; o[2 * e + 1] = (v1 - mean) * rstd * gg1 + bb1; }
            if (l == NLAYER - 1) { *(GAS f32x4*)(xo + (size_t)row * DM + col) = (f32x4){o[0], o[1], o[2], o[3]}; *(GAS f32x4*)(xo + (size_t)row * DM + col + 4) = (f32x4){o[4], o[5], o[6], o[7]}; }
            else { u32x4 w; w.x = cvt_pk_bf16(o[0], o[1]); w.y = cvt_pk_bf16(o[2], o[3]); w.z = cvt_pk_bf16(o[4], o[5]); w.w = cvt_pk_bf16(o[6], o[7]); *(GAS u32x4*)(xb + ro + 256 * i) = w; }
            asm volatile("" ::: "memory"); }
    }
}

DI int moe_table(const Ctx& F, int l) {
    unsigned char* const wsl = F.ws; float* const outl = F.out; (void)outl;
    LAS int* tb = (LAS int*)(F.lds + LDS_CTL_OFF) + 16;
    const unsigned* cnt = (const unsigned*)(wsl + WS_CTL) + CW_CNT + l * 32 * 64;
    __syncthreads();
    if (F.wave == 0) {
        const int e = F.lane; int nt = 0;
        if (e < NEXP) { const int n = (int)__hip_atomic_load(cnt + e * 64, __ATOMIC_RELAXED, __HIP_MEMORY_SCOPE_AGENT); nt = (n + 255) >> 8; }
        int incl = nt;
#pragma unroll
        for (int d = 1; d < 32; d <<= 1) { const int v = __shfl_up(incl, d); if (e >= d) incl += v; }
        if (e < NEXP) tb[e] = incl - nt;
        if (e == NEXP - 1) tb[NEXP] = incl;
    }
    __syncthreads();
    return tb[NEXP];
}


#ifdef MK_DEBUG
constexpr int CW_DBG = 40960;
DI void dbg_count_bf16(const Ctx& F, const bf16_t* p, size_t n, int k) {
    unsigned bad = 0; const size_t gt = (size_t)F.bid * NT + F.tid, ngt = (size_t)F.G * NT;
    for (size_t i = gt; i < n; i += ngt) { const unsigned b = p[i]; const float v = bf2f(b); if ((b & 0x7f80u) == 0x7f80u || fabsf(v) > 1.0e6f) ++bad; }
    if (bad) atomicAdd((unsigned*)(F.ws + WS_CTL) + CW_DBG + k * 64, bad);
}
DI void dbg_count_f32(const Ctx& F, const float* p, size_t n, int k) {
    unsigned bad = 0; const size_t gt = (size_t)F.bid * NT + F.tid, ngt = (size_t)F.G * NT;
    for (size_t i = gt; i < n; i += ngt) { const float v = p[i]; if (!(fabsf(v) <= 1.0e6f)) ++bad; }
    if (bad) atomicAdd((unsigned*)(F.ws + WS_CTL) + CW_DBG + k * 64, bad);
}
#endif
constexpr int PH_PER_LAYER = 11, N_PHASES = 1 + NLAYER * PH_PER_LAYER;

__global__ void __launch_bounds__(NT, 2) mega_fwd(Params P) {
    extern __shared__ __attribute__((aligned(16))) unsigned char lds_raw[];
    Ctx F0;
    F0.lds = (LAS unsigned char*)lds_raw;
    F0.tid = threadIdx.x; F0.lane = F0.tid & 63; F0.wave = __builtin_amdgcn_readfirstlane(F0.tid >> 6);
    F0.G = gridDim.x; F0.bid = blockIdx.x; F0.gw = F0.bid * NWAVES + F0.wave; F0.ngw = F0.G * NWAVES;
    F0.ws = P.ws; F0.out = P.out;
    for (int u = F0.tid; u < (LDS_BYTES - LDS_CTL_OFF) / 4; u += NT) ((LAS unsigned*)(F0.lds + LDS_CTL_OFF))[u] = 0u;
    __syncthreads();
    if (F0.tid < 31) *(LAS unsigned long long*)(F0.lds + LDS_KARG_OFF + F0.tid * 8) = *(const unsigned long long*)((const char*)__builtin_amdgcn_kernarg_segment_ptr() + F0.tid * 8);
    __syncthreads();
    XcdBarrier bar; bar.bar = (unsigned*)(F0.ws + WS_CTL) + CW_BAR; bar.x = 0; bar.st = nullptr;
#if !MK_PER_PHASE
    bar = xcd_barrier_post((unsigned*)(F0.ws + WS_CTL) + CW_BAR, (volatile LAS unsigned*)(F0.lds + LDS_CTL_OFF));
#endif
    const int lo = P.ph_lo, hi = P.ph_hi;
#define IN(k) (lo <= (k) && (k) < hi)
#if MK_PER_PHASE
#define SEAM(k) do { } while (0)
#else
#define SEAM(k) do { if ((k) + 1 < hi) { XcdBarrier _b = bar; asm volatile("" : "+s"(_b.bar), "+s"(_b.x)); xcd_barrier(_b); } } while (0)
#endif
#define WSL const Ctx F = relaunder(F0); unsigned char* const ws = F.ws; bf16_t* const xb = (bf16_t*)(ws + WS_XB); bf16_t* const zb = (bf16_t*)(ws + WS_Z); bf16_t* const cat = (bf16_t*)(ws + WS_CAT); (void)xb; (void)zb; (void)cat

    if (IN(0)) { WSL; phase_prologue(F, P); SEAM(0); }

    for (int l = 0; l < NLAYER; ++l) {
        const int kind = l % 3, j = l / 3, pb = 1 + l * PH_PER_LAYER;
        const int zw = (kind == 0) ? ZW_RWKV : ZW_OTH, qcol = (kind == 0) ? 5056 : 4608;
        if (IN(pb + 0)) {
            WSL; const bf16_t* winT = (const bf16_t*)(ws + WS_WIN + (size_t)l * WIN_STRIDE);
            if (kind != 2) dense_gemm(F, xb, DM, winT, DM, NTOK, zw, DM, zb, zw, 0);
            else {
                dense_gemm(F, xb, DM, winT, DM, NTOK, 3072, DM, zb, zw, 0);
                dense_gemm(F, xb, DM, winT + (size_t)4608 * DM, DM, NTOK, 512, DM, zb + 4608, zw, 0);
                dense_gemm(F, winT + (size_t)3072 * DM, DM, xb, DM, CMIX, NTOK, DM, (bf16_t*)(ws + WS_ACT), NTOK, 128);
            }
            if (l == 0) {
                dense_gemm(F, (const bf16_t*)(ws + WS_MEMB), DM, (const bf16_t*)(ws + WS_WK), DM, NBATCH * MEML, 2048, DM, (bf16_t*)(ws + WS_KM), 2048, 128);
                dense_gemm(F, (const bf16_t*)(ws + WS_WV), DM, (const bf16_t*)(ws + WS_MEMB), DM, 2048, NBATCH * MEML, DM, (bf16_t*)(ws + WS_VMT), 1024, 64);
            }
            if (kind == 0 && F.bid >= 128 && (l != 0 || (F.bid & 63) >= 32)) {
                const int hid = (l != 0) ? F.bid - 128 : ((F.bid - 128) >> 6) * 32 + (F.bid & 31), nh = (l != 0) ? 128 : 64;
                expert_convert(F, P, l, hid * NWAVES + F.wave, nh * NWAVES, 0, l == 0 ? EXP_EARLY0 : EXP_EARLY3);
            }
            SEAM(pb + 0);
        }
        if (IN(pb + 1)) {
            WSL;
            if (kind == 0) { for (int rep = 0; rep < REP_PREP; ++rep) rwkv_prep1(F, P, j, zb); for (int rep = 0; rep < REP_MIX * REP_MA; ++rep) memattn_all(F, l, zb, zw, qcol); }
            else if (kind == 1) { for (int rep = 0; rep < REP_MIX; ++rep) conv_mix(F, P, zb); for (int rep = 0; rep < REP_MIX * REP_MA; ++rep) memattn_all(F, l, zb, zw, qcol); for (int rep = 0; rep < REP_CONV; ++rep) expert_convert(F, P, l, F.gw, F.ngw, 0, EXP_ITEMS); }
            else { for (int rep = 0; rep < REP_MIX * REP_SB; ++rep) sb_attention(F, zb); for (int rep = 0; rep < REP_MIX * REP_MA; ++rep) memattn_all(F, l, zb, zw, qcol); for (int rep = 0; rep < REP_CONV; ++rep) expert_convert(F, P, l, F.gw, F.ngw, 0, EXP_ITEMS); }
            SEAM(pb + 1);
        }
        if (kind == 0) {
            if (IN(pb + 2)) {
                WSL; const bf16_t* act = (const bf16_t*)(ws + WS_ACT); const bf16_t* wa = (const bf16_t*)(ws + WS_LORA + (size_t)j * LORA_STRIDE);
                dense_gemm(F, act, 512, wa, 256, NTOK, 3072, 256, (bf16_t*)(ws + WS_LW), 3072, 0);
                dense_gemm(F, act + 256, 512, wa + (size_t)3072 * 256, 256, NTOK, CMIX, 256, (bf16_t*)(ws + WS_GATE), CMIX, 0);
                SEAM(pb + 2);
            }
            if (IN(pb + 3)) { WSL; const RwPar Q{PIN(17) + (size_t)j * 5056, PIN(18) + j * CMIX, PIN(20) + j * CMIX, PIN(23) + j * CMIX, PIN(24) + j * CMIX, PIN(25) + j * CMIX, PIN(26) + j * CMIX, PIN(27) + j * CMIX};
                for (int rep = 0; rep < REP_SCAN; ++rep) scan_w1(F, Q, zb); SEAM(pb + 3); }
            if (IN(pb + 4)) {
                WSL;
                if (F.bid < 96) scan_passB(F);
                else expert_convert(F, P, l, (F.bid - 96) * NWAVES + F.wave, (F.G - 96) * NWAVES, l == 0 ? EXP_EARLY0 : EXP_EARLY3, EXP_ITEMS);
                SEAM(pb + 4);
            }
            if (IN(pb + 5)) { WSL; const RwPar Q{PIN(17) + (size_t)j * 5056, PIN(18) + j * CMIX, PIN(20) + j * CMIX, PIN(23) + j * CMIX, PIN(24) + j * CMIX, PIN(25) + j * CMIX, PIN(26) + j * CMIX, PIN(27) + j * CMIX};
                for (int rep = 0; rep < REP_SCAN * REP_W2; ++rep) scan_w2(F, Q); SEAM(pb + 5); }
        }
        if (IN(pb + 6)) { WSL; dense_gemm(F, cat, DM, (const bf16_t*)(ws + WS_WOUT) + (size_t)l * DM * DM, DM, NTOK, DM, DM, (bf16_t*)(ws + WS_HB), DM, 0); SEAM(pb + 6); }
        if (IN(pb + 7)) { WSL; ln1_router(F, P, l, l == 0 ? PIN(0) : (const float*)P.out); SEAM(pb + 7); }
        if (IN(pb + 8)) {
            WSL; const int ntiles = moe_table(F, l);
            pg8::Gemm g{xb, (const bf16_t*)(ws + WS_EXP1), DM, DM, DM};
            pg8::MoeOrder<true> S; S.G = F.G; S.c = F.bid; S.npn = 4; S.total = ntiles * 4; S.tb = (const LAS int*)(F.lds + LDS_CTL_OFF) + 16; S.estride = (size_t)1024 * DM * 2;
            S.ltok = (const int*)(ws + WS_LTOK); S.cnt = (const unsigned*)(ws + WS_CTL) + CW_CNT + l * 32 * 64;
            pg8::EpiSwiGLU E{(bf16_t*)(ws + WS_HE)};
            for (int rep = 0; rep < REP_MOE; ++rep) pg8::gemm_phase<pg8::EpiSwiGLU, pg8::MoeOrder<true>>(F.lds, g, S, E);
            SEAM(pb + 8);
        }
        if (IN(pb + 9)) {
            WSL; const int ntiles = moe_table(F, l);
            pg8::Gemm g{(const bf16_t*)(ws + WS_HE), (const bf16_t*)(ws + WS_EXP2), DEXP, DEXP, DEXP};
            pg8::MoeOrder<false> S; S.G = F.G; S.c = F.bid; S.npn = 8; S.total = ntiles * 8; S.tb = (const LAS int*)(F.lds + LDS_CTL_OFF) + 16; S.estride = (size_t)DM * DEXP * 2;
            S.ltok = (const int*)(ws + WS_LTOK); S.cnt = (const unsigned*)(ws + WS_CTL) + CW_CNT + l * 32 * 64;
            pg8::EpiScatter E{(bf16_t*)(ws + WS_YS), (const int*)(ws + WS_LSLOT), (const float*)(ws + WS_LGATE), S.cnt};
            for (int rep = 0; rep < REP_MOE; ++rep) pg8::gemm_phase<pg8::EpiScatter, pg8::MoeOrder<false>>(F.lds, g, S, E);
            SEAM(pb + 9);
        }
        if (IN(pb + 10)) { WSL; ln2_phase(F, P, l); SEAM(pb + 10); }
    }
#ifdef MK_DEBUG
    {
        WSL;
        xcd_barrier(bar);
        dbg_count_bf16(F, (const bf16_t*)(ws + WS_CAT), (size_t)NTOK * DM, 0);
        dbg_count_bf16(F, (const bf16_t*)(ws + WS_HB), (size_t)NTOK * DM, 1);
        dbg_count_f32(F, (const float*)(ws + WS_LGATE), (size_t)32 * 16384, 2);
        dbg_count_bf16(F, (const bf16_t*)(ws + WS_YS), (size_t)32768 * 2048, 3);
        dbg_count_f32(F, (const float*)F.out, (size_t)NTOK * DM, 4);
        dbg_count_bf16(F, (const bf16_t*)(ws + WS_XB), (size_t)NTOK * DM, 5);
        xcd_barrier(bar);
        int first = 13;
        for (int k = 12; k >= 0; --k) if (__hip_atomic_load((unsigned*)(ws + WS_CTL) + CW_DBG + k * 64, __ATOMIC_RELAXED, __HIP_MEMORY_SCOPE_AGENT) != 0u) first = k;
        const float val = 1000.f * (float)(first + 1);
        for (size_t i = (size_t)F.bid * NT + F.tid; i < (size_t)NTOK * DM; i += (size_t)F.G * NT) F.out[i] = val;
    }
#endif
#undef IN
#undef SEAM
}

extern "C" void kernel_launch(void* const* d_in, const int* in_sizes, int n_in, void* d_out, int out_size, void* d_ws, size_t ws_size, hipStream_t stream) {
    static int grid = 0;
    if (grid == 0) {
        if (n_in != 31 || ws_size < WS_END) { fprintf(stderr, "kernel_launch: expected 31 inputs and >= %zu bytes of workspace, got %d / %zu\n", (size_t)WS_END, n_in, ws_size); grid = -1; return; }
        int dev = 0, cus = 0, per_cu = 0;
        if (hipGetDevice(&dev) != hipSuccess || hipDeviceGetAttribute(&cus, hipDeviceAttributeMultiprocessorCount, dev) != hipSuccess) { grid = -1; return; }
        if (hipFuncSetAttribute((const void*)mega_fwd, hipFuncAttributeMaxDynamicSharedMemorySize, LDS_BYTES) != hipSuccess) { fprintf(stderr, "kernel_launch: hipFuncSetAttribute failed\n"); grid = -1; return; }
        if (hipOccupancyMaxActiveBlocksPerMultiprocessor(&per_cu, (const void*)mega_fwd, NT, LDS_BYTES) != hipSuccess || per_cu < 1)
            fprintf(stderr, "kernel_launch: occupancy query reports %d workgroups per CU\n", per_cu);
        (void)hipGetLastError();
        grid = cus;
    }
    if (grid < 0) return;
    (void)hipMemsetAsync((char*)d_ws + WS_CTL, 0, CTL_BYTES, stream);
    Params p{};
    for (int i = 0; i < 31; ++i) p.in[i] = (const float*)d_in[i];
    p.out = (float*)d_out; p.ws = (unsigned char*)d_ws;
#if MK_PER_PHASE
    for (int ph = 0; ph < N_PHASES; ++ph) {
        if (ph > 0) { const int l = (ph - 1) / PH_PER_LAYER, loc = (ph - 1) % PH_PER_LAYER; if ((l % 3) != 0 && loc >= 2 && loc <= 5) continue; }
        p.ph_lo = ph; p.ph_hi = ph + 1;
        hipLaunchKernelGGL(mega_fwd, dim3(grid), dim3(NT), LDS_BYTES, stream, p);
    }
#else
#ifndef MK_PH_HI
#define MK_PH_HI N_PHASES
#endif
    p.ph_lo = 0; p.ph_hi = MK_PH_HI;
    hipLaunchKernelGGL(mega_fwd, dim3(grid), dim3(NT), LDS_BYTES, stream, p);
#endif
    const hipError_t le = hipPeekAtLastError();
    if (le != hipSuccess) fprintf(stderr, "kernel_launch: launch failed: %s\n", hipGetErrorName(le));
}
```
